# Optimizing an MI355X kernel written in HIP

```python
import math
import jax
import jax.numpy as jnp
from jax import lax
import numpy as np

D_MODEL = 1024
BATCH = 8
SEQ = 2048
DEPTH = 4

GRID_W = 64
CTX_LEN = 256
N_MIXERS = 3
EPS = 1e-6

S5_GROUP = 16
S5_GROUPS = D_MODEL // S5_GROUP
S5_STATE = 64
S5_DT_MIN = 1e-3
S5_DT_MAX = 1e-1

HEAD_DIM = 64
N_Q_HEADS = D_MODEL // HEAD_DIM
N_KV_HEADS = 4
Q_PER_KV = N_Q_HEADS // N_KV_HEADS
KV_COLS = 2 * N_KV_HEADS * HEAD_DIM
ROPE_AXIS_DIM = HEAD_DIM // 2
ROPE_THETA = 10000.0
Q_BLOCK = 128

ML_HEADS = 8
ML_QK_DIM = D_MODEL // 2
ML_V_DIM = D_MODEL
ML_DQK = ML_QK_DIM // ML_HEADS
ML_DV = ML_V_DIM // ML_HEADS
ML_GATE_COLS = 2 * 2 * ML_HEADS
ML_STATE_COLS = ML_QK_DIM + ML_V_DIM + ML_GATE_COLS
ML_IN_COLS = ML_STATE_COLS + ML_QK_DIM + ML_V_DIM
ML_CHUNK = 128

N_EXPERTS = 16
N_GROUPS = 4
EXPERTS_PER_GROUP = N_EXPERTS // N_GROUPS
TOP_K = 2
D_FF_EXPERT = D_MODEL // 2

N_A_LAYERS = (DEPTH + 2) // N_MIXERS
N_B_LAYERS = (DEPTH + 1) // N_MIXERS
N_C_LAYERS = DEPTH // N_MIXERS

kernel_name = 'hybrid_s5_gqa_mlstm_moe_dit'


def rmsnorm(x, g):
    x32 = x.astype(jnp.float32)
    y = x32 * lax.rsqrt(jnp.mean(x32 * x32, axis=-1, keepdims=True) + EPS)
    return (y * g.astype(jnp.float32)).astype(x.dtype)


def modulate(h, shift, scale):
    return h * (1.0 + scale) + shift


def axial_rope_tables(n_tokens):
    rows = n_tokens // GRID_W
    row = jnp.repeat(jnp.arange(rows), GRID_W).astype(jnp.float32)
    col = jnp.tile(jnp.arange(GRID_W), rows).astype(jnp.float32)
    half = ROPE_AXIS_DIM // 2
    inv_freq = ROPE_THETA ** (-jnp.arange(half, dtype=jnp.float32) / half)
    ang_r = row[:, None] * inv_freq
    ang_c = col[:, None] * inv_freq
    return jnp.cos(ang_r), jnp.sin(ang_r), jnp.cos(ang_c), jnp.sin(ang_c)


def _rotate_half(x, cos, sin):
    x1, x2 = jnp.split(x, 2, axis=-1)
    cos, sin = cos[:, None, :], sin[:, None, :]
    return jnp.concatenate([x1 * cos - x2 * sin, x2 * cos + x1 * sin], axis=-1)


def apply_axial_rope(x, tables):
    cos_r, sin_r, cos_c, sin_c = tables
    x32 = x.astype(jnp.float32)
    out = jnp.concatenate([_rotate_half(x32[..., :ROPE_AXIS_DIM], cos_r, sin_r),
                           _rotate_half(x32[..., ROPE_AXIS_DIM:], cos_c, sin_c)], axis=-1)
    return out.astype(x.dtype)


def s5_discretise(lam_re, lam_im, log_step, b_re, b_im):
    f32 = jnp.float32
    lam_re, lam_im = lam_re.astype(f32), lam_im.astype(f32)
    dt = jnp.exp(log_step.astype(f32))[:, None]
    mag = jnp.exp(lam_re * dt)
    a_re, a_im = mag * jnp.cos(lam_im * dt), mag * jnp.sin(lam_im * dt)
    den = lam_re * lam_re + lam_im * lam_im
    n_re, n_im = a_re - 1.0, a_im
    f_re = (n_re * lam_re + n_im * lam_im) / den
    f_im = (n_im * lam_re - n_re * lam_im) / den
    b_re, b_im = b_re.astype(f32), b_im.astype(f32)
    bb_re = f_re[..., None] * b_re - f_im[..., None] * b_im
    bb_im = f_re[..., None] * b_im + f_im[..., None] * b_re
    return a_re, a_im, bb_re, bb_im


def _ssm_combine(left, right):
    a_re1, a_im1, x_re1, x_im1 = left
    a_re2, a_im2, x_re2, x_im2 = right
    return (a_re1 * a_re2 - a_im1 * a_im2,
            a_re1 * a_im2 + a_im1 * a_re2,
            a_re2 * x_re1 - a_im2 * x_im1 + x_re2,
            a_re2 * x_im1 + a_im2 * x_re1 + x_im2)


def s5_scan(a_re, a_im, bu_re, bu_im, reverse):
    n = bu_re.shape[1]
    a_re_seq = jnp.broadcast_to(a_re, (1, n) + a_re.shape)
    a_im_seq = jnp.broadcast_to(a_im, (1, n) + a_im.shape)
    _, _, x_re, x_im = lax.associative_scan(
        _ssm_combine, (a_re_seq, a_im_seq, bu_re, bu_im), reverse=reverse, axis=1)
    return x_re, x_im


def s5_direction(u_c, u_l, lam_re, lam_im, log_step, b_re, b_im, c_re, c_im, reverse, with_ctx):
    a_re, a_im, bb_re, bb_im = s5_discretise(lam_re, lam_im, log_step, b_re, b_im)
    c_re, c_im = c_re.astype(jnp.float32), c_im.astype(jnp.float32)

    def drive(u):
        return (jnp.einsum('blgc,gpc->blgp', u, bb_re), jnp.einsum('blgc,gpc->blgp', u, bb_im))

    def readout(x_re, x_im):
        return (jnp.einsum('blgp,gcp->blgc', x_re, c_re)
                - jnp.einsum('blgp,gcp->blgc', x_im, c_im))

    bc_re, bc_im = drive(u_c)
    xc_re, xc_im = s5_scan(a_re, a_im, bc_re, bc_im, reverse)
    last = 0 if reverse else -1
    s_re, s_im = xc_re[:, last], xc_im[:, last]
    bl_re, bl_im = drive(u_l)
    first = -1 if reverse else 0
    bl_re = bl_re.at[:, first].add(a_re * s_re - a_im * s_im)
    bl_im = bl_im.at[:, first].add(a_re * s_im + a_im * s_re)
    xl_re, xl_im = s5_scan(a_re, a_im, bl_re, bl_im, reverse)
    y_l = readout(xl_re, xl_im)
    y_c = readout(xc_re, xc_im) if with_ctx else None
    return y_c, y_l


def s5_mixer(hc, hl, lam_re, lam_im, log_step, b_re, b_im, c_re, c_im, d_skip, w_glu, b_glu, with_ctx):
    def to_groups(h):
        return h.astype(jnp.float32).reshape(h.shape[0], h.shape[1], S5_GROUPS, S5_GROUP)

    u_c, u_l = to_groups(hc), to_groups(hl)
    y_c, y_l = 0.0, 0.0
    for d in range(2):
        yc_d, yl_d = s5_direction(u_c, u_l, lam_re[d], lam_im[d], log_step[d], b_re[d], b_im[d],
                                  c_re[d], c_im[d], d == 1, with_ctx)
        y_l = y_l + yl_d
        if with_ctx:
            y_c = y_c + yc_d

    def glu_out(y, h):
        y = y.reshape(h.shape).astype(h.dtype) + d_skip * h
        a, g = jnp.split(jax.nn.gelu(y) @ w_glu + b_glu, 2, axis=-1)
        return a * jax.nn.sigmoid(g)

    return (glu_out(y_c, hc) if with_ctx else None), glu_out(y_l, hl)


def block_attention(q, k, v):
    b, lq = q.shape[:2]
    nb = lq // Q_BLOCK
    qb = q.reshape(b, nb, Q_BLOCK, N_KV_HEADS, Q_PER_KV, HEAD_DIM).transpose(1, 0, 2, 3, 4, 5)
    scale = HEAD_DIM ** -0.5

    def one_block(q_blk):
        s = jnp.einsum('bqkgd,bskd->bkgqs', q_blk, k).astype(jnp.float32) * scale
        p = jax.nn.softmax(s, axis=-1).astype(v.dtype)
        return jnp.einsum('bkgqs,bskd->bqkgd', p, v)

    out = lax.map(one_block, qb)
    return out.transpose(1, 0, 2, 3, 4, 5).reshape(b, lq, N_Q_HEADS * HEAD_DIM)


def gqa_project(h, w_kvq, q_gain, k_gain, need_q):
    b, n, _ = h.shape
    w = w_kvq if need_q else w_kvq[:, :KV_COLS]
    proj = h @ w
    k = rmsnorm(proj[..., :KV_COLS // 2].reshape(b, n, N_KV_HEADS, HEAD_DIM), k_gain)
    v = proj[..., KV_COLS // 2:KV_COLS].reshape(b, n, N_KV_HEADS, HEAD_DIM)
    q = rmsnorm(proj[..., KV_COLS:].reshape(b, n, N_Q_HEADS, HEAD_DIM), q_gain) if need_q else None
    return q, k, v


def gqa_mixer(hc, hl, w_kvq, q_gain, k_gain, w_o, with_ctx):
    q_c, k_c, v_c = gqa_project(hc, w_kvq, q_gain, k_gain, with_ctx)
    q_l, k_l, v_l = gqa_project(hl, w_kvq, q_gain, k_gain, True)
    tables = axial_rope_tables(hl.shape[1])
    q_l = apply_axial_rope(q_l, tables)
    k_l = apply_axial_rope(k_l, tables)
    k_all = jnp.concatenate([k_l, k_c], axis=1)
    v_all = jnp.concatenate([v_l, v_c], axis=1)
    y_l = block_attention(q_l, k_all, v_all) @ w_o
    y_c = block_attention(q_c, k_c, v_c) @ w_o if with_ctx else None
    return y_c, y_l


def mlstm_project(h, w_in, b_gate, need_q_o):
    b, n, _ = h.shape
    w = w_in if need_q_o else w_in[:, :ML_STATE_COLS]
    proj = (h @ w).astype(jnp.float32)
    k = proj[..., :ML_QK_DIM].reshape(b, n, ML_HEADS, ML_DQK).transpose(0, 2, 1, 3) * (ML_DQK ** -0.5)
    v = proj[..., ML_QK_DIM:ML_QK_DIM + ML_V_DIM].reshape(b, n, ML_HEADS, ML_DV).transpose(0, 2, 1, 3)
    gates = proj[..., ML_QK_DIM + ML_V_DIM:ML_STATE_COLS] + b_gate.astype(jnp.float32)
    gates = gates.reshape(b, n, 2, 2, ML_HEADS).transpose(2, 3, 0, 4, 1)
    ig, lf = gates[:, 0], jax.nn.log_sigmoid(gates[:, 1])
    q, o = None, None
    if need_q_o:
        q = proj[..., ML_STATE_COLS:ML_STATE_COLS + ML_QK_DIM].reshape(b, n, ML_HEADS, ML_DQK).transpose(0, 2, 1, 3)
        o = proj[..., ML_STATE_COLS + ML_QK_DIM:]
    return k, v, ig, lf, q, o


def mlstm_chunk_states(k, v, ig, lf, state0):
    b, h, n, dk = k.shape
    nc = n // ML_CHUNK
    kc = k.reshape(b, h, nc, ML_CHUNK, dk)
    vc = v.reshape(b, h, nc, ML_CHUNK, v.shape[-1])
    cum = jnp.cumsum(lf.reshape(b, h, nc, ML_CHUNK), axis=-1)
    total = cum[..., -1]
    w = total[..., None] - cum + ig.reshape(b, h, nc, ML_CHUNK)
    m_loc = jnp.max(w, axis=-1)
    e = jnp.exp(w - m_loc[..., None])
    c_loc = jnp.einsum('bhncd,bhnce->bhnde', kc * e[..., None], vc)
    n_loc = jnp.einsum('bhncd,bhnc->bhnd', kc, e)

    def step(carry, xs):
        c_prev, n_prev, m_prev = carry
        g, ml, cl, nl = xs
        m_new = jnp.maximum(g + m_prev, ml)
        a = jnp.exp(g + m_prev - m_new)
        bc = jnp.exp(ml - m_new)
        c_new = a[..., None, None] * c_prev + bc[..., None, None] * cl
        n_new = a[..., None] * n_prev + bc[..., None] * nl
        return (c_new, n_new, m_new), (c_prev, n_prev, m_prev)

    xs = (jnp.moveaxis(total, 2, 0), jnp.moveaxis(m_loc, 2, 0),
          jnp.moveaxis(c_loc, 2, 0), jnp.moveaxis(n_loc, 2, 0))
    final, starts = lax.scan(step, state0, xs)
    starts = tuple(jnp.moveaxis(s, 0, 2) for s in starts)
    return final, starts, cum


def mlstm_chunk_outputs(q, k, v, ig, cum, starts):
    c0, n0, m0 = starts
    b, h, n, dk = q.shape
    dv = v.shape[-1]
    nc = n // ML_CHUNK
    qc = q.reshape(b, h, nc, ML_CHUNK, dk)
    kc = k.reshape(b, h, nc, ML_CHUNK, dk)
    vc = v.reshape(b, h, nc, ML_CHUNK, dv)
    igc = ig.reshape(b, h, nc, ML_CHUNK)
    mask = jnp.tril(jnp.ones((ML_CHUNK, ML_CHUNK), dtype=bool))
    log_d = jnp.where(mask, cum[..., :, None] - cum[..., None, :] + igc[..., None, :], -jnp.inf)
    log_inter = cum + m0[..., None]
    m_row = jnp.maximum(log_inter, jnp.max(log_d, axis=-1))
    s = jnp.einsum('bhntd,bhnsd->bhnts', qc, kc) * jnp.exp(log_d - m_row[..., None])
    a_inter = jnp.exp(log_inter - m_row)
    num = (a_inter[..., None] * jnp.einsum('bhntd,bhnde->bhnte', qc, c0)
           + jnp.einsum('bhnts,bhnse->bhnte', s, vc))
    den = a_inter * jnp.einsum('bhntd,bhnd->bhnt', qc, n0) + jnp.sum(s, axis=-1)
    den = jnp.maximum(jnp.abs(den), jnp.exp(-m_row))
    return (num / den[..., None]).reshape(b, h, n, dv)


def mlstm_mixer(hc, hl, w_in, b_gate, norm_g, w_out, with_ctx):
    k_c, v_c, ig_c, lf_c, q_c, o_c = mlstm_project(hc, w_in, b_gate, with_ctx)
    k_l, v_l, ig_l, lf_l, q_l, o_l = mlstm_project(hl, w_in, b_gate, True)
    b = hl.shape[0]
    zero_state = (jnp.zeros((b, ML_HEADS, ML_DQK, ML_DV), jnp.float32),
                  jnp.zeros((b, ML_HEADS, ML_DQK), jnp.float32),
                  jnp.zeros((b, ML_HEADS), jnp.float32))
    h_c, h_l = 0.0, 0.0
    for d in range(2):
        if d == 1:
            flip_t = lambda a: jnp.flip(a, axis=2)
            flip_g = lambda a: jnp.flip(a, axis=-1)
        else:
            flip_t = lambda a: a
            flip_g = lambda a: a
        kc_d, vc_d, igc_d, lfc_d = flip_t(k_c), flip_t(v_c), flip_g(ig_c[d]), flip_g(lf_c[d])
        final_c, starts_c, cum_c = mlstm_chunk_states(kc_d, vc_d, igc_d, lfc_d, zero_state)
        kl_d, vl_d, igl_d, lfl_d = flip_t(k_l), flip_t(v_l), flip_g(ig_l[d]), flip_g(lf_l[d])
        _, starts_l, cum_l = mlstm_chunk_states(kl_d, vl_d, igl_d, lfl_d, final_c)
        h_l = h_l + flip_t(mlstm_chunk_outputs(flip_t(q_l), kl_d, vl_d, igl_d, cum_l, starts_l))
        if with_ctx:
            h_c = h_c + flip_t(mlstm_chunk_outputs(flip_t(q_c), kc_d, vc_d, igc_d, cum_c, starts_c))

    def finish(hh, o, dtype):
        bb, _, n, _ = hh.shape
        hh = rmsnorm(hh.transpose(0, 2, 1, 3), norm_g.reshape(ML_HEADS, ML_DV))
        return (hh.reshape(bb, n, ML_V_DIM) * jax.nn.sigmoid(o)).astype(dtype) @ w_out

    return (finish(h_c, o_c, hc.dtype) if with_ctx else None), finish(h_l, o_l, hl.dtype)


def moe(h, router_w, router_bias, w_gate, w_up, w_down):
    scores = jax.nn.sigmoid((h @ router_w).astype(jnp.float32))
    sel = scores + router_bias.astype(jnp.float32)
    grouped = sel.reshape(-1, N_GROUPS, EXPERTS_PER_GROUP)
    group_score = jnp.sum(lax.top_k(grouped, TOP_K)[0], axis=-1)
    best_group = jnp.argmax(group_score, axis=-1)
    in_group = (jnp.arange(N_EXPERTS) // EXPERTS_PER_GROUP)[None, :] == best_group[:, None]
    _, idx = lax.top_k(jnp.where(in_group, sel, -jnp.inf), TOP_K)
    wk = jnp.take_along_axis(scores, idx, axis=-1)
    wk = wk / jnp.sum(wk, axis=-1, keepdims=True)
    gates = jnp.sum(jax.nn.one_hot(idx, N_EXPERTS, dtype=jnp.float32) * wk[..., None], axis=1).astype(h.dtype)
    y = jnp.zeros_like(h)
    for e in range(N_EXPERTS):
        hid = jax.nn.silu(h @ w_gate[e]) * (h @ w_up[e])
        y = y + gates[:, e:e + 1] * (hid @ w_down[e])
    return y


def setup_inputs(seed: int = 0) -> dict:
    key = jax.random.key(seed)
    keys = jax.random.split(key, 40)
    f32 = jnp.float32
    D = D_MODEL

    def nrm(i, shape, s):
        return jax.random.normal(keys[i], shape, f32) * s

    lam_im_base = math.pi * jnp.arange(S5_STATE, dtype=f32)
    ml_i_bias = nrm(24, (N_C_LAYERS, 2, 1, ML_HEADS), 0.1)
    ml_f_bias = jnp.linspace(3.0, 6.0, ML_HEADS, dtype=f32) + nrm(25, (N_C_LAYERS, 2, 1, ML_HEADS), 0.1)
    return {
        'x': nrm(0, (BATCH, SEQ, D), 1.0),
        'c': nrm(1, (BATCH, D), 1.0),
        'ctx': nrm(2, (BATCH, CTX_LEN, D), 1.0),
        'c_ctx': nrm(3, (D,), 1.0),
        'ada_w': nrm(4, (DEPTH, D, 6 * D), 0.5 * D ** -0.5),
        'ada_b': nrm(5, (DEPTH, 6 * D), 0.02),
        'norm1_g': 1.0 + nrm(6, (DEPTH, D), 0.02),
        'norm2_g': 1.0 + nrm(7, (DEPTH, D), 0.02),
        'final_g': 1.0 + nrm(8, (D,), 0.02),
        's5_lambda_re': -0.5 + nrm(9, (N_A_LAYERS, 2, S5_GROUPS, S5_STATE), 0.01),
        's5_lambda_im': lam_im_base + nrm(10, (N_A_LAYERS, 2, S5_GROUPS, S5_STATE), 0.01),
        's5_log_step': jax.random.uniform(keys[11], (N_A_LAYERS, 2, S5_GROUPS), f32,
                                          math.log(S5_DT_MIN), math.log(S5_DT_MAX)),
        's5_b_re': nrm(12, (N_A_LAYERS, 2, S5_GROUPS, S5_STATE, S5_GROUP), (2 * S5_GROUP) ** -0.5),
        's5_b_im': nrm(13, (N_A_LAYERS, 2, S5_GROUPS, S5_STATE, S5_GROUP), (2 * S5_GROUP) ** -0.5),
        's5_c_re': nrm(14, (N_A_LAYERS, 2, S5_GROUPS, S5_GROUP, S5_STATE), 0.5),
        's5_c_im': nrm(15, (N_A_LAYERS, 2, S5_GROUPS, S5_GROUP, S5_STATE), 0.5),
        's5_d': nrm(16, (N_A_LAYERS, D), 1.0),
        's5_w_glu': nrm(17, (N_A_LAYERS, D, 2 * D), D ** -0.5),
        's5_b_glu': nrm(18, (N_A_LAYERS, 2 * D), 0.02),
        'attn_w_kvq': nrm(19, (N_B_LAYERS, D, KV_COLS + N_Q_HEADS * HEAD_DIM), D ** -0.5),
        'attn_q_gain': 1.0 + nrm(20, (N_B_LAYERS, HEAD_DIM), 0.02),
        'attn_k_gain': 1.0 + nrm(21, (N_B_LAYERS, HEAD_DIM), 0.02),
        'attn_w_o': nrm(22, (N_B_LAYERS, N_Q_HEADS * HEAD_DIM, D), D ** -0.5),
        'ml_w_in': nrm(23, (N_C_LAYERS, D, ML_IN_COLS), D ** -0.5),
        'ml_b_gate': jnp.concatenate([ml_i_bias, ml_f_bias], axis=2).reshape(N_C_LAYERS, ML_GATE_COLS),
        'ml_norm_g': 1.0 + nrm(26, (N_C_LAYERS, ML_V_DIM), 0.02),
        'ml_w_out': nrm(27, (N_C_LAYERS, ML_V_DIM, D), ML_V_DIM ** -0.5),
        'router_w': nrm(28, (D, N_EXPERTS), D ** -0.5),
        'router_bias': nrm(29, (N_EXPERTS,), 0.01),
        'moe_w_gate': nrm(30, (DEPTH, N_EXPERTS, D, D_FF_EXPERT), D ** -0.5),
        'moe_w_up': nrm(31, (DEPTH, N_EXPERTS, D, D_FF_EXPERT), D ** -0.5),
        'moe_w_down': nrm(32, (DEPTH, N_EXPERTS, D_FF_EXPERT, D), D_FF_EXPERT ** -0.5),
    }


def reference(x, c, ctx, c_ctx, ada_w, ada_b, norm1_g, norm2_g, final_g,
              s5_lambda_re, s5_lambda_im, s5_log_step, s5_b_re, s5_b_im, s5_c_re, s5_c_im,
              s5_d, s5_w_glu, s5_b_glu,
              attn_w_kvq, attn_q_gain, attn_k_gain, attn_w_o,
              ml_w_in, ml_b_gate, ml_norm_g, ml_w_out,
              router_w, router_bias, moe_w_gate, moe_w_up, moe_w_down):
    x_l, x_c = x, ctx
    cond_l = jax.nn.silu(c)
    cond_c = jax.nn.silu(c_ctx)
    for layer in range(DEPTH):
        kind, j = layer % N_MIXERS, layer // N_MIXERS
        with_ctx = layer < DEPTH - 1
        mod_l = (cond_l @ ada_w[layer] + ada_b[layer])[:, None, :]
        mod_c = cond_c @ ada_w[layer] + ada_b[layer]
        sh1, sc1, g1, sh2, sc2, g2 = jnp.split(mod_l, 6, axis=-1)
        csh1, csc1, cg1, csh2, csc2, cg2 = jnp.split(mod_c, 6, axis=-1)

        h_l = modulate(rmsnorm(x_l, norm1_g[layer]), sh1, sc1)
        h_c = modulate(rmsnorm(x_c, norm1_g[layer]), csh1, csc1)
        if kind == 0:
            y_c, y_l = s5_mixer(h_c, h_l, s5_lambda_re[j], s5_lambda_im[j], s5_log_step[j],
                                s5_b_re[j], s5_b_im[j], s5_c_re[j], s5_c_im[j],
                                s5_d[j], s5_w_glu[j], s5_b_glu[j], with_ctx)
        elif kind == 1:
            y_c, y_l = gqa_mixer(h_c, h_l, attn_w_kvq[j], attn_q_gain[j], attn_k_gain[j],
                                 attn_w_o[j], with_ctx)
        else:
            y_c, y_l = mlstm_mixer(h_c, h_l, ml_w_in[j], ml_b_gate[j], ml_norm_g[j],
                                   ml_w_out[j], with_ctx)
        x_l = x_l + g1 * y_l
        h2_l = modulate(rmsnorm(x_l, norm2_g[layer]), sh2, sc2)
        if with_ctx:
            x_c = x_c + cg1 * y_c
            h2_c = modulate(rmsnorm(x_c, norm2_g[layer]), csh2, csc2)
            n_ctx_tok = h2_c.shape[0] * h2_c.shape[1]
            tokens = jnp.concatenate([h2_c.reshape(-1, D_MODEL), h2_l.reshape(-1, D_MODEL)], axis=0)
            y = moe(tokens, router_w, router_bias, moe_w_gate[layer], moe_w_up[layer], moe_w_down[layer])
            x_c = x_c + cg2 * y[:n_ctx_tok].reshape(x_c.shape)
            x_l = x_l + g2 * y[n_ctx_tok:].reshape(x_l.shape)
        else:
            y = moe(h2_l.reshape(-1, D_MODEL), router_w, router_bias,
                    moe_w_gate[layer], moe_w_up[layer], moe_w_down[layer])
            x_l = x_l + g2 * y.reshape(x_l.shape)
    return rmsnorm(x_l, final_g)
```

```cpp
#include <hip/hip_runtime.h>
#include <cstdio>
#include <cstdint>

#define GAS __attribute__((address_space(1)))
#define LAS __attribute__((address_space(3)))
typedef unsigned short bf16;
typedef unsigned v4u __attribute__((ext_vector_type(4)));
typedef unsigned v2u __attribute__((ext_vector_type(2)));
typedef float f32x4 __attribute__((ext_vector_type(4)));
typedef float f32x2 __attribute__((ext_vector_type(2)));
typedef short bf16x8 __attribute__((ext_vector_type(8)));

constexpr int D = 1024, NB = 8, SEQ = 2048, CTX = 256, DEPTH = 4;
constexpr int TC = NB * CTX;
constexpr int TL = NB * SEQ;
constexpr int T = TC + TL;
constexpr int KVLEN = SEQ + CTX;
constexpr int NEXP = 16, DFF = 512;
constexpr int SLOTS = 40960;
constexpr int ML_NIN = 3328;
constexpr float EPS = 1e-6f;
constexpr int NWAVES = 8, NTHR = 512;
constexpr float ATT_C2 = 0.125f * 1.4426950408889634f;

constexpr size_t MiB = 1u << 20;
constexpr size_t WS_CTL = 0, CTL_ZERO_BYTES = 1 * MiB;
constexpr size_t WS_MOD = 1 * MiB;
constexpr size_t WS_ROPE = 2 * MiB;
constexpr size_t WS_TOKE = 2 * MiB + 65536;
constexpr size_t WS_TOKR = WS_TOKE + 163840;
constexpr size_t WS_TOKW = WS_TOKR + 163840;
constexpr size_t WS_TOKS = WS_TOKW + 163840;
constexpr size_t WS_BCNT = WS_TOKS + 163840;
constexpr size_t WS_ETAB = WS_BCNT + 16384;
constexpr size_t WS_SLOTW = WS_ETAB + 4096;
static_assert(WS_SLOTW + SLOTS * 4 <= 4 * MiB, "small tables");
constexpr size_t WS_WGLU = 4 * MiB;
constexpr size_t WS_WKVQ = WS_WGLU + 8 * MiB;
constexpr size_t WS_WO = WS_WKVQ + 3 * MiB;
constexpr size_t WS_WIN = WS_WO + 2 * MiB;
constexpr size_t WS_WOUT = WS_WIN + 7 * MiB;
constexpr size_t WS_WG1 = WS_WOUT + 2 * MiB;
constexpr size_t WS_WG2 = WS_WG1 + 128 * MiB;
constexpr size_t WS_XRES = WS_WG2 + 64 * MiB;
constexpr size_t WS_H = WS_XRES + 72 * MiB;
constexpr size_t WS_Z = WS_H + 36 * MiB;
constexpr size_t WS_MIX = WS_Z + 36 * MiB;
constexpr size_t WS_HS = WS_MIX;
constexpr size_t WS_HID = WS_HS + 80 * MiB;
constexpr size_t WS_Y2 = WS_HID + 40 * MiB;
constexpr size_t WS_END = WS_Y2 + 80 * MiB;
constexpr size_t WS_YSUM = WS_MIX;
constexpr size_t WS_QB = WS_MIX;
constexpr size_t WS_KB = WS_QB + 36 * MiB;
constexpr size_t WS_VB = WS_KB + 9 * MiB;
constexpr size_t WS_MK = WS_MIX;
constexpr size_t WS_MV = WS_MK + 18 * MiB;
constexpr size_t WS_MQ = WS_MV + 36 * MiB;
constexpr size_t WS_MO = WS_MQ + 18 * MiB;
constexpr size_t WS_MG = WS_MO + 36 * MiB;
constexpr size_t WS_MHS = WS_MG + 3 * MiB;
static_assert(WS_MHS + 72 * MiB <= WS_END, "mLSTM view fits");
static_assert(WS_END <= 600 * MiB, "workspace budget");

constexpr int CW_BAR = 4096;

constexpr int RING_OFF = 0, RING_BYTES = 131072;
constexpr int LDSCTL_OFF = RING_BYTES, MISC_OFF = LDSCTL_OFF + 320;
constexpr int ETAB_OFF = MISC_OFF + 128;
constexpr int SCT_OFF = ETAB_OFF + 128;
constexpr int LDS_BYTES = 147456;
static_assert(SCT_OFF + 256 <= LDS_BYTES, "LDS map");

#define LDS_WAIT() asm volatile("s_waitcnt lgkmcnt(0)" ::: "memory")
#define VM_WAIT() asm volatile("s_waitcnt vmcnt(0)" ::: "memory")
__device__ __forceinline__ unsigned f2bf(float f) { unsigned u = __builtin_bit_cast(unsigned, f); return (u + 0x7fffu + ((u >> 16) & 1u)) >> 16; }
typedef float f32x2_cv __attribute__((ext_vector_type(2))); typedef __bf16 bf16x2_cv __attribute__((ext_vector_type(2)));
__device__ __forceinline__ unsigned pk2(float lo, float hi) { f32x2_cv v = {lo, hi}; bf16x2_cv b = __builtin_convertvector(v, bf16x2_cv); return __builtin_bit_cast(unsigned, b); }
__device__ __forceinline__ float bf2f(unsigned h) { return __builtin_bit_cast(float, h << 16); }
__device__ __forceinline__ float bflo(unsigned w) { return __builtin_bit_cast(float, w << 16); }
__device__ __forceinline__ float bfhi(unsigned w) { return __builtin_bit_cast(float, w & 0xffff0000u); }
template <int CTRL, int RMASK = 0xF>
__device__ __forceinline__ float dpp_f(float oldv, float v) { return __builtin_bit_cast(float, __builtin_amdgcn_update_dpp(__builtin_bit_cast(int, oldv), __builtin_bit_cast(int, v), CTRL, RMASK, 0xF, false)); }
#ifndef USE_SHFL_XOR
#define USE_SHFL_XOR 0
#endif
#ifndef USE_SHFL_PARTIAL
#define USE_SHFL_PARTIAL 0
#endif
__device__ __forceinline__ float red16_sum(float v) {
#if USE_SHFL_PARTIAL
    for (int o = 1; o < 16; o <<= 1) v += __shfl_xor(v, o);
    return v;
#endif
    v += dpp_f<0xB1>(0.f, v); v += dpp_f<0x4E>(0.f, v); v += dpp_f<0x141>(0.f, v); v += dpp_f<0x140>(0.f, v); return v; }
__device__ __forceinline__ float red16_max(float v) {
    v = fmaxf(v, dpp_f<0xB1>(v, v)); v = fmaxf(v, dpp_f<0x4E>(v, v)); v = fmaxf(v, dpp_f<0x141>(v, v)); v = fmaxf(v, dpp_f<0x140>(v, v)); return v; }
#ifndef USE_SHFL_REDUCE
#define USE_SHFL_REDUCE 0
#endif
__device__ __forceinline__ float wave_sum(float v) {
#if USE_SHFL_REDUCE
    for (int o = 1; o < 64; o <<= 1) v += __shfl_xor(v, o);
    return v;
#endif
    v = red16_sum(v); v += dpp_f<0x142, 0xA>(0.f, v); v += dpp_f<0x143, 0xC>(0.f, v);
    return __builtin_bit_cast(float, __builtin_amdgcn_readlane(__builtin_bit_cast(int, v), 63)); }
__device__ __forceinline__ float wave_max(float v) {
    v = red16_max(v); v = fmaxf(v, dpp_f<0x142, 0xA>(v, v)); v = fmaxf(v, dpp_f<0x143, 0xC>(v, v));
    return __builtin_bit_cast(float, __builtin_amdgcn_readlane(__builtin_bit_cast(int, v), 63)); }
__device__ __forceinline__ float xor16_sum(float v) { return v + __shfl_xor(v, 16); }
__device__ __forceinline__ float xor32_sum(float v) { return v + __shfl_xor(v, 32); }
__device__ __forceinline__ float sigmoidf_(float x) { return __builtin_amdgcn_rcpf(1.f + __expf(-x)); }
__device__ __forceinline__ float siluf_(float x) { return x * __builtin_amdgcn_rcpf(1.f + __expf(-x)); }
__device__ __forceinline__ float gelu_tanh(float x) {
    const float p = __builtin_fmaf(x * x, 0.044715f, 1.0f);
    const float e = __builtin_amdgcn_exp2f((x * -2.302208198f) * p);
    return x * __builtin_amdgcn_rcpf(1.0f + e);
}
__device__ __forceinline__ float log_sigmoidf_(float x) { return fminf(x, 0.f) - __logf(1.f + __expf(-fabsf(x))); }
__device__ __forceinline__ void sincos_d(double a, double& s, double& c) {
    const double k = __builtin_rint(a * 0.63661977236758134308);
    double r = __builtin_fma(-k, 1.57079632679489655800e+00, a);
    r = __builtin_fma(-k, 6.12323399573676603587e-17, r);
    const double r2 = r * r;
    double sp = -1.0 / 1307674368000.0;
    sp = sp * r2 + 1.0 / 6227020800.0; sp = sp * r2 - 1.0 / 39916800.0; sp = sp * r2 + 1.0 / 362880.0; sp = sp * r2 - 1.0 / 5040.0; sp = sp * r2 + 1.0 / 120.0; sp = sp * r2 - 1.0 / 6.0;
    const double sr = r + r * r2 * sp;
    double cp = 1.0 / 20922789888000.0;
    cp = cp * r2 - 1.0 / 87178291200.0; cp = cp * r2 + 1.0 / 479001600.0; cp = cp * r2 - 1.0 / 3628800.0; cp = cp * r2 + 1.0 / 40320.0; cp = cp * r2 - 1.0 / 720.0; cp = cp * r2 + 1.0 / 24.0; cp = cp * r2 - 0.5;
    const double cr = 1.0 + r2 * cp;
    const int q = ((int)k) & 3;
    s = (q == 0) ? sr : (q == 1) ? cr : (q == 2) ? -sr : -cr;
    c = (q == 0) ? cr : (q == 1) ? -sr : (q == 2) ? -cr : sr;
}
__device__ __forceinline__ int mrow_of(int r) { return r < TC ? 8 : ((r - TC) >> 11); }
namespace pg8 {
#define PG8_LAS __attribute__((address_space(3)))
typedef unsigned short bf16_t;
typedef short bf16x8 __attribute__((ext_vector_type(8)));
typedef float f32x4 __attribute__((ext_vector_type(4)));
typedef unsigned u32x4 __attribute__((ext_vector_type(4)));
constexpr int BM = 256, BK = 64, HALF = 128, HTB = HALF * BK * 2  , STAGE_BYTES = 8 * HTB, NXCD = 8, WGM = 8;

__host__ __device__ __forceinline__ int lds_byte(int r, int c) { const int st = (r >> 4) * 2 + (c >> 5), rr = r & 15, cc = c & 31, ob = rr * 64 + cc * 2; return st * 1024 + (ob ^ (((ob >> 9) & 1) << 5)); }
__host__ __device__ __forceinline__ void stage_rc(int b, int& R, int& C) { const int st = b / 1024, sb = b % 1024, swz = sb ^ (((sb >> 9) & 1) << 5); R = (st >> 1) * 16 + swz / 64; C = (st & 1) * 32 + (swz % 64) / 2; }
__host__ __device__ __forceinline__ int perm32(int rho) { const int n = rho >> 4, i = rho & 15; return 8 * (i >> 2) + 4 * n + (i & 3); }

struct Unit { int pm, pn; };
struct Gemm { const bf16_t* A; const bf16_t* Bt; int M, N, K; };

struct StaticOrder {
    int nM, nN, nwg, G, c;
    __host__ __device__ void init(int M, int N, int G_, int c_) { nM = M / BM; nN = N / BM; nwg = nM * nN; G = G_; c = c_; }
    __host__ __device__ bool next(int i, Unit& u) const {
        const long L = (long)i * G + c; if (L >= nwg) return false;
        int wgid = (int)L; { const int q = nwg / NXCD, r = nwg % NXCD, xcd = wgid % NXCD, off = wgid / NXCD; wgid = (xcd < r ? xcd * (q + 1) : r * (q + 1) + (xcd - r) * q) + off; }
        const int nig = WGM * nN, gid = wgid / nig, fm = gid * WGM, gsz = (nM - fm) < WGM ? (nM - fm) : WGM;
        u.pm = fm + ((wgid % nig) % gsz); u.pn = (wgid % nig) / gsz; return true;
    }
    __device__ __forceinline__ void a_ready(const Unit&) const {}
    __device__ __forceinline__ void done(const Unit&) const {}
};


template <class Epi, class Sched, bool ALIGN_EPI = false, bool SP2 = false>
__device__ __forceinline__ void gemm_phase(PG8_LAS unsigned char* lds, const Gemm g, const Sched& S, const Epi& E) {
    const int tid = threadIdx.x, wid = __builtin_amdgcn_readfirstlane(tid >> 6), lane = tid & 63, wr = wid >> 2, wc = wid & 3, fr = lane & 15, fq = lane >> 4;
    const int K = g.K, nt = K / BK;
    unsigned voffA[2], voffB[2];
#pragma unroll
    for (int i = 0; i < 2; ++i) { int R, C; stage_rc(tid * 16 + i * 8192, R, C); const int Rb = Epi::PERM ? ((R & ~31) + perm32(R & 31)) : R;
        voffA[i] = (unsigned)(R * K + C) * 2u; voffB[i] = (unsigned)(Rb * K + C) * 2u; }
    const size_t kstep = (size_t)(BK * 2);
    const size_t hstep = (size_t)HALF * K * 2;
    const size_t tstep = 2 * hstep;
    const unsigned ldsw = (unsigned)wid * 1024u;
    const int aoff = lds_byte(wr * 64 + fr, fq * 8), boff = lds_byte(wc * 32 + fr, fq * 8);
#define PG8_SA(b, h) (((b) * 2 + (h)) * HTB)
#define PG8_SB(b, h) ((4 + (b) * 2 + (h)) * HTB)
#define PG8_STAGE(bufoff, gbase, voff) do { _Pragma("unroll") for (int _i = 0; _i < 2; ++_i) \
        __builtin_amdgcn_global_load_lds((const unsigned*)((const char*)(gbase) + (voff)[_i]), (PG8_LAS unsigned*)(lds + (bufoff) + ldsw + _i * 8192), 16, 0, 0); } while (0)
#define PG8_LDA(dst, b, h) do { _Pragma("unroll") for (int m = 0; m < 4; ++m) _Pragma("unroll") for (int k = 0; k < 2; ++k) dst[m][k] = *(const PG8_LAS bf16x8*)(lds + PG8_SA(b, h) + aoff + m * 2048 + k * 1024); } while (0)
#define PG8_LDB(dst, b, h) do { _Pragma("unroll") for (int n = 0; n < 2; ++n) _Pragma("unroll") for (int k = 0; k < 2; ++k) dst[n][k] = *(const PG8_LAS bf16x8*)(lds + PG8_SB(b, h) + boff + n * 2048 + k * 1024); } while (0)
#define PG8_MMA(ai, bj, At, Bt) do { __builtin_amdgcn_s_setprio(1); _Pragma("unroll") for (int m = 0; m < 4; ++m) _Pragma("unroll") for (int n = 0; n < 2; ++n) _Pragma("unroll") for (int k = 0; k < 2; ++k) \
        acc[ai][bj][m][n] = __builtin_amdgcn_mfma_f32_16x16x32_bf16(Bt[n][k], At[m][k], acc[ai][bj][m][n], 0, 0, 0); __builtin_amdgcn_s_setprio(0); } while (0)
#define PG8_WAIT_V(n) asm volatile("s_waitcnt vmcnt(" #n ")" ::: "memory")
#define PG8_WAIT_L(n) asm volatile("s_waitcnt lgkmcnt(" #n ")" ::: "memory")
#define PG8_BAR __builtin_amdgcn_s_barrier()
#define PG8_SCHED __builtin_amdgcn_sched_barrier(0)
    Unit cur, nxt; int ui = 0;
    if (!S.next(0, cur)) return;
    f32x4 acc[2][2][4][2];
#pragma unroll
    for (int a = 0; a < 2; ++a)
#pragma unroll
        for (int b = 0; b < 2; ++b)
#pragma unroll
            for (int m = 0; m < 4; ++m)
#pragma unroll
                for (int n = 0; n < 2; ++n) acc[a][b][m][n] = (f32x4){0.f, 0.f, 0.f, 0.f};
    bf16x8 At[4][2], B0[2][2], B1[2][2];
    const char* cA = (const char*)g.A + (size_t)cur.pm * tstep; const char* cB = (const char*)g.Bt + (size_t)cur.pn * tstep;
    S.a_ready(cur);
    if constexpr (SP2) {
        PG8_STAGE(PG8_SB(0, 0), cB, voffB); PG8_STAGE(PG8_SB(0, 1), cB + hstep, voffB); PG8_STAGE(PG8_SA(0, 0), cA, voffA); PG8_STAGE(PG8_SA(0, 1), cA + hstep, voffA);
        if (wr == 1) PG8_BAR;
        PG8_WAIT_V(2); PG8_BAR;
        PG8_STAGE(PG8_SB(1, 0), cB + kstep, voffB); PG8_STAGE(PG8_SA(1, 0), cA + kstep, voffA); PG8_STAGE(PG8_SB(1, 1), cB + hstep + kstep, voffB);
        PG8_WAIT_V(6); PG8_BAR;
    } else {
        PG8_STAGE(PG8_SB(0, 0), cB, voffB); PG8_STAGE(PG8_SA(0, 0), cA, voffA); PG8_STAGE(PG8_SB(0, 1), cB + hstep, voffB); PG8_STAGE(PG8_SA(0, 1), cA + hstep, voffA);
        if (wr == 1) PG8_BAR;
        PG8_WAIT_V(4); PG8_BAR;
        PG8_STAGE(PG8_SB(1, 0), cB + kstep, voffB); PG8_STAGE(PG8_SA(1, 0), cA + kstep, voffA); PG8_STAGE(PG8_SB(1, 1), cB + hstep + kstep, voffB);
        PG8_WAIT_V(6); PG8_BAR;
    }
    for (;;) {
        const bool has_next = S.next(ui + 1, nxt);
        const char* nA = has_next ? (const char*)g.A + (size_t)nxt.pm * tstep : cA; const char* nB = has_next ? (const char*)g.Bt + (size_t)nxt.pn * tstep : cB;
        for (int t = 0; t < nt; t += 2) {
            const bool last = (t == nt - 2);
            const char* a1 = cA + (size_t)(t + 1) * kstep;
            const char* a2 = last ? nA : cA + (size_t)(t + 2) * kstep; const char* b2 = last ? nB : cB + (size_t)(t + 2) * kstep;
            const char* a3 = a2 + kstep; const char* b3 = b2 + kstep;
            if (last && has_next) S.a_ready(nxt);
            if constexpr (SP2) {
            PG8_LDB(B0, 0, 0); PG8_LDB(B1, 0, 1); PG8_SCHED; PG8_LDA(At, 0, 0); PG8_STAGE(PG8_SA(1, 1), a1 + hstep, voffA);
            PG8_WAIT_V(8); PG8_WAIT_L(0); PG8_BAR; PG8_MMA(0, 0, At, B0); PG8_MMA(0, 1, At, B1); PG8_BAR; PG8_SCHED;
            PG8_LDA(At, 0, 1); PG8_STAGE(PG8_SB(0, 0), b2, voffB); PG8_STAGE(PG8_SB(0, 1), b2 + hstep, voffB); PG8_STAGE(PG8_SA(0, 0), a2, voffA);
            PG8_WAIT_V(8); PG8_WAIT_L(0); PG8_BAR; PG8_MMA(1, 0, At, B0); PG8_MMA(1, 1, At, B1); PG8_BAR; PG8_SCHED;
            PG8_LDB(B0, 1, 0); PG8_LDB(B1, 1, 1); PG8_SCHED; PG8_LDA(At, 1, 0); PG8_STAGE(PG8_SA(0, 1), a2 + hstep, voffA);
            PG8_WAIT_V(8); PG8_WAIT_L(0); PG8_BAR; PG8_MMA(0, 0, At, B0); PG8_MMA(0, 1, At, B1); PG8_BAR; PG8_SCHED;
            PG8_LDA(At, 1, 1); PG8_STAGE(PG8_SB(1, 0), b3, voffB); PG8_STAGE(PG8_SB(1, 1), b3 + hstep, voffB); PG8_STAGE(PG8_SA(1, 0), a3, voffA);
            PG8_WAIT_V(8); PG8_WAIT_L(0); PG8_BAR; PG8_MMA(1, 0, At, B0); PG8_MMA(1, 1, At, B1); PG8_BAR; PG8_SCHED;
            } else {
            PG8_LDB(B0, 0, 0); PG8_SCHED; PG8_LDA(At, 0, 0); PG8_STAGE(PG8_SA(1, 1), a1 + hstep, voffA);
            PG8_WAIT_L(8); PG8_BAR; PG8_WAIT_L(0); PG8_MMA(0, 0, At, B0); PG8_BAR; PG8_SCHED;
            PG8_LDB(B1, 0, 1); PG8_STAGE(PG8_SB(0, 0), b2, voffB);
            PG8_BAR; PG8_WAIT_L(0); PG8_MMA(0, 1, At, B1); PG8_BAR;
            PG8_LDA(At, 0, 1); PG8_STAGE(PG8_SA(0, 0), a2, voffA);
            PG8_BAR; PG8_WAIT_L(0); PG8_MMA(1, 0, At, B0); PG8_BAR; PG8_SCHED;
            PG8_STAGE(PG8_SB(0, 1), b2 + hstep, voffB);
            PG8_WAIT_V(6); PG8_BAR; PG8_MMA(1, 1, At, B1); PG8_BAR;
            PG8_LDB(B0, 1, 0); PG8_SCHED; PG8_LDA(At, 1, 0); PG8_STAGE(PG8_SA(0, 1), a2 + hstep, voffA);
            PG8_WAIT_L(8); PG8_BAR; PG8_WAIT_L(0); PG8_MMA(0, 0, At, B0); PG8_BAR; PG8_SCHED;
            PG8_LDB(B1, 1, 1); PG8_STAGE(PG8_SB(1, 0), b3, voffB);
            PG8_BAR; PG8_WAIT_L(0); PG8_MMA(0, 1, At, B1); PG8_BAR;
            PG8_LDA(At, 1, 1); PG8_STAGE(PG8_SA(1, 0), a3, voffA);
            PG8_BAR; PG8_WAIT_L(0); PG8_MMA(1, 0, At, B0); PG8_BAR; PG8_SCHED;
            PG8_STAGE(PG8_SB(1, 1), b3 + hstep, voffB);
            PG8_WAIT_V(6); PG8_BAR; PG8_MMA(1, 1, At, B1); PG8_BAR;
            }
        }
        if constexpr (ALIGN_EPI) { if (wr == 0) PG8_BAR; }
        if constexpr (!Epi::AFTER_DRAIN) { E(acc, cur, wr, wc, fr, fq); S.done(cur); }
        if (!has_next) break;
#pragma unroll
        for (int a = 0; a < 2; ++a)
#pragma unroll
            for (int b = 0; b < 2; ++b)
#pragma unroll
                for (int m = 0; m < 4; ++m)
#pragma unroll
                    for (int n = 0; n < 2; ++n) acc[a][b][m][n] = (f32x4){0.f, 0.f, 0.f, 0.f};
        cur = nxt; cA = nA; cB = nB; ++ui;
        if constexpr (ALIGN_EPI) { if (wr == 1) PG8_BAR; }
    }
    PG8_WAIT_V(0);
    if constexpr (!ALIGN_EPI) { if (wr == 0) PG8_BAR; }
    PG8_BAR;
    if constexpr (Epi::AFTER_DRAIN) { E.fused(acc, cur, wr, wc, fr, fq, lds, wid, lane); S.done(cur); }
#undef PG8_SA
#undef PG8_SB
#undef PG8_STAGE
#undef PG8_LDA
#undef PG8_LDB
#undef PG8_MMA
#undef PG8_WAIT_V
#undef PG8_WAIT_L
#undef PG8_BAR
#undef PG8_SCHED
}
}
#define XB_TMO      128
#define XB_XCNT(j)  (256  + 64 * (j))
#define XB_XSUB(j)  (1280 + 64 * (j))
#define XB_XGEN(j)  (2304 + 64 * (j))
#define XB_TOP      3328
#define XB_TOPGEN   3392
#define XCD_BAR_WORDS 3456
#define XB_SPIN_CAP (1u << 22)

__device__ __forceinline__ unsigned xb_ld(unsigned* p)              { return __hip_atomic_load(p, __ATOMIC_RELAXED, __HIP_MEMORY_SCOPE_AGENT); }
__device__ __forceinline__ unsigned xb_add(unsigned* p, unsigned v) { return __hip_atomic_fetch_add(p, v, __ATOMIC_RELAXED, __HIP_MEMORY_SCOPE_AGENT); }
__device__ __forceinline__ unsigned xb_xcc_id() { return (unsigned)__builtin_amdgcn_s_getreg((3 << 11) | 20) & 0xFu; }
#define XB_SPIN(cond, bar) do { unsigned _sp = 0; while (cond) { __builtin_amdgcn_s_sleep(1); \
    if ((++_sp & 255u) == 0u) { if (xb_ld(&(bar)[XB_TMO])) break; if (_sp > XB_SPIN_CAP) { atomicAdd(&(bar)[XB_TMO], 1u); break; } } } } while (0)

struct XcdBarrier {
    unsigned* bar; unsigned x;
    volatile LAS unsigned* st;
};

__device__ __forceinline__ XcdBarrier xcd_barrier_post(unsigned* bar, volatile LAS unsigned* st) {
    XcdBarrier b; b.bar = bar; b.x = xb_xcc_id(); b.st = st;
    if (threadIdx.x == 0) (void)xb_add(&bar[XB_XCNT(b.x)], 1u);
    return b;
}
__device__ __forceinline__ void xcd_barrier_complete(unsigned* bar, unsigned x, unsigned& nloc, unsigned& nx) {
    const unsigned G = gridDim.x * gridDim.y * gridDim.z;
    unsigned sum, cnt, mine, sp = 0u;
    for (;;) {
        sum = 0u; cnt = 0u; mine = 0u;
#pragma unroll
        for (unsigned j = 0; j < 16; ++j) { const unsigned c = xb_ld(&bar[XB_XCNT(j)]); sum += c; cnt += (c > 0u) ? 1u : 0u; mine = (j == x) ? c : mine; }
        if (sum == G) break;
        __builtin_amdgcn_s_sleep(1);
        if ((++sp & 255u) == 0u) { if (xb_ld(&bar[XB_TMO])) break; if (sp > XB_SPIN_CAP) { atomicAdd(&bar[XB_TMO], 1u); break; } }
    }
    nloc = mine > 0u ? mine : 1u; nx = cnt > 0u ? cnt : 1u;
}

__device__ __forceinline__ void xcd_barrier(const XcdBarrier& b) {
    asm volatile("s_waitcnt vmcnt(0)" ::: "memory");
    __syncthreads();
    if (threadIdx.x == 0) {
        unsigned* bar = b.bar;
        __builtin_amdgcn_s_waitcnt(0);
        unsigned nloc = b.st[0], nx = b.st[1];
        if (nloc == 0u) { xcd_barrier_complete(bar, b.x, nloc, nx); b.st[0] = nloc; b.st[1] = nx; }
        const unsigned old = xb_add(&bar[XB_XSUB(b.x)], 1u);
        const unsigned gen = old / nloc;
        if (old + 1u == (gen + 1u) * nloc) {
            __builtin_amdgcn_fence(__ATOMIC_RELEASE, "agent");
            asm volatile("s_waitcnt vmcnt(0)" ::: "memory");
            const unsigned og = xb_add(&bar[XB_TOP], 1u);
            const unsigned tg = og / nx;
            if (og + 1u == (tg + 1u) * nx) xb_add(&bar[XB_TOPGEN], 1u);
            else XB_SPIN(xb_ld(&bar[XB_TOPGEN]) == tg, bar);
            __builtin_amdgcn_fence(__ATOMIC_ACQUIRE, "agent");
            xb_add(&bar[XB_XGEN(b.x)], 1u);
            asm volatile("s_waitcnt vmcnt(0)" ::: "memory");
        } else {
            XB_SPIN(xb_ld(&bar[XB_XGEN(b.x)]) == gen, bar);
            __builtin_amdgcn_fence(__ATOMIC_ACQUIRE, "agent");
            asm volatile("s_waitcnt vmcnt(0)" ::: "memory");
        }
    }
    __syncthreads();
}

enum { IN_X = 0, IN_C, IN_CTX, IN_CCTX, IN_ADAW, IN_ADAB, IN_N1G, IN_N2G, IN_FING, IN_S5LRE, IN_S5LIM, IN_S5LOG, IN_S5BRE, IN_S5BIM, IN_S5CRE, IN_S5CIM,
       IN_S5D, IN_S5WGLU, IN_S5BGLU, IN_AWKVQ, IN_AQG, IN_AKG, IN_AWO, IN_MLWIN, IN_MLBG, IN_MLNG, IN_MLWOUT, IN_RW, IN_RB, IN_MWG, IN_MWU, IN_MWD, N_INPUTS };

struct Frame {
    LAS unsigned char* lds;
    volatile LAS unsigned* MISC;
    unsigned* ctl;
    int tid, lane, wave, G, blk;
    const float* in[N_INPUTS];
    unsigned char* ws;
    float* out;
};

struct DenseSched {
    pg8::StaticOrder so; int pm0;
    __device__ __forceinline__ void init(int Mrows, int N, int G, int c, int pm0_) { so.init(Mrows, N, G, c); pm0 = pm0_; }
    __device__ __forceinline__ bool next(int i, pg8::Unit& u) const { if (!so.next(i, u)) return false; u.pm += pm0; return true; }
    __device__ __forceinline__ void a_ready(const pg8::Unit&) const {}
    __device__ __forceinline__ void done(const pg8::Unit&) const {}
};
struct MoeSched {
    const LAS int* tab; int G, c, npn;
    __device__ __forceinline__ bool next(int i, pg8::Unit& u) const {
        const int total = tab[16] * npn;
        int L;
        if ((G & 7) == 0) { const int x = c & 7, rank = c >> 3, per = G >> 3; const int q = total >> 3, rem = total & 7; const int start = x * q + (x < rem ? x : rem), cnt = q + (x < rem ? 1 : 0);
            const int off = rank + per * i; if (off >= cnt) return false; L = start + off; }
        else { L = i * G + c; if (L >= total) return false; }
        int e = 0;
#pragma unroll
        for (int k = 1; k < 16; ++k) e += (L >= tab[k] * npn) ? 1 : 0;
        const int ts = tab[e], te = tab[e + 1] - ts, idx = L - ts * npn;
        u.pm = __builtin_amdgcn_readfirstlane(ts + idx % te); u.pn = __builtin_amdgcn_readfirstlane(e * npn + idx / te); return true;
    }
    __device__ __forceinline__ void a_ready(const pg8::Unit&) const {}
    __device__ __forceinline__ void done(const pg8::Unit&) const {}
};

template <class Epi, class Sched>
__device__ __forceinline__ void gemm_phase_naive(const pg8::Gemm g, const Sched& S, const Epi& E) {
    const int tid = threadIdx.x, wid = tid >> 6, lane = tid & 63, wr = wid >> 2, wc = wid & 3, fr = lane & 15, fq = lane >> 4;
    const int K = g.K; pg8::Unit u;
    for (int i = 0; S.next(i, u); ++i) {
        f32x4 acc[2][2][4][2];
#pragma unroll
        for (int ai = 0; ai < 2; ++ai)
#pragma unroll
            for (int m = 0; m < 4; ++m) {
                const int row = u.pm * 256 + ai * 128 + wr * 64 + m * 16 + fr;
                const bf16* ap = g.A + (size_t)row * K;
                float s[2][2][4];
#pragma unroll
                for (int bj = 0; bj < 2; ++bj)
#pragma unroll
                    for (int n = 0; n < 2; ++n)
#pragma unroll
                        for (int e = 0; e < 4; ++e) s[bj][n][e] = 0.f;
                for (int k = 0; k < K; k += 8) {
                    const v4u av = *(const v4u*)(ap + k);
                    const float a0 = bflo(av.x), a1 = bfhi(av.x), a2 = bflo(av.y), a3 = bfhi(av.y), a4 = bflo(av.z), a5 = bfhi(av.z), a6 = bflo(av.w), a7 = bfhi(av.w);
#pragma unroll
                    for (int bj = 0; bj < 2; ++bj)
#pragma unroll
                        for (int n = 0; n < 2; ++n)
#pragma unroll
                            for (int e = 0; e < 4; ++e) {
                                const int col = u.pn * 256 + bj * 128 + wc * 32 + n * 16 + fq * 4 + e;
                                const v4u bv = *(const v4u*)(g.Bt + (size_t)col * K + k);
                                float t = s[bj][n][e];
                                t += a0 * bflo(bv.x); t += a1 * bfhi(bv.x); t += a2 * bflo(bv.y); t += a3 * bfhi(bv.y);
                                t += a4 * bflo(bv.z); t += a5 * bfhi(bv.z); t += a6 * bflo(bv.w); t += a7 * bfhi(bv.w);
                                s[bj][n][e] = t;
                            }
                }
#pragma unroll
                for (int bj = 0; bj < 2; ++bj)
#pragma unroll
                    for (int n = 0; n < 2; ++n) acc[ai][bj][m][n] = (f32x4){s[bj][n][0], s[bj][n][1], s[bj][n][2], s[bj][n][3]};
            }
        E(acc, u, wr, wc, fr, fq);
    }
}
#ifndef USE_NAIVE_GEMM
#define USE_NAIVE_GEMM 0
#endif
template <class Epi, class Sched>
__device__ __forceinline__ void run_gemm(Frame& F, const pg8::Gemm g, const Sched& S, const Epi& E) {
#if USE_NAIVE_GEMM
    gemm_phase_naive<Epi, Sched>(g, S, E);
#else
    pg8::gemm_phase<Epi, Sched, true, true>(F.lds + RING_OFF, g, S, E);
#endif
}

__device__ __forceinline__ void st_bf4(bf16* p, f32x4 v) { v2u w; w.x = pk2(v.x, v.y); w.y = pk2(v.z, v.w); *(v2u*)p = w; }

struct EpiRes {
    static constexpr bool PERM = false, AFTER_DRAIN = false;
    float* xres; const float* modg; int skip;
    __device__ __forceinline__ void operator()(const f32x4 (&acc)[2][2][4][2], const pg8::Unit& u, int wr, int wc, int fr, int fq) const {
#pragma unroll
        for (int ai = 0; ai < 2; ++ai)
#pragma unroll
            for (int m = 0; m < 4; ++m) {
                const int r = u.pm * 256 + ai * 128 + wr * 64 + m * 16 + fr;
                const float* gp = modg + mrow_of(r) * 6144; float* xp = xres + (size_t)r * D;
#pragma unroll
                for (int bj = 0; bj < 2; ++bj)
#pragma unroll
                    for (int n = 0; n < 2; ++n) {
                        const int c = u.pn * 256 + bj * 128 + wc * 32 + n * 16 + fq * 4;
                        const f32x4 gg = *(const f32x4*)(gp + c); f32x4 x = *(const f32x4*)(xp + c);
                        x = x + gg * acc[ai][bj][m][n]; if (!skip) *(f32x4*)(xp + c) = x;
                    }
            }
    }
};
struct EpiGlu {
    static constexpr bool PERM = false, AFTER_DRAIN = false;
    float* xres; const float* modg; const float* bglu; int skip;
    __device__ __forceinline__ void operator()(const f32x4 (&acc)[2][2][4][2], const pg8::Unit& u, int wr, int wc, int fr, int fq) const {
#pragma unroll
        for (int ai = 0; ai < 2; ++ai)
#pragma unroll
            for (int m = 0; m < 4; ++m) {
                const int r = u.pm * 256 + ai * 128 + wr * 64 + m * 16 + fr;
                const float* gp = modg + mrow_of(r) * 6144; float* xp = xres + (size_t)r * D;
#pragma unroll
                for (int bj = 0; bj < 2; ++bj) {
                    const int oc = u.pn * 128 + bj * 64 + wc * 16 + fq * 4;
                    const f32x4 a = acc[ai][bj][m][0] + *(const f32x4*)(bglu + oc);
                    const f32x4 g = acc[ai][bj][m][1] + *(const f32x4*)(bglu + 1024 + oc);
                    f32x4 val; val.x = a.x * sigmoidf_(g.x); val.y = a.y * sigmoidf_(g.y); val.z = a.z * sigmoidf_(g.z); val.w = a.w * sigmoidf_(g.w);
                    const f32x4 gg = *(const f32x4*)(gp + oc); f32x4 x = *(const f32x4*)(xp + oc);
                    x = x + gg * val; if (!skip) *(f32x4*)(xp + oc) = x;
                }
            }
    }
};
__device__ __forceinline__ int kvrow_of(int r) { if (r < TC) return (r >> 8) * KVLEN + SEQ + (r & 255); const int rr = r - TC; return (rr >> 11) * KVLEN + (rr & 2047); }
struct EpiKvq {
    static constexpr bool PERM = false, AFTER_DRAIN = false;
    bf16* qb; bf16* kb; bf16* vb; const float* qg; const float* kg; const float* rope;
    __device__ __forceinline__ void operator()(const f32x4 (&acc)[2][2][4][2], const pg8::Unit& u, int wr, int wc, int fr, int fq) const {
        const int pn = u.pn;
        const float* gptr = (pn == 0) ? kg : qg;
        f32x4 gn[2][2];
#pragma unroll
        for (int bj = 0; bj < 2; ++bj)
#pragma unroll
            for (int n = 0; n < 2; ++n) gn[bj][n] = *(const f32x4*)(gptr + 32 * bj + 16 * n + 4 * fq);
#pragma unroll
        for (int ai = 0; ai < 2; ++ai)
#pragma unroll
            for (int m = 0; m < 4; ++m) {
                const int r = u.pm * 256 + ai * 128 + wr * 64 + m * 16 + fr;
                f32x4 x[2][2];
#pragma unroll
                for (int bj = 0; bj < 2; ++bj)
#pragma unroll
                    for (int n = 0; n < 2; ++n) x[bj][n] = acc[ai][bj][m][n];
                if (pn != 1) {
                    float ss = 0.f;
#pragma unroll
                    for (int bj = 0; bj < 2; ++bj)
#pragma unroll
                        for (int n = 0; n < 2; ++n) { const f32x4 v = x[bj][n]; ss += v.x * v.x + v.y * v.y + v.z * v.z + v.w * v.w; }
                    ss = xor16_sum(ss); ss = xor32_sum(ss);
                    const float rs = rsqrtf(ss * (1.f / 64.f) + EPS);
#pragma unroll
                    for (int bj = 0; bj < 2; ++bj)
#pragma unroll
                        for (int n = 0; n < 2; ++n) x[bj][n] = x[bj][n] * rs * gn[bj][n];
                    if (r >= TC) {
                        const int t = (r - TC) & 2047;
#pragma unroll
                        for (int bj = 0; bj < 2; ++bj) {
                            const int pos = bj == 0 ? (t >> 6) : (t & 63);
                            const f32x4 cs = *(const f32x4*)(rope + pos * 16 + 4 * fq), sn = *(const f32x4*)(rope + 1024 + pos * 16 + 4 * fq);
                            const f32x4 x1 = x[bj][0], x2 = x[bj][1];
                            x[bj][0] = x1 * cs - x2 * sn; x[bj][1] = x2 * cs + x1 * sn;
                        }
                    }
                }
                bf16* dst;
                if (pn == 0) dst = kb + (size_t)kvrow_of(r) * 256 + wc * 64;
                else if (pn == 1) dst = vb + (size_t)kvrow_of(r) * 256 + wc * 64;
                else { dst = qb + (size_t)r * D + ((pn - 2) * 4 + wc) * 64;
#pragma unroll
                    for (int bj = 0; bj < 2; ++bj)
#pragma unroll
                        for (int n = 0; n < 2; ++n) x[bj][n] = x[bj][n] * ATT_C2; }
#pragma unroll
                for (int bj = 0; bj < 2; ++bj)
#pragma unroll
                    for (int n = 0; n < 2; ++n) st_bf4(dst + 32 * bj + 16 * n + 4 * fq, x[bj][n]);
            }
    }
};
struct EpiMlIn {
    static constexpr bool PERM = true, AFTER_DRAIN = false;
    bf16 *k, *v, *q, *o; float* g; const float* bgate;
    __device__ __forceinline__ void operator()(const f32x4 (&acc)[2][2][4][2], const pg8::Unit& u, int wr, int wc, int fr, int fq) const {
        const int pn = u.pn;
#pragma unroll
        for (int ai = 0; ai < 2; ++ai)
#pragma unroll
            for (int m = 0; m < 4; ++m) {
                const int r = u.pm * 256 + ai * 128 + wr * 64 + m * 16 + fr;
#pragma unroll
                for (int bj = 0; bj < 2; ++bj) {
                    const int cc = bj * 128 + wc * 32 + fq * 8;
                    f32x4 a = acc[ai][bj][m][0], b = acc[ai][bj][m][1];
                    if (pn == 12) { if (cc < 32) { *(f32x4*)(g + (size_t)r * 32 + cc) = a + *(const f32x4*)(bgate + cc); *(f32x4*)(g + (size_t)r * 32 + cc + 4) = b + *(const f32x4*)(bgate + cc + 4); } continue; }
                    if (pn < 2) { a = a * 0.125f; b = b * 0.125f; }
                    v4u ov; ov.x = pk2(a.x, a.y); ov.y = pk2(a.z, a.w); ov.z = pk2(b.x, b.y); ov.w = pk2(b.z, b.w);
                    bf16* dst = (pn < 2) ? k + (size_t)r * 512 + pn * 256 + cc : (pn < 6) ? v + (size_t)r * 1024 + (pn - 2) * 256 + cc : (pn < 8) ? q + (size_t)r * 512 + (pn - 6) * 256 + cc : o + (size_t)r * 1024 + (pn - 8) * 256 + cc;
                    *(v4u*)dst = ov;
                }
            }
    }
};
struct EpiG1 {
    static constexpr bool PERM = false, AFTER_DRAIN = false;
    bf16* hid;
    __device__ __forceinline__ void operator()(const f32x4 (&acc)[2][2][4][2], const pg8::Unit& u, int wr, int wc, int fr, int fq) const {
        const int pnl = u.pn & 3;
#pragma unroll
        for (int ai = 0; ai < 2; ++ai)
#pragma unroll
            for (int m = 0; m < 4; ++m) {
                const int r = u.pm * 256 + ai * 128 + wr * 64 + m * 16 + fr;
#pragma unroll
                for (int bj = 0; bj < 2; ++bj) {
                    const int hc = pnl * 128 + bj * 64 + wc * 16 + fq * 4;
                    const f32x4 ga = acc[ai][bj][m][0], up = acc[ai][bj][m][1];
                    f32x4 h; h.x = siluf_(ga.x) * up.x; h.y = siluf_(ga.y) * up.y; h.z = siluf_(ga.z) * up.z; h.w = siluf_(ga.w) * up.w;
                    st_bf4(hid + (size_t)r * DFF + hc, h);
                }
            }
    }
};
struct EpiG2 {
    static constexpr bool PERM = true, AFTER_DRAIN = false;
    bf16* y2; const float* slotw;
    __device__ __forceinline__ void operator()(const f32x4 (&acc)[2][2][4][2], const pg8::Unit& u, int wr, int wc, int fr, int fq) const {
        const int pnl = u.pn & 3;
#pragma unroll
        for (int ai = 0; ai < 2; ++ai)
#pragma unroll
            for (int m = 0; m < 4; ++m) {
                const int r = u.pm * 256 + ai * 128 + wr * 64 + m * 16 + fr;
                const float w = slotw[r];
#pragma unroll
                for (int bj = 0; bj < 2; ++bj) {
                    const int c = pnl * 256 + bj * 128 + wc * 32 + fq * 8;
                    const f32x4 a = acc[ai][bj][m][0] * w, b = acc[ai][bj][m][1] * w;
                    v4u o; o.x = pk2(a.x, a.y); o.y = pk2(a.z, a.w); o.z = pk2(b.x, b.y); o.w = pk2(b.z, b.w);
                    *(v4u*)(y2 + (size_t)r * D + c) = o;
                }
            }
    }
};

struct CmNat { const float* W; int ld; __device__ __forceinline__ const float* col(int j) const { return W + j; } };
struct CmGlu { const float* W; int ld;
    __device__ __forceinline__ const float* col(int j) const { const int pn = j >> 8, bj = (j >> 7) & 1, wc = (j >> 5) & 3, n = (j >> 4) & 1, q = j & 15; return W + n * 1024 + 128 * pn + 64 * bj + 16 * wc + q; } };
struct CmKvq { const float* W; int ld;
    __device__ __forceinline__ const float* col(int j) const { const int pn = j >> 8, bj = (j >> 7) & 1, wc = (j >> 5) & 3, n = (j >> 4) & 1, q = j & 15; return W + 256 * pn + 64 * wc + 32 * bj + 16 * n + q; } };
struct CmMlIn { const float* W; int ld;
    __device__ __forceinline__ const float* col(int j) const {
        if (j < 1536) return W + j;
        if (j < 2048) return W + 1568 + (j - 1536);
        if (j < 3072) return W + 2080 + (j - 2048);
        if (j < 3104) return W + 1536 + (j - 3072);
        return nullptr; } };
struct CmG1 { const float* Wg; const float* Wu; int ld;
    __device__ __forceinline__ const float* col(int j) const { const int le = j >> 10, jj = j & 1023; const int pn = jj >> 8, bj = (jj >> 7) & 1, wc = (jj >> 5) & 3, n = (jj >> 4) & 1, q = jj & 15;
        const uintptr_t a = (uintptr_t)Wg, b = (uintptr_t)Wu, msk = (uintptr_t)0 - (uintptr_t)n;
        return (const float*)((a & ~msk) | (b & msk)) + (size_t)le * 1024 * 512 + 128 * pn + 64 * bj + 16 * wc + q; } };
struct CmG2 { const float* Wd; int ld;
    __device__ __forceinline__ const float* col(int j) const { const int le = j >> 10, jj = j & 1023; return Wd + (size_t)le * 512 * 1024 + jj; } };

template <class CM>
__device__ __forceinline__ void transpose_item(const CM& cm, int K, bf16* WT, int kb, int nb, LAS float* scr, int lane) {
    const int k0 = 64 * kb, n0 = 32 * nb;
    const int nq = (lane & 7) * 4;
    const float* cp = cm.col(n0 + nq);
    const size_t ld = (size_t)cm.ld;
    f32x4 v[8];
#pragma unroll
    for (int i = 0; i < 8; ++i) { const int kk = 8 * i + (lane >> 3); v[i] = cp ? *(const f32x4*)(cp + (size_t)(k0 + kk) * ld) : (f32x4){0.f, 0.f, 0.f, 0.f}; }
#pragma unroll
    for (int i = 0; i < 8; ++i) { const int kk = 8 * i + (lane >> 3); LAS float* d = scr + kk * 33 + nq; d[0] = v[i].x; d[1] = v[i].y; d[2] = v[i].z; d[3] = v[i].w; }
    LDS_WAIT(); asm volatile("" ::: "memory");
    const int c = lane & 7;
#pragma unroll
    for (int j = 0; j < 4; ++j) { const int n = (lane >> 3) + 8 * j; const LAS float* s = scr + (8 * c) * 33 + n;
        v4u o; o.x = pk2(s[0 * 33], s[1 * 33]); o.y = pk2(s[2 * 33], s[3 * 33]); o.z = pk2(s[4 * 33], s[5 * 33]); o.w = pk2(s[6 * 33], s[7 * 33]);
        *(v4u*)(WT + (size_t)(n0 + n) * K + k0 + 8 * c) = o; }
    LDS_WAIT(); asm volatile("" ::: "memory");
}
template <class CM>
__device__ __forceinline__ void transpose_all(Frame& F, const CM& cm, int K, int Ndest, bf16* WT, int rot) {
    LAS float* scr = (LAS float*)(F.lds + RING_OFF + F.wave * 16384);
    const int NGW = F.G * NWAVES, gw = (F.blk * NWAVES + F.wave + rot) % NGW;
    const int nblk = Ndest / 32, items = (K / 64) * nblk;
    for (int it = gw; it < items; it += NGW) transpose_item(cm, K, WT, it / nblk, it % nblk, scr, F.lane);
}

__device__ __forceinline__ void phase_prologue(Frame& F) {
    {
        LAS float* cond = (LAS float*)(F.lds);
        LAS float* red = (LAS float*)(F.lds + 40960);
        for (int i = F.tid; i < 9 * 1024; i += NTHR) { const int mb = i >> 10, k = i & 1023; const float v = (mb < 8) ? F.in[IN_C][mb * 1024 + k] : F.in[IN_CCTX][k]; cond[i] = siluf_(v); }
        __syncthreads();
        float* mod = (float*)(F.ws + WS_MOD);
        for (int it = F.blk; it < DEPTH * 48; it += F.G) {
            const int l = it / 48, n0 = (it % 48) * 128;
            const float* w = F.in[IN_ADAW] + (size_t)l * 1024 * 6144 + n0 + 2 * F.lane;
            f32x2 a[9];
#pragma unroll
            for (int mb = 0; mb < 9; ++mb) a[mb] = (f32x2){0.f, 0.f};
            const int kb = F.wave * 128;
            for (int k8 = 0; k8 < 128; k8 += 8) {
                f32x2 wv[8];
#pragma unroll
                for (int u = 0; u < 8; ++u) wv[u] = *(const f32x2*)(w + (size_t)(kb + k8 + u) * 6144);
#pragma unroll
                for (int u = 0; u < 8; ++u)
#pragma unroll
                    for (int mb = 0; mb < 9; ++mb) a[mb] += wv[u] * cond[mb * 1024 + kb + k8 + u];
            }
#pragma unroll
            for (int mb = 0; mb < 9; ++mb) *(LAS f32x2*)(red + (F.wave * 9 + mb) * 128 + 2 * F.lane) = a[mb];
            __syncthreads();
            for (int i = F.tid; i < 9 * 128; i += NTHR) { const int mb = i >> 7, ln = i & 127; float s = F.in[IN_ADAB][l * 6144 + n0 + ln];
#pragma unroll
                for (int wv = 0; wv < 8; ++wv) s += red[(wv * 9 + mb) * 128 + ln];
                mod[(size_t)(l * 9 + mb) * 6144 + n0 + ln] = s; }
            __syncthreads();
        }
    }
    { const int idx = F.blk * NTHR + F.tid;
      if (idx < 1024) { const int pos = idx >> 4, f = idx & 15; const float inv = exp2f(-(float)f * (13.287712379549449f / 16.f)); const float ang = (float)pos * inv;
          double s, c; sincos_d((double)ang, s, c); float* rope = (float*)(F.ws + WS_ROPE); rope[idx] = (float)c; rope[1024 + idx] = (float)s; } }
    __syncthreads();
    { CmGlu cm{F.in[IN_S5WGLU], 2048}; transpose_all(F, cm, 1024, 2048, (bf16*)(F.ws + WS_WGLU), 0); }
    { CmGlu cm{F.in[IN_S5WGLU] + (size_t)1024 * 2048, 2048}; transpose_all(F, cm, 1024, 2048, (bf16*)(F.ws + WS_WGLU) + (size_t)2048 * 1024, 1024); }
    { CmKvq cm{F.in[IN_AWKVQ], 1536}; transpose_all(F, cm, 1024, 1536, (bf16*)(F.ws + WS_WKVQ), 0); }
    { CmNat cm{F.in[IN_AWO], 1024}; transpose_all(F, cm, 1024, 1024, (bf16*)(F.ws + WS_WO), 768); }
    { CmMlIn cm{F.in[IN_MLWIN], 3104}; transpose_all(F, cm, 1024, ML_NIN, (bf16*)(F.ws + WS_WIN), 1280); }
    { CmNat cm{F.in[IN_MLWOUT], 1024}; transpose_all(F, cm, 1024, 1024, (bf16*)(F.ws + WS_WOUT), 896); }
    { CmG1 cm{F.in[IN_MWG], F.in[IN_MWU], 512}; transpose_all(F, cm, 1024, DEPTH * NEXP * 1024, (bf16*)(F.ws + WS_WG1), 1408); }
    { CmG2 cm{F.in[IN_MWD], 1024}; transpose_all(F, cm, 512, DEPTH * NEXP * 1024, (bf16*)(F.ws + WS_WG2), 1408); }
}

struct RowMod { f32x4 a[4], b[4], c[4]; int mr; };
__device__ __forceinline__ void rowmod_load(RowMod& M, const float* base, int mr, int oa, int ob, int oc, int lane) {
    if (mr == M.mr) return; M.mr = mr; const float* p = base + (size_t)mr * 6144;
#pragma unroll
    for (int j = 0; j < 4; ++j) { M.a[j] = *(const f32x4*)(p + oa + 4 * lane + 256 * j); M.b[j] = *(const f32x4*)(p + ob + 4 * lane + 256 * j); if (oc >= 0) M.c[j] = *(const f32x4*)(p + oc + 4 * lane + 256 * j); }
}
struct RawRow { f32x4 x[4]; v2u ya[4], yb[4]; };
template <bool COMB>
__device__ __forceinline__ void raw_load(RawRow& R, const float* xrow, const bf16* y2, int s0, int s1, int lane) {
#pragma unroll
    for (int j = 0; j < 4; ++j) { R.x[j] = *(const f32x4*)(xrow + 4 * lane + 256 * j);
        if (COMB) { R.ya[j] = *(const v2u*)(y2 + (size_t)s0 * D + 4 * lane + 256 * j); R.yb[j] = *(const v2u*)(y2 + (size_t)s1 * D + 4 * lane + 256 * j); } }
}
template <int L>
__device__ __forceinline__ void phase_a1(Frame& F, const int skip = 0) {
    const float* mod = (const float*)(F.ws + WS_MOD);
    float* xres = (float*)(F.ws + WS_XRES); bf16* hb = (bf16*)(F.ws + WS_H);
    const bf16* y2 = (const bf16*)(F.ws + WS_Y2); const int* toks = (const int*)(F.ws + WS_TOKS);
    const int gw = F.blk * NWAVES + F.wave, NGW = F.G * NWAVES, lane = F.lane;
    const int RPW = (T + NGW - 1) / NGW, r0 = gw * RPW, r1 = (r0 + RPW < T) ? r0 + RPW : T;
    if (r0 >= T) return;
    f32x4 gv[4];
#pragma unroll
    for (int j = 0; j < 4; ++j) gv[j] = *(const f32x4*)(F.in[IN_N1G] + L * D + 4 * lane + 256 * j);
    auto rowptr = [&](int r) -> const float* { if (L == 0) return (r < TC) ? F.in[IN_CTX] + (size_t)r * D : F.in[IN_X] + (size_t)(r - TC) * D; return xres + (size_t)r * D; };
    RowMod M1, M2; M1.mr = -1; M2.mr = -1;
    int ns0 = 0, ns1 = 0;
    if (L > 0) { ns0 = toks[2 * r0]; ns1 = toks[2 * r0 + 1]; }
    RawRow nx; raw_load<(L > 0)>(nx, rowptr(r0), y2, ns0, ns1, lane);
    if (L > 0 && r0 + 1 < r1) { ns0 = toks[2 * r0 + 2]; ns1 = toks[2 * r0 + 3]; }
    for (int r = r0; r < r1; ++r) {
        const int mr = mrow_of(r);
        RawRow cur = nx;
        if (r + 1 < r1) { raw_load<(L > 0)>(nx, rowptr(r + 1), y2, ns0, ns1, lane); if (L > 0 && r + 2 < r1) { ns0 = toks[2 * r + 4]; ns1 = toks[2 * r + 5]; } }
        rowmod_load(M1, mod + (size_t)L * 9 * 6144, mr, 0, 1024, -1, lane);
        if (L > 0) rowmod_load(M2, mod + (size_t)(L - 1) * 9 * 6144, mr, 5120, 5120, -1, lane);
        float ss = 0.f;
#pragma unroll
        for (int j = 0; j < 4; ++j) {
            f32x4 v = cur.x[j];
            if (L > 0) { const v2u a = cur.ya[j], b = cur.yb[j]; const f32x4 gg = M2.a[j];
                v.x += gg.x * (bflo(a.x) + bflo(b.x)); v.y += gg.y * (bfhi(a.x) + bfhi(b.x)); v.z += gg.z * (bflo(a.y) + bflo(b.y)); v.w += gg.w * (bfhi(a.y) + bfhi(b.y)); }
            cur.x[j] = v;
            if (!skip) *(f32x4*)(xres + (size_t)r * D + 4 * lane + 256 * j) = v; ss += v.x * v.x + v.y * v.y + v.z * v.z + v.w * v.w;
        }
        const float rs = rsqrtf(wave_sum(ss) * (1.f / D) + EPS);
#pragma unroll
        for (int j = 0; j < 4; ++j) { const f32x4 h = cur.x[j] * rs * gv[j] * (M1.b[j] + 1.f) + M1.a[j]; st_bf4(hb + (size_t)r * D + 4 * lane + 256 * j, h); }
    }
}
__device__ __forceinline__ float quad_get(float v, int k) {
    return k == 1 ? dpp_f<0x39>(v, v) : k == 2 ? dpp_f<0x4E>(v, v) : dpp_f<0x93>(v, v); }
template <int L>
__device__ __forceinline__ void phase_n2(Frame& F, const int var = 0) {
    constexpr int R0 = (L == DEPTH - 1) ? TC : 0;
    const float* mod = (const float*)(F.ws + WS_MOD);
    const float* xres = (const float*)(F.ws + WS_XRES); bf16* hb = (bf16*)(F.ws + WS_H);
    int* toke = (int*)(F.ws + WS_TOKE); int* tokr = (int*)(F.ws + WS_TOKR); float* tokw = (float*)(F.ws + WS_TOKW); int* bcnt = (int*)(F.ws + WS_BCNT);
    LAS v4u* rwf = (LAS v4u*)(F.lds);
    LAS float* PS = (LAS float*)(F.lds + 65536);
    LAS float* PL = (LAS float*)(F.lds + 65536 + 1024);
    LAS int* cntL = (LAS int*)(F.lds + SCT_OFF);
    for (int i = F.tid; i < 32 * 64; i += NTHR) { const int ks = i >> 6, ln = i & 63, e = ln & 15, k0 = 32 * ks + 8 * (ln >> 4);
        float w[8]; unsigned hi[4], lo[4];
#pragma unroll
        for (int jj = 0; jj < 8; ++jj) w[jj] = F.in[IN_RW][(k0 + jj) * 16 + e];
#pragma unroll
        for (int jj = 0; jj < 4; ++jj) { hi[jj] = pk2(w[2 * jj], w[2 * jj + 1]); lo[jj] = pk2(w[2 * jj] - bflo(hi[jj]), w[2 * jj + 1] - bfhi(hi[jj])); }
        rwf[2 * i] = (v4u){hi[0], hi[1], hi[2], hi[3]}; rwf[2 * i + 1] = (v4u){lo[0], lo[1], lo[2], lo[3]}; }
    if (F.tid < 16) cntL[F.tid] = 0;
    __syncthreads();
    const int lane = F.lane, rl = lane & 15, kg = lane >> 4, w = F.wave;
    const float rbias = F.in[IN_RB][rl];
    constexpr int NTILES = (T - R0) / 16;
    const int ntl = (NTILES - F.blk + F.G - 1) / F.G;
    const int c0 = 128 * w + 8 * kg;
    f32x4 xa[4], xb[4];
    if (ntl > 0) { const float* xr = xres + (size_t)(R0 + 16 * F.blk + rl) * D + c0;
#pragma unroll
        for (int q = 0; q < 4; ++q) { xa[q] = *(const f32x4*)(xr + 32 * q); xb[q] = *(const f32x4*)(xr + 32 * q + 4); } }
    for (int j = 0; j < ntl; ++j) {
        const int tile = F.blk + F.G * j, rbase = R0 + 16 * tile, mr = mrow_of(rbase), pb = j & 1;
        f32x4 ca[4], cb[4]; float ss = 0.f;
#pragma unroll
        for (int q = 0; q < 4; ++q) { ca[q] = xa[q]; cb[q] = xb[q];
            ss += ca[q].x * ca[q].x + ca[q].y * ca[q].y + ca[q].z * ca[q].z + ca[q].w * ca[q].w + cb[q].x * cb[q].x + cb[q].y * cb[q].y + cb[q].z * cb[q].z + cb[q].w * cb[q].w; }
        ss = xor16_sum(ss); ss = xor32_sum(ss);
        if (kg == 0) PS[(pb * 8 + w) * 16 + rl] = ss;
        if (j + 1 < ntl) { const float* xr = xres + (size_t)(R0 + 16 * (tile + F.G) + rl) * D + c0;
#pragma unroll
            for (int q = 0; q < 4; ++q) { xa[q] = *(const f32x4*)(xr + 32 * q); xb[q] = *(const f32x4*)(xr + 32 * q + 4); } }
        __syncthreads();
        float tot = 0.f;
#pragma unroll
        for (int ww = 0; ww < 8; ++ww) tot += PS[(pb * 8 + ww) * 16 + rl];
        const float rs = rsqrtf(tot * (1.f / D) + EPS);
        const float* gp = F.in[IN_N2G] + L * D + c0; const float* shp = mod + (size_t)(L * 9 + mr) * 6144 + 3072 + c0; const float* scp = shp + 1024;
        bf16* hrow = hb + (size_t)(rbase + rl) * D + c0;
        f32x4 acc = (f32x4){0.f, 0.f, 0.f, 0.f};
#pragma unroll
        for (int q = 0; q < 4; ++q) {
            float h[8];
            { const f32x4 g0 = *(const f32x4*)(gp + 32 * q), g1 = *(const f32x4*)(gp + 32 * q + 4), cc0 = *(const f32x4*)(scp + 32 * q), cc1 = *(const f32x4*)(scp + 32 * q + 4), s0 = *(const f32x4*)(shp + 32 * q), s1 = *(const f32x4*)(shp + 32 * q + 4);
              const f32x4 h0 = ca[q] * rs * g0 * (cc0 + 1.f) + s0, h1 = cb[q] * rs * g1 * (cc1 + 1.f) + s1;
              h[0] = h0.x; h[1] = h0.y; h[2] = h0.z; h[3] = h0.w; h[4] = h1.x; h[5] = h1.y; h[6] = h1.z; h[7] = h1.w; }
            unsigned hi[4], lo[4];
#pragma unroll
            for (int jj = 0; jj < 4; ++jj) { hi[jj] = pk2(h[2 * jj], h[2 * jj + 1]); lo[jj] = pk2(h[2 * jj] - bflo(hi[jj]), h[2 * jj + 1] - bfhi(hi[jj])); }
            const v4u hv = (v4u){hi[0], hi[1], hi[2], hi[3]}, lv = (v4u){lo[0], lo[1], lo[2], lo[3]};
            *(v4u*)(hrow + 32 * q) = hv;
            const int ks = 4 * w + q;
            const v4u bh = rwf[2 * (ks * 64 + lane)], bl = rwf[2 * (ks * 64 + lane) + 1];
            acc = __builtin_amdgcn_mfma_f32_16x16x32_bf16(__builtin_bit_cast(bf16x8, hv), __builtin_bit_cast(bf16x8, bh), acc, 0, 0, 0);
            acc = __builtin_amdgcn_mfma_f32_16x16x32_bf16(__builtin_bit_cast(bf16x8, hv), __builtin_bit_cast(bf16x8, bl), acc, 0, 0, 0);
            acc = __builtin_amdgcn_mfma_f32_16x16x32_bf16(__builtin_bit_cast(bf16x8, lv), __builtin_bit_cast(bf16x8, bh), acc, 0, 0, 0);
        }
        *(LAS f32x4*)(PL + ((pb * 8 + w) * 64 + lane) * 4) = acc;
        __syncthreads();
        if (w != (j & 7) || (var & 1)) continue;
        f32x4 lg = (f32x4){0.f, 0.f, 0.f, 0.f};
#pragma unroll
        for (int ww = 0; ww < 8; ++ww) lg = lg + *(const LAS f32x4*)(PL + ((pb * 8 + ww) * 64 + lane) * 4);
#pragma unroll
        for (int r = 0; r < 4; ++r) {
            const float sco = sigmoidf_(lg[r]), sel = sco + rbias;
            int rank = 0;
#pragma unroll
            for (int k = 1; k < 4; ++k) { const float o = quad_get(sel, k); const int oi = (rl & ~3) | ((rl + k) & 3); rank += (o > sel || (o == sel && oi < rl)) ? 1 : 0; }
            const bool top2 = rank < 2;
            float gs = top2 ? sel : 0.f; gs += dpp_f<0xB1>(0.f, gs); gs += dpp_f<0x4E>(0.f, gs);
            bool best = true; const int q = rl >> 2;
            { const float o1 = dpp_f<0x124>(gs, gs), o2 = dpp_f<0x128>(gs, gs), o3 = dpp_f<0x12C>(gs, gs);
              const int q1 = (q + 3) & 3, q2 = (q + 2) & 3, q3 = (q + 1) & 3;
              best = !(o1 > gs || (o1 == gs && q1 < q)) && !(o2 > gs || (o2 == gs && q2 < q)) && !(o3 > gs || (o3 == gs && q3 < q)); }
            const bool selv = best && top2;
            const float wsum = red16_sum(selv ? sco : 0.f);
            if (selv) { const int row = rbase + 4 * kg + r;
                const int lr = __hip_atomic_fetch_add(cntL + rl, 1, __ATOMIC_RELAXED, __HIP_MEMORY_SCOPE_WORKGROUP);
                toke[2 * row + rank] = rl; tokr[2 * row + rank] = lr; tokw[2 * row + rank] = sco * __builtin_amdgcn_rcpf(wsum); }
        }
    }
    __syncthreads();
    if (F.tid < 16 && !(var & 1)) bcnt[F.blk * 16 + F.tid] = cntL[F.tid];
}
template <int L>
__device__ __forceinline__ void phase_sc(Frame& F) {
    constexpr int R0 = (L == DEPTH - 1) ? TC : 0;
    const int* bcnt = (const int*)(F.ws + WS_BCNT);
    LAS int* pt = (LAS int*)(F.lds);
    LAS int* tt = (LAS int*)(F.lds + 8192);
    { const int e = F.tid & 15, ch = F.tid >> 4; int tot = 0, mine = 0;
      for (int b = ch; b < F.G; b += 32) { const int c = bcnt[b * 16 + e]; tot += c; mine += (b < F.blk) ? c : 0; }
      pt[ch * 16 + e] = tot; pt[512 + ch * 16 + e] = mine; }
    __syncthreads();
    if (F.tid < 16) { int tot = 0, mine = 0; for (int ch = 0; ch < 32; ++ch) { tot += pt[ch * 16 + F.tid]; mine += pt[512 + ch * 16 + F.tid]; } tt[F.tid] = tot; tt[16 + F.tid] = mine; }
    __syncthreads();
    if (F.tid == 0) { int ts = 0; int* etab = (int*)(F.ws + WS_ETAB);
        for (int e = 0; e < 16; ++e) { tt[32 + e] = ts * 256 + tt[16 + e]; if (F.blk == 0) etab[e] = ts; ts += (tt[e] + 255) >> 8; }
        if (F.blk == 0) etab[16] = ts; }
    __syncthreads();
    const int* toke = (const int*)(F.ws + WS_TOKE); const int* tokr = (const int*)(F.ws + WS_TOKR); const float* tokw = (const float*)(F.ws + WS_TOKW);
    int* toks = (int*)(F.ws + WS_TOKS); float* slotw = (float*)(F.ws + WS_SLOTW);
    const bf16* hb = (const bf16*)(F.ws + WS_H); bf16* hs = (bf16*)(F.ws + WS_HS);
    const int lane = F.lane;
    constexpr int NTILES = (T - R0) / 16;
    for (int tile = F.blk + F.G * F.wave; tile < NTILES; tile += F.G * NWAVES) {
        const int rbase = R0 + 16 * tile;
        int slot = 0;
        if (lane < 32) { const int idx = 2 * rbase + lane; const int e = toke[idx]; slot = tt[32 + e] + tokr[idx]; toks[idx] = slot; slotw[slot] = tokw[idx]; }
#pragma unroll 4
        for (int i = 0; i < 16; ++i) {
            const int s0 = __builtin_amdgcn_readlane(slot, 2 * i), s1 = __builtin_amdgcn_readlane(slot, 2 * i + 1); const int r = rbase + i;
#pragma unroll
            for (int j = 0; j < 2; ++j) { const v4u a = *(const v4u*)(hb + (size_t)r * D + 8 * lane + 512 * j);
                *(v4u*)(hs + (size_t)s0 * D + 8 * lane + 512 * j) = a; *(v4u*)(hs + (size_t)s1 * D + 8 * lane + 512 * j) = a; }
        }
    }
}
__device__ __forceinline__ void load_etab(Frame& F) {
    LAS int* tab = (LAS int*)(F.lds + ETAB_OFF);
    if (F.tid < 17) tab[F.tid] = ((const int*)(F.ws + WS_ETAB))[F.tid];
    __syncthreads();
}
__device__ __forceinline__ void phase_fin(Frame& F) {
    const float* mod = (const float*)(F.ws + WS_MOD);
    const float* xres = (const float*)(F.ws + WS_XRES);
    const bf16* y2 = (const bf16*)(F.ws + WS_Y2); const int* toks = (const int*)(F.ws + WS_TOKS);
    const int gw = F.blk * NWAVES + F.wave, NGW = F.G * NWAVES, lane = F.lane;
    const int RPW = (TL + NGW - 1) / NGW, r0 = TC + gw * RPW, r1 = (r0 + RPW < T) ? r0 + RPW : T;
    if (r0 >= T) return;
    f32x4 gv[4];
#pragma unroll
    for (int j = 0; j < 4; ++j) gv[j] = *(const f32x4*)(F.in[IN_FING] + 4 * lane + 256 * j);
    RowMod M2; M2.mr = -1;
    int ns0 = toks[2 * r0], ns1 = toks[2 * r0 + 1];
    RawRow nx; raw_load<true>(nx, xres + (size_t)r0 * D, y2, ns0, ns1, lane);
    if (r0 + 1 < r1) { ns0 = toks[2 * r0 + 2]; ns1 = toks[2 * r0 + 3]; }
    for (int r = r0; r < r1; ++r) {
        const int mr = mrow_of(r);
        RawRow cur = nx;
        if (r + 1 < r1) { raw_load<true>(nx, xres + (size_t)(r + 1) * D, y2, ns0, ns1, lane); if (r + 2 < r1) { ns0 = toks[2 * r + 4]; ns1 = toks[2 * r + 5]; } }
        rowmod_load(M2, mod + (size_t)(DEPTH - 1) * 9 * 6144, mr, 5120, 5120, -1, lane);
        float ss = 0.f;
#pragma unroll
        for (int j = 0; j < 4; ++j) { f32x4 v = cur.x[j]; const v2u a = cur.ya[j], b = cur.yb[j]; const f32x4 gg = M2.a[j];
            v.x += gg.x * (bflo(a.x) + bflo(b.x)); v.y += gg.y * (bfhi(a.x) + bfhi(b.x)); v.z += gg.z * (bflo(a.y) + bflo(b.y)); v.w += gg.w * (bfhi(a.y) + bfhi(b.y));
            cur.x[j] = v; ss += v.x * v.x + v.y * v.y + v.z * v.z + v.w * v.w; }
        const float rs = rsqrtf(wave_sum(ss) * (1.f / D) + EPS);
#pragma unroll
        for (int j = 0; j < 4; ++j) *(f32x4*)(F.out + (size_t)(r - TC) * D + 4 * lane + 256 * j) = cur.x[j] * rs * gv[j];
    }
}

__device__ __forceinline__ int seq_row(int b, int dir, int s) {
    if (s < CTX) return b * CTX + (dir ? (CTX - 1 - s) : s);
    const int t = s - CTX; return TC + b * SEQ + (dir ? (SEQ - 1 - t) : t);
}
template <int J, bool WCTX>
__device__ __forceinline__ void phase_s5_naive(Frame& F) {
    const int gw = F.blk * NWAVES + F.wave, lane = F.lane;
    if ((gw & 3) != 0) return;
    const int it = gw >> 2; if (it >= NB * 64) return;
    const int b = it >> 6, g = it & 63, p = lane;
    const bf16* hb = (const bf16*)(F.ws + WS_H); float* ysum = (float*)(F.ws + WS_YSUM);
    for (int dir = 0; dir < 2; ++dir) {
        const int gi = (J * 2 + dir) * 64 + g, pidx = gi * 64 + p;
        const float lam_re = F.in[IN_S5LRE][pidx], lam_im = F.in[IN_S5LIM][pidx];
        const float dt = expf(F.in[IN_S5LOG][gi]);
        const float mag = expf(lam_re * dt);
        double sd, cd; sincos_d((double)(lam_im * dt), sd, cd);
        const float a_re = mag * (float)cd, a_im = mag * (float)sd;
        const float den = lam_re * lam_re + lam_im * lam_im, n_re = a_re - 1.f, n_im = a_im;
        const float f_re = (n_re * lam_re + n_im * lam_im) / den, f_im = (n_im * lam_re - n_re * lam_im) / den;
        float bbr[16], bbi[16], cre[16], cim[16];
#pragma unroll
        for (int c = 0; c < 16; ++c) { const float br = F.in[IN_S5BRE][(size_t)pidx * 16 + c], bi = F.in[IN_S5BIM][(size_t)pidx * 16 + c];
            bbr[c] = f_re * br - f_im * bi; bbi[c] = f_re * bi + f_im * br;
            cre[c] = F.in[IN_S5CRE][((size_t)gi * 16 + c) * 64 + p]; cim[c] = F.in[IN_S5CIM][((size_t)gi * 16 + c) * 64 + p]; }
        float x_re = 0.f, x_im = 0.f;
        for (int s = 0; s < CTX + SEQ; ++s) {
            const int r = seq_row(b, dir, s);
            const v4u u0 = *(const v4u*)(hb + (size_t)r * D + g * 16), u1 = *(const v4u*)(hb + (size_t)r * D + g * 16 + 8);
            float u[16];
            u[0] = bflo(u0.x); u[1] = bfhi(u0.x); u[2] = bflo(u0.y); u[3] = bfhi(u0.y); u[4] = bflo(u0.z); u[5] = bfhi(u0.z); u[6] = bflo(u0.w); u[7] = bfhi(u0.w);
            u[8] = bflo(u1.x); u[9] = bfhi(u1.x); u[10] = bflo(u1.y); u[11] = bfhi(u1.y); u[12] = bflo(u1.z); u[13] = bfhi(u1.z); u[14] = bflo(u1.w); u[15] = bfhi(u1.w);
            float bur = 0.f, bui = 0.f;
#pragma unroll
            for (int c = 0; c < 16; ++c) { bur += u[c] * bbr[c]; bui += u[c] * bbi[c]; }
            const float nr = a_re * x_re - a_im * x_im + bur, ni = a_re * x_im + a_im * x_re + bui;
            x_re = nr; x_im = ni;
            if (WCTX || s >= CTX) {
                float yv = 0.f;
#pragma unroll
                for (int c = 0; c < 16; ++c) { const float t = wave_sum(x_re * cre[c] - x_im * cim[c]); if (lane == c) yv = t; }
                if (lane < 16) { float* yp = ysum + (size_t)r * D + g * 16 + lane; if (dir == 0) *yp = yv; else *yp = *yp + yv; }
            }
        }
    }
}
template <int J, bool WCTX>
__device__ __forceinline__ void phase_s5_combine(Frame& F) {
    constexpr int R0 = WCTX ? 0 : TC;
    const bf16* hb = (const bf16*)(F.ws + WS_H); const float* ysum = (const float*)(F.ws + WS_YSUM); bf16* zb = (bf16*)(F.ws + WS_Z);
    const int gw = F.blk * NWAVES + F.wave, NGW = F.G * NWAVES, lane = F.lane;
    f32x4 dv[4];
#pragma unroll
    for (int j = 0; j < 4; ++j) dv[j] = *(const f32x4*)(F.in[IN_S5D] + J * D + 4 * lane + 256 * j);
    for (int r = R0 + gw; r < T; r += NGW) {
#pragma unroll
        for (int j = 0; j < 4; ++j) {
            const f32x4 y = *(const f32x4*)(ysum + (size_t)r * D + 4 * lane + 256 * j);
            const v2u hv = *(const v2u*)(hb + (size_t)r * D + 4 * lane + 256 * j);
            f32x4 z; z.x = gelu_tanh(y.x + dv[j].x * bflo(hv.x)); z.y = gelu_tanh(y.y + dv[j].y * bfhi(hv.x)); z.z = gelu_tanh(y.z + dv[j].z * bflo(hv.y)); z.w = gelu_tanh(y.w + dv[j].w * bfhi(hv.y));
            st_bf4(zb + (size_t)r * D + 4 * lane + 256 * j, z);
        }
    }
}
template <bool WCTX>
__device__ __forceinline__ void phase_attn_naive(Frame& F) {
    constexpr int R0 = WCTX ? 0 : TC;
    const bf16* qb = (const bf16*)(F.ws + WS_QB); const bf16* kb = (const bf16*)(F.ws + WS_KB); const bf16* vb = (const bf16*)(F.ws + WS_VB); bf16* zb = (bf16*)(F.ws + WS_Z);
    const int gw = F.blk * NWAVES + F.wave, NGW = F.G * NWAVES, lane = F.lane;
    for (int it = gw; it < (T - R0) * 16; it += NGW) {
        const int r = R0 + (it >> 4), h = it & 15, kvh = h >> 2;
        int kv0, nk;
        if (r < TC) { kv0 = (r >> 8) * KVLEN + SEQ; nk = CTX; } else { kv0 = ((r - TC) >> 11) * KVLEN; nk = KVLEN; }
        float q[64];
#pragma unroll
        for (int c = 0; c < 8; ++c) { const v4u w = *(const v4u*)(qb + (size_t)r * D + h * 64 + 8 * c);
            q[8 * c] = bflo(w.x); q[8 * c + 1] = bfhi(w.x); q[8 * c + 2] = bflo(w.y); q[8 * c + 3] = bfhi(w.y); q[8 * c + 4] = bflo(w.z); q[8 * c + 5] = bfhi(w.z); q[8 * c + 6] = bflo(w.w); q[8 * c + 7] = bfhi(w.w); }
        float m = -INFINITY, l = 0.f, o[64];
#pragma unroll
        for (int d = 0; d < 64; ++d) o[d] = 0.f;
        for (int kk = lane; kk < nk; kk += 64) {
            const bf16* kp = kb + (size_t)(kv0 + kk) * 256 + kvh * 64; const bf16* vp = vb + (size_t)(kv0 + kk) * 256 + kvh * 64;
            float s = 0.f;
#pragma unroll
            for (int c = 0; c < 8; ++c) { const v4u w = *(const v4u*)(kp + 8 * c);
                s += q[8 * c] * bflo(w.x) + q[8 * c + 1] * bfhi(w.x) + q[8 * c + 2] * bflo(w.y) + q[8 * c + 3] * bfhi(w.y) + q[8 * c + 4] * bflo(w.z) + q[8 * c + 5] * bfhi(w.z) + q[8 * c + 6] * bflo(w.w) + q[8 * c + 7] * bfhi(w.w); }
            const float mn = fmaxf(m, s), sc = exp2f(m - mn), pp = exp2f(s - mn);
            l = l * sc + pp; m = mn;
#pragma unroll
            for (int c = 0; c < 8; ++c) { const v4u w = *(const v4u*)(vp + 8 * c);
                o[8 * c] = o[8 * c] * sc + pp * bflo(w.x); o[8 * c + 1] = o[8 * c + 1] * sc + pp * bfhi(w.x); o[8 * c + 2] = o[8 * c + 2] * sc + pp * bflo(w.y); o[8 * c + 3] = o[8 * c + 3] * sc + pp * bfhi(w.y);
                o[8 * c + 4] = o[8 * c + 4] * sc + pp * bflo(w.z); o[8 * c + 5] = o[8 * c + 5] * sc + pp * bfhi(w.z); o[8 * c + 6] = o[8 * c + 6] * sc + pp * bflo(w.w); o[8 * c + 7] = o[8 * c + 7] * sc + pp * bfhi(w.w); }
        }
        const float M = wave_max(m), f = exp2f(m - M);
        const float lt = wave_sum(l * f);
        float res = 0.f;
#pragma unroll
        for (int d = 0; d < 64; ++d) { const float t = wave_sum(o[d] * f); if (lane == d) res = t; }
        zb[(size_t)r * D + h * 64 + lane] = (bf16)f2bf(res / lt);
    }
}
template <bool WCTX>
__device__ __forceinline__ void phase_mlstm_naive(Frame& F) {
    const int gw = F.blk * NWAVES + F.wave, lane = F.lane;
    if ((gw & 15) != 0) return;
    const int it = gw >> 4; if (it >= NB * 8 * 2) return;
    const int b = it >> 4, hd = (it >> 1) & 7, j = (it & 1) * 64 + lane;
    const bf16* kb = (const bf16*)(F.ws + WS_MK); const bf16* vb = (const bf16*)(F.ws + WS_MV); const bf16* qb = (const bf16*)(F.ws + WS_MQ);
    const float* gb = (const float*)(F.ws + WS_MG); float* hsum = (float*)(F.ws + WS_MHS);
    for (int dir = 0; dir < 2; ++dir) {
        float C[64], nn[64], m = 0.f;
#pragma unroll
        for (int d = 0; d < 64; ++d) { C[d] = 0.f; nn[d] = 0.f; }
        for (int s = 0; s < CTX + SEQ; ++s) {
            const int r = seq_row(b, dir, s);
            const float ig = gb[(size_t)r * 32 + dir * 16 + hd], lf = log_sigmoidf_(gb[(size_t)r * 32 + dir * 16 + 8 + hd]);
            const float mn = fmaxf(lf + m, ig), fa = __expf(lf + m - mn), ia = __expf(ig - mn); m = mn;
            const float vj = bf2f(vb[(size_t)r * 1024 + hd * 128 + j]) * ia;
            float num = 0.f, den = 0.f;
#pragma unroll
            for (int c = 0; c < 8; ++c) {
                const v4u kw = *(const v4u*)(kb + (size_t)r * 512 + hd * 64 + 8 * c), qw = *(const v4u*)(qb + (size_t)r * 512 + hd * 64 + 8 * c);
                float kk[8], qq[8];
                kk[0] = bflo(kw.x); kk[1] = bfhi(kw.x); kk[2] = bflo(kw.y); kk[3] = bfhi(kw.y); kk[4] = bflo(kw.z); kk[5] = bfhi(kw.z); kk[6] = bflo(kw.w); kk[7] = bfhi(kw.w);
                qq[0] = bflo(qw.x); qq[1] = bfhi(qw.x); qq[2] = bflo(qw.y); qq[3] = bfhi(qw.y); qq[4] = bflo(qw.z); qq[5] = bfhi(qw.z); qq[6] = bflo(qw.w); qq[7] = bfhi(qw.w);
#pragma unroll
                for (int e = 0; e < 8; ++e) { const int d = 8 * c + e;
                    C[d] = fa * C[d] + kk[e] * vj; nn[d] = fa * nn[d] + ia * kk[e]; num += C[d] * qq[e]; den += nn[d] * qq[e]; }
            }
            if (WCTX || s >= CTX) {
                const float outv = num / fmaxf(fabsf(den), __expf(-m));
                float* hp = hsum + (size_t)r * D + hd * 128 + j;
                if (dir == 0) *hp = outv; else *hp = *hp + outv;
            }
        }
    }
}
template <bool WCTX>
__device__ __forceinline__ void phase_mlstm_combine(Frame& F) {
    constexpr int R0 = WCTX ? 0 : TC;
    const float* hsum = (const float*)(F.ws + WS_MHS); const bf16* ob = (const bf16*)(F.ws + WS_MO); bf16* zb = (bf16*)(F.ws + WS_Z);
    const int gw = F.blk * NWAVES + F.wave, NGW = F.G * NWAVES, lane = F.lane;
    f32x4 gv[4];
#pragma unroll
    for (int j = 0; j < 4; ++j) gv[j] = *(const f32x4*)(F.in[IN_MLNG] + 4 * lane + 256 * j);
    for (int r = R0 + gw; r < T; r += NGW) {
#pragma unroll
        for (int j = 0; j < 4; ++j) {
            const f32x4 hv = *(const f32x4*)(hsum + (size_t)r * D + 4 * lane + 256 * j);
            float ss = hv.x * hv.x + hv.y * hv.y + hv.z * hv.z + hv.w * hv.w;
#pragma unroll
            for (int o = 1; o < 32; o <<= 1) ss += __shfl_xor(ss, o);
            const float rs = rsqrtf(ss * (1.f / 128.f) + EPS);
            const v2u ow = *(const v2u*)(ob + (size_t)r * D + 4 * lane + 256 * j);
            f32x4 z = hv * rs * gv[j];
            z.x *= sigmoidf_(bflo(ow.x)); z.y *= sigmoidf_(bfhi(ow.x)); z.z *= sigmoidf_(bflo(ow.y)); z.w *= sigmoidf_(bfhi(ow.y));
            st_bf4(zb + (size_t)r * D + 4 * lane + 256 * j, z);
        }
    }
}
#include <hip/hip_bf16.h>
#include <cmath>
namespace attn_body {
using bf16=__hip_bfloat16;
using bf16x8=__attribute__((ext_vector_type(8)))short;
using s16x4=__attribute__((ext_vector_type(4)))short;
using f32x16=__attribute__((ext_vector_type(16)))float;
using u32x4=__attribute__((ext_vector_type(4)))unsigned;
constexpr int D=64,QP=1024,KP=256;
constexpr int NW=8,QBLK=32,QB=QBLK*NW,KVBLK=64;
__device__ __forceinline__ int crow(int r,int hi){return (r&3)+8*(r>>2)+4*hi;}
#define SBAR() __builtin_amdgcn_sched_barrier(0)
__device__ __forceinline__ void cmask(f32x16&p0,f32x16&p1,int jb,int qrel,int hi){
  const float NEG=-INFINITY; int kb=64*jb+4*hi;
  #pragma unroll
  for(int r=0;r<16;++r){int kv=kb+(r&3)+8*(r>>2); if(kv>qrel)p0[r]=NEG; if(kv+32>qrel)p1[r]=NEG;}
}

constexpr int NSLOT=3, SLOTB=8192;
constexpr int LDS_K=0, LDS_V=NSLOT*SLOTB, LDS_WS=2*NSLOT*SLOTB, LDS_OST=LDS_WS+NW*64*4, LDS_BYTES=LDS_OST+NW*4096;
constexpr float C2=0.125f*1.4426950408889634f;
__device__ __forceinline__ void glds16(const void*gsrc,unsigned lds_dst){unsigned keep;
  asm volatile("s_mov_b32 %0, m0\n\ts_mov_b32 m0, %2\n\ts_nop 0\n\tglobal_load_lds_dwordx4 %1, off\n\ts_mov_b32 m0, %0":"=&s"(keep):"v"(gsrc),"s"(lds_dst):"memory");}
__device__ __forceinline__ float max3f(float a,float b,float c){float r;asm("v_max3_f32 %0, %1, %2, %3":"=v"(r):"v"(a),"v"(b),"v"(c));return r;}
__device__ __forceinline__ float max2f(float a,float b){float r;asm("v_max_f32_e32 %0, %1, %2":"=v"(r):"v"(a),"v"(b));return r;}
__device__ __forceinline__ float fadd_s(float a,float b){float r;asm("v_add_f32_e32 %0, %1, %2":"=v"(r):"v"(a),"v"(b));return r;}
__device__ __forceinline__ float fsub_s(float a,float b){float r;asm("v_sub_f32_e32 %0, %1, %2":"=v"(r):"v"(a),"v"(b));return r;}
typedef float f32x2_t __attribute__((ext_vector_type(2))); typedef __bf16 bf16x2_t __attribute__((ext_vector_type(2)));
__device__ __forceinline__ unsigned cvtpk_s(float lo,float hi){f32x2_t v={lo,hi};bf16x2_t b=__builtin_convertvector(v,bf16x2_t);return __builtin_bit_cast(unsigned,b);}
#define WAIT_BAR(N) asm volatile("s_waitcnt vmcnt(" #N ") lgkmcnt(0)\n\ts_barrier":::"memory")

__device__ __forceinline__ void qkt(f32x16&p0,f32x16&p1,const char*Kslot,const bf16x8*qr,const f32x16&negm,int r32,int hi){
  const char*kb=Kslot+hi*1024+r32*16;
  #pragma unroll
  for(int d0=0;d0<4;++d0){
    const bf16x8 b0=*reinterpret_cast<const bf16x8*>(kb+d0*2048);
    const bf16x8 b1=*reinterpret_cast<const bf16x8*>(kb+d0*2048+512);
    if(d0==0){p0=__builtin_amdgcn_mfma_f32_32x32x16_bf16(b0,qr[0],negm,0,0,0);p1=__builtin_amdgcn_mfma_f32_32x32x16_bf16(b1,qr[0],negm,0,0,0);}
    else{p0=__builtin_amdgcn_mfma_f32_32x32x16_bf16(b0,qr[d0],p0,0,0,0);p1=__builtin_amdgcn_mfma_f32_32x32x16_bf16(b1,qr[d0],p1,0,0,0);}}
}
typedef __attribute__((address_space(3))) const char* lds_cptr;
typedef short v4i16_t __attribute__((ext_vector_type(4)));
__device__ __forceinline__ void kload8(bf16x8*kf,lds_cptr kp){
  kf[0]=*(const __attribute__((address_space(3))) bf16x8*)(kp);      kf[1]=*(const __attribute__((address_space(3))) bf16x8*)(kp+512);
  kf[2]=*(const __attribute__((address_space(3))) bf16x8*)(kp+2048); kf[3]=*(const __attribute__((address_space(3))) bf16x8*)(kp+2560);
  kf[4]=*(const __attribute__((address_space(3))) bf16x8*)(kp+4096); kf[5]=*(const __attribute__((address_space(3))) bf16x8*)(kp+4608);
  kf[6]=*(const __attribute__((address_space(3))) bf16x8*)(kp+6144); kf[7]=*(const __attribute__((address_space(3))) bf16x8*)(kp+6656);
}
__device__ __forceinline__ void kload2(bf16x8*kf,lds_cptr kp,int j){ kf[2*j]=*(const __attribute__((address_space(3))) bf16x8*)(kp+j*2048); kf[2*j+1]=*(const __attribute__((address_space(3))) bf16x8*)(kp+j*2048+512); }
__device__ __forceinline__ s16x4 vtr(lds_cptr p){ return __builtin_bit_cast(s16x4,__builtin_amdgcn_ds_read_tr16_b64_v4i16((__attribute__((address_space(3))) v4i16_t*)p)); }
__device__ __forceinline__ float rowmax(const f32x16&p0,const f32x16&p1){
  float a=max3f(p0[0],p0[1],p1[0]),b=max3f(p0[2],p0[3],p1[1]);a=max3f(a,p1[2],p1[3]);
  #pragma unroll
  for(int r=4;r<16;r+=4){a=max3f(a,p0[r],p0[r+1]);b=max3f(b,p0[r+2],p0[r+3]);a=max3f(a,p1[r],p1[r+1]);b=max3f(b,p1[r+2],p1[r+3]);}
  const float m=max2f(a,b);
  auto rr=__builtin_amdgcn_permlane32_swap(__float_as_uint(m),__float_as_uint(m),false,false);
  return max2f(__uint_as_float(rr[0]),__uint_as_float(rr[1]));
}
__device__ __forceinline__ void pv(f32x16*o,int vb,bf16x8 pa0,bf16x8 pa1,bf16x8 pa2,bf16x8 pa3){
  #pragma unroll
  for(int d0=0;d0<2;++d0){s16x4 lo[4],hi[4];
    #pragma unroll
    for(int ks=0;ks<4;++ks){
      asm volatile("ds_read_b64_tr_b16 %0,%1 offset:%c2":"=&v"(lo[ks]):"v"(vb),"i"(d0*4096+ks*1024):"memory");
      asm volatile("ds_read_b64_tr_b16 %0,%1 offset:%c2":"=&v"(hi[ks]):"v"(vb),"i"(d0*4096+ks*1024+512):"memory");}
    asm volatile("s_waitcnt lgkmcnt(0)":::"memory");SBAR();
    #define PK(k) (bf16x8){lo[k][0],lo[k][1],lo[k][2],lo[k][3],hi[k][0],hi[k][1],hi[k][2],hi[k][3]}
    o[d0]=__builtin_amdgcn_mfma_f32_32x32x16_bf16(pa0,PK(0),o[d0],0,0,0);
    o[d0]=__builtin_amdgcn_mfma_f32_32x32x16_bf16(pa1,PK(1),o[d0],0,0,0);
    o[d0]=__builtin_amdgcn_mfma_f32_32x32x16_bf16(pa2,PK(2),o[d0],0,0,0);
    o[d0]=__builtin_amdgcn_mfma_f32_32x32x16_bf16(pa3,PK(3),o[d0],0,0,0);
    #undef PK
  }
}

#ifndef ATTN_STORE16
#define ATTN_STORE16(p,v) (*(u32x4*)(p)=(v))
#endif
template<int THRL> __device__ __forceinline__ void attn_unit(const bf16*Qu,const bf16*__restrict__ Kh,const bf16*__restrict__ Vh,bf16*Ou,const int NT,char*shm){
  const int tid=threadIdx.x,lane=tid&63,r32=lane&31,hi=lane>>5; const int wid=__builtin_amdgcn_readfirstlane(tid>>6);
  const bf16*Qw=Qu+(long)(wid*QBLK)*QP;
  const unsigned lds0=(unsigned)(uintptr_t)shm;
  float*wsf=(float*)(shm+LDS_WS)+wid*64;
  const bf16*ksrc=Kh+(long)lane*KP+wid*8;
  const bf16*vsrc=Vh+(long)(16*(wid&3)+(lane>>2))*KP+(wid>>2)*32+(lane&3)*8;
  const unsigned kdst=lds0+LDS_K+wid*1024, vdst=lds0+LDS_V+wid*1024;
  #define DMA_K(t,slot) glds16(ksrc+(long)(t)*KVBLK*KP,(unsigned)__builtin_amdgcn_readfirstlane(kdst+(slot)))
  #define DMA_V(t,slot) glds16(vsrc+(long)(t)*KVBLK*KP,(unsigned)__builtin_amdgcn_readfirstlane(vdst+(slot)))
  const int vb0=(int)(lds0+LDS_V)+((lane>>4)&1)*32+(lane&3)*8+(4*hi+((lane&15)>>2))*64;
  const char*Kbase=shm+LDS_K; bf16x8 kf[8];
  const lds_cptr shm3=(lds_cptr)shm; const lds_cptr kp0=shm3+LDS_K+hi*1024+r32*16; const lds_cptr vp0=shm3+LDS_V+((lane>>4)&1)*32+(lane&3)*8+(4*hi+((lane&15)>>2))*64;
  DMA_K(0,0);DMA_V(0,0);DMA_K(1,SLOTB);
  bf16x8 qr[4];
  #pragma unroll
  for(int d0=0;d0<4;++d0)qr[d0]=*reinterpret_cast<const bf16x8*>(&Qw[(long)r32*QP+d0*16+hi*8]);
  float mhat=0.f,l_reg=0.f;f32x16 o[2];o[0]=f32x16{};o[1]=f32x16{};f32x16 negm=f32x16{};asm volatile("":"+v"(negm));
  #define CMASK(P0,P1,t) do{}while(0)
  bool resc=false;
  #define START(P0,P1) do{ const float rm=rowmax(P0,P1); resc=false; \
    { const float dl=rm; mhat=fadd_s(mhat,dl); \
      _Pragma("unroll") for(int r=0;r<16;++r){P0[r]=fsub_s(P0[r],dl);P1[r]=fsub_s(P1[r],dl);} \
      _Pragma("unroll") for(int r=0;r<16;++r)negm[r]=-mhat; asm volatile("":"+v"(negm)); } \
    _Pragma("unroll") for(int r=0;r<16;++r)P0[r]=__builtin_amdgcn_exp2f(P0[r]); }while(0)
  #define RESC() do{ if(resc){ asm volatile("s_waitcnt lgkmcnt(0)":::"memory"); \
      _Pragma("unroll") for(int d_=0;d_<2;++d_) _Pragma("unroll") for(int r=0;r<16;++r)o[d_][r]*=wsf[crow(r,hi)]; } }while(0)
  f32x16 pA0,pA1,pB0,pB1;
  int sl_prev=0,sl_cur=0,sl_next=SLOTB;
  #define ROT() do{sl_prev=sl_cur;sl_cur=sl_next;sl_next=(sl_next==(NSLOT-1)*SLOTB)?0:sl_next+SLOTB;}while(0)
  DMA_K(2,2*SLOTB);
  WAIT_BAR(3);
  qkt(pA0,pA1,Kbase,qr,negm,r32,hi);asm volatile("s_nop 15\n\ts_nop 7":"+v"(pA0),"+v"(pA1));CMASK(pA0,pA1,0);
  START(pA0,pA1);
  _Pragma("unroll") for(int r=0;r<16;++r)pA1[r]=__builtin_amdgcn_exp2f(pA1[r]);
  WAIT_BAR(0);
  DMA_K(3,0);DMA_V(1,SLOTB);
  ROT();
  kload8(kf,kp0+sl_cur);
  WAIT_BAR(2);
  s16x4 vlo[8],vhi[8]; u32x4 pw0,pw1,pw2,pw3;
  #define PKW(P,B) cvtpk_s(P[B],P[B+1])
  #define PAF(k) __builtin_bit_cast(bf16x8,pw##k)
  #define VFR(i) (bf16x8){vlo[i][0],vlo[i][1],vlo[i][2],vlo[i][3],vhi[i][0],vhi[i][1],vhi[i][2],vhi[i][3]}
  #define PIN(x) asm volatile("":"+v"(x))
  #define MX3(a,b,c) __builtin_fmaxf(__builtin_fmaxf((a),(b)),(c))
  #define GAPA(MF,A0,A1,A2,A3,W0,W1,PW) do{ MF; sacc+=A0; sacc+=A1; sacc+=A2; sacc+=A3; PIN(sacc); W0; W1; PIN(PW); SBAR(); }while(0)
  #define EX(v) __builtin_amdgcn_exp2f(v)
  #define GAPB(MF,X,B) do{ MF; X[B]=EX(X[B]); X[B+1]=EX(X[B+1]); X[B+2]=EX(X[B+2]); X[B+3]=EX(X[B+3]); PIN(X); SBAR(); }while(0)
  #define VRD(i) do{ vlo[i]=vtr(vp_+(((i)>>2)*4096+((i)&3)*1024)); vhi[i]=vtr(vp_+(((i)>>2)*4096+((i)&3)*1024+512)); }while(0)
  #define KRD(G,j) do{ if(G){ kload2(kf,kp0+sl_next,j); SBAR(); } }while(0)
  #define STEP(C0,C1,P0,P1,t,GK,GV,GL) do{ SBAR(); \
    const lds_cptr vp_=vp0+sl_prev; \
    VRD(0); SBAR(); float sacc=(P0[0]+P0[1]); \
    GAPA(C0=__builtin_amdgcn_mfma_f32_32x32x16_bf16(kf[0],qr[0],negm,0,0,0), P0[2],P0[3],P0[4],P0[5],     pw0[0]=PKW(P0,0), pw0[1]=PKW(P0,2), pw0); \
    VRD(4); SBAR(); GAPA(C1=__builtin_amdgcn_mfma_f32_32x32x16_bf16(kf[1],qr[0],negm,0,0,0), P0[6],P0[7],P0[8],P0[9],     pw0[2]=PKW(P0,4), pw0[3]=PKW(P0,6), pw0); \
    VRD(1); SBAR(); GAPA(C0=__builtin_amdgcn_mfma_f32_32x32x16_bf16(kf[2],qr[1],C0,0,0,0),   P0[10],P0[11],P0[12],P0[13], pw1[0]=PKW(P0,8), pw1[1]=PKW(P0,10), pw1); \
    VRD(5); SBAR(); GAPA(C1=__builtin_amdgcn_mfma_f32_32x32x16_bf16(kf[3],qr[1],C1,0,0,0),   P0[14],P0[15],P1[0],P1[1],   pw1[2]=PKW(P0,12),pw1[3]=PKW(P0,14), pw1); \
    VRD(2); SBAR(); GAPA(C0=__builtin_amdgcn_mfma_f32_32x32x16_bf16(kf[4],qr[2],C0,0,0,0),   P1[2],P1[3],P1[4],P1[5],     pw2[0]=PKW(P1,0), pw2[1]=PKW(P1,2), pw2); \
    VRD(6); SBAR(); GAPA(C1=__builtin_amdgcn_mfma_f32_32x32x16_bf16(kf[5],qr[2],C1,0,0,0),   P1[6],P1[7],P1[8],P1[9],     pw2[2]=PKW(P1,4), pw2[3]=PKW(P1,6), pw2); \
    VRD(3); SBAR(); GAPA(C0=__builtin_amdgcn_mfma_f32_32x32x16_bf16(kf[6],qr[3],C0,0,0,0),   P1[10],P1[11],P1[12],P1[13], pw3[0]=PKW(P1,8), pw3[1]=PKW(P1,10), pw3); \
    VRD(7); SBAR(); GAPA(C1=__builtin_amdgcn_mfma_f32_32x32x16_bf16(kf[7],qr[3],C1,0,0,0),   P1[14],P1[15],0.f,0.f,       pw3[2]=PKW(P1,12),pw3[3]=PKW(P1,14), pw3); \
    l_reg+=sacc; \
    if(GK){DMA_K((t)+3,sl_cur);} if(GV){DMA_V((t)+1,sl_next);} \
    CMASK(C0,C1,t); \
    { float a=MX3(C0[0],C0[1],C1[0]),b=MX3(C0[2],C0[3],C1[1]); a=MX3(a,C1[2],C1[3]); \
      _Pragma("unroll") for(int r=4;r<16;r+=4){a=MX3(a,C0[r],C0[r+1]);b=MX3(b,C0[r+2],C0[r+3]);a=MX3(a,C1[r],C1[r+1]);b=MX3(b,C1[r+2],C1[r+3]);} \
      float rm=__builtin_fmaxf(a,b); { auto rr=__builtin_amdgcn_permlane32_swap(__float_as_uint(rm),__float_as_uint(rm),false,false); rm=__builtin_fmaxf(__uint_as_float(rr[0]),__uint_as_float(rr[1])); } \
      resc=false; \
      if(__builtin_expect(__any(rm>(float)THRL),0)){ const float dl=__builtin_fmaxf(rm,0.f); mhat+=dl; \
        _Pragma("unroll") for(int r=0;r<16;++r){C0[r]-=dl;C1[r]-=dl;} \
        _Pragma("unroll") for(int r=0;r<16;++r)negm[r]=-mhat; asm volatile("":"+v"(negm)); \
        const float f=__builtin_amdgcn_exp2f(-dl); l_reg*=f; if(hi==0)wsf[r32]=f; resc=true; } } \
    SBAR(); \
    GAPB(o[0]=__builtin_amdgcn_mfma_f32_32x32x16_bf16(PAF(0),VFR(0),o[0],0,0,0), C0,0); \
    GAPB(o[1]=__builtin_amdgcn_mfma_f32_32x32x16_bf16(PAF(0),VFR(4),o[1],0,0,0), C0,4); \
    KRD(GL,0); GAPB(o[0]=__builtin_amdgcn_mfma_f32_32x32x16_bf16(PAF(1),VFR(1),o[0],0,0,0), C0,8); \
    KRD(GL,1); GAPB(o[1]=__builtin_amdgcn_mfma_f32_32x32x16_bf16(PAF(1),VFR(5),o[1],0,0,0), C0,12); \
    KRD(GL,2); GAPB(o[0]=__builtin_amdgcn_mfma_f32_32x32x16_bf16(PAF(2),VFR(2),o[0],0,0,0), C1,0); \
    KRD(GL,3); GAPB(o[1]=__builtin_amdgcn_mfma_f32_32x32x16_bf16(PAF(2),VFR(6),o[1],0,0,0), C1,4); \
    GAPB(o[0]=__builtin_amdgcn_mfma_f32_32x32x16_bf16(PAF(3),VFR(3),o[0],0,0,0), C1,8); \
    GAPB(o[1]=__builtin_amdgcn_mfma_f32_32x32x16_bf16(PAF(3),VFR(7),o[1],0,0,0), C1,12); \
    }while(0)
  int t=1;
  #undef CMASK
  #define CMASK(P0,P1,t) do{}while(0)
  for(;t+5<NT;t+=2){
    STEP(pB0,pB1,pA0,pA1,t,true,true,true);     WAIT_BAR(2); RESC(); ROT();
    STEP(pA0,pA1,pB0,pB1,t+1,true,true,true);   WAIT_BAR(2); RESC(); ROT();
  }
  #undef CMASK
  #define CMASK(P0,P1,t) do{}while(0)
  #define ENDW(tt) do{ if((tt)+3<NT){WAIT_BAR(2);} else if((tt)+2<NT){WAIT_BAR(1);} else {WAIT_BAR(0);} }while(0)
  for(;t+1<NT;t+=2){
    STEP(pB0,pB1,pA0,pA1,t,(t+3<NT),(t+1<NT),(t+1<NT));       ENDW(t);   RESC(); ROT();
    STEP(pA0,pA1,pB0,pB1,t+1,(t+4<NT),(t+2<NT),(t+2<NT));     ENDW(t+1); RESC(); ROT();
  }
  STEP(pB0,pB1,pA0,pA1,NT-1,false,false,false); RESC();
  { float sacc=pB0[0]+pB0[1]; _Pragma("unroll") for(int r=2;r<16;++r)sacc+=pB0[r]; _Pragma("unroll") for(int r=0;r<16;++r)sacc+=pB1[r]; l_reg+=sacc;
    pw0=(u32x4){PKW(pB0,0),PKW(pB0,2),PKW(pB0,4),PKW(pB0,6)};pw1=(u32x4){PKW(pB0,8),PKW(pB0,10),PKW(pB0,12),PKW(pB0,14)};pw2=(u32x4){PKW(pB1,0),PKW(pB1,2),PKW(pB1,4),PKW(pB1,6)};pw3=(u32x4){PKW(pB1,8),PKW(pB1,10),PKW(pB1,12),PKW(pB1,14)};
    SBAR(); pv(o,vb0+sl_cur,PAF(0),PAF(1),PAF(2),PAF(3)); }
  #undef PKW
  #undef PAF
  #undef VFR
  #undef PIN
  #undef MX3
  #undef GAPA
  #undef GAPB
  #undef EX
  #undef VRD
  #undef KRD
  #undef STEP
  #undef ENDW
  {auto rr=__builtin_amdgcn_permlane32_swap(__float_as_uint(l_reg),__float_as_uint(l_reg),false,false);l_reg=__uint_as_float(rr[0])+__uint_as_float(rr[1]);}
  if(hi==0)wsf[32+r32]=l_reg;asm volatile("s_waitcnt lgkmcnt(0)":::"memory");
  float rli[16];
  #pragma unroll
  for(int r=0;r<16;++r)rli[r]=__builtin_amdgcn_rcpf(wsf[32+crow(r,hi)]);
  bf16*Ow=Ou+(long)(wid*QBLK)*QP;
  { bf16*stg=(bf16*)(shm+LDS_OST)+wid*2048;
    #pragma unroll
    for(int r=0;r<16;++r){const int orow=crow(r,hi);
      #pragma unroll
      for(int d0=0;d0<2;++d0)stg[orow*64+d0*32+r32]=__float2bfloat16(o[d0][r]*rli[r]);}
    asm volatile("s_waitcnt lgkmcnt(0)":::"memory");
    #pragma unroll
    for(int i=0;i<4;++i){const int row=i*8+(lane>>3),ch=lane&7; const u32x4 v=*(const u32x4*)(stg+row*64+ch*8); ATTN_STORE16(Ow+(long)row*QP+ch*8,v);} }
  asm volatile("s_waitcnt lgkmcnt(0)\n\ts_barrier":::"memory");
  #undef DMA_K
  #undef DMA_V
  #undef CMASK
  #undef START
  #undef RESC
  #undef ROT
}
constexpr int ATTN_LDS_BYTES=LDS_BYTES;
#undef SBAR
#undef WAIT_BAR
}

template <bool WCTX>
__device__ __forceinline__ void phase_attn_fast(Frame& F, char* ldsg) {
    typedef attn_body::bf16 abf;
    const abf* Q = (const abf*)(F.ws + WS_QB); const abf* K = (const abf*)(F.ws + WS_KB); const abf* V = (const abf*)(F.ws + WS_VB); abf* O = (abf*)(F.ws + WS_Z);
    const int vcu = (F.G % 8 == 0) ? (F.blk % 8) * (F.G / 8) + F.blk / 8 : F.blk;
    const int nunits = WCTX ? 1024 + 128 : 1024;
    for (int u = vcu; u < nunits; u += F.G) {
        int h, kvh, qrow0, kv0, NT;
        if (u < 1024) { const int grp = u >> 5, b = grp >> 2; kvh = grp & 3; const int qb = (u >> 2) & 7; h = kvh * 4 + (u & 3); qrow0 = TC + b * SEQ + qb * 256; kv0 = b * KVLEN; NT = KVLEN / 64; }
        else { const int u2 = u - 1024, b = u2 >> 4; h = u2 & 15; kvh = h >> 2; qrow0 = b * CTX; kv0 = b * KVLEN + SEQ; NT = CTX / 64; }
        attn_body::attn_unit<8>(Q + (size_t)qrow0 * 1024 + h * 64, K + (size_t)kv0 * 256 + kvh * 64, V + (size_t)kv0 * 256 + kvh * 64, O + (size_t)qrow0 * 1024 + h * 64, NT, ldsg + RING_OFF);
    }
}

constexpr int S5_BU_STRIDE = 132;
constexpr int S5_X_STRIDE = 136;
constexpr int S5_Y_STRIDE = 20;
constexpr int S5_BU_BYTES = 16 * S5_BU_STRIDE * 4, S5_X_BYTES = 16 * S5_X_STRIDE * 2, S5_Y_BYTES = 16 * S5_Y_STRIDE * 4, S5_U_BYTES = 16 * 16 * 2;
constexpr int S5_ITEM_LDS = S5_BU_BYTES + S5_X_BYTES + 2 * S5_Y_BYTES + 4 * S5_Y_BYTES + 4 * S5_U_BYTES;
static_assert(4 * S5_ITEM_LDS <= RING_BYTES, "S5 LDS");
#define S5_BAR() do { asm volatile("s_waitcnt lgkmcnt(0)" ::: "memory"); __builtin_amdgcn_s_barrier(); asm volatile("" ::: "memory"); } while (0)

template <int J, bool WCTX>
__device__ __forceinline__ void phase_s5_fast(Frame& F) {
    const int lane = F.lane, w = F.wave;
    const bool helper = w >= 4;
    const int iw = w & 3, pairi = iw >> 1, dir = iw & 1;
    const int tq = lane & 15, kg = lane >> 4;
    const bf16* hb = (const bf16*)(F.ws + WS_H); float* ypart = (float*)(F.ws + WS_YSUM); bf16* zb = (bf16*)(F.ws + WS_Z);
    LAS unsigned char* base = F.lds + iw * S5_ITEM_LDS;
    LAS float* BU = (LAS float*)base;
    LAS bf16* X = (LAS bf16*)(base + S5_BU_BYTES);
    LAS float* Y = (LAS float*)(base + S5_BU_BYTES + S5_X_BYTES);
    LAS float* HV = (LAS float*)(base + S5_BU_BYTES + S5_X_BYTES + 2 * S5_Y_BYTES);
    LAS bf16* UL = (LAS bf16*)(base + S5_BU_BYTES + S5_X_BYTES + 6 * S5_Y_BYTES);
    for (int it0 = F.blk * 2; it0 < NB * 64; it0 += F.G * 2) {
        const int it = it0 + pairi, b = it >> 6, g = it & 63;
        const int gi = (J * 2 + dir) * 64 + g;
        const float dt = expf(F.in[IN_S5LOG][gi]);
        if (helper) {
            const float d_c = F.in[IN_S5D][J * D + g * 16 + tq];
            const long rstep = dir ? -(long)D : (long)D;
            bf16x8 ub[4]; float yob[2][4] = {{0.f, 0.f, 0.f, 0.f}, {0.f, 0.f, 0.f, 0.f}};
#pragma unroll
            for (int k = 0; k < 4; ++k) { ub[k] = (bf16x8){0, 0, 0, 0, 0, 0, 0, 0}; if (kg < 2) ub[k] = *(const bf16x8*)(hb + (size_t)seq_row(b, dir, 16 * k + tq) * D + g * 16 + 8 * kg); }
#pragma unroll 4
            for (int s = -1; s < 147; ++s) {
                const int e = s - 1, d = s + 1;
                const bool e_ok = (e >= 0) && (e < 144) && (WCTX || e >= 16);
                const bool e_second = (e < 16) ? (e >= 8) : (e >= 80);
                const long idx0 = (long)seq_row(b, dir, 16 * (e < 0 ? 0 : (e > 143 ? 143 : e)) + 4 * kg) * D + g * 16 + tq;
                if (d < 144 && kg < 2) *(LAS bf16x8*)(UL + (d & 3) * 256 + tq * 16 + 8 * kg) = ub[d & 3];
                if (e_ok) {
                    const f32x4 y = *(const LAS f32x4*)(Y + (e & 1) * (16 * S5_Y_STRIDE) + tq * S5_Y_STRIDE + 4 * kg);
                    if (!e_second) {
#pragma unroll
                        for (int r = 0; r < 4; ++r) ypart[idx0 + r * rstep] = y[r];
                    } else {
                        if (e == 8 || e == 80) {
#pragma unroll
                            for (int r = 0; r < 4; ++r) yob[e & 1][r] = __hip_atomic_load(ypart + idx0 + r * rstep, __ATOMIC_RELAXED, __HIP_MEMORY_SCOPE_AGENT);
                        }
                        const f32x4 hv = *(const LAS f32x4*)(HV + (e & 3) * (16 * S5_Y_STRIDE) + tq * S5_Y_STRIDE + 4 * kg);
#pragma unroll
                        for (int r = 0; r < 4; ++r) zb[idx0 + r * rstep] = (bf16)pk2(gelu_tanh(y[r] + yob[e & 1][r] + d_c * hv[r]), 0.f);
                    }
                }
                { const int e1 = e + 1; const bool e1_ok = (e1 >= 0) && (e1 < 144) && (WCTX || e1 >= 16); const bool e1_second = (e1 < 16) ? (e1 >= 8) : (e1 >= 80);
                  if (e1_ok && e1_second && e1 != 8 && e1 != 80) {
                      const long i1 = (long)seq_row(b, dir, 16 * e1 + 4 * kg) * D + g * 16 + tq;
#pragma unroll
                      for (int r = 0; r < 4; ++r) yob[e1 & 1][r] = __hip_atomic_load(ypart + i1 + r * rstep, __ATOMIC_RELAXED, __HIP_MEMORY_SCOPE_AGENT);
                  } }
                if (d + 4 < 144 && kg < 2) ub[d & 3] = *(const bf16x8*)(hb + (size_t)seq_row(b, dir, 16 * (d + 4) + tq) * D + g * 16 + 8 * kg);
                if (e == 7 || e == 79) asm volatile("s_waitcnt vmcnt(0)" ::: "memory");
                S5_BAR();
            }
        } else {
            bf16x8 bbf[8], idf, cf[4];
#pragma unroll
            for (int nt = 0; nt < 8; ++nt) {
                const int n = 16 * nt + tq, p = n >> 1, ri = n & 1;
                bf16x8 fr = (bf16x8){0, 0, 0, 0, 0, 0, 0, 0};
                if (kg < 2) {
                    const float lr = F.in[IN_S5LRE][gi * 64 + p], li = F.in[IN_S5LIM][gi * 64 + p]; const float mag = expf(lr * dt); double sd, cd; sincos_d((double)(li * dt), sd, cd);
                    const float ar = mag * (float)cd, ai = mag * (float)sd, den = lr * lr + li * li, nr = ar - 1.f, ni = ai;
                    const float f_re = (nr * lr + ni * li) / den, f_im = (ni * lr - nr * li) / den;
                    const float* brp = F.in[IN_S5BRE] + ((size_t)gi * 64 + p) * 16 + 8 * kg; const float* bip = F.in[IN_S5BIM] + ((size_t)gi * 64 + p) * 16 + 8 * kg;
#pragma unroll
                    for (int jj = 0; jj < 8; ++jj) { const float br = brp[jj], bi = bip[jj]; const float v = ri ? (f_re * bi + f_im * br) : (f_re * br - f_im * bi); fr[jj] = (short)f2bf(v); }
                }
                bbf[nt] = fr;
            }
#pragma unroll
            for (int jj = 0; jj < 8; ++jj) idf[jj] = (short)((8 * kg + jj == tq) ? 0x3f80 : 0);
#pragma unroll
            for (int ks = 0; ks < 4; ++ks) {
                const int p0 = 16 * ks + 4 * kg;
                const f32x4 cr = *(const f32x4*)(F.in[IN_S5CRE] + ((size_t)gi * 16 + tq) * 64 + p0), ci = *(const f32x4*)(F.in[IN_S5CIM] + ((size_t)gi * 16 + tq) * 64 + p0);
                bf16x8 fr; fr[0] = (short)f2bf(cr.x); fr[1] = (short)f2bf(-ci.x); fr[2] = (short)f2bf(cr.y); fr[3] = (short)f2bf(-ci.y); fr[4] = (short)f2bf(cr.z); fr[5] = (short)f2bf(-ci.z); fr[6] = (short)f2bf(cr.w); fr[7] = (short)f2bf(-ci.w);
                cf[ks] = fr;
            }
            float a_re, a_im;
            { const float lr = F.in[IN_S5LRE][gi * 64 + lane], li = F.in[IN_S5LIM][gi * 64 + lane]; const float mag = expf(lr * dt); double sd, cd; sincos_d((double)(li * dt), sd, cd); a_re = mag * (float)cd; a_im = mag * (float)sd; }
            asm volatile("s_waitcnt vmcnt(0)" ::: "memory");
            f32x2 x = (f32x2){0.f, 0.f};
            const f32x2 are2 = (f32x2){a_re, a_re}, aim2 = (f32x2){-a_im, a_im};
            for (int s = -1; s < 147; ++s) {
                if (s >= 0 && s < 144) {
                    bf16x8 uf = (bf16x8){0, 0, 0, 0, 0, 0, 0, 0};
                    if (kg < 2) uf = *(const LAS bf16x8*)(UL + (s & 3) * 256 + tq * 16 + 8 * kg);
#pragma unroll
                    for (int nt = 0; nt < 8; ++nt) {
                        const f32x4 dacc = __builtin_amdgcn_mfma_f32_16x16x32_bf16(bbf[nt], uf, (f32x4){0.f, 0.f, 0.f, 0.f}, 0, 0, 0);
                        *(LAS f32x4*)(BU + tq * S5_BU_STRIDE + 16 * nt + 4 * kg) = dacc;
                    }
                    if (WCTX || s >= 16) {
                        const f32x4 hv = __builtin_amdgcn_mfma_f32_16x16x32_bf16(uf, idf, (f32x4){0.f, 0.f, 0.f, 0.f}, 0, 0, 0);
                        *(LAS f32x4*)(HV + (s & 3) * (16 * S5_Y_STRIDE) + tq * S5_Y_STRIDE + 4 * kg) = hv;
                    }
                    f32x2 buv[16]; unsigned xw[16];
#pragma unroll
                    for (int t = 0; t < 16; ++t) buv[t] = *(const LAS f32x2*)(BU + t * S5_BU_STRIDE + 2 * lane);
#pragma unroll
                    for (int t = 0; t < 16; ++t) { const f32x2 xs = (f32x2){x.y, x.x}; x = are2 * x + (aim2 * xs + buv[t]); xw[t] = pk2(x.x, x.y); }
                    if (WCTX || s >= 16) {
#pragma unroll
                        for (int t = 0; t < 16; ++t) *(LAS unsigned*)(X + t * S5_X_STRIDE + 2 * lane) = xw[t];
                        f32x4 y = (f32x4){0.f, 0.f, 0.f, 0.f};
#pragma unroll
                        for (int ks = 0; ks < 4; ++ks) { const bf16x8 af = *(const LAS bf16x8*)(X + tq * S5_X_STRIDE + 32 * ks + 8 * kg); y = __builtin_amdgcn_mfma_f32_16x16x32_bf16(af, cf[ks], y, 0, 0, 0); }
                        *(LAS f32x4*)(Y + (s & 1) * (16 * S5_Y_STRIDE) + tq * S5_Y_STRIDE + 4 * kg) = y;
                    }
                }
                S5_BAR();
            }
        }
        __syncthreads();
    }
}

constexpr size_t WS_MCT = WS_MHS;
constexpr size_t WS_MN = WS_MG + 2359296;
constexpr size_t WS_MSC = WS_MN + 589824;
static_assert(WS_MSC + 2304 * 16 <= WS_MHS, "mLSTM small tables");
constexpr int ML_TS = 136;
constexpr int ML_DS = 72;

template <bool MAX>
__device__ __forceinline__ void scan128(LAS float* a, int lane) {
    const float v0 = a[2 * lane], v1 = a[2 * lane + 1];
    const float s = MAX ? fmaxf(v0, v1) : v0 + v1;
    float inc = s;
#pragma unroll
    for (int o = 1; o < 64; o <<= 1) { const float t = __shfl_up(inc, o); if (lane >= o) inc = MAX ? fmaxf(inc, t) : inc + t; }
    float exc = __shfl_up(inc, 1); if (lane == 0) exc = MAX ? -INFINITY : 0.f;
    a[2 * lane] = MAX ? fmaxf(exc, v0) : exc + v0; a[2 * lane + 1] = inc;
}

__device__ __forceinline__ void phase_ml_states(Frame& F) {
    const int tid = F.tid, lane = F.lane, w = F.wave, tq = lane & 15, kg = lane >> 4;
    const bf16* kb = (const bf16*)(F.ws + WS_MK); const bf16* vb = (const bf16*)(F.ws + WS_MV); const float* gb = (const float*)(F.ws + WS_MG);
    float* cT = (float*)(F.ws + WS_MCT); float* nl = (float*)(F.ws + WS_MN); float* sc = (float*)(F.ws + WS_MSC);
    LAS bf16* KeT = (LAS bf16*)(F.lds);
    LAS bf16* VT = (LAS bf16*)(F.lds + 64 * ML_TS * 2);
    LAS float* cumS = (LAS float*)(F.lds + 192 * ML_TS * 2);
    LAS float* igS = cumS + 128; LAS float* ewS = igS + 128; LAS float* red = ewS + 128;
    for (int us = F.blk; us < 2304; us += F.G) {
        const int jc = us % 18, bhd = us / 18, dir = bhd & 1, hd = (bhd >> 1) & 7, b = bhd >> 4;
        if (tid < 128) { const int r = seq_row(b, dir, 128 * jc + tid); igS[tid] = gb[(size_t)r * 32 + dir * 16 + hd]; cumS[tid] = log_sigmoidf_(gb[(size_t)r * 32 + dir * 16 + 8 + hd]); }
        __syncthreads();
        if (w == 0) {
            scan128<false>(cumS, lane);
            const float total = __shfl(cumS[2 * lane + 1], 63);
            const float w0 = total - cumS[2 * lane] + igS[2 * lane], w1 = total - cumS[2 * lane + 1] + igS[2 * lane + 1];
            const float ml = wave_max(fmaxf(w0, w1));
            ewS[2 * lane] = __expf(w0 - ml); ewS[2 * lane + 1] = __expf(w1 - ml);
            if (lane == 0) { sc[(size_t)us * 4] = total; sc[(size_t)us * 4 + 1] = ml; }
        }
        __syncthreads();
        { const int i = tid & 127, c = tid >> 7; const int r = seq_row(b, dir, 128 * jc + i); const float e = ewS[i];
#pragma unroll
          for (int h2 = 0; h2 < 2; ++h2) { const v4u kw = *(const v4u*)(kb + (size_t)r * 512 + hd * 64 + 16 * c + 8 * h2);
              const float kv[8] = {bflo(kw.x), bfhi(kw.x), bflo(kw.y), bfhi(kw.y), bflo(kw.z), bfhi(kw.z), bflo(kw.w), bfhi(kw.w)};
#pragma unroll
              for (int jj = 0; jj < 8; ++jj) KeT[(16 * c + 8 * h2 + jj) * ML_TS + i] = (bf16)f2bf(kv[jj] * e); }
#pragma unroll
          for (int h4 = 0; h4 < 4; ++h4) { const v4u vw = *(const v4u*)(vb + (size_t)r * 1024 + hd * 128 + 32 * c + 8 * h4);
              const unsigned vv[4] = {vw.x, vw.y, vw.z, vw.w};
#pragma unroll
              for (int jj = 0; jj < 8; ++jj) VT[(32 * c + 8 * h4 + jj) * ML_TS + i] = (bf16)((jj & 1) ? (vv[jj >> 1] >> 16) : (vv[jj >> 1] & 0xffffu)); } }
        __syncthreads();
#pragma unroll
        for (int dt = 0; dt < 4; ++dt) {
            f32x4 acc = (f32x4){0.f, 0.f, 0.f, 0.f};
#pragma unroll
            for (int ks = 0; ks < 4; ++ks) {
                const bf16x8 af = *(const LAS bf16x8*)(VT + (16 * w + tq) * ML_TS + 32 * ks + 8 * kg);
                const bf16x8 bfr = *(const LAS bf16x8*)(KeT + (16 * dt + tq) * ML_TS + 32 * ks + 8 * kg);
                acc = __builtin_amdgcn_mfma_f32_16x16x32_bf16(af, bfr, acc, 0, 0, 0);
            }
#pragma unroll
            for (int r = 0; r < 4; ++r) cT[(size_t)us * 8192 + (16 * w + 4 * kg + r) * 64 + 16 * dt + tq] = acc[r];
        }
        if (tid < 64) { float s = 0.f;
#pragma unroll
            for (int c8 = 0; c8 < 16; ++c8) { const v4u q = *(const LAS v4u*)(KeT + tid * ML_TS + 8 * c8); s += bflo(q.x) + bfhi(q.x) + bflo(q.y) + bfhi(q.y) + bflo(q.z) + bfhi(q.z) + bflo(q.w) + bfhi(q.w); }
            nl[(size_t)us * 64 + tid] = s; }
        __syncthreads();
    }
}

__device__ __forceinline__ void phase_ml_scan(Frame& F, const int skip = 0) {
    const int tid = F.tid;
    float* cT = (float*)(F.ws + WS_MCT); float* nl = (float*)(F.ws + WS_MN); float* sc = (float*)(F.ws + WS_MSC);
    for (int wi = F.blk; wi < 256; wi += F.G) {
        const int sq = wi >> 1, half = wi & 1; const bool don = (half == 0 && tid < 64);
        const size_t e0 = (size_t)half * 4096 + (size_t)tid * 8;
        f32x4 c0 = (f32x4){0.f, 0.f, 0.f, 0.f}, c1 = c0; float nn = 0.f, m = 0.f;
        size_t us = (size_t)sq * 18;
        f32x4 l0 = *(const f32x4*)(cT + us * 8192 + e0), l1 = *(const f32x4*)(cT + us * 8192 + e0 + 4);
        float ln = don ? nl[us * 64 + tid] : 0.f, tot = sc[us * 4], ml = sc[us * 4 + 1];
        for (int j = 0; j < 18; ++j, ++us) {
            const f32x4 a0 = l0, a1 = l1; const float an = ln, atot = tot, aml = ml;
            if (j + 1 < 18) { l0 = *(const f32x4*)(cT + (us + 1) * 8192 + e0); l1 = *(const f32x4*)(cT + (us + 1) * 8192 + e0 + 4); ln = don ? nl[(us + 1) * 64 + tid] : 0.f; tot = sc[(us + 1) * 4]; ml = sc[(us + 1) * 4 + 1]; }
            if (!skip) { *(f32x4*)(cT + us * 8192 + e0) = c0; *(f32x4*)(cT + us * 8192 + e0 + 4) = c1;
            if (don) nl[us * 64 + tid] = nn;
            if (half == 0 && tid == 0) sc[us * 4 + 2] = m; }
            const float mn = fmaxf(atot + m, aml), fa = __expf(atot + m - mn), fb = __expf(aml - mn);
            c0 = c0 * fa + a0 * fb; c1 = c1 * fa + a1 * fb; nn = nn * fa + an * fb; m = mn;
        }
    }
}

struct M3Regs { float gi, gf, n0v, m00, m01; v4u q[2], k[2], v[4]; };
__device__ __forceinline__ void m3_load(M3Regs& R, Frame& F, int u, int tid) {
    const bf16* kb = (const bf16*)(F.ws + WS_MK); const bf16* vb = (const bf16*)(F.ws + WS_MV); const bf16* qb = (const bf16*)(F.ws + WS_MQ);
    const float* gb = (const float*)(F.ws + WS_MG); const float* cT = (const float*)(F.ws + WS_MCT); const float* nl = (const float*)(F.ws + WS_MN); const float* sc = (const float*)(F.ws + WS_MSC);
    const int jo = u % 18, bh = u / 18, hd = bh & 7, b = bh >> 3;
    const int row0 = (jo < 2) ? b * CTX + 128 * jo : TC + b * SEQ + 128 * (jo - 2);
    const int jc1 = (jo < 2) ? 1 - jo : 19 - jo;
    const size_t us0 = (size_t)((b * 8 + hd) * 2 + 0) * 18 + jo, us1 = (size_t)((b * 8 + hd) * 2 + 1) * 18 + jc1;
    R.m00 = sc[us0 * 4 + 2]; R.m01 = sc[us1 * 4 + 2];
    R.gi = 0.f; R.gf = 0.f; R.n0v = 0.f;
    if (tid < 256) { const int dd = tid >> 7, sp = tid & 127; const int r = row0 + (dd ? 127 - sp : sp); R.gi = gb[(size_t)r * 32 + dd * 16 + hd]; R.gf = gb[(size_t)r * 32 + dd * 16 + 8 + hd]; }
    { const int i = tid & 127, c = tid >> 7; const int r = row0 + i;
#pragma unroll
      for (int h2 = 0; h2 < 2; ++h2) { R.q[h2] = *(const v4u*)(qb + (size_t)r * 512 + hd * 64 + 16 * c + 8 * h2); R.k[h2] = *(const v4u*)(kb + (size_t)r * 512 + hd * 64 + 16 * c + 8 * h2); } }
    { const int tp = tid & 63, c8 = tid >> 6;
#pragma unroll
      for (int tk = 0; tk < 2; ++tk)
#pragma unroll
          for (int h2 = 0; h2 < 2; ++h2) R.v[2 * tk + h2] = *(const v4u*)(vb + (size_t)(row0 + 2 * tp + tk) * 1024 + hd * 128 + 16 * c8 + 8 * h2); }
    if (tid < 128) R.n0v = nl[((tid >> 6) ? us1 : us0) * 64 + (tid & 63)];
}
__device__ __forceinline__ void phase_ml_out(Frame& F) {
    const int tid = F.tid, lane = F.lane, w = F.wave, tq = lane & 15, kg = lane >> 4;
    const bf16* ob = (const bf16*)(F.ws + WS_MO); bf16* zb = (bf16*)(F.ws + WS_Z);
    LAS bf16* QL = (LAS bf16*)(F.lds);
    LAS bf16* KL = (LAS bf16*)(F.lds + 18432);
    LAS bf16* SwL = (LAS bf16*)(F.lds + w * (16 * ML_TS * 2));
    LAS bf16* VT = (LAS bf16*)(F.lds + 36864);
    LAS bf16* C0T = (LAS bf16*)(F.lds + 36864 + 128 * ML_TS * 2);
    LAS float* GT = (LAS float*)(F.lds + 36864 + 128 * ML_TS * 2 + 2 * 144 * ML_DS * 2);
    static_assert(36864 + 128 * ML_TS * 2 + 2 * 144 * ML_DS * 2 + 2 * 3 * 128 * 4 <= RING_BYTES, "M3 LDS");
    for (int i = tid; i < 2 * 16 * ML_DS; i += NTHR) { const int dd = i / (16 * ML_DS), ii = i % (16 * ML_DS); C0T[dd * 144 * ML_DS + 128 * ML_DS + ii] = (bf16)0u; }
    constexpr int NU = NB * 8 * 18;
    M3Regs R;
    if (F.blk < NU) m3_load(R, F, F.blk, tid);
    __syncthreads();
    for (int u = F.blk; u < NU; u += F.G) {
        const int jo = u % 18, bh = u / 18, hd = bh & 7, b = bh >> 3;
        const int row0 = (jo < 2) ? b * CTX + 128 * jo : TC + b * SEQ + 128 * (jo - 2);
        const float m00 = R.m00, m01 = R.m01;
        if (tid < 256) { const int dd = tid >> 7, sp = tid & 127; GT[dd * 384 + sp] = R.gi; GT[dd * 384 + 256 + sp] = log_sigmoidf_(R.gf); }
        { const int i = tid & 127, c = tid >> 7;
#pragma unroll
          for (int h2 = 0; h2 < 2; ++h2) { *(LAS v4u*)(QL + i * ML_DS + 16 * c + 8 * h2) = R.q[h2]; *(LAS v4u*)(KL + i * ML_DS + 16 * c + 8 * h2) = R.k[h2]; } }
        { const int tp = tid & 63, c8 = tid >> 6;
#pragma unroll
          for (int h2 = 0; h2 < 2; ++h2) { const v4u a = R.v[h2], bq = R.v[2 + h2]; const unsigned av[4] = {a.x, a.y, a.z, a.w}, bv[4] = {bq.x, bq.y, bq.z, bq.w};
#pragma unroll
              for (int jj = 0; jj < 8; ++jj) { const unsigned lo = (jj & 1) ? (av[jj >> 1] >> 16) : (av[jj >> 1] & 0xffffu), hi = (jj & 1) ? (bv[jj >> 1] & 0xffff0000u) : (bv[jj >> 1] << 16);
                  *(LAS unsigned*)(VT + (16 * c8 + 8 * h2 + jj) * ML_TS + 2 * tp) = lo | hi; } } }
        { const float* cT = (const float*)(F.ws + WS_MCT); const int jc1 = (jo < 2) ? 1 - jo : 19 - jo;
          const size_t us0 = (size_t)((b * 8 + hd) * 2 + 0) * 18 + jo, us1 = (size_t)((b * 8 + hd) * 2 + 1) * 18 + jc1;
#pragma unroll
          for (int dd = 0; dd < 2; ++dd) { const size_t us = dd ? us1 : us0; const int jv = tid >> 2, dq = (tid & 3) * 16; const float* src = cT + us * 8192 + jv * 64 + dq;
#pragma unroll
              for (int h2 = 0; h2 < 2; ++h2) { const f32x4 a = *(const f32x4*)(src + 8 * h2), bq = *(const f32x4*)(src + 8 * h2 + 4);
                  v4u o; o.x = pk2(a.x, a.y); o.y = pk2(a.z, a.w); o.z = pk2(bq.x, bq.y); o.w = pk2(bq.z, bq.w);
                  *(LAS v4u*)(C0T + dd * 144 * ML_DS + jv * ML_DS + dq + 8 * h2) = o; } } }
        if (tid < 128) C0T[(tid >> 6) * 144 * ML_DS + 128 * ML_DS + (tid & 63)] = (bf16)f2bf(R.n0v);
        __syncthreads();
        if (u + F.G < NU) m3_load(R, F, u + F.G, tid);
        if (w < 2) {
            LAS float* gS = GT + w * 384; LAS float* mmS = gS + 128; LAS float* cumS = gS + 256; const float m0 = w ? m01 : m00;
            scan128<false>(cumS, lane);
            const float g0 = gS[2 * lane] - cumS[2 * lane], g1 = gS[2 * lane + 1] - cumS[2 * lane + 1];
            gS[2 * lane] = g0; gS[2 * lane + 1] = g1; mmS[2 * lane] = g0; mmS[2 * lane + 1] = g1;
            scan128<true>(mmS, lane);
            mmS[2 * lane] = fmaxf(mmS[2 * lane], m0); mmS[2 * lane + 1] = fmaxf(mmS[2 * lane + 1], m0);
        }
        __syncthreads();
        bf16x8 qf[2];
#pragma unroll
        for (int ks = 0; ks < 2; ++ks) qf[ks] = *(const LAS bf16x8*)(QL + (16 * w + tq) * ML_DS + 32 * ks + 8 * kg);
        float mm0r[4], mm1r[4], ai0[4], ai1[4], lb0[4], lb1[4];
#pragma unroll
        for (int r = 0; r < 4; ++r) { const int t0 = 16 * w + 4 * kg + r, t1 = 127 - t0;
            mm0r[r] = GT[128 + t0]; ai0[r] = __expf(m00 - mm0r[r]); lb0[r] = __expf(-GT[256 + t0] - mm0r[r]);
            mm1r[r] = GT[384 + 128 + t1]; ai1[r] = __expf(m01 - mm1r[r]); lb1[r] = __expf(-GT[384 + 256 + t1] - mm1r[r]); }
        f32x4 sraw[8]; float rs0[4] = {0.f, 0.f, 0.f, 0.f}, rs1[4] = {0.f, 0.f, 0.f, 0.f};
#pragma unroll
        for (int ct = 0; ct < 8; ++ct) {
            f32x4 a = (f32x4){0.f, 0.f, 0.f, 0.f};
#pragma unroll
            for (int ks = 0; ks < 2; ++ks) a = __builtin_amdgcn_mfma_f32_16x16x32_bf16(qf[ks], *(const LAS bf16x8*)(KL + (16 * ct + tq) * ML_DS + 32 * ks + 8 * kg), a, 0, 0, 0);
            sraw[ct] = a;
            const int o = 16 * ct + tq; const float g0o = GT[o], g1o = GT[384 + 127 - o];
#pragma unroll
            for (int r = 0; r < 4; ++r) { const int t0 = 16 * w + 4 * kg + r;
                rs0[r] += (o <= t0) ? a[r] * __expf(g0o - mm0r[r]) : 0.f; rs1[r] += (o >= t0) ? a[r] * __expf(g1o - mm1r[r]) : 0.f; }
        }
        f32x4 acc[8]; float sc0[4], sc1[4];
        {
            f32x4 q0 = (f32x4){0.f, 0.f, 0.f, 0.f}, q1 = q0;
#pragma unroll
            for (int ks = 0; ks < 2; ++ks) { q0 = __builtin_amdgcn_mfma_f32_16x16x32_bf16(qf[ks], *(const LAS bf16x8*)(C0T + (128 + tq) * ML_DS + 32 * ks + 8 * kg), q0, 0, 0, 0);
                                             q1 = __builtin_amdgcn_mfma_f32_16x16x32_bf16(qf[ks], *(const LAS bf16x8*)(C0T + 144 * ML_DS + (128 + tq) * ML_DS + 32 * ks + 8 * kg), q1, 0, 0, 0); }
#pragma unroll
            for (int r = 0; r < 4; ++r) {
                const float qn0 = red16_sum(q0[r]), qn1 = red16_sum(q1[r]);
                const float den0 = ai0[r] * qn0 + red16_sum(rs0[r]), den1 = ai1[r] * qn1 + red16_sum(rs1[r]);
                const float inv0 = __builtin_amdgcn_rcpf(fmaxf(fabsf(den0), lb0[r])), inv1 = __builtin_amdgcn_rcpf(fmaxf(fabsf(den1), lb1[r]));
                rs0[r] = inv0; rs1[r] = inv1; sc0[r] = ai0[r] * inv0; sc1[r] = ai1[r] * inv1; }
        }
#pragma unroll
        for (int ct = 0; ct < 8; ++ct) {
            f32x4 a0 = (f32x4){0.f, 0.f, 0.f, 0.f}, a1 = a0;
#pragma unroll
            for (int ks = 0; ks < 2; ++ks) { a0 = __builtin_amdgcn_mfma_f32_16x16x32_bf16(qf[ks], *(const LAS bf16x8*)(C0T + (16 * ct + tq) * ML_DS + 32 * ks + 8 * kg), a0, 0, 0, 0);
                                             a1 = __builtin_amdgcn_mfma_f32_16x16x32_bf16(qf[ks], *(const LAS bf16x8*)(C0T + 144 * ML_DS + (16 * ct + tq) * ML_DS + 32 * ks + 8 * kg), a1, 0, 0, 0); }
#pragma unroll
            for (int r = 0; r < 4; ++r) acc[ct][r] = a0[r] * sc0[r] + a1[r] * sc1[r];
        }
        __syncthreads();
#pragma unroll
        for (int ct = 0; ct < 8; ++ct) { const int o = 16 * ct + tq; const float g0o = GT[o], g1o = GT[384 + 127 - o];
#pragma unroll
            for (int r = 0; r < 4; ++r) { const int t0 = 16 * w + 4 * kg + r;
                const float x0 = (o <= t0) ? __expf(g0o - mm0r[r]) * rs0[r] : 0.f, x1 = (o >= t0) ? __expf(g1o - mm1r[r]) * rs1[r] : 0.f;
                SwL[(4 * kg + r) * ML_TS + 16 * ct + tq] = (bf16)f2bf(sraw[ct][r] * (x0 + x1)); } }
#pragma unroll
        for (int ks = 0; ks < 4; ++ks) {
            const bf16x8 af = *(const LAS bf16x8*)(SwL + tq * ML_TS + 32 * ks + 8 * kg);
#pragma unroll
            for (int ct = 0; ct < 8; ++ct) acc[ct] = __builtin_amdgcn_mfma_f32_16x16x32_bf16(af, *(const LAS bf16x8*)(VT + (16 * ct + tq) * ML_TS + 32 * ks + 8 * kg), acc[ct], 0, 0, 0);
        }
        float ss[4] = {0.f, 0.f, 0.f, 0.f};
#pragma unroll
        for (int ct = 0; ct < 8; ++ct) { ss[0] += acc[ct].x * acc[ct].x; ss[1] += acc[ct].y * acc[ct].y; ss[2] += acc[ct].z * acc[ct].z; ss[3] += acc[ct].w * acc[ct].w; }
#pragma unroll
        for (int r = 0; r < 4; ++r) ss[r] = rsqrtf(red16_sum(ss[r]) * (1.f / 128.f) + EPS);
#pragma unroll
        for (int ct = 0; ct < 8; ++ct) { const float gn = F.in[IN_MLNG][hd * 128 + 16 * ct + tq];
#pragma unroll
            for (int r = 0; r < 4; ++r) SwL[(4 * kg + r) * ML_TS + 16 * ct + tq] = (bf16)f2bf(acc[ct][r] * ss[r] * gn); }
#pragma unroll
        for (int i = 0; i < 4; ++i) { const int rr = 4 * i + kg, ch = tq;
            const v4u hv = *(const LAS v4u*)(SwL + rr * ML_TS + 8 * ch);
            const size_t idx = (size_t)(row0 + 16 * w + rr) * D + hd * 128 + 8 * ch;
            const v4u ov = *(const v4u*)(ob + idx);
            v4u zo; zo.x = pk2(bflo(hv.x) * sigmoidf_(bflo(ov.x)), bfhi(hv.x) * sigmoidf_(bfhi(ov.x))); zo.y = pk2(bflo(hv.y) * sigmoidf_(bflo(ov.y)), bfhi(hv.y) * sigmoidf_(bfhi(ov.y)));
            zo.z = pk2(bflo(hv.z) * sigmoidf_(bflo(ov.z)), bfhi(hv.z) * sigmoidf_(bfhi(ov.z))); zo.w = pk2(bflo(hv.w) * sigmoidf_(bflo(ov.w)), bfhi(hv.w) * sigmoidf_(bfhi(ov.w)));
            *(v4u*)(zb + idx) = zo; }
        __syncthreads();
    }
}

#ifndef USE_NAIVE_ATTN
#define USE_NAIVE_ATTN 0
#endif
#ifndef USE_NAIVE_S5
#define USE_NAIVE_S5 0
#endif
#ifndef USE_NAIVE_MLSTM
#define USE_NAIVE_MLSTM 0
#endif
#ifndef MK_MODE
#define MK_MODE 0
#endif
struct Args { const float* in[N_INPUTS]; float* out; unsigned char* ws; int ph_lo, ph_hi; };
enum { CBASE = __COUNTER__ + 1 };
#ifndef S5VAR
#define S5VAR 0
#endif
#ifndef DUP_A
#define DUP_A -1
#endif
#ifndef DUP_B
#define DUP_B -1
#endif
#define PHASE_IDS() { int t_ = threadIdx.x; asm volatile("" : "+v"(t_)); F.tid = t_; F.lane = t_ & 63; F.wave = __builtin_amdgcn_readfirstlane(t_ >> 6); }
#define PHASE(...) { constexpr int k_ = __COUNTER__ - CBASE; if (lo <= k_ && k_ < hi) { PHASE_IDS() { constexpr int rep_ = 0; (void)rep_; __VA_ARGS__ } \
    if constexpr (k_ == DUP_A || k_ == DUP_B) { xcd_barrier(bar); { constexpr int rep_ = 1; (void)rep_; __VA_ARGS__ } } \
    if (k_ + 1 < hi) xcd_barrier(bar); } }

__global__ void __launch_bounds__(NTHR, 2) fwd_kernel(Args args) {
    extern __shared__ __attribute__((aligned(16))) unsigned char lds[];
    Frame F;
    F.lds = (LAS unsigned char*)lds;
    F.MISC = (volatile LAS unsigned*)(F.lds + MISC_OFF);
    F.tid = threadIdx.x; F.lane = F.tid & 63; F.wave = __builtin_amdgcn_readfirstlane(F.tid >> 6);
    F.G = gridDim.x; F.blk = blockIdx.x;
    F.ws = args.ws; F.out = args.out; F.ctl = (unsigned*)(args.ws + WS_CTL);
#pragma unroll
    for (int i = 0; i < N_INPUTS; ++i) F.in[i] = args.in[i];
    for (int u = F.tid; u < (LDS_BYTES - LDSCTL_OFF) / 4; u += NTHR) ((LAS unsigned*)(F.lds + LDSCTL_OFF))[u] = 0u;
    __syncthreads();
    const int lo = args.ph_lo, hi = args.ph_hi;
    XcdBarrier bar; bar.bar = F.ctl + CW_BAR; bar.x = 0; bar.st = nullptr;
    if (hi - lo > 1) bar = xcd_barrier_post(F.ctl + CW_BAR, F.MISC + 8);

    unsigned char* ws = F.ws;
    float* xres = (float*)(ws + WS_XRES); const float* mod = (const float*)(ws + WS_MOD);
    bf16* hb = (bf16*)(ws + WS_H); bf16* zb = (bf16*)(ws + WS_Z);
    const LAS int* etab = (const LAS int*)(F.lds + ETAB_OFF);

#define MOE_PHASES(L) \
    PHASE(phase_n2<L>(F, rep_);) \
    PHASE(phase_sc<L>(F);) \
    PHASE({ load_etab(F); pg8::Gemm g{(const bf16*)(ws + WS_HS), (const bf16*)(ws + WS_WG1) + (size_t)(L) * NEXP * 1024 * 1024, SLOTS, NEXP * 1024, 1024}; \
               MoeSched S{etab, F.G, F.blk, 4}; EpiG1 E{(bf16*)(ws + WS_HID)}; run_gemm(F, g, S, E); }) \
    PHASE({ load_etab(F); pg8::Gemm g{(const bf16*)(ws + WS_HID), (const bf16*)(ws + WS_WG2) + (size_t)(L) * NEXP * 1024 * 512, SLOTS, NEXP * 1024, 512}; \
               MoeSched S{etab, F.G, F.blk, 4}; EpiG2 E{(bf16*)(ws + WS_Y2), (const float*)(ws + WS_SLOTW)}; run_gemm(F, g, S, E); })

    PHASE(phase_prologue(F);)
    PHASE(phase_a1<0>(F, rep_);)
#if USE_NAIVE_S5
    PHASE(phase_s5_naive<0, true>(F);)
    PHASE(phase_s5_combine<0, true>(F);)
#else
    PHASE(phase_s5_fast<0, true>(F);)
#endif
    PHASE({ pg8::Gemm g{zb, (const bf16*)(ws + WS_WGLU), T, 2048, 1024}; DenseSched S; S.init(T, 2048, F.G, F.blk, 0);
               EpiGlu E{xres, mod + 0 * 9 * 6144 + 2048, F.in[IN_S5BGLU], rep_}; run_gemm(F, g, S, E); })
    MOE_PHASES(0)
    PHASE(phase_a1<1>(F, rep_);)
    PHASE({ pg8::Gemm g{hb, (const bf16*)(ws + WS_WKVQ), T, 1536, 1024}; DenseSched S; S.init(T, 1536, F.G, F.blk, 0);
               EpiKvq E{(bf16*)(ws + WS_QB), (bf16*)(ws + WS_KB), (bf16*)(ws + WS_VB), F.in[IN_AQG], F.in[IN_AKG], (const float*)(ws + WS_ROPE)}; run_gemm(F, g, S, E); })
#if USE_NAIVE_ATTN
    PHASE(phase_attn_naive<true>(F);)
#else
    PHASE(phase_attn_fast<true>(F, (char*)lds);)
#endif
    PHASE({ pg8::Gemm g{zb, (const bf16*)(ws + WS_WO), T, 1024, 1024}; DenseSched S; S.init(T, 1024, F.G, F.blk, 0);
               EpiRes E{xres, mod + 1 * 9 * 6144 + 2048, rep_}; run_gemm(F, g, S, E); })
    MOE_PHASES(1)
    PHASE(phase_a1<2>(F, rep_);)
    PHASE({ pg8::Gemm g{hb, (const bf16*)(ws + WS_WIN), T, ML_NIN, 1024}; DenseSched S; S.init(T, ML_NIN, F.G, F.blk, 0);
               EpiMlIn E{(bf16*)(ws + WS_MK), (bf16*)(ws + WS_MV), (bf16*)(ws + WS_MQ), (bf16*)(ws + WS_MO), (float*)(ws + WS_MG), F.in[IN_MLBG]}; run_gemm(F, g, S, E); })
#if USE_NAIVE_MLSTM
    PHASE(phase_mlstm_naive<true>(F);)
    PHASE(phase_mlstm_combine<true>(F);)
#else
    PHASE(phase_ml_states(F);)
    PHASE(phase_ml_scan(F, rep_);)
    PHASE(phase_ml_out(F);)
#endif
    PHASE({ pg8::Gemm g{zb, (const bf16*)(ws + WS_WOUT), T, 1024, 1024}; DenseSched S; S.init(T, 1024, F.G, F.blk, 0);
               EpiRes E{xres, mod + 2 * 9 * 6144 + 2048, rep_}; run_gemm(F, g, S, E); })
    MOE_PHASES(2)
    PHASE(phase_a1<3>(F, rep_);)
#if USE_NAIVE_S5
    PHASE(phase_s5_naive<1, false>(F);)
    PHASE(phase_s5_combine<1, false>(F);)
#else
    PHASE(phase_s5_fast<1, false>(F);)
#endif
    PHASE({ pg8::Gemm g{zb, (const bf16*)(ws + WS_WGLU) + (size_t)2048 * 1024, T, 2048, 1024}; DenseSched S; S.init(TL, 2048, F.G, F.blk, TC / 256);
               EpiGlu E{xres, mod + 3 * 9 * 6144 + 2048, F.in[IN_S5BGLU] + 2048, rep_}; run_gemm(F, g, S, E); })
    MOE_PHASES(3)
    PHASE(phase_fin(F);)
}
constexpr int NPH = __COUNTER__ - CBASE;

extern "C" void kernel_launch(void* const* d_in, const int* in_sizes, int n_in, void* d_out, int out_size, void* d_ws, size_t ws_size, hipStream_t stream) {
    static int grid = 0;
    if (grid == 0) {
        if (n_in != N_INPUTS || out_size != TL * D || ws_size < WS_END) { fprintf(stderr, "kernel_launch: unexpected problem: n_in %d out %d ws %zu (need %zu)\n", n_in, out_size, ws_size, (size_t)WS_END); grid = -1; return; }
        int dev = 0, cus = 0, per_cu = 0;
        if (hipGetDevice(&dev) != hipSuccess || hipDeviceGetAttribute(&cus, hipDeviceAttributeMultiprocessorCount, dev) != hipSuccess) { grid = -1; return; }
        if (hipFuncSetAttribute((const void*)fwd_kernel, hipFuncAttributeMaxDynamicSharedMemorySize, LDS_BYTES) != hipSuccess) { fprintf(stderr, "kernel_launch: hipFuncSetAttribute failed\n"); grid = -1; return; }
        if (hipOccupancyMaxActiveBlocksPerMultiprocessor(&per_cu, (const void*)fwd_kernel, NTHR, LDS_BYTES) != hipSuccess || per_cu < 1) fprintf(stderr, "kernel_launch: occupancy query reports %d\n", per_cu);
        (void)hipGetLastError();
        grid = cus;
        if (grid > 256) grid = 256;
    }
    if (grid < 0) return;
    if (hipMemsetAsync((char*)d_ws + WS_CTL, 0, CTL_ZERO_BYTES, stream) != hipSuccess) return;
    Args a{};
    for (int i = 0; i < N_INPUTS; ++i) a.in[i] = (const float*)d_in[i];
    a.out = (float*)d_out; a.ws = (unsigned char*)d_ws;
#if MK_MODE == 0
    a.ph_lo = 0; a.ph_hi = NPH;
    hipLaunchKernelGGL(fwd_kernel, dim3(grid), dim3(NTHR), LDS_BYTES, stream, a);
#else
    for (int p = 0; p < NPH; ++p) { a.ph_lo = p; a.ph_hi = p + 1; hipLaunchKernelGGL(fwd_kernel, dim3(grid), dim3(NTHR), LDS_BYTES, stream, a); }
#endif
}
```

```cpp
#include <hip/hip_runtime.h>
#include <cstdio>
#include <cstdint>

#define GAS __attribute__((address_space(1)))
#define LAS __attribute__((address_space(3)))
typedef unsigned short bf16;
typedef unsigned v4u __attribute__((ext_vector_type(4)));
typedef unsigned v2u __attribute__((ext_vector_type(2)));
typedef float f32x4 __attribute__((ext_vector_type(4)));
typedef float f32x2 __attribute__((ext_vector_type(2)));
typedef short bf16x8 __attribute__((ext_vector_type(8)));

constexpr int D = 1024, NB = 8, SEQ = 2048, CTX = 256, DEPTH = 4;
constexpr int TC = NB * CTX;
constexpr int TL = NB * SEQ;
constexpr int T = TC + TL;
constexpr int KVLEN = SEQ + CTX;
constexpr int NEXP = 16, DFF = 512;
constexpr int SLOTS = 40960;
constexpr int ML_NIN = 3328;
constexpr float EPS = 1e-6f;
constexpr int NWAVES = 8, NTHR = 512;
constexpr float ATT_C2 = 0.125f * 1.4426950408889634f;

constexpr size_t MiB = 1u << 20;
constexpr size_t WS_CTL = 0, CTL_ZERO_BYTES = 1 * MiB;
constexpr size_t WS_MOD = 1 * MiB;
constexpr size_t WS_ROPE = 2 * MiB;
constexpr size_t WS_TOKE = 2 * MiB + 65536;
constexpr size_t WS_TOKR = WS_TOKE + 163840;
constexpr size_t WS_TOKW = WS_TOKR + 163840;
constexpr size_t WS_TOKS = WS_TOKW + 163840;
constexpr size_t WS_BCNT = WS_TOKS + 163840;
constexpr size_t WS_ETAB = WS_BCNT + 16384;
constexpr size_t WS_SLOTW = WS_ETAB + 4096;
static_assert(WS_SLOTW + SLOTS * 4 <= 4 * MiB, "small tables");
constexpr size_t WS_WGLU = 4 * MiB;
constexpr size_t WS_WKVQ = WS_WGLU + 8 * MiB;
constexpr size_t WS_WO = WS_WKVQ + 3 * MiB;
constexpr size_t WS_WIN = WS_WO + 2 * MiB;
constexpr size_t WS_WOUT = WS_WIN + 7 * MiB;
constexpr size_t WS_WG1 = WS_WOUT + 2 * MiB;
constexpr size_t WS_WG2 = WS_WG1 + 128 * MiB;
constexpr size_t WS_XRES = WS_WG2 + 64 * MiB;
constexpr size_t WS_H = WS_XRES + 72 * MiB;
constexpr size_t WS_Z = WS_H + 36 * MiB;
constexpr size_t WS_MIX = WS_Z + 36 * MiB;
constexpr size_t WS_HS = WS_MIX;
constexpr size_t WS_HID = WS_HS + 80 * MiB;
constexpr size_t WS_Y2 = WS_HID + 40 * MiB;
constexpr size_t WS_END = WS_Y2 + 80 * MiB;
constexpr size_t WS_YSUM = WS_MIX;
constexpr size_t WS_QB = WS_MIX;
constexpr size_t WS_KB = WS_QB + 36 * MiB;
constexpr size_t WS_VB = WS_KB + 9 * MiB;
constexpr size_t WS_MK = WS_MIX;
constexpr size_t WS_MV = WS_MK + 18 * MiB;
constexpr size_t WS_MQ = WS_MV + 36 * MiB;
constexpr size_t WS_MO = WS_MQ + 18 * MiB;
constexpr size_t WS_MG = WS_MO + 36 * MiB;
constexpr size_t WS_MHS = WS_MG + 3 * MiB;
static_assert(WS_MHS + 72 * MiB <= WS_END, "mLSTM view fits");
static_assert(WS_END <= 600 * MiB, "workspace budget");

constexpr int CW_BAR = 4096;

constexpr int RING_OFF = 0, RING_BYTES = 131072;
constexpr int LDSCTL_OFF = RING_BYTES, MISC_OFF = LDSCTL_OFF + 320;
constexpr int ETAB_OFF = MISC_OFF + 128;
constexpr int SCT_OFF = ETAB_OFF + 128;
constexpr int LDS_BYTES = 147456;
static_assert(SCT_OFF + 256 <= LDS_BYTES, "LDS map");

#define LDS_WAIT() asm volatile("s_waitcnt lgkmcnt(0)" ::: "memory")
#define VM_WAIT() asm volatile("s_waitcnt vmcnt(0)" ::: "memory")
__device__ __forceinline__ unsigned f2bf(float f) { unsigned u = __builtin_bit_cast(unsigned, f); return (u + 0x7fffu + ((u >> 16) & 1u)) >> 16; }
typedef float f32x2_cv __attribute__((ext_vector_type(2))); typedef __bf16 bf16x2_cv __attribute__((ext_vector_type(2)));
__device__ __forceinline__ unsigned pk2(float lo, float hi) { f32x2_cv v = {lo, hi}; bf16x2_cv b = __builtin_convertvector(v, bf16x2_cv); return __builtin_bit_cast(unsigned, b); }
__device__ __forceinline__ float bf2f(unsigned h) { return __builtin_bit_cast(float, h << 16); }
__device__ __forceinline__ float bflo(unsigned w) { return __builtin_bit_cast(float, w << 16); }
__device__ __forceinline__ float bfhi(unsigned w) { return __builtin_bit_cast(float, w & 0xffff0000u); }
template <int CTRL, int RMASK = 0xF>
__device__ __forceinline__ float dpp_f(float oldv, float v) { return __builtin_bit_cast(float, __builtin_amdgcn_update_dpp(__builtin_bit_cast(int, oldv), __builtin_bit_cast(int, v), CTRL, RMASK, 0xF, false)); }
#ifndef USE_SHFL_XOR
#define USE_SHFL_XOR 0
#endif
#ifndef USE_SHFL_PARTIAL
#define USE_SHFL_PARTIAL 0
#endif
__device__ __forceinline__ float red16_sum(float v) {
#if USE_SHFL_PARTIAL
    for (int o = 1; o < 16; o <<= 1) v += __shfl_xor(v, o);
    return v;
#endif
    v += dpp_f<0xB1>(0.f, v); v += dpp_f<0x4E>(0.f, v); v += dpp_f<0x141>(0.f, v); v += dpp_f<0x140>(0.f, v); return v; }
__device__ __forceinline__ float red16_max(float v) {
    v = fmaxf(v, dpp_f<0xB1>(v, v)); v = fmaxf(v, dpp_f<0x4E>(v, v)); v = fmaxf(v, dpp_f<0x141>(v, v)); v = fmaxf(v, dpp_f<0x140>(v, v)); return v; }
#ifndef USE_SHFL_REDUCE
#define USE_SHFL_REDUCE 0
#endif
__device__ __forceinline__ float wave_sum(float v) {
#if USE_SHFL_REDUCE
    for (int o = 1; o < 64; o <<= 1) v += __shfl_xor(v, o);
    return v;
#endif
    v = red16_sum(v); v += dpp_f<0x142, 0xA>(0.f, v); v += dpp_f<0x143, 0xC>(0.f, v);
    return __builtin_bit_cast(float, __builtin_amdgcn_readlane(__builtin_bit_cast(int, v), 63)); }
__device__ __forceinline__ float wave_max(float v) {
    v = red16_max(v); v = fmaxf(v, dpp_f<0x142, 0xA>(v, v)); v = fmaxf(v, dpp_f<0x143, 0xC>(v, v));
    return __builtin_bit_cast(float, __builtin_amdgcn_readlane(__builtin_bit_cast(int, v), 63)); }
__device__ __forceinline__ float xor16_sum(float v) { return v + __shfl_xor(v, 16); }
__device__ __forceinline__ float xor32_sum(float v) { return v + __shfl_xor(v, 32); }
__device__ __forceinline__ float sigmoidf_(float x) { return __builtin_amdgcn_rcpf(1.f + __expf(-x)); }
__device__ __forceinline__ float siluf_(float x) { return x * __builtin_amdgcn_rcpf(1.f + __expf(-x)); }
__device__ __forceinline__ float gelu_tanh(float x) {
    const float p = __builtin_fmaf(x * x, 0.044715f, 1.0f);
    const float e = __builtin_amdgcn_exp2f((x * -2.302208198f) * p);
    return x * __builtin_amdgcn_rcpf(1.0f + e);
}
__device__ __forceinline__ float log_sigmoidf_(float x) { return fminf(x, 0.f) - __logf(1.f + __expf(-fabsf(x))); }
__device__ __forceinline__ void sincos_d(double a, double& s, double& c) {
    const double k = __builtin_rint(a * 0.63661977236758134308);
    double r = __builtin_fma(-k, 1.57079632679489655800e+00, a);
    r = __builtin_fma(-k, 6.12323399573676603587e-17, r);
    const double r2 = r * r;
    double sp = -1.0 / 1307674368000.0;
    sp = sp * r2 + 1.0 / 6227020800.0; sp = sp * r2 - 1.0 / 39916800.0; sp = sp * r2 + 1.0 / 362880.0; sp = sp * r2 - 1.0 / 5040.0; sp = sp * r2 + 1.0 / 120.0; sp = sp * r2 - 1.0 / 6.0;
    const double sr = r + r * r2 * sp;
    double cp = 1.0 / 20922789888000.0;
    cp = cp * r2 - 1.0 / 87178291200.0; cp = cp * r2 + 1.0 / 479001600.0; cp = cp * r2 - 1.0 / 3628800.0; cp = cp * r2 + 1.0 / 40320.0; cp = cp * r2 - 1.0 / 720.0; cp = cp * r2 + 1.0 / 24.0; cp = cp * r2 - 0.5;
    const double cr = 1.0 + r2 * cp;
    const int q = ((int)k) & 3;
    s = (q == 0) ? sr : (q == 1) ? cr : (q == 2) ? -sr : -cr;
    c = (q == 0) ? cr : (q == 1) ? -sr : (q == 2) ? -cr : sr;
}
__device__ __forceinline__ int mrow_of(int r) { return r < TC ? 8 : ((r - TC) >> 11); }
namespace pg8 {
#define PG8_LAS __attribute__((address_space(3)))
typedef unsigned short bf16_t;
typedef short bf16x8 __attribute__((ext_vector_type(8)));
typedef float f32x4 __attribute__((ext_vector_type(4)));
typedef unsigned u32x4 __attribute__((ext_vector_type(4)));
constexpr int BM = 256, BK = 64, HALF = 128, HTB = HALF * BK * 2  , STAGE_BYTES = 8 * HTB, NXCD = 8, WGM = 8;

__host__ __device__ __forceinline__ int lds_byte(int r, int c) { const int st = (r >> 4) * 2 + (c >> 5), rr = r & 15, cc = c & 31, ob = rr * 64 + cc * 2; return st * 1024 + (ob ^ (((ob >> 9) & 1) << 5)); }
__host__ __device__ __forceinline__ void stage_rc(int b, int& R, int& C) { const int st = b / 1024, sb = b % 1024, swz = sb ^ (((sb >> 9) & 1) << 5); R = (st >> 1) * 16 + swz / 64; C = (st & 1) * 32 + (swz % 64) / 2; }
__host__ __device__ __forceinline__ int perm32(int rho) { const int n = rho >> 4, i = rho & 15; return 8 * (i >> 2) + 4 * n + (i & 3); }

struct Unit { int pm, pn; };
struct Gemm { const bf16_t* A; const bf16_t* Bt; int M, N, K; };

struct StaticOrder {
    int nM, nN, nwg, G, c;
    __host__ __device__ void init(int M, int N, int G_, int c_) { nM = M / BM; nN = N / BM; nwg = nM * nN; G = G_; c = c_; }
    __host__ __device__ bool next(int i, Unit& u) const {
        const long L = (long)i * G + c; if (L >= nwg) return false;
        int wgid = (int)L; { const int q = nwg / NXCD, r = nwg % NXCD, xcd = wgid % NXCD, off = wgid / NXCD; wgid = (xcd < r ? xcd * (q + 1) : r * (q + 1) + (xcd - r) * q) + off; }
        const int nig = WGM * nN, gid = wgid / nig, fm = gid * WGM, gsz = (nM - fm) < WGM ? (nM - fm) : WGM;
        u.pm = fm + ((wgid % nig) % gsz); u.pn = (wgid % nig) / gsz; return true;
    }
    __device__ __forceinline__ void a_ready(const Unit&) const {}
    __device__ __forceinline__ void done(const Unit&) const {}
};


template <class Epi, class Sched, bool ALIGN_EPI = false, bool SP2 = false>
__device__ __forceinline__ void gemm_phase(PG8_LAS unsigned char* lds, const Gemm g, const Sched& S, const Epi& E) {
    const int tid = threadIdx.x, wid = __builtin_amdgcn_readfirstlane(tid >> 6), lane = tid & 63, wr = wid >> 2, wc = wid & 3, fr = lane & 15, fq = lane >> 4;
    const int K = g.K, nt = K / BK;
    unsigned voffA[2], voffB[2];
#pragma unroll
    for (int i = 0; i < 2; ++i) { int R, C; stage_rc(tid * 16 + i * 8192, R, C); const int Rb = Epi::PERM ? ((R & ~31) + perm32(R & 31)) : R;
        voffA[i] = (unsigned)(R * K + C) * 2u; voffB[i] = (unsigned)(Rb * K + C) * 2u; }
    const size_t kstep = (size_t)(BK * 2);
    const size_t hstep = (size_t)HALF * K * 2;
    const size_t tstep = 2 * hstep;
    const unsigned ldsw = (unsigned)wid * 1024u;
    const int aoff = lds_byte(wr * 64 + fr, fq * 8), boff = lds_byte(wc * 32 + fr, fq * 8);
#define PG8_SA(b, h) (((b) * 2 + (h)) * HTB)
#define PG8_SB(b, h) ((4 + (b) * 2 + (h)) * HTB)
#define PG8_STAGE(bufoff, gbase, voff) do { _Pragma("unroll") for (int _i = 0; _i < 2; ++_i) \
        __builtin_amdgcn_global_load_lds((const unsigned*)((const char*)(gbase) + (voff)[_i]), (PG8_LAS unsigned*)(lds + (bufoff) + ldsw + _i * 8192), 16, 0, 0); } while (0)
#define PG8_LDA(dst, b, h) do { _Pragma("unroll") for (int m = 0; m < 4; ++m) _Pragma("unroll") for (int k = 0; k < 2; ++k) dst[m][k] = *(const PG8_LAS bf16x8*)(lds + PG8_SA(b, h) + aoff + m * 2048 + k * 1024); } while (0)
#define PG8_LDB(dst, b, h) do { _Pragma("unroll") for (int n = 0; n < 2; ++n) _Pragma("unroll") for (int k = 0; k < 2; ++k) dst[n][k] = *(const PG8_LAS bf16x8*)(lds + PG8_SB(b, h) + boff + n * 2048 + k * 1024); } while (0)
#define PG8_MMA(ai, bj, At, Bt) do { __builtin_amdgcn_s_setprio(1); _Pragma("unroll") for (int m = 0; m < 4; ++m) _Pragma("unroll") for (int n = 0; n < 2; ++n) _Pragma("unroll") for (int k = 0; k < 2; ++k) \
        acc[ai][bj][m][n] = __builtin_amdgcn_mfma_f32_16x16x32_bf16(Bt[n][k], At[m][k], acc[ai][bj][m][n], 0, 0, 0); __builtin_amdgcn_s_setprio(0); } while (0)
#define PG8_WAIT_V(n) asm volatile("s_waitcnt vmcnt(" #n ")" ::: "memory")
#define PG8_WAIT_L(n) asm volatile("s_waitcnt lgkmcnt(" #n ")" ::: "memory")
#define PG8_BAR __builtin_amdgcn_s_barrier()
#define PG8_SCHED __builtin_amdgcn_sched_barrier(0)
    Unit cur, nxt; int ui = 0;
    if (!S.next(0, cur)) return;
    f32x4 acc[2][2][4][2];
#pragma unroll
    for (int a = 0; a < 2; ++a)
#pragma unroll
        for (int b = 0; b < 2; ++b)
#pragma unroll
            for (int m = 0; m < 4; ++m)
#pragma unroll
                for (int n = 0; n < 2; ++n) acc[a][b][m][n] = (f32x4){0.f, 0.f, 0.f, 0.f};
    bf16x8 At[4][2], B0[2][2], B1[2][2];
    const char* cA = (const char*)g.A + (size_t)cur.pm * tstep; const char* cB = (const char*)g.Bt + (size_t)cur.pn * tstep;
    S.a_ready(cur);
    if constexpr (SP2) {
        PG8_STAGE(PG8_SB(0, 0), cB, voffB); PG8_STAGE(PG8_SB(0, 1), cB + hstep, voffB); PG8_STAGE(PG8_SA(0, 0), cA, voffA); PG8_STAGE(PG8_SA(0, 1), cA + hstep, voffA);
        if (wr == 1) PG8_BAR;
        PG8_WAIT_V(2); PG8_BAR;
        PG8_STAGE(PG8_SB(1, 0), cB + kstep, voffB); PG8_STAGE(PG8_SA(1, 0), cA + kstep, voffA); PG8_STAGE(PG8_SB(1, 1), cB + hstep + kstep, voffB);
        PG8_WAIT_V(6); PG8_BAR;
    } else {
        PG8_STAGE(PG8_SB(0, 0), cB, voffB); PG8_STAGE(PG8_SA(0, 0), cA, voffA); PG8_STAGE(PG8_SB(0, 1), cB + hstep, voffB); PG8_STAGE(PG8_SA(0, 1), cA + hstep, voffA);
        if (wr == 1) PG8_BAR;
        PG8_WAIT_V(4); PG8_BAR;
        PG8_STAGE(PG8_SB(1, 0), cB + kstep, voffB); PG8_STAGE(PG8_SA(1, 0), cA + kstep, voffA); PG8_STAGE(PG8_SB(1, 1), cB + hstep + kstep, voffB);
        PG8_WAIT_V(6); PG8_BAR;
    }
    for (;;) {
        const bool has_next = S.next(ui + 1, nxt);
        const char* nA = has_next ? (const char*)g.A + (size_t)nxt.pm * tstep : cA; const char* nB = has_next ? (const char*)g.Bt + (size_t)nxt.pn * tstep : cB;
        for (int t = 0; t < nt; t += 2) {
            const bool last = (t == nt - 2);
            const char* a1 = cA + (size_t)(t + 1) * kstep;
            const char* a2 = last ? nA : cA + (size_t)(t + 2) * kstep; const char* b2 = last ? nB : cB + (size_t)(t + 2) * kstep;
            const char* a3 = a2 + kstep; const char* b3 = b2 + kstep;
            if (last && has_next) S.a_ready(nxt);
            if constexpr (SP2) {
            PG8_LDB(B0, 0, 0); PG8_LDB(B1, 0, 1); PG8_SCHED; PG8_LDA(At, 0, 0); PG8_STAGE(PG8_SA(1, 1), a1 + hstep, voffA);
            PG8_WAIT_V(8); PG8_WAIT_L(0); PG8_BAR; PG8_MMA(0, 0, At, B0); PG8_MMA(0, 1, At, B1); PG8_BAR; PG8_SCHED;
            PG8_LDA(At, 0, 1); PG8_STAGE(PG8_SB(0, 0), b2, voffB); PG8_STAGE(PG8_SB(0, 1), b2 + hstep, voffB); PG8_STAGE(PG8_SA(0, 0), a2, voffA);
            PG8_WAIT_V(8); PG8_WAIT_L(0); PG8_BAR; PG8_MMA(1, 0, At, B0); PG8_MMA(1, 1, At, B1); PG8_BAR; PG8_SCHED;
            PG8_LDB(B0, 1, 0); PG8_LDB(B1, 1, 1); PG8_SCHED; PG8_LDA(At, 1, 0); PG8_STAGE(PG8_SA(0, 1), a2 + hstep, voffA);
            PG8_WAIT_V(8); PG8_WAIT_L(0); PG8_BAR; PG8_MMA(0, 0, At, B0); PG8_MMA(0, 1, At, B1); PG8_BAR; PG8_SCHED;
            PG8_LDA(At, 1, 1); PG8_STAGE(PG8_SB(1, 0), b3, voffB); PG8_STAGE(PG8_SB(1, 1), b3 + hstep, voffB); PG8_STAGE(PG8_SA(1, 0), a3, voffA);
            PG8_WAIT_V(8); PG8_WAIT_L(0); PG8_BAR; PG8_MMA(1, 0, At, B0); PG8_MMA(1, 1, At, B1); PG8_BAR; PG8_SCHED;
            } else {
            PG8_LDB(B0, 0, 0); PG8_SCHED; PG8_LDA(At, 0, 0); PG8_STAGE(PG8_SA(1, 1), a1 + hstep, voffA);
            PG8_WAIT_L(8); PG8_BAR; PG8_WAIT_L(0); PG8_MMA(0, 0, At, B0); PG8_BAR; PG8_SCHED;
            PG8_LDB(B1, 0, 1); PG8_STAGE(PG8_SB(0, 0), b2, voffB);
            PG8_BAR; PG8_WAIT_L(0); PG8_MMA(0, 1, At, B1); PG8_BAR;
            PG8_LDA(At, 0, 1); PG8_STAGE(PG8_SA(0, 0), a2, voffA);
            PG8_BAR; PG8_WAIT_L(0); PG8_MMA(1, 0, At, B0); PG8_BAR; PG8_SCHED;
            PG8_STAGE(PG8_SB(0, 1), b2 + hstep, voffB);
            PG8_WAIT_V(6); PG8_BAR; PG8_MMA(1, 1, At, B1); PG8_BAR;
            PG8_LDB(B0, 1, 0); PG8_SCHED; PG8_LDA(At, 1, 0); PG8_STAGE(PG8_SA(0, 1), a2 + hstep, voffA);
            PG8_WAIT_L(8); PG8_BAR; PG8_WAIT_L(0); PG8_MMA(0, 0, At, B0); PG8_BAR; PG8_SCHED;
            PG8_LDB(B1, 1, 1); PG8_STAGE(PG8_SB(1, 0), b3, voffB);
            PG8_BAR; PG8_WAIT_L(0); PG8_MMA(0, 1, At, B1); PG8_BAR;
            PG8_LDA(At, 1, 1); PG8_STAGE(PG8_SA(1, 0), a3, voffA);
            PG8_BAR; PG8_WAIT_L(0); PG8_MMA(1, 0, At, B0); PG8_BAR; PG8_SCHED;
            PG8_STAGE(PG8_SB(1, 1), b3 + hstep, voffB);
            PG8_WAIT_V(6); PG8_BAR; PG8_MMA(1, 1, At, B1); PG8_BAR;
            }
        }
        if constexpr (ALIGN_EPI) { if (wr == 0) PG8_BAR; }
        if constexpr (!Epi::AFTER_DRAIN) { E(acc, cur, wr, wc, fr, fq); S.done(cur); }
        if (!has_next) break;
#pragma unroll
        for (int a = 0; a < 2; ++a)
#pragma unroll
            for (int b = 0; b < 2; ++b)
#pragma unroll
                for (int m = 0; m < 4; ++m)
#pragma unroll
                    for (int n = 0; n < 2; ++n) acc[a][b][m][n] = (f32x4){0.f, 0.f, 0.f, 0.f};
        cur = nxt; cA = nA; cB = nB; ++ui;
        if constexpr (ALIGN_EPI) { if (wr == 1) PG8_BAR; }
    }
    PG8_WAIT_V(0);
    if constexpr (!ALIGN_EPI) { if (wr == 0) PG8_BAR; }
    PG8_BAR;
    if constexpr (Epi::AFTER_DRAIN) { E.fused(acc, cur, wr, wc, fr, fq, lds, wid, lane); S.done(cur); }
#undef PG8_SA
#undef PG8_SB
#undef PG8_STAGE
#undef PG8_LDA
#undef PG8_LDB
#undef PG8_MMA
#undef PG8_WAIT_V
#undef PG8_WAIT_L
#undef PG8_BAR
#undef PG8_SCHED
}
}
#define XB_TMO      128
#define XB_XCNT(j)  (256  + 64 * (j))
#define XB_XSUB(j)  (1280 + 64 * (j))
#define XB_XGEN(j)  (2304 + 64 * (j))
#define XB_TOP      3328
#define XB_TOPGEN   3392
#define XCD_BAR_WORDS 3456
#define XB_SPIN_CAP (1u << 22)

__device__ __forceinline__ unsigned xb_ld(unsigned* p)              { return __hip_atomic_load(p, __ATOMIC_RELAXED, __HIP_MEMORY_SCOPE_AGENT); }
__device__ __forceinline__ unsigned xb_add(unsigned* p, unsigned v) { return __hip_atomic_fetch_add(p, v, __ATOMIC_RELAXED, __HIP_MEMORY_SCOPE_AGENT); }
__device__ __forceinline__ unsigned xb_xcc_id() { return (unsigned)__builtin_amdgcn_s_getreg((3 << 11) | 20) & 0xFu; }
#define XB_SPIN(cond, bar) do { unsigned _sp = 0; while (cond) { __builtin_amdgcn_s_sleep(1); \
    if ((++_sp & 255u) == 0u) { if (xb_ld(&(bar)[XB_TMO])) break; if (_sp > XB_SPIN_CAP) { atomicAdd(&(bar)[XB_TMO], 1u); break; } } } } while (0)

struct XcdBarrier {
    unsigned* bar; unsigned x;
    volatile LAS unsigned* st;
};

__device__ __forceinline__ XcdBarrier xcd_barrier_post(unsigned* bar, volatile LAS unsigned* st) {
    XcdBarrier b; b.bar = bar; b.x = xb_xcc_id(); b.st = st;
    if (threadIdx.x == 0) (void)xb_add(&bar[XB_XCNT(b.x)], 1u);
    return b;
}
__device__ __forceinline__ void xcd_barrier_complete(unsigned* bar, unsigned x, unsigned& nloc, unsigned& nx) {
    const unsigned G = gridDim.x * gridDim.y * gridDim.z;
    unsigned sum, cnt, mine, sp = 0u;
    for (;;) {
        sum = 0u; cnt = 0u; mine = 0u;
#pragma unroll
        for (unsigned j = 0; j < 16; ++j) { const unsigned c = xb_ld(&bar[XB_XCNT(j)]); sum += c; cnt += (c > 0u) ? 1u : 0u; mine = (j == x) ? c : mine; }
        if (sum == G) break;
        __builtin_amdgcn_s_sleep(1);
        if ((++sp & 255u) == 0u) { if (xb_ld(&bar[XB_TMO])) break; if (sp > XB_SPIN_CAP) { atomicAdd(&bar[XB_TMO], 1u); break; } }
    }
    nloc = mine > 0u ? mine : 1u; nx = cnt > 0u ? cnt : 1u;
}

__device__ __forceinline__ void xcd_barrier(const XcdBarrier& b) {
    asm volatile("s_waitcnt vmcnt(0)" ::: "memory");
    __syncthreads();
    if (threadIdx.x == 0) {
        unsigned* bar = b.bar;
        __builtin_amdgcn_s_waitcnt(0);
        unsigned nloc = b.st[0], nx = b.st[1];
        if (nloc == 0u) { xcd_barrier_complete(bar, b.x, nloc, nx); b.st[0] = nloc; b.st[1] = nx; }
        const unsigned old = xb_add(&bar[XB_XSUB(b.x)], 1u);
        const unsigned gen = old / nloc;
        if (old + 1u == (gen + 1u) * nloc) {
            __builtin_amdgcn_fence(__ATOMIC_RELEASE, "agent");
            asm volatile("s_waitcnt vmcnt(0)" ::: "memory");
            const unsigned og = xb_add(&bar[XB_TOP], 1u);
            const unsigned tg = og / nx;
            if (og + 1u == (tg + 1u) * nx) xb_add(&bar[XB_TOPGEN], 1u);
            else XB_SPIN(xb_ld(&bar[XB_TOPGEN]) == tg, bar);
            __builtin_amdgcn_fence(__ATOMIC_ACQUIRE, "agent");
            xb_add(&bar[XB_XGEN(b.x)], 1u);
            asm volatile("s_waitcnt vmcnt(0)" ::: "memory");
        } else {
            XB_SPIN(xb_ld(&bar[XB_XGEN(b.x)]) == gen, bar);
            __builtin_amdgcn_fence(__ATOMIC_ACQUIRE, "agent");
            asm volatile("s_waitcnt vmcnt(0)" ::: "memory");
        }
    }
    __syncthreads();
}

enum { IN_X = 0, IN_C, IN_CTX, IN_CCTX, IN_ADAW, IN_ADAB, IN_N1G, IN_N2G, IN_FING, IN_S5LRE, IN_S5LIM, IN_S5LOG, IN_S5BRE, IN_S5BIM, IN_S5CRE, IN_S5CIM,
       IN_S5D, IN_S5WGLU, IN_S5BGLU, IN_AWKVQ, IN_AQG, IN_AKG, IN_AWO, IN_MLWIN, IN_MLBG, IN_MLNG, IN_MLWOUT, IN_RW, IN_RB, IN_MWG, IN_MWU, IN_MWD, N_INPUTS };

struct Frame {
    LAS unsigned char* lds;
    volatile LAS unsigned* MISC;
    unsigned* ctl;
    int tid, lane, wave, G, blk;
    const float* in[N_INPUTS];
    unsigned char* ws;
    float* out;
};

struct DenseSched {
    pg8::StaticOrder so; int pm0;
    __device__ __forceinline__ void init(int Mrows, int N, int G, int c, int pm0_) { so.init(Mrows, N, G, c); pm0 = pm0_; }
    __device__ __forceinline__ bool next(int i, pg8::Unit& u) const { if (!so.next(i, u)) return false; u.pm += pm0; return true; }
    __device__ __forceinline__ void a_ready(const pg8::Unit&) const {}
    __device__ __forceinline__ void done(const pg8::Unit&) const {}
};
struct MoeSched {
    const LAS int* tab; int G, c, npn;
    __device__ __forceinline__ bool next(int i, pg8::Unit& u) const {
        const int total = tab[16] * npn;
        int L;
        if ((G & 7) == 0) { const int x = c & 7, rank = c >> 3, per = G >> 3; const int q = total >> 3, rem = total & 7; const int start = x * q + (x < rem ? x : rem), cnt = q + (x < rem ? 1 : 0);
            const int off = rank + per * i; if (off >= cnt) return false; L = start + off; }
        else { L = i * G + c; if (L >= total) return false; }
        int e = 0;
#pragma unroll
        for (int k = 1; k < 16; ++k) e += (L >= tab[k] * npn) ? 1 : 0;
        const int ts = tab[e], te = tab[e + 1] - ts, idx = L - ts * npn;
        u.pm = __builtin_amdgcn_readfirstlane(ts + idx % te); u.pn = __builtin_amdgcn_readfirstlane(e * npn + idx / te); return true;
    }
    __device__ __forceinline__ void a_ready(const pg8::Unit&) const {}
    __device__ __forceinline__ void done(const pg8::Unit&) const {}
};

template <class Epi, class Sched>
__device__ __forceinline__ void gemm_phase_naive(const pg8::Gemm g, const Sched& S, const Epi& E) {
    const int tid = threadIdx.x, wid = tid >> 6, lane = tid & 63, wr = wid >> 2, wc = wid & 3, fr = lane & 15, fq = lane >> 4;
    const int K = g.K; pg8::Unit u;
    for (int i = 0; S.next(i, u); ++i) {
        f32x4 acc[2][2][4][2];
#pragma unroll
        for (int ai = 0; ai < 2; ++ai)
#pragma unroll
            for (int m = 0; m < 4; ++m) {
                const int row = u.pm * 256 + ai * 128 + wr * 64 + m * 16 + fr;
                const bf16* ap = g.A + (size_t)row * K;
                float s[2][2][4];
#pragma unroll
                for (int bj = 0; bj < 2; ++bj)
#pragma unroll
                    for (int n = 0; n < 2; ++n)
#pragma unroll
                        for (int e = 0; e < 4; ++e) s[bj][n][e] = 0.f;
                for (int k = 0; k < K; k += 8) {
                    const v4u av = *(const v4u*)(ap + k);
                    const float a0 = bflo(av.x), a1 = bfhi(av.x), a2 = bflo(av.y), a3 = bfhi(av.y), a4 = bflo(av.z), a5 = bfhi(av.z), a6 = bflo(av.w), a7 = bfhi(av.w);
#pragma unroll
                    for (int bj = 0; bj < 2; ++bj)
#pragma unroll
                        for (int n = 0; n < 2; ++n)
#pragma unroll
                            for (int e = 0; e < 4; ++e) {
                                const int col = u.pn * 256 + bj * 128 + wc * 32 + n * 16 + fq * 4 + e;
                                const v4u bv = *(const v4u*)(g.Bt + (size_t)col * K + k);
                                float t = s[bj][n][e];
                                t += a0 * bflo(bv.x); t += a1 * bfhi(bv.x); t += a2 * bflo(bv.y); t += a3 * bfhi(bv.y);
                                t += a4 * bflo(bv.z); t += a5 * bfhi(bv.z); t += a6 * bflo(bv.w); t += a7 * bfhi(bv.w);
                                s[bj][n][e] = t;
                            }
                }
#pragma unroll
                for (int bj = 0; bj < 2; ++bj)
#pragma unroll
                    for (int n = 0; n < 2; ++n) acc[ai][bj][m][n] = (f32x4){s[bj][n][0], s[bj][n][1], s[bj][n][2], s[bj][n][3]};
            }
        E(acc, u, wr, wc, fr, fq);
    }
}
#ifndef USE_NAIVE_GEMM
#define USE_NAIVE_GEMM 0
#endif
template <class Epi, class Sched>
__device__ __forceinline__ void run_gemm(Frame& F, const pg8::Gemm g, const Sched& S, const Epi& E) {
#if USE_NAIVE_GEMM
    gemm_phase_naive<Epi, Sched>(g, S, E);
#else
    pg8::gemm_phase<Epi, Sched, true, true>(F.lds + RING_OFF, g, S, E);
#endif
}

__device__ __forceinline__ void st_bf4(bf16* p, f32x4 v) { v2u w; w.x = pk2(v.x, v.y); w.y = pk2(v.z, v.w); *(v2u*)p = w; }

struct EpiRes {
    static constexpr bool PERM = false, AFTER_DRAIN = false;
    float* xres; const float* modg; int skip;
    __device__ __forceinline__ void operator()(const f32x4 (&acc)[2][2][4][2], const pg8::Unit& u, int wr, int wc, int fr, int fq) const {
#pragma unroll
        for (int ai = 0; ai < 2; ++ai)
#pragma unroll
            for (int m = 0; m < 4; ++m) {
                const int r = u.pm * 256 + ai * 128 + wr * 64 + m * 16 + fr;
                const float* gp = modg + mrow_of(r) * 6144; float* xp = xres + (size_t)r * D;
#pragma unroll
                for (int bj = 0; bj < 2; ++bj)
#pragma unroll
                    for (int n = 0; n < 2; ++n) {
                        const int c = u.pn * 256 + bj * 128 + wc * 32 + n * 16 + fq * 4;
                        const f32x4 gg = *(const f32x4*)(gp + c); f32x4 x = *(const f32x4*)(xp + c);
                        x = x + gg * acc[ai][bj][m][n]; if (!skip) *(f32x4*)(xp + c) = x;
                    }
            }
    }
};
struct EpiGlu {
    static constexpr bool PERM = false, AFTER_DRAIN = false;
    float* xres; const float* modg; const float* bglu; int skip;
    __device__ __forceinline__ void operator()(const f32x4 (&acc)[2][2][4][2], const pg8::Unit& u, int wr, int wc, int fr, int fq) const {
#pragma unroll
        for (int ai = 0; ai < 2; ++ai)
#pragma unroll
            for (int m = 0; m < 4; ++m) {
                const int r = u.pm * 256 + ai * 128 + wr * 64 + m * 16 + fr;
                const float* gp = modg + mrow_of(r) * 6144; float* xp = xres + (size_t)r * D;
#pragma unroll
                for (int bj = 0; bj < 2; ++bj) {
                    const int oc = u.pn * 128 + bj * 64 + wc * 16 + fq * 4;
                    const f32x4 a = acc[ai][bj][m][0] + *(const f32x4*)(bglu + oc);
                    const f32x4 g = acc[ai][bj][m][1] + *(const f32x4*)(bglu + 1024 + oc);
                    f32x4 val; val.x = a.x * sigmoidf_(g.x); val.y = a.y * sigmoidf_(g.y); val.z = a.z * sigmoidf_(g.z); val.w = a.w * sigmoidf_(g.w);
                    const f32x4 gg = *(const f32x4*)(gp + oc); f32x4 x = *(const f32x4*)(xp + oc);
                    x = x + gg * val; if (!skip) *(f32x4*)(xp + oc) = x;
                }
            }
    }
};
__device__ __forceinline__ int kvrow_of(int r) { if (r < TC) return (r >> 8) * KVLEN + SEQ + (r & 255); const int rr = r - TC; return (rr >> 11) * KVLEN + (rr & 2047); }
struct EpiKvq {
    static constexpr bool PERM = false, AFTER_DRAIN = false;
    bf16* qb; bf16* kb; bf16* vb; const float* qg; const float* kg; const float* rope;
    __device__ __forceinline__ void operator()(const f32x4 (&acc)[2][2][4][2], const pg8::Unit& u, int wr, int wc, int fr, int fq) const {
        const int pn = u.pn;
        const float* gptr = (pn == 0) ? kg : qg;
        f32x4 gn[2][2];
#pragma unroll
        for (int bj = 0; bj < 2; ++bj)
#pragma unroll
            for (int n = 0; n < 2; ++n) gn[bj][n] = *(const f32x4*)(gptr + 32 * bj + 16 * n + 4 * fq);
#pragma unroll
        for (int ai = 0; ai < 2; ++ai)
#pragma unroll
            for (int m = 0; m < 4; ++m) {
                const int r = u.pm * 256 + ai * 128 + wr * 64 + m * 16 + fr;
                f32x4 x[2][2];
#pragma unroll
                for (int bj = 0; bj < 2; ++bj)
#pragma unroll
                    for (int n = 0; n < 2; ++n) x[bj][n] = acc[ai][bj][m][n];
                if (pn != 1) {
                    float ss = 0.f;
#pragma unroll
                    for (int bj = 0; bj < 2; ++bj)
#pragma unroll
                        for (int n = 0; n < 2; ++n) { const f32x4 v = x[bj][n]; ss += v.x * v.x + v.y * v.y + v.z * v.z + v.w * v.w; }
                    ss = xor16_sum(ss); ss = xor32_sum(ss);
                    const float rs = rsqrtf(ss * (1.f / 64.f) + EPS);
#pragma unroll
                    for (int bj = 0; bj < 2; ++bj)
#pragma unroll
                        for (int n = 0; n < 2; ++n) x[bj][n] = x[bj][n] * rs * gn[bj][n];
                    if (r >= TC) {
                        const int t = (r - TC) & 2047;
#pragma unroll
                        for (int bj = 0; bj < 2; ++bj) {
                            const int pos = bj == 0 ? (t >> 6) : (t & 63);
                            const f32x4 cs = *(const f32x4*)(rope + pos * 16 + 4 * fq), sn = *(const f32x4*)(rope + 1024 + pos * 16 + 4 * fq);
                            const f32x4 x1 = x[bj][0], x2 = x[bj][1];
                            x[bj][0] = x1 * cs - x2 * sn; x[bj][1] = x2 * cs + x1 * sn;
                        }
                    }
                }
                bf16* dst;
                if (pn == 0) dst = kb + (size_t)kvrow_of(r) * 256 + wc * 64;
                else if (pn == 1) dst = vb + (size_t)kvrow_of(r) * 256 + wc * 64;
                else { dst = qb + (size_t)r * D + ((pn - 2) * 4 + wc) * 64;
#pragma unroll
                    for (int bj = 0; bj < 2; ++bj)
#pragma unroll
                        for (int n = 0; n < 2; ++n) x[bj][n] = x[bj][n] * ATT_C2; }
#pragma unroll
                for (int bj = 0; bj < 2; ++bj)
#pragma unroll
                    for (int n = 0; n < 2; ++n) st_bf4(dst + 32 * bj + 16 * n + 4 * fq, x[bj][n]);
            }
    }
};
struct EpiMlIn {
    static constexpr bool PERM = true, AFTER_DRAIN = false;
    bf16 *k, *v, *q, *o; float* g; const float* bgate;
    __device__ __forceinline__ void operator()(const f32x4 (&acc)[2][2][4][2], const pg8::Unit& u, int wr, int wc, int fr, int fq) const {
        const int pn = u.pn;
#pragma unroll
        for (int ai = 0; ai < 2; ++ai)
#pragma unroll
            for (int m = 0; m < 4; ++m) {
                const int r = u.pm * 256 + ai * 128 + wr * 64 + m * 16 + fr;
#pragma unroll
                for (int bj = 0; bj < 2; ++bj) {
                    const int cc = bj * 128 + wc * 32 + fq * 8;
                    f32x4 a = acc[ai][bj][m][0], b = acc[ai][bj][m][1];
                    if (pn == 12) { if (cc < 32) { *(f32x4*)(g + (size_t)r * 32 + cc) = a + *(const f32x4*)(bgate + cc); *(f32x4*)(g + (size_t)r * 32 + cc + 4) = b + *(const f32x4*)(bgate + cc + 4); } continue; }
                    if (pn < 2) { a = a * 0.125f; b = b * 0.125f; }
                    v4u ov; ov.x = pk2(a.x, a.y); ov.y = pk2(a.z, a.w); ov.z = pk2(b.x, b.y); ov.w = pk2(b.z, b.w);
                    bf16* dst = (pn < 2) ? k + (size_t)r * 512 + pn * 256 + cc : (pn < 6) ? v + (size_t)r * 1024 + (pn - 2) * 256 + cc : (pn < 8) ? q + (size_t)r * 512 + (pn - 6) * 256 + cc : o + (size_t)r * 1024 + (pn - 8) * 256 + cc;
                    *(v4u*)dst = ov;
                }
            }
    }
};
struct EpiG1 {
    static constexpr bool PERM = false, AFTER_DRAIN = false;
    bf16* hid;
    __device__ __forceinline__ void operator()(const f32x4 (&acc)[2][2][4][2], const pg8::Unit& u, int wr, int wc, int fr, int fq) const {
        const int pnl = u.pn & 3;
#pragma unroll
        for (int ai = 0; ai < 2; ++ai)
#pragma unroll
            for (int m = 0; m < 4; ++m) {
                const int r = u.pm * 256 + ai * 128 + wr * 64 + m * 16 + fr;
#pragma unroll
                for (int bj = 0; bj < 2; ++bj) {
                    const int hc = pnl * 128 + bj * 64 + wc * 16 + fq * 4;
                    const f32x4 ga = acc[ai][bj][m][0], up = acc[ai][bj][m][1];
                    f32x4 h; h.x = siluf_(ga.x) * up.x; h.y = siluf_(ga.y) * up.y; h.z = siluf_(ga.z) * up.z; h.w = siluf_(ga.w) * up.w;
                    st_bf4(hid + (size_t)r * DFF + hc, h);
                }
            }
    }
};
struct EpiG2 {
    static constexpr bool PERM = true, AFTER_DRAIN = false;
    bf16* y2; const float* slotw;
    __device__ __forceinline__ void operator()(const f32x4 (&acc)[2][2][4][2], const pg8::Unit& u, int wr, int wc, int fr, int fq) const {
        const int pnl = u.pn & 3;
#pragma unroll
        for (int ai = 0; ai < 2; ++ai)
#pragma unroll
            for (int m = 0; m < 4; ++m) {
                const int r = u.pm * 256 + ai * 128 + wr * 64 + m * 16 + fr;
                const float w = slotw[r];
#pragma unroll
                for (int bj = 0; bj < 2; ++bj) {
                    const int c = pnl * 256 + bj * 128 + wc * 32 + fq * 8;
                    const f32x4 a = acc[ai][bj][m][0] * w, b = acc[ai][bj][m][1] * w;
                    v4u o; o.x = pk2(a.x, a.y); o.y = pk2(a.z, a.w); o.z = pk2(b.x, b.y); o.w = pk2(b.z, b.w);
                    *(v4u*)(y2 + (size_t)r * D + c) = o;
                }
            }
    }
};

struct CmNat { const float* W; int ld; __device__ __forceinline__ const float* col(int j) const { return W + j; } };
struct CmGlu { const float* W; int ld;
    __device__ __forceinline__ const float* col(int j) const { const int pn = j >> 8, bj = (j >> 7) & 1, wc = (j >> 5) & 3, n = (j >> 4) & 1, q = j & 15; return W + n * 1024 + 128 * pn + 64 * bj + 16 * wc + q; } };
struct CmKvq { const float* W; int ld;
    __device__ __forceinline__ const float* col(int j) const { const int pn = j >> 8, bj = (j >> 7) & 1, wc = (j >> 5) & 3, n = (j >> 4) & 1, q = j & 15; return W + 256 * pn + 64 * wc + 32 * bj + 16 * n + q; } };
struct CmMlIn { const float* W; int ld;
    __device__ __forceinline__ const float* col(int j) const {
        if (j < 1536) return W + j;
        if (j < 2048) return W + 1568 + (j - 1536);
        if (j < 3072) return W + 2080 + (j - 2048);
        if (j < 3104) return W + 1536 + (j - 3072);
        return nullptr; } };
struct CmG1 { const float* Wg; const float* Wu; int ld;
    __device__ __forceinline__ const float* col(int j) const { const int le = j >> 10, jj = j & 1023; const int pn = jj >> 8, bj = (jj >> 7) & 1, wc = (jj >> 5) & 3, n = (jj >> 4) & 1, q = jj & 15;
        const uintptr_t a = (uintptr_t)Wg, b = (uintptr_t)Wu, msk = (uintptr_t)0 - (uintptr_t)n;
        return (const float*)((a & ~msk) | (b & msk)) + (size_t)le * 1024 * 512 + 128 * pn + 64 * bj + 16 * wc + q; } };
struct CmG2 { const float* Wd; int ld;
    __device__ __forceinline__ const float* col(int j) const { const int le = j >> 10, jj = j & 1023; return Wd + (size_t)le * 512 * 1024 + jj; } };

template <class CM>
__device__ __forceinline__ void transpose_item(const CM& cm, int K, bf16* WT, int kb, int nb, LAS float* scr, int lane) {
    const int k0 = 64 * kb, n0 = 32 * nb;
    const int nq = (lane & 7) * 4;
    const float* cp = cm.col(n0 + nq);
    const size_t ld = (size_t)cm.ld;
    f32x4 v[8];
#pragma unroll
    for (int i = 0; i < 8; ++i) { const int kk = 8 * i + (lane >> 3); v[i] = cp ? *(const f32x4*)(cp + (size_t)(k0 + kk) * ld) : (f32x4){0.f, 0.f, 0.f, 0.f}; }
#pragma unroll
    for (int i = 0; i < 8; ++i) { const int kk = 8 * i + (lane >> 3); LAS float* d = scr + kk * 33 + nq; d[0] = v[i].x; d[1] = v[i].y; d[2] = v[i].z; d[3] = v[i].w; }
    LDS_WAIT(); asm volatile("" ::: "memory");
    const int c = lane & 7;
#pragma unroll
    for (int j = 0; j < 4; ++j) { const int n = (lane >> 3) + 8 * j; const LAS float* s = scr + (8 * c) * 33 + n;
        v4u o; o.x = pk2(s[0 * 33], s[1 * 33]); o.y = pk2(s[2 * 33], s[3 * 33]); o.z = pk2(s[4 * 33], s[5 * 33]); o.w = pk2(s[6 * 33], s[7 * 33]);
        *(v4u*)(WT + (size_t)(n0 + n) * K + k0 + 8 * c) = o; }
    LDS_WAIT(); asm volatile("" ::: "memory");
}
template <class CM>
__device__ __forceinline__ void transpose_all(Frame& F, const CM& cm, int K, int Ndest, bf16* WT, int rot) {
    LAS float* scr = (LAS float*)(F.lds + RING_OFF + F.wave * 16384);
    const int NGW = F.G * NWAVES, gw = (F.blk * NWAVES + F.wave + rot) % NGW;
    const int nblk = Ndest / 32, items = (K / 64) * nblk;
    for (int it = gw; it < items; it += NGW) transpose_item(cm, K, WT, it / nblk, it % nblk, scr, F.lane);
}

__device__ __forceinline__ void phase_prologue(Frame& F) {
    {
        LAS float* cond = (LAS float*)(F.lds);
        LAS float* red = (LAS float*)(F.lds + 40960);
        for (int i = F.tid; i < 9 * 1024; i += NTHR) { const int mb = i >> 10, k = i & 1023; const float v = (mb < 8) ? F.in[IN_C][mb * 1024 + k] : F.in[IN_CCTX][k]; cond[i] = siluf_(v); }
        __syncthreads();
        float* mod = (float*)(F.ws + WS_MOD);
        for (int it = F.blk; it < DEPTH * 48; it += F.G) {
            const int l = it / 48, n0 = (it % 48) * 128;
            const float* w = F.in[IN_ADAW] + (size_t)l * 1024 * 6144 + n0 + 2 * F.lane;
            f32x2 a[9];
#pragma unroll
            for (int mb = 0; mb < 9; ++mb) a[mb] = (f32x2){0.f, 0.f};
            const int kb = F.wave * 128;
            for (int k8 = 0; k8 < 128; k8 += 8) {
                f32x2 wv[8];
#pragma unroll
                for (int u = 0; u < 8; ++u) wv[u] = *(const f32x2*)(w + (size_t)(kb + k8 + u) * 6144);
#pragma unroll
                for (int u = 0; u < 8; ++u)
#pragma unroll
                    for (int mb = 0; mb < 9; ++mb) a[mb] += wv[u] * cond[mb * 1024 + kb + k8 + u];
            }
#pragma unroll
            for (int mb = 0; mb < 9; ++mb) *(LAS f32x2*)(red + (F.wave * 9 + mb) * 128 + 2 * F.lane) = a[mb];
            __syncthreads();
            for (int i = F.tid; i < 9 * 128; i += NTHR) { const int mb = i >> 7, ln = i & 127; float s = F.in[IN_ADAB][l * 6144 + n0 + ln];
#pragma unroll
                for (int wv = 0; wv < 8; ++wv) s += red[(wv * 9 + mb) * 128 + ln];
                mod[(size_t)(l * 9 + mb) * 6144 + n0 + ln] = s; }
            __syncthreads();
        }
    }
    { const int idx = F.blk * NTHR + F.tid;
      if (idx < 1024) { const int pos = idx >> 4, f = idx & 15; const float inv = exp2f(-(float)f * (13.287712379549449f / 16.f)); const float ang = (float)pos * inv;
          double s, c; sincos_d((double)ang, s, c); float* rope = (float*)(F.ws + WS_ROPE); rope[idx] = (float)c; rope[1024 + idx] = (float)s; } }
    __syncthreads();
    { CmGlu cm{F.in[IN_S5WGLU], 2048}; transpose_all(F, cm, 1024, 2048, (bf16*)(F.ws + WS_WGLU), 0); }
    { CmGlu cm{F.in[IN_S5WGLU] + (size_t)1024 * 2048, 2048}; transpose_all(F, cm, 1024, 2048, (bf16*)(F.ws + WS_WGLU) + (size_t)2048 * 1024, 1024); }
    { CmKvq cm{F.in[IN_AWKVQ], 1536}; transpose_all(F, cm, 1024, 1536, (bf16*)(F.ws + WS_WKVQ), 0); }
    { CmNat cm{F.in[IN_AWO], 1024}; transpose_all(F, cm, 1024, 1024, (bf16*)(F.ws + WS_WO), 768); }
    { CmMlIn cm{F.in[IN_MLWIN], 3104}; transpose_all(F, cm, 1024, ML_NIN, (bf16*)(F.ws + WS_WIN), 1280); }
    { CmNat cm{F.in[IN_MLWOUT], 1024}; transpose_all(F, cm, 1024, 1024, (bf16*)(F.ws + WS_WOUT), 896); }
    { CmG1 cm{F.in[IN_MWG], F.in[IN_MWU], 512}; transpose_all(F, cm, 1024, DEPTH * NEXP * 1024, (bf16*)(F.ws + WS_WG1), 1408); }
    { CmG2 cm{F.in[IN_MWD], 1024}; transpose_all(F, cm, 512, DEPTH * NEXP * 1024, (bf16*)(F.ws + WS_WG2), 1408); }
}

struct RowMod { f32x4 a[4], b[4], c[4]; int mr; };
__device__ __forceinline__ void rowmod_load(RowMod& M, const float* base, int mr, int oa, int ob, int oc, int lane) {
    if (mr == M.mr) return; M.mr = mr; const float* p = base + (size_t)mr * 6144;
#pragma unroll
    for (int j = 0; j < 4; ++j) { M.a[j] = *(const f32x4*)(p + oa + 4 * lane + 256 * j); M.b[j] = *(const f32x4*)(p + ob + 4 * lane + 256 * j); if (oc >= 0) M.c[j] = *(const f32x4*)(p + oc + 4 * lane + 256 * j); }
}
struct RawRow { f32x4 x[4]; v2u ya[4], yb[4]; };
template <bool COMB>
__device__ __forceinline__ void raw_load(RawRow& R, const float* xrow, const bf16* y2, int s0, int s1, int lane) {
#pragma unroll
    for (int j = 0; j < 4; ++j) { R.x[j] = *(const f32x4*)(xrow + 4 * lane + 256 * j);
        if (COMB) { R.ya[j] = *(const v2u*)(y2 + (size_t)s0 * D + 4 * lane + 256 * j); R.yb[j] = *(const v2u*)(y2 + (size_t)s1 * D + 4 * lane + 256 * j); } }
}
template <int L>
__device__ __forceinline__ void phase_a1(Frame& F, const int skip = 0) {
    const float* mod = (const float*)(F.ws + WS_MOD);
    float* xres = (float*)(F.ws + WS_XRES); bf16* hb = (bf16*)(F.ws + WS_H);
    const bf16* y2 = (const bf16*)(F.ws + WS_Y2); const int* toks = (const int*)(F.ws + WS_TOKS);
    const int gw = F.blk * NWAVES + F.wave, NGW = F.G * NWAVES, lane = F.lane;
    const int RPW = (T + NGW - 1) / NGW, r0 = gw * RPW, r1 = (r0 + RPW < T) ? r0 + RPW : T;
    if (r0 >= T) return;
    f32x4 gv[4];
#pragma unroll
    for (int j = 0; j < 4; ++j) gv[j] = *(const f32x4*)(F.in[IN_N1G] + L * D + 4 * lane + 256 * j);
    auto rowptr = [&](int r) -> const float* { if (L == 0) return (r < TC) ? F.in[IN_CTX] + (size_t)r * D : F.in[IN_X] + (size_t)(r - TC) * D; return xres + (size_t)r * D; };
    RowMod M1, M2; M1.mr = -1; M2.mr = -1;
    int ns0 = 0, ns1 = 0;
    if (L > 0) { ns0 = toks[2 * r0]; ns1 = toks[2 * r0 + 1]; }
    RawRow nx; raw_load<(L > 0)>(nx, rowptr(r0), y2, ns0, ns1, lane);
    if (L > 0 && r0 + 1 < r1) { ns0 = toks[2 * r0 + 2]; ns1 = toks[2 * r0 + 3]; }
    for (int r = r0; r < r1; ++r) {
        const int mr = mrow_of(r);
        RawRow cur = nx;
        if (r + 1 < r1) { raw_load<(L > 0)>(nx, rowptr(r + 1), y2, ns0, ns1, lane); if (L > 0 && r + 2 < r1) { ns0 = toks[2 * r + 4]; ns1 = toks[2 * r + 5]; } }
        rowmod_load(M1, mod + (size_t)L * 9 * 6144, mr, 0, 1024, -1, lane);
        if (L > 0) rowmod_load(M2, mod + (size_t)(L - 1) * 9 * 6144, mr, 5120, 5120, -1, lane);
        float ss = 0.f;
#pragma unroll
        for (int j = 0; j < 4; ++j) {
            f32x4 v = cur.x[j];
            if (L > 0) { const v2u a = cur.ya[j], b = cur.yb[j]; const f32x4 gg = M2.a[j];
                v.x += gg.x * (bflo(a.x) + bflo(b.x)); v.y += gg.y * (bfhi(a.x) + bfhi(b.x)); v.z += gg.z * (bflo(a.y) + bflo(b.y)); v.w += gg.w * (bfhi(a.y) + bfhi(b.y)); }
            cur.x[j] = v;
            if (!skip) *(f32x4*)(xres + (size_t)r * D + 4 * lane + 256 * j) = v; ss += v.x * v.x + v.y * v.y + v.z * v.z + v.w * v.w;
        }
        const float rs = rsqrtf(wave_sum(ss) * (1.f / D) + EPS);
#pragma unroll
        for (int j = 0; j < 4; ++j) { const f32x4 h = cur.x[j] * rs * gv[j] * (M1.b[j] + 1.f) + M1.a[j]; st_bf4(hb + (size_t)r * D + 4 * lane + 256 * j, h); }
    }
}
__device__ __forceinline__ float quad_get(float v, int k) {
    return k == 1 ? dpp_f<0x39>(v, v) : k == 2 ? dpp_f<0x4E>(v, v) : dpp_f<0x93>(v, v); }
template <int L>
__device__ __forceinline__ void phase_n2(Frame& F, const int var = 0) {
    constexpr int R0 = (L == DEPTH - 1) ? TC : 0;
    const float* mod = (const float*)(F.ws + WS_MOD);
    const float* xres = (const float*)(F.ws + WS_XRES); bf16* hb = (bf16*)(F.ws + WS_H);
    int* toke = (int*)(F.ws + WS_TOKE); int* tokr = (int*)(F.ws + WS_TOKR); float* tokw = (float*)(F.ws + WS_TOKW); int* bcnt = (int*)(F.ws + WS_BCNT);
    LAS v4u* rwf = (LAS v4u*)(F.lds);
    LAS float* PS = (LAS float*)(F.lds + 65536);
    LAS float* PL = (LAS float*)(F.lds + 65536 + 1024);
    LAS int* cntL = (LAS int*)(F.lds + SCT_OFF);
    for (int i = F.tid; i < 32 * 64; i += NTHR) { const int ks = i >> 6, ln = i & 63, e = ln & 15, k0 = 32 * ks + 8 * (ln >> 4);
        float w[8]; unsigned hi[4], lo[4];
#pragma unroll
        for (int jj = 0; jj < 8; ++jj) w[jj] = F.in[IN_RW][(k0 + jj) * 16 + e];
#pragma unroll
        for (int jj = 0; jj < 4; ++jj) { hi[jj] = pk2(w[2 * jj], w[2 * jj + 1]); lo[jj] = pk2(w[2 * jj] - bflo(hi[jj]), w[2 * jj + 1] - bfhi(hi[jj])); }
        rwf[2 * i] = (v4u){hi[0], hi[1], hi[2], hi[3]}; rwf[2 * i + 1] = (v4u){lo[0], lo[1], lo[2], lo[3]}; }
    if (F.tid < 16) cntL[F.tid] = 0;
    __syncthreads();
    const int lane = F.lane, rl = lane & 15, kg = lane >> 4, w = F.wave;
    const float rbias = F.in[IN_RB][rl];
    constexpr int NTILES = (T - R0) / 16;
    const int ntl = (NTILES - F.blk + F.G - 1) / F.G;
    const int c0 = 128 * w + 8 * kg;
    f32x4 xa[4], xb[4];
    if (ntl > 0) { const float* xr = xres + (size_t)(R0 + 16 * F.blk + rl) * D + c0;
#pragma unroll
        for (int q = 0; q < 4; ++q) { xa[q] = *(const f32x4*)(xr + 32 * q); xb[q] = *(const f32x4*)(xr + 32 * q + 4); } }
    for (int j = 0; j < ntl; ++j) {
        const int tile = F.blk + F.G * j, rbase = R0 + 16 * tile, mr = mrow_of(rbase), pb = j & 1;
        f32x4 ca[4], cb[4]; float ss = 0.f;
#pragma unroll
        for (int q = 0; q < 4; ++q) { ca[q] = xa[q]; cb[q] = xb[q];
            ss += ca[q].x * ca[q].x + ca[q].y * ca[q].y + ca[q].z * ca[q].z + ca[q].w * ca[q].w + cb[q].x * cb[q].x + cb[q].y * cb[q].y + cb[q].z * cb[q].z + cb[q].w * cb[q].w; }
        ss = xor16_sum(ss); ss = xor32_sum(ss);
        if (kg == 0) PS[(pb * 8 + w) * 16 + rl] = ss;
        if (j + 1 < ntl) { const float* xr = xres + (size_t)(R0 + 16 * (tile + F.G) + rl) * D + c0;
#pragma unroll
            for (int q = 0; q < 4; ++q) { xa[q] = *(const f32x4*)(xr + 32 * q); xb[q] = *(const f32x4*)(xr + 32 * q + 4); } }
        __syncthreads();
        float tot = 0.f;
#pragma unroll
        for (int ww = 0; ww < 8; ++ww) tot += PS[(pb * 8 + ww) * 16 + rl];
        const float rs = rsqrtf(tot * (1.f / D) + EPS);
        const float* gp = F.in[IN_N2G] + L * D + c0; const float* shp = mod + (size_t)(L * 9 + mr) * 6144 + 3072 + c0; const float* scp = shp + 1024;
        bf16* hrow = hb + (size_t)(rbase + rl) * D + c0;
        f32x4 acc = (f32x4){0.f, 0.f, 0.f, 0.f};
#pragma unroll
        for (int q = 0; q < 4; ++q) {
            float h[8];
            { const f32x4 g0 = *(const f32x4*)(gp + 32 * q), g1 = *(const f32x4*)(gp + 32 * q + 4), cc0 = *(const f32x4*)(scp + 32 * q), cc1 = *(const f32x4*)(scp + 32 * q + 4), s0 = *(const f32x4*)(shp + 32 * q), s1 = *(const f32x4*)(shp + 32 * q + 4);
              const f32x4 h0 = ca[q] * rs * g0 * (cc0 + 1.f) + s0, h1 = cb[q] * rs * g1 * (cc1 + 1.f) + s1;
              h[0] = h0.x; h[1] = h0.y; h[2] = h0.z; h[3] = h0.w; h[4] = h1.x; h[5] = h1.y; h[6] = h1.z; h[7] = h1.w; }
            unsigned hi[4], lo[4];
#pragma unroll
            for (int jj = 0; jj < 4; ++jj) { hi[jj] = pk2(h[2 * jj], h[2 * jj + 1]); lo[jj] = pk2(h[2 * jj] - bflo(hi[jj]), h[2 * jj + 1] - bfhi(hi[jj])); }
            const v4u hv = (v4u){hi[0], hi[1], hi[2], hi[3]}, lv = (v4u){lo[0], lo[1], lo[2], lo[3]};
            *(v4u*)(hrow + 32 * q) = hv;
            const int ks = 4 * w + q;
            const v4u bh = rwf[2 * (ks * 64 + lane)], bl = rwf[2 * (ks * 64 + lane) + 1];
            acc = __builtin_amdgcn_mfma_f32_16x16x32_bf16(__builtin_bit_cast(bf16x8, hv), __builtin_bit_cast(bf16x8, bh), acc, 0, 0, 0);
            acc = __builtin_amdgcn_mfma_f32_16x16x32_bf16(__builtin_bit_cast(bf16x8, hv), __builtin_bit_cast(bf16x8, bl), acc, 0, 0, 0);
            acc = __builtin_amdgcn_mfma_f32_16x16x32_bf16(__builtin_bit_cast(bf16x8, lv), __builtin_bit_cast(bf16x8, bh), acc, 0, 0, 0);
        }
        *(LAS f32x4*)(PL + ((pb * 8 + w) * 64 + lane) * 4) = acc;
        __syncthreads();
        if (w != (j & 7) || (var & 1)) continue;
        f32x4 lg = (f32x4){0.f, 0.f, 0.f, 0.f};
#pragma unroll
        for (int ww = 0; ww < 8; ++ww) lg = lg + *(const LAS f32x4*)(PL + ((pb * 8 + ww) * 64 + lane) * 4);
#pragma unroll
        for (int r = 0; r < 4; ++r) {
            const float sco = sigmoidf_(lg[r]), sel = sco + rbias;
            int rank = 0;
#pragma unroll
            for (int k = 1; k < 4; ++k) { const float o = quad_get(sel, k); const int oi = (rl & ~3) | ((rl + k) & 3); rank += (o > sel || (o == sel && oi < rl)) ? 1 : 0; }
            const bool top2 = rank < 2;
            float gs = top2 ? sel : 0.f; gs += dpp_f<0xB1>(0.f, gs); gs += dpp_f<0x4E>(0.f, gs);
            bool best = true; const int q = rl >> 2;
            { const float o1 = dpp_f<0x124>(gs, gs), o2 = dpp_f<0x128>(gs, gs), o3 = dpp_f<0x12C>(gs, gs);
              const int q1 = (q + 3) & 3, q2 = (q + 2) & 3, q3 = (q + 1) & 3;
              best = !(o1 > gs || (o1 == gs && q1 < q)) && !(o2 > gs || (o2 == gs && q2 < q)) && !(o3 > gs || (o3 == gs && q3 < q)); }
            const bool selv = best && top2;
            const float wsum = red16_sum(selv ? sco : 0.f);
            if (selv) { const int row = rbase + 4 * kg + r;
                const int lr = __hip_atomic_fetch_add(cntL + rl, 1, __ATOMIC_RELAXED, __HIP_MEMORY_SCOPE_WORKGROUP);
                toke[2 * row + rank] = rl; tokr[2 * row + rank] = lr; tokw[2 * row + rank] = sco * __builtin_amdgcn_rcpf(wsum); }
        }
    }
    __syncthreads();
    if (F.tid < 16 && !(var & 1)) bcnt[F.blk * 16 + F.tid] = cntL[F.tid];
}
template <int L>
__device__ __forceinline__ void phase_sc(Frame& F) {
    constexpr int R0 = (L == DEPTH - 1) ? TC : 0;
    const int* bcnt = (const int*)(F.ws + WS_BCNT);
    LAS int* pt = (LAS int*)(F.lds);
    LAS int* tt = (LAS int*)(F.lds + 8192);
    { const int e = F.tid & 15, ch = F.tid >> 4; int tot = 0, mine = 0;
      for (int b = ch; b < F.G; b += 32) { const int c = bcnt[b * 16 + e]; tot += c; mine += (b < F.blk) ? c : 0; }
      pt[ch * 16 + e] = tot; pt[512 + ch * 16 + e] = mine; }
    __syncthreads();
    if (F.tid < 16) { int tot = 0, mine = 0; for (int ch = 0; ch < 32; ++ch) { tot += pt[ch * 16 + F.tid]; mine += pt[512 + ch * 16 + F.tid]; } tt[F.tid] = tot; tt[16 + F.tid] = mine; }
    __syncthreads();
    if (F.tid == 0) { int ts = 0; int* etab = (int*)(F.ws + WS_ETAB);
        for (int e = 0; e < 16; ++e) { tt[32 + e] = ts * 256 + tt[16 + e]; if (F.blk == 0) etab[e] = ts; ts += (tt[e] + 255) >> 8; }
        if (F.blk == 0) etab[16] = ts; }
    __syncthreads();
    const int* toke = (const int*)(F.ws + WS_TOKE); const int* tokr = (const int*)(F.ws + WS_TOKR); const float* tokw = (const float*)(F.ws + WS_TOKW);
    int* toks = (int*)(F.ws + WS_TOKS); float* slotw = (float*)(F.ws + WS_SLOTW);
    const bf16* hb = (const bf16*)(F.ws + WS_H); bf16* hs = (bf16*)(F.ws + WS_HS);
    const int lane = F.lane;
    constexpr int NTILES = (T - R0) / 16;
    for (int tile = F.blk + F.G * F.wave; tile < NTILES; tile += F.G * NWAVES) {
        const int rbase = R0 + 16 * tile;
        int slot = 0;
        if (lane < 32) { const int idx = 2 * rbase + lane; const int e = toke[idx]; slot = tt[32 + e] + tokr[idx]; toks[idx] = slot; slotw[slot] = tokw[idx]; }
#pragma unroll 4
        for (int i = 0; i < 16; ++i) {
            const int s0 = __builtin_amdgcn_readlane(slot, 2 * i), s1 = __builtin_amdgcn_readlane(slot, 2 * i + 1); const int r = rbase + i;
#pragma unroll
            for (int j = 0; j < 2; ++j) { const v4u a = *(const v4u*)(hb + (size_t)r * D + 8 * lane + 512 * j);
                *(v4u*)(hs + (size_t)s0 * D + 8 * lane + 512 * j) = a; *(v4u*)(hs + (size_t)s1 * D + 8 * lane + 512 * j) = a; }
        }
    }
}
__device__ __forceinline__ void load_etab(Frame& F) {
    LAS int* tab = (LAS int*)(F.lds + ETAB_OFF);
    if (F.tid < 17) tab[F.tid] = ((const int*)(F.ws + WS_ETAB))[F.tid];
    __syncthreads();
}
__device__ __forceinline__ void phase_fin(Frame& F) {
    const float* mod = (const float*)(F.ws + WS_MOD);
    const float* xres = (const float*)(F.ws + WS_XRES);
    const bf16* y2 = (const bf16*)(F.ws + WS_Y2); const int* toks = (const int*)(F.ws + WS_TOKS);
    const int gw = F.blk * NWAVES + F.wave, NGW = F.G * NWAVES, lane = F.lane;
    const int RPW = (TL + NGW - 1) / NGW, r0 = TC + gw * RPW, r1 = (r0 + RPW < T) ? r0 + RPW : T;
    if (r0 >= T) return;
    f32x4 gv[4];
#pragma unroll
    for (int j = 0; j < 4; ++j) gv[j] = *(const f32x4*)(F.in[IN_FING] + 4 * lane + 256 * j);
    RowMod M2; M2.mr = -1;
    int ns0 = toks[2 * r0], ns1 = toks[2 * r0 + 1];
    RawRow nx; raw_load<true>(nx, xres + (size_t)r0 * D, y2, ns0, ns1, lane);
    if (r0 + 1 < r1) { ns0 = toks[2 * r0 + 2]; ns1 = toks[2 * r0 + 3]; }
    for (int r = r0; r < r1; ++r) {
        const int mr = mrow_of(r);
        RawRow cur = nx;
        if (r + 1 < r1) { raw_load<true>(nx, xres + (size_t)(r + 1) * D, y2, ns0, ns1, lane); if (r + 2 < r1) { ns0 = toks[2 * r + 4]; ns1 = toks[2 * r + 5]; } }
        rowmod_load(M2, mod + (size_t)(DEPTH - 1) * 9 * 6144, mr, 5120, 5120, -1, lane);
        float ss = 0.f;
#pragma unroll
        for (int j = 0; j < 4; ++j) { f32x4 v = cur.x[j]; const v2u a = cur.ya[j], b = cur.yb[j]; const f32x4 gg = M2.a[j];
            v.x += gg.x * (bflo(a.x) + bflo(b.x)); v.y += gg.y * (bfhi(a.x) + bfhi(b.x)); v.z += gg.z * (bflo(a.y) + bflo(b.y)); v.w += gg.w * (bfhi(a.y) + bfhi(b.y));
            cur.x[j] = v; ss += v.x * v.x + v.y * v.y + v.z * v.z + v.w * v.w; }
        const float rs = rsqrtf(wave_sum(ss) * (1.f / D) + EPS);
#pragma unroll
        for (int j = 0; j < 4; ++j) *(f32x4*)(F.out + (size_t)(r - TC) * D + 4 * lane + 256 * j) = cur.x[j] * rs * gv[j];
    }
}

__device__ __forceinline__ int seq_row(int b, int dir, int s) {
    if (s < CTX) return b * CTX + (dir ? (CTX - 1 - s) : s);
    const int t = s - CTX; return TC + b * SEQ + (dir ? (SEQ - 1 - t) : t);
}
template <int J, bool WCTX>
__device__ __forceinline__ void phase_s5_naive(Frame& F) {
    const int gw = F.blk * NWAVES + F.wave, lane = F.lane;
    if ((gw & 3) != 0) return;
    const int it = gw >> 2; if (it >= NB * 64) return;
    const int b = it >> 6, g = it & 63, p = lane;
    const bf16* hb = (const bf16*)(F.ws + WS_H); float* ysum = (float*)(F.ws + WS_YSUM);
    for (int dir = 0; dir < 2; ++dir) {
        const int gi = (J * 2 + dir) * 64 + g, pidx = gi * 64 + p;
        const float lam_re = F.in[IN_S5LRE][pidx], lam_im = F.in[IN_S5LIM][pidx];
        const float dt = expf(F.in[IN_S5LOG][gi]);
        const float mag = expf(lam_re * dt);
        double sd, cd; sincos_d((double)(lam_im * dt), sd, cd);
        const float a_re = mag * (float)cd, a_im = mag * (float)sd;
        const float den = lam_re * lam_re + lam_im * lam_im, n_re = a_re - 1.f, n_im = a_im;
        const float f_re = (n_re * lam_re + n_im * lam_im) / den, f_im = (n_im * lam_re - n_re * lam_im) / den;
        float bbr[16], bbi[16], cre[16], cim[16];
#pragma unroll
        for (int c = 0; c < 16; ++c) { const float br = F.in[IN_S5BRE][(size_t)pidx * 16 + c], bi = F.in[IN_S5BIM][(size_t)pidx * 16 + c];
            bbr[c] = f_re * br - f_im * bi; bbi[c] = f_re * bi + f_im * br;
            cre[c] = F.in[IN_S5CRE][((size_t)gi * 16 + c) * 64 + p]; cim[c] = F.in[IN_S5CIM][((size_t)gi * 16 + c) * 64 + p]; }
        float x_re = 0.f, x_im = 0.f;
        for (int s = 0; s < CTX + SEQ; ++s) {
            const int r = seq_row(b, dir, s);
            const v4u u0 = *(const v4u*)(hb + (size_t)r * D + g * 16), u1 = *(const v4u*)(hb + (size_t)r * D + g * 16 + 8);
            float u[16];
            u[0] = bflo(u0.x); u[1] = bfhi(u0.x); u[2] = bflo(u0.y); u[3] = bfhi(u0.y); u[4] = bflo(u0.z); u[5] = bfhi(u0.z); u[6] = bflo(u0.w); u[7] = bfhi(u0.w);
            u[8] = bflo(u1.x); u[9] = bfhi(u1.x); u[10] = bflo(u1.y); u[11] = bfhi(u1.y); u[12] = bflo(u1.z); u[13] = bfhi(u1.z); u[14] = bflo(u1.w); u[15] = bfhi(u1.w);
            float bur = 0.f, bui = 0.f;
#pragma unroll
            for (int c = 0; c < 16; ++c) { bur += u[c] * bbr[c]; bui += u[c] * bbi[c]; }
            const float nr = a_re * x_re - a_im * x_im + bur, ni = a_re * x_im + a_im * x_re + bui;
            x_re = nr; x_im = ni;
            if (WCTX || s >= CTX) {
                float yv = 0.f;
#pragma unroll
                for (int c = 0; c < 16; ++c) { const float t = wave_sum(x_re * cre[c] - x_im * cim[c]); if (lane == c) yv = t; }
                if (lane < 16) { float* yp = ysum + (size_t)r * D + g * 16 + lane; if (dir == 0) *yp = yv; else *yp = *yp + yv; }
            }
        }
    }
}
template <int J, bool WCTX>
__device__ __forceinline__ void phase_s5_combine(Frame& F) {
    constexpr int R0 = WCTX ? 0 : TC;
    const bf16* hb = (const bf16*)(F.ws + WS_H); const float* ysum = (const float*)(F.ws + WS_YSUM); bf16* zb = (bf16*)(F.ws + WS_Z);
    const int gw = F.blk * NWAVES + F.wave, NGW = F.G * NWAVES, lane = F.lane;
    f32x4 dv[4];
#pragma unroll
    for (int j = 0; j < 4; ++j) dv[j] = *(const f32x4*)(F.in[IN_S5D] + J * D + 4 * lane + 256 * j);
    for (int r = R0 + gw; r < T; r += NGW) {
#pragma unroll
        for (int j = 0; j < 4; ++j) {
            const f32x4 y = *(const f32x4*)(ysum + (size_t)r * D + 4 * lane + 256 * j);
            const v2u hv = *(const v2u*)(hb + (size_t)r * D + 4 * lane + 256 * j);
            f32x4 z; z.x = gelu_tanh(y.x + dv[j].x * bflo(hv.x)); z.y = gelu_tanh(y.y + dv[j].y * bfhi(hv.x)); z.z = gelu_tanh(y.z + dv[j].z * bflo(hv.y)); z.w = gelu_tanh(y.w + dv[j].w * bfhi(hv.y));
            st_bf4(zb + (size_t)r * D + 4 * lane + 256 * j, z);
        }
    }
}
template <bool WCTX>
__device__ __forceinline__ void phase_attn_naive(Frame& F) {
    constexpr int R0 = WCTX ? 0 : TC;
    const bf16* qb = (const bf16*)(F.ws + WS_QB); const bf16* kb = (const bf16*)(F.ws + WS_KB); const bf16* vb = (const bf16*)(F.ws + WS_VB); bf16* zb = (bf16*)(F.ws + WS_Z);
    const int gw = F.blk * NWAVES + F.wave, NGW = F.G * NWAVES, lane = F.lane;
    for (int it = gw; it < (T - R0) * 16; it += NGW) {
        const int r = R0 + (it >> 4), h = it & 15, kvh = h >> 2;
        int kv0, nk;
        if (r < TC) { kv0 = (r >> 8) * KVLEN + SEQ; nk = CTX; } else { kv0 = ((r - TC) >> 11) * KVLEN; nk = KVLEN; }
        float q[64];
#pragma unroll
        for (int c = 0; c < 8; ++c) { const v4u w = *(const v4u*)(qb + (size_t)r * D + h * 64 + 8 * c);
            q[8 * c] = bflo(w.x); q[8 * c + 1] = bfhi(w.x); q[8 * c + 2] = bflo(w.y); q[8 * c + 3] = bfhi(w.y); q[8 * c + 4] = bflo(w.z); q[8 * c + 5] = bfhi(w.z); q[8 * c + 6] = bflo(w.w); q[8 * c + 7] = bfhi(w.w); }
        float m = -INFINITY, l = 0.f, o[64];
#pragma unroll
        for (int d = 0; d < 64; ++d) o[d] = 0.f;
        for (int kk = lane; kk < nk; kk += 64) {
            const bf16* kp = kb + (size_t)(kv0 + kk) * 256 + kvh * 64; const bf16* vp = vb + (size_t)(kv0 + kk) * 256 + kvh * 64;
            float s = 0.f;
#pragma unroll
            for (int c = 0; c < 8; ++c) { const v4u w = *(const v4u*)(kp + 8 * c);
                s += q[8 * c] * bflo(w.x) + q[8 * c + 1] * bfhi(w.x) + q[8 * c + 2] * bflo(w.y) + q[8 * c + 3] * bfhi(w.y) + q[8 * c + 4] * bflo(w.z) + q[8 * c + 5] * bfhi(w.z) + q[8 * c + 6] * bflo(w.w) + q[8 * c + 7] * bfhi(w.w); }
            const float mn = fmaxf(m, s), sc = exp2f(m - mn), pp = exp2f(s - mn);
            l = l * sc + pp; m = mn;
#pragma unroll
            for (int c = 0; c < 8; ++c) { const v4u w = *(const v4u*)(vp + 8 * c);
                o[8 * c] = o[8 * c] * sc + pp * bflo(w.x); o[8 * c + 1] = o[8 * c + 1] * sc + pp * bfhi(w.x); o[8 * c + 2] = o[8 * c + 2] * sc + pp * bflo(w.y); o[8 * c + 3] = o[8 * c + 3] * sc + pp * bfhi(w.y);
                o[8 * c + 4] = o[8 * c + 4] * sc + pp * bflo(w.z); o[8 * c + 5] = o[8 * c + 5] * sc + pp * bfhi(w.z); o[8 * c + 6] = o[8 * c + 6] * sc + pp * bflo(w.w); o[8 * c + 7] = o[8 * c + 7] * sc + pp * bfhi(w.w); }
        }
        const float M = wave_max(m), f = exp2f(m - M);
        const float lt = wave_sum(l * f);
        float res = 0.f;
#pragma unroll
        for (int d = 0; d < 64; ++d) { const float t = wave_sum(o[d] * f); if (lane == d) res = t; }
        zb[(size_t)r * D + h * 64 + lane] = (bf16)f2bf(res / lt);
    }
}
template <bool WCTX>
__device__ __forceinline__ void phase_mlstm_naive(Frame& F) {
    const int gw = F.blk * NWAVES + F.wave, lane = F.lane;
    if ((gw & 15) != 0) return;
    const int it = gw >> 4; if (it >= NB * 8 * 2) return;
    const int b = it >> 4, hd = (it >> 1) & 7, j = (it & 1) * 64 + lane;
    const bf16* kb = (const bf16*)(F.ws + WS_MK); const bf16* vb = (const bf16*)(F.ws + WS_MV); const bf16* qb = (const bf16*)(F.ws + WS_MQ);
    const float* gb = (const float*)(F.ws + WS_MG); float* hsum = (float*)(F.ws + WS_MHS);
    for (int dir = 0; dir < 2; ++dir) {
        float C[64], nn[64], m = 0.f;
#pragma unroll
        for (int d = 0; d < 64; ++d) { C[d] = 0.f; nn[d] = 0.f; }
        for (int s = 0; s < CTX + SEQ; ++s) {
            const int r = seq_row(b, dir, s);
            const float ig = gb[(size_t)r * 32 + dir * 16 + hd], lf = log_sigmoidf_(gb[(size_t)r * 32 + dir * 16 + 8 + hd]);
            const float mn = fmaxf(lf + m, ig), fa = __expf(lf + m - mn), ia = __expf(ig - mn); m = mn;
            const float vj = bf2f(vb[(size_t)r * 1024 + hd * 128 + j]) * ia;
            float num = 0.f, den = 0.f;
#pragma unroll
            for (int c = 0; c < 8; ++c) {
                const v4u kw = *(const v4u*)(kb + (size_t)r * 512 + hd * 64 + 8 * c), qw = *(const v4u*)(qb + (size_t)r * 512 + hd * 64 + 8 * c);
                float kk[8], qq[8];
                kk[0] = bflo(kw.x); kk[1] = bfhi(kw.x); kk[2] = bflo(kw.y); kk[3] = bfhi(kw.y); kk[4] = bflo(kw.z); kk[5] = bfhi(kw.z); kk[6] = bflo(kw.w); kk[7] = bfhi(kw.w);
                qq[0] = bflo(qw.x); qq[1] = bfhi(qw.x); qq[2] = bflo(qw.y); qq[3] = bfhi(qw.y); qq[4] = bflo(qw.z); qq[5] = bfhi(qw.z); qq[6] = bflo(qw.w); qq[7] = bfhi(qw.w);
#pragma unroll
                for (int e = 0; e < 8; ++e) { const int d = 8 * c + e;
                    C[d] = fa * C[d] + kk[e] * vj; nn[d] = fa * nn[d] + ia * kk[e]; num += C[d] * qq[e]; den += nn[d] * qq[e]; }
            }
            if (WCTX || s >= CTX) {
                const float outv = num / fmaxf(fabsf(den), __expf(-m));
                float* hp = hsum + (size_t)r * D + hd * 128 + j;
                if (dir == 0) *hp = outv; else *hp = *hp + outv;
            }
        }
    }
}
template <bool WCTX>
__device__ __forceinline__ void phase_mlstm_combine(Frame& F) {
    constexpr int R0 = WCTX ? 0 : TC;
    const float* hsum = (const float*)(F.ws + WS_MHS); const bf16* ob = (const bf16*)(F.ws + WS_MO); bf16* zb = (bf16*)(F.ws + WS_Z);
    const int gw = F.blk * NWAVES + F.wave, NGW = F.G * NWAVES, lane = F.lane;
    f32x4 gv[4];
#pragma unroll
    for (int j = 0; j < 4; ++j) gv[j] = *(const f32x4*)(F.in[IN_MLNG] + 4 * lane + 256 * j);
    for (int r = R0 + gw; r < T; r += NGW) {
#pragma unroll
        for (int j = 0; j < 4; ++j) {
            const f32x4 hv = *(const f32x4*)(hsum + (size_t)r * D + 4 * lane + 256 * j);
            float ss = hv.x * hv.x + hv.y * hv.y + hv.z * hv.z + hv.w * hv.w;
#pragma unroll
            for (int o = 1; o < 32; o <<= 1) ss += __shfl_xor(ss, o);
            const float rs = rsqrtf(ss * (1.f / 128.f) + EPS);
            const v2u ow = *(const v2u*)(ob + (size_t)r * D + 4 * lane + 256 * j);
            f32x4 z = hv * rs * gv[j];
            z.x *= sigmoidf_(bflo(ow.x)); z.y *= sigmoidf_(bfhi(ow.x)); z.z *= sigmoidf_(bflo(ow.y)); z.w *= sigmoidf_(bfhi(ow.y));
            st_bf4(zb + (size_t)r * D + 4 * lane + 256 * j, z);
        }
    }
}
#include <hip/hip_bf16.h>
#include <cmath>
namespace attn_body {
using bf16=__hip_bfloat16;
using bf16x8=__attribute__((ext_vector_type(8)))short;
using s16x4=__attribute__((ext_vector_type(4)))short;
using f32x16=__attribute__((ext_vector_type(16)))float;
using u32x4=__attribute__((ext_vector_type(4)))unsigned;
constexpr int D=64,QP=1024,KP=256;
constexpr int NW=8,QBLK=32,QB=QBLK*NW,KVBLK=64;
__device__ __forceinline__ int crow(int r,int hi){return (r&3)+8*(r>>2)+4*hi;}
#define SBAR() __builtin_amdgcn_sched_barrier(0)
__device__ __forceinline__ void cmask(f32x16&p0,f32x16&p1,int jb,int qrel,int hi){
  const float NEG=-INFINITY; int kb=64*jb+4*hi;
  #pragma unroll
  for(int r=0;r<16;++r){int kv=kb+(r&3)+8*(r>>2); if(kv>qrel)p0[r]=NEG; if(kv+32>qrel)p1[r]=NEG;}
}

constexpr int NSLOT=3, SLOTB=8192;
constexpr int LDS_K=0, LDS_V=NSLOT*SLOTB, LDS_WS=2*NSLOT*SLOTB, LDS_OST=LDS_WS+NW*64*4, LDS_BYTES=LDS_OST+NW*4096;
constexpr float C2=0.125f*1.4426950408889634f;
__device__ __forceinline__ void glds16(const void*gsrc,unsigned lds_dst){unsigned keep;
  asm volatile("s_mov_b32 %0, m0\n\ts_mov_b32 m0, %2\n\ts_nop 0\n\tglobal_load_lds_dwordx4 %1, off\n\ts_mov_b32 m0, %0":"=&s"(keep):"v"(gsrc),"s"(lds_dst):"memory");}
__device__ __forceinline__ float max3f(float a,float b,float c){float r;asm("v_max3_f32 %0, %1, %2, %3":"=v"(r):"v"(a),"v"(b),"v"(c));return r;}
__device__ __forceinline__ float max2f(float a,float b){float r;asm("v_max_f32_e32 %0, %1, %2":"=v"(r):"v"(a),"v"(b));return r;}
__device__ __forceinline__ float fadd_s(float a,float b){float r;asm("v_add_f32_e32 %0, %1, %2":"=v"(r):"v"(a),"v"(b));return r;}
__device__ __forceinline__ float fsub_s(float a,float b){float r;asm("v_sub_f32_e32 %0, %1, %2":"=v"(r):"v"(a),"v"(b));return r;}
typedef float f32x2_t __attribute__((ext_vector_type(2))); typedef __bf16 bf16x2_t __attribute__((ext_vector_type(2)));
__device__ __forceinline__ unsigned cvtpk_s(float lo,float hi){f32x2_t v={lo,hi};bf16x2_t b=__builtin_convertvector(v,bf16x2_t);return __builtin_bit_cast(unsigned,b);}
#define WAIT_BAR(N) asm volatile("s_waitcnt vmcnt(" #N ") lgkmcnt(0)\n\ts_barrier":::"memory")

__device__ __forceinline__ void qkt(f32x16&p0,f32x16&p1,const char*Kslot,const bf16x8*qr,const f32x16&negm,int r32,int hi){
  const char*kb=Kslot+hi*1024+r32*16;
  #pragma unroll
  for(int d0=0;d0<4;++d0){
    const bf16x8 b0=*reinterpret_cast<const bf16x8*>(kb+d0*2048);
    const bf16x8 b1=*reinterpret_cast<const bf16x8*>(kb+d0*2048+512);
    if(d0==0){p0=__builtin_amdgcn_mfma_f32_32x32x16_bf16(b0,qr[0],negm,0,0,0);p1=__builtin_amdgcn_mfma_f32_32x32x16_bf16(b1,qr[0],negm,0,0,0);}
    else{p0=__builtin_amdgcn_mfma_f32_32x32x16_bf16(b0,qr[d0],p0,0,0,0);p1=__builtin_amdgcn_mfma_f32_32x32x16_bf16(b1,qr[d0],p1,0,0,0);}}
}
typedef __attribute__((address_space(3))) const char* lds_cptr;
typedef short v4i16_t __attribute__((ext_vector_type(4)));
__device__ __forceinline__ void kload8(bf16x8*kf,lds_cptr kp){
  kf[0]=*(const __attribute__((address_space(3))) bf16x8*)(kp);      kf[1]=*(const __attribute__((address_space(3))) bf16x8*)(kp+512);
  kf[2]=*(const __attribute__((address_space(3))) bf16x8*)(kp+2048); kf[3]=*(const __attribute__((address_space(3))) bf16x8*)(kp+2560);
  kf[4]=*(const __attribute__((address_space(3))) bf16x8*)(kp+4096); kf[5]=*(const __attribute__((address_space(3))) bf16x8*)(kp+4608);
  kf[6]=*(const __attribute__((address_space(3))) bf16x8*)(kp+6144); kf[7]=*(const __attribute__((address_space(3))) bf16x8*)(kp+6656);
}
__device__ __forceinline__ void kload2(bf16x8*kf,lds_cptr kp,int j){ kf[2*j]=*(const __attribute__((address_space(3))) bf16x8*)(kp+j*2048); kf[2*j+1]=*(const __attribute__((address_space(3))) bf16x8*)(kp+j*2048+512); }
__device__ __forceinline__ s16x4 vtr(lds_cptr p){ return __builtin_bit_cast(s16x4,__builtin_amdgcn_ds_read_tr16_b64_v4i16((__attribute__((address_space(3))) v4i16_t*)p)); }
__device__ __forceinline__ float rowmax(const f32x16&p0,const f32x16&p1){
  float a=max3f(p0[0],p0[1],p1[0]),b=max3f(p0[2],p0[3],p1[1]);a=max3f(a,p1[2],p1[3]);
  #pragma unroll
  for(int r=4;r<16;r+=4){a=max3f(a,p0[r],p0[r+1]);b=max3f(b,p0[r+2],p0[r+3]);a=max3f(a,p1[r],p1[r+1]);b=max3f(b,p1[r+2],p1[r+3]);}
  const float m=max2f(a,b);
  auto rr=__builtin_amdgcn_permlane32_swap(__float_as_uint(m),__float_as_uint(m),false,false);
  return max2f(__uint_as_float(rr[0]),__uint_as_float(rr[1]));
}
__device__ __forceinline__ void pv(f32x16*o,int vb,bf16x8 pa0,bf16x8 pa1,bf16x8 pa2,bf16x8 pa3){
  #pragma unroll
  for(int d0=0;d0<2;++d0){s16x4 lo[4],hi[4];
    #pragma unroll
    for(int ks=0;ks<4;++ks){
      asm volatile("ds_read_b64_tr_b16 %0,%1 offset:%c2":"=&v"(lo[ks]):"v"(vb),"i"(d0*4096+ks*1024):"memory");
      asm volatile("ds_read_b64_tr_b16 %0,%1 offset:%c2":"=&v"(hi[ks]):"v"(vb),"i"(d0*4096+ks*1024+512):"memory");}
    asm volatile("s_waitcnt lgkmcnt(0)":::"memory");SBAR();
    #define PK(k) (bf16x8){lo[k][0],lo[k][1],lo[k][2],lo[k][3],hi[k][0],hi[k][1],hi[k][2],hi[k][3]}
    o[d0]=__builtin_amdgcn_mfma_f32_32x32x16_bf16(pa0,PK(0),o[d0],0,0,0);
    o[d0]=__builtin_amdgcn_mfma_f32_32x32x16_bf16(pa1,PK(1),o[d0],0,0,0);
    o[d0]=__builtin_amdgcn_mfma_f32_32x32x16_bf16(pa2,PK(2),o[d0],0,0,0);
    o[d0]=__builtin_amdgcn_mfma_f32_32x32x16_bf16(pa3,PK(3),o[d0],0,0,0);
    #undef PK
  }
}

#ifndef ATTN_STORE16
#define ATTN_STORE16(p,v) (*(u32x4*)(p)=(v))
#endif
template<int THRL> __device__ __forceinline__ void attn_unit(const bf16*Qu,const bf16*__restrict__ Kh,const bf16*__restrict__ Vh,bf16*Ou,const int NT,char*shm){
  const int tid=threadIdx.x,lane=tid&63,r32=lane&31,hi=lane>>5; const int wid=__builtin_amdgcn_readfirstlane(tid>>6);
  const bf16*Qw=Qu+(long)(wid*QBLK)*QP;
  const unsigned lds0=(unsigned)(uintptr_t)shm;
  float*wsf=(float*)(shm+LDS_WS)+wid*64;
  const bf16*ksrc=Kh+(long)lane*KP+wid*8;
  const bf16*vsrc=Vh+(long)(16*(wid&3)+(lane>>2))*KP+(wid>>2)*32+(lane&3)*8;
  const unsigned kdst=lds0+LDS_K+wid*1024, vdst=lds0+LDS_V+wid*1024;
  #define DMA_K(t,slot) glds16(ksrc+(long)(t)*KVBLK*KP,(unsigned)__builtin_amdgcn_readfirstlane(kdst+(slot)))
  #define DMA_V(t,slot) glds16(vsrc+(long)(t)*KVBLK*KP,(unsigned)__builtin_amdgcn_readfirstlane(vdst+(slot)))
  const int vb0=(int)(lds0+LDS_V)+((lane>>4)&1)*32+(lane&3)*8+(4*hi+((lane&15)>>2))*64;
  const char*Kbase=shm+LDS_K; bf16x8 kf[8];
  const lds_cptr shm3=(lds_cptr)shm; const lds_cptr kp0=shm3+LDS_K+hi*1024+r32*16; const lds_cptr vp0=shm3+LDS_V+((lane>>4)&1)*32+(lane&3)*8+(4*hi+((lane&15)>>2))*64;
  DMA_K(0,0);DMA_V(0,0);DMA_K(1,SLOTB);
  bf16x8 qr[4];
  #pragma unroll
  for(int d0=0;d0<4;++d0)qr[d0]=*reinterpret_cast<const bf16x8*>(&Qw[(long)r32*QP+d0*16+hi*8]);
  float mhat=0.f,l_reg=0.f;f32x16 o[2];o[0]=f32x16{};o[1]=f32x16{};f32x16 negm=f32x16{};asm volatile("":"+v"(negm));
  #define CMASK(P0,P1,t) do{}while(0)
  bool resc=false;
  #define START(P0,P1) do{ const float rm=rowmax(P0,P1); resc=false; \
    { const float dl=rm; mhat=fadd_s(mhat,dl); \
      _Pragma("unroll") for(int r=0;r<16;++r){P0[r]=fsub_s(P0[r],dl);P1[r]=fsub_s(P1[r],dl);} \
      _Pragma("unroll") for(int r=0;r<16;++r)negm[r]=-mhat; asm volatile("":"+v"(negm)); } \
    _Pragma("unroll") for(int r=0;r<16;++r)P0[r]=__builtin_amdgcn_exp2f(P0[r]); }while(0)
  #define RESC() do{ if(resc){ asm volatile("s_waitcnt lgkmcnt(0)":::"memory"); \
      _Pragma("unroll") for(int d_=0;d_<2;++d_) _Pragma("unroll") for(int r=0;r<16;++r)o[d_][r]*=wsf[crow(r,hi)]; } }while(0)
  f32x16 pA0,pA1,pB0,pB1;
  int sl_prev=0,sl_cur=0,sl_next=SLOTB;
  #define ROT() do{sl_prev=sl_cur;sl_cur=sl_next;sl_next=(sl_next==(NSLOT-1)*SLOTB)?0:sl_next+SLOTB;}while(0)
  DMA_K(2,2*SLOTB);
  WAIT_BAR(3);
  qkt(pA0,pA1,Kbase,qr,negm,r32,hi);asm volatile("s_nop 15\n\ts_nop 7":"+v"(pA0),"+v"(pA1));CMASK(pA0,pA1,0);
  START(pA0,pA1);
  _Pragma("unroll") for(int r=0;r<16;++r)pA1[r]=__builtin_amdgcn_exp2f(pA1[r]);
  WAIT_BAR(0);
  DMA_K(3,0);DMA_V(1,SLOTB);
  ROT();
  kload8(kf,kp0+sl_cur);
  WAIT_BAR(2);
  s16x4 vlo[8],vhi[8]; u32x4 pw0,pw1,pw2,pw3;
  #define PKW(P,B) cvtpk_s(P[B],P[B+1])
  #define PAF(k) __builtin_bit_cast(bf16x8,pw##k)
  #define VFR(i) (bf16x8){vlo[i][0],vlo[i][1],vlo[i][2],vlo[i][3],vhi[i][0],vhi[i][1],vhi[i][2],vhi[i][3]}
  #define PIN(x) asm volatile("":"+v"(x))
  #define MX3(a,b,c) __builtin_fmaxf(__builtin_fmaxf((a),(b)),(c))
  #define GAPA(MF,A0,A1,A2,A3,W0,W1,PW) do{ MF; sacc+=A0; sacc+=A1; sacc+=A2; sacc+=A3; PIN(sacc); W0; W1; PIN(PW); SBAR(); }while(0)
  #define EX(v) __builtin_amdgcn_exp2f(v)
  #define GAPB(MF,X,B) do{ MF; X[B]=EX(X[B]); X[B+1]=EX(X[B+1]); X[B+2]=EX(X[B+2]); X[B+3]=EX(X[B+3]); PIN(X); SBAR(); }while(0)
  #define VRD(i) do{ vlo[i]=vtr(vp_+(((i)>>2)*4096+((i)&3)*1024)); vhi[i]=vtr(vp_+(((i)>>2)*4096+((i)&3)*1024+512)); }while(0)
  #define KRD(G,j) do{ if(G){ kload2(kf,kp0+sl_next,j); SBAR(); } }while(0)
  #define STEP(C0,C1,P0,P1,t,GK,GV,GL) do{ SBAR(); \
    const lds_cptr vp_=vp0+sl_prev; \
    VRD(0); SBAR(); float sacc=(P0[0]+P0[1]); \
    GAPA(C0=__builtin_amdgcn_mfma_f32_32x32x16_bf16(kf[0],qr[0],negm,0,0,0), P0[2],P0[3],P0[4],P0[5],     pw0[0]=PKW(P0,0), pw0[1]=PKW(P0,2), pw0); \
    VRD(4); SBAR(); GAPA(C1=__builtin_amdgcn_mfma_f32_32x32x16_bf16(kf[1],qr[0],negm,0,0,0), P0[6],P0[7],P0[8],P0[9],     pw0[2]=PKW(P0,4), pw0[3]=PKW(P0,6), pw0); \
    VRD(1); SBAR(); GAPA(C0=__builtin_amdgcn_mfma_f32_32x32x16_bf16(kf[2],qr[1],C0,0,0,0),   P0[10],P0[11],P0[12],P0[13], pw1[0]=PKW(P0,8), pw1[1]=PKW(P0,10), pw1); \
    VRD(5); SBAR(); GAPA(C1=__builtin_amdgcn_mfma_f32_32x32x16_bf16(kf[3],qr[1],C1,0,0,0),   P0[14],P0[15],P1[0],P1[1],   pw1[2]=PKW(P0,12),pw1[3]=PKW(P0,14), pw1); \
    VRD(2); SBAR(); GAPA(C0=__builtin_amdgcn_mfma_f32_32x32x16_bf16(kf[4],qr[2],C0,0,0,0),   P1[2],P1[3],P1[4],P1[5],     pw2[0]=PKW(P1,0), pw2[1]=PKW(P1,2), pw2); \
    VRD(6); SBAR(); GAPA(C1=__builtin_amdgcn_mfma_f32_32x32x16_bf16(kf[5],qr[2],C1,0,0,0),   P1[6],P1[7],P1[8],P1[9],     pw2[2]=PKW(P1,4), pw2[3]=PKW(P1,6), pw2); \
    VRD(3); SBAR(); GAPA(C0=__builtin_amdgcn_mfma_f32_32x32x16_bf16(kf[6],qr[3],C0,0,0,0),   P1[10],P1[11],P1[12],P1[13], pw3[0]=PKW(P1,8), pw3[1]=PKW(P1,10), pw3); \
    VRD(7); SBAR(); GAPA(C1=__builtin_amdgcn_mfma_f32_32x32x16_bf16(kf[7],qr[3],C1,0,0,0),   P1[14],P1[15],0.f,0.f,       pw3[2]=PKW(P1,12),pw3[3]=PKW(P1,14), pw3); \
    l_reg+=sacc; \
    if(GK){DMA_K((t)+3,sl_cur);} if(GV){DMA_V((t)+1,sl_next);} \
    CMASK(C0,C1,t); \
    { float a=MX3(C0[0],C0[1],C1[0]),b=MX3(C0[2],C0[3],C1[1]); a=MX3(a,C1[2],C1[3]); \
      _Pragma("unroll") for(int r=4;r<16;r+=4){a=MX3(a,C0[r],C0[r+1]);b=MX3(b,C0[r+2],C0[r+3]);a=MX3(a,C1[r],C1[r+1]);b=MX3(b,C1[r+2],C1[r+3]);} \
      float rm=__builtin_fmaxf(a,b); { auto rr=__builtin_amdgcn_permlane32_swap(__float_as_uint(rm),__float_as_uint(rm),false,false); rm=__builtin_fmaxf(__uint_as_float(rr[0]),__uint_as_float(rr[1])); } \
      resc=false; \
      if(__builtin_expect(__any(rm>(float)THRL),0)){ const float dl=__builtin_fmaxf(rm,0.f); mhat+=dl; \
        _Pragma("unroll") for(int r=0;r<16;++r){C0[r]-=dl;C1[r]-=dl;} \
        _Pragma("unroll") for(int r=0;r<16;++r)negm[r]=-mhat; asm volatile("":"+v"(negm)); \
        const float f=__builtin_amdgcn_exp2f(-dl); l_reg*=f; if(hi==0)wsf[r32]=f; resc=true; } } \
    SBAR(); \
    GAPB(o[0]=__builtin_amdgcn_mfma_f32_32x32x16_bf16(PAF(0),VFR(0),o[0],0,0,0), C0,0); \
    GAPB(o[1]=__builtin_amdgcn_mfma_f32_32x32x16_bf16(PAF(0),VFR(4),o[1],0,0,0), C0,4); \
    KRD(GL,0); GAPB(o[0]=__builtin_amdgcn_mfma_f32_32x32x16_bf16(PAF(1),VFR(1),o[0],0,0,0), C0,8); \
    KRD(GL,1); GAPB(o[1]=__builtin_amdgcn_mfma_f32_32x32x16_bf16(PAF(1),VFR(5),o[1],0,0,0), C0,12); \
    KRD(GL,2); GAPB(o[0]=__builtin_amdgcn_mfma_f32_32x32x16_bf16(PAF(2),VFR(2),o[0],0,0,0), C1,0); \
    KRD(GL,3); GAPB(o[1]=__builtin_amdgcn_mfma_f32_32x32x16_bf16(PAF(2),VFR(6),o[1],0,0,0), C1,4); \
    GAPB(o[0]=__builtin_amdgcn_mfma_f32_32x32x16_bf16(PAF(3),VFR(3),o[0],0,0,0), C1,8); \
    GAPB(o[1]=__builtin_amdgcn_mfma_f32_32x32x16_bf16(PAF(3),VFR(7),o[1],0,0,0), C1,12); \
    }while(0)
  int t=1;
  #undef CMASK
  #define CMASK(P0,P1,t) do{}while(0)
  for(;t+5<NT;t+=2){
    STEP(pB0,pB1,pA0,pA1,t,true,true,true);     WAIT_BAR(2); RESC(); ROT();
    STEP(pA0,pA1,pB0,pB1,t+1,true,true,true);   WAIT_BAR(2); RESC(); ROT();
  }
  #undef CMASK
  #define CMASK(P0,P1,t) do{}while(0)
  #define ENDW(tt) do{ if((tt)+3<NT){WAIT_BAR(2);} else if((tt)+2<NT){WAIT_BAR(1);} else {WAIT_BAR(0);} }while(0)
  for(;t+1<NT;t+=2){
    STEP(pB0,pB1,pA0,pA1,t,(t+3<NT),(t+1<NT),(t+1<NT));       ENDW(t);   RESC(); ROT();
    STEP(pA0,pA1,pB0,pB1,t+1,(t+4<NT),(t+2<NT),(t+2<NT));     ENDW(t+1); RESC(); ROT();
  }
  STEP(pB0,pB1,pA0,pA1,NT-1,false,false,false); RESC();
  { float sacc=pB0[0]+pB0[1]; _Pragma("unroll") for(int r=2;r<16;++r)sacc+=pB0[r]; _Pragma("unroll") for(int r=0;r<16;++r)sacc+=pB1[r]; l_reg+=sacc;
    pw0=(u32x4){PKW(pB0,0),PKW(pB0,2),PKW(pB0,4),PKW(pB0,6)};pw1=(u32x4){PKW(pB0,8),PKW(pB0,10),PKW(pB0,12),PKW(pB0,14)};pw2=(u32x4){PKW(pB1,0),PKW(pB1,2),PKW(pB1,4),PKW(pB1,6)};pw3=(u32x4){PKW(pB1,8),PKW(pB1,10),PKW(pB1,12),PKW(pB1,14)};
    SBAR(); pv(o,vb0+sl_cur,PAF(0),PAF(1),PAF(2),PAF(3)); }
  #undef PKW
  #undef PAF
  #undef VFR
  #undef PIN
  #undef MX3
  #undef GAPA
  #undef GAPB
  #undef EX
  #undef VRD
  #undef KRD
  #undef STEP
  #undef ENDW
  {auto rr=__builtin_amdgcn_permlane32_swap(__float_as_uint(l_reg),__float_as_uint(l_reg),false,false);l_reg=__uint_as_float(rr[0])+__uint_as_float(rr[1]);}
  if(hi==0)wsf[32+r32]=l_reg;asm volatile("s_waitcnt lgkmcnt(0)":::"memory");
  float rli[16];
  #pragma unroll
  for(int r=0;r<16;++r)rli[r]=__builtin_amdgcn_rcpf(wsf[32+crow(r,hi)]);
  bf16*Ow=Ou+(long)(wid*QBLK)*QP;
  { bf16*stg=(bf16*)(shm+LDS_OST)+wid*2048;
    #pragma unroll
    for(int r=0;r<16;++r){const int orow=crow(r,hi);
      #pragma unroll
      for(int d0=0;d0<2;++d0)stg[orow*64+d0*32+r32]=__float2bfloat16(o[d0][r]*rli[r]);}
    asm volatile("s_waitcnt lgkmcnt(0)":::"memory");
    #pragma unroll
    for(int i=0;i<4;++i){const int row=i*8+(lane>>3),ch=lane&7; const u32x4 v=*(const u32x4*)(stg+row*64+ch*8); ATTN_STORE16(Ow+(long)row*QP+ch*8,v);} }
  asm volatile("s_waitcnt lgkmcnt(0)\n\ts_barrier":::"memory");
  #undef DMA_K
  #undef DMA_V
  #undef CMASK
  #undef START
  #undef RESC
  #undef ROT
}
constexpr int ATTN_LDS_BYTES=LDS_BYTES;
#undef SBAR
#undef WAIT_BAR
}

template <bool WCTX>
__device__ __forceinline__ void phase_attn_fast(Frame& F, char* ldsg) {
    typedef attn_body::bf16 abf;
    const abf* Q = (const abf*)(F.ws + WS_QB); const abf* K = (const abf*)(F.ws + WS_KB); const abf* V = (const abf*)(F.ws + WS_VB); abf* O = (abf*)(F.ws + WS_Z);
    const int vcu = (F.G % 8 == 0) ? (F.blk % 8) * (F.G / 8) + F.blk / 8 : F.blk;
    const int nunits = WCTX ? 1024 + 128 : 1024;
    for (int u = vcu; u < nunits; u += F.G) {
        int h, kvh, qrow0, kv0, NT;
        if (u < 1024) { const int grp = u >> 5, b = grp >> 2; kvh = grp & 3; const int qb = (u >> 2) & 7; h = kvh * 4 + (u & 3); qrow0 = TC + b * SEQ + qb * 256; kv0 = b * KVLEN; NT = KVLEN / 64; }
        else { const int u2 = u - 1024, b = u2 >> 4; h = u2 & 15; kvh = h >> 2; qrow0 = b * CTX; kv0 = b * KVLEN + SEQ; NT = CTX / 64; }
        attn_body::attn_unit<8>(Q + (size_t)qrow0 * 1024 + h * 64, K + (size_t)kv0 * 256 + kvh * 64, V + (size_t)kv0 * 256 + kvh * 64, O + (size_t)qrow0 * 1024 + h * 64, NT, ldsg + RING_OFF);
    }
}

constexpr int S5_BU_STRIDE = 132;
constexpr int S5_X_STRIDE = 136;
constexpr int S5_BU_BYTES = 16 * S5_BU_STRIDE * 4, S5_X_BYTES = 16 * S5_X_STRIDE * 2, S5_Y_BYTES = 2 * 64 * 16, S5_U_BYTES = 64 * 16;
constexpr int S5_ITEM_LDS = S5_BU_BYTES + S5_X_BYTES + 2 * S5_Y_BYTES + 4 * S5_U_BYTES;
constexpr int S5_NT = (CTX + SEQ) / 32;
static_assert(4 * S5_ITEM_LDS <= RING_BYTES, "S5 LDS");
#define S5_BAR() do { asm volatile("s_waitcnt lgkmcnt(0)" ::: "memory"); __builtin_amdgcn_s_barrier(); asm volatile("" ::: "memory"); } while (0)
__device__ __forceinline__ f32x2 cmul(f32x2 a, f32x2 b) { return (f32x2){a.x * b.x - a.y * b.y, a.x * b.y + a.y * b.x}; }

template <int J, bool WCTX>
__device__ __forceinline__ void phase_s5_fast(Frame& F) {
    const int lane = F.lane, w = F.wave;
    const bool helper = w >= 4;
    const int iw = w & 3, pairi = iw >> 1, dir = iw & 1;
    const int tq = lane & 15, kg = lane >> 4;
    const bf16* hb = (const bf16*)(F.ws + WS_H); float* ypart = (float*)(F.ws + WS_YSUM); bf16* zb = (bf16*)(F.ws + WS_Z);
    LAS unsigned char* base = F.lds + iw * S5_ITEM_LDS;
    LAS float* BU = (LAS float*)base;
    LAS bf16* XS = (LAS bf16*)(base + S5_BU_BYTES);
    LAS f32x4* YL = (LAS f32x4*)(base + S5_BU_BYTES + S5_X_BYTES);
    LAS v4u* UL = (LAS v4u*)(base + S5_BU_BYTES + S5_X_BYTES + 2 * S5_Y_BYTES);
    for (int it0 = F.blk * 2; it0 < NB * 64; it0 += F.G * 2) {
        const int it = it0 + pairi, b = it >> 6, g = it & 63;
        const int gi = (J * 2 + dir) * 64 + g;
        LAS v4u* TAB = (LAS v4u*)(F.lds);
        LAS f32x2* CST = (LAS f32x2*)(F.lds + 65536);
        LAS float* KMS = (LAS float*)(F.lds + 65536 + 6144);
        static_assert(65536 + 6144 + 8192 <= 4 * S5_ITEM_LDS, "S5 set-up scratch inside the item buffers");
        if (F.tid < 256) { const int i = F.tid >> 6, p = F.tid & 63; const int git = (J * 2 + (i & 1)) * 64 + ((it0 + (i >> 1)) & 63);
            const float dt = expf(F.in[IN_S5LOG][git]);
            const float lr = F.in[IN_S5LRE][git * 64 + p], li = F.in[IN_S5LIM][git * 64 + p]; const float mag = expf(lr * dt); double sd, cd; sincos_d((double)(li * dt), sd, cd);
            const float ar = mag * (float)cd, ai = mag * (float)sd, den = lr * lr + li * li, nr = ar - 1.f, ni = ai;
            const f32x2 a = (f32x2){ar, ai};
            CST[(i * 3 + 0) * 64 + p] = a; CST[(i * 3 + 1) * 64 + p] = cmul(a, a); CST[(i * 3 + 2) * 64 + p] = (f32x2){(nr * lr + ni * li) / den, (ni * lr - nr * li) / den}; }
        __syncthreads();
        for (int f = F.tid; f < 4 * 16 * 64; f += NTHR) {
            const int i = f >> 10, fi = (f >> 6) & 15, ln = f & 63, ltq = ln & 15, lkg = ln >> 4; const int git = (J * 2 + (i & 1)) * 64 + ((it0 + (i >> 1)) & 63);
            unsigned o[4];
            if (fi < 8) {
                const int n = 16 * fi + ltq, p = n >> 1, ri = n & 1;
                f32x2 co = CST[(i * 3 + 2) * 64 + p]; if ((lkg >> 1) == 0) co = cmul(co, CST[(i * 3 + 0) * 64 + p]);
                const float* brp = F.in[IN_S5BRE] + (size_t)git * 1024 + p * 16 + 8 * (lkg & 1); const float* bip = F.in[IN_S5BIM] + (size_t)git * 1024 + p * 16 + 8 * (lkg & 1);
#pragma unroll
                for (int q = 0; q < 4; ++q) { const f32x2 v0 = cmul(co, (f32x2){brp[2 * q], bip[2 * q]}), v1 = cmul(co, (f32x2){brp[2 * q + 1], bip[2 * q + 1]}); o[q] = pk2(ri ? v0.y : v0.x, ri ? v1.y : v1.x); }
            } else {
                const int tau = (fi - 8) >> 2, ks = fi & 3, p0 = 16 * ks + 4 * lkg;
                const float* crp = F.in[IN_S5CRE] + (size_t)git * 1024 + ltq * 64 + p0; const float* cip = F.in[IN_S5CIM] + (size_t)git * 1024 + ltq * 64 + p0;
#pragma unroll
                for (int q = 0; q < 4; ++q) { const f32x2 v = cmul((f32x2){crp[q], cip[q]}, CST[(i * 3 + tau) * 64 + p0 + q]); o[q] = pk2(v.x, -v.y); }
            }
            TAB[f] = (v4u){o[0], o[1], o[2], o[3]};
        }
        __syncthreads();
        if (helper) {
            const f32x4 d4 = *(const f32x4*)(F.in[IN_S5D] + J * D + g * 16 + 4 * kg);
            v4u ub[4]; f32x4 yoA0, yoA1, yoB0, yoB1;
#pragma unroll
            for (int k = 0; k < 4; ++k) ub[k] = *(const v4u*)(hb + (size_t)seq_row(b, dir, 32 * k + 2 * tq + (kg >> 1)) * D + g * 16 + 8 * (kg & 1));
            yoA0 = (f32x4){0.f, 0.f, 0.f, 0.f}; yoA1 = yoA0; yoB0 = yoA0; yoB1 = yoA0;
            S5_BAR();
#pragma unroll 4
            for (int T = -1; T < S5_NT + 3; ++T) {
                const int e = T - 1, d = T + 1;
                const bool e_ok = (e >= 0) && (e < S5_NT) && (WCTX || e >= 8);
                const bool e_second = (e < 8) ? (e >= 4) : (e >= 40);
                if (d >= 0 && d < S5_NT) UL[(d & 3) * 64 + lane] = ub[d & 3];
                if (e_ok) {
#pragma unroll
                    for (int tau = 0; tau < 2; ++tau) {
                        const size_t idx = (size_t)seq_row(b, dir, 32 * e + 2 * tq + tau) * D + g * 16 + 4 * kg;
                        const f32x4 y = YL[((e & 1) * 2 + tau) * 64 + lane];
                        if (!e_second) *(f32x4*)(ypart + idx) = y;
                        else {
                            f32x4 yo = (e & 1) ? (tau ? yoB1 : yoB0) : (tau ? yoA1 : yoA0);
                            if (e == 4 || e == 40) yo = *(const f32x4*)(ypart + idx);
                            const v2u hw = *(const v2u*)(hb + idx);
                            f32x4 v = y + yo; v.x += d4.x * bflo(hw.x); v.y += d4.y * bfhi(hw.x); v.z += d4.z * bflo(hw.y); v.w += d4.w * bfhi(hw.y);
                            v2u zo; zo.x = pk2(gelu_tanh(v.x), gelu_tanh(v.y)); zo.y = pk2(gelu_tanh(v.z), gelu_tanh(v.w));
                            *(v2u*)(zb + idx) = zo;
                        }
                    }
                }
                { const int e1 = e + 1; const bool e1_ok = (e1 >= 0) && (e1 < S5_NT) && (WCTX || e1 >= 8); const bool e1_second = (e1 < 8) ? (e1 >= 4) : (e1 >= 40);
                  if (e1_ok && e1_second && e1 != 4 && e1 != 40) {
                      const f32x4 l0 = *(const f32x4*)(ypart + (size_t)seq_row(b, dir, 32 * e1 + 2 * tq) * D + g * 16 + 4 * kg), l1 = *(const f32x4*)(ypart + (size_t)seq_row(b, dir, 32 * e1 + 2 * tq + 1) * D + g * 16 + 4 * kg);
                      if (e1 & 1) { yoB0 = l0; yoB1 = l1; } else { yoA0 = l0; yoA1 = l1; }
                  } }
                if (d >= 0 && d + 4 < S5_NT) ub[d & 3] = *(const v4u*)(hb + (size_t)seq_row(b, dir, 32 * (d + 4) + 2 * tq + (kg >> 1)) * D + g * 16 + 8 * (kg & 1));
                if (e == 3 || e == 39) asm volatile("s_waitcnt vmcnt(0)" ::: "memory");
                S5_BAR();
            }
        } else {
            const float* cre = F.in[IN_S5CRE] + (size_t)gi * 1024; const float* cim = F.in[IN_S5CIM] + (size_t)gi * 1024;
            bf16x8 wf[8], vkf[2][5];
#pragma unroll
            for (int rt = 0; rt < 8; ++rt) wf[rt] = __builtin_bit_cast(bf16x8, TAB[(iw * 16 + rt) * 64 + lane]);
#pragma unroll
            for (int tau = 0; tau < 2; ++tau)
#pragma unroll
                for (int ks = 0; ks < 4; ++ks) vkf[tau][ks] = __builtin_bit_cast(bf16x8, TAB[(iw * 16 + 8 + tau * 4 + ks) * 64 + lane]);
            const f32x2 a2 = CST[(iw * 3 + 1) * 64 + lane];
            { LAS float* KM = KMS + iw * 512;
              const LAS bf16* W2T = (const LAS bf16*)(TAB + (iw * 16) * 64);
#pragma unroll
              for (int e = 0; e < 2; ++e) {
                  f32x4 acc = (f32x4){0.f, 0.f, 0.f, 0.f};
#pragma unroll
                  for (int ks = 0; ks < 4; ++ks) {
                      bf16x8 cfr, fr;
                      const int p0 = 16 * ks + 4 * kg;
                      const f32x4 cr = *(const f32x4*)(cre + tq * 64 + p0), ci = *(const f32x4*)(cim + tq * 64 + p0);
                      cfr[0] = (short)f2bf(cr.x); cfr[1] = (short)f2bf(-ci.x); cfr[2] = (short)f2bf(cr.y); cfr[3] = (short)f2bf(-ci.y); cfr[4] = (short)f2bf(cr.z); cfr[5] = (short)f2bf(-ci.z); cfr[6] = (short)f2bf(cr.w); cfr[7] = (short)f2bf(-ci.w);
#pragma unroll
                      for (int jj = 0; jj < 8; ++jj) { const int n = 32 * ks + 8 * kg + jj, k = 16 * (1 - e) + tq; fr[jj] = (short)W2T[(((n >> 4) * 64) + (n & 15) + 16 * (k >> 3)) * 8 + (k & 7)]; }
                      acc = __builtin_amdgcn_mfma_f32_16x16x32_bf16(cfr, fr, acc, 0, 0, 0);
                  }
#pragma unroll
                  for (int r = 0; r < 4; ++r) KM[(e * 16 + 4 * kg + r) * 16 + tq] = acc[r];
              }
#pragma unroll
              for (int tau = 0; tau < 2; ++tau) { const int tp = kg >> 1; bf16x8 fr;
#pragma unroll
                  for (int jj = 0; jj < 8; ++jj) { const float v = (tp <= tau) ? KM[((tau - tp) * 16 + tq) * 16 + 8 * (kg & 1) + jj] : 0.f; fr[jj] = (short)f2bf(v); }
                  vkf[tau][4] = fr; } }
            asm volatile("s_waitcnt vmcnt(0) lgkmcnt(0)" ::: "memory");
            f32x2 x = (f32x2){0.f, 0.f};
            const f32x2 a2re = (f32x2){a2.x, a2.x}, a2im = (f32x2){-a2.y, a2.y};
            S5_BAR();
            for (int T = -1; T < S5_NT + 3; ++T) {
                if (T >= 0 && T < S5_NT) {
                    const bf16x8 uf = __builtin_bit_cast(bf16x8, UL[(T & 3) * 64 + lane]);
#pragma unroll
                    for (int rt = 0; rt < 8; ++rt) {
                        const f32x4 dacc = __builtin_amdgcn_mfma_f32_16x16x32_bf16(wf[rt], uf, (f32x4){0.f, 0.f, 0.f, 0.f}, 0, 0, 0);
                        *(LAS f32x4*)(BU + tq * S5_BU_STRIDE + 16 * rt + 4 * kg) = dacc;
                    }
                    f32x2 buv[16]; unsigned xw[16];
#pragma unroll
                    for (int t = 0; t < 16; ++t) buv[t] = *(const LAS f32x2*)(BU + t * S5_BU_STRIDE + 2 * lane);
#pragma unroll
                    for (int t = 0; t < 16; ++t) { xw[t] = pk2(x.x, x.y); const f32x2 xs = (f32x2){x.y, x.x}; x = a2re * x + (a2im * xs + buv[t]); }
                    if (WCTX || T >= 8) {
#pragma unroll
                        for (int t = 0; t < 16; ++t) *(LAS unsigned*)(XS + t * S5_X_STRIDE + 2 * lane) = xw[t];
                        bf16x8 xf[4];
#pragma unroll
                        for (int ks = 0; ks < 4; ++ks) xf[ks] = *(const LAS bf16x8*)(XS + tq * S5_X_STRIDE + 32 * ks + 8 * kg);
#pragma unroll
                        for (int tau = 0; tau < 2; ++tau) {
                            f32x4 y = __builtin_amdgcn_mfma_f32_16x16x32_bf16(vkf[tau][4], uf, (f32x4){0.f, 0.f, 0.f, 0.f}, 0, 0, 0);
#pragma unroll
                            for (int ks = 0; ks < 4; ++ks) y = __builtin_amdgcn_mfma_f32_16x16x32_bf16(vkf[tau][ks], xf[ks], y, 0, 0, 0);
                            YL[((T & 1) * 2 + tau) * 64 + lane] = y;
                        }
                    }
                }
                S5_BAR();
            }
        }
        __syncthreads();
    }
}

constexpr size_t WS_MCT = WS_MHS;
constexpr size_t WS_MN = WS_MG + 2359296;
constexpr size_t WS_MSC = WS_MN + 589824;
static_assert(WS_MSC + 2304 * 16 <= WS_MHS, "mLSTM small tables");
constexpr int ML_TS = 136;
constexpr int ML_DS = 72;

template <bool MAX>
__device__ __forceinline__ void scan128(LAS float* a, int lane) {
    const float v0 = a[2 * lane], v1 = a[2 * lane + 1];
    const float s = MAX ? fmaxf(v0, v1) : v0 + v1;
    float inc = s;
#pragma unroll
    for (int o = 1; o < 64; o <<= 1) { const float t = __shfl_up(inc, o); if (lane >= o) inc = MAX ? fmaxf(inc, t) : inc + t; }
    float exc = __shfl_up(inc, 1); if (lane == 0) exc = MAX ? -INFINITY : 0.f;
    a[2 * lane] = MAX ? fmaxf(exc, v0) : exc + v0; a[2 * lane + 1] = inc;
}

__device__ __forceinline__ void phase_ml_states(Frame& F) {
    const int tid = F.tid, lane = F.lane, w = F.wave, tq = lane & 15, kg = lane >> 4;
    const bf16* kb = (const bf16*)(F.ws + WS_MK); const bf16* vb = (const bf16*)(F.ws + WS_MV); const float* gb = (const float*)(F.ws + WS_MG);
    float* cT = (float*)(F.ws + WS_MCT); float* nl = (float*)(F.ws + WS_MN); float* sc = (float*)(F.ws + WS_MSC);
    LAS bf16* KeT = (LAS bf16*)(F.lds);
    LAS bf16* VT = (LAS bf16*)(F.lds + 64 * ML_TS * 2);
    LAS float* cumS = (LAS float*)(F.lds + 192 * ML_TS * 2);
    LAS float* igS = cumS + 128; LAS float* ewS = igS + 128; LAS float* red = ewS + 128;
    for (int us = F.blk; us < 2304; us += F.G) {
        const int jc = us % 18, bhd = us / 18, dir = bhd & 1, hd = (bhd >> 1) & 7, b = bhd >> 4;
        if (tid < 128) { const int r = seq_row(b, dir, 128 * jc + tid); igS[tid] = gb[(size_t)r * 32 + dir * 16 + hd]; cumS[tid] = log_sigmoidf_(gb[(size_t)r * 32 + dir * 16 + 8 + hd]); }
        __syncthreads();
        if (w == 0) {
            scan128<false>(cumS, lane);
            const float total = __shfl(cumS[2 * lane + 1], 63);
            const float w0 = total - cumS[2 * lane] + igS[2 * lane], w1 = total - cumS[2 * lane + 1] + igS[2 * lane + 1];
            const float ml = wave_max(fmaxf(w0, w1));
            ewS[2 * lane] = __expf(w0 - ml); ewS[2 * lane + 1] = __expf(w1 - ml);
            if (lane == 0) { sc[(size_t)us * 4] = total; sc[(size_t)us * 4 + 1] = ml; }
        }
        __syncthreads();
        { const int i = tid & 127, c = tid >> 7; const int r = seq_row(b, dir, 128 * jc + i); const float e = ewS[i];
#pragma unroll
          for (int h2 = 0; h2 < 2; ++h2) { const v4u kw = *(const v4u*)(kb + (size_t)r * 512 + hd * 64 + 16 * c + 8 * h2);
              const float kv[8] = {bflo(kw.x), bfhi(kw.x), bflo(kw.y), bfhi(kw.y), bflo(kw.z), bfhi(kw.z), bflo(kw.w), bfhi(kw.w)};
#pragma unroll
              for (int jj = 0; jj < 8; ++jj) KeT[(16 * c + 8 * h2 + jj) * ML_TS + i] = (bf16)f2bf(kv[jj] * e); }
#pragma unroll
          for (int h4 = 0; h4 < 4; ++h4) { const v4u vw = *(const v4u*)(vb + (size_t)r * 1024 + hd * 128 + 32 * c + 8 * h4);
              const unsigned vv[4] = {vw.x, vw.y, vw.z, vw.w};
#pragma unroll
              for (int jj = 0; jj < 8; ++jj) VT[(32 * c + 8 * h4 + jj) * ML_TS + i] = (bf16)((jj & 1) ? (vv[jj >> 1] >> 16) : (vv[jj >> 1] & 0xffffu)); } }
        __syncthreads();
#pragma unroll
        for (int dt = 0; dt < 4; ++dt) {
            f32x4 acc = (f32x4){0.f, 0.f, 0.f, 0.f};
#pragma unroll
            for (int ks = 0; ks < 4; ++ks) {
                const bf16x8 af = *(const LAS bf16x8*)(VT + (16 * w + tq) * ML_TS + 32 * ks + 8 * kg);
                const bf16x8 bfr = *(const LAS bf16x8*)(KeT + (16 * dt + tq) * ML_TS + 32 * ks + 8 * kg);
                acc = __builtin_amdgcn_mfma_f32_16x16x32_bf16(af, bfr, acc, 0, 0, 0);
            }
#pragma unroll
            for (int r = 0; r < 4; ++r) cT[(size_t)us * 8192 + (16 * w + 4 * kg + r) * 64 + 16 * dt + tq] = acc[r];
        }
        if (tid < 64) { float s = 0.f;
#pragma unroll
            for (int c8 = 0; c8 < 16; ++c8) { const v4u q = *(const LAS v4u*)(KeT + tid * ML_TS + 8 * c8); s += bflo(q.x) + bfhi(q.x) + bflo(q.y) + bfhi(q.y) + bflo(q.z) + bfhi(q.z) + bflo(q.w) + bfhi(q.w); }
            nl[(size_t)us * 64 + tid] = s; }
        __syncthreads();
    }
}

__device__ __forceinline__ void phase_ml_scan(Frame& F, const int skip = 0) {
    const int tid = F.tid;
    float* cT = (float*)(F.ws + WS_MCT); float* nl = (float*)(F.ws + WS_MN); float* sc = (float*)(F.ws + WS_MSC);
    for (int wi = F.blk; wi < 256; wi += F.G) {
        const int sq = wi >> 1, half = wi & 1; const bool don = (half == 0 && tid < 64);
        const size_t e0 = (size_t)half * 4096 + (size_t)tid * 8;
        f32x4 c0 = (f32x4){0.f, 0.f, 0.f, 0.f}, c1 = c0; float nn = 0.f, m = 0.f;
        size_t us = (size_t)sq * 18;
        f32x4 l0 = *(const f32x4*)(cT + us * 8192 + e0), l1 = *(const f32x4*)(cT + us * 8192 + e0 + 4);
        float ln = don ? nl[us * 64 + tid] : 0.f, tot = sc[us * 4], ml = sc[us * 4 + 1];
        for (int j = 0; j < 18; ++j, ++us) {
            const f32x4 a0 = l0, a1 = l1; const float an = ln, atot = tot, aml = ml;
            if (j + 1 < 18) { l0 = *(const f32x4*)(cT + (us + 1) * 8192 + e0); l1 = *(const f32x4*)(cT + (us + 1) * 8192 + e0 + 4); ln = don ? nl[(us + 1) * 64 + tid] : 0.f; tot = sc[(us + 1) * 4]; ml = sc[(us + 1) * 4 + 1]; }
            if (!skip) { *(f32x4*)(cT + us * 8192 + e0) = c0; *(f32x4*)(cT + us * 8192 + e0 + 4) = c1;
            if (don) nl[us * 64 + tid] = nn;
            if (half == 0 && tid == 0) sc[us * 4 + 2] = m; }
            const float mn = fmaxf(atot + m, aml), fa = __expf(atot + m - mn), fb = __expf(aml - mn);
            c0 = c0 * fa + a0 * fb; c1 = c1 * fa + a1 * fb; nn = nn * fa + an * fb; m = mn;
        }
    }
}

struct M3Regs { float gi, gf, n0v, m00, m01; v4u q[2], k[2], v[4]; };
__device__ __forceinline__ void m3_load(M3Regs& R, Frame& F, int u, int tid) {
    const bf16* kb = (const bf16*)(F.ws + WS_MK); const bf16* vb = (const bf16*)(F.ws + WS_MV); const bf16* qb = (const bf16*)(F.ws + WS_MQ);
    const float* gb = (const float*)(F.ws + WS_MG); const float* cT = (const float*)(F.ws + WS_MCT); const float* nl = (const float*)(F.ws + WS_MN); const float* sc = (const float*)(F.ws + WS_MSC);
    const int jo = u % 18, bh = u / 18, hd = bh & 7, b = bh >> 3;
    const int row0 = (jo < 2) ? b * CTX + 128 * jo : TC + b * SEQ + 128 * (jo - 2);
    const int jc1 = (jo < 2) ? 1 - jo : 19 - jo;
    const size_t us0 = (size_t)((b * 8 + hd) * 2 + 0) * 18 + jo, us1 = (size_t)((b * 8 + hd) * 2 + 1) * 18 + jc1;
    R.m00 = sc[us0 * 4 + 2]; R.m01 = sc[us1 * 4 + 2];
    R.gi = 0.f; R.gf = 0.f; R.n0v = 0.f;
    if (tid < 256) { const int dd = tid >> 7, sp = tid & 127; const int r = row0 + (dd ? 127 - sp : sp); R.gi = gb[(size_t)r * 32 + dd * 16 + hd]; R.gf = gb[(size_t)r * 32 + dd * 16 + 8 + hd]; }
    { const int i = tid & 127, c = tid >> 7; const int r = row0 + i;
#pragma unroll
      for (int h2 = 0; h2 < 2; ++h2) { R.q[h2] = *(const v4u*)(qb + (size_t)r * 512 + hd * 64 + 16 * c + 8 * h2); R.k[h2] = *(const v4u*)(kb + (size_t)r * 512 + hd * 64 + 16 * c + 8 * h2); } }
    { const int tp = tid & 63, c8 = tid >> 6;
#pragma unroll
      for (int tk = 0; tk < 2; ++tk)
#pragma unroll
          for (int h2 = 0; h2 < 2; ++h2) R.v[2 * tk + h2] = *(const v4u*)(vb + (size_t)(row0 + 2 * tp + tk) * 1024 + hd * 128 + 16 * c8 + 8 * h2); }
    if (tid < 128) R.n0v = nl[((tid >> 6) ? us1 : us0) * 64 + (tid & 63)];
}
__device__ __forceinline__ void phase_ml_out(Frame& F) {
    const int tid = F.tid, lane = F.lane, w = F.wave, tq = lane & 15, kg = lane >> 4;
    const bf16* ob = (const bf16*)(F.ws + WS_MO); bf16* zb = (bf16*)(F.ws + WS_Z);
    LAS bf16* QL = (LAS bf16*)(F.lds);
    LAS bf16* KL = (LAS bf16*)(F.lds + 18432);
    LAS bf16* SwL = (LAS bf16*)(F.lds + w * (16 * ML_TS * 2));
    LAS bf16* VT = (LAS bf16*)(F.lds + 36864);
    LAS bf16* C0T = (LAS bf16*)(F.lds + 36864 + 128 * ML_TS * 2);
    LAS float* GT = (LAS float*)(F.lds + 36864 + 128 * ML_TS * 2 + 2 * 144 * ML_DS * 2);
    static_assert(36864 + 128 * ML_TS * 2 + 2 * 144 * ML_DS * 2 + 2 * 3 * 128 * 4 <= RING_BYTES, "M3 LDS");
    for (int i = tid; i < 2 * 16 * ML_DS; i += NTHR) { const int dd = i / (16 * ML_DS), ii = i % (16 * ML_DS); C0T[dd * 144 * ML_DS + 128 * ML_DS + ii] = (bf16)0u; }
    constexpr int NU = NB * 8 * 18;
    M3Regs R;
    if (F.blk < NU) m3_load(R, F, F.blk, tid);
    __syncthreads();
    for (int u = F.blk; u < NU; u += F.G) {
        const int jo = u % 18, bh = u / 18, hd = bh & 7, b = bh >> 3;
        const int row0 = (jo < 2) ? b * CTX + 128 * jo : TC + b * SEQ + 128 * (jo - 2);
        const float m00 = R.m00, m01 = R.m01;
        if (tid < 256) { const int dd = tid >> 7, sp = tid & 127; GT[dd * 384 + sp] = R.gi; GT[dd * 384 + 256 + sp] = log_sigmoidf_(R.gf); }
        { const int i = tid & 127, c = tid >> 7;
#pragma unroll
          for (int h2 = 0; h2 < 2; ++h2) { *(LAS v4u*)(QL + i * ML_DS + 16 * c + 8 * h2) = R.q[h2]; *(LAS v4u*)(KL + i * ML_DS + 16 * c + 8 * h2) = R.k[h2]; } }
        { const int tp = tid & 63, c8 = tid >> 6;
#pragma unroll
          for (int h2 = 0; h2 < 2; ++h2) { const v4u a = R.v[h2], bq = R.v[2 + h2]; const unsigned av[4] = {a.x, a.y, a.z, a.w}, bv[4] = {bq.x, bq.y, bq.z, bq.w};
#pragma unroll
              for (int jj = 0; jj < 8; ++jj) { const unsigned lo = (jj & 1) ? (av[jj >> 1] >> 16) : (av[jj >> 1] & 0xffffu), hi = (jj & 1) ? (bv[jj >> 1] & 0xffff0000u) : (bv[jj >> 1] << 16);
                  *(LAS unsigned*)(VT + (16 * c8 + 8 * h2 + jj) * ML_TS + 2 * tp) = lo | hi; } } }
        { const float* cT = (const float*)(F.ws + WS_MCT); const int jc1 = (jo < 2) ? 1 - jo : 19 - jo;
          const size_t us0 = (size_t)((b * 8 + hd) * 2 + 0) * 18 + jo, us1 = (size_t)((b * 8 + hd) * 2 + 1) * 18 + jc1;
#pragma unroll
          for (int dd = 0; dd < 2; ++dd) { const size_t us = dd ? us1 : us0; const int jv = tid >> 2, dq = (tid & 3) * 16; const float* src = cT + us * 8192 + jv * 64 + dq;
#pragma unroll
              for (int h2 = 0; h2 < 2; ++h2) { const f32x4 a = *(const f32x4*)(src + 8 * h2), bq = *(const f32x4*)(src + 8 * h2 + 4);
                  v4u o; o.x = pk2(a.x, a.y); o.y = pk2(a.z, a.w); o.z = pk2(bq.x, bq.y); o.w = pk2(bq.z, bq.w);
                  *(LAS v4u*)(C0T + dd * 144 * ML_DS + jv * ML_DS + dq + 8 * h2) = o; } } }
        if (tid < 128) C0T[(tid >> 6) * 144 * ML_DS + 128 * ML_DS + (tid & 63)] = (bf16)f2bf(R.n0v);
        __syncthreads();
        if (u + F.G < NU) m3_load(R, F, u + F.G, tid);
        if (w < 2) {
            LAS float* gS = GT + w * 384; LAS float* mmS = gS + 128; LAS float* cumS = gS + 256; const float m0 = w ? m01 : m00;
            scan128<false>(cumS, lane);
            const float g0 = gS[2 * lane] - cumS[2 * lane], g1 = gS[2 * lane + 1] - cumS[2 * lane + 1];
            gS[2 * lane] = g0; gS[2 * lane + 1] = g1; mmS[2 * lane] = g0; mmS[2 * lane + 1] = g1;
            scan128<true>(mmS, lane);
            mmS[2 * lane] = fmaxf(mmS[2 * lane], m0); mmS[2 * lane + 1] = fmaxf(mmS[2 * lane + 1], m0);
        }
        __syncthreads();
        bf16x8 qf[2];
#pragma unroll
        for (int ks = 0; ks < 2; ++ks) qf[ks] = *(const LAS bf16x8*)(QL + (16 * w + tq) * ML_DS + 32 * ks + 8 * kg);
        float mm0r[4], mm1r[4], ai0[4], ai1[4], lb0[4], lb1[4];
#pragma unroll
        for (int r = 0; r < 4; ++r) { const int t0 = 16 * w + 4 * kg + r, t1 = 127 - t0;
            mm0r[r] = GT[128 + t0]; ai0[r] = __expf(m00 - mm0r[r]); lb0[r] = __expf(-GT[256 + t0] - mm0r[r]);
            mm1r[r] = GT[384 + 128 + t1]; ai1[r] = __expf(m01 - mm1r[r]); lb1[r] = __expf(-GT[384 + 256 + t1] - mm1r[r]); }
        f32x4 sraw[8]; float rs0[4] = {0.f, 0.f, 0.f, 0.f}, rs1[4] = {0.f, 0.f, 0.f, 0.f};
#pragma unroll
        for (int ct = 0; ct < 8; ++ct) {
            f32x4 a = (f32x4){0.f, 0.f, 0.f, 0.f};
#pragma unroll
            for (int ks = 0; ks < 2; ++ks) a = __builtin_amdgcn_mfma_f32_16x16x32_bf16(qf[ks], *(const LAS bf16x8*)(KL + (16 * ct + tq) * ML_DS + 32 * ks + 8 * kg), a, 0, 0, 0);
            sraw[ct] = a;
            const int o = 16 * ct + tq; const float g0o = GT[o], g1o = GT[384 + 127 - o];
#pragma unroll
            for (int r = 0; r < 4; ++r) { const int t0 = 16 * w + 4 * kg + r;
                rs0[r] += (o <= t0) ? a[r] * __expf(g0o - mm0r[r]) : 0.f; rs1[r] += (o >= t0) ? a[r] * __expf(g1o - mm1r[r]) : 0.f; }
        }
        f32x4 acc[8]; float sc0[4], sc1[4];
        {
            f32x4 q0 = (f32x4){0.f, 0.f, 0.f, 0.f}, q1 = q0;
#pragma unroll
            for (int ks = 0; ks < 2; ++ks) { q0 = __builtin_amdgcn_mfma_f32_16x16x32_bf16(qf[ks], *(const LAS bf16x8*)(C0T + (128 + tq) * ML_DS + 32 * ks + 8 * kg), q0, 0, 0, 0);
                                             q1 = __builtin_amdgcn_mfma_f32_16x16x32_bf16(qf[ks], *(const LAS bf16x8*)(C0T + 144 * ML_DS + (128 + tq) * ML_DS + 32 * ks + 8 * kg), q1, 0, 0, 0); }
#pragma unroll
            for (int r = 0; r < 4; ++r) {
                const float qn0 = red16_sum(q0[r]), qn1 = red16_sum(q1[r]);
                const float den0 = ai0[r] * qn0 + red16_sum(rs0[r]), den1 = ai1[r] * qn1 + red16_sum(rs1[r]);
                const float inv0 = __builtin_amdgcn_rcpf(fmaxf(fabsf(den0), lb0[r])), inv1 = __builtin_amdgcn_rcpf(fmaxf(fabsf(den1), lb1[r]));
                rs0[r] = inv0; rs1[r] = inv1; sc0[r] = ai0[r] * inv0; sc1[r] = ai1[r] * inv1; }
        }
#pragma unroll
        for (int ct = 0; ct < 8; ++ct) {
            f32x4 a0 = (f32x4){0.f, 0.f, 0.f, 0.f}, a1 = a0;
#pragma unroll
            for (int ks = 0; ks < 2; ++ks) { a0 = __builtin_amdgcn_mfma_f32_16x16x32_bf16(qf[ks], *(const LAS bf16x8*)(C0T + (16 * ct + tq) * ML_DS + 32 * ks + 8 * kg), a0, 0, 0, 0);
                                             a1 = __builtin_amdgcn_mfma_f32_16x16x32_bf16(qf[ks], *(const LAS bf16x8*)(C0T + 144 * ML_DS + (16 * ct + tq) * ML_DS + 32 * ks + 8 * kg), a1, 0, 0, 0); }
#pragma unroll
            for (int r = 0; r < 4; ++r) acc[ct][r] = a0[r] * sc0[r] + a1[r] * sc1[r];
        }
        __syncthreads();
#pragma unroll
        for (int ct = 0; ct < 8; ++ct) { const int o = 16 * ct + tq; const float g0o = GT[o], g1o = GT[384 + 127 - o];
#pragma unroll
            for (int r = 0; r < 4; ++r) { const int t0 = 16 * w + 4 * kg + r;
                const float x0 = (o <= t0) ? __expf(g0o - mm0r[r]) * rs0[r] : 0.f, x1 = (o >= t0) ? __expf(g1o - mm1r[r]) * rs1[r] : 0.f;
                SwL[(4 * kg + r) * ML_TS + 16 * ct + tq] = (bf16)f2bf(sraw[ct][r] * (x0 + x1)); } }
#pragma unroll
        for (int ks = 0; ks < 4; ++ks) {
            const bf16x8 af = *(const LAS bf16x8*)(SwL + tq * ML_TS + 32 * ks + 8 * kg);
#pragma unroll
            for (int ct = 0; ct < 8; ++ct) acc[ct] = __builtin_amdgcn_mfma_f32_16x16x32_bf16(af, *(const LAS bf16x8*)(VT + (16 * ct + tq) * ML_TS + 32 * ks + 8 * kg), acc[ct], 0, 0, 0);
        }
        float ss[4] = {0.f, 0.f, 0.f, 0.f};
#pragma unroll
        for (int ct = 0; ct < 8; ++ct) { ss[0] += acc[ct].x * acc[ct].x; ss[1] += acc[ct].y * acc[ct].y; ss[2] += acc[ct].z * acc[ct].z; ss[3] += acc[ct].w * acc[ct].w; }
#pragma unroll
        for (int r = 0; r < 4; ++r) ss[r] = rsqrtf(red16_sum(ss[r]) * (1.f / 128.f) + EPS);
#pragma unroll
        for (int ct = 0; ct < 8; ++ct) { const float gn = F.in[IN_MLNG][hd * 128 + 16 * ct + tq];
#pragma unroll
            for (int r = 0; r < 4; ++r) SwL[(4 * kg + r) * ML_TS + 16 * ct + tq] = (bf16)f2bf(acc[ct][r] * ss[r] * gn); }
#pragma unroll
        for (int i = 0; i < 4; ++i) { const int rr = 4 * i + kg, ch = tq;
            const v4u hv = *(const LAS v4u*)(SwL + rr * ML_TS + 8 * ch);
            const size_t idx = (size_t)(row0 + 16 * w + rr) * D + hd * 128 + 8 * ch;
            const v4u ov = *(const v4u*)(ob + idx);
            v4u zo; zo.x = pk2(bflo(hv.x) * sigmoidf_(bflo(ov.x)), bfhi(hv.x) * sigmoidf_(bfhi(ov.x))); zo.y = pk2(bflo(hv.y) * sigmoidf_(bflo(ov.y)), bfhi(hv.y) * sigmoidf_(bfhi(ov.y)));
            zo.z = pk2(bflo(hv.z) * sigmoidf_(bflo(ov.z)), bfhi(hv.z) * sigmoidf_(bfhi(ov.z))); zo.w = pk2(bflo(hv.w) * sigmoidf_(bflo(ov.w)), bfhi(hv.w) * sigmoidf_(bfhi(ov.w)));
            *(v4u*)(zb + idx) = zo; }
        __syncthreads();
    }
}

#ifndef USE_NAIVE_ATTN
#define USE_NAIVE_ATTN 0
#endif
#ifndef USE_NAIVE_S5
#define USE_NAIVE_S5 0
#endif
#ifndef USE_NAIVE_MLSTM
#define USE_NAIVE_MLSTM 0
#endif
#ifndef MK_MODE
#define MK_MODE 0
#endif
struct Args { const float* in[N_INPUTS]; float* out; unsigned char* ws; int ph_lo, ph_hi; };
enum { CBASE = __COUNTER__ + 1 };
#ifndef S5VAR
#define S5VAR 0
#endif
#ifndef DUP_A
#define DUP_A -1
#endif
#ifndef DUP_B
#define DUP_B -1
#endif
#define PHASE_IDS() { int t_ = threadIdx.x; asm volatile("" : "+v"(t_)); F.tid = t_; F.lane = t_ & 63; F.wave = __builtin_amdgcn_readfirstlane(t_ >> 6); }
#define PHASE(...) { constexpr int k_ = __COUNTER__ - CBASE; if (lo <= k_ && k_ < hi) { PHASE_IDS() { constexpr int rep_ = 0; (void)rep_; __VA_ARGS__ } \
    if constexpr (k_ == DUP_A || k_ == DUP_B) { xcd_barrier(bar); { constexpr int rep_ = 1; (void)rep_; __VA_ARGS__ } } \
    if (k_ + 1 < hi) xcd_barrier(bar); } }

__global__ void __launch_bounds__(NTHR, 2) fwd_kernel(Args args) {
    extern __shared__ __attribute__((aligned(16))) unsigned char lds[];
    Frame F;
    F.lds = (LAS unsigned char*)lds;
    F.MISC = (volatile LAS unsigned*)(F.lds + MISC_OFF);
    F.tid = threadIdx.x; F.lane = F.tid & 63; F.wave = __builtin_amdgcn_readfirstlane(F.tid >> 6);
    F.G = gridDim.x; F.blk = blockIdx.x;
    F.ws = args.ws; F.out = args.out; F.ctl = (unsigned*)(args.ws + WS_CTL);
#pragma unroll
    for (int i = 0; i < N_INPUTS; ++i) F.in[i] = args.in[i];
    for (int u = F.tid; u < (LDS_BYTES - LDSCTL_OFF) / 4; u += NTHR) ((LAS unsigned*)(F.lds + LDSCTL_OFF))[u] = 0u;
    __syncthreads();
    const int lo = args.ph_lo, hi = args.ph_hi;
    XcdBarrier bar; bar.bar = F.ctl + CW_BAR; bar.x = 0; bar.st = nullptr;
    if (hi - lo > 1) bar = xcd_barrier_post(F.ctl + CW_BAR, F.MISC + 8);

    unsigned char* ws = F.ws;
    float* xres = (float*)(ws + WS_XRES); const float* mod = (const float*)(ws + WS_MOD);
    bf16* hb = (bf16*)(ws + WS_H); bf16* zb = (bf16*)(ws + WS_Z);
    const LAS int* etab = (const LAS int*)(F.lds + ETAB_OFF);

#define MOE_PHASES(L) \
    PHASE(phase_n2<L>(F, rep_);) \
    PHASE(phase_sc<L>(F);) \
    PHASE({ load_etab(F); pg8::Gemm g{(const bf16*)(ws + WS_HS), (const bf16*)(ws + WS_WG1) + (size_t)(L) * NEXP * 1024 * 1024, SLOTS, NEXP * 1024, 1024}; \
               MoeSched S{etab, F.G, F.blk, 4}; EpiG1 E{(bf16*)(ws + WS_HID)}; run_gemm(F, g, S, E); }) \
    PHASE({ load_etab(F); pg8::Gemm g{(const bf16*)(ws + WS_HID), (const bf16*)(ws + WS_WG2) + (size_t)(L) * NEXP * 1024 * 512, SLOTS, NEXP * 1024, 512}; \
               MoeSched S{etab, F.G, F.blk, 4}; EpiG2 E{(bf16*)(ws + WS_Y2), (const float*)(ws + WS_SLOTW)}; run_gemm(F, g, S, E); })

    PHASE(phase_prologue(F);)
    PHASE(phase_a1<0>(F, rep_);)
#if USE_NAIVE_S5
    PHASE(phase_s5_naive<0, true>(F);)
    PHASE(phase_s5_combine<0, true>(F);)
#else
    PHASE(phase_s5_fast<0, true>(F);)
#endif
    PHASE({ pg8::Gemm g{zb, (const bf16*)(ws + WS_WGLU), T, 2048, 1024}; DenseSched S; S.init(T, 2048, F.G, F.blk, 0);
               EpiGlu E{xres, mod + 0 * 9 * 6144 + 2048, F.in[IN_S5BGLU], rep_}; run_gemm(F, g, S, E); })
    MOE_PHASES(0)
    PHASE(phase_a1<1>(F, rep_);)
    PHASE({ pg8::Gemm g{hb, (const bf16*)(ws + WS_WKVQ), T, 1536, 1024}; DenseSched S; S.init(T, 1536, F.G, F.blk, 0);
               EpiKvq E{(bf16*)(ws + WS_QB), (bf16*)(ws + WS_KB), (bf16*)(ws + WS_VB), F.in[IN_AQG], F.in[IN_AKG], (const float*)(ws + WS_ROPE)}; run_gemm(F, g, S, E); })
#if USE_NAIVE_ATTN
    PHASE(phase_attn_naive<true>(F);)
#else
    PHASE(phase_attn_fast<true>(F, (char*)lds);)
#endif
    PHASE({ pg8::Gemm g{zb, (const bf16*)(ws + WS_WO), T, 1024, 1024}; DenseSched S; S.init(T, 1024, F.G, F.blk, 0);
               EpiRes E{xres, mod + 1 * 9 * 6144 + 2048, rep_}; run_gemm(F, g, S, E); })
    MOE_PHASES(1)
    PHASE(phase_a1<2>(F, rep_);)
    PHASE({ pg8::Gemm g{hb, (const bf16*)(ws + WS_WIN), T, ML_NIN, 1024}; DenseSched S; S.init(T, ML_NIN, F.G, F.blk, 0);
               EpiMlIn E{(bf16*)(ws + WS_MK), (bf16*)(ws + WS_MV), (bf16*)(ws + WS_MQ), (bf16*)(ws + WS_MO), (float*)(ws + WS_MG), F.in[IN_MLBG]}; run_gemm(F, g, S, E); })
#if USE_NAIVE_MLSTM
    PHASE(phase_mlstm_naive<true>(F);)
    PHASE(phase_mlstm_combine<true>(F);)
#else
    PHASE(phase_ml_states(F);)
    PHASE(phase_ml_scan(F, rep_);)
    PHASE(phase_ml_out(F);)
#endif
    PHASE({ pg8::Gemm g{zb, (const bf16*)(ws + WS_WOUT), T, 1024, 1024}; DenseSched S; S.init(T, 1024, F.G, F.blk, 0);
               EpiRes E{xres, mod + 2 * 9 * 6144 + 2048, rep_}; run_gemm(F, g, S, E); })
    MOE_PHASES(2)
    PHASE(phase_a1<3>(F, rep_);)
#if USE_NAIVE_S5
    PHASE(phase_s5_naive<1, false>(F);)
    PHASE(phase_s5_combine<1, false>(F);)
#else
    PHASE(phase_s5_fast<1, false>(F);)
#endif
    PHASE({ pg8::Gemm g{zb, (const bf16*)(ws + WS_WGLU) + (size_t)2048 * 1024, T, 2048, 1024}; DenseSched S; S.init(TL, 2048, F.G, F.blk, TC / 256);
               EpiGlu E{xres, mod + 3 * 9 * 6144 + 2048, F.in[IN_S5BGLU] + 2048, rep_}; run_gemm(F, g, S, E); })
    MOE_PHASES(3)
    PHASE(phase_fin(F);)
}
constexpr int NPH = __COUNTER__ - CBASE;

extern "C" void kernel_launch(void* const* d_in, const int* in_sizes, int n_in, void* d_out, int out_size, void* d_ws, size_t ws_size, hipStream_t stream) {
    static int grid = 0;
    if (grid == 0) {
        if (n_in != N_INPUTS || out_size != TL * D || ws_size < WS_END) { fprintf(stderr, "kernel_launch: unexpected problem: n_in %d out %d ws %zu (need %zu)\n", n_in, out_size, ws_size, (size_t)WS_END); grid = -1; return; }
        int dev = 0, cus = 0, per_cu = 0;
        if (hipGetDevice(&dev) != hipSuccess || hipDeviceGetAttribute(&cus, hipDeviceAttributeMultiprocessorCount, dev) != hipSuccess) { grid = -1; return; }
        if (hipFuncSetAttribute((const void*)fwd_kernel, hipFuncAttributeMaxDynamicSharedMemorySize, LDS_BYTES) != hipSuccess) { fprintf(stderr, "kernel_launch: hipFuncSetAttribute failed\n"); grid = -1; return; }
        if (hipOccupancyMaxActiveBlocksPerMultiprocessor(&per_cu, (const void*)fwd_kernel, NTHR, LDS_BYTES) != hipSuccess || per_cu < 1) fprintf(stderr, "kernel_launch: occupancy query reports %d\n", per_cu);
        (void)hipGetLastError();
        grid = cus;
        if (grid > 256) grid = 256;
    }
    if (grid < 0) return;
    if (hipMemsetAsync((char*)d_ws + WS_CTL, 0, CTL_ZERO_BYTES, stream) != hipSuccess) return;
    Args a{};
    for (int i = 0; i < N_INPUTS; ++i) a.in[i] = (const float*)d_in[i];
    a.out = (float*)d_out; a.ws = (unsigned char*)d_ws;
#if MK_MODE == 0
    a.ph_lo = 0; a.ph_hi = NPH;
    hipLaunchKernelGGL(fwd_kernel, dim3(grid), dim3(NTHR), LDS_BYTES, stream, a);
#else
    for (int p = 0; p < NPH; ++p) { a.ph_lo = p; a.ph_hi = p + 1; hipLaunchKernelGGL(fwd_kernel, dim3(grid), dim3(NTHR), LDS_BYTES, stream, a); }
#endif
}
```

```cpp
#include <hip/hip_runtime.h>
#include <cstdio>
#include <cstdint>

#define GAS __attribute__((address_space(1)))
#define LAS __attribute__((address_space(3)))
typedef unsigned short bf16;
typedef unsigned v4u __attribute__((ext_vector_type(4)));
typedef unsigned v2u __attribute__((ext_vector_type(2)));
typedef float f32x4 __attribute__((ext_vector_type(4)));
typedef float f32x2 __attribute__((ext_vector_type(2)));
typedef short bf16x8 __attribute__((ext_vector_type(8)));

constexpr int D = 1024, NB = 8, SEQ = 2048, CTX = 256, DEPTH = 4;
constexpr int TC = NB * CTX;
constexpr int TL = NB * SEQ;
constexpr int T = TC + TL;
constexpr int KVLEN = SEQ + CTX;
constexpr int NEXP = 16, DFF = 512;
constexpr int SLOTS = 40960;
constexpr int ML_NIN = 3328;
constexpr float EPS = 1e-6f;
constexpr int NWAVES = 8, NTHR = 512;
constexpr float ATT_C2 = 0.125f * 1.4426950408889634f;

constexpr size_t MiB = 1u << 20;
constexpr size_t WS_CTL = 0, CTL_ZERO_BYTES = 1 * MiB;
constexpr size_t WS_MOD = 1 * MiB;
constexpr size_t WS_ROPE = 2 * MiB;
constexpr size_t WS_TOKE = 2 * MiB + 65536;
constexpr size_t WS_TOKR = WS_TOKE + 163840;
constexpr size_t WS_TOKW = WS_TOKR + 163840;
constexpr size_t WS_TOKS = WS_TOKW + 163840;
constexpr size_t WS_BCNT = WS_TOKS + 163840;
constexpr size_t WS_ETAB = WS_BCNT + 16384;
constexpr size_t WS_SLOTW = WS_ETAB + 4096;
static_assert(WS_SLOTW + SLOTS * 4 <= 4 * MiB, "small tables");
constexpr size_t WS_WGLU = 4 * MiB;
constexpr size_t WS_WKVQ = WS_WGLU + 8 * MiB;
constexpr size_t WS_WO = WS_WKVQ + 3 * MiB;
constexpr size_t WS_WIN = WS_WO + 2 * MiB;
constexpr size_t WS_WOUT = WS_WIN + 7 * MiB;
constexpr size_t WS_WG1 = WS_WOUT + 2 * MiB;
constexpr size_t WS_WG2 = WS_WG1 + 128 * MiB;
constexpr size_t WS_XRES = WS_WG2 + 64 * MiB;
constexpr size_t WS_H = WS_XRES + 72 * MiB;
constexpr size_t WS_Z = WS_H + 36 * MiB;
constexpr size_t WS_MIX = WS_Z + 36 * MiB;
constexpr size_t WS_HS = WS_MIX;
constexpr size_t WS_HID = WS_HS + 80 * MiB;
constexpr size_t WS_Y2 = WS_HID + 40 * MiB;
constexpr size_t WS_END = WS_Y2 + 80 * MiB;
constexpr size_t WS_YSUM = WS_MIX;
constexpr size_t WS_QB = WS_MIX;
constexpr size_t WS_KB = WS_QB + 36 * MiB;
constexpr size_t WS_VB = WS_KB + 9 * MiB;
constexpr size_t WS_MK = WS_MIX;
constexpr size_t WS_MV = WS_MK + 18 * MiB;
constexpr size_t WS_MQ = WS_MV + 36 * MiB;
constexpr size_t WS_MO = WS_MQ + 18 * MiB;
constexpr size_t WS_MG = WS_MO + 36 * MiB;
constexpr size_t WS_MHS = WS_MG + 3 * MiB;
static_assert(WS_MHS + 72 * MiB <= WS_END, "mLSTM view fits");
static_assert(WS_END <= 600 * MiB, "workspace budget");

constexpr int CW_BAR = 4096;

constexpr int RING_OFF = 0, RING_BYTES = 131072;
constexpr int LDSCTL_OFF = RING_BYTES, MISC_OFF = LDSCTL_OFF + 320;
constexpr int ETAB_OFF = MISC_OFF + 128;
constexpr int SCT_OFF = ETAB_OFF + 128;
constexpr int LDS_BYTES = 147456;
static_assert(SCT_OFF + 256 <= LDS_BYTES, "LDS map");

#define LDS_WAIT() asm volatile("s_waitcnt lgkmcnt(0)" ::: "memory")
#define VM_WAIT() asm volatile("s_waitcnt vmcnt(0)" ::: "memory")
__device__ __forceinline__ unsigned f2bf(float f) { unsigned u = __builtin_bit_cast(unsigned, f); return (u + 0x7fffu + ((u >> 16) & 1u)) >> 16; }
typedef float f32x2_cv __attribute__((ext_vector_type(2))); typedef __bf16 bf16x2_cv __attribute__((ext_vector_type(2)));
__device__ __forceinline__ unsigned pk2(float lo, float hi) { f32x2_cv v = {lo, hi}; bf16x2_cv b = __builtin_convertvector(v, bf16x2_cv); return __builtin_bit_cast(unsigned, b); }
__device__ __forceinline__ float bf2f(unsigned h) { return __builtin_bit_cast(float, h << 16); }
__device__ __forceinline__ float bflo(unsigned w) { return __builtin_bit_cast(float, w << 16); }
__device__ __forceinline__ float bfhi(unsigned w) { return __builtin_bit_cast(float, w & 0xffff0000u); }
template <int CTRL, int RMASK = 0xF>
__device__ __forceinline__ float dpp_f(float oldv, float v) { return __builtin_bit_cast(float, __builtin_amdgcn_update_dpp(__builtin_bit_cast(int, oldv), __builtin_bit_cast(int, v), CTRL, RMASK, 0xF, false)); }
#ifndef USE_SHFL_XOR
#define USE_SHFL_XOR 0
#endif
#ifndef USE_SHFL_PARTIAL
#define USE_SHFL_PARTIAL 0
#endif
__device__ __forceinline__ float red16_sum(float v) {
#if USE_SHFL_PARTIAL
    for (int o = 1; o < 16; o <<= 1) v += __shfl_xor(v, o);
    return v;
#endif
    v += dpp_f<0xB1>(0.f, v); v += dpp_f<0x4E>(0.f, v); v += dpp_f<0x141>(0.f, v); v += dpp_f<0x140>(0.f, v); return v; }
__device__ __forceinline__ float red16_max(float v) {
    v = fmaxf(v, dpp_f<0xB1>(v, v)); v = fmaxf(v, dpp_f<0x4E>(v, v)); v = fmaxf(v, dpp_f<0x141>(v, v)); v = fmaxf(v, dpp_f<0x140>(v, v)); return v; }
#ifndef USE_SHFL_REDUCE
#define USE_SHFL_REDUCE 0
#endif
__device__ __forceinline__ float wave_sum(float v) {
#if USE_SHFL_REDUCE
    for (int o = 1; o < 64; o <<= 1) v += __shfl_xor(v, o);
    return v;
#endif
    v = red16_sum(v); v += dpp_f<0x142, 0xA>(0.f, v); v += dpp_f<0x143, 0xC>(0.f, v);
    return __builtin_bit_cast(float, __builtin_amdgcn_readlane(__builtin_bit_cast(int, v), 63)); }
__device__ __forceinline__ float wave_max(float v) {
    v = red16_max(v); v = fmaxf(v, dpp_f<0x142, 0xA>(v, v)); v = fmaxf(v, dpp_f<0x143, 0xC>(v, v));
    return __builtin_bit_cast(float, __builtin_amdgcn_readlane(__builtin_bit_cast(int, v), 63)); }
__device__ __forceinline__ float xor16_sum(float v) { return v + __shfl_xor(v, 16); }
__device__ __forceinline__ float xor32_sum(float v) { return v + __shfl_xor(v, 32); }
__device__ __forceinline__ float sigmoidf_(float x) { return __builtin_amdgcn_rcpf(1.f + __expf(-x)); }
__device__ __forceinline__ float siluf_(float x) { return x * __builtin_amdgcn_rcpf(1.f + __expf(-x)); }
__device__ __forceinline__ float gelu_tanh(float x) {
    const float p = __builtin_fmaf(x * x, 0.044715f, 1.0f);
    const float e = __builtin_amdgcn_exp2f((x * -2.302208198f) * p);
    return x * __builtin_amdgcn_rcpf(1.0f + e);
}
__device__ __forceinline__ float log_sigmoidf_(float x) { return fminf(x, 0.f) - __logf(1.f + __expf(-fabsf(x))); }
__device__ __forceinline__ void sincos_d(double a, double& s, double& c) {
    const double k = __builtin_rint(a * 0.63661977236758134308);
    double r = __builtin_fma(-k, 1.57079632679489655800e+00, a);
    r = __builtin_fma(-k, 6.12323399573676603587e-17, r);
    const double r2 = r * r;
    double sp = -1.0 / 1307674368000.0;
    sp = sp * r2 + 1.0 / 6227020800.0; sp = sp * r2 - 1.0 / 39916800.0; sp = sp * r2 + 1.0 / 362880.0; sp = sp * r2 - 1.0 / 5040.0; sp = sp * r2 + 1.0 / 120.0; sp = sp * r2 - 1.0 / 6.0;
    const double sr = r + r * r2 * sp;
    double cp = 1.0 / 20922789888000.0;
    cp = cp * r2 - 1.0 / 87178291200.0; cp = cp * r2 + 1.0 / 479001600.0; cp = cp * r2 - 1.0 / 3628800.0; cp = cp * r2 + 1.0 / 40320.0; cp = cp * r2 - 1.0 / 720.0; cp = cp * r2 + 1.0 / 24.0; cp = cp * r2 - 0.5;
    const double cr = 1.0 + r2 * cp;
    const int q = ((int)k) & 3;
    s = (q == 0) ? sr : (q == 1) ? cr : (q == 2) ? -sr : -cr;
    c = (q == 0) ? cr : (q == 1) ? -sr : (q == 2) ? -cr : sr;
}
__device__ __forceinline__ int mrow_of(int r) { return r < TC ? 8 : ((r - TC) >> 11); }
namespace pg8 {
#define PG8_LAS __attribute__((address_space(3)))
typedef unsigned short bf16_t;
typedef short bf16x8 __attribute__((ext_vector_type(8)));
typedef float f32x4 __attribute__((ext_vector_type(4)));
typedef unsigned u32x4 __attribute__((ext_vector_type(4)));
constexpr int BM = 256, BK = 64, HALF = 128, HTB = HALF * BK * 2  , STAGE_BYTES = 8 * HTB, NXCD = 8, WGM = 8;

__host__ __device__ __forceinline__ int lds_byte(int r, int c) { const int st = (r >> 4) * 2 + (c >> 5), rr = r & 15, cc = c & 31, ob = rr * 64 + cc * 2; return st * 1024 + (ob ^ (((ob >> 9) & 1) << 5)); }
__host__ __device__ __forceinline__ void stage_rc(int b, int& R, int& C) { const int st = b / 1024, sb = b % 1024, swz = sb ^ (((sb >> 9) & 1) << 5); R = (st >> 1) * 16 + swz / 64; C = (st & 1) * 32 + (swz % 64) / 2; }
__host__ __device__ __forceinline__ int perm32(int rho) { const int n = rho >> 4, i = rho & 15; return 8 * (i >> 2) + 4 * n + (i & 3); }

struct Unit { int pm, pn; };
struct Gemm { const bf16_t* A; const bf16_t* Bt; int M, N, K; };

struct StaticOrder {
    int nM, nN, nwg, G, c;
    __host__ __device__ void init(int M, int N, int G_, int c_) { nM = M / BM; nN = N / BM; nwg = nM * nN; G = G_; c = c_; }
    __host__ __device__ bool next(int i, Unit& u) const {
        const long L = (long)i * G + c; if (L >= nwg) return false;
        int wgid = (int)L; { const int q = nwg / NXCD, r = nwg % NXCD, xcd = wgid % NXCD, off = wgid / NXCD; wgid = (xcd < r ? xcd * (q + 1) : r * (q + 1) + (xcd - r) * q) + off; }
        const int nig = WGM * nN, gid = wgid / nig, fm = gid * WGM, gsz = (nM - fm) < WGM ? (nM - fm) : WGM;
        u.pm = fm + ((wgid % nig) % gsz); u.pn = (wgid % nig) / gsz; return true;
    }
    __device__ __forceinline__ void a_ready(const Unit&) const {}
    __device__ __forceinline__ void done(const Unit&) const {}
};


template <class Epi, class Sched, bool ALIGN_EPI = false, bool SP2 = false>
__device__ __forceinline__ void gemm_phase(PG8_LAS unsigned char* lds, const Gemm g, const Sched& S, const Epi& E) {
    const int tid = threadIdx.x, wid = __builtin_amdgcn_readfirstlane(tid >> 6), lane = tid & 63, wr = wid >> 2, wc = wid & 3, fr = lane & 15, fq = lane >> 4;
    const int K = g.K, nt = K / BK;
    unsigned voffA[2], voffB[2];
#pragma unroll
    for (int i = 0; i < 2; ++i) { int R, C; stage_rc(tid * 16 + i * 8192, R, C); const int Rb = Epi::PERM ? ((R & ~31) + perm32(R & 31)) : R;
        voffA[i] = (unsigned)(R * K + C) * 2u; voffB[i] = (unsigned)(Rb * K + C) * 2u; }
    const size_t kstep = (size_t)(BK * 2);
    const size_t hstep = (size_t)HALF * K * 2;
    const size_t tstep = 2 * hstep;
    const unsigned ldsw = (unsigned)wid * 1024u;
    const int aoff = lds_byte(wr * 64 + fr, fq * 8), boff = lds_byte(wc * 32 + fr, fq * 8);
#define PG8_SA(b, h) (((b) * 2 + (h)) * HTB)
#define PG8_SB(b, h) ((4 + (b) * 2 + (h)) * HTB)
#define PG8_STAGE(bufoff, gbase, voff) do { _Pragma("unroll") for (int _i = 0; _i < 2; ++_i) \
        __builtin_amdgcn_global_load_lds((const unsigned*)((const char*)(gbase) + (voff)[_i]), (PG8_LAS unsigned*)(lds + (bufoff) + ldsw + _i * 8192), 16, 0, 0); } while (0)
#define PG8_LDA(dst, b, h) do { _Pragma("unroll") for (int m = 0; m < 4; ++m) _Pragma("unroll") for (int k = 0; k < 2; ++k) dst[m][k] = *(const PG8_LAS bf16x8*)(lds + PG8_SA(b, h) + aoff + m * 2048 + k * 1024); } while (0)
#define PG8_LDB(dst, b, h) do { _Pragma("unroll") for (int n = 0; n < 2; ++n) _Pragma("unroll") for (int k = 0; k < 2; ++k) dst[n][k] = *(const PG8_LAS bf16x8*)(lds + PG8_SB(b, h) + boff + n * 2048 + k * 1024); } while (0)
#define PG8_MMA(ai, bj, At, Bt) do { __builtin_amdgcn_s_setprio(1); _Pragma("unroll") for (int m = 0; m < 4; ++m) _Pragma("unroll") for (int n = 0; n < 2; ++n) _Pragma("unroll") for (int k = 0; k < 2; ++k) \
        acc[ai][bj][m][n] = __builtin_amdgcn_mfma_f32_16x16x32_bf16(Bt[n][k], At[m][k], acc[ai][bj][m][n], 0, 0, 0); __builtin_amdgcn_s_setprio(0); } while (0)
#define PG8_WAIT_V(n) asm volatile("s_waitcnt vmcnt(" #n ")" ::: "memory")
#define PG8_WAIT_L(n) asm volatile("s_waitcnt lgkmcnt(" #n ")" ::: "memory")
#define PG8_BAR __builtin_amdgcn_s_barrier()
#define PG8_SCHED __builtin_amdgcn_sched_barrier(0)
    Unit cur, nxt; int ui = 0;
    if (!S.next(0, cur)) return;
    f32x4 acc[2][2][4][2];
#pragma unroll
    for (int a = 0; a < 2; ++a)
#pragma unroll
        for (int b = 0; b < 2; ++b)
#pragma unroll
            for (int m = 0; m < 4; ++m)
#pragma unroll
                for (int n = 0; n < 2; ++n) acc[a][b][m][n] = (f32x4){0.f, 0.f, 0.f, 0.f};
    bf16x8 At[4][2], B0[2][2], B1[2][2];
    const char* cA = (const char*)g.A + (size_t)cur.pm * tstep; const char* cB = (const char*)g.Bt + (size_t)cur.pn * tstep;
    S.a_ready(cur);
    if constexpr (SP2) {
        PG8_STAGE(PG8_SB(0, 0), cB, voffB); PG8_STAGE(PG8_SB(0, 1), cB + hstep, voffB); PG8_STAGE(PG8_SA(0, 0), cA, voffA); PG8_STAGE(PG8_SA(0, 1), cA + hstep, voffA);
        if (wr == 1) PG8_BAR;
        PG8_WAIT_V(2); PG8_BAR;
        PG8_STAGE(PG8_SB(1, 0), cB + kstep, voffB); PG8_STAGE(PG8_SA(1, 0), cA + kstep, voffA); PG8_STAGE(PG8_SB(1, 1), cB + hstep + kstep, voffB);
        PG8_WAIT_V(6); PG8_BAR;
    } else {
        PG8_STAGE(PG8_SB(0, 0), cB, voffB); PG8_STAGE(PG8_SA(0, 0), cA, voffA); PG8_STAGE(PG8_SB(0, 1), cB + hstep, voffB); PG8_STAGE(PG8_SA(0, 1), cA + hstep, voffA);
        if (wr == 1) PG8_BAR;
        PG8_WAIT_V(4); PG8_BAR;
        PG8_STAGE(PG8_SB(1, 0), cB + kstep, voffB); PG8_STAGE(PG8_SA(1, 0), cA + kstep, voffA); PG8_STAGE(PG8_SB(1, 1), cB + hstep + kstep, voffB);
        PG8_WAIT_V(6); PG8_BAR;
    }
    for (;;) {
        const bool has_next = S.next(ui + 1, nxt);
        const char* nA = has_next ? (const char*)g.A + (size_t)nxt.pm * tstep : cA; const char* nB = has_next ? (const char*)g.Bt + (size_t)nxt.pn * tstep : cB;
        for (int t = 0; t < nt; t += 2) {
            const bool last = (t == nt - 2);
            const char* a1 = cA + (size_t)(t + 1) * kstep;
            const char* a2 = last ? nA : cA + (size_t)(t + 2) * kstep; const char* b2 = last ? nB : cB + (size_t)(t + 2) * kstep;
            const char* a3 = a2 + kstep; const char* b3 = b2 + kstep;
            if (last && has_next) S.a_ready(nxt);
            if constexpr (SP2) {
            PG8_LDB(B0, 0, 0); PG8_LDB(B1, 0, 1); PG8_SCHED; PG8_LDA(At, 0, 0); PG8_STAGE(PG8_SA(1, 1), a1 + hstep, voffA);
            PG8_WAIT_V(8); PG8_WAIT_L(0); PG8_BAR; PG8_MMA(0, 0, At, B0); PG8_MMA(0, 1, At, B1); PG8_BAR; PG8_SCHED;
            PG8_LDA(At, 0, 1); PG8_STAGE(PG8_SB(0, 0), b2, voffB); PG8_STAGE(PG8_SB(0, 1), b2 + hstep, voffB); PG8_STAGE(PG8_SA(0, 0), a2, voffA);
            PG8_WAIT_V(8); PG8_WAIT_L(0); PG8_BAR; PG8_MMA(1, 0, At, B0); PG8_MMA(1, 1, At, B1); PG8_BAR; PG8_SCHED;
            PG8_LDB(B0, 1, 0); PG8_LDB(B1, 1, 1); PG8_SCHED; PG8_LDA(At, 1, 0); PG8_STAGE(PG8_SA(0, 1), a2 + hstep, voffA);
            PG8_WAIT_V(8); PG8_WAIT_L(0); PG8_BAR; PG8_MMA(0, 0, At, B0); PG8_MMA(0, 1, At, B1); PG8_BAR; PG8_SCHED;
            PG8_LDA(At, 1, 1); PG8_STAGE(PG8_SB(1, 0), b3, voffB); PG8_STAGE(PG8_SB(1, 1), b3 + hstep, voffB); PG8_STAGE(PG8_SA(1, 0), a3, voffA);
            PG8_WAIT_V(8); PG8_WAIT_L(0); PG8_BAR; PG8_MMA(1, 0, At, B0); PG8_MMA(1, 1, At, B1); PG8_BAR; PG8_SCHED;
            } else {
            PG8_LDB(B0, 0, 0); PG8_SCHED; PG8_LDA(At, 0, 0); PG8_STAGE(PG8_SA(1, 1), a1 + hstep, voffA);
            PG8_WAIT_L(8); PG8_BAR; PG8_WAIT_L(0); PG8_MMA(0, 0, At, B0); PG8_BAR; PG8_SCHED;
            PG8_LDB(B1, 0, 1); PG8_STAGE(PG8_SB(0, 0), b2, voffB);
            PG8_BAR; PG8_WAIT_L(0); PG8_MMA(0, 1, At, B1); PG8_BAR;
            PG8_LDA(At, 0, 1); PG8_STAGE(PG8_SA(0, 0), a2, voffA);
            PG8_BAR; PG8_WAIT_L(0); PG8_MMA(1, 0, At, B0); PG8_BAR; PG8_SCHED;
            PG8_STAGE(PG8_SB(0, 1), b2 + hstep, voffB);
            PG8_WAIT_V(6); PG8_BAR; PG8_MMA(1, 1, At, B1); PG8_BAR;
            PG8_LDB(B0, 1, 0); PG8_SCHED; PG8_LDA(At, 1, 0); PG8_STAGE(PG8_SA(0, 1), a2 + hstep, voffA);
            PG8_WAIT_L(8); PG8_BAR; PG8_WAIT_L(0); PG8_MMA(0, 0, At, B0); PG8_BAR; PG8_SCHED;
            PG8_LDB(B1, 1, 1); PG8_STAGE(PG8_SB(1, 0), b3, voffB);
            PG8_BAR; PG8_WAIT_L(0); PG8_MMA(0, 1, At, B1); PG8_BAR;
            PG8_LDA(At, 1, 1); PG8_STAGE(PG8_SA(1, 0), a3, voffA);
            PG8_BAR; PG8_WAIT_L(0); PG8_MMA(1, 0, At, B0); PG8_BAR; PG8_SCHED;
            PG8_STAGE(PG8_SB(1, 1), b3 + hstep, voffB);
            PG8_WAIT_V(6); PG8_BAR; PG8_MMA(1, 1, At, B1); PG8_BAR;
            }
        }
        if constexpr (ALIGN_EPI) { if (wr == 0) PG8_BAR; }
        if constexpr (!Epi::AFTER_DRAIN) { E(acc, cur, wr, wc, fr, fq); S.done(cur); }
        if (!has_next) break;
#pragma unroll
        for (int a = 0; a < 2; ++a)
#pragma unroll
            for (int b = 0; b < 2; ++b)
#pragma unroll
                for (int m = 0; m < 4; ++m)
#pragma unroll
                    for (int n = 0; n < 2; ++n) acc[a][b][m][n] = (f32x4){0.f, 0.f, 0.f, 0.f};
        cur = nxt; cA = nA; cB = nB; ++ui;
        if constexpr (ALIGN_EPI) { if (wr == 1) PG8_BAR; }
    }
    PG8_WAIT_V(0);
    if constexpr (!ALIGN_EPI) { if (wr == 0) PG8_BAR; }
    PG8_BAR;
    if constexpr (Epi::AFTER_DRAIN) { E.fused(acc, cur, wr, wc, fr, fq, lds, wid, lane); S.done(cur); }
#undef PG8_SA
#undef PG8_SB
#undef PG8_STAGE
#undef PG8_LDA
#undef PG8_LDB
#undef PG8_MMA
#undef PG8_WAIT_V
#undef PG8_WAIT_L
#undef PG8_BAR
#undef PG8_SCHED
}
}
#define XB_TMO      128
#define XB_XCNT(j)  (256  + 64 * (j))
#define XB_XSUB(j)  (1280 + 64 * (j))
#define XB_XGEN(j)  (2304 + 64 * (j))
#define XB_TOP      3328
#define XB_TOPGEN   3392
#define XCD_BAR_WORDS 3456
#define XB_SPIN_CAP (1u << 22)

__device__ __forceinline__ unsigned xb_ld(unsigned* p)              { return __hip_atomic_load(p, __ATOMIC_RELAXED, __HIP_MEMORY_SCOPE_AGENT); }
__device__ __forceinline__ unsigned xb_add(unsigned* p, unsigned v) { return __hip_atomic_fetch_add(p, v, __ATOMIC_RELAXED, __HIP_MEMORY_SCOPE_AGENT); }
__device__ __forceinline__ unsigned xb_xcc_id() { return (unsigned)__builtin_amdgcn_s_getreg((3 << 11) | 20) & 0xFu; }
#define XB_SPIN(cond, bar) do { unsigned _sp = 0; while (cond) { __builtin_amdgcn_s_sleep(1); \
    if ((++_sp & 255u) == 0u) { if (xb_ld(&(bar)[XB_TMO])) break; if (_sp > XB_SPIN_CAP) { atomicAdd(&(bar)[XB_TMO], 1u); break; } } } } while (0)

struct XcdBarrier {
    unsigned* bar; unsigned x;
    volatile LAS unsigned* st;
};

__device__ __forceinline__ XcdBarrier xcd_barrier_post(unsigned* bar, volatile LAS unsigned* st) {
    XcdBarrier b; b.bar = bar; b.x = xb_xcc_id(); b.st = st;
    if (threadIdx.x == 0) (void)xb_add(&bar[XB_XCNT(b.x)], 1u);
    return b;
}
__device__ __forceinline__ void xcd_barrier_complete(unsigned* bar, unsigned x, unsigned& nloc, unsigned& nx) {
    const unsigned G = gridDim.x * gridDim.y * gridDim.z;
    unsigned sum, cnt, mine, sp = 0u;
    for (;;) {
        sum = 0u; cnt = 0u; mine = 0u;
#pragma unroll
        for (unsigned j = 0; j < 16; ++j) { const unsigned c = xb_ld(&bar[XB_XCNT(j)]); sum += c; cnt += (c > 0u) ? 1u : 0u; mine = (j == x) ? c : mine; }
        if (sum == G) break;
        __builtin_amdgcn_s_sleep(1);
        if ((++sp & 255u) == 0u) { if (xb_ld(&bar[XB_TMO])) break; if (sp > XB_SPIN_CAP) { atomicAdd(&bar[XB_TMO], 1u); break; } }
    }
    nloc = mine > 0u ? mine : 1u; nx = cnt > 0u ? cnt : 1u;
}

__device__ __forceinline__ void xcd_barrier(const XcdBarrier& b) {
    asm volatile("s_waitcnt vmcnt(0)" ::: "memory");
    __syncthreads();
    if (threadIdx.x == 0) {
        unsigned* bar = b.bar;
        __builtin_amdgcn_s_waitcnt(0);
        unsigned nloc = b.st[0], nx = b.st[1];
        if (nloc == 0u) { xcd_barrier_complete(bar, b.x, nloc, nx); b.st[0] = nloc; b.st[1] = nx; }
        const unsigned old = xb_add(&bar[XB_XSUB(b.x)], 1u);
        const unsigned gen = old / nloc;
        if (old + 1u == (gen + 1u) * nloc) {
            __builtin_amdgcn_fence(__ATOMIC_RELEASE, "agent");
            asm volatile("s_waitcnt vmcnt(0)" ::: "memory");
            const unsigned og = xb_add(&bar[XB_TOP], 1u);
            const unsigned tg = og / nx;
            if (og + 1u == (tg + 1u) * nx) xb_add(&bar[XB_TOPGEN], 1u);
            else XB_SPIN(xb_ld(&bar[XB_TOPGEN]) == tg, bar);
            __builtin_amdgcn_fence(__ATOMIC_ACQUIRE, "agent");
            xb_add(&bar[XB_XGEN(b.x)], 1u);
            asm volatile("s_waitcnt vmcnt(0)" ::: "memory");
        } else {
            XB_SPIN(xb_ld(&bar[XB_XGEN(b.x)]) == gen, bar);
            __builtin_amdgcn_fence(__ATOMIC_ACQUIRE, "agent");
            asm volatile("s_waitcnt vmcnt(0)" ::: "memory");
        }
    }
    __syncthreads();
}

enum { IN_X = 0, IN_C, IN_CTX, IN_CCTX, IN_ADAW, IN_ADAB, IN_N1G, IN_N2G, IN_FING, IN_S5LRE, IN_S5LIM, IN_S5LOG, IN_S5BRE, IN_S5BIM, IN_S5CRE, IN_S5CIM,
       IN_S5D, IN_S5WGLU, IN_S5BGLU, IN_AWKVQ, IN_AQG, IN_AKG, IN_AWO, IN_MLWIN, IN_MLBG, IN_MLNG, IN_MLWOUT, IN_RW, IN_RB, IN_MWG, IN_MWU, IN_MWD, N_INPUTS };

struct Frame {
    LAS unsigned char* lds;
    volatile LAS unsigned* MISC;
    unsigned* ctl;
    int tid, lane, wave, G, blk;
    const float* in[N_INPUTS];
    unsigned char* ws;
    float* out;
};

struct DenseSched {
    pg8::StaticOrder so; int pm0;
    __device__ __forceinline__ void init(int Mrows, int N, int G, int c, int pm0_) { so.init(Mrows, N, G, c); pm0 = pm0_; }
    __device__ __forceinline__ bool next(int i, pg8::Unit& u) const { if (!so.next(i, u)) return false; u.pm += pm0; return true; }
    __device__ __forceinline__ void a_ready(const pg8::Unit&) const {}
    __device__ __forceinline__ void done(const pg8::Unit&) const {}
};
struct MoeSched {
    const LAS int* tab; int G, c, npn;
    __device__ __forceinline__ bool next(int i, pg8::Unit& u) const {
        const int total = tab[16] * npn;
        int L;
        if ((G & 7) == 0) { const int x = c & 7, rank = c >> 3, per = G >> 3; const int q = total >> 3, rem = total & 7; const int start = x * q + (x < rem ? x : rem), cnt = q + (x < rem ? 1 : 0);
            const int off = rank + per * i; if (off >= cnt) return false; L = start + off; }
        else { L = i * G + c; if (L >= total) return false; }
        int e = 0;
#pragma unroll
        for (int k = 1; k < 16; ++k) e += (L >= tab[k] * npn) ? 1 : 0;
        const int ts = tab[e], te = tab[e + 1] - ts, idx = L - ts * npn;
        u.pm = __builtin_amdgcn_readfirstlane(ts + idx % te); u.pn = __builtin_amdgcn_readfirstlane(e * npn + idx / te); return true;
    }
    __device__ __forceinline__ void a_ready(const pg8::Unit&) const {}
    __device__ __forceinline__ void done(const pg8::Unit&) const {}
};

template <class Epi, class Sched>
__device__ __forceinline__ void gemm_phase_naive(const pg8::Gemm g, const Sched& S, const Epi& E) {
    const int tid = threadIdx.x, wid = tid >> 6, lane = tid & 63, wr = wid >> 2, wc = wid & 3, fr = lane & 15, fq = lane >> 4;
    const int K = g.K; pg8::Unit u;
    for (int i = 0; S.next(i, u); ++i) {
        f32x4 acc[2][2][4][2];
#pragma unroll
        for (int ai = 0; ai < 2; ++ai)
#pragma unroll
            for (int m = 0; m < 4; ++m) {
                const int row = u.pm * 256 + ai * 128 + wr * 64 + m * 16 + fr;
                const bf16* ap = g.A + (size_t)row * K;
                float s[2][2][4];
#pragma unroll
                for (int bj = 0; bj < 2; ++bj)
#pragma unroll
                    for (int n = 0; n < 2; ++n)
#pragma unroll
                        for (int e = 0; e < 4; ++e) s[bj][n][e] = 0.f;
                for (int k = 0; k < K; k += 8) {
                    const v4u av = *(const v4u*)(ap + k);
                    const float a0 = bflo(av.x), a1 = bfhi(av.x), a2 = bflo(av.y), a3 = bfhi(av.y), a4 = bflo(av.z), a5 = bfhi(av.z), a6 = bflo(av.w), a7 = bfhi(av.w);
#pragma unroll
                    for (int bj = 0; bj < 2; ++bj)
#pragma unroll
                        for (int n = 0; n < 2; ++n)
#pragma unroll
                            for (int e = 0; e < 4; ++e) {
                                const int col = u.pn * 256 + bj * 128 + wc * 32 + n * 16 + fq * 4 + e;
                                const v4u bv = *(const v4u*)(g.Bt + (size_t)col * K + k);
                                float t = s[bj][n][e];
                                t += a0 * bflo(bv.x); t += a1 * bfhi(bv.x); t += a2 * bflo(bv.y); t += a3 * bfhi(bv.y);
                                t += a4 * bflo(bv.z); t += a5 * bfhi(bv.z); t += a6 * bflo(bv.w); t += a7 * bfhi(bv.w);
                                s[bj][n][e] = t;
                            }
                }
#pragma unroll
                for (int bj = 0; bj < 2; ++bj)
#pragma unroll
                    for (int n = 0; n < 2; ++n) acc[ai][bj][m][n] = (f32x4){s[bj][n][0], s[bj][n][1], s[bj][n][2], s[bj][n][3]};
            }
        E(acc, u, wr, wc, fr, fq);
    }
}
#ifndef USE_NAIVE_GEMM
#define USE_NAIVE_GEMM 0
#endif
template <class Epi, class Sched>
__device__ __forceinline__ void run_gemm(Frame& F, const pg8::Gemm g, const Sched& S, const Epi& E) {
#if USE_NAIVE_GEMM
    gemm_phase_naive<Epi, Sched>(g, S, E);
#else
    pg8::gemm_phase<Epi, Sched, true, true>(F.lds + RING_OFF, g, S, E);
#endif
}

__device__ __forceinline__ void st_bf4(bf16* p, f32x4 v) { v2u w; w.x = pk2(v.x, v.y); w.y = pk2(v.z, v.w); *(v2u*)p = w; }

struct EpiRes {
    static constexpr bool PERM = true, AFTER_DRAIN = false;
    bf16* xres; const float* __restrict__ modg; int skip; bf16* dummy;
    __device__ __forceinline__ void operator()(const f32x4 (&acc)[2][2][4][2], const pg8::Unit& u, int wr, int wc, int fr, int fq) const {
        const int cbase = u.pn * 256 + wc * 32 + fq * 8;
#pragma unroll
        for (int am = 0; am < 4; ++am) { const int ai = am >> 1, m0 = (am & 1) * 2;
            v4u x[4][2]; f32x4 g0[4][2], g1[4][2];
#pragma unroll
            for (int m = m0; m < m0 + 2; ++m) { const int r = u.pm * 256 + ai * 128 + wr * 64 + m * 16 + fr; const float* gp = modg + mrow_of(r) * 6144; const bf16* xp = xres + (size_t)r * D;
#pragma unroll
                for (int bj = 0; bj < 2; ++bj) { const int c = cbase + bj * 128; g0[m][bj] = *(const f32x4*)(gp + c); g1[m][bj] = *(const f32x4*)(gp + c + 4); x[m][bj] = *(const v4u*)(xp + c); } }
            asm volatile("" ::: "memory");
#pragma unroll
            for (int m = m0; m < m0 + 2; ++m) { const int r = u.pm * 256 + ai * 128 + wr * 64 + m * 16 + fr; bf16* xp = (skip ? dummy : xres) + (size_t)r * D;
#pragma unroll
                for (int bj = 0; bj < 2; ++bj) { const int c = cbase + bj * 128; const v4u xv = x[m][bj]; const f32x4 a = g0[m][bj] * acc[ai][bj][m][0], b = g1[m][bj] * acc[ai][bj][m][1];
                    v4u o; o.x = pk2(bflo(xv.x) + a.x, bfhi(xv.x) + a.y); o.y = pk2(bflo(xv.y) + a.z, bfhi(xv.y) + a.w); o.z = pk2(bflo(xv.z) + b.x, bfhi(xv.z) + b.y); o.w = pk2(bflo(xv.w) + b.z, bfhi(xv.w) + b.w);
                    *(v4u*)(xp + c) = o; } }
        }
    }
};
struct EpiGlu {
    static constexpr bool PERM = true, AFTER_DRAIN = false;
    bf16* xres; const float* __restrict__ modg; const float* __restrict__ bglu; int skip;
    __device__ __forceinline__ void operator()(const f32x4 (&acc)[2][2][4][2], const pg8::Unit& u, int wr, int wc, int fr, int fq) const {
        const int oc = u.pn * 128 + wc * 32 + fq * 8;
        const f32x4 ba0 = *(const f32x4*)(bglu + oc), ba1 = *(const f32x4*)(bglu + oc + 4), bg0 = *(const f32x4*)(bglu + 1024 + oc), bg1 = *(const f32x4*)(bglu + 1024 + oc + 4);
#pragma unroll
        for (int ai = 0; ai < 2; ++ai) {
            v4u x[4]; f32x4 g0[4], g1[4];
#pragma unroll
            for (int m = 0; m < 4; ++m) { const int r = u.pm * 256 + ai * 128 + wr * 64 + m * 16 + fr; const float* gp = modg + mrow_of(r) * 6144;
                g0[m] = *(const f32x4*)(gp + oc); g1[m] = *(const f32x4*)(gp + oc + 4); x[m] = *(const v4u*)(xres + (size_t)r * D + oc); }
            asm volatile("" ::: "memory");
#pragma unroll
            for (int m = 0; m < 4; ++m) { const int r = u.pm * 256 + ai * 128 + wr * 64 + m * 16 + fr;
                const f32x4 a0 = acc[ai][0][m][0] + ba0, a1 = acc[ai][0][m][1] + ba1, q0 = acc[ai][1][m][0] + bg0, q1 = acc[ai][1][m][1] + bg1;
                f32x4 v0, v1; v0.x = a0.x * sigmoidf_(q0.x); v0.y = a0.y * sigmoidf_(q0.y); v0.z = a0.z * sigmoidf_(q0.z); v0.w = a0.w * sigmoidf_(q0.w);
                v1.x = a1.x * sigmoidf_(q1.x); v1.y = a1.y * sigmoidf_(q1.y); v1.z = a1.z * sigmoidf_(q1.z); v1.w = a1.w * sigmoidf_(q1.w);
                v0 = v0 * g0[m]; v1 = v1 * g1[m]; const v4u xv = x[m];
                v4u o; o.x = pk2(bflo(xv.x) + v0.x, bfhi(xv.x) + v0.y); o.y = pk2(bflo(xv.y) + v0.z, bfhi(xv.y) + v0.w); o.z = pk2(bflo(xv.z) + v1.x, bfhi(xv.z) + v1.y); o.w = pk2(bflo(xv.w) + v1.z, bfhi(xv.w) + v1.w);
                if (!skip) *(v4u*)(xres + (size_t)r * D + oc) = o; }
        }
    }
};
__device__ __forceinline__ int kvrow_of(int r) { if (r < TC) return (r >> 8) * KVLEN + SEQ + (r & 255); const int rr = r - TC; return (rr >> 11) * KVLEN + (rr & 2047); }
struct EpiKvq {
    static constexpr bool PERM = false, AFTER_DRAIN = false;
    bf16* qb; bf16* kb; bf16* vb; const float* __restrict__ qg; const float* __restrict__ kg; const float* __restrict__ rope;
    __device__ __forceinline__ void operator()(const f32x4 (&acc)[2][2][4][2], const pg8::Unit& u, int wr, int wc, int fr, int fq) const {
        const int pn = u.pn;
        const float* gptr = (pn == 0) ? kg : qg;
        f32x4 gn[2][2];
#pragma unroll
        for (int bj = 0; bj < 2; ++bj)
#pragma unroll
            for (int n = 0; n < 2; ++n) gn[bj][n] = *(const f32x4*)(gptr + 32 * bj + 16 * n + 4 * fq);
#pragma unroll
        for (int ai = 0; ai < 2; ++ai)
#pragma unroll
            for (int m = 0; m < 4; ++m) {
                const int r = u.pm * 256 + ai * 128 + wr * 64 + m * 16 + fr;
                f32x4 x[2][2];
#pragma unroll
                for (int bj = 0; bj < 2; ++bj)
#pragma unroll
                    for (int n = 0; n < 2; ++n) x[bj][n] = acc[ai][bj][m][n];
                if (pn != 1) {
                    float ss = 0.f;
#pragma unroll
                    for (int bj = 0; bj < 2; ++bj)
#pragma unroll
                        for (int n = 0; n < 2; ++n) { const f32x4 v = x[bj][n]; ss += v.x * v.x + v.y * v.y + v.z * v.z + v.w * v.w; }
                    ss = xor16_sum(ss); ss = xor32_sum(ss);
                    const float rs = rsqrtf(ss * (1.f / 64.f) + EPS);
#pragma unroll
                    for (int bj = 0; bj < 2; ++bj)
#pragma unroll
                        for (int n = 0; n < 2; ++n) x[bj][n] = x[bj][n] * rs * gn[bj][n];
                    if (r >= TC) {
                        const int t = (r - TC) & 2047;
#pragma unroll
                        for (int bj = 0; bj < 2; ++bj) {
                            const int pos = bj == 0 ? (t >> 6) : (t & 63);
                            const f32x4 cs = *(const f32x4*)(rope + pos * 16 + 4 * fq), sn = *(const f32x4*)(rope + 1024 + pos * 16 + 4 * fq);
                            const f32x4 x1 = x[bj][0], x2 = x[bj][1];
                            x[bj][0] = x1 * cs - x2 * sn; x[bj][1] = x2 * cs + x1 * sn;
                        }
                    }
                }
                bf16* dst;
                if (pn == 0) dst = kb + (size_t)kvrow_of(r) * 256 + wc * 64;
                else if (pn == 1) dst = vb + (size_t)kvrow_of(r) * 256 + wc * 64;
                else { dst = qb + (size_t)r * D + ((pn - 2) * 4 + wc) * 64;
#pragma unroll
                    for (int bj = 0; bj < 2; ++bj)
#pragma unroll
                        for (int n = 0; n < 2; ++n) x[bj][n] = x[bj][n] * ATT_C2; }
#pragma unroll
                for (int bj = 0; bj < 2; ++bj)
#pragma unroll
                    for (int n = 0; n < 2; ++n) st_bf4(dst + 32 * bj + 16 * n + 4 * fq, x[bj][n]);
            }
    }
};
struct EpiMlIn {
    static constexpr bool PERM = true, AFTER_DRAIN = false;
    bf16 *k, *v, *q, *o; float* g; const float* bgate;
    __device__ __forceinline__ void operator()(const f32x4 (&acc)[2][2][4][2], const pg8::Unit& u, int wr, int wc, int fr, int fq) const {
        const int pn = u.pn;
#pragma unroll
        for (int ai = 0; ai < 2; ++ai)
#pragma unroll
            for (int m = 0; m < 4; ++m) {
                const int r = u.pm * 256 + ai * 128 + wr * 64 + m * 16 + fr;
#pragma unroll
                for (int bj = 0; bj < 2; ++bj) {
                    const int cc = bj * 128 + wc * 32 + fq * 8;
                    f32x4 a = acc[ai][bj][m][0], b = acc[ai][bj][m][1];
                    if (pn == 12) { if (cc < 32) { *(f32x4*)(g + (size_t)r * 32 + cc) = a + *(const f32x4*)(bgate + cc); *(f32x4*)(g + (size_t)r * 32 + cc + 4) = b + *(const f32x4*)(bgate + cc + 4); } continue; }
                    if (pn < 2) { a = a * 0.125f; b = b * 0.125f; }
                    v4u ov; ov.x = pk2(a.x, a.y); ov.y = pk2(a.z, a.w); ov.z = pk2(b.x, b.y); ov.w = pk2(b.z, b.w);
                    bf16* dst = (pn < 2) ? k + (size_t)r * 512 + pn * 256 + cc : (pn < 6) ? v + (size_t)r * 1024 + (pn - 2) * 256 + cc : (pn < 8) ? q + (size_t)r * 512 + (pn - 6) * 256 + cc : o + (size_t)r * 1024 + (pn - 8) * 256 + cc;
                    *(v4u*)dst = ov;
                }
            }
    }
};
struct EpiG1 {
    static constexpr bool PERM = false, AFTER_DRAIN = false;
    bf16* hid;
    __device__ __forceinline__ void operator()(const f32x4 (&acc)[2][2][4][2], const pg8::Unit& u, int wr, int wc, int fr, int fq) const {
        const int pnl = u.pn & 3;
#pragma unroll
        for (int ai = 0; ai < 2; ++ai)
#pragma unroll
            for (int m = 0; m < 4; ++m) {
                const int r = u.pm * 256 + ai * 128 + wr * 64 + m * 16 + fr;
#pragma unroll
                for (int bj = 0; bj < 2; ++bj) {
                    const int hc = pnl * 128 + bj * 64 + wc * 16 + fq * 4;
                    const f32x4 ga = acc[ai][bj][m][0], up = acc[ai][bj][m][1];
                    f32x4 h; h.x = siluf_(ga.x) * up.x; h.y = siluf_(ga.y) * up.y; h.z = siluf_(ga.z) * up.z; h.w = siluf_(ga.w) * up.w;
                    st_bf4(hid + (size_t)r * DFF + hc, h);
                }
            }
    }
};
struct EpiG2 {
    static constexpr bool PERM = true, AFTER_DRAIN = false;
    bf16* y2; const float* __restrict__ slotw;
    __device__ __forceinline__ void operator()(const f32x4 (&acc)[2][2][4][2], const pg8::Unit& u, int wr, int wc, int fr, int fq) const {
        const int pnl = u.pn & 3;
#pragma unroll
        for (int ai = 0; ai < 2; ++ai)
#pragma unroll
            for (int m = 0; m < 4; ++m) {
                const int r = u.pm * 256 + ai * 128 + wr * 64 + m * 16 + fr;
                const float w = slotw[r];
#pragma unroll
                for (int bj = 0; bj < 2; ++bj) {
                    const int c = pnl * 256 + bj * 128 + wc * 32 + fq * 8;
                    const f32x4 a = acc[ai][bj][m][0] * w, b = acc[ai][bj][m][1] * w;
                    v4u o; o.x = pk2(a.x, a.y); o.y = pk2(a.z, a.w); o.z = pk2(b.x, b.y); o.w = pk2(b.z, b.w);
                    *(v4u*)(y2 + (size_t)r * D + c) = o;
                }
            }
    }
};

struct CmNat { const float* W; int ld; __device__ __forceinline__ const float* col(int j) const { return W + j; } };
struct CmGlu { const float* W; int ld;
    __device__ __forceinline__ const float* col(int j) const { const int pn = j >> 8, gpart = (j >> 7) & 1, c = j & 127; return W + gpart * 1024 + 128 * pn + c; } };
struct CmKvq { const float* W; int ld;
    __device__ __forceinline__ const float* col(int j) const { const int pn = j >> 8, bj = (j >> 7) & 1, wc = (j >> 5) & 3, n = (j >> 4) & 1, q = j & 15; return W + 256 * pn + 64 * wc + 32 * bj + 16 * n + q; } };
struct CmMlIn { const float* W; int ld;
    __device__ __forceinline__ const float* col(int j) const {
        if (j < 1536) return W + j;
        if (j < 2048) return W + 1568 + (j - 1536);
        if (j < 3072) return W + 2080 + (j - 2048);
        if (j < 3104) return W + 1536 + (j - 3072);
        return nullptr; } };
struct CmG1 { const float* Wg; const float* Wu; int ld;
    __device__ __forceinline__ const float* col(int j) const { const int le = j >> 10, jj = j & 1023; const int pn = jj >> 8, bj = (jj >> 7) & 1, wc = (jj >> 5) & 3, n = (jj >> 4) & 1, q = jj & 15;
        const uintptr_t a = (uintptr_t)Wg, b = (uintptr_t)Wu, msk = (uintptr_t)0 - (uintptr_t)n;
        return (const float*)((a & ~msk) | (b & msk)) + (size_t)le * 1024 * 512 + 128 * pn + 64 * bj + 16 * wc + q; } };
struct CmG2 { const float* Wd; int ld;
    __device__ __forceinline__ const float* col(int j) const { const int le = j >> 10, jj = j & 1023; return Wd + (size_t)le * 512 * 1024 + jj; } };

template <class CM>
__device__ __forceinline__ void transpose_item(const CM& cm, int K, bf16* WT, int kb, int nb, LAS float* scr, int lane) {
    const int k0 = 64 * kb, n0 = 32 * nb;
    const int nq = (lane & 7) * 4;
    const float* cp = cm.col(n0 + nq);
    const size_t ld = (size_t)cm.ld;
    f32x4 v[8];
#pragma unroll
    for (int i = 0; i < 8; ++i) { const int kk = 8 * i + (lane >> 3); v[i] = cp ? *(const f32x4*)(cp + (size_t)(k0 + kk) * ld) : (f32x4){0.f, 0.f, 0.f, 0.f}; }
#pragma unroll
    for (int i = 0; i < 8; ++i) { const int kk = 8 * i + (lane >> 3); LAS float* d = scr + kk * 33 + nq; d[0] = v[i].x; d[1] = v[i].y; d[2] = v[i].z; d[3] = v[i].w; }
    LDS_WAIT(); asm volatile("" ::: "memory");
    const int c = lane & 7;
#pragma unroll
    for (int j = 0; j < 4; ++j) { const int n = (lane >> 3) + 8 * j; const LAS float* s = scr + (8 * c) * 33 + n;
        v4u o; o.x = pk2(s[0 * 33], s[1 * 33]); o.y = pk2(s[2 * 33], s[3 * 33]); o.z = pk2(s[4 * 33], s[5 * 33]); o.w = pk2(s[6 * 33], s[7 * 33]);
        *(v4u*)(WT + (size_t)(n0 + n) * K + k0 + 8 * c) = o; }
    LDS_WAIT(); asm volatile("" ::: "memory");
}
template <class CM>
__device__ __forceinline__ void transpose_all(Frame& F, const CM& cm, int K, int Ndest, bf16* WT, int rot) {
    LAS float* scr = (LAS float*)(F.lds + RING_OFF + F.wave * 16384);
    const int NGW = F.G * NWAVES, gw = (F.blk * NWAVES + F.wave + rot) % NGW;
    const int nblk = Ndest / 32, items = (K / 64) * nblk;
    for (int it = gw; it < items; it += NGW) transpose_item(cm, K, WT, it / nblk, it % nblk, scr, F.lane);
}

__device__ __forceinline__ void phase_prologue(Frame& F) {
    {
        LAS float* cond = (LAS float*)(F.lds);
        LAS float* red = (LAS float*)(F.lds + 40960);
        for (int i = F.tid; i < 9 * 1024; i += NTHR) { const int mb = i >> 10, k = i & 1023; const float v = (mb < 8) ? F.in[IN_C][mb * 1024 + k] : F.in[IN_CCTX][k]; cond[i] = siluf_(v); }
        __syncthreads();
        float* mod = (float*)(F.ws + WS_MOD);
        for (int it = F.blk; it < DEPTH * 48; it += F.G) {
            const int l = it / 48, n0 = (it % 48) * 128;
            const float* w = F.in[IN_ADAW] + (size_t)l * 1024 * 6144 + n0 + 2 * F.lane;
            f32x2 a[9];
#pragma unroll
            for (int mb = 0; mb < 9; ++mb) a[mb] = (f32x2){0.f, 0.f};
            const int kb = F.wave * 128;
            for (int k8 = 0; k8 < 128; k8 += 8) {
                f32x2 wv[8];
#pragma unroll
                for (int u = 0; u < 8; ++u) wv[u] = *(const f32x2*)(w + (size_t)(kb + k8 + u) * 6144);
#pragma unroll
                for (int u = 0; u < 8; ++u)
#pragma unroll
                    for (int mb = 0; mb < 9; ++mb) a[mb] += wv[u] * cond[mb * 1024 + kb + k8 + u];
            }
#pragma unroll
            for (int mb = 0; mb < 9; ++mb) *(LAS f32x2*)(red + (F.wave * 9 + mb) * 128 + 2 * F.lane) = a[mb];
            __syncthreads();
            for (int i = F.tid; i < 9 * 128; i += NTHR) { const int mb = i >> 7, ln = i & 127; float s = F.in[IN_ADAB][l * 6144 + n0 + ln];
#pragma unroll
                for (int wv = 0; wv < 8; ++wv) s += red[(wv * 9 + mb) * 128 + ln];
                mod[(size_t)(l * 9 + mb) * 6144 + n0 + ln] = s; }
            __syncthreads();
        }
    }
    { const int idx = F.blk * NTHR + F.tid;
      if (idx < 1024) { const int pos = idx >> 4, f = idx & 15; const float inv = exp2f(-(float)f * (13.287712379549449f / 16.f)); const float ang = (float)pos * inv;
          double s, c; sincos_d((double)ang, s, c); float* rope = (float*)(F.ws + WS_ROPE); rope[idx] = (float)c; rope[1024 + idx] = (float)s; } }
    __syncthreads();
    { CmGlu cm{F.in[IN_S5WGLU], 2048}; transpose_all(F, cm, 1024, 2048, (bf16*)(F.ws + WS_WGLU), 0); }
    { CmGlu cm{F.in[IN_S5WGLU] + (size_t)1024 * 2048, 2048}; transpose_all(F, cm, 1024, 2048, (bf16*)(F.ws + WS_WGLU) + (size_t)2048 * 1024, 1024); }
    { CmKvq cm{F.in[IN_AWKVQ], 1536}; transpose_all(F, cm, 1024, 1536, (bf16*)(F.ws + WS_WKVQ), 0); }
    { CmNat cm{F.in[IN_AWO], 1024}; transpose_all(F, cm, 1024, 1024, (bf16*)(F.ws + WS_WO), 768); }
    { CmMlIn cm{F.in[IN_MLWIN], 3104}; transpose_all(F, cm, 1024, ML_NIN, (bf16*)(F.ws + WS_WIN), 1280); }
    { CmNat cm{F.in[IN_MLWOUT], 1024}; transpose_all(F, cm, 1024, 1024, (bf16*)(F.ws + WS_WOUT), 896); }
    { CmG1 cm{F.in[IN_MWG], F.in[IN_MWU], 512}; transpose_all(F, cm, 1024, DEPTH * NEXP * 1024, (bf16*)(F.ws + WS_WG1), 1408); }
    { CmG2 cm{F.in[IN_MWD], 1024}; transpose_all(F, cm, 512, DEPTH * NEXP * 1024, (bf16*)(F.ws + WS_WG2), 1408); }
}

struct RowMod { f32x4 a[4], b[4], c[4]; int mr; };
__device__ __forceinline__ void rowmod_load(RowMod& M, const float* base, int mr, int oa, int ob, int oc, int lane) {
    if (mr == M.mr) return; M.mr = mr; const float* p = base + (size_t)mr * 6144;
#pragma unroll
    for (int j = 0; j < 4; ++j) { M.a[j] = *(const f32x4*)(p + oa + 4 * lane + 256 * j); M.b[j] = *(const f32x4*)(p + ob + 4 * lane + 256 * j); if (oc >= 0) M.c[j] = *(const f32x4*)(p + oc + 4 * lane + 256 * j); }
}
struct RawRow { f32x4 x[4]; v2u ya[4], yb[4]; };
template <bool COMB, bool XBF>
__device__ __forceinline__ void raw_load(RawRow& R, const void* xrow, const bf16* y2, int s0, int s1, int lane) {
#pragma unroll
    for (int j = 0; j < 4; ++j) {
        if (XBF) { const v2u w = *(const v2u*)((const bf16*)xrow + 4 * lane + 256 * j); R.x[j] = (f32x4){bflo(w.x), bfhi(w.x), bflo(w.y), bfhi(w.y)}; }
        else R.x[j] = *(const f32x4*)((const float*)xrow + 4 * lane + 256 * j);
        if (COMB) { R.ya[j] = *(const v2u*)(y2 + (size_t)s0 * D + 4 * lane + 256 * j); R.yb[j] = *(const v2u*)(y2 + (size_t)s1 * D + 4 * lane + 256 * j); } }
}
template <int L>
__device__ __forceinline__ void phase_a1(Frame& F, const int skip = 0) {
    const float* mod = (const float*)(F.ws + WS_MOD);
    bf16* xres = (bf16*)(F.ws + WS_XRES); bf16* hb = (bf16*)(F.ws + WS_H);
    const bf16* y2 = (const bf16*)(F.ws + WS_Y2); const int* toks = (const int*)(F.ws + WS_TOKS);
    const int gw = F.blk * NWAVES + F.wave, NGW = F.G * NWAVES, lane = F.lane;
    const int RPW = (T + NGW - 1) / NGW, r0 = gw * RPW, r1 = (r0 + RPW < T) ? r0 + RPW : T;
    if (r0 >= T) return;
    f32x4 gv[4];
#pragma unroll
    for (int j = 0; j < 4; ++j) gv[j] = *(const f32x4*)(F.in[IN_N1G] + L * D + 4 * lane + 256 * j);
    auto rowptr = [&](int r) -> const void* { if (L == 0) return (r < TC) ? (const void*)(F.in[IN_CTX] + (size_t)r * D) : (const void*)(F.in[IN_X] + (size_t)(r - TC) * D); return (const void*)(xres + (size_t)r * D); };
    RowMod M1, M2; M1.mr = -1; M2.mr = -1;
    int ns0 = 0, ns1 = 0;
    if (L > 0) { ns0 = toks[2 * r0]; ns1 = toks[2 * r0 + 1]; }
    RawRow nx; raw_load<(L > 0), (L > 0)>(nx, rowptr(r0), y2, ns0, ns1, lane);
    if (L > 0 && r0 + 1 < r1) { ns0 = toks[2 * r0 + 2]; ns1 = toks[2 * r0 + 3]; }
    for (int r = r0; r < r1; ++r) {
        const int mr = mrow_of(r);
        RawRow cur = nx;
        if (r + 1 < r1) { raw_load<(L > 0), (L > 0)>(nx, rowptr(r + 1), y2, ns0, ns1, lane); if (L > 0 && r + 2 < r1) { ns0 = toks[2 * r + 4]; ns1 = toks[2 * r + 5]; } }
        rowmod_load(M1, mod + (size_t)L * 9 * 6144, mr, 0, 1024, -1, lane);
        if (L > 0) rowmod_load(M2, mod + (size_t)(L - 1) * 9 * 6144, mr, 5120, 5120, -1, lane);
        float ss = 0.f;
#pragma unroll
        for (int j = 0; j < 4; ++j) {
            f32x4 v = cur.x[j];
            if (L > 0) { const v2u a = cur.ya[j], b = cur.yb[j]; const f32x4 gg = M2.a[j];
                v.x += gg.x * (bflo(a.x) + bflo(b.x)); v.y += gg.y * (bfhi(a.x) + bfhi(b.x)); v.z += gg.z * (bflo(a.y) + bflo(b.y)); v.w += gg.w * (bfhi(a.y) + bfhi(b.y)); }
            cur.x[j] = v;
            if (!skip) st_bf4(xres + (size_t)r * D + 4 * lane + 256 * j, v); ss += v.x * v.x + v.y * v.y + v.z * v.z + v.w * v.w;
        }
        const float rs = rsqrtf(wave_sum(ss) * (1.f / D) + EPS);
#pragma unroll
        for (int j = 0; j < 4; ++j) { const f32x4 h = cur.x[j] * rs * gv[j] * (M1.b[j] + 1.f) + M1.a[j]; st_bf4(hb + (size_t)r * D + 4 * lane + 256 * j, h); }
    }
}
__device__ __forceinline__ float quad_get(float v, int k) {
    return k == 1 ? dpp_f<0x39>(v, v) : k == 2 ? dpp_f<0x4E>(v, v) : dpp_f<0x93>(v, v); }
template <int L>
__device__ __forceinline__ void phase_n2(Frame& F, const int var = 0) {
    constexpr int R0 = (L == DEPTH - 1) ? TC : 0;
    const float* mod = (const float*)(F.ws + WS_MOD);
    const bf16* xres = (const bf16*)(F.ws + WS_XRES); bf16* hb = (bf16*)(F.ws + WS_H);
    int* toke = (int*)(F.ws + WS_TOKE); int* tokr = (int*)(F.ws + WS_TOKR); float* tokw = (float*)(F.ws + WS_TOKW); int* bcnt = (int*)(F.ws + WS_BCNT);
    LAS v4u* rwf = (LAS v4u*)(F.lds);
    LAS float* PS = (LAS float*)(F.lds + 65536);
    LAS float* PL = (LAS float*)(F.lds + 65536 + 1024);
    LAS int* cntL = (LAS int*)(F.lds + SCT_OFF);
    for (int i = F.tid; i < 32 * 64; i += NTHR) { const int ks = i >> 6, ln = i & 63, e = ln & 15, k0 = 32 * ks + 8 * (ln >> 4);
        float w[8]; unsigned hi[4], lo[4];
#pragma unroll
        for (int jj = 0; jj < 8; ++jj) w[jj] = F.in[IN_RW][(k0 + jj) * 16 + e];
#pragma unroll
        for (int jj = 0; jj < 4; ++jj) { hi[jj] = pk2(w[2 * jj], w[2 * jj + 1]); lo[jj] = pk2(w[2 * jj] - bflo(hi[jj]), w[2 * jj + 1] - bfhi(hi[jj])); }
        rwf[2 * i] = (v4u){hi[0], hi[1], hi[2], hi[3]}; rwf[2 * i + 1] = (v4u){lo[0], lo[1], lo[2], lo[3]}; }
    if (F.tid < 16) cntL[F.tid] = 0;
    __syncthreads();
    const int lane = F.lane, rl = lane & 15, kg = lane >> 4, w = F.wave;
    const float rbias = F.in[IN_RB][rl];
    constexpr int NTILES = (T - R0) / 16;
    const int ntl = (NTILES - F.blk + F.G - 1) / F.G;
    const int c0 = 128 * w + 8 * kg;
    v4u xw4[4];
    if (ntl > 0) { const bf16* xr = xres + (size_t)(R0 + 16 * F.blk + rl) * D + c0;
#pragma unroll
        for (int q = 0; q < 4; ++q) xw4[q] = *(const v4u*)(xr + 32 * q); }
    for (int j = 0; j < ntl; ++j) {
        const int tile = F.blk + F.G * j, rbase = R0 + 16 * tile, mr = mrow_of(rbase), pb = j & 1;
        f32x4 ca[4], cb[4]; float ss = 0.f;
#pragma unroll
        for (int q = 0; q < 4; ++q) { const v4u t = xw4[q]; ca[q] = (f32x4){bflo(t.x), bfhi(t.x), bflo(t.y), bfhi(t.y)}; cb[q] = (f32x4){bflo(t.z), bfhi(t.z), bflo(t.w), bfhi(t.w)};
            ss += ca[q].x * ca[q].x + ca[q].y * ca[q].y + ca[q].z * ca[q].z + ca[q].w * ca[q].w + cb[q].x * cb[q].x + cb[q].y * cb[q].y + cb[q].z * cb[q].z + cb[q].w * cb[q].w; }
        ss = xor16_sum(ss); ss = xor32_sum(ss);
        if (kg == 0) PS[(pb * 8 + w) * 16 + rl] = ss;
        if (j + 1 < ntl) { const bf16* xr = xres + (size_t)(R0 + 16 * (tile + F.G) + rl) * D + c0;
#pragma unroll
            for (int q = 0; q < 4; ++q) xw4[q] = *(const v4u*)(xr + 32 * q); }
        __syncthreads();
        float tot = 0.f;
#pragma unroll
        for (int ww = 0; ww < 8; ++ww) tot += PS[(pb * 8 + ww) * 16 + rl];
        const float rs = rsqrtf(tot * (1.f / D) + EPS);
        const float* gp = F.in[IN_N2G] + L * D + c0; const float* shp = mod + (size_t)(L * 9 + mr) * 6144 + 3072 + c0; const float* scp = shp + 1024;
        bf16* hrow = hb + (size_t)(rbase + rl) * D + c0;
        f32x4 acc = (f32x4){0.f, 0.f, 0.f, 0.f};
#pragma unroll
        for (int q = 0; q < 4; ++q) {
            float h[8];
            { const f32x4 g0 = *(const f32x4*)(gp + 32 * q), g1 = *(const f32x4*)(gp + 32 * q + 4), cc0 = *(const f32x4*)(scp + 32 * q), cc1 = *(const f32x4*)(scp + 32 * q + 4), s0 = *(const f32x4*)(shp + 32 * q), s1 = *(const f32x4*)(shp + 32 * q + 4);
              const f32x4 h0 = ca[q] * rs * g0 * (cc0 + 1.f) + s0, h1 = cb[q] * rs * g1 * (cc1 + 1.f) + s1;
              h[0] = h0.x; h[1] = h0.y; h[2] = h0.z; h[3] = h0.w; h[4] = h1.x; h[5] = h1.y; h[6] = h1.z; h[7] = h1.w; }
            unsigned hi[4], lo[4];
#pragma unroll
            for (int jj = 0; jj < 4; ++jj) { hi[jj] = pk2(h[2 * jj], h[2 * jj + 1]); lo[jj] = pk2(h[2 * jj] - bflo(hi[jj]), h[2 * jj + 1] - bfhi(hi[jj])); }
            const v4u hv = (v4u){hi[0], hi[1], hi[2], hi[3]}, lv = (v4u){lo[0], lo[1], lo[2], lo[3]};
            *(v4u*)(hrow + 32 * q) = hv;
            const int ks = 4 * w + q;
            const v4u bh = rwf[2 * (ks * 64 + lane)], bl = rwf[2 * (ks * 64 + lane) + 1];
            acc = __builtin_amdgcn_mfma_f32_16x16x32_bf16(__builtin_bit_cast(bf16x8, hv), __builtin_bit_cast(bf16x8, bh), acc, 0, 0, 0);
            acc = __builtin_amdgcn_mfma_f32_16x16x32_bf16(__builtin_bit_cast(bf16x8, hv), __builtin_bit_cast(bf16x8, bl), acc, 0, 0, 0);
            acc = __builtin_amdgcn_mfma_f32_16x16x32_bf16(__builtin_bit_cast(bf16x8, lv), __builtin_bit_cast(bf16x8, bh), acc, 0, 0, 0);
        }
        *(LAS f32x4*)(PL + ((pb * 8 + w) * 64 + lane) * 4) = acc;
        __syncthreads();
        if (w != (j & 7) || (var & 1)) continue;
        f32x4 lg = (f32x4){0.f, 0.f, 0.f, 0.f};
#pragma unroll
        for (int ww = 0; ww < 8; ++ww) lg = lg + *(const LAS f32x4*)(PL + ((pb * 8 + ww) * 64 + lane) * 4);
#pragma unroll
        for (int r = 0; r < 4; ++r) {
            const float sco = sigmoidf_(lg[r]), sel = sco + rbias;
            int rank = 0;
#pragma unroll
            for (int k = 1; k < 4; ++k) { const float o = quad_get(sel, k); const int oi = (rl & ~3) | ((rl + k) & 3); rank += (o > sel || (o == sel && oi < rl)) ? 1 : 0; }
            const bool top2 = rank < 2;
            float gs = top2 ? sel : 0.f; gs += dpp_f<0xB1>(0.f, gs); gs += dpp_f<0x4E>(0.f, gs);
            bool best = true; const int q = rl >> 2;
            { const float o1 = dpp_f<0x124>(gs, gs), o2 = dpp_f<0x128>(gs, gs), o3 = dpp_f<0x12C>(gs, gs);
              const int q1 = (q + 3) & 3, q2 = (q + 2) & 3, q3 = (q + 1) & 3;
              best = !(o1 > gs || (o1 == gs && q1 < q)) && !(o2 > gs || (o2 == gs && q2 < q)) && !(o3 > gs || (o3 == gs && q3 < q)); }
            const bool selv = best && top2;
            const float wsum = red16_sum(selv ? sco : 0.f);
            if (selv) { const int row = rbase + 4 * kg + r;
                const int lr = __hip_atomic_fetch_add(cntL + rl, 1, __ATOMIC_RELAXED, __HIP_MEMORY_SCOPE_WORKGROUP);
                toke[2 * row + rank] = rl; tokr[2 * row + rank] = lr; tokw[2 * row + rank] = sco * __builtin_amdgcn_rcpf(wsum); }
        }
    }
    __syncthreads();
    if (F.tid < 16 && !(var & 1)) bcnt[F.blk * 16 + F.tid] = cntL[F.tid];
}
template <int L>
__device__ __forceinline__ void phase_sc(Frame& F) {
    constexpr int R0 = (L == DEPTH - 1) ? TC : 0;
    const int* bcnt = (const int*)(F.ws + WS_BCNT);
    LAS int* pt = (LAS int*)(F.lds);
    LAS int* tt = (LAS int*)(F.lds + 8192);
    { const int e = F.tid & 15, ch = F.tid >> 4; int tot = 0, mine = 0;
      for (int b = ch; b < F.G; b += 32) { const int c = bcnt[b * 16 + e]; tot += c; mine += (b < F.blk) ? c : 0; }
      pt[ch * 16 + e] = tot; pt[512 + ch * 16 + e] = mine; }
    __syncthreads();
    if (F.tid < 16) { int tot = 0, mine = 0; for (int ch = 0; ch < 32; ++ch) { tot += pt[ch * 16 + F.tid]; mine += pt[512 + ch * 16 + F.tid]; } tt[F.tid] = tot; tt[16 + F.tid] = mine; }
    __syncthreads();
    if (F.tid == 0) { int ts = 0; int* etab = (int*)(F.ws + WS_ETAB);
        for (int e = 0; e < 16; ++e) { tt[32 + e] = ts * 256 + tt[16 + e]; if (F.blk == 0) etab[e] = ts; ts += (tt[e] + 255) >> 8; }
        if (F.blk == 0) etab[16] = ts; }
    __syncthreads();
    const int* toke = (const int*)(F.ws + WS_TOKE); const int* tokr = (const int*)(F.ws + WS_TOKR); const float* tokw = (const float*)(F.ws + WS_TOKW);
    int* toks = (int*)(F.ws + WS_TOKS); float* slotw = (float*)(F.ws + WS_SLOTW);
    const bf16* hb = (const bf16*)(F.ws + WS_H); bf16* hs = (bf16*)(F.ws + WS_HS);
    const int lane = F.lane;
    constexpr int NTILES = (T - R0) / 16;
    for (int tile = F.blk + F.G * F.wave; tile < NTILES; tile += F.G * NWAVES) {
        const int rbase = R0 + 16 * tile;
        int slot = 0;
        if (lane < 32) { const int idx = 2 * rbase + lane; const int e = toke[idx]; slot = tt[32 + e] + tokr[idx]; toks[idx] = slot; slotw[slot] = tokw[idx]; }
#pragma unroll 4
        for (int i = 0; i < 16; ++i) {
            const int s0 = __builtin_amdgcn_readlane(slot, 2 * i), s1 = __builtin_amdgcn_readlane(slot, 2 * i + 1); const int r = rbase + i;
#pragma unroll
            for (int j = 0; j < 2; ++j) { const v4u a = *(const v4u*)(hb + (size_t)r * D + 8 * lane + 512 * j);
                *(v4u*)(hs + (size_t)s0 * D + 8 * lane + 512 * j) = a; *(v4u*)(hs + (size_t)s1 * D + 8 * lane + 512 * j) = a; }
        }
    }
}
__device__ __forceinline__ void load_etab(Frame& F) {
    LAS int* tab = (LAS int*)(F.lds + ETAB_OFF);
    if (F.tid < 17) tab[F.tid] = ((const int*)(F.ws + WS_ETAB))[F.tid];
    __syncthreads();
}
__device__ __forceinline__ void phase_fin(Frame& F) {
    const float* mod = (const float*)(F.ws + WS_MOD);
    const bf16* xres = (const bf16*)(F.ws + WS_XRES);
    const bf16* y2 = (const bf16*)(F.ws + WS_Y2); const int* toks = (const int*)(F.ws + WS_TOKS);
    const int gw = F.blk * NWAVES + F.wave, NGW = F.G * NWAVES, lane = F.lane;
    const int RPW = (TL + NGW - 1) / NGW, r0 = TC + gw * RPW, r1 = (r0 + RPW < T) ? r0 + RPW : T;
    if (r0 >= T) return;
    f32x4 gv[4];
#pragma unroll
    for (int j = 0; j < 4; ++j) gv[j] = *(const f32x4*)(F.in[IN_FING] + 4 * lane + 256 * j);
    RowMod M2; M2.mr = -1;
    int ns0 = toks[2 * r0], ns1 = toks[2 * r0 + 1];
    RawRow nx; raw_load<true, true>(nx, xres + (size_t)r0 * D, y2, ns0, ns1, lane);
    if (r0 + 1 < r1) { ns0 = toks[2 * r0 + 2]; ns1 = toks[2 * r0 + 3]; }
    for (int r = r0; r < r1; ++r) {
        const int mr = mrow_of(r);
        RawRow cur = nx;
        if (r + 1 < r1) { raw_load<true, true>(nx, xres + (size_t)(r + 1) * D, y2, ns0, ns1, lane); if (r + 2 < r1) { ns0 = toks[2 * r + 4]; ns1 = toks[2 * r + 5]; } }
        rowmod_load(M2, mod + (size_t)(DEPTH - 1) * 9 * 6144, mr, 5120, 5120, -1, lane);
        float ss = 0.f;
#pragma unroll
        for (int j = 0; j < 4; ++j) { f32x4 v = cur.x[j]; const v2u a = cur.ya[j], b = cur.yb[j]; const f32x4 gg = M2.a[j];
            v.x += gg.x * (bflo(a.x) + bflo(b.x)); v.y += gg.y * (bfhi(a.x) + bfhi(b.x)); v.z += gg.z * (bflo(a.y) + bflo(b.y)); v.w += gg.w * (bfhi(a.y) + bfhi(b.y));
            cur.x[j] = v; ss += v.x * v.x + v.y * v.y + v.z * v.z + v.w * v.w; }
        const float rs = rsqrtf(wave_sum(ss) * (1.f / D) + EPS);
#pragma unroll
        for (int j = 0; j < 4; ++j) *(f32x4*)(F.out + (size_t)(r - TC) * D + 4 * lane + 256 * j) = cur.x[j] * rs * gv[j];
    }
}

__device__ __forceinline__ int seq_row(int b, int dir, int s) {
    if (s < CTX) return b * CTX + (dir ? (CTX - 1 - s) : s);
    const int t = s - CTX; return TC + b * SEQ + (dir ? (SEQ - 1 - t) : t);
}
template <int J, bool WCTX>
__device__ __forceinline__ void phase_s5_naive(Frame& F) {
    const int gw = F.blk * NWAVES + F.wave, lane = F.lane;
    if ((gw & 3) != 0) return;
    const int it = gw >> 2; if (it >= NB * 64) return;
    const int b = it >> 6, g = it & 63, p = lane;
    const bf16* hb = (const bf16*)(F.ws + WS_H); float* ysum = (float*)(F.ws + WS_YSUM);
    for (int dir = 0; dir < 2; ++dir) {
        const int gi = (J * 2 + dir) * 64 + g, pidx = gi * 64 + p;
        const float lam_re = F.in[IN_S5LRE][pidx], lam_im = F.in[IN_S5LIM][pidx];
        const float dt = expf(F.in[IN_S5LOG][gi]);
        const float mag = expf(lam_re * dt);
        double sd, cd; sincos_d((double)(lam_im * dt), sd, cd);
        const float a_re = mag * (float)cd, a_im = mag * (float)sd;
        const float den = lam_re * lam_re + lam_im * lam_im, n_re = a_re - 1.f, n_im = a_im;
        const float f_re = (n_re * lam_re + n_im * lam_im) / den, f_im = (n_im * lam_re - n_re * lam_im) / den;
        float bbr[16], bbi[16], cre[16], cim[16];
#pragma unroll
        for (int c = 0; c < 16; ++c) { const float br = F.in[IN_S5BRE][(size_t)pidx * 16 + c], bi = F.in[IN_S5BIM][(size_t)pidx * 16 + c];
            bbr[c] = f_re * br - f_im * bi; bbi[c] = f_re * bi + f_im * br;
            cre[c] = F.in[IN_S5CRE][((size_t)gi * 16 + c) * 64 + p]; cim[c] = F.in[IN_S5CIM][((size_t)gi * 16 + c) * 64 + p]; }
        float x_re = 0.f, x_im = 0.f;
        for (int s = 0; s < CTX + SEQ; ++s) {
            const int r = seq_row(b, dir, s);
            const v4u u0 = *(const v4u*)(hb + (size_t)r * D + g * 16), u1 = *(const v4u*)(hb + (size_t)r * D + g * 16 + 8);
            float u[16];
            u[0] = bflo(u0.x); u[1] = bfhi(u0.x); u[2] = bflo(u0.y); u[3] = bfhi(u0.y); u[4] = bflo(u0.z); u[5] = bfhi(u0.z); u[6] = bflo(u0.w); u[7] = bfhi(u0.w);
            u[8] = bflo(u1.x); u[9] = bfhi(u1.x); u[10] = bflo(u1.y); u[11] = bfhi(u1.y); u[12] = bflo(u1.z); u[13] = bfhi(u1.z); u[14] = bflo(u1.w); u[15] = bfhi(u1.w);
            float bur = 0.f, bui = 0.f;
#pragma unroll
            for (int c = 0; c < 16; ++c) { bur += u[c] * bbr[c]; bui += u[c] * bbi[c]; }
            const float nr = a_re * x_re - a_im * x_im + bur, ni = a_re * x_im + a_im * x_re + bui;
            x_re = nr; x_im = ni;
            if (WCTX || s >= CTX) {
                float yv = 0.f;
#pragma unroll
                for (int c = 0; c < 16; ++c) { const float t = wave_sum(x_re * cre[c] - x_im * cim[c]); if (lane == c) yv = t; }
                if (lane < 16) { float* yp = ysum + (size_t)r * D + g * 16 + lane; if (dir == 0) *yp = yv; else *yp = *yp + yv; }
            }
        }
    }
}
template <int J, bool WCTX>
__device__ __forceinline__ void phase_s5_combine(Frame& F) {
    constexpr int R0 = WCTX ? 0 : TC;
    const bf16* hb = (const bf16*)(F.ws + WS_H); const float* ysum = (const float*)(F.ws + WS_YSUM); bf16* zb = (bf16*)(F.ws + WS_Z);
    const int gw = F.blk * NWAVES + F.wave, NGW = F.G * NWAVES, lane = F.lane;
    f32x4 dv[4];
#pragma unroll
    for (int j = 0; j < 4; ++j) dv[j] = *(const f32x4*)(F.in[IN_S5D] + J * D + 4 * lane + 256 * j);
    for (int r = R0 + gw; r < T; r += NGW) {
#pragma unroll
        for (int j = 0; j < 4; ++j) {
            const f32x4 y = *(const f32x4*)(ysum + (size_t)r * D + 4 * lane + 256 * j);
            const v2u hv = *(const v2u*)(hb + (size_t)r * D + 4 * lane + 256 * j);
            f32x4 z; z.x = gelu_tanh(y.x + dv[j].x * bflo(hv.x)); z.y = gelu_tanh(y.y + dv[j].y * bfhi(hv.x)); z.z = gelu_tanh(y.z + dv[j].z * bflo(hv.y)); z.w = gelu_tanh(y.w + dv[j].w * bfhi(hv.y));
            st_bf4(zb + (size_t)r * D + 4 * lane + 256 * j, z);
        }
    }
}
template <bool WCTX>
__device__ __forceinline__ void phase_attn_naive(Frame& F) {
    constexpr int R0 = WCTX ? 0 : TC;
    const bf16* qb = (const bf16*)(F.ws + WS_QB); const bf16* kb = (const bf16*)(F.ws + WS_KB); const bf16* vb = (const bf16*)(F.ws + WS_VB); bf16* zb = (bf16*)(F.ws + WS_Z);
    const int gw = F.blk * NWAVES + F.wave, NGW = F.G * NWAVES, lane = F.lane;
    for (int it = gw; it < (T - R0) * 16; it += NGW) {
        const int r = R0 + (it >> 4), h = it & 15, kvh = h >> 2;
        int kv0, nk;
        if (r < TC) { kv0 = (r >> 8) * KVLEN + SEQ; nk = CTX; } else { kv0 = ((r - TC) >> 11) * KVLEN; nk = KVLEN; }
        float q[64];
#pragma unroll
        for (int c = 0; c < 8; ++c) { const v4u w = *(const v4u*)(qb + (size_t)r * D + h * 64 + 8 * c);
            q[8 * c] = bflo(w.x); q[8 * c + 1] = bfhi(w.x); q[8 * c + 2] = bflo(w.y); q[8 * c + 3] = bfhi(w.y); q[8 * c + 4] = bflo(w.z); q[8 * c + 5] = bfhi(w.z); q[8 * c + 6] = bflo(w.w); q[8 * c + 7] = bfhi(w.w); }
        float m = -INFINITY, l = 0.f, o[64];
#pragma unroll
        for (int d = 0; d < 64; ++d) o[d] = 0.f;
        for (int kk = lane; kk < nk; kk += 64) {
            const bf16* kp = kb + (size_t)(kv0 + kk) * 256 + kvh * 64; const bf16* vp = vb + (size_t)(kv0 + kk) * 256 + kvh * 64;
            float s = 0.f;
#pragma unroll
            for (int c = 0; c < 8; ++c) { const v4u w = *(const v4u*)(kp + 8 * c);
                s += q[8 * c] * bflo(w.x) + q[8 * c + 1] * bfhi(w.x) + q[8 * c + 2] * bflo(w.y) + q[8 * c + 3] * bfhi(w.y) + q[8 * c + 4] * bflo(w.z) + q[8 * c + 5] * bfhi(w.z) + q[8 * c + 6] * bflo(w.w) + q[8 * c + 7] * bfhi(w.w); }
            const float mn = fmaxf(m, s), sc = exp2f(m - mn), pp = exp2f(s - mn);
            l = l * sc + pp; m = mn;
#pragma unroll
            for (int c = 0; c < 8; ++c) { const v4u w = *(const v4u*)(vp + 8 * c);
                o[8 * c] = o[8 * c] * sc + pp * bflo(w.x); o[8 * c + 1] = o[8 * c + 1] * sc + pp * bfhi(w.x); o[8 * c + 2] = o[8 * c + 2] * sc + pp * bflo(w.y); o[8 * c + 3] = o[8 * c + 3] * sc + pp * bfhi(w.y);
                o[8 * c + 4] = o[8 * c + 4] * sc + pp * bflo(w.z); o[8 * c + 5] = o[8 * c + 5] * sc + pp * bfhi(w.z); o[8 * c + 6] = o[8 * c + 6] * sc + pp * bflo(w.w); o[8 * c + 7] = o[8 * c + 7] * sc + pp * bfhi(w.w); }
        }
        const float M = wave_max(m), f = exp2f(m - M);
        const float lt = wave_sum(l * f);
        float res = 0.f;
#pragma unroll
        for (int d = 0; d < 64; ++d) { const float t = wave_sum(o[d] * f); if (lane == d) res = t; }
        zb[(size_t)r * D + h * 64 + lane] = (bf16)f2bf(res / lt);
    }
}
template <bool WCTX>
__device__ __forceinline__ void phase_mlstm_naive(Frame& F) {
    const int gw = F.blk * NWAVES + F.wave, lane = F.lane;
    if ((gw & 15) != 0) return;
    const int it = gw >> 4; if (it >= NB * 8 * 2) return;
    const int b = it >> 4, hd = (it >> 1) & 7, j = (it & 1) * 64 + lane;
    const bf16* kb = (const bf16*)(F.ws + WS_MK); const bf16* vb = (const bf16*)(F.ws + WS_MV); const bf16* qb = (const bf16*)(F.ws + WS_MQ);
    const float* gb = (const float*)(F.ws + WS_MG); float* hsum = (float*)(F.ws + WS_MHS);
    for (int dir = 0; dir < 2; ++dir) {
        float C[64], nn[64], m = 0.f;
#pragma unroll
        for (int d = 0; d < 64; ++d) { C[d] = 0.f; nn[d] = 0.f; }
        for (int s = 0; s < CTX + SEQ; ++s) {
            const int r = seq_row(b, dir, s);
            const float ig = gb[(size_t)r * 32 + dir * 16 + hd], lf = log_sigmoidf_(gb[(size_t)r * 32 + dir * 16 + 8 + hd]);
            const float mn = fmaxf(lf + m, ig), fa = __expf(lf + m - mn), ia = __expf(ig - mn); m = mn;
            const float vj = bf2f(vb[(size_t)r * 1024 + hd * 128 + j]) * ia;
            float num = 0.f, den = 0.f;
#pragma unroll
            for (int c = 0; c < 8; ++c) {
                const v4u kw = *(const v4u*)(kb + (size_t)r * 512 + hd * 64 + 8 * c), qw = *(const v4u*)(qb + (size_t)r * 512 + hd * 64 + 8 * c);
                float kk[8], qq[8];
                kk[0] = bflo(kw.x); kk[1] = bfhi(kw.x); kk[2] = bflo(kw.y); kk[3] = bfhi(kw.y); kk[4] = bflo(kw.z); kk[5] = bfhi(kw.z); kk[6] = bflo(kw.w); kk[7] = bfhi(kw.w);
                qq[0] = bflo(qw.x); qq[1] = bfhi(qw.x); qq[2] = bflo(qw.y); qq[3] = bfhi(qw.y); qq[4] = bflo(qw.z); qq[5] = bfhi(qw.z); qq[6] = bflo(qw.w); qq[7] = bfhi(qw.w);
#pragma unroll
                for (int e = 0; e < 8; ++e) { const int d = 8 * c + e;
                    C[d] = fa * C[d] + kk[e] * vj; nn[d] = fa * nn[d] + ia * kk[e]; num += C[d] * qq[e]; den += nn[d] * qq[e]; }
            }
            if (WCTX || s >= CTX) {
                const float outv = num / fmaxf(fabsf(den), __expf(-m));
                float* hp = hsum + (size_t)r * D + hd * 128 + j;
                if (dir == 0) *hp = outv; else *hp = *hp + outv;
            }
        }
    }
}
template <bool WCTX>
__device__ __forceinline__ void phase_mlstm_combine(Frame& F) {
    constexpr int R0 = WCTX ? 0 : TC;
    const float* hsum = (const float*)(F.ws + WS_MHS); const bf16* ob = (const bf16*)(F.ws + WS_MO); bf16* zb = (bf16*)(F.ws + WS_Z);
    const int gw = F.blk * NWAVES + F.wave, NGW = F.G * NWAVES, lane = F.lane;
    f32x4 gv[4];
#pragma unroll
    for (int j = 0; j < 4; ++j) gv[j] = *(const f32x4*)(F.in[IN_MLNG] + 4 * lane + 256 * j);
    for (int r = R0 + gw; r < T; r += NGW) {
#pragma unroll
        for (int j = 0; j < 4; ++j) {
            const f32x4 hv = *(const f32x4*)(hsum + (size_t)r * D + 4 * lane + 256 * j);
            float ss = hv.x * hv.x + hv.y * hv.y + hv.z * hv.z + hv.w * hv.w;
#pragma unroll
            for (int o = 1; o < 32; o <<= 1) ss += __shfl_xor(ss, o);
            const float rs = rsqrtf(ss * (1.f / 128.f) + EPS);
            const v2u ow = *(const v2u*)(ob + (size_t)r * D + 4 * lane + 256 * j);
            f32x4 z = hv * rs * gv[j];
            z.x *= sigmoidf_(bflo(ow.x)); z.y *= sigmoidf_(bfhi(ow.x)); z.z *= sigmoidf_(bflo(ow.y)); z.w *= sigmoidf_(bfhi(ow.y));
            st_bf4(zb + (size_t)r * D + 4 * lane + 256 * j, z);
        }
    }
}
#include <hip/hip_bf16.h>
#include <cmath>
namespace attn_body {
using bf16=__hip_bfloat16;
using bf16x8=__attribute__((ext_vector_type(8)))short;
using s16x4=__attribute__((ext_vector_type(4)))short;
using f32x16=__attribute__((ext_vector_type(16)))float;
using u32x4=__attribute__((ext_vector_type(4)))unsigned;
constexpr int D=64,QP=1024,KP=256;
constexpr int NW=8,QBLK=32,QB=QBLK*NW,KVBLK=64;
__device__ __forceinline__ int crow(int r,int hi){return (r&3)+8*(r>>2)+4*hi;}
#define SBAR() __builtin_amdgcn_sched_barrier(0)
__device__ __forceinline__ void cmask(f32x16&p0,f32x16&p1,int jb,int qrel,int hi){
  const float NEG=-INFINITY; int kb=64*jb+4*hi;
  #pragma unroll
  for(int r=0;r<16;++r){int kv=kb+(r&3)+8*(r>>2); if(kv>qrel)p0[r]=NEG; if(kv+32>qrel)p1[r]=NEG;}
}

constexpr int NSLOT=3, SLOTB=8192;
constexpr int LDS_K=0, LDS_V=NSLOT*SLOTB, LDS_WS=2*NSLOT*SLOTB, LDS_OST=LDS_WS+NW*64*4, LDS_BYTES=LDS_OST+NW*4096;
constexpr float C2=0.125f*1.4426950408889634f;
__device__ __forceinline__ void glds16(const void*gsrc,unsigned lds_dst){unsigned keep;
  asm volatile("s_mov_b32 %0, m0\n\ts_mov_b32 m0, %2\n\ts_nop 0\n\tglobal_load_lds_dwordx4 %1, off\n\ts_mov_b32 m0, %0":"=&s"(keep):"v"(gsrc),"s"(lds_dst):"memory");}
__device__ __forceinline__ float max3f(float a,float b,float c){float r;asm("v_max3_f32 %0, %1, %2, %3":"=v"(r):"v"(a),"v"(b),"v"(c));return r;}
__device__ __forceinline__ float max2f(float a,float b){float r;asm("v_max_f32_e32 %0, %1, %2":"=v"(r):"v"(a),"v"(b));return r;}
__device__ __forceinline__ float fadd_s(float a,float b){float r;asm("v_add_f32_e32 %0, %1, %2":"=v"(r):"v"(a),"v"(b));return r;}
__device__ __forceinline__ float fsub_s(float a,float b){float r;asm("v_sub_f32_e32 %0, %1, %2":"=v"(r):"v"(a),"v"(b));return r;}
typedef float f32x2_t __attribute__((ext_vector_type(2))); typedef __bf16 bf16x2_t __attribute__((ext_vector_type(2)));
__device__ __forceinline__ unsigned cvtpk_s(float lo,float hi){f32x2_t v={lo,hi};bf16x2_t b=__builtin_convertvector(v,bf16x2_t);return __builtin_bit_cast(unsigned,b);}
#define WAIT_BAR(N) asm volatile("s_waitcnt vmcnt(" #N ") lgkmcnt(0)\n\ts_barrier":::"memory")

__device__ __forceinline__ void qkt(f32x16&p0,f32x16&p1,const char*Kslot,const bf16x8*qr,const f32x16&negm,int r32,int hi){
  const char*kb=Kslot+hi*1024+r32*16;
  #pragma unroll
  for(int d0=0;d0<4;++d0){
    const bf16x8 b0=*reinterpret_cast<const bf16x8*>(kb+d0*2048);
    const bf16x8 b1=*reinterpret_cast<const bf16x8*>(kb+d0*2048+512);
    if(d0==0){p0=__builtin_amdgcn_mfma_f32_32x32x16_bf16(b0,qr[0],negm,0,0,0);p1=__builtin_amdgcn_mfma_f32_32x32x16_bf16(b1,qr[0],negm,0,0,0);}
    else{p0=__builtin_amdgcn_mfma_f32_32x32x16_bf16(b0,qr[d0],p0,0,0,0);p1=__builtin_amdgcn_mfma_f32_32x32x16_bf16(b1,qr[d0],p1,0,0,0);}}
}
typedef __attribute__((address_space(3))) const char* lds_cptr;
typedef short v4i16_t __attribute__((ext_vector_type(4)));
__device__ __forceinline__ void kload8(bf16x8*kf,lds_cptr kp){
  kf[0]=*(const __attribute__((address_space(3))) bf16x8*)(kp);      kf[1]=*(const __attribute__((address_space(3))) bf16x8*)(kp+512);
  kf[2]=*(const __attribute__((address_space(3))) bf16x8*)(kp+2048); kf[3]=*(const __attribute__((address_space(3))) bf16x8*)(kp+2560);
  kf[4]=*(const __attribute__((address_space(3))) bf16x8*)(kp+4096); kf[5]=*(const __attribute__((address_space(3))) bf16x8*)(kp+4608);
  kf[6]=*(const __attribute__((address_space(3))) bf16x8*)(kp+6144); kf[7]=*(const __attribute__((address_space(3))) bf16x8*)(kp+6656);
}
__device__ __forceinline__ void kload2(bf16x8*kf,lds_cptr kp,int j){ kf[2*j]=*(const __attribute__((address_space(3))) bf16x8*)(kp+j*2048); kf[2*j+1]=*(const __attribute__((address_space(3))) bf16x8*)(kp+j*2048+512); }
__device__ __forceinline__ s16x4 vtr(lds_cptr p){ return __builtin_bit_cast(s16x4,__builtin_amdgcn_ds_read_tr16_b64_v4i16((__attribute__((address_space(3))) v4i16_t*)p)); }
__device__ __forceinline__ float rowmax(const f32x16&p0,const f32x16&p1){
  float a=max3f(p0[0],p0[1],p1[0]),b=max3f(p0[2],p0[3],p1[1]);a=max3f(a,p1[2],p1[3]);
  #pragma unroll
  for(int r=4;r<16;r+=4){a=max3f(a,p0[r],p0[r+1]);b=max3f(b,p0[r+2],p0[r+3]);a=max3f(a,p1[r],p1[r+1]);b=max3f(b,p1[r+2],p1[r+3]);}
  const float m=max2f(a,b);
  auto rr=__builtin_amdgcn_permlane32_swap(__float_as_uint(m),__float_as_uint(m),false,false);
  return max2f(__uint_as_float(rr[0]),__uint_as_float(rr[1]));
}
__device__ __forceinline__ void pv(f32x16*o,int vb,bf16x8 pa0,bf16x8 pa1,bf16x8 pa2,bf16x8 pa3){
  #pragma unroll
  for(int d0=0;d0<2;++d0){s16x4 lo[4],hi[4];
    #pragma unroll
    for(int ks=0;ks<4;++ks){
      asm volatile("ds_read_b64_tr_b16 %0,%1 offset:%c2":"=&v"(lo[ks]):"v"(vb),"i"(d0*4096+ks*1024):"memory");
      asm volatile("ds_read_b64_tr_b16 %0,%1 offset:%c2":"=&v"(hi[ks]):"v"(vb),"i"(d0*4096+ks*1024+512):"memory");}
    asm volatile("s_waitcnt lgkmcnt(0)":::"memory");SBAR();
    #define PK(k) (bf16x8){lo[k][0],lo[k][1],lo[k][2],lo[k][3],hi[k][0],hi[k][1],hi[k][2],hi[k][3]}
    o[d0]=__builtin_amdgcn_mfma_f32_32x32x16_bf16(pa0,PK(0),o[d0],0,0,0);
    o[d0]=__builtin_amdgcn_mfma_f32_32x32x16_bf16(pa1,PK(1),o[d0],0,0,0);
    o[d0]=__builtin_amdgcn_mfma_f32_32x32x16_bf16(pa2,PK(2),o[d0],0,0,0);
    o[d0]=__builtin_amdgcn_mfma_f32_32x32x16_bf16(pa3,PK(3),o[d0],0,0,0);
    #undef PK
  }
}

#ifndef ATTN_STORE16
#define ATTN_STORE16(p,v) (*(u32x4*)(p)=(v))
#endif
template<int THRL> __device__ __forceinline__ void attn_unit(const bf16*Qu,const bf16*__restrict__ Kh,const bf16*__restrict__ Vh,bf16*Ou,const int NT,char*shm){
  const int tid=threadIdx.x,lane=tid&63,r32=lane&31,hi=lane>>5; const int wid=__builtin_amdgcn_readfirstlane(tid>>6);
  const bf16*Qw=Qu+(long)(wid*QBLK)*QP;
  const unsigned lds0=(unsigned)(uintptr_t)shm;
  float*wsf=(float*)(shm+LDS_WS)+wid*64;
  const bf16*ksrc=Kh+(long)lane*KP+wid*8;
  const bf16*vsrc=Vh+(long)(16*(wid&3)+(lane>>2))*KP+(wid>>2)*32+(lane&3)*8;
  const unsigned kdst=lds0+LDS_K+wid*1024, vdst=lds0+LDS_V+wid*1024;
  #define DMA_K(t,slot) glds16(ksrc+(long)(t)*KVBLK*KP,(unsigned)__builtin_amdgcn_readfirstlane(kdst+(slot)))
  #define DMA_V(t,slot) glds16(vsrc+(long)(t)*KVBLK*KP,(unsigned)__builtin_amdgcn_readfirstlane(vdst+(slot)))
  const int vb0=(int)(lds0+LDS_V)+((lane>>4)&1)*32+(lane&3)*8+(4*hi+((lane&15)>>2))*64;
  const char*Kbase=shm+LDS_K; bf16x8 kf[8];
  const lds_cptr shm3=(lds_cptr)shm; const lds_cptr kp0=shm3+LDS_K+hi*1024+r32*16; const lds_cptr vp0=shm3+LDS_V+((lane>>4)&1)*32+(lane&3)*8+(4*hi+((lane&15)>>2))*64;
  DMA_K(0,0);DMA_V(0,0);DMA_K(1,SLOTB);
  bf16x8 qr[4];
  #pragma unroll
  for(int d0=0;d0<4;++d0)qr[d0]=*reinterpret_cast<const bf16x8*>(&Qw[(long)r32*QP+d0*16+hi*8]);
  float mhat=0.f,l_reg=0.f;f32x16 o[2];o[0]=f32x16{};o[1]=f32x16{};f32x16 negm=f32x16{};asm volatile("":"+v"(negm));
  #define CMASK(P0,P1,t) do{}while(0)
  bool resc=false;
  #define START(P0,P1) do{ const float rm=rowmax(P0,P1); resc=false; \
    { const float dl=rm; mhat=fadd_s(mhat,dl); \
      _Pragma("unroll") for(int r=0;r<16;++r){P0[r]=fsub_s(P0[r],dl);P1[r]=fsub_s(P1[r],dl);} \
      _Pragma("unroll") for(int r=0;r<16;++r)negm[r]=-mhat; asm volatile("":"+v"(negm)); } \
    _Pragma("unroll") for(int r=0;r<16;++r)P0[r]=__builtin_amdgcn_exp2f(P0[r]); }while(0)
  #define RESC() do{ if(resc){ asm volatile("s_waitcnt lgkmcnt(0)":::"memory"); \
      _Pragma("unroll") for(int d_=0;d_<2;++d_) _Pragma("unroll") for(int r=0;r<16;++r)o[d_][r]*=wsf[crow(r,hi)]; } }while(0)
  f32x16 pA0,pA1,pB0,pB1;
  int sl_prev=0,sl_cur=0,sl_next=SLOTB;
  #define ROT() do{sl_prev=sl_cur;sl_cur=sl_next;sl_next=(sl_next==(NSLOT-1)*SLOTB)?0:sl_next+SLOTB;}while(0)
  DMA_K(2,2*SLOTB);
  WAIT_BAR(3);
  qkt(pA0,pA1,Kbase,qr,negm,r32,hi);asm volatile("s_nop 15\n\ts_nop 7":"+v"(pA0),"+v"(pA1));CMASK(pA0,pA1,0);
  START(pA0,pA1);
  _Pragma("unroll") for(int r=0;r<16;++r)pA1[r]=__builtin_amdgcn_exp2f(pA1[r]);
  WAIT_BAR(0);
  DMA_K(3,0);DMA_V(1,SLOTB);
  ROT();
  kload8(kf,kp0+sl_cur);
  WAIT_BAR(2);
  s16x4 vlo[8],vhi[8]; u32x4 pw0,pw1,pw2,pw3;
  #define PKW(P,B) cvtpk_s(P[B],P[B+1])
  #define PAF(k) __builtin_bit_cast(bf16x8,pw##k)
  #define VFR(i) (bf16x8){vlo[i][0],vlo[i][1],vlo[i][2],vlo[i][3],vhi[i][0],vhi[i][1],vhi[i][2],vhi[i][3]}
  #define PIN(x) asm volatile("":"+v"(x))
  #define MX3(a,b,c) __builtin_fmaxf(__builtin_fmaxf((a),(b)),(c))
  #define GAPA(MF,A0,A1,A2,A3,W0,W1,PW) do{ MF; sacc+=A0; sacc+=A1; sacc+=A2; sacc+=A3; PIN(sacc); W0; W1; PIN(PW); SBAR(); }while(0)
  #define EX(v) __builtin_amdgcn_exp2f(v)
  #define GAPB(MF,X,B) do{ MF; X[B]=EX(X[B]); X[B+1]=EX(X[B+1]); X[B+2]=EX(X[B+2]); X[B+3]=EX(X[B+3]); PIN(X); SBAR(); }while(0)
  #define VRD(i) do{ vlo[i]=vtr(vp_+(((i)>>2)*4096+((i)&3)*1024)); vhi[i]=vtr(vp_+(((i)>>2)*4096+((i)&3)*1024+512)); }while(0)
  #define KRD(G,j) do{ if(G){ kload2(kf,kp0+sl_next,j); SBAR(); } }while(0)
  #define STEP(C0,C1,P0,P1,t,GK,GV,GL) do{ SBAR(); \
    const lds_cptr vp_=vp0+sl_prev; \
    VRD(0); SBAR(); float sacc=(P0[0]+P0[1]); \
    GAPA(C0=__builtin_amdgcn_mfma_f32_32x32x16_bf16(kf[0],qr[0],negm,0,0,0), P0[2],P0[3],P0[4],P0[5],     pw0[0]=PKW(P0,0), pw0[1]=PKW(P0,2), pw0); \
    VRD(4); SBAR(); GAPA(C1=__builtin_amdgcn_mfma_f32_32x32x16_bf16(kf[1],qr[0],negm,0,0,0), P0[6],P0[7],P0[8],P0[9],     pw0[2]=PKW(P0,4), pw0[3]=PKW(P0,6), pw0); \
    VRD(1); SBAR(); GAPA(C0=__builtin_amdgcn_mfma_f32_32x32x16_bf16(kf[2],qr[1],C0,0,0,0),   P0[10],P0[11],P0[12],P0[13], pw1[0]=PKW(P0,8), pw1[1]=PKW(P0,10), pw1); \
    VRD(5); SBAR(); GAPA(C1=__builtin_amdgcn_mfma_f32_32x32x16_bf16(kf[3],qr[1],C1,0,0,0),   P0[14],P0[15],P1[0],P1[1],   pw1[2]=PKW(P0,12),pw1[3]=PKW(P0,14), pw1); \
    VRD(2); SBAR(); GAPA(C0=__builtin_amdgcn_mfma_f32_32x32x16_bf16(kf[4],qr[2],C0,0,0,0),   P1[2],P1[3],P1[4],P1[5],     pw2[0]=PKW(P1,0), pw2[1]=PKW(P1,2), pw2); \
    VRD(6); SBAR(); GAPA(C1=__builtin_amdgcn_mfma_f32_32x32x16_bf16(kf[5],qr[2],C1,0,0,0),   P1[6],P1[7],P1[8],P1[9],     pw2[2]=PKW(P1,4), pw2[3]=PKW(P1,6), pw2); \
    VRD(3); SBAR(); GAPA(C0=__builtin_amdgcn_mfma_f32_32x32x16_bf16(kf[6],qr[3],C0,0,0,0),   P1[10],P1[11],P1[12],P1[13], pw3[0]=PKW(P1,8), pw3[1]=PKW(P1,10), pw3); \
    VRD(7); SBAR(); GAPA(C1=__builtin_amdgcn_mfma_f32_32x32x16_bf16(kf[7],qr[3],C1,0,0,0),   P1[14],P1[15],0.f,0.f,       pw3[2]=PKW(P1,12),pw3[3]=PKW(P1,14), pw3); \
    l_reg+=sacc; \
    if(GK){DMA_K((t)+3,sl_cur);} if(GV){DMA_V((t)+1,sl_next);} \
    CMASK(C0,C1,t); \
    { float a=MX3(C0[0],C0[1],C1[0]),b=MX3(C0[2],C0[3],C1[1]); a=MX3(a,C1[2],C1[3]); \
      _Pragma("unroll") for(int r=4;r<16;r+=4){a=MX3(a,C0[r],C0[r+1]);b=MX3(b,C0[r+2],C0[r+3]);a=MX3(a,C1[r],C1[r+1]);b=MX3(b,C1[r+2],C1[r+3]);} \
      float rm=__builtin_fmaxf(a,b); { auto rr=__builtin_amdgcn_permlane32_swap(__float_as_uint(rm),__float_as_uint(rm),false,false); rm=__builtin_fmaxf(__uint_as_float(rr[0]),__uint_as_float(rr[1])); } \
      resc=false; \
      if(__builtin_expect(__any(rm>(float)THRL),0)){ const float dl=__builtin_fmaxf(rm,0.f); mhat+=dl; \
        _Pragma("unroll") for(int r=0;r<16;++r){C0[r]-=dl;C1[r]-=dl;} \
        _Pragma("unroll") for(int r=0;r<16;++r)negm[r]=-mhat; asm volatile("":"+v"(negm)); \
        const float f=__builtin_amdgcn_exp2f(-dl); l_reg*=f; if(hi==0)wsf[r32]=f; resc=true; } } \
    SBAR(); \
    GAPB(o[0]=__builtin_amdgcn_mfma_f32_32x32x16_bf16(PAF(0),VFR(0),o[0],0,0,0), C0,0); \
    GAPB(o[1]=__builtin_amdgcn_mfma_f32_32x32x16_bf16(PAF(0),VFR(4),o[1],0,0,0), C0,4); \
    KRD(GL,0); GAPB(o[0]=__builtin_amdgcn_mfma_f32_32x32x16_bf16(PAF(1),VFR(1),o[0],0,0,0), C0,8); \
    KRD(GL,1); GAPB(o[1]=__builtin_amdgcn_mfma_f32_32x32x16_bf16(PAF(1),VFR(5),o[1],0,0,0), C0,12); \
    KRD(GL,2); GAPB(o[0]=__builtin_amdgcn_mfma_f32_32x32x16_bf16(PAF(2),VFR(2),o[0],0,0,0), C1,0); \
    KRD(GL,3); GAPB(o[1]=__builtin_amdgcn_mfma_f32_32x32x16_bf16(PAF(2),VFR(6),o[1],0,0,0), C1,4); \
    GAPB(o[0]=__builtin_amdgcn_mfma_f32_32x32x16_bf16(PAF(3),VFR(3),o[0],0,0,0), C1,8); \
    GAPB(o[1]=__builtin_amdgcn_mfma_f32_32x32x16_bf16(PAF(3),VFR(7),o[1],0,0,0), C1,12); \
    }while(0)
  int t=1;
  #undef CMASK
  #define CMASK(P0,P1,t) do{}while(0)
  for(;t+5<NT;t+=2){
    STEP(pB0,pB1,pA0,pA1,t,true,true,true);     WAIT_BAR(2); RESC(); ROT();
    STEP(pA0,pA1,pB0,pB1,t+1,true,true,true);   WAIT_BAR(2); RESC(); ROT();
  }
  #undef CMASK
  #define CMASK(P0,P1,t) do{}while(0)
  #define ENDW(tt) do{ if((tt)+3<NT){WAIT_BAR(2);} else if((tt)+2<NT){WAIT_BAR(1);} else {WAIT_BAR(0);} }while(0)
  for(;t+1<NT;t+=2){
    STEP(pB0,pB1,pA0,pA1,t,(t+3<NT),(t+1<NT),(t+1<NT));       ENDW(t);   RESC(); ROT();
    STEP(pA0,pA1,pB0,pB1,t+1,(t+4<NT),(t+2<NT),(t+2<NT));     ENDW(t+1); RESC(); ROT();
  }
  STEP(pB0,pB1,pA0,pA1,NT-1,false,false,false); RESC();
  { float sacc=pB0[0]+pB0[1]; _Pragma("unroll") for(int r=2;r<16;++r)sacc+=pB0[r]; _Pragma("unroll") for(int r=0;r<16;++r)sacc+=pB1[r]; l_reg+=sacc;
    pw0=(u32x4){PKW(pB0,0),PKW(pB0,2),PKW(pB0,4),PKW(pB0,6)};pw1=(u32x4){PKW(pB0,8),PKW(pB0,10),PKW(pB0,12),PKW(pB0,14)};pw2=(u32x4){PKW(pB1,0),PKW(pB1,2),PKW(pB1,4),PKW(pB1,6)};pw3=(u32x4){PKW(pB1,8),PKW(pB1,10),PKW(pB1,12),PKW(pB1,14)};
    SBAR(); pv(o,vb0+sl_cur,PAF(0),PAF(1),PAF(2),PAF(3)); }
  #undef PKW
  #undef PAF
  #undef VFR
  #undef PIN
  #undef MX3
  #undef GAPA
  #undef GAPB
  #undef EX
  #undef VRD
  #undef KRD
  #undef STEP
  #undef ENDW
  {auto rr=__builtin_amdgcn_permlane32_swap(__float_as_uint(l_reg),__float_as_uint(l_reg),false,false);l_reg=__uint_as_float(rr[0])+__uint_as_float(rr[1]);}
  if(hi==0)wsf[32+r32]=l_reg;asm volatile("s_waitcnt lgkmcnt(0)":::"memory");
  float rli[16];
  #pragma unroll
  for(int r=0;r<16;++r)rli[r]=__builtin_amdgcn_rcpf(wsf[32+crow(r,hi)]);
  bf16*Ow=Ou+(long)(wid*QBLK)*QP;
  { bf16*stg=(bf16*)(shm+LDS_OST)+wid*2048;
    #pragma unroll
    for(int r=0;r<16;++r){const int orow=crow(r,hi);
      #pragma unroll
      for(int d0=0;d0<2;++d0)stg[orow*64+d0*32+r32]=__float2bfloat16(o[d0][r]*rli[r]);}
    asm volatile("s_waitcnt lgkmcnt(0)":::"memory");
    #pragma unroll
    for(int i=0;i<4;++i){const int row=i*8+(lane>>3),ch=lane&7; const u32x4 v=*(const u32x4*)(stg+row*64+ch*8); ATTN_STORE16(Ow+(long)row*QP+ch*8,v);} }
  asm volatile("s_waitcnt lgkmcnt(0)\n\ts_barrier":::"memory");
  #undef DMA_K
  #undef DMA_V
  #undef CMASK
  #undef START
  #undef RESC
  #undef ROT
}
constexpr int ATTN_LDS_BYTES=LDS_BYTES;
#undef SBAR
#undef WAIT_BAR
}

template <bool WCTX>
__device__ __forceinline__ void phase_attn_fast(Frame& F, char* ldsg) {
    typedef attn_body::bf16 abf;
    const abf* Q = (const abf*)(F.ws + WS_QB); const abf* K = (const abf*)(F.ws + WS_KB); const abf* V = (const abf*)(F.ws + WS_VB); abf* O = (abf*)(F.ws + WS_Z);
    const int vcu = (F.G % 8 == 0) ? (F.blk % 8) * (F.G / 8) + F.blk / 8 : F.blk;
    const int nunits = WCTX ? 1024 + 128 : 1024;
    for (int u = vcu; u < nunits; u += F.G) {
        int h, kvh, qrow0, kv0, NT;
        if (u < 1024) { const int grp = u >> 5, b = grp >> 2; kvh = grp & 3; const int qb = (u >> 2) & 7; h = kvh * 4 + (u & 3); qrow0 = TC + b * SEQ + qb * 256; kv0 = b * KVLEN; NT = KVLEN / 64; }
        else { const int u2 = u - 1024, b = u2 >> 4; h = u2 & 15; kvh = h >> 2; qrow0 = b * CTX; kv0 = b * KVLEN + SEQ; NT = CTX / 64; }
        attn_body::attn_unit<8>(Q + (size_t)qrow0 * 1024 + h * 64, K + (size_t)kv0 * 256 + kvh * 64, V + (size_t)kv0 * 256 + kvh * 64, O + (size_t)qrow0 * 1024 + h * 64, NT, ldsg + RING_OFF);
    }
}

constexpr int S5_BU_STRIDE = 132;
constexpr int S5_X_STRIDE = 136;
constexpr int S5_BU_BYTES = 16 * S5_BU_STRIDE * 4, S5_X_BYTES = 16 * S5_X_STRIDE * 2, S5_Y_BYTES = 2 * 64 * 16, S5_U_BYTES = 64 * 16;
constexpr int S5_ITEM_LDS = S5_BU_BYTES + S5_X_BYTES + 2 * S5_Y_BYTES + 4 * S5_U_BYTES;
constexpr int S5_NT = (CTX + SEQ) / 32;
static_assert(4 * S5_ITEM_LDS <= RING_BYTES, "S5 LDS");
#define S5_BAR() do { asm volatile("s_waitcnt lgkmcnt(0)" ::: "memory"); __builtin_amdgcn_s_barrier(); asm volatile("" ::: "memory"); } while (0)
__device__ __forceinline__ f32x2 cmul(f32x2 a, f32x2 b) { return (f32x2){a.x * b.x - a.y * b.y, a.x * b.y + a.y * b.x}; }

template <int J, bool WCTX>
__device__ __forceinline__ void phase_s5_fast(Frame& F) {
    const int lane = F.lane, w = F.wave;
    const bool helper = w >= 4;
    const int iw = w & 3, pairi = iw >> 1, dir = iw & 1;
    const int tq = lane & 15, kg = lane >> 4;
    const bf16* hb = (const bf16*)(F.ws + WS_H); float* ypart = (float*)(F.ws + WS_YSUM); bf16* zb = (bf16*)(F.ws + WS_Z);
    LAS unsigned char* base = F.lds + iw * S5_ITEM_LDS;
    LAS float* BU = (LAS float*)base;
    LAS bf16* XS = (LAS bf16*)(base + S5_BU_BYTES);
    LAS f32x4* YL = (LAS f32x4*)(base + S5_BU_BYTES + S5_X_BYTES);
    LAS v4u* UL = (LAS v4u*)(base + S5_BU_BYTES + S5_X_BYTES + 2 * S5_Y_BYTES);
    for (int it0 = F.blk * 2; it0 < NB * 64; it0 += F.G * 2) {
        const int it = it0 + pairi, b = it >> 6, g = it & 63;
        const int gi = (J * 2 + dir) * 64 + g;
        LAS v4u* TAB = (LAS v4u*)(F.lds);
        LAS f32x2* CST = (LAS f32x2*)(F.lds + 65536);
        LAS float* KMS = (LAS float*)(F.lds + 65536 + 6144);
        static_assert(65536 + 6144 + 8192 <= 4 * S5_ITEM_LDS, "S5 set-up scratch inside the item buffers");
        if (F.tid < 256) { const int i = F.tid >> 6, p = F.tid & 63; const int git = (J * 2 + (i & 1)) * 64 + ((it0 + (i >> 1)) & 63);
            const float dt = expf(F.in[IN_S5LOG][git]);
            const float lr = F.in[IN_S5LRE][git * 64 + p], li = F.in[IN_S5LIM][git * 64 + p]; const float mag = expf(lr * dt); double sd, cd; sincos_d((double)(li * dt), sd, cd);
            const float ar = mag * (float)cd, ai = mag * (float)sd, den = lr * lr + li * li, nr = ar - 1.f, ni = ai;
            const f32x2 a = (f32x2){ar, ai};
            CST[(i * 3 + 0) * 64 + p] = a; CST[(i * 3 + 1) * 64 + p] = cmul(a, a); CST[(i * 3 + 2) * 64 + p] = (f32x2){(nr * lr + ni * li) / den, (ni * lr - nr * li) / den}; }
        __syncthreads();
        for (int f = F.tid; f < 4 * 16 * 64; f += NTHR) {
            const int i = f >> 10, fi = (f >> 6) & 15, ln = f & 63, ltq = ln & 15, lkg = ln >> 4; const int git = (J * 2 + (i & 1)) * 64 + ((it0 + (i >> 1)) & 63);
            unsigned o[4];
            if (fi < 8) {
                const int n = 16 * fi + ltq, p = n >> 1, ri = n & 1;
                f32x2 co = CST[(i * 3 + 2) * 64 + p]; if ((lkg >> 1) == 0) co = cmul(co, CST[(i * 3 + 0) * 64 + p]);
                const float* brp = F.in[IN_S5BRE] + (size_t)git * 1024 + p * 16 + 8 * (lkg & 1); const float* bip = F.in[IN_S5BIM] + (size_t)git * 1024 + p * 16 + 8 * (lkg & 1);
#pragma unroll
                for (int q = 0; q < 4; ++q) { const f32x2 v0 = cmul(co, (f32x2){brp[2 * q], bip[2 * q]}), v1 = cmul(co, (f32x2){brp[2 * q + 1], bip[2 * q + 1]}); o[q] = pk2(ri ? v0.y : v0.x, ri ? v1.y : v1.x); }
            } else {
                const int tau = (fi - 8) >> 2, ks = fi & 3, p0 = 16 * ks + 4 * lkg;
                const float* crp = F.in[IN_S5CRE] + (size_t)git * 1024 + ltq * 64 + p0; const float* cip = F.in[IN_S5CIM] + (size_t)git * 1024 + ltq * 64 + p0;
#pragma unroll
                for (int q = 0; q < 4; ++q) { const f32x2 v = cmul((f32x2){crp[q], cip[q]}, CST[(i * 3 + tau) * 64 + p0 + q]); o[q] = pk2(v.x, -v.y); }
            }
            TAB[f] = (v4u){o[0], o[1], o[2], o[3]};
        }
        __syncthreads();
        if (helper) {
            const f32x4 d4 = *(const f32x4*)(F.in[IN_S5D] + J * D + g * 16 + 4 * kg);
            v4u ub[4]; f32x4 yoA0, yoA1, yoB0, yoB1;
#pragma unroll
            for (int k = 0; k < 4; ++k) ub[k] = *(const v4u*)(hb + (size_t)seq_row(b, dir, 32 * k + 2 * tq + (kg >> 1)) * D + g * 16 + 8 * (kg & 1));
            yoA0 = (f32x4){0.f, 0.f, 0.f, 0.f}; yoA1 = yoA0; yoB0 = yoA0; yoB1 = yoA0;
            S5_BAR();
#pragma unroll 4
            for (int T = -1; T < S5_NT + 3; ++T) {
                const int e = T - 1, d = T + 1;
                const bool e_ok = (e >= 0) && (e < S5_NT) && (WCTX || e >= 8);
                const bool e_second = (e < 8) ? (e >= 4) : (e >= 40);
                if (d >= 0 && d < S5_NT) UL[(d & 3) * 64 + lane] = ub[d & 3];
                if (e_ok) {
#pragma unroll
                    for (int tau = 0; tau < 2; ++tau) {
                        const size_t idx = (size_t)seq_row(b, dir, 32 * e + 2 * tq + tau) * D + g * 16 + 4 * kg;
                        const f32x4 y = YL[((e & 1) * 2 + tau) * 64 + lane];
                        if (!e_second) *(f32x4*)(ypart + idx) = y;
                        else {
                            f32x4 yo = (e & 1) ? (tau ? yoB1 : yoB0) : (tau ? yoA1 : yoA0);
                            if (e == 4 || e == 40) yo = *(const f32x4*)(ypart + idx);
                            const v2u hw = *(const v2u*)(hb + idx);
                            f32x4 v = y + yo; v.x += d4.x * bflo(hw.x); v.y += d4.y * bfhi(hw.x); v.z += d4.z * bflo(hw.y); v.w += d4.w * bfhi(hw.y);
                            v2u zo; zo.x = pk2(gelu_tanh(v.x), gelu_tanh(v.y)); zo.y = pk2(gelu_tanh(v.z), gelu_tanh(v.w));
                            *(v2u*)(zb + idx) = zo;
                        }
                    }
                }
                { const int e1 = e + 1; const bool e1_ok = (e1 >= 0) && (e1 < S5_NT) && (WCTX || e1 >= 8); const bool e1_second = (e1 < 8) ? (e1 >= 4) : (e1 >= 40);
                  if (e1_ok && e1_second && e1 != 4 && e1 != 40) {
                      const f32x4 l0 = *(const f32x4*)(ypart + (size_t)seq_row(b, dir, 32 * e1 + 2 * tq) * D + g * 16 + 4 * kg), l1 = *(const f32x4*)(ypart + (size_t)seq_row(b, dir, 32 * e1 + 2 * tq + 1) * D + g * 16 + 4 * kg);
                      if (e1 & 1) { yoB0 = l0; yoB1 = l1; } else { yoA0 = l0; yoA1 = l1; }
                  } }
                if (d >= 0 && d + 4 < S5_NT) ub[d & 3] = *(const v4u*)(hb + (size_t)seq_row(b, dir, 32 * (d + 4) + 2 * tq + (kg >> 1)) * D + g * 16 + 8 * (kg & 1));
                if (e == 3 || e == 39) asm volatile("s_waitcnt vmcnt(0)" ::: "memory");
                S5_BAR();
            }
        } else {
            const float* cre = F.in[IN_S5CRE] + (size_t)gi * 1024; const float* cim = F.in[IN_S5CIM] + (size_t)gi * 1024;
            bf16x8 wf[8], vkf[2][5];
#pragma unroll
            for (int rt = 0; rt < 8; ++rt) wf[rt] = __builtin_bit_cast(bf16x8, TAB[(iw * 16 + rt) * 64 + lane]);
#pragma unroll
            for (int tau = 0; tau < 2; ++tau)
#pragma unroll
                for (int ks = 0; ks < 4; ++ks) vkf[tau][ks] = __builtin_bit_cast(bf16x8, TAB[(iw * 16 + 8 + tau * 4 + ks) * 64 + lane]);
            const f32x2 a2 = CST[(iw * 3 + 1) * 64 + lane];
            { LAS float* KM = KMS + iw * 512;
              const LAS bf16* W2T = (const LAS bf16*)(TAB + (iw * 16) * 64);
#pragma unroll
              for (int e = 0; e < 2; ++e) {
                  f32x4 acc = (f32x4){0.f, 0.f, 0.f, 0.f};
#pragma unroll
                  for (int ks = 0; ks < 4; ++ks) {
                      bf16x8 cfr, fr;
                      const int p0 = 16 * ks + 4 * kg;
                      const f32x4 cr = *(const f32x4*)(cre + tq * 64 + p0), ci = *(const f32x4*)(cim + tq * 64 + p0);
                      cfr[0] = (short)f2bf(cr.x); cfr[1] = (short)f2bf(-ci.x); cfr[2] = (short)f2bf(cr.y); cfr[3] = (short)f2bf(-ci.y); cfr[4] = (short)f2bf(cr.z); cfr[5] = (short)f2bf(-ci.z); cfr[6] = (short)f2bf(cr.w); cfr[7] = (short)f2bf(-ci.w);
#pragma unroll
                      for (int jj = 0; jj < 8; ++jj) { const int n = 32 * ks + 8 * kg + jj, k = 16 * (1 - e) + tq; fr[jj] = (short)W2T[(((n >> 4) * 64) + (n & 15) + 16 * (k >> 3)) * 8 + (k & 7)]; }
                      acc = __builtin_amdgcn_mfma_f32_16x16x32_bf16(cfr, fr, acc, 0, 0, 0);
                  }
#pragma unroll
                  for (int r = 0; r < 4; ++r) KM[(e * 16 + 4 * kg + r) * 16 + tq] = acc[r];
              }
#pragma unroll
              for (int tau = 0; tau < 2; ++tau) { const int tp = kg >> 1; bf16x8 fr;
#pragma unroll
                  for (int jj = 0; jj < 8; ++jj) { const float v = (tp <= tau) ? KM[((tau - tp) * 16 + tq) * 16 + 8 * (kg & 1) + jj] : 0.f; fr[jj] = (short)f2bf(v); }
                  vkf[tau][4] = fr; } }
            asm volatile("s_waitcnt vmcnt(0) lgkmcnt(0)" ::: "memory");
            f32x2 x = (f32x2){0.f, 0.f};
            const f32x2 a2re = (f32x2){a2.x, a2.x}, a2im = (f32x2){-a2.y, a2.y};
            S5_BAR();
            for (int T = -1; T < S5_NT + 3; ++T) {
                if (T >= 0 && T < S5_NT) {
                    const bf16x8 uf = __builtin_bit_cast(bf16x8, UL[(T & 3) * 64 + lane]);
#pragma unroll
                    for (int rt = 0; rt < 8; ++rt) {
                        const f32x4 dacc = __builtin_amdgcn_mfma_f32_16x16x32_bf16(wf[rt], uf, (f32x4){0.f, 0.f, 0.f, 0.f}, 0, 0, 0);
                        *(LAS f32x4*)(BU + tq * S5_BU_STRIDE + 16 * rt + 4 * kg) = dacc;
                    }
                    f32x2 buv[16]; unsigned xw[16];
#pragma unroll
                    for (int t = 0; t < 16; ++t) buv[t] = *(const LAS f32x2*)(BU + t * S5_BU_STRIDE + 2 * lane);
#pragma unroll
                    for (int t = 0; t < 16; ++t) { xw[t] = pk2(x.x, x.y); const f32x2 xs = (f32x2){x.y, x.x}; x = a2re * x + (a2im * xs + buv[t]); }
                    if (WCTX || T >= 8) {
#pragma unroll
                        for (int t = 0; t < 16; ++t) *(LAS unsigned*)(XS + t * S5_X_STRIDE + 2 * lane) = xw[t];
                        bf16x8 xf[4];
#pragma unroll
                        for (int ks = 0; ks < 4; ++ks) xf[ks] = *(const LAS bf16x8*)(XS + tq * S5_X_STRIDE + 32 * ks + 8 * kg);
#pragma unroll
                        for (int tau = 0; tau < 2; ++tau) {
                            f32x4 y = __builtin_amdgcn_mfma_f32_16x16x32_bf16(vkf[tau][4], uf, (f32x4){0.f, 0.f, 0.f, 0.f}, 0, 0, 0);
#pragma unroll
                            for (int ks = 0; ks < 4; ++ks) y = __builtin_amdgcn_mfma_f32_16x16x32_bf16(vkf[tau][ks], xf[ks], y, 0, 0, 0);
                            YL[((T & 1) * 2 + tau) * 64 + lane] = y;
                        }
                    }
                }
                S5_BAR();
            }
        }
        __syncthreads();
    }
}

constexpr size_t WS_MCT = WS_MHS;
constexpr size_t WS_MN = WS_MG + 2359296;
constexpr size_t WS_MSC = WS_MN + 589824;
static_assert(WS_MSC + 2304 * 16 <= WS_MHS, "mLSTM small tables");
constexpr int ML_TS = 136;
constexpr int ML_DS = 72;

template <bool MAX>
__device__ __forceinline__ void scan128(LAS float* a, int lane) {
    const float v0 = a[2 * lane], v1 = a[2 * lane + 1];
    const float s = MAX ? fmaxf(v0, v1) : v0 + v1;
    float inc = s;
#pragma unroll
    for (int o = 1; o < 64; o <<= 1) { const float t = __shfl_up(inc, o); if (lane >= o) inc = MAX ? fmaxf(inc, t) : inc + t; }
    float exc = __shfl_up(inc, 1); if (lane == 0) exc = MAX ? -INFINITY : 0.f;
    a[2 * lane] = MAX ? fmaxf(exc, v0) : exc + v0; a[2 * lane + 1] = inc;
}

__device__ __forceinline__ void phase_ml_states(Frame& F) {
    const int tid = F.tid, lane = F.lane, w = F.wave, tq = lane & 15, kg = lane >> 4;
    const bf16* kb = (const bf16*)(F.ws + WS_MK); const bf16* vb = (const bf16*)(F.ws + WS_MV); const float* gb = (const float*)(F.ws + WS_MG);
    float* cT = (float*)(F.ws + WS_MCT); float* nl = (float*)(F.ws + WS_MN); float* sc = (float*)(F.ws + WS_MSC);
    LAS bf16* KeT = (LAS bf16*)(F.lds);
    LAS bf16* VT = (LAS bf16*)(F.lds + 64 * ML_TS * 2);
    LAS float* cumS = (LAS float*)(F.lds + 192 * ML_TS * 2);
    LAS float* igS = cumS + 128; LAS float* ewS = igS + 128; LAS float* red = ewS + 128;
    for (int us = F.blk; us < 2304; us += F.G) {
        const int jc = us % 18, bhd = us / 18, dir = bhd & 1, hd = (bhd >> 1) & 7, b = bhd >> 4;
        if (tid < 128) { const int r = seq_row(b, dir, 128 * jc + tid); igS[tid] = gb[(size_t)r * 32 + dir * 16 + hd]; cumS[tid] = log_sigmoidf_(gb[(size_t)r * 32 + dir * 16 + 8 + hd]); }
        __syncthreads();
        if (w == 0) {
            scan128<false>(cumS, lane);
            const float total = __shfl(cumS[2 * lane + 1], 63);
            const float w0 = total - cumS[2 * lane] + igS[2 * lane], w1 = total - cumS[2 * lane + 1] + igS[2 * lane + 1];
            const float ml = wave_max(fmaxf(w0, w1));
            ewS[2 * lane] = __expf(w0 - ml); ewS[2 * lane + 1] = __expf(w1 - ml);
            if (lane == 0) { sc[(size_t)us * 4] = total; sc[(size_t)us * 4 + 1] = ml; }
        }
        __syncthreads();
        { const int i = tid & 127, c = tid >> 7; const int r = seq_row(b, dir, 128 * jc + i); const float e = ewS[i];
#pragma unroll
          for (int h2 = 0; h2 < 2; ++h2) { const v4u kw = *(const v4u*)(kb + (size_t)r * 512 + hd * 64 + 16 * c + 8 * h2);
              const float kv[8] = {bflo(kw.x), bfhi(kw.x), bflo(kw.y), bfhi(kw.y), bflo(kw.z), bfhi(kw.z), bflo(kw.w), bfhi(kw.w)};
#pragma unroll
              for (int jj = 0; jj < 8; ++jj) KeT[(16 * c + 8 * h2 + jj) * ML_TS + i] = (bf16)f2bf(kv[jj] * e); }
#pragma unroll
          for (int h4 = 0; h4 < 4; ++h4) { const v4u vw = *(const v4u*)(vb + (size_t)r * 1024 + hd * 128 + 32 * c + 8 * h4);
              const unsigned vv[4] = {vw.x, vw.y, vw.z, vw.w};
#pragma unroll
              for (int jj = 0; jj < 8; ++jj) VT[(32 * c + 8 * h4 + jj) * ML_TS + i] = (bf16)((jj & 1) ? (vv[jj >> 1] >> 16) : (vv[jj >> 1] & 0xffffu)); } }
        __syncthreads();
#pragma unroll
        for (int dt = 0; dt < 4; ++dt) {
            f32x4 acc = (f32x4){0.f, 0.f, 0.f, 0.f};
#pragma unroll
            for (int ks = 0; ks < 4; ++ks) {
                const bf16x8 af = *(const LAS bf16x8*)(VT + (16 * w + tq) * ML_TS + 32 * ks + 8 * kg);
                const bf16x8 bfr = *(const LAS bf16x8*)(KeT + (16 * dt + tq) * ML_TS + 32 * ks + 8 * kg);
                acc = __builtin_amdgcn_mfma_f32_16x16x32_bf16(af, bfr, acc, 0, 0, 0);
            }
#pragma unroll
            for (int r = 0; r < 4; ++r) cT[(size_t)us * 8192 + (16 * w + 4 * kg + r) * 64 + 16 * dt + tq] = acc[r];
        }
        if (tid < 64) { float s = 0.f;
#pragma unroll
            for (int c8 = 0; c8 < 16; ++c8) { const v4u q = *(const LAS v4u*)(KeT + tid * ML_TS + 8 * c8); s += bflo(q.x) + bfhi(q.x) + bflo(q.y) + bfhi(q.y) + bflo(q.z) + bfhi(q.z) + bflo(q.w) + bfhi(q.w); }
            nl[(size_t)us * 64 + tid] = s; }
        __syncthreads();
    }
}

__device__ __forceinline__ void phase_ml_scan(Frame& F, const int skip = 0) {
    const int tid = F.tid;
    float* cT = (float*)(F.ws + WS_MCT); float* nl = (float*)(F.ws + WS_MN); float* sc = (float*)(F.ws + WS_MSC);
    for (int wi = F.blk; wi < 256; wi += F.G) {
        const int sq = wi >> 1, half = wi & 1; const bool don = (half == 0 && tid < 64);
        const size_t e0 = (size_t)half * 4096 + (size_t)tid * 8;
        f32x4 c0 = (f32x4){0.f, 0.f, 0.f, 0.f}, c1 = c0; float nn = 0.f, m = 0.f;
        size_t us = (size_t)sq * 18;
        f32x4 l0 = *(const f32x4*)(cT + us * 8192 + e0), l1 = *(const f32x4*)(cT + us * 8192 + e0 + 4);
        float ln = don ? nl[us * 64 + tid] : 0.f, tot = sc[us * 4], ml = sc[us * 4 + 1];
        for (int j = 0; j < 18; ++j, ++us) {
            const f32x4 a0 = l0, a1 = l1; const float an = ln, atot = tot, aml = ml;
            if (j + 1 < 18) { l0 = *(const f32x4*)(cT + (us + 1) * 8192 + e0); l1 = *(const f32x4*)(cT + (us + 1) * 8192 + e0 + 4); ln = don ? nl[(us + 1) * 64 + tid] : 0.f; tot = sc[(us + 1) * 4]; ml = sc[(us + 1) * 4 + 1]; }
            if (!skip) { *(f32x4*)(cT + us * 8192 + e0) = c0; *(f32x4*)(cT + us * 8192 + e0 + 4) = c1;
            if (don) nl[us * 64 + tid] = nn;
            if (half == 0 && tid == 0) sc[us * 4 + 2] = m; }
            const float mn = fmaxf(atot + m, aml), fa = __expf(atot + m - mn), fb = __expf(aml - mn);
            c0 = c0 * fa + a0 * fb; c1 = c1 * fa + a1 * fb; nn = nn * fa + an * fb; m = mn;
        }
    }
}

struct M3Regs { float gi, gf, n0v, m00, m01; v4u q[2], k[2], v[4]; };
__device__ __forceinline__ void m3_load(M3Regs& R, Frame& F, int u, int tid) {
    const bf16* kb = (const bf16*)(F.ws + WS_MK); const bf16* vb = (const bf16*)(F.ws + WS_MV); const bf16* qb = (const bf16*)(F.ws + WS_MQ);
    const float* gb = (const float*)(F.ws + WS_MG); const float* cT = (const float*)(F.ws + WS_MCT); const float* nl = (const float*)(F.ws + WS_MN); const float* sc = (const float*)(F.ws + WS_MSC);
    const int jo = u % 18, bh = u / 18, hd = bh & 7, b = bh >> 3;
    const int row0 = (jo < 2) ? b * CTX + 128 * jo : TC + b * SEQ + 128 * (jo - 2);
    const int jc1 = (jo < 2) ? 1 - jo : 19 - jo;
    const size_t us0 = (size_t)((b * 8 + hd) * 2 + 0) * 18 + jo, us1 = (size_t)((b * 8 + hd) * 2 + 1) * 18 + jc1;
    R.m00 = sc[us0 * 4 + 2]; R.m01 = sc[us1 * 4 + 2];
    R.gi = 0.f; R.gf = 0.f; R.n0v = 0.f;
    if (tid < 256) { const int dd = tid >> 7, sp = tid & 127; const int r = row0 + (dd ? 127 - sp : sp); R.gi = gb[(size_t)r * 32 + dd * 16 + hd]; R.gf = gb[(size_t)r * 32 + dd * 16 + 8 + hd]; }
    { const int i = tid & 127, c = tid >> 7; const int r = row0 + i;
#pragma unroll
      for (int h2 = 0; h2 < 2; ++h2) { R.q[h2] = *(const v4u*)(qb + (size_t)r * 512 + hd * 64 + 16 * c + 8 * h2); R.k[h2] = *(const v4u*)(kb + (size_t)r * 512 + hd * 64 + 16 * c + 8 * h2); } }
    { const int tp = tid & 63, c8 = tid >> 6;
#pragma unroll
      for (int tk = 0; tk < 2; ++tk)
#pragma unroll
          for (int h2 = 0; h2 < 2; ++h2) R.v[2 * tk + h2] = *(const v4u*)(vb + (size_t)(row0 + 2 * tp + tk) * 1024 + hd * 128 + 16 * c8 + 8 * h2); }
    if (tid < 128) R.n0v = nl[((tid >> 6) ? us1 : us0) * 64 + (tid & 63)];
}
__device__ __forceinline__ void phase_ml_out(Frame& F) {
    const int tid = F.tid, lane = F.lane, w = F.wave, tq = lane & 15, kg = lane >> 4;
    const bf16* ob = (const bf16*)(F.ws + WS_MO); bf16* zb = (bf16*)(F.ws + WS_Z);
    LAS bf16* QL = (LAS bf16*)(F.lds);
    LAS bf16* KL = (LAS bf16*)(F.lds + 18432);
    LAS bf16* SwL = (LAS bf16*)(F.lds + w * (16 * ML_TS * 2));
    LAS bf16* VT = (LAS bf16*)(F.lds + 36864);
    LAS bf16* C0T = (LAS bf16*)(F.lds + 36864 + 128 * ML_TS * 2);
    LAS float* GT = (LAS float*)(F.lds + 36864 + 128 * ML_TS * 2 + 2 * 144 * ML_DS * 2);
    static_assert(36864 + 128 * ML_TS * 2 + 2 * 144 * ML_DS * 2 + 2 * 3 * 128 * 4 <= RING_BYTES, "M3 LDS");
    for (int i = tid; i < 2 * 16 * ML_DS; i += NTHR) { const int dd = i / (16 * ML_DS), ii = i % (16 * ML_DS); C0T[dd * 144 * ML_DS + 128 * ML_DS + ii] = (bf16)0u; }
    constexpr int NU = NB * 8 * 18;
    M3Regs R;
    if (F.blk < NU) m3_load(R, F, F.blk, tid);
    __syncthreads();
    for (int u = F.blk; u < NU; u += F.G) {
        const int jo = u % 18, bh = u / 18, hd = bh & 7, b = bh >> 3;
        const int row0 = (jo < 2) ? b * CTX + 128 * jo : TC + b * SEQ + 128 * (jo - 2);
        const float m00 = R.m00, m01 = R.m01;
        if (tid < 256) { const int dd = tid >> 7, sp = tid & 127; GT[dd * 384 + sp] = R.gi; GT[dd * 384 + 256 + sp] = log_sigmoidf_(R.gf); }
        { const int i = tid & 127, c = tid >> 7;
#pragma unroll
          for (int h2 = 0; h2 < 2; ++h2) { *(LAS v4u*)(QL + i * ML_DS + 16 * c + 8 * h2) = R.q[h2]; *(LAS v4u*)(KL + i * ML_DS + 16 * c + 8 * h2) = R.k[h2]; } }
        { const int tp = tid & 63, c8 = tid >> 6;
#pragma unroll
          for (int h2 = 0; h2 < 2; ++h2) { const v4u a = R.v[h2], bq = R.v[2 + h2]; const unsigned av[4] = {a.x, a.y, a.z, a.w}, bv[4] = {bq.x, bq.y, bq.z, bq.w};
#pragma unroll
              for (int jj = 0; jj < 8; ++jj) { const unsigned lo = (jj & 1) ? (av[jj >> 1] >> 16) : (av[jj >> 1] & 0xffffu), hi = (jj & 1) ? (bv[jj >> 1] & 0xffff0000u) : (bv[jj >> 1] << 16);
                  *(LAS unsigned*)(VT + (16 * c8 + 8 * h2 + jj) * ML_TS + 2 * tp) = lo | hi; } } }
        { const float* cT = (const float*)(F.ws + WS_MCT); const int jc1 = (jo < 2) ? 1 - jo : 19 - jo;
          const size_t us0 = (size_t)((b * 8 + hd) * 2 + 0) * 18 + jo, us1 = (size_t)((b * 8 + hd) * 2 + 1) * 18 + jc1;
#pragma unroll
          for (int dd = 0; dd < 2; ++dd) { const size_t us = dd ? us1 : us0; const int jv = tid >> 2, dq = (tid & 3) * 16; const float* src = cT + us * 8192 + jv * 64 + dq;
#pragma unroll
              for (int h2 = 0; h2 < 2; ++h2) { const f32x4 a = *(const f32x4*)(src + 8 * h2), bq = *(const f32x4*)(src + 8 * h2 + 4);
                  v4u o; o.x = pk2(a.x, a.y); o.y = pk2(a.z, a.w); o.z = pk2(bq.x, bq.y); o.w = pk2(bq.z, bq.w);
                  *(LAS v4u*)(C0T + dd * 144 * ML_DS + jv * ML_DS + dq + 8 * h2) = o; } } }
        if (tid < 128) C0T[(tid >> 6) * 144 * ML_DS + 128 * ML_DS + (tid & 63)] = (bf16)f2bf(R.n0v);
        __syncthreads();
        if (u + F.G < NU) m3_load(R, F, u + F.G, tid);
        if (w < 2) {
            LAS float* gS = GT + w * 384; LAS float* mmS = gS + 128; LAS float* cumS = gS + 256; const float m0 = w ? m01 : m00;
            scan128<false>(cumS, lane);
            const float g0 = gS[2 * lane] - cumS[2 * lane], g1 = gS[2 * lane + 1] - cumS[2 * lane + 1];
            gS[2 * lane] = g0; gS[2 * lane + 1] = g1; mmS[2 * lane] = g0; mmS[2 * lane + 1] = g1;
            scan128<true>(mmS, lane);
            mmS[2 * lane] = fmaxf(mmS[2 * lane], m0); mmS[2 * lane + 1] = fmaxf(mmS[2 * lane + 1], m0);
        }
        __syncthreads();
        bf16x8 qf[2];
#pragma unroll
        for (int ks = 0; ks < 2; ++ks) qf[ks] = *(const LAS bf16x8*)(QL + (16 * w + tq) * ML_DS + 32 * ks + 8 * kg);
        float mm0r[4], mm1r[4], ai0[4], ai1[4], lb0[4], lb1[4];
#pragma unroll
        for (int r = 0; r < 4; ++r) { const int t0 = 16 * w + 4 * kg + r, t1 = 127 - t0;
            mm0r[r] = GT[128 + t0]; ai0[r] = __expf(m00 - mm0r[r]); lb0[r] = __expf(-GT[256 + t0] - mm0r[r]);
            mm1r[r] = GT[384 + 128 + t1]; ai1[r] = __expf(m01 - mm1r[r]); lb1[r] = __expf(-GT[384 + 256 + t1] - mm1r[r]); }
        f32x4 sraw[8]; float rs0[4] = {0.f, 0.f, 0.f, 0.f}, rs1[4] = {0.f, 0.f, 0.f, 0.f};
#pragma unroll
        for (int ct = 0; ct < 8; ++ct) {
            f32x4 a = (f32x4){0.f, 0.f, 0.f, 0.f};
#pragma unroll
            for (int ks = 0; ks < 2; ++ks) a = __builtin_amdgcn_mfma_f32_16x16x32_bf16(qf[ks], *(const LAS bf16x8*)(KL + (16 * ct + tq) * ML_DS + 32 * ks + 8 * kg), a, 0, 0, 0);
            sraw[ct] = a;
            const int o = 16 * ct + tq; const float g0o = GT[o], g1o = GT[384 + 127 - o];
#pragma unroll
            for (int r = 0; r < 4; ++r) { const int t0 = 16 * w + 4 * kg + r;
                rs0[r] += (o <= t0) ? a[r] * __expf(g0o - mm0r[r]) : 0.f; rs1[r] += (o >= t0) ? a[r] * __expf(g1o - mm1r[r]) : 0.f; }
        }
        f32x4 acc[8]; float sc0[4], sc1[4];
        {
            f32x4 q0 = (f32x4){0.f, 0.f, 0.f, 0.f}, q1 = q0;
#pragma unroll
            for (int ks = 0; ks < 2; ++ks) { q0 = __builtin_amdgcn_mfma_f32_16x16x32_bf16(qf[ks], *(const LAS bf16x8*)(C0T + (128 + tq) * ML_DS + 32 * ks + 8 * kg), q0, 0, 0, 0);
                                             q1 = __builtin_amdgcn_mfma_f32_16x16x32_bf16(qf[ks], *(const LAS bf16x8*)(C0T + 144 * ML_DS + (128 + tq) * ML_DS + 32 * ks + 8 * kg), q1, 0, 0, 0); }
#pragma unroll
            for (int r = 0; r < 4; ++r) {
                const float qn0 = red16_sum(q0[r]), qn1 = red16_sum(q1[r]);
                const float den0 = ai0[r] * qn0 + red16_sum(rs0[r]), den1 = ai1[r] * qn1 + red16_sum(rs1[r]);
                const float inv0 = __builtin_amdgcn_rcpf(fmaxf(fabsf(den0), lb0[r])), inv1 = __builtin_amdgcn_rcpf(fmaxf(fabsf(den1), lb1[r]));
                rs0[r] = inv0; rs1[r] = inv1; sc0[r] = ai0[r] * inv0; sc1[r] = ai1[r] * inv1; }
        }
#pragma unroll
        for (int ct = 0; ct < 8; ++ct) {
            f32x4 a0 = (f32x4){0.f, 0.f, 0.f, 0.f}, a1 = a0;
#pragma unroll
            for (int ks = 0; ks < 2; ++ks) { a0 = __builtin_amdgcn_mfma_f32_16x16x32_bf16(qf[ks], *(const LAS bf16x8*)(C0T + (16 * ct + tq) * ML_DS + 32 * ks + 8 * kg), a0, 0, 0, 0);
                                             a1 = __builtin_amdgcn_mfma_f32_16x16x32_bf16(qf[ks], *(const LAS bf16x8*)(C0T + 144 * ML_DS + (16 * ct + tq) * ML_DS + 32 * ks + 8 * kg), a1, 0, 0, 0); }
#pragma unroll
            for (int r = 0; r < 4; ++r) acc[ct][r] = a0[r] * sc0[r] + a1[r] * sc1[r];
        }
        __syncthreads();
#pragma unroll
        for (int ct = 0; ct < 8; ++ct) { const int o = 16 * ct + tq; const float g0o = GT[o], g1o = GT[384 + 127 - o];
#pragma unroll
            for (int r = 0; r < 4; ++r) { const int t0 = 16 * w + 4 * kg + r;
                const float x0 = (o <= t0) ? __expf(g0o - mm0r[r]) * rs0[r] : 0.f, x1 = (o >= t0) ? __expf(g1o - mm1r[r]) * rs1[r] : 0.f;
                SwL[(4 * kg + r) * ML_TS + 16 * ct + tq] = (bf16)f2bf(sraw[ct][r] * (x0 + x1)); } }
#pragma unroll
        for (int ks = 0; ks < 4; ++ks) {
            const bf16x8 af = *(const LAS bf16x8*)(SwL + tq * ML_TS + 32 * ks + 8 * kg);
#pragma unroll
            for (int ct = 0; ct < 8; ++ct) acc[ct] = __builtin_amdgcn_mfma_f32_16x16x32_bf16(af, *(const LAS bf16x8*)(VT + (16 * ct + tq) * ML_TS + 32 * ks + 8 * kg), acc[ct], 0, 0, 0);
        }
        float ss[4] = {0.f, 0.f, 0.f, 0.f};
#pragma unroll
        for (int ct = 0; ct < 8; ++ct) { ss[0] += acc[ct].x * acc[ct].x; ss[1] += acc[ct].y * acc[ct].y; ss[2] += acc[ct].z * acc[ct].z; ss[3] += acc[ct].w * acc[ct].w; }
#pragma unroll
        for (int r = 0; r < 4; ++r) ss[r] = rsqrtf(red16_sum(ss[r]) * (1.f / 128.f) + EPS);
#pragma unroll
        for (int ct = 0; ct < 8; ++ct) { const float gn = F.in[IN_MLNG][hd * 128 + 16 * ct + tq];
#pragma unroll
            for (int r = 0; r < 4; ++r) SwL[(4 * kg + r) * ML_TS + 16 * ct + tq] = (bf16)f2bf(acc[ct][r] * ss[r] * gn); }
#pragma unroll
        for (int i = 0; i < 4; ++i) { const int rr = 4 * i + kg, ch = tq;
            const v4u hv = *(const LAS v4u*)(SwL + rr * ML_TS + 8 * ch);
            const size_t idx = (size_t)(row0 + 16 * w + rr) * D + hd * 128 + 8 * ch;
            const v4u ov = *(const v4u*)(ob + idx);
            v4u zo; zo.x = pk2(bflo(hv.x) * sigmoidf_(bflo(ov.x)), bfhi(hv.x) * sigmoidf_(bfhi(ov.x))); zo.y = pk2(bflo(hv.y) * sigmoidf_(bflo(ov.y)), bfhi(hv.y) * sigmoidf_(bfhi(ov.y)));
            zo.z = pk2(bflo(hv.z) * sigmoidf_(bflo(ov.z)), bfhi(hv.z) * sigmoidf_(bfhi(ov.z))); zo.w = pk2(bflo(hv.w) * sigmoidf_(bflo(ov.w)), bfhi(hv.w) * sigmoidf_(bfhi(ov.w)));
            *(v4u*)(zb + idx) = zo; }
        __syncthreads();
    }
}

#ifndef USE_NAIVE_ATTN
#define USE_NAIVE_ATTN 0
#endif
#ifndef USE_NAIVE_S5
#define USE_NAIVE_S5 0
#endif
#ifndef USE_NAIVE_MLSTM
#define USE_NAIVE_MLSTM 0
#endif
#ifndef MK_MODE
#define MK_MODE 0
#endif
struct Args { const float* in[N_INPUTS]; float* out; unsigned char* ws; int ph_lo, ph_hi; };
enum { CBASE = __COUNTER__ + 1 };
#ifndef S5VAR
#define S5VAR 0
#endif
#ifndef DUP_A
#define DUP_A -1
#endif
#ifndef DUP_B
#define DUP_B -1
#endif
#define PHASE_IDS() { int t_ = threadIdx.x; asm volatile("" : "+v"(t_)); F.tid = t_; F.lane = t_ & 63; F.wave = __builtin_amdgcn_readfirstlane(t_ >> 6); }
#ifndef SW_PHASE
#define SW_PHASE -1
#endif
#define PHASE(...) { constexpr int k_ = __COUNTER__ - CBASE; if (lo <= k_ && k_ < hi) { PHASE_IDS() unsigned long long swt_ = 0; if (k_ == SW_PHASE) swt_ = __builtin_amdgcn_s_memtime(); \
    { constexpr int rep_ = 0; (void)rep_; __VA_ARGS__ } \
    if constexpr (k_ == DUP_A || k_ == DUP_B) { xcd_barrier(bar); { constexpr int rep_ = 1; (void)rep_; __VA_ARGS__ } } \
    if (k_ + 1 < hi) xcd_barrier(bar); \
    if (k_ == SW_PHASE && F.blk == 0 && threadIdx.x == 0) F.ctl[64] = (unsigned)((__builtin_amdgcn_s_memtime() - swt_) >> 4); } }

__global__ void __launch_bounds__(NTHR, 2) fwd_kernel(Args args) {
    extern __shared__ __attribute__((aligned(16))) unsigned char lds[];
    Frame F;
    F.lds = (LAS unsigned char*)lds;
    F.MISC = (volatile LAS unsigned*)(F.lds + MISC_OFF);
    F.tid = threadIdx.x; F.lane = F.tid & 63; F.wave = __builtin_amdgcn_readfirstlane(F.tid >> 6);
    F.G = gridDim.x; F.blk = blockIdx.x;
    F.ws = args.ws; F.out = args.out; F.ctl = (unsigned*)(args.ws + WS_CTL);
#pragma unroll
    for (int i = 0; i < N_INPUTS; ++i) F.in[i] = args.in[i];
    for (int u = F.tid; u < (LDS_BYTES - LDSCTL_OFF) / 4; u += NTHR) ((LAS unsigned*)(F.lds + LDSCTL_OFF))[u] = 0u;
    __syncthreads();
    const int lo = args.ph_lo, hi = args.ph_hi;
    XcdBarrier bar; bar.bar = F.ctl + CW_BAR; bar.x = 0; bar.st = nullptr;
    if (hi - lo > 1) bar = xcd_barrier_post(F.ctl + CW_BAR, F.MISC + 8);

    unsigned char* ws = F.ws;
    bf16* xres = (bf16*)(ws + WS_XRES); const float* mod = (const float*)(ws + WS_MOD);
    bf16* hb = (bf16*)(ws + WS_H); bf16* zb = (bf16*)(ws + WS_Z);
    const LAS int* etab = (const LAS int*)(F.lds + ETAB_OFF);

#define MOE_PHASES(L) \
    PHASE(phase_n2<L>(F, rep_);) \
    PHASE(phase_sc<L>(F);) \
    PHASE({ load_etab(F); pg8::Gemm g{(const bf16*)(ws + WS_HS), (const bf16*)(ws + WS_WG1) + (size_t)(L) * NEXP * 1024 * 1024, SLOTS, NEXP * 1024, 1024}; \
               MoeSched S{etab, F.G, F.blk, 4}; EpiG1 E{(bf16*)(ws + WS_HID)}; run_gemm(F, g, S, E); }) \
    PHASE({ load_etab(F); pg8::Gemm g{(const bf16*)(ws + WS_HID), (const bf16*)(ws + WS_WG2) + (size_t)(L) * NEXP * 1024 * 512, SLOTS, NEXP * 1024, 512}; \
               MoeSched S{etab, F.G, F.blk, 4}; EpiG2 E{(bf16*)(ws + WS_Y2), (const float*)(ws + WS_SLOTW)}; run_gemm(F, g, S, E); })

    PHASE(phase_prologue(F);)
    PHASE(phase_a1<0>(F, rep_);)
#if USE_NAIVE_S5
    PHASE(phase_s5_naive<0, true>(F);)
    PHASE(phase_s5_combine<0, true>(F);)
#else
    PHASE(phase_s5_fast<0, true>(F);)
#endif
    PHASE({ pg8::Gemm g{zb, (const bf16*)(ws + WS_WGLU), T, 2048, 1024}; DenseSched S; S.init(T, 2048, F.G, F.blk, 0);
               EpiGlu E{xres, mod + 0 * 9 * 6144 + 2048, F.in[IN_S5BGLU], rep_}; run_gemm(F, g, S, E); })
    MOE_PHASES(0)
    PHASE(phase_a1<1>(F, rep_);)
    PHASE({ pg8::Gemm g{hb, (const bf16*)(ws + WS_WKVQ), T, 1536, 1024}; DenseSched S; S.init(T, 1536, F.G, F.blk, 0);
               EpiKvq E{(bf16*)(ws + WS_QB), (bf16*)(ws + WS_KB), (bf16*)(ws + WS_VB), F.in[IN_AQG], F.in[IN_AKG], (const float*)(ws + WS_ROPE)}; run_gemm(F, g, S, E); })
#if USE_NAIVE_ATTN
    PHASE(phase_attn_naive<true>(F);)
#else
    PHASE(phase_attn_fast<true>(F, (char*)lds);)
#endif
    PHASE({ pg8::Gemm g{zb, (const bf16*)(ws + WS_WO), T, 1024, 1024}; DenseSched S; S.init(T, 1024, F.G, F.blk, 0);
               EpiRes E{xres, mod + 1 * 9 * 6144 + 2048, rep_, (bf16*)(ws + WS_MIX)}; run_gemm(F, g, S, E); })
    MOE_PHASES(1)
    PHASE(phase_a1<2>(F, rep_);)
    PHASE({ pg8::Gemm g{hb, (const bf16*)(ws + WS_WIN), T, ML_NIN, 1024}; DenseSched S; S.init(T, ML_NIN, F.G, F.blk, 0);
               EpiMlIn E{(bf16*)(ws + WS_MK), (bf16*)(ws + WS_MV), (bf16*)(ws + WS_MQ), (bf16*)(ws + WS_MO), (float*)(ws + WS_MG), F.in[IN_MLBG]}; run_gemm(F, g, S, E); })
#if USE_NAIVE_MLSTM
    PHASE(phase_mlstm_naive<true>(F);)
    PHASE(phase_mlstm_combine<true>(F);)
#else
    PHASE(phase_ml_states(F);)
    PHASE(phase_ml_scan(F, rep_);)
    PHASE(phase_ml_out(F);)
#endif
    PHASE({ pg8::Gemm g{zb, (const bf16*)(ws + WS_WOUT), T, 1024, 1024}; DenseSched S; S.init(T, 1024, F.G, F.blk, 0);
               EpiRes E{xres, mod + 2 * 9 * 6144 + 2048, rep_, (bf16*)(ws + WS_MHS)}; run_gemm(F, g, S, E); })
    MOE_PHASES(2)
    PHASE(phase_a1<3>(F, rep_);)
#if USE_NAIVE_S5
    PHASE(phase_s5_naive<1, false>(F);)
    PHASE(phase_s5_combine<1, false>(F);)
#else
    PHASE(phase_s5_fast<1, false>(F);)
#endif
    PHASE({ pg8::Gemm g{zb, (const bf16*)(ws + WS_WGLU) + (size_t)2048 * 1024, T, 2048, 1024}; DenseSched S; S.init(TL, 2048, F.G, F.blk, TC / 256);
               EpiGlu E{xres, mod + 3 * 9 * 6144 + 2048, F.in[IN_S5BGLU] + 2048, rep_}; run_gemm(F, g, S, E); })
    MOE_PHASES(3)
    PHASE(phase_fin(F);)
#if SW_PHASE >= 0
    if (F.blk == 0 && threadIdx.x == 0) { const unsigned v = __hip_atomic_load(F.ctl + 64, __ATOMIC_RELAXED, __HIP_MEMORY_SCOPE_AGENT); const unsigned long long t0 = __builtin_amdgcn_s_memtime();
        while (__builtin_amdgcn_s_memtime() - t0 < (unsigned long long)v * 16ull * 16ull) __builtin_amdgcn_s_sleep(8); }
#endif
}
constexpr int NPH = __COUNTER__ - CBASE;

extern "C" void kernel_launch(void* const* d_in, const int* in_sizes, int n_in, void* d_out, int out_size, void* d_ws, size_t ws_size, hipStream_t stream) {
    static int grid = 0;
    if (grid == 0) {
        if (n_in != N_INPUTS || out_size != TL * D || ws_size < WS_END) { fprintf(stderr, "kernel_launch: unexpected problem: n_in %d out %d ws %zu (need %zu)\n", n_in, out_size, ws_size, (size_t)WS_END); grid = -1; return; }
        int dev = 0, cus = 0, per_cu = 0;
        if (hipGetDevice(&dev) != hipSuccess || hipDeviceGetAttribute(&cus, hipDeviceAttributeMultiprocessorCount, dev) != hipSuccess) { grid = -1; return; }
        if (hipFuncSetAttribute((const void*)fwd_kernel, hipFuncAttributeMaxDynamicSharedMemorySize, LDS_BYTES) != hipSuccess) { fprintf(stderr, "kernel_launch: hipFuncSetAttribute failed\n"); grid = -1; return; }
        if (hipOccupancyMaxActiveBlocksPerMultiprocessor(&per_cu, (const void*)fwd_kernel, NTHR, LDS_BYTES) != hipSuccess || per_cu < 1) fprintf(stderr, "kernel_launch: occupancy query reports %d\n", per_cu);
        (void)hipGetLastError();
        grid = cus;
        if (grid > 256) grid = 256;
    }
    if (grid < 0) return;
    if (hipMemsetAsync((char*)d_ws + WS_CTL, 0, CTL_ZERO_BYTES, stream) != hipSuccess) return;
    Args a{};
    for (int i = 0; i < N_INPUTS; ++i) a.in[i] = (const float*)d_in[i];
    a.out = (float*)d_out; a.ws = (unsigned char*)d_ws;
#if MK_MODE == 0
    a.ph_lo = 0; a.ph_hi = NPH;
    hipLaunchKernelGGL(fwd_kernel, dim3(grid), dim3(NTHR), LDS_BYTES, stream, a);
#else
    for (int p = 0; p < NPH; ++p) { a.ph_lo = p; a.ph_hi = p + 1; hipLaunchKernelGGL(fwd_kernel, dim3(grid), dim3(NTHR), LDS_BYTES, stream, a); }
#endif
}
```

```cpp
#include <hip/hip_runtime.h>
#include <cstdio>
#include <cstdint>

#define GAS __attribute__((address_space(1)))
#define LAS __attribute__((address_space(3)))
typedef unsigned short bf16;
typedef unsigned v4u __attribute__((ext_vector_type(4)));
typedef unsigned v2u __attribute__((ext_vector_type(2)));
typedef float f32x4 __attribute__((ext_vector_type(4)));
typedef float f32x2 __attribute__((ext_vector_type(2)));
typedef short bf16x8 __attribute__((ext_vector_type(8)));

constexpr int D = 1024, NB = 8, SEQ = 2048, CTX = 256, DEPTH = 4;
constexpr int TC = NB * CTX;
constexpr int TL = NB * SEQ;
constexpr int T = TC + TL;
constexpr int KVLEN = SEQ + CTX;
constexpr int NEXP = 16, DFF = 512;
constexpr int SLOTS = 40960;
constexpr int ML_NIN = 3328;
constexpr float EPS = 1e-6f;
constexpr int NWAVES = 8, NTHR = 512;
constexpr float ATT_C2 = 0.125f * 1.4426950408889634f;

constexpr size_t MiB = 1u << 20;
constexpr size_t WS_CTL = 0, CTL_ZERO_BYTES = 1 * MiB;
constexpr size_t WS_MOD = 1 * MiB;
constexpr size_t WS_ROPE = 2 * MiB;
constexpr size_t WS_TOKE = 2 * MiB + 65536;
constexpr size_t WS_TOKR = WS_TOKE + 163840;
constexpr size_t WS_TOKW = WS_TOKR + 163840;
constexpr size_t WS_TOKS = WS_TOKW + 163840;
constexpr size_t WS_BCNT = WS_TOKS + 163840;
constexpr size_t WS_ETAB = WS_BCNT + 16384;
constexpr size_t WS_SLOTW = WS_ETAB + 4096;
constexpr size_t WS_SLOTR = WS_SLOTW + 163840;
static_assert(WS_SLOTR + SLOTS * 4 <= 4 * MiB, "small tables");
constexpr size_t WS_WGLU = 4 * MiB;
constexpr size_t WS_WKVQ = WS_WGLU + 8 * MiB;
constexpr size_t WS_WO = WS_WKVQ + 3 * MiB;
constexpr size_t WS_WIN = WS_WO + 2 * MiB;
constexpr size_t WS_WOUT = WS_WIN + 7 * MiB;
constexpr size_t WS_WG1 = WS_WOUT + 2 * MiB;
constexpr size_t WS_WG2 = WS_WG1 + 128 * MiB;
constexpr size_t WS_XRES = WS_WG2 + 64 * MiB;
constexpr size_t WS_H = WS_XRES + 72 * MiB;
constexpr size_t WS_Z = WS_H + 36 * MiB;
constexpr size_t WS_MIX = WS_Z + 36 * MiB;
constexpr size_t WS_HS = WS_MIX;
constexpr size_t WS_HID = WS_HS + 80 * MiB;
constexpr size_t WS_Y2 = WS_HID + 40 * MiB;
constexpr size_t WS_END = WS_Y2 + 80 * MiB;
constexpr size_t WS_YSUM = WS_MIX;
constexpr size_t WS_QB = WS_MIX;
constexpr size_t WS_KB = WS_QB + 36 * MiB;
constexpr size_t WS_VB = WS_KB + 9 * MiB;
constexpr size_t WS_MK = WS_MIX;
constexpr size_t WS_MV = WS_MK + 18 * MiB;
constexpr size_t WS_MQ = WS_MV + 36 * MiB;
constexpr size_t WS_MO = WS_MQ + 18 * MiB;
constexpr size_t WS_MG = WS_MO + 36 * MiB;
constexpr size_t WS_MHS = WS_MG + 3 * MiB;
static_assert(WS_MHS + 72 * MiB <= WS_END, "mLSTM view fits");
static_assert(WS_END <= 600 * MiB, "workspace budget");

constexpr int CW_BAR = 4096;

constexpr int RING_OFF = 0, RING_BYTES = 131072;
constexpr int LDSCTL_OFF = RING_BYTES, MISC_OFF = LDSCTL_OFF + 320;
constexpr int ETAB_OFF = MISC_OFF + 128;
constexpr int SCT_OFF = ETAB_OFF + 128;
constexpr int LDS_BYTES = 147456;
static_assert(SCT_OFF + 256 <= LDS_BYTES, "LDS map");

#define LDS_WAIT() asm volatile("s_waitcnt lgkmcnt(0)" ::: "memory")
#define VM_WAIT() asm volatile("s_waitcnt vmcnt(0)" ::: "memory")
__device__ __forceinline__ unsigned f2bf(float f) { unsigned u = __builtin_bit_cast(unsigned, f); return (u + 0x7fffu + ((u >> 16) & 1u)) >> 16; }
typedef float f32x2_cv __attribute__((ext_vector_type(2))); typedef __bf16 bf16x2_cv __attribute__((ext_vector_type(2)));
__device__ __forceinline__ unsigned pk2(float lo, float hi) { f32x2_cv v = {lo, hi}; bf16x2_cv b = __builtin_convertvector(v, bf16x2_cv); return __builtin_bit_cast(unsigned, b); }
__device__ __forceinline__ float bf2f(unsigned h) { return __builtin_bit_cast(float, h << 16); }
__device__ __forceinline__ float bflo(unsigned w) { return __builtin_bit_cast(float, w << 16); }
__device__ __forceinline__ float bfhi(unsigned w) { return __builtin_bit_cast(float, w & 0xffff0000u); }
template <int CTRL, int RMASK = 0xF>
__device__ __forceinline__ float dpp_f(float oldv, float v) { return __builtin_bit_cast(float, __builtin_amdgcn_update_dpp(__builtin_bit_cast(int, oldv), __builtin_bit_cast(int, v), CTRL, RMASK, 0xF, false)); }
#ifndef USE_SHFL_XOR
#define USE_SHFL_XOR 0
#endif
#ifndef USE_SHFL_PARTIAL
#define USE_SHFL_PARTIAL 0
#endif
__device__ __forceinline__ float red16_sum(float v) {
#if USE_SHFL_PARTIAL
    for (int o = 1; o < 16; o <<= 1) v += __shfl_xor(v, o);
    return v;
#endif
    v += dpp_f<0xB1>(0.f, v); v += dpp_f<0x4E>(0.f, v); v += dpp_f<0x141>(0.f, v); v += dpp_f<0x140>(0.f, v); return v; }
__device__ __forceinline__ float red16_max(float v) {
    v = fmaxf(v, dpp_f<0xB1>(v, v)); v = fmaxf(v, dpp_f<0x4E>(v, v)); v = fmaxf(v, dpp_f<0x141>(v, v)); v = fmaxf(v, dpp_f<0x140>(v, v)); return v; }
#ifndef USE_SHFL_REDUCE
#define USE_SHFL_REDUCE 0
#endif
__device__ __forceinline__ float wave_sum(float v) {
#if USE_SHFL_REDUCE
    for (int o = 1; o < 64; o <<= 1) v += __shfl_xor(v, o);
    return v;
#endif
    v = red16_sum(v); v += dpp_f<0x142, 0xA>(0.f, v); v += dpp_f<0x143, 0xC>(0.f, v);
    return __builtin_bit_cast(float, __builtin_amdgcn_readlane(__builtin_bit_cast(int, v), 63)); }
__device__ __forceinline__ float wave_max(float v) {
    v = red16_max(v); v = fmaxf(v, dpp_f<0x142, 0xA>(v, v)); v = fmaxf(v, dpp_f<0x143, 0xC>(v, v));
    return __builtin_bit_cast(float, __builtin_amdgcn_readlane(__builtin_bit_cast(int, v), 63)); }
__device__ __forceinline__ float xor16_sum(float v) { return v + __shfl_xor(v, 16); }
__device__ __forceinline__ float xor32_sum(float v) { return v + __shfl_xor(v, 32); }
__device__ __forceinline__ float sigmoidf_(float x) { return __builtin_amdgcn_rcpf(1.f + __expf(-x)); }
__device__ __forceinline__ float siluf_(float x) { return x * __builtin_amdgcn_rcpf(1.f + __expf(-x)); }
__device__ __forceinline__ float gelu_tanh(float x) {
    const float p = __builtin_fmaf(x * x, 0.044715f, 1.0f);
    const float e = __builtin_amdgcn_exp2f((x * -2.302208198f) * p);
    return x * __builtin_amdgcn_rcpf(1.0f + e);
}
__device__ __forceinline__ float log_sigmoidf_(float x) { return fminf(x, 0.f) - __logf(1.f + __expf(-fabsf(x))); }
__device__ __forceinline__ void sincos_d(double a, double& s, double& c) {
    const double k = __builtin_rint(a * 0.63661977236758134308);
    double r = __builtin_fma(-k, 1.57079632679489655800e+00, a);
    r = __builtin_fma(-k, 6.12323399573676603587e-17, r);
    const double r2 = r * r;
    double sp = -1.0 / 1307674368000.0;
    sp = sp * r2 + 1.0 / 6227020800.0; sp = sp * r2 - 1.0 / 39916800.0; sp = sp * r2 + 1.0 / 362880.0; sp = sp * r2 - 1.0 / 5040.0; sp = sp * r2 + 1.0 / 120.0; sp = sp * r2 - 1.0 / 6.0;
    const double sr = r + r * r2 * sp;
    double cp = 1.0 / 20922789888000.0;
    cp = cp * r2 - 1.0 / 87178291200.0; cp = cp * r2 + 1.0 / 479001600.0; cp = cp * r2 - 1.0 / 3628800.0; cp = cp * r2 + 1.0 / 40320.0; cp = cp * r2 - 1.0 / 720.0; cp = cp * r2 + 1.0 / 24.0; cp = cp * r2 - 0.5;
    const double cr = 1.0 + r2 * cp;
    const int q = ((int)k) & 3;
    s = (q == 0) ? sr : (q == 1) ? cr : (q == 2) ? -sr : -cr;
    c = (q == 0) ? cr : (q == 1) ? -sr : (q == 2) ? -cr : sr;
}
__device__ __forceinline__ int mrow_of(int r) { return r < TC ? 8 : ((r - TC) >> 11); }
namespace pg8 {
#define PG8_LAS __attribute__((address_space(3)))
typedef unsigned short bf16_t;
typedef short bf16x8 __attribute__((ext_vector_type(8)));
typedef float f32x4 __attribute__((ext_vector_type(4)));
typedef unsigned u32x4 __attribute__((ext_vector_type(4)));
constexpr int BM = 256, BK = 64, HALF = 128, HTB = HALF * BK * 2  , STAGE_BYTES = 8 * HTB, NXCD = 8, WGM = 8;

__host__ __device__ __forceinline__ int lds_byte(int r, int c) { const int st = (r >> 4) * 2 + (c >> 5), rr = r & 15, cc = c & 31, ob = rr * 64 + cc * 2; return st * 1024 + (ob ^ (((ob >> 9) & 1) << 5)); }
__host__ __device__ __forceinline__ void stage_rc(int b, int& R, int& C) { const int st = b / 1024, sb = b % 1024, swz = sb ^ (((sb >> 9) & 1) << 5); R = (st >> 1) * 16 + swz / 64; C = (st & 1) * 32 + (swz % 64) / 2; }
__host__ __device__ __forceinline__ int perm32(int rho) { const int n = rho >> 4, i = rho & 15; return 8 * (i >> 2) + 4 * n + (i & 3); }

struct Unit { int pm, pn; };
struct Gemm { const bf16_t* A; const bf16_t* Bt; int M, N, K; const int* rowmap; };

struct StaticOrder {
    int nM, nN, nwg, G, c;
    __host__ __device__ void init(int M, int N, int G_, int c_) { nM = M / BM; nN = N / BM; nwg = nM * nN; G = G_; c = c_; }
    __host__ __device__ bool next(int i, Unit& u) const {
        const long L = (long)i * G + c; if (L >= nwg) return false;
        int wgid = (int)L; { const int q = nwg / NXCD, r = nwg % NXCD, xcd = wgid % NXCD, off = wgid / NXCD; wgid = (xcd < r ? xcd * (q + 1) : r * (q + 1) + (xcd - r) * q) + off; }
        const int nig = WGM * nN, gid = wgid / nig, fm = gid * WGM, gsz = (nM - fm) < WGM ? (nM - fm) : WGM;
        u.pm = fm + ((wgid % nig) % gsz); u.pn = (wgid % nig) / gsz; return true;
    }
    __device__ __forceinline__ void a_ready(const Unit&) const {}
    __device__ __forceinline__ void done(const Unit&) const {}
};


template <class Epi, class Sched, bool ALIGN_EPI = false, bool SP2 = false, bool GATHER = false>
__device__ __forceinline__ void gemm_phase(PG8_LAS unsigned char* lds, const Gemm g, const Sched& S, const Epi& E) {
    const int tid = threadIdx.x, wid = __builtin_amdgcn_readfirstlane(tid >> 6), lane = tid & 63, wr = wid >> 2, wc = wid & 3, fr = lane & 15, fq = lane >> 4;
    const int K = g.K, nt = K / BK;
    unsigned voffA[2], voffB[2];
#pragma unroll
    for (int i = 0; i < 2; ++i) { int R, C; stage_rc(tid * 16 + i * 8192, R, C); const int Rb = Epi::PERM ? ((R & ~31) + perm32(R & 31)) : R;
        voffA[i] = (unsigned)(R * K + C) * 2u; voffB[i] = (unsigned)(Rb * K + C) * 2u; }
    static_assert(!GATHER || SP2, "gather path is written for the SP2 loop");
    unsigned oc[2][2], rn[2][2], cbA[2]; int Rg[2];
    if constexpr (GATHER) {
#pragma unroll
        for (int i = 0; i < 2; ++i) { int R, C; stage_rc(tid * 16 + i * 8192, R, C); Rg[i] = R; cbA[i] = (unsigned)C * 2u; } }
    const char* gA = (const char*)g.A;
    const size_t kstep = (size_t)(BK * 2);
    const size_t hstep = (size_t)HALF * K * 2;
    const size_t tstep = 2 * hstep;
    const unsigned ldsw = (unsigned)wid * 1024u;
    const int aoff = lds_byte(wr * 64 + fr, fq * 8), boff = lds_byte(wc * 32 + fr, fq * 8);
#define PG8_SA(b, h) (((b) * 2 + (h)) * HTB)
#define PG8_SB(b, h) ((4 + (b) * 2 + (h)) * HTB)
#define PG8_STAGE(bufoff, gbase, voff) do { _Pragma("unroll") for (int _i = 0; _i < 2; ++_i) \
        __builtin_amdgcn_global_load_lds((const unsigned*)((const char*)(gbase) + (voff)[_i]), (PG8_LAS unsigned*)(lds + (bufoff) + ldsw + _i * 8192), 16, 0, 0); } while (0)
#define PG8_STA(b, h, base_ng, base_g, OFF) do { if constexpr (GATHER) PG8_STAGE(PG8_SA(b, h), base_g, OFF[h]); else PG8_STAGE(PG8_SA(b, h), (base_ng) + (h) * hstep, voffA); } while (0)
#define PG8_LDA(dst, b, h) do { _Pragma("unroll") for (int m = 0; m < 4; ++m) _Pragma("unroll") for (int k = 0; k < 2; ++k) dst[m][k] = *(const PG8_LAS bf16x8*)(lds + PG8_SA(b, h) + aoff + m * 2048 + k * 1024); } while (0)
#define PG8_LDB(dst, b, h) do { _Pragma("unroll") for (int n = 0; n < 2; ++n) _Pragma("unroll") for (int k = 0; k < 2; ++k) dst[n][k] = *(const PG8_LAS bf16x8*)(lds + PG8_SB(b, h) + boff + n * 2048 + k * 1024); } while (0)
#define PG8_MMA(ai, bj, At, Bt) do { __builtin_amdgcn_s_setprio(1); _Pragma("unroll") for (int m = 0; m < 4; ++m) _Pragma("unroll") for (int n = 0; n < 2; ++n) _Pragma("unroll") for (int k = 0; k < 2; ++k) \
        acc[ai][bj][m][n] = __builtin_amdgcn_mfma_f32_16x16x32_bf16(Bt[n][k], At[m][k], acc[ai][bj][m][n], 0, 0, 0); __builtin_amdgcn_s_setprio(0); } while (0)
#define PG8_WAIT_V(n) asm volatile("s_waitcnt vmcnt(" #n ")" ::: "memory")
#define PG8_WAIT_L(n) asm volatile("s_waitcnt lgkmcnt(" #n ")" ::: "memory")
#define PG8_BAR __builtin_amdgcn_s_barrier()
#define PG8_SCHED __builtin_amdgcn_sched_barrier(0)
    Unit cur, nxt; int ui = 0;
    if (!S.next(0, cur)) return;
    f32x4 acc[2][2][4][2];
#pragma unroll
    for (int a = 0; a < 2; ++a)
#pragma unroll
        for (int b = 0; b < 2; ++b)
#pragma unroll
            for (int m = 0; m < 4; ++m)
#pragma unroll
                for (int n = 0; n < 2; ++n) acc[a][b][m][n] = (f32x4){0.f, 0.f, 0.f, 0.f};
    bf16x8 At[4][2], B0[2][2], B1[2][2];
    const char* cA = (const char*)g.A + (size_t)cur.pm * tstep; const char* cB = (const char*)g.Bt + (size_t)cur.pn * tstep;
    S.a_ready(cur);
    if constexpr (GATHER) {
#pragma unroll
        for (int h = 0; h < 2; ++h)
#pragma unroll
            for (int i = 0; i < 2; ++i) oc[h][i] = (unsigned)g.rowmap[cur.pm * 256 + h * 128 + Rg[i]] * (unsigned)(K * 2) + cbA[i]; }
    if constexpr (SP2) {
        PG8_STAGE(PG8_SB(0, 0), cB, voffB); PG8_STAGE(PG8_SB(0, 1), cB + hstep, voffB); PG8_STA(0, 0, cA, gA, oc); PG8_STA(0, 1, cA, gA, oc);
        if (wr == 1) PG8_BAR;
        PG8_WAIT_V(2); PG8_BAR;
        PG8_STAGE(PG8_SB(1, 0), cB + kstep, voffB); PG8_STA(1, 0, cA + kstep, gA + kstep, oc); PG8_STAGE(PG8_SB(1, 1), cB + hstep + kstep, voffB);
        PG8_WAIT_V(6); PG8_BAR;
    } else {
        PG8_STAGE(PG8_SB(0, 0), cB, voffB); PG8_STAGE(PG8_SA(0, 0), cA, voffA); PG8_STAGE(PG8_SB(0, 1), cB + hstep, voffB); PG8_STAGE(PG8_SA(0, 1), cA + hstep, voffA);
        if (wr == 1) PG8_BAR;
        PG8_WAIT_V(4); PG8_BAR;
        PG8_STAGE(PG8_SB(1, 0), cB + kstep, voffB); PG8_STAGE(PG8_SA(1, 0), cA + kstep, voffA); PG8_STAGE(PG8_SB(1, 1), cB + hstep + kstep, voffB);
        PG8_WAIT_V(6); PG8_BAR;
    }
    for (;;) {
        const bool has_next = S.next(ui + 1, nxt);
        if constexpr (GATHER) { if (has_next) {
#pragma unroll
            for (int h = 0; h < 2; ++h)
#pragma unroll
                for (int i = 0; i < 2; ++i) rn[h][i] = (unsigned)g.rowmap[nxt.pm * 256 + h * 128 + Rg[i]]; } }
        const char* nA = has_next ? (const char*)g.A + (size_t)nxt.pm * tstep : cA; const char* nB = has_next ? (const char*)g.Bt + (size_t)nxt.pn * tstep : cB;
        for (int t = 0; t < nt; t += 2) {
            const bool last = (t == nt - 2);
            const char* a1 = cA + (size_t)(t + 1) * kstep;
            const char* a2 = last ? nA : cA + (size_t)(t + 2) * kstep; const char* b2 = last ? nB : cB + (size_t)(t + 2) * kstep;
            const char* a3 = a2 + kstep; const char* b3 = b2 + kstep;
            if (last && has_next) S.a_ready(nxt);
            unsigned o2[2][2]; const char* a1g = gA + (size_t)(t + 1) * kstep; const char* a2g = gA + (last ? (size_t)0 : (size_t)(t + 2) * kstep); const char* a3g = a2g + kstep;
            if constexpr (GATHER) {
                if (last && has_next) {
#pragma unroll
                    for (int h = 0; h < 2; ++h)
#pragma unroll
                        for (int i = 0; i < 2; ++i) { unsigned v = rn[h][i]; asm volatile("" : "+v"(v)); o2[h][i] = v * (unsigned)(K * 2) + cbA[i]; } }
                else {
#pragma unroll
                    for (int h = 0; h < 2; ++h)
#pragma unroll
                        for (int i = 0; i < 2; ++i) o2[h][i] = oc[h][i]; }
            }
            if constexpr (SP2) {
            PG8_LDB(B0, 0, 0); PG8_LDB(B1, 0, 1); PG8_SCHED; PG8_LDA(At, 0, 0); PG8_STA(1, 1, a1, a1g, oc);
            PG8_WAIT_V(8); PG8_WAIT_L(0); PG8_BAR; PG8_MMA(0, 0, At, B0); PG8_MMA(0, 1, At, B1); PG8_BAR; PG8_SCHED;
            PG8_LDA(At, 0, 1); PG8_STAGE(PG8_SB(0, 0), b2, voffB); PG8_STAGE(PG8_SB(0, 1), b2 + hstep, voffB); PG8_STA(0, 0, a2, a2g, o2);
            PG8_WAIT_V(8); PG8_WAIT_L(0); PG8_BAR; PG8_MMA(1, 0, At, B0); PG8_MMA(1, 1, At, B1); PG8_BAR; PG8_SCHED;
            PG8_LDB(B0, 1, 0); PG8_LDB(B1, 1, 1); PG8_SCHED; PG8_LDA(At, 1, 0); PG8_STA(0, 1, a2, a2g, o2);
            PG8_WAIT_V(8); PG8_WAIT_L(0); PG8_BAR; PG8_MMA(0, 0, At, B0); PG8_MMA(0, 1, At, B1); PG8_BAR; PG8_SCHED;
            PG8_LDA(At, 1, 1); PG8_STAGE(PG8_SB(1, 0), b3, voffB); PG8_STAGE(PG8_SB(1, 1), b3 + hstep, voffB); PG8_STA(1, 0, a3, a3g, o2);
            PG8_WAIT_V(8); PG8_WAIT_L(0); PG8_BAR; PG8_MMA(1, 0, At, B0); PG8_MMA(1, 1, At, B1); PG8_BAR; PG8_SCHED;
            } else {
            PG8_LDB(B0, 0, 0); PG8_SCHED; PG8_LDA(At, 0, 0); PG8_STAGE(PG8_SA(1, 1), a1 + hstep, voffA);
            PG8_WAIT_L(8); PG8_BAR; PG8_WAIT_L(0); PG8_MMA(0, 0, At, B0); PG8_BAR; PG8_SCHED;
            PG8_LDB(B1, 0, 1); PG8_STAGE(PG8_SB(0, 0), b2, voffB);
            PG8_BAR; PG8_WAIT_L(0); PG8_MMA(0, 1, At, B1); PG8_BAR;
            PG8_LDA(At, 0, 1); PG8_STAGE(PG8_SA(0, 0), a2, voffA);
            PG8_BAR; PG8_WAIT_L(0); PG8_MMA(1, 0, At, B0); PG8_BAR; PG8_SCHED;
            PG8_STAGE(PG8_SB(0, 1), b2 + hstep, voffB);
            PG8_WAIT_V(6); PG8_BAR; PG8_MMA(1, 1, At, B1); PG8_BAR;
            PG8_LDB(B0, 1, 0); PG8_SCHED; PG8_LDA(At, 1, 0); PG8_STAGE(PG8_SA(0, 1), a2 + hstep, voffA);
            PG8_WAIT_L(8); PG8_BAR; PG8_WAIT_L(0); PG8_MMA(0, 0, At, B0); PG8_BAR; PG8_SCHED;
            PG8_LDB(B1, 1, 1); PG8_STAGE(PG8_SB(1, 0), b3, voffB);
            PG8_BAR; PG8_WAIT_L(0); PG8_MMA(0, 1, At, B1); PG8_BAR;
            PG8_LDA(At, 1, 1); PG8_STAGE(PG8_SA(1, 0), a3, voffA);
            PG8_BAR; PG8_WAIT_L(0); PG8_MMA(1, 0, At, B0); PG8_BAR; PG8_SCHED;
            PG8_STAGE(PG8_SB(1, 1), b3 + hstep, voffB);
            PG8_WAIT_V(6); PG8_BAR; PG8_MMA(1, 1, At, B1); PG8_BAR;
            }
        }
        if constexpr (ALIGN_EPI) { if (wr == 0) PG8_BAR; }
        if constexpr (!Epi::AFTER_DRAIN) { E(acc, cur, wr, wc, fr, fq); S.done(cur); }
        if (!has_next) break;
#pragma unroll
        for (int a = 0; a < 2; ++a)
#pragma unroll
            for (int b = 0; b < 2; ++b)
#pragma unroll
                for (int m = 0; m < 4; ++m)
#pragma unroll
                    for (int n = 0; n < 2; ++n) acc[a][b][m][n] = (f32x4){0.f, 0.f, 0.f, 0.f};
        cur = nxt; cA = nA; cB = nB; ++ui;
        if constexpr (GATHER) {
#pragma unroll
            for (int h = 0; h < 2; ++h)
#pragma unroll
                for (int i = 0; i < 2; ++i) oc[h][i] = rn[h][i] * (unsigned)(K * 2) + cbA[i]; }
        if constexpr (ALIGN_EPI) { if (wr == 1) PG8_BAR; }
    }
    PG8_WAIT_V(0);
    if constexpr (!ALIGN_EPI) { if (wr == 0) PG8_BAR; }
    PG8_BAR;
    if constexpr (Epi::AFTER_DRAIN) { E.fused(acc, cur, wr, wc, fr, fq, lds, wid, lane); S.done(cur); }
#undef PG8_SA
#undef PG8_SB
#undef PG8_STAGE
#undef PG8_STA
#undef PG8_LDA
#undef PG8_LDB
#undef PG8_MMA
#undef PG8_WAIT_V
#undef PG8_WAIT_L
#undef PG8_BAR
#undef PG8_SCHED
}
}
#define XB_TMO      128
#define XB_XCNT(j)  (256  + 64 * (j))
#define XB_XSUB(j)  (1280 + 64 * (j))
#define XB_XGEN(j)  (2304 + 64 * (j))
#define XB_TOP      3328
#define XB_TOPGEN   3392
#define XCD_BAR_WORDS 3456
#define XB_SPIN_CAP (1u << 22)

__device__ __forceinline__ unsigned xb_ld(unsigned* p)              { return __hip_atomic_load(p, __ATOMIC_RELAXED, __HIP_MEMORY_SCOPE_AGENT); }
__device__ __forceinline__ unsigned xb_add(unsigned* p, unsigned v) { return __hip_atomic_fetch_add(p, v, __ATOMIC_RELAXED, __HIP_MEMORY_SCOPE_AGENT); }
__device__ __forceinline__ unsigned xb_xcc_id() { return (unsigned)__builtin_amdgcn_s_getreg((3 << 11) | 20) & 0xFu; }
#define XB_SPIN(cond, bar) do { unsigned _sp = 0; while (cond) { __builtin_amdgcn_s_sleep(1); \
    if ((++_sp & 255u) == 0u) { if (xb_ld(&(bar)[XB_TMO])) break; if (_sp > XB_SPIN_CAP) { atomicAdd(&(bar)[XB_TMO], 1u); break; } } } } while (0)

struct XcdBarrier {
    unsigned* bar; unsigned x;
    volatile LAS unsigned* st;
};

__device__ __forceinline__ XcdBarrier xcd_barrier_post(unsigned* bar, volatile LAS unsigned* st) {
    XcdBarrier b; b.bar = bar; b.x = xb_xcc_id(); b.st = st;
    if (threadIdx.x == 0) (void)xb_add(&bar[XB_XCNT(b.x)], 1u);
    return b;
}
__device__ __forceinline__ void xcd_barrier_complete(unsigned* bar, unsigned x, unsigned& nloc, unsigned& nx) {
    const unsigned G = gridDim.x * gridDim.y * gridDim.z;
    unsigned sum, cnt, mine, sp = 0u;
    for (;;) {
        sum = 0u; cnt = 0u; mine = 0u;
#pragma unroll
        for (unsigned j = 0; j < 16; ++j) { const unsigned c = xb_ld(&bar[XB_XCNT(j)]); sum += c; cnt += (c > 0u) ? 1u : 0u; mine = (j == x) ? c : mine; }
        if (sum == G) break;
        __builtin_amdgcn_s_sleep(1);
        if ((++sp & 255u) == 0u) { if (xb_ld(&bar[XB_TMO])) break; if (sp > XB_SPIN_CAP) { atomicAdd(&bar[XB_TMO], 1u); break; } }
    }
    nloc = mine > 0u ? mine : 1u; nx = cnt > 0u ? cnt : 1u;
}

__device__ __forceinline__ void xcd_barrier(const XcdBarrier& b) {
    asm volatile("s_waitcnt vmcnt(0)" ::: "memory");
    __syncthreads();
    if (threadIdx.x == 0) {
        unsigned* bar = b.bar;
        __builtin_amdgcn_s_waitcnt(0);
        unsigned nloc = b.st[0], nx = b.st[1];
        if (nloc == 0u) { xcd_barrier_complete(bar, b.x, nloc, nx); b.st[0] = nloc; b.st[1] = nx; }
        const unsigned old = xb_add(&bar[XB_XSUB(b.x)], 1u);
        const unsigned gen = old / nloc;
        if (old + 1u == (gen + 1u) * nloc) {
            __builtin_amdgcn_fence(__ATOMIC_RELEASE, "agent");
            asm volatile("s_waitcnt vmcnt(0)" ::: "memory");
            const unsigned og = xb_add(&bar[XB_TOP], 1u);
            const unsigned tg = og / nx;
            if (og + 1u == (tg + 1u) * nx) xb_add(&bar[XB_TOPGEN], 1u);
            else XB_SPIN(xb_ld(&bar[XB_TOPGEN]) == tg, bar);
            __builtin_amdgcn_fence(__ATOMIC_ACQUIRE, "agent");
            xb_add(&bar[XB_XGEN(b.x)], 1u);
            asm volatile("s_waitcnt vmcnt(0)" ::: "memory");
        } else {
            XB_SPIN(xb_ld(&bar[XB_XGEN(b.x)]) == gen, bar);
            __builtin_amdgcn_fence(__ATOMIC_ACQUIRE, "agent");
            asm volatile("s_waitcnt vmcnt(0)" ::: "memory");
        }
    }
    __syncthreads();
}

enum { IN_X = 0, IN_C, IN_CTX, IN_CCTX, IN_ADAW, IN_ADAB, IN_N1G, IN_N2G, IN_FING, IN_S5LRE, IN_S5LIM, IN_S5LOG, IN_S5BRE, IN_S5BIM, IN_S5CRE, IN_S5CIM,
       IN_S5D, IN_S5WGLU, IN_S5BGLU, IN_AWKVQ, IN_AQG, IN_AKG, IN_AWO, IN_MLWIN, IN_MLBG, IN_MLNG, IN_MLWOUT, IN_RW, IN_RB, IN_MWG, IN_MWU, IN_MWD, N_INPUTS };

struct Frame {
    LAS unsigned char* lds;
    volatile LAS unsigned* MISC;
    unsigned* ctl;
    int tid, lane, wave, G, blk;
    const float* in[N_INPUTS];
    unsigned char* ws;
    float* out;
};

struct DenseSched {
    pg8::StaticOrder so; int pm0;
    __device__ __forceinline__ void init(int Mrows, int N, int G, int c, int pm0_) { so.init(Mrows, N, G, c); pm0 = pm0_; }
    __device__ __forceinline__ bool next(int i, pg8::Unit& u) const { if (!so.next(i, u)) return false; u.pm += pm0; return true; }
    __device__ __forceinline__ void a_ready(const pg8::Unit&) const {}
    __device__ __forceinline__ void done(const pg8::Unit&) const {}
};
struct MoeSched {
    const LAS int* tab; int G, c, npn;
    __device__ __forceinline__ bool next(int i, pg8::Unit& u) const {
        const int total = tab[16] * npn;
        int L;
        if ((G & 7) == 0) { const int x = c & 7, rank = c >> 3, per = G >> 3; const int q = total >> 3, rem = total & 7; const int start = x * q + (x < rem ? x : rem), cnt = q + (x < rem ? 1 : 0);
            const int off = rank + per * i; if (off >= cnt) return false; L = start + off; }
        else { L = i * G + c; if (L >= total) return false; }
        int e = 0;
#pragma unroll
        for (int k = 1; k < 16; ++k) e += (L >= tab[k] * npn) ? 1 : 0;
        const int ts = tab[e], te = tab[e + 1] - ts, idx = L - ts * npn;
        u.pm = __builtin_amdgcn_readfirstlane(ts + idx % te); u.pn = __builtin_amdgcn_readfirstlane(e * npn + idx / te); return true;
    }
    __device__ __forceinline__ void a_ready(const pg8::Unit&) const {}
    __device__ __forceinline__ void done(const pg8::Unit&) const {}
};

template <class Epi, class Sched>
__device__ __forceinline__ void gemm_phase_naive(const pg8::Gemm g, const Sched& S, const Epi& E) {
    const int tid = threadIdx.x, wid = tid >> 6, lane = tid & 63, wr = wid >> 2, wc = wid & 3, fr = lane & 15, fq = lane >> 4;
    const int K = g.K; pg8::Unit u;
    for (int i = 0; S.next(i, u); ++i) {
        f32x4 acc[2][2][4][2];
#pragma unroll
        for (int ai = 0; ai < 2; ++ai)
#pragma unroll
            for (int m = 0; m < 4; ++m) {
                const int row = u.pm * 256 + ai * 128 + wr * 64 + m * 16 + fr;
                const bf16* ap = g.A + (size_t)row * K;
                float s[2][2][4];
#pragma unroll
                for (int bj = 0; bj < 2; ++bj)
#pragma unroll
                    for (int n = 0; n < 2; ++n)
#pragma unroll
                        for (int e = 0; e < 4; ++e) s[bj][n][e] = 0.f;
                for (int k = 0; k < K; k += 8) {
                    const v4u av = *(const v4u*)(ap + k);
                    const float a0 = bflo(av.x), a1 = bfhi(av.x), a2 = bflo(av.y), a3 = bfhi(av.y), a4 = bflo(av.z), a5 = bfhi(av.z), a6 = bflo(av.w), a7 = bfhi(av.w);
#pragma unroll
                    for (int bj = 0; bj < 2; ++bj)
#pragma unroll
                        for (int n = 0; n < 2; ++n)
#pragma unroll
                            for (int e = 0; e < 4; ++e) {
                                const int col = u.pn * 256 + bj * 128 + wc * 32 + n * 16 + fq * 4 + e;
                                const v4u bv = *(const v4u*)(g.Bt + (size_t)col * K + k);
                                float t = s[bj][n][e];
                                t += a0 * bflo(bv.x); t += a1 * bfhi(bv.x); t += a2 * bflo(bv.y); t += a3 * bfhi(bv.y);
                                t += a4 * bflo(bv.z); t += a5 * bfhi(bv.z); t += a6 * bflo(bv.w); t += a7 * bfhi(bv.w);
                                s[bj][n][e] = t;
                            }
                }
#pragma unroll
                for (int bj = 0; bj < 2; ++bj)
#pragma unroll
                    for (int n = 0; n < 2; ++n) acc[ai][bj][m][n] = (f32x4){s[bj][n][0], s[bj][n][1], s[bj][n][2], s[bj][n][3]};
            }
        E(acc, u, wr, wc, fr, fq);
    }
}
#ifndef USE_NAIVE_GEMM
#define USE_NAIVE_GEMM 0
#endif
template <class Epi, class Sched>
__device__ __forceinline__ void run_gemm(Frame& F, const pg8::Gemm g, const Sched& S, const Epi& E) {
#if USE_NAIVE_GEMM
    gemm_phase_naive<Epi, Sched>(g, S, E);
#else
    pg8::gemm_phase<Epi, Sched, true, true>(F.lds + RING_OFF, g, S, E);
#endif
}
template <class Epi, class Sched>
__device__ __forceinline__ void run_gemm_gather(Frame& F, const pg8::Gemm g, const Sched& S, const Epi& E) {
    pg8::gemm_phase<Epi, Sched, true, true, true>(F.lds + RING_OFF, g, S, E);
}

__device__ __forceinline__ void st_bf4(bf16* p, f32x4 v) { v2u w; w.x = pk2(v.x, v.y); w.y = pk2(v.z, v.w); *(v2u*)p = w; }

struct EpiRes {
    static constexpr bool PERM = true, AFTER_DRAIN = false;
    bf16* xres; const float* __restrict__ modg; int skip; bf16* dummy;
    __device__ __forceinline__ void operator()(const f32x4 (&acc)[2][2][4][2], const pg8::Unit& u, int wr, int wc, int fr, int fq) const {
        const int cbase = u.pn * 256 + wc * 32 + fq * 8;
#pragma unroll
        for (int am = 0; am < 4; ++am) { const int ai = am >> 1, m0 = (am & 1) * 2;
            v4u x[4][2]; f32x4 g0[4][2], g1[4][2];
#pragma unroll
            for (int m = m0; m < m0 + 2; ++m) { const int r = u.pm * 256 + ai * 128 + wr * 64 + m * 16 + fr; const float* gp = modg + mrow_of(r) * 6144; const bf16* xp = xres + (size_t)r * D;
#pragma unroll
                for (int bj = 0; bj < 2; ++bj) { const int c = cbase + bj * 128; g0[m][bj] = *(const f32x4*)(gp + c); g1[m][bj] = *(const f32x4*)(gp + c + 4); x[m][bj] = *(const v4u*)(xp + c); } }
            asm volatile("" ::: "memory");
#pragma unroll
            for (int m = m0; m < m0 + 2; ++m) { const int r = u.pm * 256 + ai * 128 + wr * 64 + m * 16 + fr; bf16* xp = (skip ? dummy : xres) + (size_t)r * D;
#pragma unroll
                for (int bj = 0; bj < 2; ++bj) { const int c = cbase + bj * 128; const v4u xv = x[m][bj]; const f32x4 a = g0[m][bj] * acc[ai][bj][m][0], b = g1[m][bj] * acc[ai][bj][m][1];
                    v4u o; o.x = pk2(bflo(xv.x) + a.x, bfhi(xv.x) + a.y); o.y = pk2(bflo(xv.y) + a.z, bfhi(xv.y) + a.w); o.z = pk2(bflo(xv.z) + b.x, bfhi(xv.z) + b.y); o.w = pk2(bflo(xv.w) + b.z, bfhi(xv.w) + b.w);
                    *(v4u*)(xp + c) = o; } }
        }
    }
};
struct EpiGlu {
    static constexpr bool PERM = true, AFTER_DRAIN = false;
    bf16* xres; const float* __restrict__ modg; const float* __restrict__ bglu; int skip;
    __device__ __forceinline__ void operator()(const f32x4 (&acc)[2][2][4][2], const pg8::Unit& u, int wr, int wc, int fr, int fq) const {
        const int oc = u.pn * 128 + wc * 32 + fq * 8;
        const f32x4 ba0 = *(const f32x4*)(bglu + oc), ba1 = *(const f32x4*)(bglu + oc + 4), bg0 = *(const f32x4*)(bglu + 1024 + oc), bg1 = *(const f32x4*)(bglu + 1024 + oc + 4);
#pragma unroll
        for (int ai = 0; ai < 2; ++ai) {
            v4u x[4]; f32x4 g0[4], g1[4];
#pragma unroll
            for (int m = 0; m < 4; ++m) { const int r = u.pm * 256 + ai * 128 + wr * 64 + m * 16 + fr; const float* gp = modg + mrow_of(r) * 6144;
                g0[m] = *(const f32x4*)(gp + oc); g1[m] = *(const f32x4*)(gp + oc + 4); x[m] = *(const v4u*)(xres + (size_t)r * D + oc); }
            asm volatile("" ::: "memory");
#pragma unroll
            for (int m = 0; m < 4; ++m) { const int r = u.pm * 256 + ai * 128 + wr * 64 + m * 16 + fr;
                const f32x4 a0 = acc[ai][0][m][0] + ba0, a1 = acc[ai][0][m][1] + ba1, q0 = acc[ai][1][m][0] + bg0, q1 = acc[ai][1][m][1] + bg1;
                f32x4 v0, v1; v0.x = a0.x * sigmoidf_(q0.x); v0.y = a0.y * sigmoidf_(q0.y); v0.z = a0.z * sigmoidf_(q0.z); v0.w = a0.w * sigmoidf_(q0.w);
                v1.x = a1.x * sigmoidf_(q1.x); v1.y = a1.y * sigmoidf_(q1.y); v1.z = a1.z * sigmoidf_(q1.z); v1.w = a1.w * sigmoidf_(q1.w);
                v0 = v0 * g0[m]; v1 = v1 * g1[m]; const v4u xv = x[m];
                v4u o; o.x = pk2(bflo(xv.x) + v0.x, bfhi(xv.x) + v0.y); o.y = pk2(bflo(xv.y) + v0.z, bfhi(xv.y) + v0.w); o.z = pk2(bflo(xv.z) + v1.x, bfhi(xv.z) + v1.y); o.w = pk2(bflo(xv.w) + v1.z, bfhi(xv.w) + v1.w);
                if (!skip) *(v4u*)(xres + (size_t)r * D + oc) = o; }
        }
    }
};
__device__ __forceinline__ int kvrow_of(int r) { if (r < TC) return (r >> 8) * KVLEN + SEQ + (r & 255); const int rr = r - TC; return (rr >> 11) * KVLEN + (rr & 2047); }
struct EpiKvq {
    static constexpr bool PERM = false, AFTER_DRAIN = false;
    bf16* qb; bf16* kb; bf16* vb; const float* __restrict__ qg; const float* __restrict__ kg; const float* __restrict__ rope;
    __device__ __forceinline__ void operator()(const f32x4 (&acc)[2][2][4][2], const pg8::Unit& u, int wr, int wc, int fr, int fq) const {
        const int pn = u.pn;
        const float* gptr = (pn == 0) ? kg : qg;
        f32x4 gn[2][2];
#pragma unroll
        for (int bj = 0; bj < 2; ++bj)
#pragma unroll
            for (int n = 0; n < 2; ++n) gn[bj][n] = *(const f32x4*)(gptr + 32 * bj + 16 * n + 4 * fq);
#pragma unroll
        for (int ai = 0; ai < 2; ++ai)
#pragma unroll
            for (int m = 0; m < 4; ++m) {
                const int r = u.pm * 256 + ai * 128 + wr * 64 + m * 16 + fr;
                f32x4 x[2][2];
#pragma unroll
                for (int bj = 0; bj < 2; ++bj)
#pragma unroll
                    for (int n = 0; n < 2; ++n) x[bj][n] = acc[ai][bj][m][n];
                if (pn != 1) {
                    float ss = 0.f;
#pragma unroll
                    for (int bj = 0; bj < 2; ++bj)
#pragma unroll
                        for (int n = 0; n < 2; ++n) { const f32x4 v = x[bj][n]; ss += v.x * v.x + v.y * v.y + v.z * v.z + v.w * v.w; }
                    ss = xor16_sum(ss); ss = xor32_sum(ss);
                    const float rs = rsqrtf(ss * (1.f / 64.f) + EPS);
#pragma unroll
                    for (int bj = 0; bj < 2; ++bj)
#pragma unroll
                        for (int n = 0; n < 2; ++n) x[bj][n] = x[bj][n] * rs * gn[bj][n];
                    if (r >= TC) {
                        const int t = (r - TC) & 2047;
#pragma unroll
                        for (int bj = 0; bj < 2; ++bj) {
                            const int pos = bj == 0 ? (t >> 6) : (t & 63);
                            const f32x4 cs = *(const f32x4*)(rope + pos * 16 + 4 * fq), sn = *(const f32x4*)(rope + 1024 + pos * 16 + 4 * fq);
                            const f32x4 x1 = x[bj][0], x2 = x[bj][1];
                            x[bj][0] = x1 * cs - x2 * sn; x[bj][1] = x2 * cs + x1 * sn;
                        }
                    }
                }
                bf16* dst;
                if (pn == 0) dst = kb + (size_t)kvrow_of(r) * 256 + wc * 64;
                else if (pn == 1) dst = vb + (size_t)kvrow_of(r) * 256 + wc * 64;
                else { dst = qb + (size_t)r * D + ((pn - 2) * 4 + wc) * 64;
#pragma unroll
                    for (int bj = 0; bj < 2; ++bj)
#pragma unroll
                        for (int n = 0; n < 2; ++n) x[bj][n] = x[bj][n] * ATT_C2; }
#pragma unroll
                for (int bj = 0; bj < 2; ++bj)
#pragma unroll
                    for (int n = 0; n < 2; ++n) st_bf4(dst + 32 * bj + 16 * n + 4 * fq, x[bj][n]);
            }
    }
};
struct EpiMlIn {
    static constexpr bool PERM = true, AFTER_DRAIN = false;
    bf16 *k, *v, *q, *o; float* g; const float* bgate;
    __device__ __forceinline__ void operator()(const f32x4 (&acc)[2][2][4][2], const pg8::Unit& u, int wr, int wc, int fr, int fq) const {
        const int pn = u.pn;
#pragma unroll
        for (int ai = 0; ai < 2; ++ai)
#pragma unroll
            for (int m = 0; m < 4; ++m) {
                const int r = u.pm * 256 + ai * 128 + wr * 64 + m * 16 + fr;
#pragma unroll
                for (int bj = 0; bj < 2; ++bj) {
                    const int cc = bj * 128 + wc * 32 + fq * 8;
                    f32x4 a = acc[ai][bj][m][0], b = acc[ai][bj][m][1];
                    if (pn == 12) { if (cc < 32) { *(f32x4*)(g + (size_t)r * 32 + cc) = a + *(const f32x4*)(bgate + cc); *(f32x4*)(g + (size_t)r * 32 + cc + 4) = b + *(const f32x4*)(bgate + cc + 4); } continue; }
                    if (pn < 2) { a = a * 0.125f; b = b * 0.125f; }
                    v4u ov; ov.x = pk2(a.x, a.y); ov.y = pk2(a.z, a.w); ov.z = pk2(b.x, b.y); ov.w = pk2(b.z, b.w);
                    bf16* dst = (pn < 2) ? k + (size_t)r * 512 + pn * 256 + cc : (pn < 6) ? v + (size_t)r * 1024 + (pn - 2) * 256 + cc : (pn < 8) ? q + (size_t)r * 512 + (pn - 6) * 256 + cc : o + (size_t)r * 1024 + (pn - 8) * 256 + cc;
                    *(v4u*)dst = ov;
                }
            }
    }
};
struct EpiG1 {
    static constexpr bool PERM = false, AFTER_DRAIN = false;
    bf16* hid;
    __device__ __forceinline__ void operator()(const f32x4 (&acc)[2][2][4][2], const pg8::Unit& u, int wr, int wc, int fr, int fq) const {
        const int pnl = u.pn & 3;
#pragma unroll
        for (int ai = 0; ai < 2; ++ai)
#pragma unroll
            for (int m = 0; m < 4; ++m) {
                const int r = u.pm * 256 + ai * 128 + wr * 64 + m * 16 + fr;
#pragma unroll
                for (int bj = 0; bj < 2; ++bj) {
                    const int hc = pnl * 128 + bj * 64 + wc * 16 + fq * 4;
                    const f32x4 ga = acc[ai][bj][m][0], up = acc[ai][bj][m][1];
                    f32x4 h; h.x = siluf_(ga.x) * up.x; h.y = siluf_(ga.y) * up.y; h.z = siluf_(ga.z) * up.z; h.w = siluf_(ga.w) * up.w;
                    st_bf4(hid + (size_t)r * DFF + hc, h);
                }
            }
    }
};
struct EpiG2 {
    static constexpr bool PERM = true, AFTER_DRAIN = false;
    bf16* y2; const float* __restrict__ slotw;
    __device__ __forceinline__ void operator()(const f32x4 (&acc)[2][2][4][2], const pg8::Unit& u, int wr, int wc, int fr, int fq) const {
        const int pnl = u.pn & 3;
#pragma unroll
        for (int ai = 0; ai < 2; ++ai)
#pragma unroll
            for (int m = 0; m < 4; ++m) {
                const int r = u.pm * 256 + ai * 128 + wr * 64 + m * 16 + fr;
                const float w = slotw[r];
#pragma unroll
                for (int bj = 0; bj < 2; ++bj) {
                    const int c = pnl * 256 + bj * 128 + wc * 32 + fq * 8;
                    const f32x4 a = acc[ai][bj][m][0] * w, b = acc[ai][bj][m][1] * w;
                    v4u o; o.x = pk2(a.x, a.y); o.y = pk2(a.z, a.w); o.z = pk2(b.x, b.y); o.w = pk2(b.z, b.w);
                    *(v4u*)(y2 + (size_t)r * D + c) = o;
                }
            }
    }
};

struct CmNat { const float* W; int ld; __device__ __forceinline__ const float* col(int j) const { return W + j; } };
struct CmGlu { const float* W; int ld;
    __device__ __forceinline__ const float* col(int j) const { const int pn = j >> 8, gpart = (j >> 7) & 1, c = j & 127; return W + gpart * 1024 + 128 * pn + c; } };
struct CmKvq { const float* W; int ld;
    __device__ __forceinline__ const float* col(int j) const { const int pn = j >> 8, bj = (j >> 7) & 1, wc = (j >> 5) & 3, n = (j >> 4) & 1, q = j & 15; return W + 256 * pn + 64 * wc + 32 * bj + 16 * n + q; } };
struct CmMlIn { const float* W; int ld;
    __device__ __forceinline__ const float* col(int j) const {
        if (j < 1536) return W + j;
        if (j < 2048) return W + 1568 + (j - 1536);
        if (j < 3072) return W + 2080 + (j - 2048);
        if (j < 3104) return W + 1536 + (j - 3072);
        return nullptr; } };
struct CmG1 { const float* Wg; const float* Wu; int ld;
    __device__ __forceinline__ const float* col(int j) const { const int le = j >> 10, jj = j & 1023; const int pn = jj >> 8, bj = (jj >> 7) & 1, wc = (jj >> 5) & 3, n = (jj >> 4) & 1, q = jj & 15;
        const uintptr_t a = (uintptr_t)Wg, b = (uintptr_t)Wu, msk = (uintptr_t)0 - (uintptr_t)n;
        return (const float*)((a & ~msk) | (b & msk)) + (size_t)le * 1024 * 512 + 128 * pn + 64 * bj + 16 * wc + q; } };
struct CmG2 { const float* Wd; int ld;
    __device__ __forceinline__ const float* col(int j) const { const int le = j >> 10, jj = j & 1023; return Wd + (size_t)le * 512 * 1024 + jj; } };

template <class CM>
__device__ __forceinline__ void transpose_item(const CM& cm, int K, bf16* WT, int kb, int nb, LAS float* scr, int lane) {
    const int k0 = 64 * kb, n0 = 32 * nb;
    const int nq = (lane & 7) * 4;
    const float* cp = cm.col(n0 + nq);
    const size_t ld = (size_t)cm.ld;
    f32x4 v[8];
#pragma unroll
    for (int i = 0; i < 8; ++i) { const int kk = 8 * i + (lane >> 3); v[i] = cp ? *(const f32x4*)(cp + (size_t)(k0 + kk) * ld) : (f32x4){0.f, 0.f, 0.f, 0.f}; }
#pragma unroll
    for (int i = 0; i < 8; ++i) { const int kk = 8 * i + (lane >> 3); LAS float* d = scr + kk * 33 + nq; d[0] = v[i].x; d[1] = v[i].y; d[2] = v[i].z; d[3] = v[i].w; }
    LDS_WAIT(); asm volatile("" ::: "memory");
    const int c = lane & 7;
#pragma unroll
    for (int j = 0; j < 4; ++j) { const int n = (lane >> 3) + 8 * j; const LAS float* s = scr + (8 * c) * 33 + n;
        v4u o; o.x = pk2(s[0 * 33], s[1 * 33]); o.y = pk2(s[2 * 33], s[3 * 33]); o.z = pk2(s[4 * 33], s[5 * 33]); o.w = pk2(s[6 * 33], s[7 * 33]);
        *(v4u*)(WT + (size_t)(n0 + n) * K + k0 + 8 * c) = o; }
    LDS_WAIT(); asm volatile("" ::: "memory");
}
template <class CM>
__device__ __forceinline__ void transpose_all(Frame& F, const CM& cm, int K, int Ndest, bf16* WT, int rot) {
    LAS float* scr = (LAS float*)(F.lds + RING_OFF + F.wave * 16384);
    const int NGW = F.G * NWAVES, gw = (F.blk * NWAVES + F.wave + rot) % NGW;
    const int nblk = Ndest / 32, items = (K / 64) * nblk;
    for (int it = gw; it < items; it += NGW) transpose_item(cm, K, WT, it / nblk, it % nblk, scr, F.lane);
}

__device__ __forceinline__ void phase_prologue(Frame& F) {
    {
        LAS float* cond = (LAS float*)(F.lds);
        LAS float* red = (LAS float*)(F.lds + 40960);
        for (int i = F.tid; i < 9 * 1024; i += NTHR) { const int mb = i >> 10, k = i & 1023; const float v = (mb < 8) ? F.in[IN_C][mb * 1024 + k] : F.in[IN_CCTX][k]; cond[i] = siluf_(v); }
        __syncthreads();
        float* mod = (float*)(F.ws + WS_MOD);
        for (int it = F.blk; it < DEPTH * 48; it += F.G) {
            const int l = it / 48, n0 = (it % 48) * 128;
            const float* w = F.in[IN_ADAW] + (size_t)l * 1024 * 6144 + n0 + 2 * F.lane;
            f32x2 a[9];
#pragma unroll
            for (int mb = 0; mb < 9; ++mb) a[mb] = (f32x2){0.f, 0.f};
            const int kb = F.wave * 128;
            for (int k8 = 0; k8 < 128; k8 += 8) {
                f32x2 wv[8];
#pragma unroll
                for (int u = 0; u < 8; ++u) wv[u] = *(const f32x2*)(w + (size_t)(kb + k8 + u) * 6144);
#pragma unroll
                for (int u = 0; u < 8; ++u)
#pragma unroll
                    for (int mb = 0; mb < 9; ++mb) a[mb] += wv[u] * cond[mb * 1024 + kb + k8 + u];
            }
#pragma unroll
            for (int mb = 0; mb < 9; ++mb) *(LAS f32x2*)(red + (F.wave * 9 + mb) * 128 + 2 * F.lane) = a[mb];
            __syncthreads();
            for (int i = F.tid; i < 9 * 128; i += NTHR) { const int mb = i >> 7, ln = i & 127; float s = F.in[IN_ADAB][l * 6144 + n0 + ln];
#pragma unroll
                for (int wv = 0; wv < 8; ++wv) s += red[(wv * 9 + mb) * 128 + ln];
                mod[(size_t)(l * 9 + mb) * 6144 + n0 + ln] = s; }
            __syncthreads();
        }
    }
    { const int idx = F.blk * NTHR + F.tid;
      if (idx < 1024) { const int pos = idx >> 4, f = idx & 15; const float inv = exp2f(-(float)f * (13.287712379549449f / 16.f)); const float ang = (float)pos * inv;
          double s, c; sincos_d((double)ang, s, c); float* rope = (float*)(F.ws + WS_ROPE); rope[idx] = (float)c; rope[1024 + idx] = (float)s; } }
    __syncthreads();
    { CmGlu cm{F.in[IN_S5WGLU], 2048}; transpose_all(F, cm, 1024, 2048, (bf16*)(F.ws + WS_WGLU), 0); }
    { CmGlu cm{F.in[IN_S5WGLU] + (size_t)1024 * 2048, 2048}; transpose_all(F, cm, 1024, 2048, (bf16*)(F.ws + WS_WGLU) + (size_t)2048 * 1024, 1024); }
    { CmKvq cm{F.in[IN_AWKVQ], 1536}; transpose_all(F, cm, 1024, 1536, (bf16*)(F.ws + WS_WKVQ), 0); }
    { CmNat cm{F.in[IN_AWO], 1024}; transpose_all(F, cm, 1024, 1024, (bf16*)(F.ws + WS_WO), 768); }
    { CmMlIn cm{F.in[IN_MLWIN], 3104}; transpose_all(F, cm, 1024, ML_NIN, (bf16*)(F.ws + WS_WIN), 1280); }
    { CmNat cm{F.in[IN_MLWOUT], 1024}; transpose_all(F, cm, 1024, 1024, (bf16*)(F.ws + WS_WOUT), 896); }
    { CmG1 cm{F.in[IN_MWG], F.in[IN_MWU], 512}; transpose_all(F, cm, 1024, DEPTH * NEXP * 1024, (bf16*)(F.ws + WS_WG1), 1408); }
    { CmG2 cm{F.in[IN_MWD], 1024}; transpose_all(F, cm, 512, DEPTH * NEXP * 1024, (bf16*)(F.ws + WS_WG2), 1408); }
}

struct RowMod { f32x4 a[4], b[4], c[4]; int mr; };
__device__ __forceinline__ void rowmod_load(RowMod& M, const float* base, int mr, int oa, int ob, int oc, int lane) {
    if (mr == M.mr) return; M.mr = mr; const float* p = base + (size_t)mr * 6144;
#pragma unroll
    for (int j = 0; j < 4; ++j) { M.a[j] = *(const f32x4*)(p + oa + 4 * lane + 256 * j); M.b[j] = *(const f32x4*)(p + ob + 4 * lane + 256 * j); if (oc >= 0) M.c[j] = *(const f32x4*)(p + oc + 4 * lane + 256 * j); }
}
struct RawRow { f32x4 x[4]; v2u ya[4], yb[4]; };
template <bool COMB, bool XBF>
__device__ __forceinline__ void raw_load(RawRow& R, const void* xrow, const bf16* y2, int s0, int s1, int lane) {
#pragma unroll
    for (int j = 0; j < 4; ++j) {
        if (XBF) { const v2u w = *(const v2u*)((const bf16*)xrow + 4 * lane + 256 * j); R.x[j] = (f32x4){bflo(w.x), bfhi(w.x), bflo(w.y), bfhi(w.y)}; }
        else R.x[j] = *(const f32x4*)((const float*)xrow + 4 * lane + 256 * j);
        if (COMB) { R.ya[j] = *(const v2u*)(y2 + (size_t)s0 * D + 4 * lane + 256 * j); R.yb[j] = *(const v2u*)(y2 + (size_t)s1 * D + 4 * lane + 256 * j); } }
}
template <int L>
__device__ __forceinline__ void phase_a1(Frame& F, const int skip = 0) {
    const float* mod = (const float*)(F.ws + WS_MOD);
    bf16* xres = (bf16*)(F.ws + WS_XRES); bf16* hb = (bf16*)(F.ws + WS_H);
    const bf16* y2 = (const bf16*)(F.ws + WS_Y2); const int* toks = (const int*)(F.ws + WS_TOKS);
    const int gw = F.blk * NWAVES + F.wave, NGW = F.G * NWAVES, lane = F.lane;
    const int RPW = (T + NGW - 1) / NGW, r0 = gw * RPW, r1 = (r0 + RPW < T) ? r0 + RPW : T;
    if (r0 >= T) return;
    f32x4 gv[4];
#pragma unroll
    for (int j = 0; j < 4; ++j) gv[j] = *(const f32x4*)(F.in[IN_N1G] + L * D + 4 * lane + 256 * j);
    auto rowptr = [&](int r) -> const void* { if (L == 0) return (r < TC) ? (const void*)(F.in[IN_CTX] + (size_t)r * D) : (const void*)(F.in[IN_X] + (size_t)(r - TC) * D); return (const void*)(xres + (size_t)r * D); };
    RowMod M1, M2; M1.mr = -1; M2.mr = -1;
    int ns0 = 0, ns1 = 0;
    if (L > 0) { ns0 = toks[2 * r0]; ns1 = toks[2 * r0 + 1]; }
    RawRow nx; raw_load<(L > 0), (L > 0)>(nx, rowptr(r0), y2, ns0, ns1, lane);
    if (L > 0 && r0 + 1 < r1) { ns0 = toks[2 * r0 + 2]; ns1 = toks[2 * r0 + 3]; }
    for (int r = r0; r < r1; ++r) {
        const int mr = mrow_of(r);
        RawRow cur = nx;
        if (r + 1 < r1) { raw_load<(L > 0), (L > 0)>(nx, rowptr(r + 1), y2, ns0, ns1, lane); if (L > 0 && r + 2 < r1) { ns0 = toks[2 * r + 4]; ns1 = toks[2 * r + 5]; } }
        rowmod_load(M1, mod + (size_t)L * 9 * 6144, mr, 0, 1024, -1, lane);
        if (L > 0) rowmod_load(M2, mod + (size_t)(L - 1) * 9 * 6144, mr, 5120, 5120, -1, lane);
        float ss = 0.f;
#pragma unroll
        for (int j = 0; j < 4; ++j) {
            f32x4 v = cur.x[j];
            if (L > 0) { const v2u a = cur.ya[j], b = cur.yb[j]; const f32x4 gg = M2.a[j];
                v.x += gg.x * (bflo(a.x) + bflo(b.x)); v.y += gg.y * (bfhi(a.x) + bfhi(b.x)); v.z += gg.z * (bflo(a.y) + bflo(b.y)); v.w += gg.w * (bfhi(a.y) + bfhi(b.y)); }
            cur.x[j] = v;
            if (!skip) st_bf4(xres + (size_t)r * D + 4 * lane + 256 * j, v); ss += v.x * v.x + v.y * v.y + v.z * v.z + v.w * v.w;
        }
        const float rs = rsqrtf(wave_sum(ss) * (1.f / D) + EPS);
#pragma unroll
        for (int j = 0; j < 4; ++j) { const f32x4 h = cur.x[j] * rs * gv[j] * (M1.b[j] + 1.f) + M1.a[j]; st_bf4(hb + (size_t)r * D + 4 * lane + 256 * j, h); }
    }
}
__device__ __forceinline__ float quad_get(float v, int k) {
    return k == 1 ? dpp_f<0x39>(v, v) : k == 2 ? dpp_f<0x4E>(v, v) : dpp_f<0x93>(v, v); }
template <int L>
__device__ __forceinline__ void phase_n2(Frame& F, const int var = 0) {
    constexpr int R0 = (L == DEPTH - 1) ? TC : 0;
    const float* mod = (const float*)(F.ws + WS_MOD);
    const bf16* xres = (const bf16*)(F.ws + WS_XRES); bf16* hb = (bf16*)(F.ws + WS_H);
    int* toke = (int*)(F.ws + WS_TOKE); int* tokr = (int*)(F.ws + WS_TOKR); float* tokw = (float*)(F.ws + WS_TOKW); int* bcnt = (int*)(F.ws + WS_BCNT);
    LAS v4u* rwf = (LAS v4u*)(F.lds);
    LAS float* PS = (LAS float*)(F.lds + 65536);
    LAS float* PL = (LAS float*)(F.lds + 65536 + 1024);
    LAS int* cntL = (LAS int*)(F.lds + SCT_OFF);
    for (int i = F.tid; i < 32 * 64; i += NTHR) { const int ks = i >> 6, ln = i & 63, e = ln & 15, k0 = 32 * ks + 8 * (ln >> 4);
        float w[8]; unsigned hi[4], lo[4];
#pragma unroll
        for (int jj = 0; jj < 8; ++jj) w[jj] = F.in[IN_RW][(k0 + jj) * 16 + e];
#pragma unroll
        for (int jj = 0; jj < 4; ++jj) { hi[jj] = pk2(w[2 * jj], w[2 * jj + 1]); lo[jj] = pk2(w[2 * jj] - bflo(hi[jj]), w[2 * jj + 1] - bfhi(hi[jj])); }
        rwf[2 * i] = (v4u){hi[0], hi[1], hi[2], hi[3]}; rwf[2 * i + 1] = (v4u){lo[0], lo[1], lo[2], lo[3]}; }
    if (F.tid < 16) cntL[F.tid] = 0;
    __syncthreads();
    const int lane = F.lane, rl = lane & 15, kg = lane >> 4, w = F.wave;
    const float rbias = F.in[IN_RB][rl];
    constexpr int NTILES = (T - R0) / 16;
    const int ntl = (NTILES - F.blk + F.G - 1) / F.G;
    const int c0 = 128 * w + 8 * kg;
    v4u xw4[4];
    if (ntl > 0) { const bf16* xr = xres + (size_t)(R0 + 16 * F.blk + rl) * D + c0;
#pragma unroll
        for (int q = 0; q < 4; ++q) xw4[q] = *(const v4u*)(xr + 32 * q); }
    for (int j = 0; j < ntl; ++j) {
        const int tile = F.blk + F.G * j, rbase = R0 + 16 * tile, mr = mrow_of(rbase), pb = j & 1;
        f32x4 ca[4], cb[4]; float ss = 0.f;
#pragma unroll
        for (int q = 0; q < 4; ++q) { const v4u t = xw4[q]; ca[q] = (f32x4){bflo(t.x), bfhi(t.x), bflo(t.y), bfhi(t.y)}; cb[q] = (f32x4){bflo(t.z), bfhi(t.z), bflo(t.w), bfhi(t.w)};
            ss += ca[q].x * ca[q].x + ca[q].y * ca[q].y + ca[q].z * ca[q].z + ca[q].w * ca[q].w + cb[q].x * cb[q].x + cb[q].y * cb[q].y + cb[q].z * cb[q].z + cb[q].w * cb[q].w; }
        ss = xor16_sum(ss); ss = xor32_sum(ss);
        if (kg == 0) PS[(pb * 8 + w) * 16 + rl] = ss;
        if (j + 1 < ntl) { const bf16* xr = xres + (size_t)(R0 + 16 * (tile + F.G) + rl) * D + c0;
#pragma unroll
            for (int q = 0; q < 4; ++q) xw4[q] = *(const v4u*)(xr + 32 * q); }
        __syncthreads();
        float tot = 0.f;
#pragma unroll
        for (int ww = 0; ww < 8; ++ww) tot += PS[(pb * 8 + ww) * 16 + rl];
        const float rs = rsqrtf(tot * (1.f / D) + EPS);
        const float* gp = F.in[IN_N2G] + L * D + c0; const float* shp = mod + (size_t)(L * 9 + mr) * 6144 + 3072 + c0; const float* scp = shp + 1024;
        bf16* hrow = hb + (size_t)(rbase + rl) * D + c0;
        f32x4 acc = (f32x4){0.f, 0.f, 0.f, 0.f};
#pragma unroll
        for (int q = 0; q < 4; ++q) {
            float h[8];
            { const f32x4 g0 = *(const f32x4*)(gp + 32 * q), g1 = *(const f32x4*)(gp + 32 * q + 4), cc0 = *(const f32x4*)(scp + 32 * q), cc1 = *(const f32x4*)(scp + 32 * q + 4), s0 = *(const f32x4*)(shp + 32 * q), s1 = *(const f32x4*)(shp + 32 * q + 4);
              const f32x4 h0 = ca[q] * rs * g0 * (cc0 + 1.f) + s0, h1 = cb[q] * rs * g1 * (cc1 + 1.f) + s1;
              h[0] = h0.x; h[1] = h0.y; h[2] = h0.z; h[3] = h0.w; h[4] = h1.x; h[5] = h1.y; h[6] = h1.z; h[7] = h1.w; }
            unsigned hi[4], lo[4];
#pragma unroll
            for (int jj = 0; jj < 4; ++jj) { hi[jj] = pk2(h[2 * jj], h[2 * jj + 1]); lo[jj] = pk2(h[2 * jj] - bflo(hi[jj]), h[2 * jj + 1] - bfhi(hi[jj])); }
            const v4u hv = (v4u){hi[0], hi[1], hi[2], hi[3]}, lv = (v4u){lo[0], lo[1], lo[2], lo[3]};
            *(v4u*)(hrow + 32 * q) = hv;
            const int ks = 4 * w + q;
            const v4u bh = rwf[2 * (ks * 64 + lane)], bl = rwf[2 * (ks * 64 + lane) + 1];
            acc = __builtin_amdgcn_mfma_f32_16x16x32_bf16(__builtin_bit_cast(bf16x8, hv), __builtin_bit_cast(bf16x8, bh), acc, 0, 0, 0);
            acc = __builtin_amdgcn_mfma_f32_16x16x32_bf16(__builtin_bit_cast(bf16x8, hv), __builtin_bit_cast(bf16x8, bl), acc, 0, 0, 0);
            acc = __builtin_amdgcn_mfma_f32_16x16x32_bf16(__builtin_bit_cast(bf16x8, lv), __builtin_bit_cast(bf16x8, bh), acc, 0, 0, 0);
        }
        *(LAS f32x4*)(PL + ((pb * 8 + w) * 64 + lane) * 4) = acc;
        __syncthreads();
        if (w != (j & 7) || (var & 1)) continue;
        f32x4 lg = (f32x4){0.f, 0.f, 0.f, 0.f};
#pragma unroll
        for (int ww = 0; ww < 8; ++ww) lg = lg + *(const LAS f32x4*)(PL + ((pb * 8 + ww) * 64 + lane) * 4);
#pragma unroll
        for (int r = 0; r < 4; ++r) {
            const float sco = sigmoidf_(lg[r]), sel = sco + rbias;
            int rank = 0;
#pragma unroll
            for (int k = 1; k < 4; ++k) { const float o = quad_get(sel, k); const int oi = (rl & ~3) | ((rl + k) & 3); rank += (o > sel || (o == sel && oi < rl)) ? 1 : 0; }
            const bool top2 = rank < 2;
            float gs = top2 ? sel : 0.f; gs += dpp_f<0xB1>(0.f, gs); gs += dpp_f<0x4E>(0.f, gs);
            bool best = true; const int q = rl >> 2;
            { const float o1 = dpp_f<0x124>(gs, gs), o2 = dpp_f<0x128>(gs, gs), o3 = dpp_f<0x12C>(gs, gs);
              const int q1 = (q + 3) & 3, q2 = (q + 2) & 3, q3 = (q + 1) & 3;
              best = !(o1 > gs || (o1 == gs && q1 < q)) && !(o2 > gs || (o2 == gs && q2 < q)) && !(o3 > gs || (o3 == gs && q3 < q)); }
            const bool selv = best && top2;
            const float wsum = red16_sum(selv ? sco : 0.f);
            if (selv) { const int row = rbase + 4 * kg + r;
                const int lr = __hip_atomic_fetch_add(cntL + rl, 1, __ATOMIC_RELAXED, __HIP_MEMORY_SCOPE_WORKGROUP);
                toke[2 * row + rank] = rl; tokr[2 * row + rank] = lr; tokw[2 * row + rank] = sco * __builtin_amdgcn_rcpf(wsum); }
        }
    }
    __syncthreads();
    if (F.tid < 16 && !(var & 1)) bcnt[F.blk * 16 + F.tid] = cntL[F.tid];
}
template <int L>
__device__ __forceinline__ void phase_sc(Frame& F) {
    constexpr int R0 = (L == DEPTH - 1) ? TC : 0;
    const int* bcnt = (const int*)(F.ws + WS_BCNT);
    LAS int* pt = (LAS int*)(F.lds);
    LAS int* tt = (LAS int*)(F.lds + 8192);
    { const int e = F.tid & 15, ch = F.tid >> 4; int tot = 0, mine = 0;
      for (int b = ch; b < F.G; b += 32) { const int c = bcnt[b * 16 + e]; tot += c; mine += (b < F.blk) ? c : 0; }
      pt[ch * 16 + e] = tot; pt[512 + ch * 16 + e] = mine; }
    __syncthreads();
    if (F.tid < 16) { int tot = 0, mine = 0; for (int ch = 0; ch < 32; ++ch) { tot += pt[ch * 16 + F.tid]; mine += pt[512 + ch * 16 + F.tid]; } tt[F.tid] = tot; tt[16 + F.tid] = mine; }
    __syncthreads();
    int* slotr = (int*)(F.ws + WS_SLOTR);
    if (F.tid == 0) { int ts = 0; int* etab = (int*)(F.ws + WS_ETAB);
        for (int e = 0; e < 16; ++e) { tt[32 + e] = ts * 256 + tt[16 + e]; tt[48 + e] = ts * 256 + tt[e]; if (F.blk == 0) etab[e] = ts; ts += (tt[e] + 255) >> 8; tt[64 + e] = ts * 256; }
        if (F.blk == 0) etab[16] = ts; }
    __syncthreads();
    if (F.blk < 16) { for (int s = tt[48 + F.blk] + F.tid; s < tt[64 + F.blk]; s += NTHR) slotr[s] = R0; }
    const int* toke = (const int*)(F.ws + WS_TOKE); const int* tokr = (const int*)(F.ws + WS_TOKR); const float* tokw = (const float*)(F.ws + WS_TOKW);
    int* toks = (int*)(F.ws + WS_TOKS); float* slotw = (float*)(F.ws + WS_SLOTW);
    const int lane = F.lane;
    constexpr int NTILES = (T - R0) / 16;
    for (int tile = F.blk + F.G * F.wave; tile < NTILES; tile += F.G * NWAVES) {
        const int rbase = R0 + 16 * tile;
        if (lane < 32) { const int idx = 2 * rbase + lane; const int e = toke[idx]; const int slot = tt[32 + e] + tokr[idx]; toks[idx] = slot; slotw[slot] = tokw[idx]; slotr[slot] = rbase + (lane >> 1); }
    }
}
__device__ __forceinline__ void load_etab(Frame& F) {
    LAS int* tab = (LAS int*)(F.lds + ETAB_OFF);
    if (F.tid < 17) tab[F.tid] = ((const int*)(F.ws + WS_ETAB))[F.tid];
    __syncthreads();
}
__device__ __forceinline__ void phase_fin(Frame& F) {
    const float* mod = (const float*)(F.ws + WS_MOD);
    const bf16* xres = (const bf16*)(F.ws + WS_XRES);
    const bf16* y2 = (const bf16*)(F.ws + WS_Y2); const int* toks = (const int*)(F.ws + WS_TOKS);
    const int gw = F.blk * NWAVES + F.wave, NGW = F.G * NWAVES, lane = F.lane;
    const int RPW = (TL + NGW - 1) / NGW, r0 = TC + gw * RPW, r1 = (r0 + RPW < T) ? r0 + RPW : T;
    if (r0 >= T) return;
    f32x4 gv[4];
#pragma unroll
    for (int j = 0; j < 4; ++j) gv[j] = *(const f32x4*)(F.in[IN_FING] + 4 * lane + 256 * j);
    RowMod M2; M2.mr = -1;
    int ns0 = toks[2 * r0], ns1 = toks[2 * r0 + 1];
    RawRow nx; raw_load<true, true>(nx, xres + (size_t)r0 * D, y2, ns0, ns1, lane);
    if (r0 + 1 < r1) { ns0 = toks[2 * r0 + 2]; ns1 = toks[2 * r0 + 3]; }
    for (int r = r0; r < r1; ++r) {
        const int mr = mrow_of(r);
        RawRow cur = nx;
        if (r + 1 < r1) { raw_load<true, true>(nx, xres + (size_t)(r + 1) * D, y2, ns0, ns1, lane); if (r + 2 < r1) { ns0 = toks[2 * r + 4]; ns1 = toks[2 * r + 5]; } }
        rowmod_load(M2, mod + (size_t)(DEPTH - 1) * 9 * 6144, mr, 5120, 5120, -1, lane);
        float ss = 0.f;
#pragma unroll
        for (int j = 0; j < 4; ++j) { f32x4 v = cur.x[j]; const v2u a = cur.ya[j], b = cur.yb[j]; const f32x4 gg = M2.a[j];
            v.x += gg.x * (bflo(a.x) + bflo(b.x)); v.y += gg.y * (bfhi(a.x) + bfhi(b.x)); v.z += gg.z * (bflo(a.y) + bflo(b.y)); v.w += gg.w * (bfhi(a.y) + bfhi(b.y));
            cur.x[j] = v; ss += v.x * v.x + v.y * v.y + v.z * v.z + v.w * v.w; }
        const float rs = rsqrtf(wave_sum(ss) * (1.f / D) + EPS);
#pragma unroll
        for (int j = 0; j < 4; ++j) *(f32x4*)(F.out + (size_t)(r - TC) * D + 4 * lane + 256 * j) = cur.x[j] * rs * gv[j];
    }
}

__device__ __forceinline__ int seq_row(int b, int dir, int s) {
    if (s < CTX) return b * CTX + (dir ? (CTX - 1 - s) : s);
    const int t = s - CTX; return TC + b * SEQ + (dir ? (SEQ - 1 - t) : t);
}
template <int J, bool WCTX>
__device__ __forceinline__ void phase_s5_naive(Frame& F) {
    const int gw = F.blk * NWAVES + F.wave, lane = F.lane;
    if ((gw & 3) != 0) return;
    const int it = gw >> 2; if (it >= NB * 64) return;
    const int b = it >> 6, g = it & 63, p = lane;
    const bf16* hb = (const bf16*)(F.ws + WS_H); float* ysum = (float*)(F.ws + WS_YSUM);
    for (int dir = 0; dir < 2; ++dir) {
        const int gi = (J * 2 + dir) * 64 + g, pidx = gi * 64 + p;
        const float lam_re = F.in[IN_S5LRE][pidx], lam_im = F.in[IN_S5LIM][pidx];
        const float dt = expf(F.in[IN_S5LOG][gi]);
        const float mag = expf(lam_re * dt);
        double sd, cd; sincos_d((double)(lam_im * dt), sd, cd);
        const float a_re = mag * (float)cd, a_im = mag * (float)sd;
        const float den = lam_re * lam_re + lam_im * lam_im, n_re = a_re - 1.f, n_im = a_im;
        const float f_re = (n_re * lam_re + n_im * lam_im) / den, f_im = (n_im * lam_re - n_re * lam_im) / den;
        float bbr[16], bbi[16], cre[16], cim[16];
#pragma unroll
        for (int c = 0; c < 16; ++c) { const float br = F.in[IN_S5BRE][(size_t)pidx * 16 + c], bi = F.in[IN_S5BIM][(size_t)pidx * 16 + c];
            bbr[c] = f_re * br - f_im * bi; bbi[c] = f_re * bi + f_im * br;
            cre[c] = F.in[IN_S5CRE][((size_t)gi * 16 + c) * 64 + p]; cim[c] = F.in[IN_S5CIM][((size_t)gi * 16 + c) * 64 + p]; }
        float x_re = 0.f, x_im = 0.f;
        for (int s = 0; s < CTX + SEQ; ++s) {
            const int r = seq_row(b, dir, s);
            const v4u u0 = *(const v4u*)(hb + (size_t)r * D + g * 16), u1 = *(const v4u*)(hb + (size_t)r * D + g * 16 + 8);
            float u[16];
            u[0] = bflo(u0.x); u[1] = bfhi(u0.x); u[2] = bflo(u0.y); u[3] = bfhi(u0.y); u[4] = bflo(u0.z); u[5] = bfhi(u0.z); u[6] = bflo(u0.w); u[7] = bfhi(u0.w);
            u[8] = bflo(u1.x); u[9] = bfhi(u1.x); u[10] = bflo(u1.y); u[11] = bfhi(u1.y); u[12] = bflo(u1.z); u[13] = bfhi(u1.z); u[14] = bflo(u1.w); u[15] = bfhi(u1.w);
            float bur = 0.f, bui = 0.f;
#pragma unroll
            for (int c = 0; c < 16; ++c) { bur += u[c] * bbr[c]; bui += u[c] * bbi[c]; }
            const float nr = a_re * x_re - a_im * x_im + bur, ni = a_re * x_im + a_im * x_re + bui;
            x_re = nr; x_im = ni;
            if (WCTX || s >= CTX) {
                float yv = 0.f;
#pragma unroll
                for (int c = 0; c < 16; ++c) { const float t = wave_sum(x_re * cre[c] - x_im * cim[c]); if (lane == c) yv = t; }
                if (lane < 16) { float* yp = ysum + (size_t)r * D + g * 16 + lane; if (dir == 0) *yp = yv; else *yp = *yp + yv; }
            }
        }
    }
}
template <int J, bool WCTX>
__device__ __forceinline__ void phase_s5_combine(Frame& F) {
    constexpr int R0 = WCTX ? 0 : TC;
    const bf16* hb = (const bf16*)(F.ws + WS_H); const float* ysum = (const float*)(F.ws + WS_YSUM); bf16* zb = (bf16*)(F.ws + WS_Z);
    const int gw = F.blk * NWAVES + F.wave, NGW = F.G * NWAVES, lane = F.lane;
    f32x4 dv[4];
#pragma unroll
    for (int j = 0; j < 4; ++j) dv[j] = *(const f32x4*)(F.in[IN_S5D] + J * D + 4 * lane + 256 * j);
    for (int r = R0 + gw; r < T; r += NGW) {
#pragma unroll
        for (int j = 0; j < 4; ++j) {
            const f32x4 y = *(const f32x4*)(ysum + (size_t)r * D + 4 * lane + 256 * j);
            const v2u hv = *(const v2u*)(hb + (size_t)r * D + 4 * lane + 256 * j);
            f32x4 z; z.x = gelu_tanh(y.x + dv[j].x * bflo(hv.x)); z.y = gelu_tanh(y.y + dv[j].y * bfhi(hv.x)); z.z = gelu_tanh(y.z + dv[j].z * bflo(hv.y)); z.w = gelu_tanh(y.w + dv[j].w * bfhi(hv.y));
            st_bf4(zb + (size_t)r * D + 4 * lane + 256 * j, z);
        }
    }
}
template <bool WCTX>
__device__ __forceinline__ void phase_attn_naive(Frame& F) {
    constexpr int R0 = WCTX ? 0 : TC;
    const bf16* qb = (const bf16*)(F.ws + WS_QB); const bf16* kb = (const bf16*)(F.ws + WS_KB); const bf16* vb = (const bf16*)(F.ws + WS_VB); bf16* zb = (bf16*)(F.ws + WS_Z);
    const int gw = F.blk * NWAVES + F.wave, NGW = F.G * NWAVES, lane = F.lane;
    for (int it = gw; it < (T - R0) * 16; it += NGW) {
        const int r = R0 + (it >> 4), h = it & 15, kvh = h >> 2;
        int kv0, nk;
        if (r < TC) { kv0 = (r >> 8) * KVLEN + SEQ; nk = CTX; } else { kv0 = ((r - TC) >> 11) * KVLEN; nk = KVLEN; }
        float q[64];
#pragma unroll
        for (int c = 0; c < 8; ++c) { const v4u w = *(const v4u*)(qb + (size_t)r * D + h * 64 + 8 * c);
            q[8 * c] = bflo(w.x); q[8 * c + 1] = bfhi(w.x); q[8 * c + 2] = bflo(w.y); q[8 * c + 3] = bfhi(w.y); q[8 * c + 4] = bflo(w.z); q[8 * c + 5] = bfhi(w.z); q[8 * c + 6] = bflo(w.w); q[8 * c + 7] = bfhi(w.w); }
        float m = -INFINITY, l = 0.f, o[64];
#pragma unroll
        for (int d = 0; d < 64; ++d) o[d] = 0.f;
        for (int kk = lane; kk < nk; kk += 64) {
            const bf16* kp = kb + (size_t)(kv0 + kk) * 256 + kvh * 64; const bf16* vp = vb + (size_t)(kv0 + kk) * 256 + kvh * 64;
            float s = 0.f;
#pragma unroll
            for (int c = 0; c < 8; ++c) { const v4u w = *(const v4u*)(kp + 8 * c);
                s += q[8 * c] * bflo(w.x) + q[8 * c + 1] * bfhi(w.x) + q[8 * c + 2] * bflo(w.y) + q[8 * c + 3] * bfhi(w.y) + q[8 * c + 4] * bflo(w.z) + q[8 * c + 5] * bfhi(w.z) + q[8 * c + 6] * bflo(w.w) + q[8 * c + 7] * bfhi(w.w); }
            const float mn = fmaxf(m, s), sc = exp2f(m - mn), pp = exp2f(s - mn);
            l = l * sc + pp; m = mn;
#pragma unroll
            for (int c = 0; c < 8; ++c) { const v4u w = *(const v4u*)(vp + 8 * c);
                o[8 * c] = o[8 * c] * sc + pp * bflo(w.x); o[8 * c + 1] = o[8 * c + 1] * sc + pp * bfhi(w.x); o[8 * c + 2] = o[8 * c + 2] * sc + pp * bflo(w.y); o[8 * c + 3] = o[8 * c + 3] * sc + pp * bfhi(w.y);
                o[8 * c + 4] = o[8 * c + 4] * sc + pp * bflo(w.z); o[8 * c + 5] = o[8 * c + 5] * sc + pp * bfhi(w.z); o[8 * c + 6] = o[8 * c + 6] * sc + pp * bflo(w.w); o[8 * c + 7] = o[8 * c + 7] * sc + pp * bfhi(w.w); }
        }
        const float M = wave_max(m), f = exp2f(m - M);
        const float lt = wave_sum(l * f);
        float res = 0.f;
#pragma unroll
        for (int d = 0; d < 64; ++d) { const float t = wave_sum(o[d] * f); if (lane == d) res = t; }
        zb[(size_t)r * D + h * 64 + lane] = (bf16)f2bf(res / lt);
    }
}
template <bool WCTX>
__device__ __forceinline__ void phase_mlstm_naive(Frame& F) {
    const int gw = F.blk * NWAVES + F.wave, lane = F.lane;
    if ((gw & 15) != 0) return;
    const int it = gw >> 4; if (it >= NB * 8 * 2) return;
    const int b = it >> 4, hd = (it >> 1) & 7, j = (it & 1) * 64 + lane;
    const bf16* kb = (const bf16*)(F.ws + WS_MK); const bf16* vb = (const bf16*)(F.ws + WS_MV); const bf16* qb = (const bf16*)(F.ws + WS_MQ);
    const float* gb = (const float*)(F.ws + WS_MG); float* hsum = (float*)(F.ws + WS_MHS);
    for (int dir = 0; dir < 2; ++dir) {
        float C[64], nn[64], m = 0.f;
#pragma unroll
        for (int d = 0; d < 64; ++d) { C[d] = 0.f; nn[d] = 0.f; }
        for (int s = 0; s < CTX + SEQ; ++s) {
            const int r = seq_row(b, dir, s);
            const float ig = gb[(size_t)r * 32 + dir * 16 + hd], lf = log_sigmoidf_(gb[(size_t)r * 32 + dir * 16 + 8 + hd]);
            const float mn = fmaxf(lf + m, ig), fa = __expf(lf + m - mn), ia = __expf(ig - mn); m = mn;
            const float vj = bf2f(vb[(size_t)r * 1024 + hd * 128 + j]) * ia;
            float num = 0.f, den = 0.f;
#pragma unroll
            for (int c = 0; c < 8; ++c) {
                const v4u kw = *(const v4u*)(kb + (size_t)r * 512 + hd * 64 + 8 * c), qw = *(const v4u*)(qb + (size_t)r * 512 + hd * 64 + 8 * c);
                float kk[8], qq[8];
                kk[0] = bflo(kw.x); kk[1] = bfhi(kw.x); kk[2] = bflo(kw.y); kk[3] = bfhi(kw.y); kk[4] = bflo(kw.z); kk[5] = bfhi(kw.z); kk[6] = bflo(kw.w); kk[7] = bfhi(kw.w);
                qq[0] = bflo(qw.x); qq[1] = bfhi(qw.x); qq[2] = bflo(qw.y); qq[3] = bfhi(qw.y); qq[4] = bflo(qw.z); qq[5] = bfhi(qw.z); qq[6] = bflo(qw.w); qq[7] = bfhi(qw.w);
#pragma unroll
                for (int e = 0; e < 8; ++e) { const int d = 8 * c + e;
                    C[d] = fa * C[d] + kk[e] * vj; nn[d] = fa * nn[d] + ia * kk[e]; num += C[d] * qq[e]; den += nn[d] * qq[e]; }
            }
            if (WCTX || s >= CTX) {
                const float outv = num / fmaxf(fabsf(den), __expf(-m));
                float* hp = hsum + (size_t)r * D + hd * 128 + j;
                if (dir == 0) *hp = outv; else *hp = *hp + outv;
            }
        }
    }
}
template <bool WCTX>
__device__ __forceinline__ void phase_mlstm_combine(Frame& F) {
    constexpr int R0 = WCTX ? 0 : TC;
    const float* hsum = (const float*)(F.ws + WS_MHS); const bf16* ob = (const bf16*)(F.ws + WS_MO); bf16* zb = (bf16*)(F.ws + WS_Z);
    const int gw = F.blk * NWAVES + F.wave, NGW = F.G * NWAVES, lane = F.lane;
    f32x4 gv[4];
#pragma unroll
    for (int j = 0; j < 4; ++j) gv[j] = *(const f32x4*)(F.in[IN_MLNG] + 4 * lane + 256 * j);
    for (int r = R0 + gw; r < T; r += NGW) {
#pragma unroll
        for (int j = 0; j < 4; ++j) {
            const f32x4 hv = *(const f32x4*)(hsum + (size_t)r * D + 4 * lane + 256 * j);
            float ss = hv.x * hv.x + hv.y * hv.y + hv.z * hv.z + hv.w * hv.w;
#pragma unroll
            for (int o = 1; o < 32; o <<= 1) ss += __shfl_xor(ss, o);
            const float rs = rsqrtf(ss * (1.f / 128.f) + EPS);
            const v2u ow = *(const v2u*)(ob + (size_t)r * D + 4 * lane + 256 * j);
            f32x4 z = hv * rs * gv[j];
            z.x *= sigmoidf_(bflo(ow.x)); z.y *= sigmoidf_(bfhi(ow.x)); z.z *= sigmoidf_(bflo(ow.y)); z.w *= sigmoidf_(bfhi(ow.y));
            st_bf4(zb + (size_t)r * D + 4 * lane + 256 * j, z);
        }
    }
}
#include <hip/hip_bf16.h>
#include <cmath>
namespace attn_body {
using bf16=__hip_bfloat16;
using bf16x8=__attribute__((ext_vector_type(8)))short;
using s16x4=__attribute__((ext_vector_type(4)))short;
using f32x16=__attribute__((ext_vector_type(16)))float;
using u32x4=__attribute__((ext_vector_type(4)))unsigned;
constexpr int D=64,QP=1024,KP=256;
constexpr int NW=8,QBLK=32,QB=QBLK*NW,KVBLK=64;
__device__ __forceinline__ int crow(int r,int hi){return (r&3)+8*(r>>2)+4*hi;}
#define SBAR() __builtin_amdgcn_sched_barrier(0)
__device__ __forceinline__ void cmask(f32x16&p0,f32x16&p1,int jb,int qrel,int hi){
  const float NEG=-INFINITY; int kb=64*jb+4*hi;
  #pragma unroll
  for(int r=0;r<16;++r){int kv=kb+(r&3)+8*(r>>2); if(kv>qrel)p0[r]=NEG; if(kv+32>qrel)p1[r]=NEG;}
}

constexpr int NSLOT=3, SLOTB=8192;
constexpr int LDS_K=0, LDS_V=NSLOT*SLOTB, LDS_WS=2*NSLOT*SLOTB, LDS_OST=LDS_WS+NW*64*4, LDS_BYTES=LDS_OST+NW*4096;
constexpr float C2=0.125f*1.4426950408889634f;
__device__ __forceinline__ void glds16(const void*gsrc,unsigned lds_dst){unsigned keep;
  asm volatile("s_mov_b32 %0, m0\n\ts_mov_b32 m0, %2\n\ts_nop 0\n\tglobal_load_lds_dwordx4 %1, off\n\ts_mov_b32 m0, %0":"=&s"(keep):"v"(gsrc),"s"(lds_dst):"memory");}
__device__ __forceinline__ float max3f(float a,float b,float c){float r;asm("v_max3_f32 %0, %1, %2, %3":"=v"(r):"v"(a),"v"(b),"v"(c));return r;}
__device__ __forceinline__ float max2f(float a,float b){float r;asm("v_max_f32_e32 %0, %1, %2":"=v"(r):"v"(a),"v"(b));return r;}
__device__ __forceinline__ float fadd_s(float a,float b){float r;asm("v_add_f32_e32 %0, %1, %2":"=v"(r):"v"(a),"v"(b));return r;}
__device__ __forceinline__ float fsub_s(float a,float b){float r;asm("v_sub_f32_e32 %0, %1, %2":"=v"(r):"v"(a),"v"(b));return r;}
typedef float f32x2_t __attribute__((ext_vector_type(2))); typedef __bf16 bf16x2_t __attribute__((ext_vector_type(2)));
__device__ __forceinline__ unsigned cvtpk_s(float lo,float hi){f32x2_t v={lo,hi};bf16x2_t b=__builtin_convertvector(v,bf16x2_t);return __builtin_bit_cast(unsigned,b);}
#define WAIT_BAR(N) asm volatile("s_waitcnt vmcnt(" #N ") lgkmcnt(0)\n\ts_barrier":::"memory")

__device__ __forceinline__ void qkt(f32x16&p0,f32x16&p1,const char*Kslot,const bf16x8*qr,const f32x16&negm,int r32,int hi){
  const char*kb=Kslot+hi*1024+r32*16;
  #pragma unroll
  for(int d0=0;d0<4;++d0){
    const bf16x8 b0=*reinterpret_cast<const bf16x8*>(kb+d0*2048);
    const bf16x8 b1=*reinterpret_cast<const bf16x8*>(kb+d0*2048+512);
    if(d0==0){p0=__builtin_amdgcn_mfma_f32_32x32x16_bf16(b0,qr[0],negm,0,0,0);p1=__builtin_amdgcn_mfma_f32_32x32x16_bf16(b1,qr[0],negm,0,0,0);}
    else{p0=__builtin_amdgcn_mfma_f32_32x32x16_bf16(b0,qr[d0],p0,0,0,0);p1=__builtin_amdgcn_mfma_f32_32x32x16_bf16(b1,qr[d0],p1,0,0,0);}}
}
typedef __attribute__((address_space(3))) const char* lds_cptr;
typedef short v4i16_t __attribute__((ext_vector_type(4)));
__device__ __forceinline__ void kload8(bf16x8*kf,lds_cptr kp){
  kf[0]=*(const __attribute__((address_space(3))) bf16x8*)(kp);      kf[1]=*(const __attribute__((address_space(3))) bf16x8*)(kp+512);
  kf[2]=*(const __attribute__((address_space(3))) bf16x8*)(kp+2048); kf[3]=*(const __attribute__((address_space(3))) bf16x8*)(kp+2560);
  kf[4]=*(const __attribute__((address_space(3))) bf16x8*)(kp+4096); kf[5]=*(const __attribute__((address_space(3))) bf16x8*)(kp+4608);
  kf[6]=*(const __attribute__((address_space(3))) bf16x8*)(kp+6144); kf[7]=*(const __attribute__((address_space(3))) bf16x8*)(kp+6656);
}
__device__ __forceinline__ void kload2(bf16x8*kf,lds_cptr kp,int j){ kf[2*j]=*(const __attribute__((address_space(3))) bf16x8*)(kp+j*2048); kf[2*j+1]=*(const __attribute__((address_space(3))) bf16x8*)(kp+j*2048+512); }
__device__ __forceinline__ s16x4 vtr(lds_cptr p){ return __builtin_bit_cast(s16x4,__builtin_amdgcn_ds_read_tr16_b64_v4i16((__attribute__((address_space(3))) v4i16_t*)p)); }
__device__ __forceinline__ float rowmax(const f32x16&p0,const f32x16&p1){
  float a=max3f(p0[0],p0[1],p1[0]),b=max3f(p0[2],p0[3],p1[1]);a=max3f(a,p1[2],p1[3]);
  #pragma unroll
  for(int r=4;r<16;r+=4){a=max3f(a,p0[r],p0[r+1]);b=max3f(b,p0[r+2],p0[r+3]);a=max3f(a,p1[r],p1[r+1]);b=max3f(b,p1[r+2],p1[r+3]);}
  const float m=max2f(a,b);
  auto rr=__builtin_amdgcn_permlane32_swap(__float_as_uint(m),__float_as_uint(m),false,false);
  return max2f(__uint_as_float(rr[0]),__uint_as_float(rr[1]));
}
__device__ __forceinline__ void pv(f32x16*o,int vb,bf16x8 pa0,bf16x8 pa1,bf16x8 pa2,bf16x8 pa3){
  #pragma unroll
  for(int d0=0;d0<2;++d0){s16x4 lo[4],hi[4];
    #pragma unroll
    for(int ks=0;ks<4;++ks){
      asm volatile("ds_read_b64_tr_b16 %0,%1 offset:%c2":"=&v"(lo[ks]):"v"(vb),"i"(d0*4096+ks*1024):"memory");
      asm volatile("ds_read_b64_tr_b16 %0,%1 offset:%c2":"=&v"(hi[ks]):"v"(vb),"i"(d0*4096+ks*1024+512):"memory");}
    asm volatile("s_waitcnt lgkmcnt(0)":::"memory");SBAR();
    #define PK(k) (bf16x8){lo[k][0],lo[k][1],lo[k][2],lo[k][3],hi[k][0],hi[k][1],hi[k][2],hi[k][3]}
    o[d0]=__builtin_amdgcn_mfma_f32_32x32x16_bf16(pa0,PK(0),o[d0],0,0,0);
    o[d0]=__builtin_amdgcn_mfma_f32_32x32x16_bf16(pa1,PK(1),o[d0],0,0,0);
    o[d0]=__builtin_amdgcn_mfma_f32_32x32x16_bf16(pa2,PK(2),o[d0],0,0,0);
    o[d0]=__builtin_amdgcn_mfma_f32_32x32x16_bf16(pa3,PK(3),o[d0],0,0,0);
    #undef PK
  }
}

#ifndef ATTN_STORE16
#define ATTN_STORE16(p,v) (*(u32x4*)(p)=(v))
#endif
template<int THRL> __device__ __forceinline__ void attn_unit(const bf16*Qu,const bf16*__restrict__ Kh,const bf16*__restrict__ Vh,bf16*Ou,const int NT,char*shm){
  const int tid=threadIdx.x,lane=tid&63,r32=lane&31,hi=lane>>5; const int wid=__builtin_amdgcn_readfirstlane(tid>>6);
  const bf16*Qw=Qu+(long)(wid*QBLK)*QP;
  const unsigned lds0=(unsigned)(uintptr_t)shm;
  float*wsf=(float*)(shm+LDS_WS)+wid*64;
  const bf16*ksrc=Kh+(long)lane*KP+wid*8;
  const bf16*vsrc=Vh+(long)(16*(wid&3)+(lane>>2))*KP+(wid>>2)*32+(lane&3)*8;
  const unsigned kdst=lds0+LDS_K+wid*1024, vdst=lds0+LDS_V+wid*1024;
  #define DMA_K(t,slot) glds16(ksrc+(long)(t)*KVBLK*KP,(unsigned)__builtin_amdgcn_readfirstlane(kdst+(slot)))
  #define DMA_V(t,slot) glds16(vsrc+(long)(t)*KVBLK*KP,(unsigned)__builtin_amdgcn_readfirstlane(vdst+(slot)))
  const int vb0=(int)(lds0+LDS_V)+((lane>>4)&1)*32+(lane&3)*8+(4*hi+((lane&15)>>2))*64;
  const char*Kbase=shm+LDS_K; bf16x8 kf[8];
  const lds_cptr shm3=(lds_cptr)shm; const lds_cptr kp0=shm3+LDS_K+hi*1024+r32*16; const lds_cptr vp0=shm3+LDS_V+((lane>>4)&1)*32+(lane&3)*8+(4*hi+((lane&15)>>2))*64;
  DMA_K(0,0);DMA_V(0,0);DMA_K(1,SLOTB);
  bf16x8 qr[4];
  #pragma unroll
  for(int d0=0;d0<4;++d0)qr[d0]=*reinterpret_cast<const bf16x8*>(&Qw[(long)r32*QP+d0*16+hi*8]);
  float mhat=0.f,l_reg=0.f;f32x16 o[2];o[0]=f32x16{};o[1]=f32x16{};f32x16 negm=f32x16{};asm volatile("":"+v"(negm));
  #define CMASK(P0,P1,t) do{}while(0)
  bool resc=false;
  #define START(P0,P1) do{ const float rm=rowmax(P0,P1); resc=false; \
    { const float dl=rm; mhat=fadd_s(mhat,dl); \
      _Pragma("unroll") for(int r=0;r<16;++r){P0[r]=fsub_s(P0[r],dl);P1[r]=fsub_s(P1[r],dl);} \
      _Pragma("unroll") for(int r=0;r<16;++r)negm[r]=-mhat; asm volatile("":"+v"(negm)); } \
    _Pragma("unroll") for(int r=0;r<16;++r)P0[r]=__builtin_amdgcn_exp2f(P0[r]); }while(0)
  #define RESC() do{ if(resc){ asm volatile("s_waitcnt lgkmcnt(0)":::"memory"); \
      _Pragma("unroll") for(int d_=0;d_<2;++d_) _Pragma("unroll") for(int r=0;r<16;++r)o[d_][r]*=wsf[crow(r,hi)]; } }while(0)
  f32x16 pA0,pA1,pB0,pB1;
  int sl_prev=0,sl_cur=0,sl_next=SLOTB;
  #define ROT() do{sl_prev=sl_cur;sl_cur=sl_next;sl_next=(sl_next==(NSLOT-1)*SLOTB)?0:sl_next+SLOTB;}while(0)
  DMA_K(2,2*SLOTB);
  WAIT_BAR(3);
  qkt(pA0,pA1,Kbase,qr,negm,r32,hi);asm volatile("s_nop 15\n\ts_nop 7":"+v"(pA0),"+v"(pA1));CMASK(pA0,pA1,0);
  START(pA0,pA1);
  _Pragma("unroll") for(int r=0;r<16;++r)pA1[r]=__builtin_amdgcn_exp2f(pA1[r]);
  WAIT_BAR(0);
  DMA_K(3,0);DMA_V(1,SLOTB);
  ROT();
  kload8(kf,kp0+sl_cur);
  WAIT_BAR(2);
  s16x4 vlo[8],vhi[8]; u32x4 pw0,pw1,pw2,pw3;
  #define PKW(P,B) cvtpk_s(P[B],P[B+1])
  #define PAF(k) __builtin_bit_cast(bf16x8,pw##k)
  #define VFR(i) (bf16x8){vlo[i][0],vlo[i][1],vlo[i][2],vlo[i][3],vhi[i][0],vhi[i][1],vhi[i][2],vhi[i][3]}
  #define PIN(x) asm volatile("":"+v"(x))
  #define MX3(a,b,c) __builtin_fmaxf(__builtin_fmaxf((a),(b)),(c))
  #define GAPA(MF,A0,A1,A2,A3,W0,W1,PW) do{ MF; sacc+=A0; sacc+=A1; sacc+=A2; sacc+=A3; PIN(sacc); W0; W1; PIN(PW); SBAR(); }while(0)
  #define EX(v) __builtin_amdgcn_exp2f(v)
  #define GAPB(MF,X,B) do{ MF; X[B]=EX(X[B]); X[B+1]=EX(X[B+1]); X[B+2]=EX(X[B+2]); X[B+3]=EX(X[B+3]); PIN(X); SBAR(); }while(0)
  #define VRD(i) do{ vlo[i]=vtr(vp_+(((i)>>2)*4096+((i)&3)*1024)); vhi[i]=vtr(vp_+(((i)>>2)*4096+((i)&3)*1024+512)); }while(0)
  #define KRD(G,j) do{ if(G){ kload2(kf,kp0+sl_next,j); SBAR(); } }while(0)
  #define STEP(C0,C1,P0,P1,t,GK,GV,GL) do{ SBAR(); \
    const lds_cptr vp_=vp0+sl_prev; \
    VRD(0); SBAR(); float sacc=(P0[0]+P0[1]); \
    GAPA(C0=__builtin_amdgcn_mfma_f32_32x32x16_bf16(kf[0],qr[0],negm,0,0,0), P0[2],P0[3],P0[4],P0[5],     pw0[0]=PKW(P0,0), pw0[1]=PKW(P0,2), pw0); \
    VRD(4); SBAR(); GAPA(C1=__builtin_amdgcn_mfma_f32_32x32x16_bf16(kf[1],qr[0],negm,0,0,0), P0[6],P0[7],P0[8],P0[9],     pw0[2]=PKW(P0,4), pw0[3]=PKW(P0,6), pw0); \
    VRD(1); SBAR(); GAPA(C0=__builtin_amdgcn_mfma_f32_32x32x16_bf16(kf[2],qr[1],C0,0,0,0),   P0[10],P0[11],P0[12],P0[13], pw1[0]=PKW(P0,8), pw1[1]=PKW(P0,10), pw1); \
    VRD(5); SBAR(); GAPA(C1=__builtin_amdgcn_mfma_f32_32x32x16_bf16(kf[3],qr[1],C1,0,0,0),   P0[14],P0[15],P1[0],P1[1],   pw1[2]=PKW(P0,12),pw1[3]=PKW(P0,14), pw1); \
    VRD(2); SBAR(); GAPA(C0=__builtin_amdgcn_mfma_f32_32x32x16_bf16(kf[4],qr[2],C0,0,0,0),   P1[2],P1[3],P1[4],P1[5],     pw2[0]=PKW(P1,0), pw2[1]=PKW(P1,2), pw2); \
    VRD(6); SBAR(); GAPA(C1=__builtin_amdgcn_mfma_f32_32x32x16_bf16(kf[5],qr[2],C1,0,0,0),   P1[6],P1[7],P1[8],P1[9],     pw2[2]=PKW(P1,4), pw2[3]=PKW(P1,6), pw2); \
    VRD(3); SBAR(); GAPA(C0=__builtin_amdgcn_mfma_f32_32x32x16_bf16(kf[6],qr[3],C0,0,0,0),   P1[10],P1[11],P1[12],P1[13], pw3[0]=PKW(P1,8), pw3[1]=PKW(P1,10), pw3); \
    VRD(7); SBAR(); GAPA(C1=__builtin_amdgcn_mfma_f32_32x32x16_bf16(kf[7],qr[3],C1,0,0,0),   P1[14],P1[15],0.f,0.f,       pw3[2]=PKW(P1,12),pw3[3]=PKW(P1,14), pw3); \
    l_reg+=sacc; \
    if(GK){DMA_K((t)+3,sl_cur);} if(GV){DMA_V((t)+1,sl_next);} \
    CMASK(C0,C1,t); \
    { float a=MX3(C0[0],C0[1],C1[0]),b=MX3(C0[2],C0[3],C1[1]); a=MX3(a,C1[2],C1[3]); \
      _Pragma("unroll") for(int r=4;r<16;r+=4){a=MX3(a,C0[r],C0[r+1]);b=MX3(b,C0[r+2],C0[r+3]);a=MX3(a,C1[r],C1[r+1]);b=MX3(b,C1[r+2],C1[r+3]);} \
      float rm=__builtin_fmaxf(a,b); { auto rr=__builtin_amdgcn_permlane32_swap(__float_as_uint(rm),__float_as_uint(rm),false,false); rm=__builtin_fmaxf(__uint_as_float(rr[0]),__uint_as_float(rr[1])); } \
      resc=false; \
      if(__builtin_expect(__any(rm>(float)THRL),0)){ const float dl=__builtin_fmaxf(rm,0.f); mhat+=dl; \
        _Pragma("unroll") for(int r=0;r<16;++r){C0[r]-=dl;C1[r]-=dl;} \
        _Pragma("unroll") for(int r=0;r<16;++r)negm[r]=-mhat; asm volatile("":"+v"(negm)); \
        const float f=__builtin_amdgcn_exp2f(-dl); l_reg*=f; if(hi==0)wsf[r32]=f; resc=true; } } \
    SBAR(); \
    GAPB(o[0]=__builtin_amdgcn_mfma_f32_32x32x16_bf16(PAF(0),VFR(0),o[0],0,0,0), C0,0); \
    GAPB(o[1]=__builtin_amdgcn_mfma_f32_32x32x16_bf16(PAF(0),VFR(4),o[1],0,0,0), C0,4); \
    KRD(GL,0); GAPB(o[0]=__builtin_amdgcn_mfma_f32_32x32x16_bf16(PAF(1),VFR(1),o[0],0,0,0), C0,8); \
    KRD(GL,1); GAPB(o[1]=__builtin_amdgcn_mfma_f32_32x32x16_bf16(PAF(1),VFR(5),o[1],0,0,0), C0,12); \
    KRD(GL,2); GAPB(o[0]=__builtin_amdgcn_mfma_f32_32x32x16_bf16(PAF(2),VFR(2),o[0],0,0,0), C1,0); \
    KRD(GL,3); GAPB(o[1]=__builtin_amdgcn_mfma_f32_32x32x16_bf16(PAF(2),VFR(6),o[1],0,0,0), C1,4); \
    GAPB(o[0]=__builtin_amdgcn_mfma_f32_32x32x16_bf16(PAF(3),VFR(3),o[0],0,0,0), C1,8); \
    GAPB(o[1]=__builtin_amdgcn_mfma_f32_32x32x16_bf16(PAF(3),VFR(7),o[1],0,0,0), C1,12); \
    }while(0)
  int t=1;
  #undef CMASK
  #define CMASK(P0,P1,t) do{}while(0)
  for(;t+5<NT;t+=2){
    STEP(pB0,pB1,pA0,pA1,t,true,true,true);     WAIT_BAR(2); RESC(); ROT();
    STEP(pA0,pA1,pB0,pB1,t+1,true,true,true);   WAIT_BAR(2); RESC(); ROT();
  }
  #undef CMASK
  #define CMASK(P0,P1,t) do{}while(0)
  #define ENDW(tt) do{ if((tt)+3<NT){WAIT_BAR(2);} else if((tt)+2<NT){WAIT_BAR(1);} else {WAIT_BAR(0);} }while(0)
  for(;t+1<NT;t+=2){
    STEP(pB0,pB1,pA0,pA1,t,(t+3<NT),(t+1<NT),(t+1<NT));       ENDW(t);   RESC(); ROT();
    STEP(pA0,pA1,pB0,pB1,t+1,(t+4<NT),(t+2<NT),(t+2<NT));     ENDW(t+1); RESC(); ROT();
  }
  STEP(pB0,pB1,pA0,pA1,NT-1,false,false,false); RESC();
  { float sacc=pB0[0]+pB0[1]; _Pragma("unroll") for(int r=2;r<16;++r)sacc+=pB0[r]; _Pragma("unroll") for(int r=0;r<16;++r)sacc+=pB1[r]; l_reg+=sacc;
    pw0=(u32x4){PKW(pB0,0),PKW(pB0,2),PKW(pB0,4),PKW(pB0,6)};pw1=(u32x4){PKW(pB0,8),PKW(pB0,10),PKW(pB0,12),PKW(pB0,14)};pw2=(u32x4){PKW(pB1,0),PKW(pB1,2),PKW(pB1,4),PKW(pB1,6)};pw3=(u32x4){PKW(pB1,8),PKW(pB1,10),PKW(pB1,12),PKW(pB1,14)};
    SBAR(); pv(o,vb0+sl_cur,PAF(0),PAF(1),PAF(2),PAF(3)); }
  #undef PKW
  #undef PAF
  #undef VFR
  #undef PIN
  #undef MX3
  #undef GAPA
  #undef GAPB
  #undef EX
  #undef VRD
  #undef KRD
  #undef STEP
  #undef ENDW
  {auto rr=__builtin_amdgcn_permlane32_swap(__float_as_uint(l_reg),__float_as_uint(l_reg),false,false);l_reg=__uint_as_float(rr[0])+__uint_as_float(rr[1]);}
  if(hi==0)wsf[32+r32]=l_reg;asm volatile("s_waitcnt lgkmcnt(0)":::"memory");
  float rli[16];
  #pragma unroll
  for(int r=0;r<16;++r)rli[r]=__builtin_amdgcn_rcpf(wsf[32+crow(r,hi)]);
  bf16*Ow=Ou+(long)(wid*QBLK)*QP;
  { bf16*stg=(bf16*)(shm+LDS_OST)+wid*2048;
    #pragma unroll
    for(int r=0;r<16;++r){const int orow=crow(r,hi);
      #pragma unroll
      for(int d0=0;d0<2;++d0)stg[orow*64+d0*32+r32]=__float2bfloat16(o[d0][r]*rli[r]);}
    asm volatile("s_waitcnt lgkmcnt(0)":::"memory");
    #pragma unroll
    for(int i=0;i<4;++i){const int row=i*8+(lane>>3),ch=lane&7; const u32x4 v=*(const u32x4*)(stg+row*64+ch*8); ATTN_STORE16(Ow+(long)row*QP+ch*8,v);} }
  asm volatile("s_waitcnt lgkmcnt(0)\n\ts_barrier":::"memory");
  #undef DMA_K
  #undef DMA_V
  #undef CMASK
  #undef START
  #undef RESC
  #undef ROT
}
constexpr int ATTN_LDS_BYTES=LDS_BYTES;
#undef SBAR
#undef WAIT_BAR
}

template <bool WCTX>
__device__ __forceinline__ void phase_attn_fast(Frame& F, char* ldsg) {
    typedef attn_body::bf16 abf;
    const abf* Q = (const abf*)(F.ws + WS_QB); const abf* K = (const abf*)(F.ws + WS_KB); const abf* V = (const abf*)(F.ws + WS_VB); abf* O = (abf*)(F.ws + WS_Z);
    const int vcu = (F.G % 8 == 0) ? (F.blk % 8) * (F.G / 8) + F.blk / 8 : F.blk;
    const int nunits = WCTX ? 1024 + 128 : 1024;
    for (int u = vcu; u < nunits; u += F.G) {
        int h, kvh, qrow0, kv0, NT;
        if (u < 1024) { const int grp = u >> 5, b = grp >> 2; kvh = grp & 3; const int qb = (u >> 2) & 7; h = kvh * 4 + (u & 3); qrow0 = TC + b * SEQ + qb * 256; kv0 = b * KVLEN; NT = KVLEN / 64; }
        else { const int u2 = u - 1024, b = u2 >> 4; h = u2 & 15; kvh = h >> 2; qrow0 = b * CTX; kv0 = b * KVLEN + SEQ; NT = CTX / 64; }
        attn_body::attn_unit<8>(Q + (size_t)qrow0 * 1024 + h * 64, K + (size_t)kv0 * 256 + kvh * 64, V + (size_t)kv0 * 256 + kvh * 64, O + (size_t)qrow0 * 1024 + h * 64, NT, ldsg + RING_OFF);
    }
}

constexpr int S5_BU_STRIDE = 132;
constexpr int S5_X_STRIDE = 136;
constexpr int S5_BU_BYTES = 16 * S5_BU_STRIDE * 4, S5_X_BYTES = 16 * S5_X_STRIDE * 2, S5_Y_BYTES = 2 * 64 * 16, S5_U_BYTES = 64 * 16;
constexpr int S5_ITEM_LDS = S5_BU_BYTES + S5_X_BYTES + 2 * S5_Y_BYTES + 4 * S5_U_BYTES;
constexpr int S5_NT = (CTX + SEQ) / 32;
static_assert(4 * S5_ITEM_LDS <= RING_BYTES, "S5 LDS");
#define S5_BAR() do { asm volatile("s_waitcnt lgkmcnt(0)" ::: "memory"); __builtin_amdgcn_s_barrier(); asm volatile("" ::: "memory"); } while (0)
__device__ __forceinline__ f32x2 cmul(f32x2 a, f32x2 b) { return (f32x2){a.x * b.x - a.y * b.y, a.x * b.y + a.y * b.x}; }

template <int J, bool WCTX>
__device__ __forceinline__ void phase_s5_fast(Frame& F) {
    const int lane = F.lane, w = F.wave;
    const bool helper = w >= 4;
    const int iw = w & 3, pairi = iw >> 1, dir = iw & 1;
    const int tq = lane & 15, kg = lane >> 4;
    const bf16* hb = (const bf16*)(F.ws + WS_H); float* ypart = (float*)(F.ws + WS_YSUM); bf16* zb = (bf16*)(F.ws + WS_Z);
    LAS unsigned char* base = F.lds + iw * S5_ITEM_LDS;
    LAS float* BU = (LAS float*)base;
    LAS bf16* XS = (LAS bf16*)(base + S5_BU_BYTES);
    LAS f32x4* YL = (LAS f32x4*)(base + S5_BU_BYTES + S5_X_BYTES);
    LAS v4u* UL = (LAS v4u*)(base + S5_BU_BYTES + S5_X_BYTES + 2 * S5_Y_BYTES);
    for (int it0 = F.blk * 2; it0 < NB * 64; it0 += F.G * 2) {
        const int it = it0 + pairi, b = it >> 6, g = it & 63;
        const int gi = (J * 2 + dir) * 64 + g;
        LAS v4u* TAB = (LAS v4u*)(F.lds);
        LAS f32x2* CST = (LAS f32x2*)(F.lds + 65536);
        LAS float* KMS = (LAS float*)(F.lds + 65536 + 6144);
        static_assert(65536 + 6144 + 8192 <= 4 * S5_ITEM_LDS, "S5 set-up scratch inside the item buffers");
        if (F.tid < 256) { const int i = F.tid >> 6, p = F.tid & 63; const int git = (J * 2 + (i & 1)) * 64 + ((it0 + (i >> 1)) & 63);
            const float dt = expf(F.in[IN_S5LOG][git]);
            const float lr = F.in[IN_S5LRE][git * 64 + p], li = F.in[IN_S5LIM][git * 64 + p]; const float mag = expf(lr * dt); double sd, cd; sincos_d((double)(li * dt), sd, cd);
            const float ar = mag * (float)cd, ai = mag * (float)sd, den = lr * lr + li * li, nr = ar - 1.f, ni = ai;
            const f32x2 a = (f32x2){ar, ai};
            CST[(i * 3 + 0) * 64 + p] = a; CST[(i * 3 + 1) * 64 + p] = cmul(a, a); CST[(i * 3 + 2) * 64 + p] = (f32x2){(nr * lr + ni * li) / den, (ni * lr - nr * li) / den}; }
        __syncthreads();
        for (int f = F.tid; f < 4 * 16 * 64; f += NTHR) {
            const int i = f >> 10, fi = (f >> 6) & 15, ln = f & 63, ltq = ln & 15, lkg = ln >> 4; const int git = (J * 2 + (i & 1)) * 64 + ((it0 + (i >> 1)) & 63);
            unsigned o[4];
            if (fi < 8) {
                const int n = 16 * fi + ltq, p = n >> 1, ri = n & 1;
                f32x2 co = CST[(i * 3 + 2) * 64 + p]; if ((lkg >> 1) == 0) co = cmul(co, CST[(i * 3 + 0) * 64 + p]);
                const float* brp = F.in[IN_S5BRE] + (size_t)git * 1024 + p * 16 + 8 * (lkg & 1); const float* bip = F.in[IN_S5BIM] + (size_t)git * 1024 + p * 16 + 8 * (lkg & 1);
#pragma unroll
                for (int q = 0; q < 4; ++q) { const f32x2 v0 = cmul(co, (f32x2){brp[2 * q], bip[2 * q]}), v1 = cmul(co, (f32x2){brp[2 * q + 1], bip[2 * q + 1]}); o[q] = pk2(ri ? v0.y : v0.x, ri ? v1.y : v1.x); }
            } else {
                const int tau = (fi - 8) >> 2, ks = fi & 3, p0 = 16 * ks + 4 * lkg;
                const float* crp = F.in[IN_S5CRE] + (size_t)git * 1024 + ltq * 64 + p0; const float* cip = F.in[IN_S5CIM] + (size_t)git * 1024 + ltq * 64 + p0;
#pragma unroll
                for (int q = 0; q < 4; ++q) { const f32x2 v = cmul((f32x2){crp[q], cip[q]}, CST[(i * 3 + tau) * 64 + p0 + q]); o[q] = pk2(v.x, -v.y); }
            }
            TAB[f] = (v4u){o[0], o[1], o[2], o[3]};
        }
        __syncthreads();
        if (helper) {
            const f32x4 d4 = *(const f32x4*)(F.in[IN_S5D] + J * D + g * 16 + 4 * kg);
            v4u ub[4]; f32x4 yoA0, yoA1, yoB0, yoB1;
#pragma unroll
            for (int k = 0; k < 4; ++k) ub[k] = *(const v4u*)(hb + (size_t)seq_row(b, dir, 32 * k + 2 * tq + (kg >> 1)) * D + g * 16 + 8 * (kg & 1));
            yoA0 = (f32x4){0.f, 0.f, 0.f, 0.f}; yoA1 = yoA0; yoB0 = yoA0; yoB1 = yoA0;
            S5_BAR();
#pragma unroll 4
            for (int T = -1; T < S5_NT + 3; ++T) {
                const int e = T - 1, d = T + 1;
                const bool e_ok = (e >= 0) && (e < S5_NT) && (WCTX || e >= 8);
                const bool e_second = (e < 8) ? (e >= 4) : (e >= 40);
                if (d >= 0 && d < S5_NT) UL[(d & 3) * 64 + lane] = ub[d & 3];
                if (e_ok) {
#pragma unroll
                    for (int tau = 0; tau < 2; ++tau) {
                        const size_t idx = (size_t)seq_row(b, dir, 32 * e + 2 * tq + tau) * D + g * 16 + 4 * kg;
                        const f32x4 y = YL[((e & 1) * 2 + tau) * 64 + lane];
                        if (!e_second) *(f32x4*)(ypart + idx) = y;
                        else {
                            f32x4 yo = (e & 1) ? (tau ? yoB1 : yoB0) : (tau ? yoA1 : yoA0);
                            if (e == 4 || e == 40) yo = *(const f32x4*)(ypart + idx);
                            const v2u hw = *(const v2u*)(hb + idx);
                            f32x4 v = y + yo; v.x += d4.x * bflo(hw.x); v.y += d4.y * bfhi(hw.x); v.z += d4.z * bflo(hw.y); v.w += d4.w * bfhi(hw.y);
                            v2u zo; zo.x = pk2(gelu_tanh(v.x), gelu_tanh(v.y)); zo.y = pk2(gelu_tanh(v.z), gelu_tanh(v.w));
                            *(v2u*)(zb + idx) = zo;
                        }
                    }
                }
                { const int e1 = e + 1; const bool e1_ok = (e1 >= 0) && (e1 < S5_NT) && (WCTX || e1 >= 8); const bool e1_second = (e1 < 8) ? (e1 >= 4) : (e1 >= 40);
                  if (e1_ok && e1_second && e1 != 4 && e1 != 40) {
                      const f32x4 l0 = *(const f32x4*)(ypart + (size_t)seq_row(b, dir, 32 * e1 + 2 * tq) * D + g * 16 + 4 * kg), l1 = *(const f32x4*)(ypart + (size_t)seq_row(b, dir, 32 * e1 + 2 * tq + 1) * D + g * 16 + 4 * kg);
                      if (e1 & 1) { yoB0 = l0; yoB1 = l1; } else { yoA0 = l0; yoA1 = l1; }
                  } }
                if (d >= 0 && d + 4 < S5_NT) ub[d & 3] = *(const v4u*)(hb + (size_t)seq_row(b, dir, 32 * (d + 4) + 2 * tq + (kg >> 1)) * D + g * 16 + 8 * (kg & 1));
                if (e == 3 || e == 39) asm volatile("s_waitcnt vmcnt(0)" ::: "memory");
                S5_BAR();
            }
        } else {
            const float* cre = F.in[IN_S5CRE] + (size_t)gi * 1024; const float* cim = F.in[IN_S5CIM] + (size_t)gi * 1024;
            bf16x8 wf[8], vkf[2][5];
#pragma unroll
            for (int rt = 0; rt < 8; ++rt) wf[rt] = __builtin_bit_cast(bf16x8, TAB[(iw * 16 + rt) * 64 + lane]);
#pragma unroll
            for (int tau = 0; tau < 2; ++tau)
#pragma unroll
                for (int ks = 0; ks < 4; ++ks) vkf[tau][ks] = __builtin_bit_cast(bf16x8, TAB[(iw * 16 + 8 + tau * 4 + ks) * 64 + lane]);
            const f32x2 a2 = CST[(iw * 3 + 1) * 64 + lane];
            { LAS float* KM = KMS + iw * 512;
              const LAS bf16* W2T = (const LAS bf16*)(TAB + (iw * 16) * 64);
#pragma unroll
              for (int e = 0; e < 2; ++e) {
                  f32x4 acc = (f32x4){0.f, 0.f, 0.f, 0.f};
#pragma unroll
                  for (int ks = 0; ks < 4; ++ks) {
                      bf16x8 cfr, fr;
                      const int p0 = 16 * ks + 4 * kg;
                      const f32x4 cr = *(const f32x4*)(cre + tq * 64 + p0), ci = *(const f32x4*)(cim + tq * 64 + p0);
                      cfr[0] = (short)f2bf(cr.x); cfr[1] = (short)f2bf(-ci.x); cfr[2] = (short)f2bf(cr.y); cfr[3] = (short)f2bf(-ci.y); cfr[4] = (short)f2bf(cr.z); cfr[5] = (short)f2bf(-ci.z); cfr[6] = (short)f2bf(cr.w); cfr[7] = (short)f2bf(-ci.w);
#pragma unroll
                      for (int jj = 0; jj < 8; ++jj) { const int n = 32 * ks + 8 * kg + jj, k = 16 * (1 - e) + tq; fr[jj] = (short)W2T[(((n >> 4) * 64) + (n & 15) + 16 * (k >> 3)) * 8 + (k & 7)]; }
                      acc = __builtin_amdgcn_mfma_f32_16x16x32_bf16(cfr, fr, acc, 0, 0, 0);
                  }
#pragma unroll
                  for (int r = 0; r < 4; ++r) KM[(e * 16 + 4 * kg + r) * 16 + tq] = acc[r];
              }
#pragma unroll
              for (int tau = 0; tau < 2; ++tau) { const int tp = kg >> 1; bf16x8 fr;
#pragma unroll
                  for (int jj = 0; jj < 8; ++jj) { const float v = (tp <= tau) ? KM[((tau - tp) * 16 + tq) * 16 + 8 * (kg & 1) + jj] : 0.f; fr[jj] = (short)f2bf(v); }
                  vkf[tau][4] = fr; } }
            asm volatile("s_waitcnt vmcnt(0) lgkmcnt(0)" ::: "memory");
            f32x2 x = (f32x2){0.f, 0.f};
            const f32x2 a2re = (f32x2){a2.x, a2.x}, a2im = (f32x2){-a2.y, a2.y};
            S5_BAR();
            for (int T = -1; T < S5_NT + 3; ++T) {
                if (T >= 0 && T < S5_NT) {
                    const bf16x8 uf = __builtin_bit_cast(bf16x8, UL[(T & 3) * 64 + lane]);
#pragma unroll
                    for (int rt = 0; rt < 8; ++rt) {
                        const f32x4 dacc = __builtin_amdgcn_mfma_f32_16x16x32_bf16(wf[rt], uf, (f32x4){0.f, 0.f, 0.f, 0.f}, 0, 0, 0);
                        *(LAS f32x4*)(BU + tq * S5_BU_STRIDE + 16 * rt + 4 * kg) = dacc;
                    }
                    f32x2 buv[16]; unsigned xw[16];
#pragma unroll
                    for (int t = 0; t < 16; ++t) buv[t] = *(const LAS f32x2*)(BU + t * S5_BU_STRIDE + 2 * lane);
#pragma unroll
                    for (int t = 0; t < 16; ++t) { xw[t] = pk2(x.x, x.y); const f32x2 xs = (f32x2){x.y, x.x}; x = a2re * x + (a2im * xs + buv[t]); }
                    if (WCTX || T >= 8) {
#pragma unroll
                        for (int t = 0; t < 16; ++t) *(LAS unsigned*)(XS + t * S5_X_STRIDE + 2 * lane) = xw[t];
                        bf16x8 xf[4];
#pragma unroll
                        for (int ks = 0; ks < 4; ++ks) xf[ks] = *(const LAS bf16x8*)(XS + tq * S5_X_STRIDE + 32 * ks + 8 * kg);
#pragma unroll
                        for (int tau = 0; tau < 2; ++tau) {
                            f32x4 y = __builtin_amdgcn_mfma_f32_16x16x32_bf16(vkf[tau][4], uf, (f32x4){0.f, 0.f, 0.f, 0.f}, 0, 0, 0);
#pragma unroll
                            for (int ks = 0; ks < 4; ++ks) y = __builtin_amdgcn_mfma_f32_16x16x32_bf16(vkf[tau][ks], xf[ks], y, 0, 0, 0);
                            YL[((T & 1) * 2 + tau) * 64 + lane] = y;
                        }
                    }
                }
                S5_BAR();
            }
        }
        __syncthreads();
    }
}

constexpr size_t WS_MCT = WS_MHS;
constexpr size_t WS_MN = WS_MG + 2359296;
constexpr size_t WS_MSC = WS_MN + 589824;
static_assert(WS_MSC + 2304 * 16 <= WS_MHS, "mLSTM small tables");
constexpr int ML_TS = 136;
constexpr int ML_DS = 72;

template <bool MAX>
__device__ __forceinline__ void scan128(LAS float* a, int lane) {
    const float v0 = a[2 * lane], v1 = a[2 * lane + 1];
    const float s = MAX ? fmaxf(v0, v1) : v0 + v1;
    float inc = s;
#pragma unroll
    for (int o = 1; o < 64; o <<= 1) { const float t = __shfl_up(inc, o); if (lane >= o) inc = MAX ? fmaxf(inc, t) : inc + t; }
    float exc = __shfl_up(inc, 1); if (lane == 0) exc = MAX ? -INFINITY : 0.f;
    a[2 * lane] = MAX ? fmaxf(exc, v0) : exc + v0; a[2 * lane + 1] = inc;
}

__device__ __forceinline__ void phase_ml_states(Frame& F) {
    const int tid = F.tid, lane = F.lane, w = F.wave, tq = lane & 15, kg = lane >> 4;
    const bf16* kb = (const bf16*)(F.ws + WS_MK); const bf16* vb = (const bf16*)(F.ws + WS_MV); const float* gb = (const float*)(F.ws + WS_MG);
    float* cT = (float*)(F.ws + WS_MCT); float* nl = (float*)(F.ws + WS_MN); float* sc = (float*)(F.ws + WS_MSC);
    LAS bf16* KeT = (LAS bf16*)(F.lds);
    LAS bf16* VT = (LAS bf16*)(F.lds + 64 * ML_TS * 2);
    LAS float* cumS = (LAS float*)(F.lds + 192 * ML_TS * 2);
    LAS float* igS = cumS + 128; LAS float* ewS = igS + 128; LAS float* red = ewS + 128;
    for (int us = F.blk; us < 2304; us += F.G) {
        const int jc = us % 18, bhd = us / 18, dir = bhd & 1, hd = (bhd >> 1) & 7, b = bhd >> 4;
        if (tid < 128) { const int r = seq_row(b, dir, 128 * jc + tid); igS[tid] = gb[(size_t)r * 32 + dir * 16 + hd]; cumS[tid] = log_sigmoidf_(gb[(size_t)r * 32 + dir * 16 + 8 + hd]); }
        __syncthreads();
        if (w == 0) {
            scan128<false>(cumS, lane);
            const float total = __shfl(cumS[2 * lane + 1], 63);
            const float w0 = total - cumS[2 * lane] + igS[2 * lane], w1 = total - cumS[2 * lane + 1] + igS[2 * lane + 1];
            const float ml = wave_max(fmaxf(w0, w1));
            ewS[2 * lane] = __expf(w0 - ml); ewS[2 * lane + 1] = __expf(w1 - ml);
            if (lane == 0) { sc[(size_t)us * 4] = total; sc[(size_t)us * 4 + 1] = ml; }
        }
        __syncthreads();
        { const int i = tid & 127, c = tid >> 7; const int r = seq_row(b, dir, 128 * jc + i); const float e = ewS[i];
#pragma unroll
          for (int h2 = 0; h2 < 2; ++h2) { const v4u kw = *(const v4u*)(kb + (size_t)r * 512 + hd * 64 + 16 * c + 8 * h2);
              const float kv[8] = {bflo(kw.x), bfhi(kw.x), bflo(kw.y), bfhi(kw.y), bflo(kw.z), bfhi(kw.z), bflo(kw.w), bfhi(kw.w)};
#pragma unroll
              for (int jj = 0; jj < 8; ++jj) KeT[(16 * c + 8 * h2 + jj) * ML_TS + i] = (bf16)f2bf(kv[jj] * e); }
#pragma unroll
          for (int h4 = 0; h4 < 4; ++h4) { const v4u vw = *(const v4u*)(vb + (size_t)r * 1024 + hd * 128 + 32 * c + 8 * h4);
              const unsigned vv[4] = {vw.x, vw.y, vw.z, vw.w};
#pragma unroll
              for (int jj = 0; jj < 8; ++jj) VT[(32 * c + 8 * h4 + jj) * ML_TS + i] = (bf16)((jj & 1) ? (vv[jj >> 1] >> 16) : (vv[jj >> 1] & 0xffffu)); } }
        __syncthreads();
#pragma unroll
        for (int dt = 0; dt < 4; ++dt) {
            f32x4 acc = (f32x4){0.f, 0.f, 0.f, 0.f};
#pragma unroll
            for (int ks = 0; ks < 4; ++ks) {
                const bf16x8 af = *(const LAS bf16x8*)(VT + (16 * w + tq) * ML_TS + 32 * ks + 8 * kg);
                const bf16x8 bfr = *(const LAS bf16x8*)(KeT + (16 * dt + tq) * ML_TS + 32 * ks + 8 * kg);
                acc = __builtin_amdgcn_mfma_f32_16x16x32_bf16(af, bfr, acc, 0, 0, 0);
            }
#pragma unroll
            for (int r = 0; r < 4; ++r) cT[(size_t)us * 8192 + (16 * w + 4 * kg + r) * 64 + 16 * dt + tq] = acc[r];
        }
        if (tid < 64) { float s = 0.f;
#pragma unroll
            for (int c8 = 0; c8 < 16; ++c8) { const v4u q = *(const LAS v4u*)(KeT + tid * ML_TS + 8 * c8); s += bflo(q.x) + bfhi(q.x) + bflo(q.y) + bfhi(q.y) + bflo(q.z) + bfhi(q.z) + bflo(q.w) + bfhi(q.w); }
            nl[(size_t)us * 64 + tid] = s; }
        __syncthreads();
    }
}

__device__ __forceinline__ void phase_ml_scan(Frame& F, const int skip = 0) {
    const int tid = F.tid;
    float* cT = (float*)(F.ws + WS_MCT); float* nl = (float*)(F.ws + WS_MN); float* sc = (float*)(F.ws + WS_MSC);
    for (int wi = F.blk; wi < 256; wi += F.G) {
        const int sq = wi >> 1, half = wi & 1; const bool don = (half == 0 && tid < 64);
        const size_t e0 = (size_t)half * 4096 + (size_t)tid * 8;
        f32x4 c0 = (f32x4){0.f, 0.f, 0.f, 0.f}, c1 = c0; float nn = 0.f, m = 0.f;
        size_t us = (size_t)sq * 18;
        f32x4 l0 = *(const f32x4*)(cT + us * 8192 + e0), l1 = *(const f32x4*)(cT + us * 8192 + e0 + 4);
        float ln = don ? nl[us * 64 + tid] : 0.f, tot = sc[us * 4], ml = sc[us * 4 + 1];
        for (int j = 0; j < 18; ++j, ++us) {
            const f32x4 a0 = l0, a1 = l1; const float an = ln, atot = tot, aml = ml;
            if (j + 1 < 18) { l0 = *(const f32x4*)(cT + (us + 1) * 8192 + e0); l1 = *(const f32x4*)(cT + (us + 1) * 8192 + e0 + 4); ln = don ? nl[(us + 1) * 64 + tid] : 0.f; tot = sc[(us + 1) * 4]; ml = sc[(us + 1) * 4 + 1]; }
            if (!skip) { *(f32x4*)(cT + us * 8192 + e0) = c0; *(f32x4*)(cT + us * 8192 + e0 + 4) = c1;
            if (don) nl[us * 64 + tid] = nn;
            if (half == 0 && tid == 0) sc[us * 4 + 2] = m; }
            const float mn = fmaxf(atot + m, aml), fa = __expf(atot + m - mn), fb = __expf(aml - mn);
            c0 = c0 * fa + a0 * fb; c1 = c1 * fa + a1 * fb; nn = nn * fa + an * fb; m = mn;
        }
    }
}

struct M3Regs { float gi, gf, n0v, m00, m01; v4u q[2], k[2], v[4]; };
__device__ __forceinline__ void m3_load(M3Regs& R, Frame& F, int u, int tid) {
    const bf16* kb = (const bf16*)(F.ws + WS_MK); const bf16* vb = (const bf16*)(F.ws + WS_MV); const bf16* qb = (const bf16*)(F.ws + WS_MQ);
    const float* gb = (const float*)(F.ws + WS_MG); const float* cT = (const float*)(F.ws + WS_MCT); const float* nl = (const float*)(F.ws + WS_MN); const float* sc = (const float*)(F.ws + WS_MSC);
    const int jo = u % 18, bh = u / 18, hd = bh & 7, b = bh >> 3;
    const int row0 = (jo < 2) ? b * CTX + 128 * jo : TC + b * SEQ + 128 * (jo - 2);
    const int jc1 = (jo < 2) ? 1 - jo : 19 - jo;
    const size_t us0 = (size_t)((b * 8 + hd) * 2 + 0) * 18 + jo, us1 = (size_t)((b * 8 + hd) * 2 + 1) * 18 + jc1;
    R.m00 = sc[us0 * 4 + 2]; R.m01 = sc[us1 * 4 + 2];
    R.gi = 0.f; R.gf = 0.f; R.n0v = 0.f;
    if (tid < 256) { const int dd = tid >> 7, sp = tid & 127; const int r = row0 + (dd ? 127 - sp : sp); R.gi = gb[(size_t)r * 32 + dd * 16 + hd]; R.gf = gb[(size_t)r * 32 + dd * 16 + 8 + hd]; }
    { const int i = tid & 127, c = tid >> 7; const int r = row0 + i;
#pragma unroll
      for (int h2 = 0; h2 < 2; ++h2) { R.q[h2] = *(const v4u*)(qb + (size_t)r * 512 + hd * 64 + 16 * c + 8 * h2); R.k[h2] = *(const v4u*)(kb + (size_t)r * 512 + hd * 64 + 16 * c + 8 * h2); } }
    { const int tp = tid & 63, c8 = tid >> 6;
#pragma unroll
      for (int tk = 0; tk < 2; ++tk)
#pragma unroll
          for (int h2 = 0; h2 < 2; ++h2) R.v[2 * tk + h2] = *(const v4u*)(vb + (size_t)(row0 + 2 * tp + tk) * 1024 + hd * 128 + 16 * c8 + 8 * h2); }
    if (tid < 128) R.n0v = nl[((tid >> 6) ? us1 : us0) * 64 + (tid & 63)];
}
__device__ __forceinline__ void phase_ml_out(Frame& F) {
    const int tid = F.tid, lane = F.lane, w = F.wave, tq = lane & 15, kg = lane >> 4;
    const bf16* ob = (const bf16*)(F.ws + WS_MO); bf16* zb = (bf16*)(F.ws + WS_Z);
    LAS bf16* QL = (LAS bf16*)(F.lds);
    LAS bf16* KL = (LAS bf16*)(F.lds + 18432);
    LAS bf16* SwL = (LAS bf16*)(F.lds + w * (16 * ML_TS * 2));
    LAS bf16* VT = (LAS bf16*)(F.lds + 36864);
    LAS bf16* C0T = (LAS bf16*)(F.lds + 36864 + 128 * ML_TS * 2);
    LAS float* GT = (LAS float*)(F.lds + 36864 + 128 * ML_TS * 2 + 2 * 144 * ML_DS * 2);
    static_assert(36864 + 128 * ML_TS * 2 + 2 * 144 * ML_DS * 2 + 2 * 3 * 128 * 4 <= RING_BYTES, "M3 LDS");
    for (int i = tid; i < 2 * 16 * ML_DS; i += NTHR) { const int dd = i / (16 * ML_DS), ii = i % (16 * ML_DS); C0T[dd * 144 * ML_DS + 128 * ML_DS + ii] = (bf16)0u; }
    constexpr int NU = NB * 8 * 18;
    M3Regs R;
    if (F.blk < NU) m3_load(R, F, F.blk, tid);
    __syncthreads();
    for (int u = F.blk; u < NU; u += F.G) {
        const int jo = u % 18, bh = u / 18, hd = bh & 7, b = bh >> 3;
        const int row0 = (jo < 2) ? b * CTX + 128 * jo : TC + b * SEQ + 128 * (jo - 2);
        const float m00 = R.m00, m01 = R.m01;
        if (tid < 256) { const int dd = tid >> 7, sp = tid & 127; GT[dd * 384 + sp] = R.gi; GT[dd * 384 + 256 + sp] = log_sigmoidf_(R.gf); }
        { const int i = tid & 127, c = tid >> 7;
#pragma unroll
          for (int h2 = 0; h2 < 2; ++h2) { *(LAS v4u*)(QL + i * ML_DS + 16 * c + 8 * h2) = R.q[h2]; *(LAS v4u*)(KL + i * ML_DS + 16 * c + 8 * h2) = R.k[h2]; } }
        { const int tp = tid & 63, c8 = tid >> 6;
#pragma unroll
          for (int h2 = 0; h2 < 2; ++h2) { const v4u a = R.v[h2], bq = R.v[2 + h2]; const unsigned av[4] = {a.x, a.y, a.z, a.w}, bv[4] = {bq.x, bq.y, bq.z, bq.w};
#pragma unroll
              for (int jj = 0; jj < 8; ++jj) { const unsigned lo = (jj & 1) ? (av[jj >> 1] >> 16) : (av[jj >> 1] & 0xffffu), hi = (jj & 1) ? (bv[jj >> 1] & 0xffff0000u) : (bv[jj >> 1] << 16);
                  *(LAS unsigned*)(VT + (16 * c8 + 8 * h2 + jj) * ML_TS + 2 * tp) = lo | hi; } } }
        { const float* cT = (const float*)(F.ws + WS_MCT); const int jc1 = (jo < 2) ? 1 - jo : 19 - jo;
          const size_t us0 = (size_t)((b * 8 + hd) * 2 + 0) * 18 + jo, us1 = (size_t)((b * 8 + hd) * 2 + 1) * 18 + jc1;
#pragma unroll
          for (int dd = 0; dd < 2; ++dd) { const size_t us = dd ? us1 : us0; const int jv = tid >> 2, dq = (tid & 3) * 16; const float* src = cT + us * 8192 + jv * 64 + dq;
#pragma unroll
              for (int h2 = 0; h2 < 2; ++h2) { const f32x4 a = *(const f32x4*)(src + 8 * h2), bq = *(const f32x4*)(src + 8 * h2 + 4);
                  v4u o; o.x = pk2(a.x, a.y); o.y = pk2(a.z, a.w); o.z = pk2(bq.x, bq.y); o.w = pk2(bq.z, bq.w);
                  *(LAS v4u*)(C0T + dd * 144 * ML_DS + jv * ML_DS + dq + 8 * h2) = o; } } }
        if (tid < 128) C0T[(tid >> 6) * 144 * ML_DS + 128 * ML_DS + (tid & 63)] = (bf16)f2bf(R.n0v);
        __syncthreads();
        if (u + F.G < NU) m3_load(R, F, u + F.G, tid);
        if (w < 2) {
            LAS float* gS = GT + w * 384; LAS float* mmS = gS + 128; LAS float* cumS = gS + 256; const float m0 = w ? m01 : m00;
            scan128<false>(cumS, lane);
            const float g0 = gS[2 * lane] - cumS[2 * lane], g1 = gS[2 * lane + 1] - cumS[2 * lane + 1];
            gS[2 * lane] = g0; gS[2 * lane + 1] = g1; mmS[2 * lane] = g0; mmS[2 * lane + 1] = g1;
            scan128<true>(mmS, lane);
            mmS[2 * lane] = fmaxf(mmS[2 * lane], m0); mmS[2 * lane + 1] = fmaxf(mmS[2 * lane + 1], m0);
        }
        __syncthreads();
        bf16x8 qf[2];
#pragma unroll
        for (int ks = 0; ks < 2; ++ks) qf[ks] = *(const LAS bf16x8*)(QL + (16 * w + tq) * ML_DS + 32 * ks + 8 * kg);
        float mm0r[4], mm1r[4], ai0[4], ai1[4], lb0[4], lb1[4];
#pragma unroll
        for (int r = 0; r < 4; ++r) { const int t0 = 16 * w + 4 * kg + r, t1 = 127 - t0;
            mm0r[r] = GT[128 + t0]; ai0[r] = __expf(m00 - mm0r[r]); lb0[r] = __expf(-GT[256 + t0] - mm0r[r]);
            mm1r[r] = GT[384 + 128 + t1]; ai1[r] = __expf(m01 - mm1r[r]); lb1[r] = __expf(-GT[384 + 256 + t1] - mm1r[r]); }
        f32x4 sraw[8]; float rs0[4] = {0.f, 0.f, 0.f, 0.f}, rs1[4] = {0.f, 0.f, 0.f, 0.f};
#pragma unroll
        for (int ct = 0; ct < 8; ++ct) {
            f32x4 a = (f32x4){0.f, 0.f, 0.f, 0.f};
#pragma unroll
            for (int ks = 0; ks < 2; ++ks) a = __builtin_amdgcn_mfma_f32_16x16x32_bf16(qf[ks], *(const LAS bf16x8*)(KL + (16 * ct + tq) * ML_DS + 32 * ks + 8 * kg), a, 0, 0, 0);
            sraw[ct] = a;
            const int o = 16 * ct + tq; const float g0o = GT[o], g1o = GT[384 + 127 - o];
#pragma unroll
            for (int r = 0; r < 4; ++r) { const int t0 = 16 * w + 4 * kg + r;
                rs0[r] += (o <= t0) ? a[r] * __expf(g0o - mm0r[r]) : 0.f; rs1[r] += (o >= t0) ? a[r] * __expf(g1o - mm1r[r]) : 0.f; }
        }
        f32x4 acc[8]; float sc0[4], sc1[4];
        {
            f32x4 q0 = (f32x4){0.f, 0.f, 0.f, 0.f}, q1 = q0;
#pragma unroll
            for (int ks = 0; ks < 2; ++ks) { q0 = __builtin_amdgcn_mfma_f32_16x16x32_bf16(qf[ks], *(const LAS bf16x8*)(C0T + (128 + tq) * ML_DS + 32 * ks + 8 * kg), q0, 0, 0, 0);
                                             q1 = __builtin_amdgcn_mfma_f32_16x16x32_bf16(qf[ks], *(const LAS bf16x8*)(C0T + 144 * ML_DS + (128 + tq) * ML_DS + 32 * ks + 8 * kg), q1, 0, 0, 0); }
#pragma unroll
            for (int r = 0; r < 4; ++r) {
                const float qn0 = red16_sum(q0[r]), qn1 = red16_sum(q1[r]);
                const float den0 = ai0[r] * qn0 + red16_sum(rs0[r]), den1 = ai1[r] * qn1 + red16_sum(rs1[r]);
                const float inv0 = __builtin_amdgcn_rcpf(fmaxf(fabsf(den0), lb0[r])), inv1 = __builtin_amdgcn_rcpf(fmaxf(fabsf(den1), lb1[r]));
                rs0[r] = inv0; rs1[r] = inv1; sc0[r] = ai0[r] * inv0; sc1[r] = ai1[r] * inv1; }
        }
#pragma unroll
        for (int ct = 0; ct < 8; ++ct) {
            f32x4 a0 = (f32x4){0.f, 0.f, 0.f, 0.f}, a1 = a0;
#pragma unroll
            for (int ks = 0; ks < 2; ++ks) { a0 = __builtin_amdgcn_mfma_f32_16x16x32_bf16(qf[ks], *(const LAS bf16x8*)(C0T + (16 * ct + tq) * ML_DS + 32 * ks + 8 * kg), a0, 0, 0, 0);
                                             a1 = __builtin_amdgcn_mfma_f32_16x16x32_bf16(qf[ks], *(const LAS bf16x8*)(C0T + 144 * ML_DS + (16 * ct + tq) * ML_DS + 32 * ks + 8 * kg), a1, 0, 0, 0); }
#pragma unroll
            for (int r = 0; r < 4; ++r) acc[ct][r] = a0[r] * sc0[r] + a1[r] * sc1[r];
        }
        __syncthreads();
#pragma unroll
        for (int ct = 0; ct < 8; ++ct) { const int o = 16 * ct + tq; const float g0o = GT[o], g1o = GT[384 + 127 - o];
#pragma unroll
            for (int r = 0; r < 4; ++r) { const int t0 = 16 * w + 4 * kg + r;
                const float x0 = (o <= t0) ? __expf(g0o - mm0r[r]) * rs0[r] : 0.f, x1 = (o >= t0) ? __expf(g1o - mm1r[r]) * rs1[r] : 0.f;
                SwL[(4 * kg + r) * ML_TS + 16 * ct + tq] = (bf16)f2bf(sraw[ct][r] * (x0 + x1)); } }
#pragma unroll
        for (int ks = 0; ks < 4; ++ks) {
            const bf16x8 af = *(const LAS bf16x8*)(SwL + tq * ML_TS + 32 * ks + 8 * kg);
#pragma unroll
            for (int ct = 0; ct < 8; ++ct) acc[ct] = __builtin_amdgcn_mfma_f32_16x16x32_bf16(af, *(const LAS bf16x8*)(VT + (16 * ct + tq) * ML_TS + 32 * ks + 8 * kg), acc[ct], 0, 0, 0);
        }
        float ss[4] = {0.f, 0.f, 0.f, 0.f};
#pragma unroll
        for (int ct = 0; ct < 8; ++ct) { ss[0] += acc[ct].x * acc[ct].x; ss[1] += acc[ct].y * acc[ct].y; ss[2] += acc[ct].z * acc[ct].z; ss[3] += acc[ct].w * acc[ct].w; }
#pragma unroll
        for (int r = 0; r < 4; ++r) ss[r] = rsqrtf(red16_sum(ss[r]) * (1.f / 128.f) + EPS);
#pragma unroll
        for (int ct = 0; ct < 8; ++ct) { const float gn = F.in[IN_MLNG][hd * 128 + 16 * ct + tq];
#pragma unroll
            for (int r = 0; r < 4; ++r) SwL[(4 * kg + r) * ML_TS + 16 * ct + tq] = (bf16)f2bf(acc[ct][r] * ss[r] * gn); }
#pragma unroll
        for (int i = 0; i < 4; ++i) { const int rr = 4 * i + kg, ch = tq;
            const v4u hv = *(const LAS v4u*)(SwL + rr * ML_TS + 8 * ch);
            const size_t idx = (size_t)(row0 + 16 * w + rr) * D + hd * 128 + 8 * ch;
            const v4u ov = *(const v4u*)(ob + idx);
            v4u zo; zo.x = pk2(bflo(hv.x) * sigmoidf_(bflo(ov.x)), bfhi(hv.x) * sigmoidf_(bfhi(ov.x))); zo.y = pk2(bflo(hv.y) * sigmoidf_(bflo(ov.y)), bfhi(hv.y) * sigmoidf_(bfhi(ov.y)));
            zo.z = pk2(bflo(hv.z) * sigmoidf_(bflo(ov.z)), bfhi(hv.z) * sigmoidf_(bfhi(ov.z))); zo.w = pk2(bflo(hv.w) * sigmoidf_(bflo(ov.w)), bfhi(hv.w) * sigmoidf_(bfhi(ov.w)));
            *(v4u*)(zb + idx) = zo; }
        __syncthreads();
    }
}

#ifndef USE_NAIVE_ATTN
#define USE_NAIVE_ATTN 0
#endif
#ifndef USE_NAIVE_S5
#define USE_NAIVE_S5 0
#endif
#ifndef USE_NAIVE_MLSTM
#define USE_NAIVE_MLSTM 0
#endif
#ifndef MK_MODE
#define MK_MODE 0
#endif
struct Args { const float* in[N_INPUTS]; float* out; unsigned char* ws; int ph_lo, ph_hi; };
enum { CBASE = __COUNTER__ + 1 };
#ifndef S5VAR
#define S5VAR 0
#endif
#ifndef DUP_A
#define DUP_A -1
#endif
#ifndef DUP_B
#define DUP_B -1
#endif
#define PHASE_IDS() { int t_ = threadIdx.x; asm volatile("" : "+v"(t_)); F.tid = t_; F.lane = t_ & 63; F.wave = __builtin_amdgcn_readfirstlane(t_ >> 6); }
#ifndef SW_PHASE
#define SW_PHASE -1
#endif
#define PHASE(...) { constexpr int k_ = __COUNTER__ - CBASE; if (lo <= k_ && k_ < hi) { PHASE_IDS() unsigned long long swt_ = 0; if (k_ == SW_PHASE) swt_ = __builtin_amdgcn_s_memtime(); \
    { constexpr int rep_ = 0; (void)rep_; __VA_ARGS__ } \
    if constexpr (k_ == DUP_A || k_ == DUP_B) { xcd_barrier(bar); { constexpr int rep_ = 1; (void)rep_; __VA_ARGS__ } } \
    if (k_ + 1 < hi) xcd_barrier(bar); \
    if (k_ == SW_PHASE && F.blk == 0 && threadIdx.x == 0) F.ctl[64] = (unsigned)((__builtin_amdgcn_s_memtime() - swt_) >> 4); } }

__global__ void __launch_bounds__(NTHR, 2) fwd_kernel(Args args) {
    extern __shared__ __attribute__((aligned(16))) unsigned char lds[];
    Frame F;
    F.lds = (LAS unsigned char*)lds;
    F.MISC = (volatile LAS unsigned*)(F.lds + MISC_OFF);
    F.tid = threadIdx.x; F.lane = F.tid & 63; F.wave = __builtin_amdgcn_readfirstlane(F.tid >> 6);
    F.G = gridDim.x; F.blk = blockIdx.x;
    F.ws = args.ws; F.out = args.out; F.ctl = (unsigned*)(args.ws + WS_CTL);
#pragma unroll
    for (int i = 0; i < N_INPUTS; ++i) F.in[i] = args.in[i];
    for (int u = F.tid; u < (LDS_BYTES - LDSCTL_OFF) / 4; u += NTHR) ((LAS unsigned*)(F.lds + LDSCTL_OFF))[u] = 0u;
    __syncthreads();
    const int lo = args.ph_lo, hi = args.ph_hi;
    XcdBarrier bar; bar.bar = F.ctl + CW_BAR; bar.x = 0; bar.st = nullptr;
    if (hi - lo > 1) bar = xcd_barrier_post(F.ctl + CW_BAR, F.MISC + 8);

    unsigned char* ws = F.ws;
    bf16* xres = (bf16*)(ws + WS_XRES); const float* mod = (const float*)(ws + WS_MOD);
    bf16* hb = (bf16*)(ws + WS_H); bf16* zb = (bf16*)(ws + WS_Z);
    const LAS int* etab = (const LAS int*)(F.lds + ETAB_OFF);

#define MOE_PHASES(L) \
    PHASE(phase_n2<L>(F, rep_);) \
    PHASE(phase_sc<L>(F);) \
    PHASE({ load_etab(F); pg8::Gemm g{(const bf16*)(ws + WS_H), (const bf16*)(ws + WS_WG1) + (size_t)(L) * NEXP * 1024 * 1024, SLOTS, NEXP * 1024, 1024, (const int*)(ws + WS_SLOTR)}; \
               MoeSched S{etab, F.G, F.blk, 4}; EpiG1 E{(bf16*)(ws + WS_HID)}; run_gemm_gather(F, g, S, E); }) \
    PHASE({ load_etab(F); pg8::Gemm g{(const bf16*)(ws + WS_HID), (const bf16*)(ws + WS_WG2) + (size_t)(L) * NEXP * 1024 * 512, SLOTS, NEXP * 1024, 512}; \
               MoeSched S{etab, F.G, F.blk, 4}; EpiG2 E{(bf16*)(ws + WS_Y2), (const float*)(ws + WS_SLOTW)}; run_gemm(F, g, S, E); })

    PHASE(phase_prologue(F);)
    PHASE(phase_a1<0>(F, rep_);)
#if USE_NAIVE_S5
    PHASE(phase_s5_naive<0, true>(F);)
    PHASE(phase_s5_combine<0, true>(F);)
#else
    PHASE(phase_s5_fast<0, true>(F);)
#endif
    PHASE({ pg8::Gemm g{zb, (const bf16*)(ws + WS_WGLU), T, 2048, 1024}; DenseSched S; S.init(T, 2048, F.G, F.blk, 0);
               EpiGlu E{xres, mod + 0 * 9 * 6144 + 2048, F.in[IN_S5BGLU], rep_}; run_gemm(F, g, S, E); })
    MOE_PHASES(0)
    PHASE(phase_a1<1>(F, rep_);)
    PHASE({ pg8::Gemm g{hb, (const bf16*)(ws + WS_WKVQ), T, 1536, 1024}; DenseSched S; S.init(T, 1536, F.G, F.blk, 0);
               EpiKvq E{(bf16*)(ws + WS_QB), (bf16*)(ws + WS_KB), (bf16*)(ws + WS_VB), F.in[IN_AQG], F.in[IN_AKG], (const float*)(ws + WS_ROPE)}; run_gemm(F, g, S, E); })
#if USE_NAIVE_ATTN
    PHASE(phase_attn_naive<true>(F);)
#else
    PHASE(phase_attn_fast<true>(F, (char*)lds);)
#endif
    PHASE({ pg8::Gemm g{zb, (const bf16*)(ws + WS_WO), T, 1024, 1024}; DenseSched S; S.init(T, 1024, F.G, F.blk, 0);
               EpiRes E{xres, mod + 1 * 9 * 6144 + 2048, rep_, (bf16*)(ws + WS_MIX)}; run_gemm(F, g, S, E); })
    MOE_PHASES(1)
    PHASE(phase_a1<2>(F, rep_);)
    PHASE({ pg8::Gemm g{hb, (const bf16*)(ws + WS_WIN), T, ML_NIN, 1024}; DenseSched S; S.init(T, ML_NIN, F.G, F.blk, 0);
               EpiMlIn E{(bf16*)(ws + WS_MK), (bf16*)(ws + WS_MV), (bf16*)(ws + WS_MQ), (bf16*)(ws + WS_MO), (float*)(ws + WS_MG), F.in[IN_MLBG]}; run_gemm(F, g, S, E); })
#if USE_NAIVE_MLSTM
    PHASE(phase_mlstm_naive<true>(F);)
    PHASE(phase_mlstm_combine<true>(F);)
#else
    PHASE(phase_ml_states(F);)
    PHASE(phase_ml_scan(F, rep_);)
    PHASE(phase_ml_out(F);)
#endif
    PHASE({ pg8::Gemm g{zb, (const bf16*)(ws + WS_WOUT), T, 1024, 1024}; DenseSched S; S.init(T, 1024, F.G, F.blk, 0);
               EpiRes E{xres, mod + 2 * 9 * 6144 + 2048, rep_, (bf16*)(ws + WS_MHS)}; run_gemm(F, g, S, E); })
    MOE_PHASES(2)
    PHASE(phase_a1<3>(F, rep_);)
#if USE_NAIVE_S5
    PHASE(phase_s5_naive<1, false>(F);)
    PHASE(phase_s5_combine<1, false>(F);)
#else
    PHASE(phase_s5_fast<1, false>(F);)
#endif
    PHASE({ pg8::Gemm g{zb, (const bf16*)(ws + WS_WGLU) + (size_t)2048 * 1024, T, 2048, 1024}; DenseSched S; S.init(TL, 2048, F.G, F.blk, TC / 256);
               EpiGlu E{xres, mod + 3 * 9 * 6144 + 2048, F.in[IN_S5BGLU] + 2048, rep_}; run_gemm(F, g, S, E); })
    MOE_PHASES(3)
    PHASE(phase_fin(F);)
#if SW_PHASE >= 0
    if (F.blk == 0 && threadIdx.x == 0) { const unsigned v = __hip_atomic_load(F.ctl + 64, __ATOMIC_RELAXED, __HIP_MEMORY_SCOPE_AGENT); const unsigned long long t0 = __builtin_amdgcn_s_memtime();
        while (__builtin_amdgcn_s_memtime() - t0 < (unsigned long long)v * 16ull * 16ull) __builtin_amdgcn_s_sleep(8); }
#endif
}
constexpr int NPH = __COUNTER__ - CBASE;

extern "C" void kernel_launch(void* const* d_in, const int* in_sizes, int n_in, void* d_out, int out_size, void* d_ws, size_t ws_size, hipStream_t stream) {
    static int grid = 0;
    if (grid == 0) {
        if (n_in != N_INPUTS || out_size != TL * D || ws_size < WS_END) { fprintf(stderr, "kernel_launch: unexpected problem: n_in %d out %d ws %zu (need %zu)\n", n_in, out_size, ws_size, (size_t)WS_END); grid = -1; return; }
        int dev = 0, cus = 0, per_cu = 0;
        if (hipGetDevice(&dev) != hipSuccess || hipDeviceGetAttribute(&cus, hipDeviceAttributeMultiprocessorCount, dev) != hipSuccess) { grid = -1; return; }
        if (hipFuncSetAttribute((const void*)fwd_kernel, hipFuncAttributeMaxDynamicSharedMemorySize, LDS_BYTES) != hipSuccess) { fprintf(stderr, "kernel_launch: hipFuncSetAttribute failed\n"); grid = -1; return; }
        if (hipOccupancyMaxActiveBlocksPerMultiprocessor(&per_cu, (const void*)fwd_kernel, NTHR, LDS_BYTES) != hipSuccess || per_cu < 1) fprintf(stderr, "kernel_launch: occupancy query reports %d\n", per_cu);
        (void)hipGetLastError();
        grid = cus;
        if (grid > 256) grid = 256;
    }
    if (grid < 0) return;
    if (hipMemsetAsync((char*)d_ws + WS_CTL, 0, CTL_ZERO_BYTES, stream) != hipSuccess) return;
    Args a{};
    for (int i = 0; i < N_INPUTS; ++i) a.in[i] = (const float*)d_in[i];
    a.out = (float*)d_out; a.ws = (unsigned char*)d_ws;
#if MK_MODE == 0
    a.ph_lo = 0; a.ph_hi = NPH;
    hipLaunchKernelGGL(fwd_kernel, dim3(grid), dim3(NTHR), LDS_BYTES, stream, a);
#else
    for (int p = 0; p < NPH; ++p) { a.ph_lo = p; a.ph_hi = p + 1; hipLaunchKernelGGL(fwd_kernel, dim3(grid), dim3(NTHR), LDS_BYTES, stream, a); }
#endif
}
```

```cpp
#include <hip/hip_runtime.h>
#include <cstdio>
#include <cstdint>

#define GAS __attribute__((address_space(1)))
#define LAS __attribute__((address_space(3)))
typedef unsigned short bf16;
typedef unsigned v4u __attribute__((ext_vector_type(4)));
typedef unsigned v2u __attribute__((ext_vector_type(2)));
typedef float f32x4 __attribute__((ext_vector_type(4)));
typedef float f32x2 __attribute__((ext_vector_type(2)));
typedef short bf16x8 __attribute__((ext_vector_type(8)));

constexpr int D = 1024, NB = 8, SEQ = 2048, CTX = 256, DEPTH = 4;
constexpr int TC = NB * CTX;
constexpr int TL = NB * SEQ;
constexpr int T = TC + TL;
constexpr int KVLEN = SEQ + CTX;
constexpr int NEXP = 16, DFF = 512;
constexpr int SLOTS = 40960;
constexpr int ML_NIN = 3328;
constexpr float EPS = 1e-6f;
constexpr int NWAVES = 8, NTHR = 512;
constexpr float ATT_C2 = 0.125f * 1.4426950408889634f;

constexpr size_t MiB = 1u << 20;
constexpr size_t WS_CTL = 0, CTL_ZERO_BYTES = 1 * MiB;
constexpr size_t WS_MOD = 1 * MiB;
constexpr size_t WS_ROPE = 2 * MiB;
constexpr size_t WS_TOKE = 2 * MiB + 65536;
constexpr size_t WS_TOKR = WS_TOKE + 163840;
constexpr size_t WS_TOKW = WS_TOKR + 163840;
constexpr size_t WS_TOKS = WS_TOKW + 163840;
constexpr size_t WS_BCNT = WS_TOKS + 163840;
constexpr size_t WS_ETAB = WS_BCNT + 16384;
constexpr size_t WS_SLOTW = WS_ETAB + 4096;
constexpr size_t WS_SLOTR = WS_SLOTW + 163840;
static_assert(WS_SLOTR + SLOTS * 4 <= 4 * MiB, "small tables");
constexpr size_t WS_WGLU = 4 * MiB;
constexpr size_t WS_WKVQ = WS_WGLU + 8 * MiB;
constexpr size_t WS_WO = WS_WKVQ + 3 * MiB;
constexpr size_t WS_WIN = WS_WO + 2 * MiB;
constexpr size_t WS_WOUT = WS_WIN + 7 * MiB;
constexpr size_t WS_WG1 = WS_WOUT + 2 * MiB;
constexpr size_t WS_WG2 = WS_WG1 + 128 * MiB;
constexpr size_t WS_XRES = WS_WG2 + 64 * MiB;
constexpr size_t WS_H = WS_XRES + 72 * MiB;
constexpr size_t WS_Z = WS_H + 36 * MiB;
constexpr size_t WS_MIX = WS_Z + 36 * MiB;
constexpr size_t WS_HS = WS_MIX;
constexpr size_t WS_HID = WS_HS + 80 * MiB;
constexpr size_t WS_Y2 = WS_HID + 40 * MiB;
constexpr size_t WS_END = WS_Y2 + 80 * MiB;
constexpr size_t WS_YSUM = WS_MIX;
constexpr size_t WS_QB = WS_MIX;
constexpr size_t WS_KB = WS_QB + 36 * MiB;
constexpr size_t WS_VB = WS_KB + 9 * MiB;
constexpr size_t WS_MK = WS_MIX;
constexpr size_t WS_MV = WS_MK + 18 * MiB;
constexpr size_t WS_MQ = WS_MV + 36 * MiB;
constexpr size_t WS_MO = WS_MQ + 18 * MiB;
constexpr size_t WS_MG = WS_MO + 36 * MiB;
constexpr size_t WS_MHS = WS_MG + 3 * MiB;
static_assert(WS_MHS + 72 * MiB <= WS_END, "mLSTM view fits");
static_assert(WS_END <= 600 * MiB, "workspace budget");

constexpr int CW_BAR = 4096;

constexpr int RING_OFF = 0, RING_BYTES = 131072;
constexpr int LDSCTL_OFF = RING_BYTES, MISC_OFF = LDSCTL_OFF + 320;
constexpr int ETAB_OFF = MISC_OFF + 128;
constexpr int SCT_OFF = ETAB_OFF + 128;
constexpr int LDS_BYTES = 147456;
static_assert(SCT_OFF + 256 <= LDS_BYTES, "LDS map");

#define LDS_WAIT() asm volatile("s_waitcnt lgkmcnt(0)" ::: "memory")
#define VM_WAIT() asm volatile("s_waitcnt vmcnt(0)" ::: "memory")
__device__ __forceinline__ unsigned f2bf(float f) { unsigned u = __builtin_bit_cast(unsigned, f); return (u + 0x7fffu + ((u >> 16) & 1u)) >> 16; }
typedef float f32x2_cv __attribute__((ext_vector_type(2))); typedef __bf16 bf16x2_cv __attribute__((ext_vector_type(2)));
__device__ __forceinline__ unsigned pk2(float lo, float hi) { f32x2_cv v = {lo, hi}; bf16x2_cv b = __builtin_convertvector(v, bf16x2_cv); return __builtin_bit_cast(unsigned, b); }
__device__ __forceinline__ float bf2f(unsigned h) { return __builtin_bit_cast(float, h << 16); }
__device__ __forceinline__ float bflo(unsigned w) { return __builtin_bit_cast(float, w << 16); }
__device__ __forceinline__ float bfhi(unsigned w) { return __builtin_bit_cast(float, w & 0xffff0000u); }
template <int CTRL, int RMASK = 0xF>
__device__ __forceinline__ float dpp_f(float oldv, float v) { return __builtin_bit_cast(float, __builtin_amdgcn_update_dpp(__builtin_bit_cast(int, oldv), __builtin_bit_cast(int, v), CTRL, RMASK, 0xF, false)); }
#ifndef USE_SHFL_XOR
#define USE_SHFL_XOR 0
#endif
#ifndef USE_SHFL_PARTIAL
#define USE_SHFL_PARTIAL 0
#endif
__device__ __forceinline__ float red16_sum(float v) {
#if USE_SHFL_PARTIAL
    for (int o = 1; o < 16; o <<= 1) v += __shfl_xor(v, o);
    return v;
#endif
    v += dpp_f<0xB1>(0.f, v); v += dpp_f<0x4E>(0.f, v); v += dpp_f<0x141>(0.f, v); v += dpp_f<0x140>(0.f, v); return v; }
__device__ __forceinline__ float red16_max(float v) {
    v = fmaxf(v, dpp_f<0xB1>(v, v)); v = fmaxf(v, dpp_f<0x4E>(v, v)); v = fmaxf(v, dpp_f<0x141>(v, v)); v = fmaxf(v, dpp_f<0x140>(v, v)); return v; }
#ifndef USE_SHFL_REDUCE
#define USE_SHFL_REDUCE 0
#endif
__device__ __forceinline__ float wave_sum(float v) {
#if USE_SHFL_REDUCE
    for (int o = 1; o < 64; o <<= 1) v += __shfl_xor(v, o);
    return v;
#endif
    v = red16_sum(v); v += dpp_f<0x142, 0xA>(0.f, v); v += dpp_f<0x143, 0xC>(0.f, v);
    return __builtin_bit_cast(float, __builtin_amdgcn_readlane(__builtin_bit_cast(int, v), 63)); }
__device__ __forceinline__ float wave_max(float v) {
    v = red16_max(v); v = fmaxf(v, dpp_f<0x142, 0xA>(v, v)); v = fmaxf(v, dpp_f<0x143, 0xC>(v, v));
    return __builtin_bit_cast(float, __builtin_amdgcn_readlane(__builtin_bit_cast(int, v), 63)); }
__device__ __forceinline__ float xor16_sum(float v) { return v + __shfl_xor(v, 16); }
__device__ __forceinline__ float xor32_sum(float v) { return v + __shfl_xor(v, 32); }
__device__ __forceinline__ float sigmoidf_(float x) { return __builtin_amdgcn_rcpf(1.f + __expf(-x)); }
__device__ __forceinline__ float siluf_(float x) { return x * __builtin_amdgcn_rcpf(1.f + __expf(-x)); }
__device__ __forceinline__ float gelu_tanh(float x) {
    const float p = __builtin_fmaf(x * x, 0.044715f, 1.0f);
    const float e = __builtin_amdgcn_exp2f((x * -2.302208198f) * p);
    return x * __builtin_amdgcn_rcpf(1.0f + e);
}
__device__ __forceinline__ float log_sigmoidf_(float x) { return fminf(x, 0.f) - __logf(1.f + __expf(-fabsf(x))); }
__device__ __forceinline__ void sincos_d(double a, double& s, double& c) {
    const double k = __builtin_rint(a * 0.63661977236758134308);
    double r = __builtin_fma(-k, 1.57079632679489655800e+00, a);
    r = __builtin_fma(-k, 6.12323399573676603587e-17, r);
    const double r2 = r * r;
    double sp = -1.0 / 1307674368000.0;
    sp = sp * r2 + 1.0 / 6227020800.0; sp = sp * r2 - 1.0 / 39916800.0; sp = sp * r2 + 1.0 / 362880.0; sp = sp * r2 - 1.0 / 5040.0; sp = sp * r2 + 1.0 / 120.0; sp = sp * r2 - 1.0 / 6.0;
    const double sr = r + r * r2 * sp;
    double cp = 1.0 / 20922789888000.0;
    cp = cp * r2 - 1.0 / 87178291200.0; cp = cp * r2 + 1.0 / 479001600.0; cp = cp * r2 - 1.0 / 3628800.0; cp = cp * r2 + 1.0 / 40320.0; cp = cp * r2 - 1.0 / 720.0; cp = cp * r2 + 1.0 / 24.0; cp = cp * r2 - 0.5;
    const double cr = 1.0 + r2 * cp;
    const int q = ((int)k) & 3;
    s = (q == 0) ? sr : (q == 1) ? cr : (q == 2) ? -sr : -cr;
    c = (q == 0) ? cr : (q == 1) ? -sr : (q == 2) ? -cr : sr;
}
__device__ __forceinline__ int mrow_of(int r) { return r < TC ? 8 : ((r - TC) >> 11); }
namespace pg8 {
#define PG8_LAS __attribute__((address_space(3)))
typedef unsigned short bf16_t;
typedef short bf16x8 __attribute__((ext_vector_type(8)));
typedef float f32x4 __attribute__((ext_vector_type(4)));
typedef unsigned u32x4 __attribute__((ext_vector_type(4)));
constexpr int BM = 256, BK = 64, HALF = 128, HTB = HALF * BK * 2  , STAGE_BYTES = 8 * HTB, NXCD = 8, WGM = 8;

__host__ __device__ __forceinline__ int lds_byte(int r, int c) { const int st = (r >> 4) * 2 + (c >> 5), rr = r & 15, cc = c & 31, ob = rr * 64 + cc * 2; return st * 1024 + (ob ^ (((ob >> 9) & 1) << 5)); }
__host__ __device__ __forceinline__ void stage_rc(int b, int& R, int& C) { const int st = b / 1024, sb = b % 1024, swz = sb ^ (((sb >> 9) & 1) << 5); R = (st >> 1) * 16 + swz / 64; C = (st & 1) * 32 + (swz % 64) / 2; }
__host__ __device__ __forceinline__ int perm32(int rho) { const int n = rho >> 4, i = rho & 15; return 8 * (i >> 2) + 4 * n + (i & 3); }

struct Unit { int pm, pn, half; };
__device__ __forceinline__ int row0(const Unit& u) { return u.pm * 256 + ((u.half >> 1) << 7); }
struct Gemm { const bf16_t* A; const bf16_t* Bt; int M, N, K; const int* rowmap; };

struct StaticOrder {
    int nM, nN, nwg, G, c;
    __host__ __device__ void init(int M, int N, int G_, int c_) { nM = M / BM; nN = N / BM; nwg = nM * nN; G = G_; c = c_; }
    __host__ __device__ bool next(int i, Unit& u) const {
        const long L = (long)i * G + c; if (L >= nwg) return false;
        int wgid = (int)L; { const int q = nwg / NXCD, r = nwg % NXCD, xcd = wgid % NXCD, off = wgid / NXCD; wgid = (xcd < r ? xcd * (q + 1) : r * (q + 1) + (xcd - r) * q) + off; }
        const int nig = WGM * nN, gid = wgid / nig, fm = gid * WGM, gsz = (nM - fm) < WGM ? (nM - fm) : WGM;
        u.pm = fm + ((wgid % nig) % gsz); u.pn = (wgid % nig) / gsz; u.half = 0; return true;
    }
    __device__ __forceinline__ void a_ready(const Unit&) const {}
    __device__ __forceinline__ void done(const Unit&) const {}
};


template <class Epi, class Sched, bool ALIGN_EPI = false, bool SP2 = false, bool GATHER = false>
__device__ __forceinline__ void gemm_phase(PG8_LAS unsigned char* lds, const Gemm g, const Sched& S, const Epi& E) {
    const int tid = threadIdx.x, wid = __builtin_amdgcn_readfirstlane(tid >> 6), lane = tid & 63, wr = wid >> 2, wc = wid & 3, fr = lane & 15, fq = lane >> 4;
    const int K = g.K, nt = K / BK;
    unsigned voffA[2], voffB[2];
#pragma unroll
    for (int i = 0; i < 2; ++i) { int R, C; stage_rc(tid * 16 + i * 8192, R, C); const int Rb = Epi::PERM ? ((R & ~31) + perm32(R & 31)) : R;
        voffA[i] = (unsigned)(R * K + C) * 2u; voffB[i] = (unsigned)(Rb * K + C) * 2u; }
    static_assert(!GATHER || SP2, "gather path is written for the SP2 loop");
    unsigned oc[2][2], rn[2][2], cbA[2]; int Rg[2];
    if constexpr (GATHER) {
#pragma unroll
        for (int i = 0; i < 2; ++i) { int R, C; stage_rc(tid * 16 + i * 8192, R, C); Rg[i] = R; cbA[i] = (unsigned)C * 2u; } }
    const char* gA = (const char*)g.A;
    const size_t kstep = (size_t)(BK * 2);
    const size_t hstep = (size_t)HALF * K * 2;
    const size_t tstep = 2 * hstep;
    const unsigned ldsw = (unsigned)wid * 1024u;
    const int aoff = lds_byte(wr * 64 + fr, fq * 8), boff = lds_byte(wc * 32 + fr, fq * 8);
#define PG8_SA(b, h) (((b) * 2 + (h)) * HTB)
#define PG8_SB(b, h) ((4 + (b) * 2 + (h)) * HTB)
#define PG8_STAGE(bufoff, gbase, voff) do { _Pragma("unroll") for (int _i = 0; _i < 2; ++_i) \
        __builtin_amdgcn_global_load_lds((const unsigned*)((const char*)(gbase) + (voff)[_i]), (PG8_LAS unsigned*)(lds + (bufoff) + ldsw + _i * 8192), 16, 0, 0); } while (0)
#define PG8_STA(b, h, base_ng, base_g, OFF) do { if constexpr (GATHER) PG8_STAGE(PG8_SA(b, h), base_g, OFF[h]); else PG8_STAGE(PG8_SA(b, h), (base_ng) + (h) * hstep, voffA); } while (0)
#define PG8_LDA(dst, b, h) do { _Pragma("unroll") for (int m = 0; m < 4; ++m) _Pragma("unroll") for (int k = 0; k < 2; ++k) dst[m][k] = *(const PG8_LAS bf16x8*)(lds + PG8_SA(b, h) + aoff + m * 2048 + k * 1024); } while (0)
#define PG8_LDB(dst, b, h) do { _Pragma("unroll") for (int n = 0; n < 2; ++n) _Pragma("unroll") for (int k = 0; k < 2; ++k) dst[n][k] = *(const PG8_LAS bf16x8*)(lds + PG8_SB(b, h) + boff + n * 2048 + k * 1024); } while (0)
#define PG8_MMA(ai, bj, At, Bt) do { __builtin_amdgcn_s_setprio(1); _Pragma("unroll") for (int m = 0; m < 4; ++m) _Pragma("unroll") for (int n = 0; n < 2; ++n) _Pragma("unroll") for (int k = 0; k < 2; ++k) \
        acc[ai][bj][m][n] = __builtin_amdgcn_mfma_f32_16x16x32_bf16(Bt[n][k], At[m][k], acc[ai][bj][m][n], 0, 0, 0); __builtin_amdgcn_s_setprio(0); } while (0)
#define PG8_WAIT_V(n) asm volatile("s_waitcnt vmcnt(" #n ")" ::: "memory")
#define PG8_WAIT_L(n) asm volatile("s_waitcnt lgkmcnt(" #n ")" ::: "memory")
#define PG8_BAR __builtin_amdgcn_s_barrier()
#define PG8_SCHED __builtin_amdgcn_sched_barrier(0)
    Unit cur, nxt; int ui = 0;
    if (!S.next(0, cur)) return;
    f32x4 acc[2][2][4][2];
#pragma unroll
    for (int a = 0; a < 2; ++a)
#pragma unroll
        for (int b = 0; b < 2; ++b)
#pragma unroll
            for (int m = 0; m < 4; ++m)
#pragma unroll
                for (int n = 0; n < 2; ++n) acc[a][b][m][n] = (f32x4){0.f, 0.f, 0.f, 0.f};
    bf16x8 At[4][2], B0[2][2], B1[2][2];
    const char* cA = (const char*)g.A + (size_t)cur.pm * tstep + (cur.half == 2 ? hstep : (size_t)0); const char* cB = (const char*)g.Bt + (size_t)cur.pn * tstep;
    bool hf = cur.half != 0;
    S.a_ready(cur);
    if constexpr (GATHER) {
#pragma unroll
        for (int h = 0; h < 2; ++h)
#pragma unroll
            for (int i = 0; i < 2; ++i) oc[h][i] = (unsigned)g.rowmap[cur.pm * 256 + (cur.half == 2 ? 128 : h * 128) + Rg[i]] * (unsigned)(K * 2) + cbA[i]; }
    if constexpr (SP2) {
        PG8_STAGE(PG8_SB(0, 0), cB, voffB); PG8_STAGE(PG8_SB(0, 1), cB + hstep, voffB); PG8_STA(0, 0, cA, gA, oc); PG8_STA(0, 1, cA, gA, oc);
        if (wr == 1) PG8_BAR;
        PG8_WAIT_V(2); PG8_BAR;
        PG8_STAGE(PG8_SB(1, 0), cB + kstep, voffB); PG8_STA(1, 0, cA + kstep, gA + kstep, oc); PG8_STAGE(PG8_SB(1, 1), cB + hstep + kstep, voffB);
        PG8_WAIT_V(6); PG8_BAR;
    } else {
        PG8_STAGE(PG8_SB(0, 0), cB, voffB); PG8_STAGE(PG8_SA(0, 0), cA, voffA); PG8_STAGE(PG8_SB(0, 1), cB + hstep, voffB); PG8_STAGE(PG8_SA(0, 1), cA + hstep, voffA);
        if (wr == 1) PG8_BAR;
        PG8_WAIT_V(4); PG8_BAR;
        PG8_STAGE(PG8_SB(1, 0), cB + kstep, voffB); PG8_STAGE(PG8_SA(1, 0), cA + kstep, voffA); PG8_STAGE(PG8_SB(1, 1), cB + hstep + kstep, voffB);
        PG8_WAIT_V(6); PG8_BAR;
    }
    for (;;) {
        const bool has_next = S.next(ui + 1, nxt);
        if constexpr (GATHER) { if (has_next) {
#pragma unroll
            for (int h = 0; h < 2; ++h)
#pragma unroll
                for (int i = 0; i < 2; ++i) rn[h][i] = (unsigned)g.rowmap[nxt.pm * 256 + (nxt.half == 2 ? 128 : h * 128) + Rg[i]]; } }
        const char* nA = has_next ? (const char*)g.A + (size_t)nxt.pm * tstep + (nxt.half == 2 ? hstep : (size_t)0) : cA; const char* nB = has_next ? (const char*)g.Bt + (size_t)nxt.pn * tstep : cB;
        for (int t = 0; t < nt; t += 2) {
            const bool last = (t == nt - 2);
            const char* a1 = cA + (size_t)(t + 1) * kstep;
            const char* a2 = last ? nA : cA + (size_t)(t + 2) * kstep; const char* b2 = last ? nB : cB + (size_t)(t + 2) * kstep;
            const char* a3 = a2 + kstep; const char* b3 = b2 + kstep;
            if (last && has_next) S.a_ready(nxt);
            unsigned o2[2][2]; const char* a1g = gA + (size_t)(t + 1) * kstep; const char* a2g = gA + (last ? (size_t)0 : (size_t)(t + 2) * kstep); const char* a3g = a2g + kstep;
            if constexpr (GATHER) {
                if (last && has_next) {
#pragma unroll
                    for (int h = 0; h < 2; ++h)
#pragma unroll
                        for (int i = 0; i < 2; ++i) { unsigned v = rn[h][i]; asm volatile("" : "+v"(v)); o2[h][i] = v * (unsigned)(K * 2) + cbA[i]; } }
                else {
#pragma unroll
                    for (int h = 0; h < 2; ++h)
#pragma unroll
                        for (int i = 0; i < 2; ++i) o2[h][i] = oc[h][i]; }
            }
            if constexpr (SP2) {
            PG8_LDB(B0, 0, 0); PG8_LDB(B1, 0, 1); PG8_SCHED; PG8_LDA(At, 0, 0); PG8_STA(1, 1, a1, a1g, oc);
            PG8_WAIT_V(8); PG8_WAIT_L(0); PG8_BAR; PG8_MMA(0, 0, At, B0); PG8_MMA(0, 1, At, B1); PG8_BAR; PG8_SCHED;
            if (!hf) PG8_LDA(At, 0, 1); PG8_STAGE(PG8_SB(0, 0), b2, voffB); PG8_STAGE(PG8_SB(0, 1), b2 + hstep, voffB); PG8_STA(0, 0, a2, a2g, o2);
            PG8_WAIT_V(8); PG8_WAIT_L(0); PG8_BAR; if (!hf) { PG8_MMA(1, 0, At, B0); PG8_MMA(1, 1, At, B1); } PG8_BAR; PG8_SCHED;
            PG8_LDB(B0, 1, 0); PG8_LDB(B1, 1, 1); PG8_SCHED; PG8_LDA(At, 1, 0); PG8_STA(0, 1, a2, a2g, o2);
            PG8_WAIT_V(8); PG8_WAIT_L(0); PG8_BAR; PG8_MMA(0, 0, At, B0); PG8_MMA(0, 1, At, B1); PG8_BAR; PG8_SCHED;
            if (!hf) PG8_LDA(At, 1, 1); PG8_STAGE(PG8_SB(1, 0), b3, voffB); PG8_STAGE(PG8_SB(1, 1), b3 + hstep, voffB); PG8_STA(1, 0, a3, a3g, o2);
            PG8_WAIT_V(8); PG8_WAIT_L(0); PG8_BAR; if (!hf) { PG8_MMA(1, 0, At, B0); PG8_MMA(1, 1, At, B1); } PG8_BAR; PG8_SCHED;
            } else {
            PG8_LDB(B0, 0, 0); PG8_SCHED; PG8_LDA(At, 0, 0); PG8_STAGE(PG8_SA(1, 1), a1 + hstep, voffA);
            PG8_WAIT_L(8); PG8_BAR; PG8_WAIT_L(0); PG8_MMA(0, 0, At, B0); PG8_BAR; PG8_SCHED;
            PG8_LDB(B1, 0, 1); PG8_STAGE(PG8_SB(0, 0), b2, voffB);
            PG8_BAR; PG8_WAIT_L(0); PG8_MMA(0, 1, At, B1); PG8_BAR;
            PG8_LDA(At, 0, 1); PG8_STAGE(PG8_SA(0, 0), a2, voffA);
            PG8_BAR; PG8_WAIT_L(0); PG8_MMA(1, 0, At, B0); PG8_BAR; PG8_SCHED;
            PG8_STAGE(PG8_SB(0, 1), b2 + hstep, voffB);
            PG8_WAIT_V(6); PG8_BAR; PG8_MMA(1, 1, At, B1); PG8_BAR;
            PG8_LDB(B0, 1, 0); PG8_SCHED; PG8_LDA(At, 1, 0); PG8_STAGE(PG8_SA(0, 1), a2 + hstep, voffA);
            PG8_WAIT_L(8); PG8_BAR; PG8_WAIT_L(0); PG8_MMA(0, 0, At, B0); PG8_BAR; PG8_SCHED;
            PG8_LDB(B1, 1, 1); PG8_STAGE(PG8_SB(1, 0), b3, voffB);
            PG8_BAR; PG8_WAIT_L(0); PG8_MMA(0, 1, At, B1); PG8_BAR;
            PG8_LDA(At, 1, 1); PG8_STAGE(PG8_SA(1, 0), a3, voffA);
            PG8_BAR; PG8_WAIT_L(0); PG8_MMA(1, 0, At, B0); PG8_BAR; PG8_SCHED;
            PG8_STAGE(PG8_SB(1, 1), b3 + hstep, voffB);
            PG8_WAIT_V(6); PG8_BAR; PG8_MMA(1, 1, At, B1); PG8_BAR;
            }
        }
        if constexpr (ALIGN_EPI) { if (wr == 0) PG8_BAR; }
        if constexpr (!Epi::AFTER_DRAIN) { E(acc, cur, wr, wc, fr, fq); S.done(cur); }
        if (!has_next) break;
#pragma unroll
        for (int a = 0; a < 2; ++a)
#pragma unroll
            for (int b = 0; b < 2; ++b)
#pragma unroll
                for (int m = 0; m < 4; ++m)
#pragma unroll
                    for (int n = 0; n < 2; ++n) acc[a][b][m][n] = (f32x4){0.f, 0.f, 0.f, 0.f};
        cur = nxt; cA = nA; cB = nB; ++ui; hf = cur.half != 0;
        if constexpr (GATHER) {
#pragma unroll
            for (int h = 0; h < 2; ++h)
#pragma unroll
                for (int i = 0; i < 2; ++i) oc[h][i] = rn[h][i] * (unsigned)(K * 2) + cbA[i]; }
        if constexpr (ALIGN_EPI) { if (wr == 1) PG8_BAR; }
    }
    PG8_WAIT_V(0);
    if constexpr (!ALIGN_EPI) { if (wr == 0) PG8_BAR; }
    PG8_BAR;
    if constexpr (Epi::AFTER_DRAIN) { E.fused(acc, cur, wr, wc, fr, fq, lds, wid, lane); S.done(cur); }
#undef PG8_SA
#undef PG8_SB
#undef PG8_STAGE
#undef PG8_STA
#undef PG8_LDA
#undef PG8_LDB
#undef PG8_MMA
#undef PG8_WAIT_V
#undef PG8_WAIT_L
#undef PG8_BAR
#undef PG8_SCHED
}
}
#define XB_TMO      128
#define XB_XCNT(j)  (256  + 64 * (j))
#define XB_XSUB(j)  (1280 + 64 * (j))
#define XB_XGEN(j)  (2304 + 64 * (j))
#define XB_TOP      3328
#define XB_TOPGEN   3392
#define XCD_BAR_WORDS 3456
#define XB_SPIN_CAP (1u << 22)

__device__ __forceinline__ unsigned xb_ld(unsigned* p)              { return __hip_atomic_load(p, __ATOMIC_RELAXED, __HIP_MEMORY_SCOPE_AGENT); }
__device__ __forceinline__ unsigned xb_add(unsigned* p, unsigned v) { return __hip_atomic_fetch_add(p, v, __ATOMIC_RELAXED, __HIP_MEMORY_SCOPE_AGENT); }
__device__ __forceinline__ unsigned xb_xcc_id() { return (unsigned)__builtin_amdgcn_s_getreg((3 << 11) | 20) & 0xFu; }
#define XB_SPIN(cond, bar) do { unsigned _sp = 0; while (cond) { __builtin_amdgcn_s_sleep(1); \
    if ((++_sp & 255u) == 0u) { if (xb_ld(&(bar)[XB_TMO])) break; if (_sp > XB_SPIN_CAP) { atomicAdd(&(bar)[XB_TMO], 1u); break; } } } } while (0)

struct XcdBarrier {
    unsigned* bar; unsigned x;
    volatile LAS unsigned* st;
};

__device__ __forceinline__ XcdBarrier xcd_barrier_post(unsigned* bar, volatile LAS unsigned* st) {
    XcdBarrier b; b.bar = bar; b.x = xb_xcc_id(); b.st = st;
    if (threadIdx.x == 0) (void)xb_add(&bar[XB_XCNT(b.x)], 1u);
    return b;
}
__device__ __forceinline__ void xcd_barrier_complete(unsigned* bar, unsigned x, unsigned& nloc, unsigned& nx) {
    const unsigned G = gridDim.x * gridDim.y * gridDim.z;
    unsigned sum, cnt, mine, sp = 0u;
    for (;;) {
        sum = 0u; cnt = 0u; mine = 0u;
#pragma unroll
        for (unsigned j = 0; j < 16; ++j) { const unsigned c = xb_ld(&bar[XB_XCNT(j)]); sum += c; cnt += (c > 0u) ? 1u : 0u; mine = (j == x) ? c : mine; }
        if (sum == G) break;
        __builtin_amdgcn_s_sleep(1);
        if ((++sp & 255u) == 0u) { if (xb_ld(&bar[XB_TMO])) break; if (sp > XB_SPIN_CAP) { atomicAdd(&bar[XB_TMO], 1u); break; } }
    }
    nloc = mine > 0u ? mine : 1u; nx = cnt > 0u ? cnt : 1u;
}

__device__ __forceinline__ void xcd_barrier(const XcdBarrier& b) {
    asm volatile("s_waitcnt vmcnt(0)" ::: "memory");
    __syncthreads();
    if (threadIdx.x == 0) {
        unsigned* bar = b.bar;
        __builtin_amdgcn_s_waitcnt(0);
        unsigned nloc = b.st[0], nx = b.st[1];
        if (nloc == 0u) { xcd_barrier_complete(bar, b.x, nloc, nx); b.st[0] = nloc; b.st[1] = nx; }
        const unsigned old = xb_add(&bar[XB_XSUB(b.x)], 1u);
        const unsigned gen = old / nloc;
        if (old + 1u == (gen + 1u) * nloc) {
            __builtin_amdgcn_fence(__ATOMIC_RELEASE, "agent");
            asm volatile("s_waitcnt vmcnt(0)" ::: "memory");
            const unsigned og = xb_add(&bar[XB_TOP], 1u);
            const unsigned tg = og / nx;
            if (og + 1u == (tg + 1u) * nx) xb_add(&bar[XB_TOPGEN], 1u);
            else XB_SPIN(xb_ld(&bar[XB_TOPGEN]) == tg, bar);
            __builtin_amdgcn_fence(__ATOMIC_ACQUIRE, "agent");
            xb_add(&bar[XB_XGEN(b.x)], 1u);
            asm volatile("s_waitcnt vmcnt(0)" ::: "memory");
        } else {
            XB_SPIN(xb_ld(&bar[XB_XGEN(b.x)]) == gen, bar);
            __builtin_amdgcn_fence(__ATOMIC_ACQUIRE, "agent");
            asm volatile("s_waitcnt vmcnt(0)" ::: "memory");
        }
    }
    __syncthreads();
}

enum { IN_X = 0, IN_C, IN_CTX, IN_CCTX, IN_ADAW, IN_ADAB, IN_N1G, IN_N2G, IN_FING, IN_S5LRE, IN_S5LIM, IN_S5LOG, IN_S5BRE, IN_S5BIM, IN_S5CRE, IN_S5CIM,
       IN_S5D, IN_S5WGLU, IN_S5BGLU, IN_AWKVQ, IN_AQG, IN_AKG, IN_AWO, IN_MLWIN, IN_MLBG, IN_MLNG, IN_MLWOUT, IN_RW, IN_RB, IN_MWG, IN_MWU, IN_MWD, N_INPUTS };

struct Frame {
    LAS unsigned char* lds;
    volatile LAS unsigned* MISC;
    unsigned* ctl;
    int tid, lane, wave, G, blk;
    const float* in[N_INPUTS];
    unsigned char* ws;
    float* out;
};

template <bool HV = false>
struct DenseSchedT {
    pg8::StaticOrder so; int pm0;
    __device__ __forceinline__ void init(int Mrows, int N, int G, int c, int pm0_) { so.init(Mrows, N, G, c); pm0 = pm0_; }
    __device__ __forceinline__ bool next(int i, pg8::Unit& u) const {
        const int G = so.G, rounds = (so.nwg + G - 1) / G, R = so.nwg - G * (rounds - 1);
        if (HV && i == rounds - 1 && 2 * R <= G && (G & 15) == 0) {
            const int c = so.c, idx = ((c >> 4) << 3) | (c & 7); if (idx >= R) return false;
            pg8::StaticOrder t = so; t.c = idx; if (!t.next(i, u)) return false; u.pm += pm0; u.half = 1 + ((c >> 3) & 1); return true; }
        if (!so.next(i, u)) return false; u.pm += pm0; return true; }
    __device__ __forceinline__ void a_ready(const pg8::Unit&) const {}
    __device__ __forceinline__ void done(const pg8::Unit&) const {}
};
typedef DenseSchedT<false> DenseSched;
typedef DenseSchedT<true> DenseSchedH;
struct MoeSched {
    const LAS int* tab; int G, c, npn;
    __device__ __forceinline__ bool next(int i, pg8::Unit& u) const {
        const int total = tab[16] * npn;
        int L;
        int hsel = 0;
        if ((G & 7) == 0) { const int x = c & 7, rank = c >> 3, per = G >> 3; const int q = total >> 3, rem = total & 7; const int start = x * q + (x < rem ? x : rem), cnt = q + (x < rem ? 1 : 0);
            const int nfr = cnt / per, R = cnt - nfr * per;
            if (i < nfr) L = start + rank + per * i;
            else if (i > nfr || R == 0) return false;
            else if (2 * R <= per) { if (rank >= 2 * R) return false; L = start + nfr * per + (rank >> 1); hsel = 1 + (rank & 1); }
            else { if (rank >= R) return false; L = start + nfr * per + rank; } }
        else { L = i * G + c; if (L >= total) return false; }
        int e = 0;
#pragma unroll
        for (int k = 1; k < 16; ++k) e += (L >= tab[k] * npn) ? 1 : 0;
        const int ts = tab[e], te = tab[e + 1] - ts, idx = L - ts * npn;
        u.pm = __builtin_amdgcn_readfirstlane(ts + idx % te); u.pn = __builtin_amdgcn_readfirstlane(e * npn + idx / te); u.half = __builtin_amdgcn_readfirstlane(hsel); return true;
    }
    __device__ __forceinline__ void a_ready(const pg8::Unit&) const {}
    __device__ __forceinline__ void done(const pg8::Unit&) const {}
};

template <class Epi, class Sched>
__device__ __forceinline__ void gemm_phase_naive(const pg8::Gemm g, const Sched& S, const Epi& E) {
    const int tid = threadIdx.x, wid = tid >> 6, lane = tid & 63, wr = wid >> 2, wc = wid & 3, fr = lane & 15, fq = lane >> 4;
    const int K = g.K; pg8::Unit u;
    for (int i = 0; S.next(i, u); ++i) {
        f32x4 acc[2][2][4][2];
#pragma unroll
        for (int ai = 0; ai < 2; ++ai)
#pragma unroll
            for (int m = 0; m < 4; ++m) {
                const int row = pg8::row0(u) + ai * 128 + wr * 64 + m * 16 + fr;
                const bf16* ap = g.A + (size_t)row * K;
                float s[2][2][4];
#pragma unroll
                for (int bj = 0; bj < 2; ++bj)
#pragma unroll
                    for (int n = 0; n < 2; ++n)
#pragma unroll
                        for (int e = 0; e < 4; ++e) s[bj][n][e] = 0.f;
                for (int k = 0; k < K; k += 8) {
                    const v4u av = *(const v4u*)(ap + k);
                    const float a0 = bflo(av.x), a1 = bfhi(av.x), a2 = bflo(av.y), a3 = bfhi(av.y), a4 = bflo(av.z), a5 = bfhi(av.z), a6 = bflo(av.w), a7 = bfhi(av.w);
#pragma unroll
                    for (int bj = 0; bj < 2; ++bj)
#pragma unroll
                        for (int n = 0; n < 2; ++n)
#pragma unroll
                            for (int e = 0; e < 4; ++e) {
                                const int col = u.pn * 256 + bj * 128 + wc * 32 + n * 16 + fq * 4 + e;
                                const v4u bv = *(const v4u*)(g.Bt + (size_t)col * K + k);
                                float t = s[bj][n][e];
                                t += a0 * bflo(bv.x); t += a1 * bfhi(bv.x); t += a2 * bflo(bv.y); t += a3 * bfhi(bv.y);
                                t += a4 * bflo(bv.z); t += a5 * bfhi(bv.z); t += a6 * bflo(bv.w); t += a7 * bfhi(bv.w);
                                s[bj][n][e] = t;
                            }
                }
#pragma unroll
                for (int bj = 0; bj < 2; ++bj)
#pragma unroll
                    for (int n = 0; n < 2; ++n) acc[ai][bj][m][n] = (f32x4){s[bj][n][0], s[bj][n][1], s[bj][n][2], s[bj][n][3]};
            }
        E(acc, u, wr, wc, fr, fq);
    }
}
#ifndef USE_NAIVE_GEMM
#define USE_NAIVE_GEMM 0
#endif
template <class Epi, class Sched>
__device__ __forceinline__ void run_gemm(Frame& F, const pg8::Gemm g, const Sched& S, const Epi& E) {
#if USE_NAIVE_GEMM
    gemm_phase_naive<Epi, Sched>(g, S, E);
#else
    pg8::gemm_phase<Epi, Sched, true, true>(F.lds + RING_OFF, g, S, E);
#endif
}
template <class Epi, class Sched>
__device__ __forceinline__ void run_gemm_gather(Frame& F, const pg8::Gemm g, const Sched& S, const Epi& E) {
    pg8::gemm_phase<Epi, Sched, true, true, true>(F.lds + RING_OFF, g, S, E);
}

__device__ __forceinline__ void st_bf4(bf16* p, f32x4 v) { v2u w; w.x = pk2(v.x, v.y); w.y = pk2(v.z, v.w); *(v2u*)p = w; }

struct EpiRes {
    static constexpr bool PERM = true, AFTER_DRAIN = false;
    bf16* xres; const float* __restrict__ modg; int skip; bf16* dummy;
    __device__ __forceinline__ void operator()(const f32x4 (&acc)[2][2][4][2], const pg8::Unit& u, int wr, int wc, int fr, int fq) const {
        const int cbase = u.pn * 256 + wc * 32 + fq * 8;
#pragma unroll
        for (int am = 0; am < 4; ++am) { const int ai = am >> 1, m0 = (am & 1) * 2; if (ai == 1 && u.half) break;
            v4u x[4][2]; f32x4 g0[4][2], g1[4][2];
#pragma unroll
            for (int m = m0; m < m0 + 2; ++m) { const int r = pg8::row0(u) + ai * 128 + wr * 64 + m * 16 + fr; const float* gp = modg + mrow_of(r) * 6144; const bf16* xp = xres + (size_t)r * D;
#pragma unroll
                for (int bj = 0; bj < 2; ++bj) { const int c = cbase + bj * 128; g0[m][bj] = *(const f32x4*)(gp + c); g1[m][bj] = *(const f32x4*)(gp + c + 4); x[m][bj] = *(const v4u*)(xp + c); } }
            asm volatile("" ::: "memory");
#pragma unroll
            for (int m = m0; m < m0 + 2; ++m) { const int r = pg8::row0(u) + ai * 128 + wr * 64 + m * 16 + fr; bf16* xp = (skip ? dummy : xres) + (size_t)r * D;
#pragma unroll
                for (int bj = 0; bj < 2; ++bj) { const int c = cbase + bj * 128; const v4u xv = x[m][bj]; const f32x4 a = g0[m][bj] * acc[ai][bj][m][0], b = g1[m][bj] * acc[ai][bj][m][1];
                    v4u o; o.x = pk2(bflo(xv.x) + a.x, bfhi(xv.x) + a.y); o.y = pk2(bflo(xv.y) + a.z, bfhi(xv.y) + a.w); o.z = pk2(bflo(xv.z) + b.x, bfhi(xv.z) + b.y); o.w = pk2(bflo(xv.w) + b.z, bfhi(xv.w) + b.w);
                    *(v4u*)(xp + c) = o; } }
        }
    }
};
struct EpiGlu {
    static constexpr bool PERM = true, AFTER_DRAIN = false;
    bf16* xres; const float* __restrict__ modg; const float* __restrict__ bglu; int skip;
    __device__ __forceinline__ void operator()(const f32x4 (&acc)[2][2][4][2], const pg8::Unit& u, int wr, int wc, int fr, int fq) const {
        const int oc = u.pn * 128 + wc * 32 + fq * 8;
        const f32x4 ba0 = *(const f32x4*)(bglu + oc), ba1 = *(const f32x4*)(bglu + oc + 4), bg0 = *(const f32x4*)(bglu + 1024 + oc), bg1 = *(const f32x4*)(bglu + 1024 + oc + 4);
#pragma unroll
        for (int ai = 0; ai < 2; ++ai) { if (ai == 1 && u.half) break;
            v4u x[4]; f32x4 g0[4], g1[4];
#pragma unroll
            for (int m = 0; m < 4; ++m) { const int r = pg8::row0(u) + ai * 128 + wr * 64 + m * 16 + fr; const float* gp = modg + mrow_of(r) * 6144;
                g0[m] = *(const f32x4*)(gp + oc); g1[m] = *(const f32x4*)(gp + oc + 4); x[m] = *(const v4u*)(xres + (size_t)r * D + oc); }
            asm volatile("" ::: "memory");
#pragma unroll
            for (int m = 0; m < 4; ++m) { const int r = pg8::row0(u) + ai * 128 + wr * 64 + m * 16 + fr;
                const f32x4 a0 = acc[ai][0][m][0] + ba0, a1 = acc[ai][0][m][1] + ba1, q0 = acc[ai][1][m][0] + bg0, q1 = acc[ai][1][m][1] + bg1;
                f32x4 v0, v1; v0.x = a0.x * sigmoidf_(q0.x); v0.y = a0.y * sigmoidf_(q0.y); v0.z = a0.z * sigmoidf_(q0.z); v0.w = a0.w * sigmoidf_(q0.w);
                v1.x = a1.x * sigmoidf_(q1.x); v1.y = a1.y * sigmoidf_(q1.y); v1.z = a1.z * sigmoidf_(q1.z); v1.w = a1.w * sigmoidf_(q1.w);
                v0 = v0 * g0[m]; v1 = v1 * g1[m]; const v4u xv = x[m];
                v4u o; o.x = pk2(bflo(xv.x) + v0.x, bfhi(xv.x) + v0.y); o.y = pk2(bflo(xv.y) + v0.z, bfhi(xv.y) + v0.w); o.z = pk2(bflo(xv.z) + v1.x, bfhi(xv.z) + v1.y); o.w = pk2(bflo(xv.w) + v1.z, bfhi(xv.w) + v1.w);
                if (!skip) *(v4u*)(xres + (size_t)r * D + oc) = o; }
        }
    }
};
__device__ __forceinline__ int kvrow_of(int r) { if (r < TC) return (r >> 8) * KVLEN + SEQ + (r & 255); const int rr = r - TC; return (rr >> 11) * KVLEN + (rr & 2047); }
struct EpiKvq {
    static constexpr bool PERM = false, AFTER_DRAIN = false;
    bf16* qb; bf16* kb; bf16* vb; const float* __restrict__ qg; const float* __restrict__ kg; const float* __restrict__ rope;
    __device__ __forceinline__ void operator()(const f32x4 (&acc)[2][2][4][2], const pg8::Unit& u, int wr, int wc, int fr, int fq) const {
        const int pn = u.pn;
        const float* gptr = (pn == 0) ? kg : qg;
        f32x4 gn[2][2];
#pragma unroll
        for (int bj = 0; bj < 2; ++bj)
#pragma unroll
            for (int n = 0; n < 2; ++n) gn[bj][n] = *(const f32x4*)(gptr + 32 * bj + 16 * n + 4 * fq);
#pragma unroll
        for (int ai = 0; ai < 2; ++ai)
#pragma unroll
            for (int m = 0; m < 4; ++m) { if (ai == 1 && u.half) break;
                const int r = pg8::row0(u) + ai * 128 + wr * 64 + m * 16 + fr;
                f32x4 x[2][2];
#pragma unroll
                for (int bj = 0; bj < 2; ++bj)
#pragma unroll
                    for (int n = 0; n < 2; ++n) x[bj][n] = acc[ai][bj][m][n];
                if (pn != 1) {
                    float ss = 0.f;
#pragma unroll
                    for (int bj = 0; bj < 2; ++bj)
#pragma unroll
                        for (int n = 0; n < 2; ++n) { const f32x4 v = x[bj][n]; ss += v.x * v.x + v.y * v.y + v.z * v.z + v.w * v.w; }
                    ss = xor16_sum(ss); ss = xor32_sum(ss);
                    const float rs = rsqrtf(ss * (1.f / 64.f) + EPS);
#pragma unroll
                    for (int bj = 0; bj < 2; ++bj)
#pragma unroll
                        for (int n = 0; n < 2; ++n) x[bj][n] = x[bj][n] * rs * gn[bj][n];
                    if (r >= TC) {
                        const int t = (r - TC) & 2047;
#pragma unroll
                        for (int bj = 0; bj < 2; ++bj) {
                            const int pos = bj == 0 ? (t >> 6) : (t & 63);
                            const f32x4 cs = *(const f32x4*)(rope + pos * 16 + 4 * fq), sn = *(const f32x4*)(rope + 1024 + pos * 16 + 4 * fq);
                            const f32x4 x1 = x[bj][0], x2 = x[bj][1];
                            x[bj][0] = x1 * cs - x2 * sn; x[bj][1] = x2 * cs + x1 * sn;
                        }
                    }
                }
                bf16* dst;
                if (pn == 0) dst = kb + (size_t)kvrow_of(r) * 256 + wc * 64;
                else if (pn == 1) dst = vb + (size_t)kvrow_of(r) * 256 + wc * 64;
                else { dst = qb + (size_t)r * D + ((pn - 2) * 4 + wc) * 64;
#pragma unroll
                    for (int bj = 0; bj < 2; ++bj)
#pragma unroll
                        for (int n = 0; n < 2; ++n) x[bj][n] = x[bj][n] * ATT_C2; }
#pragma unroll
                for (int bj = 0; bj < 2; ++bj)
#pragma unroll
                    for (int n = 0; n < 2; ++n) st_bf4(dst + 32 * bj + 16 * n + 4 * fq, x[bj][n]);
            }
    }
};
struct EpiMlIn {
    static constexpr bool PERM = true, AFTER_DRAIN = false;
    bf16 *k, *v, *q, *o; float* g; const float* bgate;
    __device__ __forceinline__ void operator()(const f32x4 (&acc)[2][2][4][2], const pg8::Unit& u, int wr, int wc, int fr, int fq) const {
        const int pn = u.pn;
#pragma unroll
        for (int ai = 0; ai < 2; ++ai)
#pragma unroll
            for (int m = 0; m < 4; ++m) { if (ai == 1 && u.half) break;
                const int r = pg8::row0(u) + ai * 128 + wr * 64 + m * 16 + fr;
#pragma unroll
                for (int bj = 0; bj < 2; ++bj) {
                    const int cc = bj * 128 + wc * 32 + fq * 8;
                    f32x4 a = acc[ai][bj][m][0], b = acc[ai][bj][m][1];
                    if (pn == 12) { if (cc < 32) { *(f32x4*)(g + (size_t)r * 32 + cc) = a + *(const f32x4*)(bgate + cc); *(f32x4*)(g + (size_t)r * 32 + cc + 4) = b + *(const f32x4*)(bgate + cc + 4); } continue; }
                    if (pn < 2) { a = a * 0.125f; b = b * 0.125f; }
                    v4u ov; ov.x = pk2(a.x, a.y); ov.y = pk2(a.z, a.w); ov.z = pk2(b.x, b.y); ov.w = pk2(b.z, b.w);
                    bf16* dst = (pn < 2) ? k + (size_t)r * 512 + pn * 256 + cc : (pn < 6) ? v + (size_t)r * 1024 + (pn - 2) * 256 + cc : (pn < 8) ? q + (size_t)r * 512 + (pn - 6) * 256 + cc : o + (size_t)r * 1024 + (pn - 8) * 256 + cc;
                    *(v4u*)dst = ov;
                }
            }
    }
};
struct EpiG1 {
    static constexpr bool PERM = false, AFTER_DRAIN = false;
    bf16* hid;
    __device__ __forceinline__ void operator()(const f32x4 (&acc)[2][2][4][2], const pg8::Unit& u, int wr, int wc, int fr, int fq) const {
        const int pnl = u.pn & 3;
#pragma unroll
        for (int ai = 0; ai < 2; ++ai)
#pragma unroll
            for (int m = 0; m < 4; ++m) { if (ai == 1 && u.half) break;
                const int r = pg8::row0(u) + ai * 128 + wr * 64 + m * 16 + fr;
#pragma unroll
                for (int bj = 0; bj < 2; ++bj) {
                    const int hc = pnl * 128 + bj * 64 + wc * 16 + fq * 4;
                    const f32x4 ga = acc[ai][bj][m][0], up = acc[ai][bj][m][1];
                    f32x4 h; h.x = siluf_(ga.x) * up.x; h.y = siluf_(ga.y) * up.y; h.z = siluf_(ga.z) * up.z; h.w = siluf_(ga.w) * up.w;
                    st_bf4(hid + (size_t)r * DFF + hc, h);
                }
            }
    }
};
struct EpiG2 {
    static constexpr bool PERM = true, AFTER_DRAIN = false;
    bf16* y2; const float* __restrict__ slotw;
    __device__ __forceinline__ void operator()(const f32x4 (&acc)[2][2][4][2], const pg8::Unit& u, int wr, int wc, int fr, int fq) const {
        const int pnl = u.pn & 3;
#pragma unroll
        for (int ai = 0; ai < 2; ++ai)
#pragma unroll
            for (int m = 0; m < 4; ++m) { if (ai == 1 && u.half) break;
                const int r = pg8::row0(u) + ai * 128 + wr * 64 + m * 16 + fr;
                const float w = slotw[r];
#pragma unroll
                for (int bj = 0; bj < 2; ++bj) {
                    const int c = pnl * 256 + bj * 128 + wc * 32 + fq * 8;
                    const f32x4 a = acc[ai][bj][m][0] * w, b = acc[ai][bj][m][1] * w;
                    v4u o; o.x = pk2(a.x, a.y); o.y = pk2(a.z, a.w); o.z = pk2(b.x, b.y); o.w = pk2(b.z, b.w);
                    *(v4u*)(y2 + (size_t)r * D + c) = o;
                }
            }
    }
};

struct CmNat { const float* W; int ld; __device__ __forceinline__ const float* col(int j) const { return W + j; } };
struct CmGlu { const float* W; int ld;
    __device__ __forceinline__ const float* col(int j) const { const int pn = j >> 8, gpart = (j >> 7) & 1, c = j & 127; return W + gpart * 1024 + 128 * pn + c; } };
struct CmKvq { const float* W; int ld;
    __device__ __forceinline__ const float* col(int j) const { const int pn = j >> 8, bj = (j >> 7) & 1, wc = (j >> 5) & 3, n = (j >> 4) & 1, q = j & 15; return W + 256 * pn + 64 * wc + 32 * bj + 16 * n + q; } };
struct CmMlIn { const float* W; int ld;
    __device__ __forceinline__ const float* col(int j) const {
        if (j < 1536) return W + j;
        if (j < 2048) return W + 1568 + (j - 1536);
        if (j < 3072) return W + 2080 + (j - 2048);
        if (j < 3104) return W + 1536 + (j - 3072);
        return nullptr; } };
struct CmG1 { const float* Wg; const float* Wu; int ld;
    __device__ __forceinline__ const float* col(int j) const { const int le = j >> 10, jj = j & 1023; const int pn = jj >> 8, bj = (jj >> 7) & 1, wc = (jj >> 5) & 3, n = (jj >> 4) & 1, q = jj & 15;
        const uintptr_t a = (uintptr_t)Wg, b = (uintptr_t)Wu, msk = (uintptr_t)0 - (uintptr_t)n;
        return (const float*)((a & ~msk) | (b & msk)) + (size_t)le * 1024 * 512 + 128 * pn + 64 * bj + 16 * wc + q; } };
struct CmG2 { const float* Wd; int ld;
    __device__ __forceinline__ const float* col(int j) const { const int le = j >> 10, jj = j & 1023; return Wd + (size_t)le * 512 * 1024 + jj; } };

template <class CM>
__device__ __forceinline__ void transpose_item(const CM& cm, int K, bf16* WT, int kb, int nb, LAS float* scr, int lane) {
    const int k0 = 64 * kb, n0 = 32 * nb;
    const int nq = (lane & 7) * 4;
    const float* cp = cm.col(n0 + nq);
    const size_t ld = (size_t)cm.ld;
    f32x4 v[8];
#pragma unroll
    for (int i = 0; i < 8; ++i) { const int kk = 8 * i + (lane >> 3); v[i] = cp ? *(const f32x4*)(cp + (size_t)(k0 + kk) * ld) : (f32x4){0.f, 0.f, 0.f, 0.f}; }
#pragma unroll
    for (int i = 0; i < 8; ++i) { const int kk = 8 * i + (lane >> 3); LAS float* d = scr + kk * 33 + nq; d[0] = v[i].x; d[1] = v[i].y; d[2] = v[i].z; d[3] = v[i].w; }
    LDS_WAIT(); asm volatile("" ::: "memory");
    const int c = lane & 7;
#pragma unroll
    for (int j = 0; j < 4; ++j) { const int n = (lane >> 3) + 8 * j; const LAS float* s = scr + (8 * c) * 33 + n;
        v4u o; o.x = pk2(s[0 * 33], s[1 * 33]); o.y = pk2(s[2 * 33], s[3 * 33]); o.z = pk2(s[4 * 33], s[5 * 33]); o.w = pk2(s[6 * 33], s[7 * 33]);
        *(v4u*)(WT + (size_t)(n0 + n) * K + k0 + 8 * c) = o; }
    LDS_WAIT(); asm volatile("" ::: "memory");
}
template <class CM>
__device__ __forceinline__ void transpose_all(Frame& F, const CM& cm, int K, int Ndest, bf16* WT, int rot) {
    LAS float* scr = (LAS float*)(F.lds + RING_OFF + F.wave * 16384);
    const int NGW = F.G * NWAVES, gw = (F.blk * NWAVES + F.wave + rot) % NGW;
    const int nblk = Ndest / 32, items = (K / 64) * nblk;
    for (int it = gw; it < items; it += NGW) transpose_item(cm, K, WT, it / nblk, it % nblk, scr, F.lane);
}

__device__ __forceinline__ void phase_prologue(Frame& F) {
    {
        LAS float* cond = (LAS float*)(F.lds);
        LAS float* red = (LAS float*)(F.lds + 40960);
        for (int i = F.tid; i < 9 * 1024; i += NTHR) { const int mb = i >> 10, k = i & 1023; const float v = (mb < 8) ? F.in[IN_C][mb * 1024 + k] : F.in[IN_CCTX][k]; cond[i] = siluf_(v); }
        __syncthreads();
        float* mod = (float*)(F.ws + WS_MOD);
        for (int it = F.blk; it < DEPTH * 48; it += F.G) {
            const int l = it / 48, n0 = (it % 48) * 128;
            const float* w = F.in[IN_ADAW] + (size_t)l * 1024 * 6144 + n0 + 2 * F.lane;
            f32x2 a[9];
#pragma unroll
            for (int mb = 0; mb < 9; ++mb) a[mb] = (f32x2){0.f, 0.f};
            const int kb = F.wave * 128;
            for (int k8 = 0; k8 < 128; k8 += 8) {
                f32x2 wv[8];
#pragma unroll
                for (int u = 0; u < 8; ++u) wv[u] = *(const f32x2*)(w + (size_t)(kb + k8 + u) * 6144);
#pragma unroll
                for (int u = 0; u < 8; ++u)
#pragma unroll
                    for (int mb = 0; mb < 9; ++mb) a[mb] += wv[u] * cond[mb * 1024 + kb + k8 + u];
            }
#pragma unroll
            for (int mb = 0; mb < 9; ++mb) *(LAS f32x2*)(red + (F.wave * 9 + mb) * 128 + 2 * F.lane) = a[mb];
            __syncthreads();
            for (int i = F.tid; i < 9 * 128; i += NTHR) { const int mb = i >> 7, ln = i & 127; float s = F.in[IN_ADAB][l * 6144 + n0 + ln];
#pragma unroll
                for (int wv = 0; wv < 8; ++wv) s += red[(wv * 9 + mb) * 128 + ln];
                mod[(size_t)(l * 9 + mb) * 6144 + n0 + ln] = s; }
            __syncthreads();
        }
    }
    { const int idx = F.blk * NTHR + F.tid;
      if (idx < 1024) { const int pos = idx >> 4, f = idx & 15; const float inv = exp2f(-(float)f * (13.287712379549449f / 16.f)); const float ang = (float)pos * inv;
          double s, c; sincos_d((double)ang, s, c); float* rope = (float*)(F.ws + WS_ROPE); rope[idx] = (float)c; rope[1024 + idx] = (float)s; } }
    __syncthreads();
    { CmGlu cm{F.in[IN_S5WGLU], 2048}; transpose_all(F, cm, 1024, 2048, (bf16*)(F.ws + WS_WGLU), 0); }
    { CmGlu cm{F.in[IN_S5WGLU] + (size_t)1024 * 2048, 2048}; transpose_all(F, cm, 1024, 2048, (bf16*)(F.ws + WS_WGLU) + (size_t)2048 * 1024, 1024); }
    { CmKvq cm{F.in[IN_AWKVQ], 1536}; transpose_all(F, cm, 1024, 1536, (bf16*)(F.ws + WS_WKVQ), 0); }
    { CmNat cm{F.in[IN_AWO], 1024}; transpose_all(F, cm, 1024, 1024, (bf16*)(F.ws + WS_WO), 768); }
    { CmMlIn cm{F.in[IN_MLWIN], 3104}; transpose_all(F, cm, 1024, ML_NIN, (bf16*)(F.ws + WS_WIN), 1280); }
    { CmNat cm{F.in[IN_MLWOUT], 1024}; transpose_all(F, cm, 1024, 1024, (bf16*)(F.ws + WS_WOUT), 896); }
    { CmG1 cm{F.in[IN_MWG], F.in[IN_MWU], 512}; transpose_all(F, cm, 1024, DEPTH * NEXP * 1024, (bf16*)(F.ws + WS_WG1), 1408); }
    { CmG2 cm{F.in[IN_MWD], 1024}; transpose_all(F, cm, 512, DEPTH * NEXP * 1024, (bf16*)(F.ws + WS_WG2), 1408); }
}

struct RowMod { f32x4 a[4], b[4], c[4]; int mr; };
__device__ __forceinline__ void rowmod_load(RowMod& M, const float* base, int mr, int oa, int ob, int oc, int lane) {
    if (mr == M.mr) return; M.mr = mr; const float* p = base + (size_t)mr * 6144;
#pragma unroll
    for (int j = 0; j < 4; ++j) { M.a[j] = *(const f32x4*)(p + oa + 4 * lane + 256 * j); M.b[j] = *(const f32x4*)(p + ob + 4 * lane + 256 * j); if (oc >= 0) M.c[j] = *(const f32x4*)(p + oc + 4 * lane + 256 * j); }
}
struct RawRow { f32x4 x[4]; v2u ya[4], yb[4]; };
template <bool COMB, bool XBF>
__device__ __forceinline__ void raw_load(RawRow& R, const void* xrow, const bf16* y2, int s0, int s1, int lane) {
#pragma unroll
    for (int j = 0; j < 4; ++j) {
        if (XBF) { const v2u w = *(const v2u*)((const bf16*)xrow + 4 * lane + 256 * j); R.x[j] = (f32x4){bflo(w.x), bfhi(w.x), bflo(w.y), bfhi(w.y)}; }
        else R.x[j] = *(const f32x4*)((const float*)xrow + 4 * lane + 256 * j);
        if (COMB) { R.ya[j] = *(const v2u*)(y2 + (size_t)s0 * D + 4 * lane + 256 * j); R.yb[j] = *(const v2u*)(y2 + (size_t)s1 * D + 4 * lane + 256 * j); } }
}
template <int L>
__device__ __forceinline__ void phase_a1(Frame& F, const int skip = 0) {
    const float* mod = (const float*)(F.ws + WS_MOD);
    bf16* xres = (bf16*)(F.ws + WS_XRES); bf16* hb = (bf16*)(F.ws + WS_H);
    const bf16* y2 = (const bf16*)(F.ws + WS_Y2); const int* toks = (const int*)(F.ws + WS_TOKS);
    const int gw = F.blk * NWAVES + F.wave, NGW = F.G * NWAVES, lane = F.lane;
    const int RPW = (T + NGW - 1) / NGW, r0 = gw * RPW, r1 = (r0 + RPW < T) ? r0 + RPW : T;
    if (r0 >= T) return;
    f32x4 gv[4];
#pragma unroll
    for (int j = 0; j < 4; ++j) gv[j] = *(const f32x4*)(F.in[IN_N1G] + L * D + 4 * lane + 256 * j);
    auto rowptr = [&](int r) -> const void* { if (L == 0) return (r < TC) ? (const void*)(F.in[IN_CTX] + (size_t)r * D) : (const void*)(F.in[IN_X] + (size_t)(r - TC) * D); return (const void*)(xres + (size_t)r * D); };
    RowMod M1, M2; M1.mr = -1; M2.mr = -1;
    int ns0 = 0, ns1 = 0;
    if (L > 0) { ns0 = toks[2 * r0]; ns1 = toks[2 * r0 + 1]; }
    RawRow nx; raw_load<(L > 0), (L > 0)>(nx, rowptr(r0), y2, ns0, ns1, lane);
    if (L > 0 && r0 + 1 < r1) { ns0 = toks[2 * r0 + 2]; ns1 = toks[2 * r0 + 3]; }
    for (int r = r0; r < r1; ++r) {
        const int mr = mrow_of(r);
        RawRow cur = nx;
        if (r + 1 < r1) { raw_load<(L > 0), (L > 0)>(nx, rowptr(r + 1), y2, ns0, ns1, lane); if (L > 0 && r + 2 < r1) { ns0 = toks[2 * r + 4]; ns1 = toks[2 * r + 5]; } }
        rowmod_load(M1, mod + (size_t)L * 9 * 6144, mr, 0, 1024, -1, lane);
        if (L > 0) rowmod_load(M2, mod + (size_t)(L - 1) * 9 * 6144, mr, 5120, 5120, -1, lane);
        float ss = 0.f;
#pragma unroll
        for (int j = 0; j < 4; ++j) {
            f32x4 v = cur.x[j];
            if (L > 0) { const v2u a = cur.ya[j], b = cur.yb[j]; const f32x4 gg = M2.a[j];
                v.x += gg.x * (bflo(a.x) + bflo(b.x)); v.y += gg.y * (bfhi(a.x) + bfhi(b.x)); v.z += gg.z * (bflo(a.y) + bflo(b.y)); v.w += gg.w * (bfhi(a.y) + bfhi(b.y)); }
            cur.x[j] = v;
            if (!skip) st_bf4(xres + (size_t)r * D + 4 * lane + 256 * j, v); ss += v.x * v.x + v.y * v.y + v.z * v.z + v.w * v.w;
        }
        const float rs = rsqrtf(wave_sum(ss) * (1.f / D) + EPS);
#pragma unroll
        for (int j = 0; j < 4; ++j) { const f32x4 h = cur.x[j] * rs * gv[j] * (M1.b[j] + 1.f) + M1.a[j]; st_bf4(hb + (size_t)r * D + 4 * lane + 256 * j, h); }
    }
}
__device__ __forceinline__ float quad_get(float v, int k) {
    return k == 1 ? dpp_f<0x39>(v, v) : k == 2 ? dpp_f<0x4E>(v, v) : dpp_f<0x93>(v, v); }
template <int L>
__device__ __forceinline__ void phase_n2(Frame& F, const int var = 0) {
    constexpr int R0 = (L == DEPTH - 1) ? TC : 0;
    const float* mod = (const float*)(F.ws + WS_MOD);
    const bf16* xres = (const bf16*)(F.ws + WS_XRES); bf16* hb = (bf16*)(F.ws + WS_H);
    int* toke = (int*)(F.ws + WS_TOKE); int* tokr = (int*)(F.ws + WS_TOKR); float* tokw = (float*)(F.ws + WS_TOKW); int* bcnt = (int*)(F.ws + WS_BCNT);
    LAS v4u* rwf = (LAS v4u*)(F.lds);
    LAS float* PS = (LAS float*)(F.lds + 65536);
    LAS float* PL = (LAS float*)(F.lds + 65536 + 1024);
    LAS int* cntL = (LAS int*)(F.lds + SCT_OFF);
    for (int i = F.tid; i < 32 * 64; i += NTHR) { const int ks = i >> 6, ln = i & 63, e = ln & 15, k0 = 32 * ks + 8 * (ln >> 4);
        float w[8]; unsigned hi[4], lo[4];
#pragma unroll
        for (int jj = 0; jj < 8; ++jj) w[jj] = F.in[IN_RW][(k0 + jj) * 16 + e];
#pragma unroll
        for (int jj = 0; jj < 4; ++jj) { hi[jj] = pk2(w[2 * jj], w[2 * jj + 1]); lo[jj] = pk2(w[2 * jj] - bflo(hi[jj]), w[2 * jj + 1] - bfhi(hi[jj])); }
        rwf[2 * i] = (v4u){hi[0], hi[1], hi[2], hi[3]}; rwf[2 * i + 1] = (v4u){lo[0], lo[1], lo[2], lo[3]}; }
    if (F.tid < 16) cntL[F.tid] = 0;
    __syncthreads();
    const int lane = F.lane, rl = lane & 15, kg = lane >> 4, w = F.wave;
    const float rbias = F.in[IN_RB][rl];
    constexpr int NTILES = (T - R0) / 16;
    const int ntl = (NTILES - F.blk + F.G - 1) / F.G;
    const int c0 = 128 * w + 8 * kg;
    v4u xw4[4];
    if (ntl > 0) { const bf16* xr = xres + (size_t)(R0 + 16 * F.blk + rl) * D + c0;
#pragma unroll
        for (int q = 0; q < 4; ++q) xw4[q] = *(const v4u*)(xr + 32 * q); }
    for (int j = 0; j < ntl; ++j) {
        const int tile = F.blk + F.G * j, rbase = R0 + 16 * tile, mr = mrow_of(rbase), pb = j & 1;
        f32x4 ca[4], cb[4]; float ss = 0.f;
#pragma unroll
        for (int q = 0; q < 4; ++q) { const v4u t = xw4[q]; ca[q] = (f32x4){bflo(t.x), bfhi(t.x), bflo(t.y), bfhi(t.y)}; cb[q] = (f32x4){bflo(t.z), bfhi(t.z), bflo(t.w), bfhi(t.w)};
            ss += ca[q].x * ca[q].x + ca[q].y * ca[q].y + ca[q].z * ca[q].z + ca[q].w * ca[q].w + cb[q].x * cb[q].x + cb[q].y * cb[q].y + cb[q].z * cb[q].z + cb[q].w * cb[q].w; }
        ss = xor16_sum(ss); ss = xor32_sum(ss);
        if (kg == 0) PS[(pb * 8 + w) * 16 + rl] = ss;
        if (j + 1 < ntl) { const bf16* xr = xres + (size_t)(R0 + 16 * (tile + F.G) + rl) * D + c0;
#pragma unroll
            for (int q = 0; q < 4; ++q) xw4[q] = *(const v4u*)(xr + 32 * q); }
        __syncthreads();
        float tot = 0.f;
#pragma unroll
        for (int ww = 0; ww < 8; ++ww) tot += PS[(pb * 8 + ww) * 16 + rl];
        const float rs = rsqrtf(tot * (1.f / D) + EPS);
        const float* gp = F.in[IN_N2G] + L * D + c0; const float* shp = mod + (size_t)(L * 9 + mr) * 6144 + 3072 + c0; const float* scp = shp + 1024;
        bf16* hrow = hb + (size_t)(rbase + rl) * D + c0;
        f32x4 acc = (f32x4){0.f, 0.f, 0.f, 0.f};
#pragma unroll
        for (int q = 0; q < 4; ++q) {
            float h[8];
            { const f32x4 g0 = *(const f32x4*)(gp + 32 * q), g1 = *(const f32x4*)(gp + 32 * q + 4), cc0 = *(const f32x4*)(scp + 32 * q), cc1 = *(const f32x4*)(scp + 32 * q + 4), s0 = *(const f32x4*)(shp + 32 * q), s1 = *(const f32x4*)(shp + 32 * q + 4);
              const f32x4 h0 = ca[q] * rs * g0 * (cc0 + 1.f) + s0, h1 = cb[q] * rs * g1 * (cc1 + 1.f) + s1;
              h[0] = h0.x; h[1] = h0.y; h[2] = h0.z; h[3] = h0.w; h[4] = h1.x; h[5] = h1.y; h[6] = h1.z; h[7] = h1.w; }
            unsigned hi[4], lo[4];
#pragma unroll
            for (int jj = 0; jj < 4; ++jj) { hi[jj] = pk2(h[2 * jj], h[2 * jj + 1]); lo[jj] = pk2(h[2 * jj] - bflo(hi[jj]), h[2 * jj + 1] - bfhi(hi[jj])); }
            const v4u hv = (v4u){hi[0], hi[1], hi[2], hi[3]}, lv = (v4u){lo[0], lo[1], lo[2], lo[3]};
            *(v4u*)(hrow + 32 * q) = hv;
            const int ks = 4 * w + q;
            const v4u bh = rwf[2 * (ks * 64 + lane)], bl = rwf[2 * (ks * 64 + lane) + 1];
            acc = __builtin_amdgcn_mfma_f32_16x16x32_bf16(__builtin_bit_cast(bf16x8, hv), __builtin_bit_cast(bf16x8, bh), acc, 0, 0, 0);
            acc = __builtin_amdgcn_mfma_f32_16x16x32_bf16(__builtin_bit_cast(bf16x8, hv), __builtin_bit_cast(bf16x8, bl), acc, 0, 0, 0);
            acc = __builtin_amdgcn_mfma_f32_16x16x32_bf16(__builtin_bit_cast(bf16x8, lv), __builtin_bit_cast(bf16x8, bh), acc, 0, 0, 0);
        }
        *(LAS f32x4*)(PL + ((pb * 8 + w) * 64 + lane) * 4) = acc;
        __syncthreads();
        if (w != (j & 7) || (var & 1)) continue;
        f32x4 lg = (f32x4){0.f, 0.f, 0.f, 0.f};
#pragma unroll
        for (int ww = 0; ww < 8; ++ww) lg = lg + *(const LAS f32x4*)(PL + ((pb * 8 + ww) * 64 + lane) * 4);
#pragma unroll
        for (int r = 0; r < 4; ++r) {
            const float sco = sigmoidf_(lg[r]), sel = sco + rbias;
            int rank = 0;
#pragma unroll
            for (int k = 1; k < 4; ++k) { const float o = quad_get(sel, k); const int oi = (rl & ~3) | ((rl + k) & 3); rank += (o > sel || (o == sel && oi < rl)) ? 1 : 0; }
            const bool top2 = rank < 2;
            float gs = top2 ? sel : 0.f; gs += dpp_f<0xB1>(0.f, gs); gs += dpp_f<0x4E>(0.f, gs);
            bool best = true; const int q = rl >> 2;
            { const float o1 = dpp_f<0x124>(gs, gs), o2 = dpp_f<0x128>(gs, gs), o3 = dpp_f<0x12C>(gs, gs);
              const int q1 = (q + 3) & 3, q2 = (q + 2) & 3, q3 = (q + 1) & 3;
              best = !(o1 > gs || (o1 == gs && q1 < q)) && !(o2 > gs || (o2 == gs && q2 < q)) && !(o3 > gs || (o3 == gs && q3 < q)); }
            const bool selv = best && top2;
            const float wsum = red16_sum(selv ? sco : 0.f);
            if (selv) { const int row = rbase + 4 * kg + r;
                const int lr = __hip_atomic_fetch_add(cntL + rl, 1, __ATOMIC_RELAXED, __HIP_MEMORY_SCOPE_WORKGROUP);
                toke[2 * row + rank] = rl; tokr[2 * row + rank] = lr; tokw[2 * row + rank] = sco * __builtin_amdgcn_rcpf(wsum); }
        }
    }
    __syncthreads();
    if (F.tid < 16 && !(var & 1)) bcnt[F.blk * 16 + F.tid] = cntL[F.tid];
}
template <int L>
__device__ __forceinline__ void phase_sc(Frame& F) {
    constexpr int R0 = (L == DEPTH - 1) ? TC : 0;
    const int* bcnt = (const int*)(F.ws + WS_BCNT);
    LAS int* pt = (LAS int*)(F.lds);
    LAS int* tt = (LAS int*)(F.lds + 8192);
    { const int e = F.tid & 15, ch = F.tid >> 4; int tot = 0, mine = 0;
      for (int b = ch; b < F.G; b += 32) { const int c = bcnt[b * 16 + e]; tot += c; mine += (b < F.blk) ? c : 0; }
      pt[ch * 16 + e] = tot; pt[512 + ch * 16 + e] = mine; }
    __syncthreads();
    if (F.tid < 16) { int tot = 0, mine = 0; for (int ch = 0; ch < 32; ++ch) { tot += pt[ch * 16 + F.tid]; mine += pt[512 + ch * 16 + F.tid]; } tt[F.tid] = tot; tt[16 + F.tid] = mine; }
    __syncthreads();
    int* slotr = (int*)(F.ws + WS_SLOTR);
    if (F.tid == 0) { int ts = 0; int* etab = (int*)(F.ws + WS_ETAB);
        for (int e = 0; e < 16; ++e) { tt[32 + e] = ts * 256 + tt[16 + e]; tt[48 + e] = ts * 256 + tt[e]; if (F.blk == 0) etab[e] = ts; ts += (tt[e] + 255) >> 8; tt[64 + e] = ts * 256; }
        if (F.blk == 0) etab[16] = ts; }
    __syncthreads();
    if (F.blk < 16) { for (int s = tt[48 + F.blk] + F.tid; s < tt[64 + F.blk]; s += NTHR) slotr[s] = R0; }
    const int* toke = (const int*)(F.ws + WS_TOKE); const int* tokr = (const int*)(F.ws + WS_TOKR); const float* tokw = (const float*)(F.ws + WS_TOKW);
    int* toks = (int*)(F.ws + WS_TOKS); float* slotw = (float*)(F.ws + WS_SLOTW);
    const int lane = F.lane;
    constexpr int NTILES = (T - R0) / 16;
    for (int tile = F.blk + F.G * F.wave; tile < NTILES; tile += F.G * NWAVES) {
        const int rbase = R0 + 16 * tile;
        if (lane < 32) { const int idx = 2 * rbase + lane; const int e = toke[idx]; const int slot = tt[32 + e] + tokr[idx]; toks[idx] = slot; slotw[slot] = tokw[idx]; slotr[slot] = rbase + (lane >> 1); }
    }
}
__device__ __forceinline__ void load_etab(Frame& F) {
    LAS int* tab = (LAS int*)(F.lds + ETAB_OFF);
    if (F.tid < 17) tab[F.tid] = ((const int*)(F.ws + WS_ETAB))[F.tid];
    __syncthreads();
}
__device__ __forceinline__ void phase_fin(Frame& F) {
    const float* mod = (const float*)(F.ws + WS_MOD);
    const bf16* xres = (const bf16*)(F.ws + WS_XRES);
    const bf16* y2 = (const bf16*)(F.ws + WS_Y2); const int* toks = (const int*)(F.ws + WS_TOKS);
    const int gw = F.blk * NWAVES + F.wave, NGW = F.G * NWAVES, lane = F.lane;
    const int RPW = (TL + NGW - 1) / NGW, r0 = TC + gw * RPW, r1 = (r0 + RPW < T) ? r0 + RPW : T;
    if (r0 >= T) return;
    f32x4 gv[4];
#pragma unroll
    for (int j = 0; j < 4; ++j) gv[j] = *(const f32x4*)(F.in[IN_FING] + 4 * lane + 256 * j);
    RowMod M2; M2.mr = -1;
    int ns0 = toks[2 * r0], ns1 = toks[2 * r0 + 1];
    RawRow nx; raw_load<true, true>(nx, xres + (size_t)r0 * D, y2, ns0, ns1, lane);
    if (r0 + 1 < r1) { ns0 = toks[2 * r0 + 2]; ns1 = toks[2 * r0 + 3]; }
    for (int r = r0; r < r1; ++r) {
        const int mr = mrow_of(r);
        RawRow cur = nx;
        if (r + 1 < r1) { raw_load<true, true>(nx, xres + (size_t)(r + 1) * D, y2, ns0, ns1, lane); if (r + 2 < r1) { ns0 = toks[2 * r + 4]; ns1 = toks[2 * r + 5]; } }
        rowmod_load(M2, mod + (size_t)(DEPTH - 1) * 9 * 6144, mr, 5120, 5120, -1, lane);
        float ss = 0.f;
#pragma unroll
        for (int j = 0; j < 4; ++j) { f32x4 v = cur.x[j]; const v2u a = cur.ya[j], b = cur.yb[j]; const f32x4 gg = M2.a[j];
            v.x += gg.x * (bflo(a.x) + bflo(b.x)); v.y += gg.y * (bfhi(a.x) + bfhi(b.x)); v.z += gg.z * (bflo(a.y) + bflo(b.y)); v.w += gg.w * (bfhi(a.y) + bfhi(b.y));
            cur.x[j] = v; ss += v.x * v.x + v.y * v.y + v.z * v.z + v.w * v.w; }
        const float rs = rsqrtf(wave_sum(ss) * (1.f / D) + EPS);
#pragma unroll
        for (int j = 0; j < 4; ++j) *(f32x4*)(F.out + (size_t)(r - TC) * D + 4 * lane + 256 * j) = cur.x[j] * rs * gv[j];
    }
}

__device__ __forceinline__ int seq_row(int b, int dir, int s) {
    if (s < CTX) return b * CTX + (dir ? (CTX - 1 - s) : s);
    const int t = s - CTX; return TC + b * SEQ + (dir ? (SEQ - 1 - t) : t);
}
template <int J, bool WCTX>
__device__ __forceinline__ void phase_s5_naive(Frame& F) {
    const int gw = F.blk * NWAVES + F.wave, lane = F.lane;
    if ((gw & 3) != 0) return;
    const int it = gw >> 2; if (it >= NB * 64) return;
    const int b = it >> 6, g = it & 63, p = lane;
    const bf16* hb = (const bf16*)(F.ws + WS_H); float* ysum = (float*)(F.ws + WS_YSUM);
    for (int dir = 0; dir < 2; ++dir) {
        const int gi = (J * 2 + dir) * 64 + g, pidx = gi * 64 + p;
        const float lam_re = F.in[IN_S5LRE][pidx], lam_im = F.in[IN_S5LIM][pidx];
        const float dt = expf(F.in[IN_S5LOG][gi]);
        const float mag = expf(lam_re * dt);
        double sd, cd; sincos_d((double)(lam_im * dt), sd, cd);
        const float a_re = mag * (float)cd, a_im = mag * (float)sd;
        const float den = lam_re * lam_re + lam_im * lam_im, n_re = a_re - 1.f, n_im = a_im;
        const float f_re = (n_re * lam_re + n_im * lam_im) / den, f_im = (n_im * lam_re - n_re * lam_im) / den;
        float bbr[16], bbi[16], cre[16], cim[16];
#pragma unroll
        for (int c = 0; c < 16; ++c) { const float br = F.in[IN_S5BRE][(size_t)pidx * 16 + c], bi = F.in[IN_S5BIM][(size_t)pidx * 16 + c];
            bbr[c] = f_re * br - f_im * bi; bbi[c] = f_re * bi + f_im * br;
            cre[c] = F.in[IN_S5CRE][((size_t)gi * 16 + c) * 64 + p]; cim[c] = F.in[IN_S5CIM][((size_t)gi * 16 + c) * 64 + p]; }
        float x_re = 0.f, x_im = 0.f;
        for (int s = 0; s < CTX + SEQ; ++s) {
            const int r = seq_row(b, dir, s);
            const v4u u0 = *(const v4u*)(hb + (size_t)r * D + g * 16), u1 = *(const v4u*)(hb + (size_t)r * D + g * 16 + 8);
            float u[16];
            u[0] = bflo(u0.x); u[1] = bfhi(u0.x); u[2] = bflo(u0.y); u[3] = bfhi(u0.y); u[4] = bflo(u0.z); u[5] = bfhi(u0.z); u[6] = bflo(u0.w); u[7] = bfhi(u0.w);
            u[8] = bflo(u1.x); u[9] = bfhi(u1.x); u[10] = bflo(u1.y); u[11] = bfhi(u1.y); u[12] = bflo(u1.z); u[13] = bfhi(u1.z); u[14] = bflo(u1.w); u[15] = bfhi(u1.w);
            float bur = 0.f, bui = 0.f;
#pragma unroll
            for (int c = 0; c < 16; ++c) { bur += u[c] * bbr[c]; bui += u[c] * bbi[c]; }
            const float nr = a_re * x_re - a_im * x_im + bur, ni = a_re * x_im + a_im * x_re + bui;
            x_re = nr; x_im = ni;
            if (WCTX || s >= CTX) {
                float yv = 0.f;
#pragma unroll
                for (int c = 0; c < 16; ++c) { const float t = wave_sum(x_re * cre[c] - x_im * cim[c]); if (lane == c) yv = t; }
                if (lane < 16) { float* yp = ysum + (size_t)r * D + g * 16 + lane; if (dir == 0) *yp = yv; else *yp = *yp + yv; }
            }
        }
    }
}
template <int J, bool WCTX>
__device__ __forceinline__ void phase_s5_combine(Frame& F) {
    constexpr int R0 = WCTX ? 0 : TC;
    const bf16* hb = (const bf16*)(F.ws + WS_H); const float* ysum = (const float*)(F.ws + WS_YSUM); bf16* zb = (bf16*)(F.ws + WS_Z);
    const int gw = F.blk * NWAVES + F.wave, NGW = F.G * NWAVES, lane = F.lane;
    f32x4 dv[4];
#pragma unroll
    for (int j = 0; j < 4; ++j) dv[j] = *(const f32x4*)(F.in[IN_S5D] + J * D + 4 * lane + 256 * j);
    for (int r = R0 + gw; r < T; r += NGW) {
#pragma unroll
        for (int j = 0; j < 4; ++j) {
            const f32x4 y = *(const f32x4*)(ysum + (size_t)r * D + 4 * lane + 256 * j);
            const v2u hv = *(const v2u*)(hb + (size_t)r * D + 4 * lane + 256 * j);
            f32x4 z; z.x = gelu_tanh(y.x + dv[j].x * bflo(hv.x)); z.y = gelu_tanh(y.y + dv[j].y * bfhi(hv.x)); z.z = gelu_tanh(y.z + dv[j].z * bflo(hv.y)); z.w = gelu_tanh(y.w + dv[j].w * bfhi(hv.y));
            st_bf4(zb + (size_t)r * D + 4 * lane + 256 * j, z);
        }
    }
}
template <bool WCTX>
__device__ __forceinline__ void phase_attn_naive(Frame& F) {
    constexpr int R0 = WCTX ? 0 : TC;
    const bf16* qb = (const bf16*)(F.ws + WS_QB); const bf16* kb = (const bf16*)(F.ws + WS_KB); const bf16* vb = (const bf16*)(F.ws + WS_VB); bf16* zb = (bf16*)(F.ws + WS_Z);
    const int gw = F.blk * NWAVES + F.wave, NGW = F.G * NWAVES, lane = F.lane;
    for (int it = gw; it < (T - R0) * 16; it += NGW) {
        const int r = R0 + (it >> 4), h = it & 15, kvh = h >> 2;
        int kv0, nk;
        if (r < TC) { kv0 = (r >> 8) * KVLEN + SEQ; nk = CTX; } else { kv0 = ((r - TC) >> 11) * KVLEN; nk = KVLEN; }
        float q[64];
#pragma unroll
        for (int c = 0; c < 8; ++c) { const v4u w = *(const v4u*)(qb + (size_t)r * D + h * 64 + 8 * c);
            q[8 * c] = bflo(w.x); q[8 * c + 1] = bfhi(w.x); q[8 * c + 2] = bflo(w.y); q[8 * c + 3] = bfhi(w.y); q[8 * c + 4] = bflo(w.z); q[8 * c + 5] = bfhi(w.z); q[8 * c + 6] = bflo(w.w); q[8 * c + 7] = bfhi(w.w); }
        float m = -INFINITY, l = 0.f, o[64];
#pragma unroll
        for (int d = 0; d < 64; ++d) o[d] = 0.f;
        for (int kk = lane; kk < nk; kk += 64) {
            const bf16* kp = kb + (size_t)(kv0 + kk) * 256 + kvh * 64; const bf16* vp = vb + (size_t)(kv0 + kk) * 256 + kvh * 64;
            float s = 0.f;
#pragma unroll
            for (int c = 0; c < 8; ++c) { const v4u w = *(const v4u*)(kp + 8 * c);
                s += q[8 * c] * bflo(w.x) + q[8 * c + 1] * bfhi(w.x) + q[8 * c + 2] * bflo(w.y) + q[8 * c + 3] * bfhi(w.y) + q[8 * c + 4] * bflo(w.z) + q[8 * c + 5] * bfhi(w.z) + q[8 * c + 6] * bflo(w.w) + q[8 * c + 7] * bfhi(w.w); }
            const float mn = fmaxf(m, s), sc = exp2f(m - mn), pp = exp2f(s - mn);
            l = l * sc + pp; m = mn;
#pragma unroll
            for (int c = 0; c < 8; ++c) { const v4u w = *(const v4u*)(vp + 8 * c);
                o[8 * c] = o[8 * c] * sc + pp * bflo(w.x); o[8 * c + 1] = o[8 * c + 1] * sc + pp * bfhi(w.x); o[8 * c + 2] = o[8 * c + 2] * sc + pp * bflo(w.y); o[8 * c + 3] = o[8 * c + 3] * sc + pp * bfhi(w.y);
                o[8 * c + 4] = o[8 * c + 4] * sc + pp * bflo(w.z); o[8 * c + 5] = o[8 * c + 5] * sc + pp * bfhi(w.z); o[8 * c + 6] = o[8 * c + 6] * sc + pp * bflo(w.w); o[8 * c + 7] = o[8 * c + 7] * sc + pp * bfhi(w.w); }
        }
        const float M = wave_max(m), f = exp2f(m - M);
        const float lt = wave_sum(l * f);
        float res = 0.f;
#pragma unroll
        for (int d = 0; d < 64; ++d) { const float t = wave_sum(o[d] * f); if (lane == d) res = t; }
        zb[(size_t)r * D + h * 64 + lane] = (bf16)f2bf(res / lt);
    }
}
template <bool WCTX>
__device__ __forceinline__ void phase_mlstm_naive(Frame& F) {
    const int gw = F.blk * NWAVES + F.wave, lane = F.lane;
    if ((gw & 15) != 0) return;
    const int it = gw >> 4; if (it >= NB * 8 * 2) return;
    const int b = it >> 4, hd = (it >> 1) & 7, j = (it & 1) * 64 + lane;
    const bf16* kb = (const bf16*)(F.ws + WS_MK); const bf16* vb = (const bf16*)(F.ws + WS_MV); const bf16* qb = (const bf16*)(F.ws + WS_MQ);
    const float* gb = (const float*)(F.ws + WS_MG); float* hsum = (float*)(F.ws + WS_MHS);
    for (int dir = 0; dir < 2; ++dir) {
        float C[64], nn[64], m = 0.f;
#pragma unroll
        for (int d = 0; d < 64; ++d) { C[d] = 0.f; nn[d] = 0.f; }
        for (int s = 0; s < CTX + SEQ; ++s) {
            const int r = seq_row(b, dir, s);
            const float ig = gb[(size_t)r * 32 + dir * 16 + hd], lf = log_sigmoidf_(gb[(size_t)r * 32 + dir * 16 + 8 + hd]);
            const float mn = fmaxf(lf + m, ig), fa = __expf(lf + m - mn), ia = __expf(ig - mn); m = mn;
            const float vj = bf2f(vb[(size_t)r * 1024 + hd * 128 + j]) * ia;
            float num = 0.f, den = 0.f;
#pragma unroll
            for (int c = 0; c < 8; ++c) {
                const v4u kw = *(const v4u*)(kb + (size_t)r * 512 + hd * 64 + 8 * c), qw = *(const v4u*)(qb + (size_t)r * 512 + hd * 64 + 8 * c);
                float kk[8], qq[8];
                kk[0] = bflo(kw.x); kk[1] = bfhi(kw.x); kk[2] = bflo(kw.y); kk[3] = bfhi(kw.y); kk[4] = bflo(kw.z); kk[5] = bfhi(kw.z); kk[6] = bflo(kw.w); kk[7] = bfhi(kw.w);
                qq[0] = bflo(qw.x); qq[1] = bfhi(qw.x); qq[2] = bflo(qw.y); qq[3] = bfhi(qw.y); qq[4] = bflo(qw.z); qq[5] = bfhi(qw.z); qq[6] = bflo(qw.w); qq[7] = bfhi(qw.w);
#pragma unroll
                for (int e = 0; e < 8; ++e) { const int d = 8 * c + e;
                    C[d] = fa * C[d] + kk[e] * vj; nn[d] = fa * nn[d] + ia * kk[e]; num += C[d] * qq[e]; den += nn[d] * qq[e]; }
            }
            if (WCTX || s >= CTX) {
                const float outv = num / fmaxf(fabsf(den), __expf(-m));
                float* hp = hsum + (size_t)r * D + hd * 128 + j;
                if (dir == 0) *hp = outv; else *hp = *hp + outv;
            }
        }
    }
}
template <bool WCTX>
__device__ __forceinline__ void phase_mlstm_combine(Frame& F) {
    constexpr int R0 = WCTX ? 0 : TC;
    const float* hsum = (const float*)(F.ws + WS_MHS); const bf16* ob = (const bf16*)(F.ws + WS_MO); bf16* zb = (bf16*)(F.ws + WS_Z);
    const int gw = F.blk * NWAVES + F.wave, NGW = F.G * NWAVES, lane = F.lane;
    f32x4 gv[4];
#pragma unroll
    for (int j = 0; j < 4; ++j) gv[j] = *(const f32x4*)(F.in[IN_MLNG] + 4 * lane + 256 * j);
    for (int r = R0 + gw; r < T; r += NGW) {
#pragma unroll
        for (int j = 0; j < 4; ++j) {
            const f32x4 hv = *(const f32x4*)(hsum + (size_t)r * D + 4 * lane + 256 * j);
            float ss = hv.x * hv.x + hv.y * hv.y + hv.z * hv.z + hv.w * hv.w;
#pragma unroll
            for (int o = 1; o < 32; o <<= 1) ss += __shfl_xor(ss, o);
            const float rs = rsqrtf(ss * (1.f / 128.f) + EPS);
            const v2u ow = *(const v2u*)(ob + (size_t)r * D + 4 * lane + 256 * j);
            f32x4 z = hv * rs * gv[j];
            z.x *= sigmoidf_(bflo(ow.x)); z.y *= sigmoidf_(bfhi(ow.x)); z.z *= sigmoidf_(bflo(ow.y)); z.w *= sigmoidf_(bfhi(ow.y));
            st_bf4(zb + (size_t)r * D + 4 * lane + 256 * j, z);
        }
    }
}
#include <hip/hip_bf16.h>
#include <cmath>
namespace attn_body {
using bf16=__hip_bfloat16;
using bf16x8=__attribute__((ext_vector_type(8)))short;
using s16x4=__attribute__((ext_vector_type(4)))short;
using f32x16=__attribute__((ext_vector_type(16)))float;
using u32x4=__attribute__((ext_vector_type(4)))unsigned;
constexpr int D=64,QP=1024,KP=256;
constexpr int NW=8,QBLK=32,QB=QBLK*NW,KVBLK=64;
__device__ __forceinline__ int crow(int r,int hi){return (r&3)+8*(r>>2)+4*hi;}
#define SBAR() __builtin_amdgcn_sched_barrier(0)
__device__ __forceinline__ void cmask(f32x16&p0,f32x16&p1,int jb,int qrel,int hi){
  const float NEG=-INFINITY; int kb=64*jb+4*hi;
  #pragma unroll
  for(int r=0;r<16;++r){int kv=kb+(r&3)+8*(r>>2); if(kv>qrel)p0[r]=NEG; if(kv+32>qrel)p1[r]=NEG;}
}

constexpr int NSLOT=3, SLOTB=8192;
constexpr int LDS_K=0, LDS_V=NSLOT*SLOTB, LDS_WS=2*NSLOT*SLOTB, LDS_OST=LDS_WS+NW*64*4, LDS_BYTES=LDS_OST+NW*4096;
constexpr float C2=0.125f*1.4426950408889634f;
__device__ __forceinline__ void glds16(const void*gsrc,unsigned lds_dst){unsigned keep;
  asm volatile("s_mov_b32 %0, m0\n\ts_mov_b32 m0, %2\n\ts_nop 0\n\tglobal_load_lds_dwordx4 %1, off\n\ts_mov_b32 m0, %0":"=&s"(keep):"v"(gsrc),"s"(lds_dst):"memory");}
__device__ __forceinline__ float max3f(float a,float b,float c){float r;asm("v_max3_f32 %0, %1, %2, %3":"=v"(r):"v"(a),"v"(b),"v"(c));return r;}
__device__ __forceinline__ float max2f(float a,float b){float r;asm("v_max_f32_e32 %0, %1, %2":"=v"(r):"v"(a),"v"(b));return r;}
__device__ __forceinline__ float fadd_s(float a,float b){float r;asm("v_add_f32_e32 %0, %1, %2":"=v"(r):"v"(a),"v"(b));return r;}
__device__ __forceinline__ float fsub_s(float a,float b){float r;asm("v_sub_f32_e32 %0, %1, %2":"=v"(r):"v"(a),"v"(b));return r;}
typedef float f32x2_t __attribute__((ext_vector_type(2))); typedef __bf16 bf16x2_t __attribute__((ext_vector_type(2)));
__device__ __forceinline__ unsigned cvtpk_s(float lo,float hi){f32x2_t v={lo,hi};bf16x2_t b=__builtin_convertvector(v,bf16x2_t);return __builtin_bit_cast(unsigned,b);}
#define WAIT_BAR(N) asm volatile("s_waitcnt vmcnt(" #N ") lgkmcnt(0)\n\ts_barrier":::"memory")

__device__ __forceinline__ void qkt(f32x16&p0,f32x16&p1,const char*Kslot,const bf16x8*qr,const f32x16&negm,int r32,int hi){
  const char*kb=Kslot+hi*1024+r32*16;
  #pragma unroll
  for(int d0=0;d0<4;++d0){
    const bf16x8 b0=*reinterpret_cast<const bf16x8*>(kb+d0*2048);
    const bf16x8 b1=*reinterpret_cast<const bf16x8*>(kb+d0*2048+512);
    if(d0==0){p0=__builtin_amdgcn_mfma_f32_32x32x16_bf16(b0,qr[0],negm,0,0,0);p1=__builtin_amdgcn_mfma_f32_32x32x16_bf16(b1,qr[0],negm,0,0,0);}
    else{p0=__builtin_amdgcn_mfma_f32_32x32x16_bf16(b0,qr[d0],p0,0,0,0);p1=__builtin_amdgcn_mfma_f32_32x32x16_bf16(b1,qr[d0],p1,0,0,0);}}
}
typedef __attribute__((address_space(3))) const char* lds_cptr;
typedef short v4i16_t __attribute__((ext_vector_type(4)));
__device__ __forceinline__ void kload8(bf16x8*kf,lds_cptr kp){
  kf[0]=*(const __attribute__((address_space(3))) bf16x8*)(kp);      kf[1]=*(const __attribute__((address_space(3))) bf16x8*)(kp+512);
  kf[2]=*(const __attribute__((address_space(3))) bf16x8*)(kp+2048); kf[3]=*(const __attribute__((address_space(3))) bf16x8*)(kp+2560);
  kf[4]=*(const __attribute__((address_space(3))) bf16x8*)(kp+4096); kf[5]=*(const __attribute__((address_space(3))) bf16x8*)(kp+4608);
  kf[6]=*(const __attribute__((address_space(3))) bf16x8*)(kp+6144); kf[7]=*(const __attribute__((address_space(3))) bf16x8*)(kp+6656);
}
__device__ __forceinline__ void kload2(bf16x8*kf,lds_cptr kp,int j){ kf[2*j]=*(const __attribute__((address_space(3))) bf16x8*)(kp+j*2048); kf[2*j+1]=*(const __attribute__((address_space(3))) bf16x8*)(kp+j*2048+512); }
__device__ __forceinline__ s16x4 vtr(lds_cptr p){ return __builtin_bit_cast(s16x4,__builtin_amdgcn_ds_read_tr16_b64_v4i16((__attribute__((address_space(3))) v4i16_t*)p)); }
__device__ __forceinline__ float rowmax(const f32x16&p0,const f32x16&p1){
  float a=max3f(p0[0],p0[1],p1[0]),b=max3f(p0[2],p0[3],p1[1]);a=max3f(a,p1[2],p1[3]);
  #pragma unroll
  for(int r=4;r<16;r+=4){a=max3f(a,p0[r],p0[r+1]);b=max3f(b,p0[r+2],p0[r+3]);a=max3f(a,p1[r],p1[r+1]);b=max3f(b,p1[r+2],p1[r+3]);}
  const float m=max2f(a,b);
  auto rr=__builtin_amdgcn_permlane32_swap(__float_as_uint(m),__float_as_uint(m),false,false);
  return max2f(__uint_as_float(rr[0]),__uint_as_float(rr[1]));
}
__device__ __forceinline__ void pv(f32x16*o,int vb,bf16x8 pa0,bf16x8 pa1,bf16x8 pa2,bf16x8 pa3){
  #pragma unroll
  for(int d0=0;d0<2;++d0){s16x4 lo[4],hi[4];
    #pragma unroll
    for(int ks=0;ks<4;++ks){
      asm volatile("ds_read_b64_tr_b16 %0,%1 offset:%c2":"=&v"(lo[ks]):"v"(vb),"i"(d0*4096+ks*1024):"memory");
      asm volatile("ds_read_b64_tr_b16 %0,%1 offset:%c2":"=&v"(hi[ks]):"v"(vb),"i"(d0*4096+ks*1024+512):"memory");}
    asm volatile("s_waitcnt lgkmcnt(0)":::"memory");SBAR();
    #define PK(k) (bf16x8){lo[k][0],lo[k][1],lo[k][2],lo[k][3],hi[k][0],hi[k][1],hi[k][2],hi[k][3]}
    o[d0]=__builtin_amdgcn_mfma_f32_32x32x16_bf16(pa0,PK(0),o[d0],0,0,0);
    o[d0]=__builtin_amdgcn_mfma_f32_32x32x16_bf16(pa1,PK(1),o[d0],0,0,0);
    o[d0]=__builtin_amdgcn_mfma_f32_32x32x16_bf16(pa2,PK(2),o[d0],0,0,0);
    o[d0]=__builtin_amdgcn_mfma_f32_32x32x16_bf16(pa3,PK(3),o[d0],0,0,0);
    #undef PK
  }
}

#ifndef ATTN_STORE16
#define ATTN_STORE16(p,v) (*(u32x4*)(p)=(v))
#endif
template<int THRL> __device__ __forceinline__ void attn_unit(const bf16*Qu,const bf16*__restrict__ Kh,const bf16*__restrict__ Vh,bf16*Ou,const int NT,char*shm){
  const int tid=threadIdx.x,lane=tid&63,r32=lane&31,hi=lane>>5; const int wid=__builtin_amdgcn_readfirstlane(tid>>6);
  const bf16*Qw=Qu+(long)(wid*QBLK)*QP;
  const unsigned lds0=(unsigned)(uintptr_t)shm;
  float*wsf=(float*)(shm+LDS_WS)+wid*64;
  const bf16*ksrc=Kh+(long)lane*KP+wid*8;
  const bf16*vsrc=Vh+(long)(16*(wid&3)+(lane>>2))*KP+(wid>>2)*32+(lane&3)*8;
  const unsigned kdst=lds0+LDS_K+wid*1024, vdst=lds0+LDS_V+wid*1024;
  #define DMA_K(t,slot) glds16(ksrc+(long)(t)*KVBLK*KP,(unsigned)__builtin_amdgcn_readfirstlane(kdst+(slot)))
  #define DMA_V(t,slot) glds16(vsrc+(long)(t)*KVBLK*KP,(unsigned)__builtin_amdgcn_readfirstlane(vdst+(slot)))
  const int vb0=(int)(lds0+LDS_V)+((lane>>4)&1)*32+(lane&3)*8+(4*hi+((lane&15)>>2))*64;
  const char*Kbase=shm+LDS_K; bf16x8 kf[8];
  const lds_cptr shm3=(lds_cptr)shm; const lds_cptr kp0=shm3+LDS_K+hi*1024+r32*16; const lds_cptr vp0=shm3+LDS_V+((lane>>4)&1)*32+(lane&3)*8+(4*hi+((lane&15)>>2))*64;
  DMA_K(0,0);DMA_V(0,0);DMA_K(1,SLOTB);
  bf16x8 qr[4];
  #pragma unroll
  for(int d0=0;d0<4;++d0)qr[d0]=*reinterpret_cast<const bf16x8*>(&Qw[(long)r32*QP+d0*16+hi*8]);
  float mhat=0.f,l_reg=0.f;f32x16 o[2];o[0]=f32x16{};o[1]=f32x16{};f32x16 negm=f32x16{};asm volatile("":"+v"(negm));
  #define CMASK(P0,P1,t) do{}while(0)
  bool resc=false;
  #define START(P0,P1) do{ const float rm=rowmax(P0,P1); resc=false; \
    { const float dl=rm; mhat=fadd_s(mhat,dl); \
      _Pragma("unroll") for(int r=0;r<16;++r){P0[r]=fsub_s(P0[r],dl);P1[r]=fsub_s(P1[r],dl);} \
      _Pragma("unroll") for(int r=0;r<16;++r)negm[r]=-mhat; asm volatile("":"+v"(negm)); } \
    _Pragma("unroll") for(int r=0;r<16;++r)P0[r]=__builtin_amdgcn_exp2f(P0[r]); }while(0)
  #define RESC() do{ if(resc){ asm volatile("s_waitcnt lgkmcnt(0)":::"memory"); \
      _Pragma("unroll") for(int d_=0;d_<2;++d_) _Pragma("unroll") for(int r=0;r<16;++r)o[d_][r]*=wsf[crow(r,hi)]; } }while(0)
  f32x16 pA0,pA1,pB0,pB1;
  int sl_prev=0,sl_cur=0,sl_next=SLOTB;
  #define ROT() do{sl_prev=sl_cur;sl_cur=sl_next;sl_next=(sl_next==(NSLOT-1)*SLOTB)?0:sl_next+SLOTB;}while(0)
  DMA_K(2,2*SLOTB);
  WAIT_BAR(3);
  qkt(pA0,pA1,Kbase,qr,negm,r32,hi);asm volatile("s_nop 15\n\ts_nop 7":"+v"(pA0),"+v"(pA1));CMASK(pA0,pA1,0);
  START(pA0,pA1);
  _Pragma("unroll") for(int r=0;r<16;++r)pA1[r]=__builtin_amdgcn_exp2f(pA1[r]);
  WAIT_BAR(0);
  DMA_K(3,0);DMA_V(1,SLOTB);
  ROT();
  kload8(kf,kp0+sl_cur);
  WAIT_BAR(2);
  s16x4 vlo[8],vhi[8]; u32x4 pw0,pw1,pw2,pw3;
  #define PKW(P,B) cvtpk_s(P[B],P[B+1])
  #define PAF(k) __builtin_bit_cast(bf16x8,pw##k)
  #define VFR(i) (bf16x8){vlo[i][0],vlo[i][1],vlo[i][2],vlo[i][3],vhi[i][0],vhi[i][1],vhi[i][2],vhi[i][3]}
  #define PIN(x) asm volatile("":"+v"(x))
  #define MX3(a,b,c) __builtin_fmaxf(__builtin_fmaxf((a),(b)),(c))
  #define GAPA(MF,A0,A1,A2,A3,W0,W1,PW) do{ MF; sacc+=A0; sacc+=A1; sacc+=A2; sacc+=A3; PIN(sacc); W0; W1; PIN(PW); SBAR(); }while(0)
  #define EX(v) __builtin_amdgcn_exp2f(v)
  #define GAPB(MF,X,B) do{ MF; X[B]=EX(X[B]); X[B+1]=EX(X[B+1]); X[B+2]=EX(X[B+2]); X[B+3]=EX(X[B+3]); PIN(X); SBAR(); }while(0)
  #define VRD(i) do{ vlo[i]=vtr(vp_+(((i)>>2)*4096+((i)&3)*1024)); vhi[i]=vtr(vp_+(((i)>>2)*4096+((i)&3)*1024+512)); }while(0)
  #define KRD(G,j) do{ if(G){ kload2(kf,kp0+sl_next,j); SBAR(); } }while(0)
  #define STEP(C0,C1,P0,P1,t,GK,GV,GL) do{ SBAR(); \
    const lds_cptr vp_=vp0+sl_prev; \
    VRD(0); SBAR(); float sacc=(P0[0]+P0[1]); \
    GAPA(C0=__builtin_amdgcn_mfma_f32_32x32x16_bf16(kf[0],qr[0],negm,0,0,0), P0[2],P0[3],P0[4],P0[5],     pw0[0]=PKW(P0,0), pw0[1]=PKW(P0,2), pw0); \
    VRD(4); SBAR(); GAPA(C1=__builtin_amdgcn_mfma_f32_32x32x16_bf16(kf[1],qr[0],negm,0,0,0), P0[6],P0[7],P0[8],P0[9],     pw0[2]=PKW(P0,4), pw0[3]=PKW(P0,6), pw0); \
    VRD(1); SBAR(); GAPA(C0=__builtin_amdgcn_mfma_f32_32x32x16_bf16(kf[2],qr[1],C0,0,0,0),   P0[10],P0[11],P0[12],P0[13], pw1[0]=PKW(P0,8), pw1[1]=PKW(P0,10), pw1); \
    VRD(5); SBAR(); GAPA(C1=__builtin_amdgcn_mfma_f32_32x32x16_bf16(kf[3],qr[1],C1,0,0,0),   P0[14],P0[15],P1[0],P1[1],   pw1[2]=PKW(P0,12),pw1[3]=PKW(P0,14), pw1); \
    VRD(2); SBAR(); GAPA(C0=__builtin_amdgcn_mfma_f32_32x32x16_bf16(kf[4],qr[2],C0,0,0,0),   P1[2],P1[3],P1[4],P1[5],     pw2[0]=PKW(P1,0), pw2[1]=PKW(P1,2), pw2); \
    VRD(6); SBAR(); GAPA(C1=__builtin_amdgcn_mfma_f32_32x32x16_bf16(kf[5],qr[2],C1,0,0,0),   P1[6],P1[7],P1[8],P1[9],     pw2[2]=PKW(P1,4), pw2[3]=PKW(P1,6), pw2); \
    VRD(3); SBAR(); GAPA(C0=__builtin_amdgcn_mfma_f32_32x32x16_bf16(kf[6],qr[3],C0,0,0,0),   P1[10],P1[11],P1[12],P1[13], pw3[0]=PKW(P1,8), pw3[1]=PKW(P1,10), pw3); \
    VRD(7); SBAR(); GAPA(C1=__builtin_amdgcn_mfma_f32_32x32x16_bf16(kf[7],qr[3],C1,0,0,0),   P1[14],P1[15],0.f,0.f,       pw3[2]=PKW(P1,12),pw3[3]=PKW(P1,14), pw3); \
    l_reg+=sacc; \
    if(GK){DMA_K((t)+3,sl_cur);} if(GV){DMA_V((t)+1,sl_next);} \
    CMASK(C0,C1,t); \
    { float a=MX3(C0[0],C0[1],C1[0]),b=MX3(C0[2],C0[3],C1[1]); a=MX3(a,C1[2],C1[3]); \
      _Pragma("unroll") for(int r=4;r<16;r+=4){a=MX3(a,C0[r],C0[r+1]);b=MX3(b,C0[r+2],C0[r+3]);a=MX3(a,C1[r],C1[r+1]);b=MX3(b,C1[r+2],C1[r+3]);} \
      float rm=__builtin_fmaxf(a,b); { auto rr=__builtin_amdgcn_permlane32_swap(__float_as_uint(rm),__float_as_uint(rm),false,false); rm=__builtin_fmaxf(__uint_as_float(rr[0]),__uint_as_float(rr[1])); } \
      resc=false; \
      if(__builtin_expect(__any(rm>(float)THRL),0)){ const float dl=__builtin_fmaxf(rm,0.f); mhat+=dl; \
        _Pragma("unroll") for(int r=0;r<16;++r){C0[r]-=dl;C1[r]-=dl;} \
        _Pragma("unroll") for(int r=0;r<16;++r)negm[r]=-mhat; asm volatile("":"+v"(negm)); \
        const float f=__builtin_amdgcn_exp2f(-dl); l_reg*=f; if(hi==0)wsf[r32]=f; resc=true; } } \
    SBAR(); \
    GAPB(o[0]=__builtin_amdgcn_mfma_f32_32x32x16_bf16(PAF(0),VFR(0),o[0],0,0,0), C0,0); \
    GAPB(o[1]=__builtin_amdgcn_mfma_f32_32x32x16_bf16(PAF(0),VFR(4),o[1],0,0,0), C0,4); \
    KRD(GL,0); GAPB(o[0]=__builtin_amdgcn_mfma_f32_32x32x16_bf16(PAF(1),VFR(1),o[0],0,0,0), C0,8); \
    KRD(GL,1); GAPB(o[1]=__builtin_amdgcn_mfma_f32_32x32x16_bf16(PAF(1),VFR(5),o[1],0,0,0), C0,12); \
    KRD(GL,2); GAPB(o[0]=__builtin_amdgcn_mfma_f32_32x32x16_bf16(PAF(2),VFR(2),o[0],0,0,0), C1,0); \
    KRD(GL,3); GAPB(o[1]=__builtin_amdgcn_mfma_f32_32x32x16_bf16(PAF(2),VFR(6),o[1],0,0,0), C1,4); \
    GAPB(o[0]=__builtin_amdgcn_mfma_f32_32x32x16_bf16(PAF(3),VFR(3),o[0],0,0,0), C1,8); \
    GAPB(o[1]=__builtin_amdgcn_mfma_f32_32x32x16_bf16(PAF(3),VFR(7),o[1],0,0,0), C1,12); \
    }while(0)
  int t=1;
  #undef CMASK
  #define CMASK(P0,P1,t) do{}while(0)
  for(;t+5<NT;t+=2){
    STEP(pB0,pB1,pA0,pA1,t,true,true,true);     WAIT_BAR(2); RESC(); ROT();
    STEP(pA0,pA1,pB0,pB1,t+1,true,true,true);   WAIT_BAR(2); RESC(); ROT();
  }
  #undef CMASK
  #define CMASK(P0,P1,t) do{}while(0)
  #define ENDW(tt) do{ if((tt)+3<NT){WAIT_BAR(2);} else if((tt)+2<NT){WAIT_BAR(1);} else {WAIT_BAR(0);} }while(0)
  for(;t+1<NT;t+=2){
    STEP(pB0,pB1,pA0,pA1,t,(t+3<NT),(t+1<NT),(t+1<NT));       ENDW(t);   RESC(); ROT();
    STEP(pA0,pA1,pB0,pB1,t+1,(t+4<NT),(t+2<NT),(t+2<NT));     ENDW(t+1); RESC(); ROT();
  }
  STEP(pB0,pB1,pA0,pA1,NT-1,false,false,false); RESC();
  { float sacc=pB0[0]+pB0[1]; _Pragma("unroll") for(int r=2;r<16;++r)sacc+=pB0[r]; _Pragma("unroll") for(int r=0;r<16;++r)sacc+=pB1[r]; l_reg+=sacc;
    pw0=(u32x4){PKW(pB0,0),PKW(pB0,2),PKW(pB0,4),PKW(pB0,6)};pw1=(u32x4){PKW(pB0,8),PKW(pB0,10),PKW(pB0,12),PKW(pB0,14)};pw2=(u32x4){PKW(pB1,0),PKW(pB1,2),PKW(pB1,4),PKW(pB1,6)};pw3=(u32x4){PKW(pB1,8),PKW(pB1,10),PKW(pB1,12),PKW(pB1,14)};
    SBAR(); pv(o,vb0+sl_cur,PAF(0),PAF(1),PAF(2),PAF(3)); }
  #undef PKW
  #undef PAF
  #undef VFR
  #undef PIN
  #undef MX3
  #undef GAPA
  #undef GAPB
  #undef EX
  #undef VRD
  #undef KRD
  #undef STEP
  #undef ENDW
  {auto rr=__builtin_amdgcn_permlane32_swap(__float_as_uint(l_reg),__float_as_uint(l_reg),false,false);l_reg=__uint_as_float(rr[0])+__uint_as_float(rr[1]);}
  if(hi==0)wsf[32+r32]=l_reg;asm volatile("s_waitcnt lgkmcnt(0)":::"memory");
  float rli[16];
  #pragma unroll
  for(int r=0;r<16;++r)rli[r]=__builtin_amdgcn_rcpf(wsf[32+crow(r,hi)]);
  bf16*Ow=Ou+(long)(wid*QBLK)*QP;
  { bf16*stg=(bf16*)(shm+LDS_OST)+wid*2048;
    #pragma unroll
    for(int r=0;r<16;++r){const int orow=crow(r,hi);
      #pragma unroll
      for(int d0=0;d0<2;++d0)stg[orow*64+d0*32+r32]=__float2bfloat16(o[d0][r]*rli[r]);}
    asm volatile("s_waitcnt lgkmcnt(0)":::"memory");
    #pragma unroll
    for(int i=0;i<4;++i){const int row=i*8+(lane>>3),ch=lane&7; const u32x4 v=*(const u32x4*)(stg+row*64+ch*8); ATTN_STORE16(Ow+(long)row*QP+ch*8,v);} }
  asm volatile("s_waitcnt lgkmcnt(0)\n\ts_barrier":::"memory");
  #undef DMA_K
  #undef DMA_V
  #undef CMASK
  #undef START
  #undef RESC
  #undef ROT
}
constexpr int ATTN_LDS_BYTES=LDS_BYTES;
#undef SBAR
#undef WAIT_BAR
}

template <bool WCTX>
__device__ __forceinline__ void phase_attn_fast(Frame& F, char* ldsg) {
    typedef attn_body::bf16 abf;
    const abf* Q = (const abf*)(F.ws + WS_QB); const abf* K = (const abf*)(F.ws + WS_KB); const abf* V = (const abf*)(F.ws + WS_VB); abf* O = (abf*)(F.ws + WS_Z);
    const int vcu = (F.G % 8 == 0) ? (F.blk % 8) * (F.G / 8) + F.blk / 8 : F.blk;
    const int nunits = WCTX ? 1024 + 128 : 1024;
    for (int u = vcu; u < nunits; u += F.G) {
        int h, kvh, qrow0, kv0, NT;
        if (u < 1024) { const int grp = u >> 5, b = grp >> 2; kvh = grp & 3; const int qb = (u >> 2) & 7; h = kvh * 4 + (u & 3); qrow0 = TC + b * SEQ + qb * 256; kv0 = b * KVLEN; NT = KVLEN / 64; }
        else { const int u2 = u - 1024, b = u2 >> 4; h = u2 & 15; kvh = h >> 2; qrow0 = b * CTX; kv0 = b * KVLEN + SEQ; NT = CTX / 64; }
        attn_body::attn_unit<8>(Q + (size_t)qrow0 * 1024 + h * 64, K + (size_t)kv0 * 256 + kvh * 64, V + (size_t)kv0 * 256 + kvh * 64, O + (size_t)qrow0 * 1024 + h * 64, NT, ldsg + RING_OFF);
    }
}

constexpr int S5_BU_STRIDE = 132;
constexpr int S5_X_STRIDE = 136;
constexpr int S5_BU_BYTES = 16 * S5_BU_STRIDE * 4, S5_X_BYTES = 16 * S5_X_STRIDE * 2, S5_Y_BYTES = 2 * 64 * 16, S5_U_BYTES = 64 * 16;
constexpr int S5_ITEM_LDS = S5_BU_BYTES + S5_X_BYTES + 2 * S5_Y_BYTES + 4 * S5_U_BYTES;
constexpr int S5_NT = (CTX + SEQ) / 32;
static_assert(4 * S5_ITEM_LDS <= RING_BYTES, "S5 LDS");
#define S5_BAR() do { asm volatile("s_waitcnt lgkmcnt(0)" ::: "memory"); __builtin_amdgcn_s_barrier(); asm volatile("" ::: "memory"); } while (0)
__device__ __forceinline__ f32x2 cmul(f32x2 a, f32x2 b) { return (f32x2){a.x * b.x - a.y * b.y, a.x * b.y + a.y * b.x}; }

template <int J, bool WCTX>
__device__ __forceinline__ void phase_s5_fast(Frame& F) {
    const int lane = F.lane, w = F.wave;
    const bool helper = w >= 4;
    const int iw = w & 3, pairi = iw >> 1, dir = iw & 1;
    const int tq = lane & 15, kg = lane >> 4;
    const bf16* hb = (const bf16*)(F.ws + WS_H); float* ypart = (float*)(F.ws + WS_YSUM); bf16* zb = (bf16*)(F.ws + WS_Z);
    LAS unsigned char* base = F.lds + iw * S5_ITEM_LDS;
    LAS float* BU = (LAS float*)base;
    LAS bf16* XS = (LAS bf16*)(base + S5_BU_BYTES);
    LAS f32x4* YL = (LAS f32x4*)(base + S5_BU_BYTES + S5_X_BYTES);
    LAS v4u* UL = (LAS v4u*)(base + S5_BU_BYTES + S5_X_BYTES + 2 * S5_Y_BYTES);
    for (int it0 = F.blk * 2; it0 < NB * 64; it0 += F.G * 2) {
        const int it = it0 + pairi, b = it >> 6, g = it & 63;
        const int gi = (J * 2 + dir) * 64 + g;
        LAS v4u* TAB = (LAS v4u*)(F.lds);
        LAS f32x2* CST = (LAS f32x2*)(F.lds + 65536);
        LAS float* KMS = (LAS float*)(F.lds + 65536 + 6144);
        static_assert(65536 + 6144 + 8192 <= 4 * S5_ITEM_LDS, "S5 set-up scratch inside the item buffers");
        if (F.tid < 256) { const int i = F.tid >> 6, p = F.tid & 63; const int git = (J * 2 + (i & 1)) * 64 + ((it0 + (i >> 1)) & 63);
            const float dt = expf(F.in[IN_S5LOG][git]);
            const float lr = F.in[IN_S5LRE][git * 64 + p], li = F.in[IN_S5LIM][git * 64 + p]; const float mag = expf(lr * dt); double sd, cd; sincos_d((double)(li * dt), sd, cd);
            const float ar = mag * (float)cd, ai = mag * (float)sd, den = lr * lr + li * li, nr = ar - 1.f, ni = ai;
            const f32x2 a = (f32x2){ar, ai};
            CST[(i * 3 + 0) * 64 + p] = a; CST[(i * 3 + 1) * 64 + p] = cmul(a, a); CST[(i * 3 + 2) * 64 + p] = (f32x2){(nr * lr + ni * li) / den, (ni * lr - nr * li) / den}; }
        __syncthreads();
        for (int f = F.tid; f < 4 * 16 * 64; f += NTHR) {
            const int i = f >> 10, fi = (f >> 6) & 15, ln = f & 63, ltq = ln & 15, lkg = ln >> 4; const int git = (J * 2 + (i & 1)) * 64 + ((it0 + (i >> 1)) & 63);
            unsigned o[4];
            if (fi < 8) {
                const int n = 16 * fi + ltq, p = n >> 1, ri = n & 1;
                f32x2 co = CST[(i * 3 + 2) * 64 + p]; if ((lkg >> 1) == 0) co = cmul(co, CST[(i * 3 + 0) * 64 + p]);
                const float* brp = F.in[IN_S5BRE] + (size_t)git * 1024 + p * 16 + 8 * (lkg & 1); const float* bip = F.in[IN_S5BIM] + (size_t)git * 1024 + p * 16 + 8 * (lkg & 1);
#pragma unroll
                for (int q = 0; q < 4; ++q) { const f32x2 v0 = cmul(co, (f32x2){brp[2 * q], bip[2 * q]}), v1 = cmul(co, (f32x2){brp[2 * q + 1], bip[2 * q + 1]}); o[q] = pk2(ri ? v0.y : v0.x, ri ? v1.y : v1.x); }
            } else {
                const int tau = (fi - 8) >> 2, ks = fi & 3, p0 = 16 * ks + 4 * lkg;
                const float* crp = F.in[IN_S5CRE] + (size_t)git * 1024 + ltq * 64 + p0; const float* cip = F.in[IN_S5CIM] + (size_t)git * 1024 + ltq * 64 + p0;
#pragma unroll
                for (int q = 0; q < 4; ++q) { const f32x2 v = cmul((f32x2){crp[q], cip[q]}, CST[(i * 3 + tau) * 64 + p0 + q]); o[q] = pk2(v.x, -v.y); }
            }
            TAB[f] = (v4u){o[0], o[1], o[2], o[3]};
        }
        __syncthreads();
        if (helper) {
            const f32x4 d4 = *(const f32x4*)(F.in[IN_S5D] + J * D + g * 16 + 4 * kg);
            v4u ub[4]; f32x4 yoA0, yoA1, yoB0, yoB1;
#pragma unroll
            for (int k = 0; k < 4; ++k) ub[k] = *(const v4u*)(hb + (size_t)seq_row(b, dir, 32 * k + 2 * tq + (kg >> 1)) * D + g * 16 + 8 * (kg & 1));
            yoA0 = (f32x4){0.f, 0.f, 0.f, 0.f}; yoA1 = yoA0; yoB0 = yoA0; yoB1 = yoA0;
            S5_BAR();
#pragma unroll 4
            for (int T = -1; T < S5_NT + 3; ++T) {
                const int e = T - 1, d = T + 1;
                const bool e_ok = (e >= 0) && (e < S5_NT) && (WCTX || e >= 8);
                const bool e_second = (e < 8) ? (e >= 4) : (e >= 40);
                if (d >= 0 && d < S5_NT) UL[(d & 3) * 64 + lane] = ub[d & 3];
                if (e_ok) {
#pragma unroll
                    for (int tau = 0; tau < 2; ++tau) {
                        const size_t idx = (size_t)seq_row(b, dir, 32 * e + 2 * tq + tau) * D + g * 16 + 4 * kg;
                        const f32x4 y = YL[((e & 1) * 2 + tau) * 64 + lane];
                        if (!e_second) *(f32x4*)(ypart + idx) = y;
                        else {
                            f32x4 yo = (e & 1) ? (tau ? yoB1 : yoB0) : (tau ? yoA1 : yoA0);
                            if (e == 4 || e == 40) yo = *(const f32x4*)(ypart + idx);
                            const v2u hw = *(const v2u*)(hb + idx);
                            f32x4 v = y + yo; v.x += d4.x * bflo(hw.x); v.y += d4.y * bfhi(hw.x); v.z += d4.z * bflo(hw.y); v.w += d4.w * bfhi(hw.y);
                            v2u zo; zo.x = pk2(gelu_tanh(v.x), gelu_tanh(v.y)); zo.y = pk2(gelu_tanh(v.z), gelu_tanh(v.w));
                            *(v2u*)(zb + idx) = zo;
                        }
                    }
                }
                { const int e1 = e + 1; const bool e1_ok = (e1 >= 0) && (e1 < S5_NT) && (WCTX || e1 >= 8); const bool e1_second = (e1 < 8) ? (e1 >= 4) : (e1 >= 40);
                  if (e1_ok && e1_second && e1 != 4 && e1 != 40) {
                      const f32x4 l0 = *(const f32x4*)(ypart + (size_t)seq_row(b, dir, 32 * e1 + 2 * tq) * D + g * 16 + 4 * kg), l1 = *(const f32x4*)(ypart + (size_t)seq_row(b, dir, 32 * e1 + 2 * tq + 1) * D + g * 16 + 4 * kg);
                      if (e1 & 1) { yoB0 = l0; yoB1 = l1; } else { yoA0 = l0; yoA1 = l1; }
                  } }
                if (d >= 0 && d + 4 < S5_NT) ub[d & 3] = *(const v4u*)(hb + (size_t)seq_row(b, dir, 32 * (d + 4) + 2 * tq + (kg >> 1)) * D + g * 16 + 8 * (kg & 1));
                if (e == 3 || e == 39) asm volatile("s_waitcnt vmcnt(0)" ::: "memory");
                S5_BAR();
            }
        } else {
            const float* cre = F.in[IN_S5CRE] + (size_t)gi * 1024; const float* cim = F.in[IN_S5CIM] + (size_t)gi * 1024;
            bf16x8 wf[8], vkf[2][5];
#pragma unroll
            for (int rt = 0; rt < 8; ++rt) wf[rt] = __builtin_bit_cast(bf16x8, TAB[(iw * 16 + rt) * 64 + lane]);
#pragma unroll
            for (int tau = 0; tau < 2; ++tau)
#pragma unroll
                for (int ks = 0; ks < 4; ++ks) vkf[tau][ks] = __builtin_bit_cast(bf16x8, TAB[(iw * 16 + 8 + tau * 4 + ks) * 64 + lane]);
            const f32x2 a2 = CST[(iw * 3 + 1) * 64 + lane];
            { LAS float* KM = KMS + iw * 512;
              const LAS bf16* W2T = (const LAS bf16*)(TAB + (iw * 16) * 64);
#pragma unroll
              for (int e = 0; e < 2; ++e) {
                  f32x4 acc = (f32x4){0.f, 0.f, 0.f, 0.f};
#pragma unroll
                  for (int ks = 0; ks < 4; ++ks) {
                      bf16x8 cfr, fr;
                      const int p0 = 16 * ks + 4 * kg;
                      const f32x4 cr = *(const f32x4*)(cre + tq * 64 + p0), ci = *(const f32x4*)(cim + tq * 64 + p0);
                      cfr[0] = (short)f2bf(cr.x); cfr[1] = (short)f2bf(-ci.x); cfr[2] = (short)f2bf(cr.y); cfr[3] = (short)f2bf(-ci.y); cfr[4] = (short)f2bf(cr.z); cfr[5] = (short)f2bf(-ci.z); cfr[6] = (short)f2bf(cr.w); cfr[7] = (short)f2bf(-ci.w);
#pragma unroll
                      for (int jj = 0; jj < 8; ++jj) { const int n = 32 * ks + 8 * kg + jj, k = 16 * (1 - e) + tq; fr[jj] = (short)W2T[(((n >> 4) * 64) + (n & 15) + 16 * (k >> 3)) * 8 + (k & 7)]; }
                      acc = __builtin_amdgcn_mfma_f32_16x16x32_bf16(cfr, fr, acc, 0, 0, 0);
                  }
#pragma unroll
                  for (int r = 0; r < 4; ++r) KM[(e * 16 + 4 * kg + r) * 16 + tq] = acc[r];
              }
#pragma unroll
              for (int tau = 0; tau < 2; ++tau) { const int tp = kg >> 1; bf16x8 fr;
#pragma unroll
                  for (int jj = 0; jj < 8; ++jj) { const float v = (tp <= tau) ? KM[((tau - tp) * 16 + tq) * 16 + 8 * (kg & 1) + jj] : 0.f; fr[jj] = (short)f2bf(v); }
                  vkf[tau][4] = fr; } }
            asm volatile("s_waitcnt vmcnt(0) lgkmcnt(0)" ::: "memory");
            f32x2 x = (f32x2){0.f, 0.f};
            const f32x2 a2re = (f32x2){a2.x, a2.x}, a2im = (f32x2){-a2.y, a2.y};
            S5_BAR();
            for (int T = -1; T < S5_NT + 3; ++T) {
                if (T >= 0 && T < S5_NT) {
                    const bf16x8 uf = __builtin_bit_cast(bf16x8, UL[(T & 3) * 64 + lane]);
#pragma unroll
                    for (int rt = 0; rt < 8; ++rt) {
                        const f32x4 dacc = __builtin_amdgcn_mfma_f32_16x16x32_bf16(wf[rt], uf, (f32x4){0.f, 0.f, 0.f, 0.f}, 0, 0, 0);
                        *(LAS f32x4*)(BU + tq * S5_BU_STRIDE + 16 * rt + 4 * kg) = dacc;
                    }
                    f32x2 buv[16]; unsigned xw[16];
#pragma unroll
                    for (int t = 0; t < 16; ++t) buv[t] = *(const LAS f32x2*)(BU + t * S5_BU_STRIDE + 2 * lane);
#pragma unroll
                    for (int t = 0; t < 16; ++t) { xw[t] = pk2(x.x, x.y); const f32x2 xs = (f32x2){x.y, x.x}; x = a2re * x + (a2im * xs + buv[t]); }
                    if (WCTX || T >= 8) {
#pragma unroll
                        for (int t = 0; t < 16; ++t) *(LAS unsigned*)(XS + t * S5_X_STRIDE + 2 * lane) = xw[t];
                        bf16x8 xf[4];
#pragma unroll
                        for (int ks = 0; ks < 4; ++ks) xf[ks] = *(const LAS bf16x8*)(XS + tq * S5_X_STRIDE + 32 * ks + 8 * kg);
#pragma unroll
                        for (int tau = 0; tau < 2; ++tau) {
                            f32x4 y = __builtin_amdgcn_mfma_f32_16x16x32_bf16(vkf[tau][4], uf, (f32x4){0.f, 0.f, 0.f, 0.f}, 0, 0, 0);
#pragma unroll
                            for (int ks = 0; ks < 4; ++ks) y = __builtin_amdgcn_mfma_f32_16x16x32_bf16(vkf[tau][ks], xf[ks], y, 0, 0, 0);
                            YL[((T & 1) * 2 + tau) * 64 + lane] = y;
                        }
                    }
                }
                S5_BAR();
            }
        }
        __syncthreads();
    }
}

constexpr size_t WS_MCT = WS_MHS;
constexpr size_t WS_MN = WS_MG + 2359296;
constexpr size_t WS_MSC = WS_MN + 589824;
static_assert(WS_MSC + 2304 * 16 <= WS_MHS, "mLSTM small tables");
constexpr int ML_TS = 136;
constexpr int ML_DS = 72;

template <bool MAX>
__device__ __forceinline__ void scan128(LAS float* a, int lane) {
    const float v0 = a[2 * lane], v1 = a[2 * lane + 1];
    const float s = MAX ? fmaxf(v0, v1) : v0 + v1;
    float inc = s;
#pragma unroll
    for (int o = 1; o < 64; o <<= 1) { const float t = __shfl_up(inc, o); if (lane >= o) inc = MAX ? fmaxf(inc, t) : inc + t; }
    float exc = __shfl_up(inc, 1); if (lane == 0) exc = MAX ? -INFINITY : 0.f;
    a[2 * lane] = MAX ? fmaxf(exc, v0) : exc + v0; a[2 * lane + 1] = inc;
}

__device__ __forceinline__ void phase_ml_states(Frame& F) {
    const int tid = F.tid, lane = F.lane, w = F.wave, tq = lane & 15, kg = lane >> 4;
    const bf16* kb = (const bf16*)(F.ws + WS_MK); const bf16* vb = (const bf16*)(F.ws + WS_MV); const float* gb = (const float*)(F.ws + WS_MG);
    float* cT = (float*)(F.ws + WS_MCT); float* nl = (float*)(F.ws + WS_MN); float* sc = (float*)(F.ws + WS_MSC);
    LAS bf16* KeT = (LAS bf16*)(F.lds);
    LAS bf16* VT = (LAS bf16*)(F.lds + 64 * ML_TS * 2);
    LAS float* cumS = (LAS float*)(F.lds + 192 * ML_TS * 2);
    LAS float* igS = cumS + 128; LAS float* ewS = igS + 128; LAS float* red = ewS + 128;
    for (int us = F.blk; us < 2304; us += F.G) {
        const int jc = us % 18, bhd = us / 18, dir = bhd & 1, hd = (bhd >> 1) & 7, b = bhd >> 4;
        if (tid < 128) { const int r = seq_row(b, dir, 128 * jc + tid); igS[tid] = gb[(size_t)r * 32 + dir * 16 + hd]; cumS[tid] = log_sigmoidf_(gb[(size_t)r * 32 + dir * 16 + 8 + hd]); }
        __syncthreads();
        if (w == 0) {
            scan128<false>(cumS, lane);
            const float total = __shfl(cumS[2 * lane + 1], 63);
            const float w0 = total - cumS[2 * lane] + igS[2 * lane], w1 = total - cumS[2 * lane + 1] + igS[2 * lane + 1];
            const float ml = wave_max(fmaxf(w0, w1));
            ewS[2 * lane] = __expf(w0 - ml); ewS[2 * lane + 1] = __expf(w1 - ml);
            if (lane == 0) { sc[(size_t)us * 4] = total; sc[(size_t)us * 4 + 1] = ml; }
        }
        __syncthreads();
        { const int i = tid & 127, c = tid >> 7; const int r = seq_row(b, dir, 128 * jc + i); const float e = ewS[i];
#pragma unroll
          for (int h2 = 0; h2 < 2; ++h2) { const v4u kw = *(const v4u*)(kb + (size_t)r * 512 + hd * 64 + 16 * c + 8 * h2);
              const float kv[8] = {bflo(kw.x), bfhi(kw.x), bflo(kw.y), bfhi(kw.y), bflo(kw.z), bfhi(kw.z), bflo(kw.w), bfhi(kw.w)};
#pragma unroll
              for (int jj = 0; jj < 8; ++jj) KeT[(16 * c + 8 * h2 + jj) * ML_TS + i] = (bf16)f2bf(kv[jj] * e); }
#pragma unroll
          for (int h4 = 0; h4 < 4; ++h4) { const v4u vw = *(const v4u*)(vb + (size_t)r * 1024 + hd * 128 + 32 * c + 8 * h4);
              const unsigned vv[4] = {vw.x, vw.y, vw.z, vw.w};
#pragma unroll
              for (int jj = 0; jj < 8; ++jj) VT[(32 * c + 8 * h4 + jj) * ML_TS + i] = (bf16)((jj & 1) ? (vv[jj >> 1] >> 16) : (vv[jj >> 1] & 0xffffu)); } }
        __syncthreads();
#pragma unroll
        for (int dt = 0; dt < 4; ++dt) {
            f32x4 acc = (f32x4){0.f, 0.f, 0.f, 0.f};
#pragma unroll
            for (int ks = 0; ks < 4; ++ks) {
                const bf16x8 af = *(const LAS bf16x8*)(VT + (16 * w + tq) * ML_TS + 32 * ks + 8 * kg);
                const bf16x8 bfr = *(const LAS bf16x8*)(KeT + (16 * dt + tq) * ML_TS + 32 * ks + 8 * kg);
                acc = __builtin_amdgcn_mfma_f32_16x16x32_bf16(af, bfr, acc, 0, 0, 0);
            }
#pragma unroll
            for (int r = 0; r < 4; ++r) cT[(size_t)us * 8192 + (16 * w + 4 * kg + r) * 64 + 16 * dt + tq] = acc[r];
        }
        if (tid < 64) { float s = 0.f;
#pragma unroll
            for (int c8 = 0; c8 < 16; ++c8) { const v4u q = *(const LAS v4u*)(KeT + tid * ML_TS + 8 * c8); s += bflo(q.x) + bfhi(q.x) + bflo(q.y) + bfhi(q.y) + bflo(q.z) + bfhi(q.z) + bflo(q.w) + bfhi(q.w); }
            nl[(size_t)us * 64 + tid] = s; }
        __syncthreads();
    }
}

__device__ __forceinline__ void phase_ml_scan(Frame& F, const int skip = 0) {
    const int tid = F.tid;
    float* cT = (float*)(F.ws + WS_MCT); float* nl = (float*)(F.ws + WS_MN); float* sc = (float*)(F.ws + WS_MSC);
    for (int wi = F.blk; wi < 256; wi += F.G) {
        const int sq = wi >> 1, half = wi & 1; const bool don = (half == 0 && tid < 64);
        const size_t e0 = (size_t)half * 4096 + (size_t)tid * 8;
        f32x4 c0 = (f32x4){0.f, 0.f, 0.f, 0.f}, c1 = c0; float nn = 0.f, m = 0.f;
        size_t us = (size_t)sq * 18;
        f32x4 l0 = *(const f32x4*)(cT + us * 8192 + e0), l1 = *(const f32x4*)(cT + us * 8192 + e0 + 4);
        float ln = don ? nl[us * 64 + tid] : 0.f, tot = sc[us * 4], ml = sc[us * 4 + 1];
        for (int j = 0; j < 18; ++j, ++us) {
            const f32x4 a0 = l0, a1 = l1; const float an = ln, atot = tot, aml = ml;
            if (j + 1 < 18) { l0 = *(const f32x4*)(cT + (us + 1) * 8192 + e0); l1 = *(const f32x4*)(cT + (us + 1) * 8192 + e0 + 4); ln = don ? nl[(us + 1) * 64 + tid] : 0.f; tot = sc[(us + 1) * 4]; ml = sc[(us + 1) * 4 + 1]; }
            if (!skip) { *(f32x4*)(cT + us * 8192 + e0) = c0; *(f32x4*)(cT + us * 8192 + e0 + 4) = c1;
            if (don) nl[us * 64 + tid] = nn;
            if (half == 0 && tid == 0) sc[us * 4 + 2] = m; }
            const float mn = fmaxf(atot + m, aml), fa = __expf(atot + m - mn), fb = __expf(aml - mn);
            c0 = c0 * fa + a0 * fb; c1 = c1 * fa + a1 * fb; nn = nn * fa + an * fb; m = mn;
        }
    }
}

struct M3Regs { float gi, gf, n0v, m00, m01; v4u q[2], k[2], v[4]; };
__device__ __forceinline__ void m3_load(M3Regs& R, Frame& F, int u, int tid) {
    const bf16* kb = (const bf16*)(F.ws + WS_MK); const bf16* vb = (const bf16*)(F.ws + WS_MV); const bf16* qb = (const bf16*)(F.ws + WS_MQ);
    const float* gb = (const float*)(F.ws + WS_MG); const float* cT = (const float*)(F.ws + WS_MCT); const float* nl = (const float*)(F.ws + WS_MN); const float* sc = (const float*)(F.ws + WS_MSC);
    const int jo = u % 18, bh = u / 18, hd = bh & 7, b = bh >> 3;
    const int row0 = (jo < 2) ? b * CTX + 128 * jo : TC + b * SEQ + 128 * (jo - 2);
    const int jc1 = (jo < 2) ? 1 - jo : 19 - jo;
    const size_t us0 = (size_t)((b * 8 + hd) * 2 + 0) * 18 + jo, us1 = (size_t)((b * 8 + hd) * 2 + 1) * 18 + jc1;
    R.m00 = sc[us0 * 4 + 2]; R.m01 = sc[us1 * 4 + 2];
    R.gi = 0.f; R.gf = 0.f; R.n0v = 0.f;
    if (tid < 256) { const int dd = tid >> 7, sp = tid & 127; const int r = row0 + (dd ? 127 - sp : sp); R.gi = gb[(size_t)r * 32 + dd * 16 + hd]; R.gf = gb[(size_t)r * 32 + dd * 16 + 8 + hd]; }
    { const int i = tid & 127, c = tid >> 7; const int r = row0 + i;
#pragma unroll
      for (int h2 = 0; h2 < 2; ++h2) { R.q[h2] = *(const v4u*)(qb + (size_t)r * 512 + hd * 64 + 16 * c + 8 * h2); R.k[h2] = *(const v4u*)(kb + (size_t)r * 512 + hd * 64 + 16 * c + 8 * h2); } }
    { const int tp = tid & 63, c8 = tid >> 6;
#pragma unroll
      for (int tk = 0; tk < 2; ++tk)
#pragma unroll
          for (int h2 = 0; h2 < 2; ++h2) R.v[2 * tk + h2] = *(const v4u*)(vb + (size_t)(row0 + 2 * tp + tk) * 1024 + hd * 128 + 16 * c8 + 8 * h2); }
    if (tid < 128) R.n0v = nl[((tid >> 6) ? us1 : us0) * 64 + (tid & 63)];
}
__device__ __forceinline__ void phase_ml_out(Frame& F) {
    const int tid = F.tid, lane = F.lane, w = F.wave, tq = lane & 15, kg = lane >> 4;
    const bf16* ob = (const bf16*)(F.ws + WS_MO); bf16* zb = (bf16*)(F.ws + WS_Z);
    LAS bf16* QL = (LAS bf16*)(F.lds);
    LAS bf16* KL = (LAS bf16*)(F.lds + 18432);
    LAS bf16* SwL = (LAS bf16*)(F.lds + w * (16 * ML_TS * 2));
    LAS bf16* VT = (LAS bf16*)(F.lds + 36864);
    LAS bf16* C0T = (LAS bf16*)(F.lds + 36864 + 128 * ML_TS * 2);
    LAS float* GT = (LAS float*)(F.lds + 36864 + 128 * ML_TS * 2 + 2 * 144 * ML_DS * 2);
    static_assert(36864 + 128 * ML_TS * 2 + 2 * 144 * ML_DS * 2 + 2 * 3 * 128 * 4 <= RING_BYTES, "M3 LDS");
    for (int i = tid; i < 2 * 16 * ML_DS; i += NTHR) { const int dd = i / (16 * ML_DS), ii = i % (16 * ML_DS); C0T[dd * 144 * ML_DS + 128 * ML_DS + ii] = (bf16)0u; }
    constexpr int NU = NB * 8 * 18;
    M3Regs R;
    if (F.blk < NU) m3_load(R, F, F.blk, tid);
    __syncthreads();
    for (int u = F.blk; u < NU; u += F.G) {
        const int jo = u % 18, bh = u / 18, hd = bh & 7, b = bh >> 3;
        const int row0 = (jo < 2) ? b * CTX + 128 * jo : TC + b * SEQ + 128 * (jo - 2);
        const float m00 = R.m00, m01 = R.m01;
        if (tid < 256) { const int dd = tid >> 7, sp = tid & 127; GT[dd * 384 + sp] = R.gi; GT[dd * 384 + 256 + sp] = log_sigmoidf_(R.gf); }
        { const int i = tid & 127, c = tid >> 7;
#pragma unroll
          for (int h2 = 0; h2 < 2; ++h2) { *(LAS v4u*)(QL + i * ML_DS + 16 * c + 8 * h2) = R.q[h2]; *(LAS v4u*)(KL + i * ML_DS + 16 * c + 8 * h2) = R.k[h2]; } }
        { const int tp = tid & 63, c8 = tid >> 6;
#pragma unroll
          for (int h2 = 0; h2 < 2; ++h2) { const v4u a = R.v[h2], bq = R.v[2 + h2]; const unsigned av[4] = {a.x, a.y, a.z, a.w}, bv[4] = {bq.x, bq.y, bq.z, bq.w};
#pragma unroll
              for (int jj = 0; jj < 8; ++jj) { const unsigned lo = (jj & 1) ? (av[jj >> 1] >> 16) : (av[jj >> 1] & 0xffffu), hi = (jj & 1) ? (bv[jj >> 1] & 0xffff0000u) : (bv[jj >> 1] << 16);
                  *(LAS unsigned*)(VT + (16 * c8 + 8 * h2 + jj) * ML_TS + 2 * tp) = lo | hi; } } }
        { const float* cT = (const float*)(F.ws + WS_MCT); const int jc1 = (jo < 2) ? 1 - jo : 19 - jo;
          const size_t us0 = (size_t)((b * 8 + hd) * 2 + 0) * 18 + jo, us1 = (size_t)((b * 8 + hd) * 2 + 1) * 18 + jc1;
#pragma unroll
          for (int dd = 0; dd < 2; ++dd) { const size_t us = dd ? us1 : us0; const int jv = tid >> 2, dq = (tid & 3) * 16; const float* src = cT + us * 8192 + jv * 64 + dq;
#pragma unroll
              for (int h2 = 0; h2 < 2; ++h2) { const f32x4 a = *(const f32x4*)(src + 8 * h2), bq = *(const f32x4*)(src + 8 * h2 + 4);
                  v4u o; o.x = pk2(a.x, a.y); o.y = pk2(a.z, a.w); o.z = pk2(bq.x, bq.y); o.w = pk2(bq.z, bq.w);
                  *(LAS v4u*)(C0T + dd * 144 * ML_DS + jv * ML_DS + dq + 8 * h2) = o; } } }
        if (tid < 128) C0T[(tid >> 6) * 144 * ML_DS + 128 * ML_DS + (tid & 63)] = (bf16)f2bf(R.n0v);
        __syncthreads();
        if (u + F.G < NU) m3_load(R, F, u + F.G, tid);
        if (w < 2) {
            LAS float* gS = GT + w * 384; LAS float* mmS = gS + 128; LAS float* cumS = gS + 256; const float m0 = w ? m01 : m00;
            scan128<false>(cumS, lane);
            const float g0 = gS[2 * lane] - cumS[2 * lane], g1 = gS[2 * lane + 1] - cumS[2 * lane + 1];
            gS[2 * lane] = g0; gS[2 * lane + 1] = g1; mmS[2 * lane] = g0; mmS[2 * lane + 1] = g1;
            scan128<true>(mmS, lane);
            mmS[2 * lane] = fmaxf(mmS[2 * lane], m0); mmS[2 * lane + 1] = fmaxf(mmS[2 * lane + 1], m0);
        }
        __syncthreads();
        bf16x8 qf[2];
#pragma unroll
        for (int ks = 0; ks < 2; ++ks) qf[ks] = *(const LAS bf16x8*)(QL + (16 * w + tq) * ML_DS + 32 * ks + 8 * kg);
        float mm0r[4], mm1r[4], ai0[4], ai1[4], lb0[4], lb1[4];
#pragma unroll
        for (int r = 0; r < 4; ++r) { const int t0 = 16 * w + 4 * kg + r, t1 = 127 - t0;
            mm0r[r] = GT[128 + t0]; ai0[r] = __expf(m00 - mm0r[r]); lb0[r] = __expf(-GT[256 + t0] - mm0r[r]);
            mm1r[r] = GT[384 + 128 + t1]; ai1[r] = __expf(m01 - mm1r[r]); lb1[r] = __expf(-GT[384 + 256 + t1] - mm1r[r]); }
        f32x4 sraw[8]; float rs0[4] = {0.f, 0.f, 0.f, 0.f}, rs1[4] = {0.f, 0.f, 0.f, 0.f};
#pragma unroll
        for (int ct = 0; ct < 8; ++ct) {
            f32x4 a = (f32x4){0.f, 0.f, 0.f, 0.f};
#pragma unroll
            for (int ks = 0; ks < 2; ++ks) a = __builtin_amdgcn_mfma_f32_16x16x32_bf16(qf[ks], *(const LAS bf16x8*)(KL + (16 * ct + tq) * ML_DS + 32 * ks + 8 * kg), a, 0, 0, 0);
            sraw[ct] = a;
            const int o = 16 * ct + tq; const float g0o = GT[o], g1o = GT[384 + 127 - o];
#pragma unroll
            for (int r = 0; r < 4; ++r) { const int t0 = 16 * w + 4 * kg + r;
                rs0[r] += (o <= t0) ? a[r] * __expf(g0o - mm0r[r]) : 0.f; rs1[r] += (o >= t0) ? a[r] * __expf(g1o - mm1r[r]) : 0.f; }
        }
        f32x4 acc[8]; float sc0[4], sc1[4];
        {
            f32x4 q0 = (f32x4){0.f, 0.f, 0.f, 0.f}, q1 = q0;
#pragma unroll
            for (int ks = 0; ks < 2; ++ks) { q0 = __builtin_amdgcn_mfma_f32_16x16x32_bf16(qf[ks], *(const LAS bf16x8*)(C0T + (128 + tq) * ML_DS + 32 * ks + 8 * kg), q0, 0, 0, 0);
                                             q1 = __builtin_amdgcn_mfma_f32_16x16x32_bf16(qf[ks], *(const LAS bf16x8*)(C0T + 144 * ML_DS + (128 + tq) * ML_DS + 32 * ks + 8 * kg), q1, 0, 0, 0); }
#pragma unroll
            for (int r = 0; r < 4; ++r) {
                const float qn0 = red16_sum(q0[r]), qn1 = red16_sum(q1[r]);
                const float den0 = ai0[r] * qn0 + red16_sum(rs0[r]), den1 = ai1[r] * qn1 + red16_sum(rs1[r]);
                const float inv0 = __builtin_amdgcn_rcpf(fmaxf(fabsf(den0), lb0[r])), inv1 = __builtin_amdgcn_rcpf(fmaxf(fabsf(den1), lb1[r]));
                rs0[r] = inv0; rs1[r] = inv1; sc0[r] = ai0[r] * inv0; sc1[r] = ai1[r] * inv1; }
        }
#pragma unroll
        for (int ct = 0; ct < 8; ++ct) {
            f32x4 a0 = (f32x4){0.f, 0.f, 0.f, 0.f}, a1 = a0;
#pragma unroll
            for (int ks = 0; ks < 2; ++ks) { a0 = __builtin_amdgcn_mfma_f32_16x16x32_bf16(qf[ks], *(const LAS bf16x8*)(C0T + (16 * ct + tq) * ML_DS + 32 * ks + 8 * kg), a0, 0, 0, 0);
                                             a1 = __builtin_amdgcn_mfma_f32_16x16x32_bf16(qf[ks], *(const LAS bf16x8*)(C0T + 144 * ML_DS + (16 * ct + tq) * ML_DS + 32 * ks + 8 * kg), a1, 0, 0, 0); }
#pragma unroll
            for (int r = 0; r < 4; ++r) acc[ct][r] = a0[r] * sc0[r] + a1[r] * sc1[r];
        }
        __syncthreads();
#pragma unroll
        for (int ct = 0; ct < 8; ++ct) { const int o = 16 * ct + tq; const float g0o = GT[o], g1o = GT[384 + 127 - o];
#pragma unroll
            for (int r = 0; r < 4; ++r) { const int t0 = 16 * w + 4 * kg + r;
                const float x0 = (o <= t0) ? __expf(g0o - mm0r[r]) * rs0[r] : 0.f, x1 = (o >= t0) ? __expf(g1o - mm1r[r]) * rs1[r] : 0.f;
                SwL[(4 * kg + r) * ML_TS + 16 * ct + tq] = (bf16)f2bf(sraw[ct][r] * (x0 + x1)); } }
#pragma unroll
        for (int ks = 0; ks < 4; ++ks) {
            const bf16x8 af = *(const LAS bf16x8*)(SwL + tq * ML_TS + 32 * ks + 8 * kg);
#pragma unroll
            for (int ct = 0; ct < 8; ++ct) acc[ct] = __builtin_amdgcn_mfma_f32_16x16x32_bf16(af, *(const LAS bf16x8*)(VT + (16 * ct + tq) * ML_TS + 32 * ks + 8 * kg), acc[ct], 0, 0, 0);
        }
        float ss[4] = {0.f, 0.f, 0.f, 0.f};
#pragma unroll
        for (int ct = 0; ct < 8; ++ct) { ss[0] += acc[ct].x * acc[ct].x; ss[1] += acc[ct].y * acc[ct].y; ss[2] += acc[ct].z * acc[ct].z; ss[3] += acc[ct].w * acc[ct].w; }
#pragma unroll
        for (int r = 0; r < 4; ++r) ss[r] = rsqrtf(red16_sum(ss[r]) * (1.f / 128.f) + EPS);
#pragma unroll
        for (int ct = 0; ct < 8; ++ct) { const float gn = F.in[IN_MLNG][hd * 128 + 16 * ct + tq];
#pragma unroll
            for (int r = 0; r < 4; ++r) SwL[(4 * kg + r) * ML_TS + 16 * ct + tq] = (bf16)f2bf(acc[ct][r] * ss[r] * gn); }
#pragma unroll
        for (int i = 0; i < 4; ++i) { const int rr = 4 * i + kg, ch = tq;
            const v4u hv = *(const LAS v4u*)(SwL + rr * ML_TS + 8 * ch);
            const size_t idx = (size_t)(row0 + 16 * w + rr) * D + hd * 128 + 8 * ch;
            const v4u ov = *(const v4u*)(ob + idx);
            v4u zo; zo.x = pk2(bflo(hv.x) * sigmoidf_(bflo(ov.x)), bfhi(hv.x) * sigmoidf_(bfhi(ov.x))); zo.y = pk2(bflo(hv.y) * sigmoidf_(bflo(ov.y)), bfhi(hv.y) * sigmoidf_(bfhi(ov.y)));
            zo.z = pk2(bflo(hv.z) * sigmoidf_(bflo(ov.z)), bfhi(hv.z) * sigmoidf_(bfhi(ov.z))); zo.w = pk2(bflo(hv.w) * sigmoidf_(bflo(ov.w)), bfhi(hv.w) * sigmoidf_(bfhi(ov.w)));
            *(v4u*)(zb + idx) = zo; }
        __syncthreads();
    }
}

#ifndef USE_NAIVE_ATTN
#define USE_NAIVE_ATTN 0
#endif
#ifndef USE_NAIVE_S5
#define USE_NAIVE_S5 0
#endif
#ifndef USE_NAIVE_MLSTM
#define USE_NAIVE_MLSTM 0
#endif
#ifndef MK_MODE
#define MK_MODE 0
#endif
struct Args { const float* in[N_INPUTS]; float* out; unsigned char* ws; int ph_lo, ph_hi; };
enum { CBASE = __COUNTER__ + 1 };
#ifndef S5VAR
#define S5VAR 0
#endif
#ifndef DUP_A
#define DUP_A -1
#endif
#ifndef DUP_B
#define DUP_B -1
#endif
#define PHASE_IDS() { int t_ = threadIdx.x; asm volatile("" : "+v"(t_)); F.tid = t_; F.lane = t_ & 63; F.wave = __builtin_amdgcn_readfirstlane(t_ >> 6); }
#ifndef SW_PHASE
#define SW_PHASE -1
#endif
#define PHASE(...) { constexpr int k_ = __COUNTER__ - CBASE; if (lo <= k_ && k_ < hi) { PHASE_IDS() unsigned long long swt_ = 0; if (k_ == SW_PHASE) swt_ = __builtin_amdgcn_s_memtime(); \
    { constexpr int rep_ = 0; (void)rep_; __VA_ARGS__ } \
    if constexpr (k_ == DUP_A || k_ == DUP_B) { xcd_barrier(bar); { constexpr int rep_ = 1; (void)rep_; __VA_ARGS__ } } \
    if (k_ + 1 < hi) xcd_barrier(bar); \
    if (k_ == SW_PHASE && F.blk == 0 && threadIdx.x == 0) F.ctl[64] = (unsigned)((__builtin_amdgcn_s_memtime() - swt_) >> 4); } }

__global__ void __launch_bounds__(NTHR, 2) fwd_kernel(Args args) {
    extern __shared__ __attribute__((aligned(16))) unsigned char lds[];
    Frame F;
    F.lds = (LAS unsigned char*)lds;
    F.MISC = (volatile LAS unsigned*)(F.lds + MISC_OFF);
    F.tid = threadIdx.x; F.lane = F.tid & 63; F.wave = __builtin_amdgcn_readfirstlane(F.tid >> 6);
    F.G = gridDim.x; F.blk = blockIdx.x;
    F.ws = args.ws; F.out = args.out; F.ctl = (unsigned*)(args.ws + WS_CTL);
#pragma unroll
    for (int i = 0; i < N_INPUTS; ++i) F.in[i] = args.in[i];
    for (int u = F.tid; u < (LDS_BYTES - LDSCTL_OFF) / 4; u += NTHR) ((LAS unsigned*)(F.lds + LDSCTL_OFF))[u] = 0u;
    __syncthreads();
    const int lo = args.ph_lo, hi = args.ph_hi;
    XcdBarrier bar; bar.bar = F.ctl + CW_BAR; bar.x = 0; bar.st = nullptr;
    if (hi - lo > 1) bar = xcd_barrier_post(F.ctl + CW_BAR, F.MISC + 8);

    unsigned char* ws = F.ws;
    bf16* xres = (bf16*)(ws + WS_XRES); const float* mod = (const float*)(ws + WS_MOD);
    bf16* hb = (bf16*)(ws + WS_H); bf16* zb = (bf16*)(ws + WS_Z);
    const LAS int* etab = (const LAS int*)(F.lds + ETAB_OFF);

#define MOE_PHASES(L) \
    PHASE(phase_n2<L>(F, rep_);) \
    PHASE(phase_sc<L>(F);) \
    PHASE({ load_etab(F); pg8::Gemm g{(const bf16*)(ws + WS_H), (const bf16*)(ws + WS_WG1) + (size_t)(L) * NEXP * 1024 * 1024, SLOTS, NEXP * 1024, 1024, (const int*)(ws + WS_SLOTR)}; \
               MoeSched S{etab, F.G, F.blk, 4}; EpiG1 E{(bf16*)(ws + WS_HID)}; run_gemm_gather(F, g, S, E); }) \
    PHASE({ load_etab(F); pg8::Gemm g{(const bf16*)(ws + WS_HID), (const bf16*)(ws + WS_WG2) + (size_t)(L) * NEXP * 1024 * 512, SLOTS, NEXP * 1024, 512}; \
               MoeSched S{etab, F.G, F.blk, 4}; EpiG2 E{(bf16*)(ws + WS_Y2), (const float*)(ws + WS_SLOTW)}; run_gemm(F, g, S, E); })

    PHASE(phase_prologue(F);)
    PHASE(phase_a1<0>(F, rep_);)
#if USE_NAIVE_S5
    PHASE(phase_s5_naive<0, true>(F);)
    PHASE(phase_s5_combine<0, true>(F);)
#else
    PHASE(phase_s5_fast<0, true>(F);)
#endif
    PHASE({ pg8::Gemm g{zb, (const bf16*)(ws + WS_WGLU), T, 2048, 1024}; DenseSchedH S; S.init(T, 2048, F.G, F.blk, 0);
               EpiGlu E{xres, mod + 0 * 9 * 6144 + 2048, F.in[IN_S5BGLU], rep_}; run_gemm(F, g, S, E); })
    MOE_PHASES(0)
    PHASE(phase_a1<1>(F, rep_);)
    PHASE({ pg8::Gemm g{hb, (const bf16*)(ws + WS_WKVQ), T, 1536, 1024}; DenseSched S; S.init(T, 1536, F.G, F.blk, 0);
               EpiKvq E{(bf16*)(ws + WS_QB), (bf16*)(ws + WS_KB), (bf16*)(ws + WS_VB), F.in[IN_AQG], F.in[IN_AKG], (const float*)(ws + WS_ROPE)}; run_gemm(F, g, S, E); })
#if USE_NAIVE_ATTN
    PHASE(phase_attn_naive<true>(F);)
#else
    PHASE(phase_attn_fast<true>(F, (char*)lds);)
#endif
    PHASE({ pg8::Gemm g{zb, (const bf16*)(ws + WS_WO), T, 1024, 1024}; DenseSchedH S; S.init(T, 1024, F.G, F.blk, 0);
               EpiRes E{xres, mod + 1 * 9 * 6144 + 2048, rep_, (bf16*)(ws + WS_MIX)}; run_gemm(F, g, S, E); })
    MOE_PHASES(1)
    PHASE(phase_a1<2>(F, rep_);)
    PHASE({ pg8::Gemm g{hb, (const bf16*)(ws + WS_WIN), T, ML_NIN, 1024}; DenseSched S; S.init(T, ML_NIN, F.G, F.blk, 0);
               EpiMlIn E{(bf16*)(ws + WS_MK), (bf16*)(ws + WS_MV), (bf16*)(ws + WS_MQ), (bf16*)(ws + WS_MO), (float*)(ws + WS_MG), F.in[IN_MLBG]}; run_gemm(F, g, S, E); })
#if USE_NAIVE_MLSTM
    PHASE(phase_mlstm_naive<true>(F);)
    PHASE(phase_mlstm_combine<true>(F);)
#else
    PHASE(phase_ml_states(F);)
    PHASE(phase_ml_scan(F, rep_);)
    PHASE(phase_ml_out(F);)
#endif
    PHASE({ pg8::Gemm g{zb, (const bf16*)(ws + WS_WOUT), T, 1024, 1024}; DenseSchedH S; S.init(T, 1024, F.G, F.blk, 0);
               EpiRes E{xres, mod + 2 * 9 * 6144 + 2048, rep_, (bf16*)(ws + WS_MHS)}; run_gemm(F, g, S, E); })
    MOE_PHASES(2)
    PHASE(phase_a1<3>(F, rep_);)
#if USE_NAIVE_S5
    PHASE(phase_s5_naive<1, false>(F);)
    PHASE(phase_s5_combine<1, false>(F);)
#else
    PHASE(phase_s5_fast<1, false>(F);)
#endif
    PHASE({ pg8::Gemm g{zb, (const bf16*)(ws + WS_WGLU) + (size_t)2048 * 1024, T, 2048, 1024}; DenseSched S; S.init(TL, 2048, F.G, F.blk, TC / 256);
               EpiGlu E{xres, mod + 3 * 9 * 6144 + 2048, F.in[IN_S5BGLU] + 2048, rep_}; run_gemm(F, g, S, E); })
    MOE_PHASES(3)
    PHASE(phase_fin(F);)
#if SW_PHASE >= 0
    if (F.blk == 0 && threadIdx.x == 0) { const unsigned v = __hip_atomic_load(F.ctl + 64, __ATOMIC_RELAXED, __HIP_MEMORY_SCOPE_AGENT); const unsigned long long t0 = __builtin_amdgcn_s_memtime();
        while (__builtin_amdgcn_s_memtime() - t0 < (unsigned long long)v * 16ull * 16ull) __builtin_amdgcn_s_sleep(8); }
#endif
}
constexpr int NPH = __COUNTER__ - CBASE;

extern "C" void kernel_launch(void* const* d_in, const int* in_sizes, int n_in, void* d_out, int out_size, void* d_ws, size_t ws_size, hipStream_t stream) {
    static int grid = 0;
    if (grid == 0) {
        if (n_in != N_INPUTS || out_size != TL * D || ws_size < WS_END) { fprintf(stderr, "kernel_launch: unexpected problem: n_in %d out %d ws %zu (need %zu)\n", n_in, out_size, ws_size, (size_t)WS_END); grid = -1; return; }
        int dev = 0, cus = 0, per_cu = 0;
        if (hipGetDevice(&dev) != hipSuccess || hipDeviceGetAttribute(&cus, hipDeviceAttributeMultiprocessorCount, dev) != hipSuccess) { grid = -1; return; }
        if (hipFuncSetAttribute((const void*)fwd_kernel, hipFuncAttributeMaxDynamicSharedMemorySize, LDS_BYTES) != hipSuccess) { fprintf(stderr, "kernel_launch: hipFuncSetAttribute failed\n"); grid = -1; return; }
        if (hipOccupancyMaxActiveBlocksPerMultiprocessor(&per_cu, (const void*)fwd_kernel, NTHR, LDS_BYTES) != hipSuccess || per_cu < 1) fprintf(stderr, "kernel_launch: occupancy query reports %d\n", per_cu);
        (void)hipGetLastError();
        grid = cus;
        if (grid > 256) grid = 256;
    }
    if (grid < 0) return;
    if (hipMemsetAsync((char*)d_ws + WS_CTL, 0, CTL_ZERO_BYTES, stream) != hipSuccess) return;
    Args a{};
    for (int i = 0; i < N_INPUTS; ++i) a.in[i] = (const float*)d_in[i];
    a.out = (float*)d_out; a.ws = (unsigned char*)d_ws;
#if MK_MODE == 0
    a.ph_lo = 0; a.ph_hi = NPH;
    hipLaunchKernelGGL(fwd_kernel, dim3(grid), dim3(NTHR), LDS_BYTES, stream, a);
#else
    for (int p = 0; p < NPH; ++p) { a.ph_lo = p; a.ph_hi = p + 1; hipLaunchKernelGGL(fwd_kernel, dim3(grid), dim3(NTHR), LDS_BYTES, stream, a); }
#endif
}
```

```cpp
#include <hip/hip_runtime.h>
#include <cstdio>
#include <cstdint>

#define GAS __attribute__((address_space(1)))
#define LAS __attribute__((address_space(3)))
typedef unsigned short bf16;
typedef unsigned v4u __attribute__((ext_vector_type(4)));
typedef unsigned v2u __attribute__((ext_vector_type(2)));
typedef float f32x4 __attribute__((ext_vector_type(4)));
typedef float f32x2 __attribute__((ext_vector_type(2)));
typedef short bf16x8 __attribute__((ext_vector_type(8)));

constexpr int D = 1024, NB = 8, SEQ = 2048, CTX = 256, DEPTH = 4;
constexpr int TC = NB * CTX;
constexpr int TL = NB * SEQ;
constexpr int T = TC + TL;
constexpr int KVLEN = SEQ + CTX;
constexpr int NEXP = 16, DFF = 512;
constexpr int SLOTS = 40960;
constexpr int ML_NIN = 3328;
constexpr float EPS = 1e-6f;
constexpr int NWAVES = 8, NTHR = 512;
constexpr float ATT_C2 = 0.125f * 1.4426950408889634f;

constexpr size_t MiB = 1u << 20;
constexpr size_t WS_CTL = 0, CTL_ZERO_BYTES = 1 * MiB;
constexpr size_t WS_MOD = 1 * MiB;
constexpr size_t WS_ROPE = 2 * MiB;
constexpr size_t WS_TOKE = 2 * MiB + 65536;
constexpr size_t WS_TOKR = WS_TOKE + 163840;
constexpr size_t WS_TOKW = WS_TOKR + 163840;
constexpr size_t WS_TOKS = WS_TOKW + 163840;
constexpr size_t WS_BCNT = WS_TOKS + 163840;
constexpr size_t WS_ETAB = WS_BCNT + 16384;
constexpr size_t WS_SLOTW = WS_ETAB + 4096;
static_assert(WS_SLOTW + SLOTS * 4 <= 4 * MiB, "small tables");
constexpr int CTL_GCNT = 8192;
constexpr size_t WS_WGLU = 4 * MiB;
constexpr size_t WS_WKVQ = WS_WGLU + 8 * MiB;
constexpr size_t WS_WO = WS_WKVQ + 3 * MiB;
constexpr size_t WS_WIN = WS_WO + 2 * MiB;
constexpr size_t WS_WOUT = WS_WIN + 7 * MiB;
constexpr size_t WS_WG1 = WS_WOUT + 2 * MiB;
constexpr size_t WS_WG2 = WS_WG1 + 128 * MiB;
constexpr size_t WS_XRES = WS_WG2 + 64 * MiB;
constexpr size_t WS_H = WS_XRES + 72 * MiB;
constexpr size_t WS_Z = WS_H + 36 * MiB;
constexpr size_t WS_MIX = WS_Z + 36 * MiB;
constexpr size_t WS_HS = WS_MIX;
constexpr size_t WS_SLOTRE = WS_HS;
constexpr size_t WS_SLOTWE = WS_HS + 2 * MiB;
constexpr size_t WS_HID = WS_HS + 80 * MiB;
constexpr size_t WS_Y2 = WS_HID + 40 * MiB;
constexpr size_t WS_END = WS_Y2 + 80 * MiB;
constexpr size_t WS_YSUM = WS_MIX;
constexpr size_t WS_QB = WS_MIX;
constexpr size_t WS_KB = WS_QB + 36 * MiB;
constexpr size_t WS_VB = WS_KB + 9 * MiB;
constexpr size_t WS_MK = WS_MIX;
constexpr size_t WS_MV = WS_MK + 18 * MiB;
constexpr size_t WS_MQ = WS_MV + 36 * MiB;
constexpr size_t WS_MO = WS_MQ + 18 * MiB;
constexpr size_t WS_MG = WS_MO + 36 * MiB;
constexpr size_t WS_MHS = WS_MG + 3 * MiB;
static_assert(WS_MHS + 72 * MiB <= WS_END, "mLSTM view fits");
static_assert(WS_END <= 600 * MiB, "workspace budget");

constexpr int CW_BAR = 4096;

constexpr int RING_OFF = 0, RING_BYTES = 131072;
constexpr int LDSCTL_OFF = RING_BYTES, MISC_OFF = LDSCTL_OFF + 320;
constexpr int ETAB_OFF = MISC_OFF + 128;
constexpr int SCT_OFF = ETAB_OFF + 256;
constexpr int LDS_BYTES = 147456;
static_assert(SCT_OFF + 256 <= LDS_BYTES, "LDS map");

#define LDS_WAIT() asm volatile("s_waitcnt lgkmcnt(0)" ::: "memory")
#define VM_WAIT() asm volatile("s_waitcnt vmcnt(0)" ::: "memory")
__device__ __forceinline__ unsigned f2bf(float f) { unsigned u = __builtin_bit_cast(unsigned, f); return (u + 0x7fffu + ((u >> 16) & 1u)) >> 16; }
typedef float f32x2_cv __attribute__((ext_vector_type(2))); typedef __bf16 bf16x2_cv __attribute__((ext_vector_type(2)));
__device__ __forceinline__ unsigned pk2(float lo, float hi) { f32x2_cv v = {lo, hi}; bf16x2_cv b = __builtin_convertvector(v, bf16x2_cv); return __builtin_bit_cast(unsigned, b); }
__device__ __forceinline__ float bf2f(unsigned h) { return __builtin_bit_cast(float, h << 16); }
__device__ __forceinline__ float bflo(unsigned w) { return __builtin_bit_cast(float, w << 16); }
__device__ __forceinline__ float bfhi(unsigned w) { return __builtin_bit_cast(float, w & 0xffff0000u); }
template <int CTRL, int RMASK = 0xF>
__device__ __forceinline__ float dpp_f(float oldv, float v) { return __builtin_bit_cast(float, __builtin_amdgcn_update_dpp(__builtin_bit_cast(int, oldv), __builtin_bit_cast(int, v), CTRL, RMASK, 0xF, false)); }
#ifndef USE_SHFL_XOR
#define USE_SHFL_XOR 0
#endif
#ifndef USE_SHFL_PARTIAL
#define USE_SHFL_PARTIAL 0
#endif
__device__ __forceinline__ float red16_sum(float v) {
#if USE_SHFL_PARTIAL
    for (int o = 1; o < 16; o <<= 1) v += __shfl_xor(v, o);
    return v;
#endif
    v += dpp_f<0xB1>(0.f, v); v += dpp_f<0x4E>(0.f, v); v += dpp_f<0x141>(0.f, v); v += dpp_f<0x140>(0.f, v); return v; }
__device__ __forceinline__ float red16_max(float v) {
    v = fmaxf(v, dpp_f<0xB1>(v, v)); v = fmaxf(v, dpp_f<0x4E>(v, v)); v = fmaxf(v, dpp_f<0x141>(v, v)); v = fmaxf(v, dpp_f<0x140>(v, v)); return v; }
#ifndef USE_SHFL_REDUCE
#define USE_SHFL_REDUCE 0
#endif
__device__ __forceinline__ float wave_sum(float v) {
#if USE_SHFL_REDUCE
    for (int o = 1; o < 64; o <<= 1) v += __shfl_xor(v, o);
    return v;
#endif
    v = red16_sum(v); v += dpp_f<0x142, 0xA>(0.f, v); v += dpp_f<0x143, 0xC>(0.f, v);
    return __builtin_bit_cast(float, __builtin_amdgcn_readlane(__builtin_bit_cast(int, v), 63)); }
__device__ __forceinline__ float wave_max(float v) {
    v = red16_max(v); v = fmaxf(v, dpp_f<0x142, 0xA>(v, v)); v = fmaxf(v, dpp_f<0x143, 0xC>(v, v));
    return __builtin_bit_cast(float, __builtin_amdgcn_readlane(__builtin_bit_cast(int, v), 63)); }
__device__ __forceinline__ float xor16_sum(float v) { return v + __shfl_xor(v, 16); }
__device__ __forceinline__ float xor32_sum(float v) { return v + __shfl_xor(v, 32); }
__device__ __forceinline__ float sigmoidf_(float x) { return __builtin_amdgcn_rcpf(1.f + __expf(-x)); }
__device__ __forceinline__ float siluf_(float x) { return x * __builtin_amdgcn_rcpf(1.f + __expf(-x)); }
__device__ __forceinline__ float gelu_tanh(float x) {
    const float p = __builtin_fmaf(x * x, 0.044715f, 1.0f);
    const float e = __builtin_amdgcn_exp2f((x * -2.302208198f) * p);
    return x * __builtin_amdgcn_rcpf(1.0f + e);
}
__device__ __forceinline__ float log_sigmoidf_(float x) { return fminf(x, 0.f) - __logf(1.f + __expf(-fabsf(x))); }
__device__ __forceinline__ void sincos_d(double a, double& s, double& c) {
    const double k = __builtin_rint(a * 0.63661977236758134308);
    double r = __builtin_fma(-k, 1.57079632679489655800e+00, a);
    r = __builtin_fma(-k, 6.12323399573676603587e-17, r);
    const double r2 = r * r;
    double sp = -1.0 / 1307674368000.0;
    sp = sp * r2 + 1.0 / 6227020800.0; sp = sp * r2 - 1.0 / 39916800.0; sp = sp * r2 + 1.0 / 362880.0; sp = sp * r2 - 1.0 / 5040.0; sp = sp * r2 + 1.0 / 120.0; sp = sp * r2 - 1.0 / 6.0;
    const double sr = r + r * r2 * sp;
    double cp = 1.0 / 20922789888000.0;
    cp = cp * r2 - 1.0 / 87178291200.0; cp = cp * r2 + 1.0 / 479001600.0; cp = cp * r2 - 1.0 / 3628800.0; cp = cp * r2 + 1.0 / 40320.0; cp = cp * r2 - 1.0 / 720.0; cp = cp * r2 + 1.0 / 24.0; cp = cp * r2 - 0.5;
    const double cr = 1.0 + r2 * cp;
    const int q = ((int)k) & 3;
    s = (q == 0) ? sr : (q == 1) ? cr : (q == 2) ? -sr : -cr;
    c = (q == 0) ? cr : (q == 1) ? -sr : (q == 2) ? -cr : sr;
}
__device__ __forceinline__ int mrow_of(int r) { return r < TC ? 8 : ((r - TC) >> 11); }
namespace pg8 {
#define PG8_LAS __attribute__((address_space(3)))
typedef unsigned short bf16_t;
typedef short bf16x8 __attribute__((ext_vector_type(8)));
typedef float f32x4 __attribute__((ext_vector_type(4)));
typedef unsigned u32x4 __attribute__((ext_vector_type(4)));
constexpr int BM = 256, BK = 64, HALF = 128, HTB = HALF * BK * 2  , STAGE_BYTES = 8 * HTB, NXCD = 8, WGM = 8;

__host__ __device__ __forceinline__ int lds_byte(int r, int c) { const int st = (r >> 4) * 2 + (c >> 5), rr = r & 15, cc = c & 31, ob = rr * 64 + cc * 2; return st * 1024 + (ob ^ (((ob >> 9) & 1) << 5)); }
__host__ __device__ __forceinline__ void stage_rc(int b, int& R, int& C) { const int st = b / 1024, sb = b % 1024, swz = sb ^ (((sb >> 9) & 1) << 5); R = (st >> 1) * 16 + swz / 64; C = (st & 1) * 32 + (swz % 64) / 2; }
__host__ __device__ __forceinline__ int perm32(int rho) { const int n = rho >> 4, i = rho & 15; return 8 * (i >> 2) + 4 * n + (i & 3); }

struct Unit { int pm, pn, half, mb, lim; };
__device__ __forceinline__ int row0(const Unit& u) { return u.pm * 256 + ((u.half >> 1) << 7); }
struct Gemm { const bf16_t* A; const bf16_t* Bt; int M, N, K; const int* rowmap; };

struct StaticOrder {
    int nM, nN, nwg, G, c;
    __host__ __device__ void init(int M, int N, int G_, int c_) { nM = M / BM; nN = N / BM; nwg = nM * nN; G = G_; c = c_; }
    __host__ __device__ bool next(int i, Unit& u) const {
        const long L = (long)i * G + c; if (L >= nwg) return false;
        int wgid = (int)L; { const int q = nwg / NXCD, r = nwg % NXCD, xcd = wgid % NXCD, off = wgid / NXCD; wgid = (xcd < r ? xcd * (q + 1) : r * (q + 1) + (xcd - r) * q) + off; }
        const int nig = WGM * nN, gid = wgid / nig, fm = gid * WGM, gsz = (nM - fm) < WGM ? (nM - fm) : WGM;
        u.pm = fm + ((wgid % nig) % gsz); u.pn = (wgid % nig) / gsz; u.half = 0; u.mb = 0; u.lim = 256; return true;
    }
    __device__ __forceinline__ void a_ready(const Unit&) const {}
    __device__ __forceinline__ void done(const Unit&) const {}
};


template <class Epi, class Sched, bool ALIGN_EPI = false, bool SP2 = false, bool GATHER = false>
__device__ __forceinline__ void gemm_phase(PG8_LAS unsigned char* lds, const Gemm g, const Sched& S, const Epi& E) {
    const int tid = threadIdx.x, wid = __builtin_amdgcn_readfirstlane(tid >> 6), lane = tid & 63, wr = wid >> 2, wc = wid & 3, fr = lane & 15, fq = lane >> 4;
    const int K = g.K, nt = K / BK;
    unsigned voffA[2], voffB[2];
#pragma unroll
    for (int i = 0; i < 2; ++i) { int R, C; stage_rc(tid * 16 + i * 8192, R, C); const int Rb = Epi::PERM ? ((R & ~31) + perm32(R & 31)) : R;
        voffA[i] = (unsigned)(R * K + C) * 2u; voffB[i] = (unsigned)(Rb * K + C) * 2u; }
    static_assert(!GATHER || SP2, "gather path is written for the SP2 loop");
    unsigned oc[2][2], rn[2][2], cbA[2]; int Rg[2];
    if constexpr (GATHER) {
#pragma unroll
        for (int i = 0; i < 2; ++i) { int R, C; stage_rc(tid * 16 + i * 8192, R, C); Rg[i] = R; cbA[i] = (unsigned)C * 2u; } }
    const char* gA = (const char*)g.A;
    const size_t kstep = (size_t)(BK * 2);
    const size_t hstep = (size_t)HALF * K * 2;
    const size_t tstep = 2 * hstep;
    const unsigned ldsw = (unsigned)wid * 1024u;
    const int aoff = lds_byte(wr * 64 + fr, fq * 8), boff = lds_byte(wc * 32 + fr, fq * 8);
#define PG8_SA(b, h) (((b) * 2 + (h)) * HTB)
#define PG8_SB(b, h) ((4 + (b) * 2 + (h)) * HTB)
#define PG8_STAGE(bufoff, gbase, voff) do { _Pragma("unroll") for (int _i = 0; _i < 2; ++_i) \
        __builtin_amdgcn_global_load_lds((const unsigned*)((const char*)(gbase) + (voff)[_i]), (PG8_LAS unsigned*)(lds + (bufoff) + ldsw + _i * 8192), 16, 0, 0); } while (0)
#define PG8_STA(b, h, base_ng, base_g, OFF) do { if constexpr (GATHER) PG8_STAGE(PG8_SA(b, h), base_g, OFF[h]); else PG8_STAGE(PG8_SA(b, h), (base_ng) + (h) * hstep, voffA); } while (0)
#define PG8_LDA(dst, b, h) do { _Pragma("unroll") for (int m = 0; m < 4; ++m) _Pragma("unroll") for (int k = 0; k < 2; ++k) dst[m][k] = *(const PG8_LAS bf16x8*)(lds + PG8_SA(b, h) + aoff + m * 2048 + k * 1024); } while (0)
#define PG8_LDB(dst, b, h) do { _Pragma("unroll") for (int n = 0; n < 2; ++n) _Pragma("unroll") for (int k = 0; k < 2; ++k) dst[n][k] = *(const PG8_LAS bf16x8*)(lds + PG8_SB(b, h) + boff + n * 2048 + k * 1024); } while (0)
#define PG8_MMA(ai, bj, At, Bt) do { __builtin_amdgcn_s_setprio(1); _Pragma("unroll") for (int m = 0; m < 4; ++m) _Pragma("unroll") for (int n = 0; n < 2; ++n) _Pragma("unroll") for (int k = 0; k < 2; ++k) \
        acc[ai][bj][m][n] = __builtin_amdgcn_mfma_f32_16x16x32_bf16(Bt[n][k], At[m][k], acc[ai][bj][m][n], 0, 0, 0); __builtin_amdgcn_s_setprio(0); } while (0)
#define PG8_WAIT_V(n) asm volatile("s_waitcnt vmcnt(" #n ")" ::: "memory")
#define PG8_WAIT_L(n) asm volatile("s_waitcnt lgkmcnt(" #n ")" ::: "memory")
#define PG8_BAR __builtin_amdgcn_s_barrier()
#define PG8_SCHED __builtin_amdgcn_sched_barrier(0)
    Unit cur, nxt; int ui = 0;
    if (!S.next(0, cur)) return;
    f32x4 acc[2][2][4][2];
#pragma unroll
    for (int a = 0; a < 2; ++a)
#pragma unroll
        for (int b = 0; b < 2; ++b)
#pragma unroll
            for (int m = 0; m < 4; ++m)
#pragma unroll
                for (int n = 0; n < 2; ++n) acc[a][b][m][n] = (f32x4){0.f, 0.f, 0.f, 0.f};
    bf16x8 At[4][2], B0[2][2], B1[2][2];
    const char* cA = (const char*)g.A + (size_t)cur.pm * tstep + (cur.half == 2 ? hstep : (size_t)0); const char* cB = (const char*)g.Bt + (size_t)cur.pn * tstep;
    bool hf = cur.half != 0;
    S.a_ready(cur);
    if constexpr (GATHER) {
#pragma unroll
        for (int h = 0; h < 2; ++h)
#pragma unroll
            for (int i = 0; i < 2; ++i) { const int lr = (cur.half == 2 ? 128 : h * 128) + Rg[i]; oc[h][i] = (unsigned)g.rowmap[cur.mb + (lr < cur.lim ? lr : 0)] * (unsigned)(K * 2) + cbA[i]; } }
    if constexpr (SP2) {
        PG8_STAGE(PG8_SB(0, 0), cB, voffB); PG8_STAGE(PG8_SB(0, 1), cB + hstep, voffB); PG8_STA(0, 0, cA, gA, oc); PG8_STA(0, 1, cA, gA, oc);
        if (wr == 1) PG8_BAR;
        PG8_WAIT_V(2); PG8_BAR;
        PG8_STAGE(PG8_SB(1, 0), cB + kstep, voffB); PG8_STA(1, 0, cA + kstep, gA + kstep, oc); PG8_STAGE(PG8_SB(1, 1), cB + hstep + kstep, voffB);
        PG8_WAIT_V(6); PG8_BAR;
    } else {
        PG8_STAGE(PG8_SB(0, 0), cB, voffB); PG8_STAGE(PG8_SA(0, 0), cA, voffA); PG8_STAGE(PG8_SB(0, 1), cB + hstep, voffB); PG8_STAGE(PG8_SA(0, 1), cA + hstep, voffA);
        if (wr == 1) PG8_BAR;
        PG8_WAIT_V(4); PG8_BAR;
        PG8_STAGE(PG8_SB(1, 0), cB + kstep, voffB); PG8_STAGE(PG8_SA(1, 0), cA + kstep, voffA); PG8_STAGE(PG8_SB(1, 1), cB + hstep + kstep, voffB);
        PG8_WAIT_V(6); PG8_BAR;
    }
    for (;;) {
        const bool has_next = S.next(ui + 1, nxt);
        if constexpr (GATHER) { if (has_next) {
#pragma unroll
            for (int h = 0; h < 2; ++h)
#pragma unroll
                for (int i = 0; i < 2; ++i) { const int lr = (nxt.half == 2 ? 128 : h * 128) + Rg[i]; rn[h][i] = (unsigned)g.rowmap[nxt.mb + (lr < nxt.lim ? lr : 0)]; } } }
        const char* nA = has_next ? (const char*)g.A + (size_t)nxt.pm * tstep + (nxt.half == 2 ? hstep : (size_t)0) : cA; const char* nB = has_next ? (const char*)g.Bt + (size_t)nxt.pn * tstep : cB;
        for (int t = 0; t < nt; t += 2) {
            const bool last = (t == nt - 2);
            const char* a1 = cA + (size_t)(t + 1) * kstep;
            const char* a2 = last ? nA : cA + (size_t)(t + 2) * kstep; const char* b2 = last ? nB : cB + (size_t)(t + 2) * kstep;
            const char* a3 = a2 + kstep; const char* b3 = b2 + kstep;
            if (last && has_next) S.a_ready(nxt);
            unsigned o2[2][2]; const char* a1g = gA + (size_t)(t + 1) * kstep; const char* a2g = gA + (last ? (size_t)0 : (size_t)(t + 2) * kstep); const char* a3g = a2g + kstep;
            if constexpr (GATHER) {
                if (last && has_next) {
#pragma unroll
                    for (int h = 0; h < 2; ++h)
#pragma unroll
                        for (int i = 0; i < 2; ++i) { unsigned v = rn[h][i]; asm volatile("" : "+v"(v)); o2[h][i] = v * (unsigned)(K * 2) + cbA[i]; } }
                else {
#pragma unroll
                    for (int h = 0; h < 2; ++h)
#pragma unroll
                        for (int i = 0; i < 2; ++i) o2[h][i] = oc[h][i]; }
            }
            if constexpr (SP2) {
            PG8_LDB(B0, 0, 0); PG8_LDB(B1, 0, 1); PG8_SCHED; PG8_LDA(At, 0, 0); PG8_STA(1, 1, a1, a1g, oc);
            PG8_WAIT_V(8); PG8_WAIT_L(0); PG8_BAR; PG8_MMA(0, 0, At, B0); PG8_MMA(0, 1, At, B1); PG8_BAR; PG8_SCHED;
            if (!hf) PG8_LDA(At, 0, 1); PG8_STAGE(PG8_SB(0, 0), b2, voffB); PG8_STAGE(PG8_SB(0, 1), b2 + hstep, voffB); PG8_STA(0, 0, a2, a2g, o2);
            PG8_WAIT_V(8); PG8_WAIT_L(0); PG8_BAR; if (!hf) { PG8_MMA(1, 0, At, B0); PG8_MMA(1, 1, At, B1); } PG8_BAR; PG8_SCHED;
            PG8_LDB(B0, 1, 0); PG8_LDB(B1, 1, 1); PG8_SCHED; PG8_LDA(At, 1, 0); PG8_STA(0, 1, a2, a2g, o2);
            PG8_WAIT_V(8); PG8_WAIT_L(0); PG8_BAR; PG8_MMA(0, 0, At, B0); PG8_MMA(0, 1, At, B1); PG8_BAR; PG8_SCHED;
            if (!hf) PG8_LDA(At, 1, 1); PG8_STAGE(PG8_SB(1, 0), b3, voffB); PG8_STAGE(PG8_SB(1, 1), b3 + hstep, voffB); PG8_STA(1, 0, a3, a3g, o2);
            PG8_WAIT_V(8); PG8_WAIT_L(0); PG8_BAR; if (!hf) { PG8_MMA(1, 0, At, B0); PG8_MMA(1, 1, At, B1); } PG8_BAR; PG8_SCHED;
            } else {
            PG8_LDB(B0, 0, 0); PG8_SCHED; PG8_LDA(At, 0, 0); PG8_STAGE(PG8_SA(1, 1), a1 + hstep, voffA);
            PG8_WAIT_L(8); PG8_BAR; PG8_WAIT_L(0); PG8_MMA(0, 0, At, B0); PG8_BAR; PG8_SCHED;
            PG8_LDB(B1, 0, 1); PG8_STAGE(PG8_SB(0, 0), b2, voffB);
            PG8_BAR; PG8_WAIT_L(0); PG8_MMA(0, 1, At, B1); PG8_BAR;
            PG8_LDA(At, 0, 1); PG8_STAGE(PG8_SA(0, 0), a2, voffA);
            PG8_BAR; PG8_WAIT_L(0); PG8_MMA(1, 0, At, B0); PG8_BAR; PG8_SCHED;
            PG8_STAGE(PG8_SB(0, 1), b2 + hstep, voffB);
            PG8_WAIT_V(6); PG8_BAR; PG8_MMA(1, 1, At, B1); PG8_BAR;
            PG8_LDB(B0, 1, 0); PG8_SCHED; PG8_LDA(At, 1, 0); PG8_STAGE(PG8_SA(0, 1), a2 + hstep, voffA);
            PG8_WAIT_L(8); PG8_BAR; PG8_WAIT_L(0); PG8_MMA(0, 0, At, B0); PG8_BAR; PG8_SCHED;
            PG8_LDB(B1, 1, 1); PG8_STAGE(PG8_SB(1, 0), b3, voffB);
            PG8_BAR; PG8_WAIT_L(0); PG8_MMA(0, 1, At, B1); PG8_BAR;
            PG8_LDA(At, 1, 1); PG8_STAGE(PG8_SA(1, 0), a3, voffA);
            PG8_BAR; PG8_WAIT_L(0); PG8_MMA(1, 0, At, B0); PG8_BAR; PG8_SCHED;
            PG8_STAGE(PG8_SB(1, 1), b3 + hstep, voffB);
            PG8_WAIT_V(6); PG8_BAR; PG8_MMA(1, 1, At, B1); PG8_BAR;
            }
        }
        if constexpr (ALIGN_EPI) { if (wr == 0) PG8_BAR; }
        if constexpr (!Epi::AFTER_DRAIN) { E(acc, cur, wr, wc, fr, fq); S.done(cur); }
        if (!has_next) break;
#pragma unroll
        for (int a = 0; a < 2; ++a)
#pragma unroll
            for (int b = 0; b < 2; ++b)
#pragma unroll
                for (int m = 0; m < 4; ++m)
#pragma unroll
                    for (int n = 0; n < 2; ++n) acc[a][b][m][n] = (f32x4){0.f, 0.f, 0.f, 0.f};
        cur = nxt; cA = nA; cB = nB; ++ui; hf = cur.half != 0;
        if constexpr (GATHER) {
#pragma unroll
            for (int h = 0; h < 2; ++h)
#pragma unroll
                for (int i = 0; i < 2; ++i) oc[h][i] = rn[h][i] * (unsigned)(K * 2) + cbA[i]; }
        if constexpr (ALIGN_EPI) { if (wr == 1) PG8_BAR; }
    }
    PG8_WAIT_V(0);
    if constexpr (!ALIGN_EPI) { if (wr == 0) PG8_BAR; }
    PG8_BAR;
    if constexpr (Epi::AFTER_DRAIN) { E.fused(acc, cur, wr, wc, fr, fq, lds, wid, lane); S.done(cur); }
#undef PG8_SA
#undef PG8_SB
#undef PG8_STAGE
#undef PG8_STA
#undef PG8_LDA
#undef PG8_LDB
#undef PG8_MMA
#undef PG8_WAIT_V
#undef PG8_WAIT_L
#undef PG8_BAR
#undef PG8_SCHED
}
}
#define XB_TMO      128
#define XB_XCNT(j)  (256  + 64 * (j))
#define XB_XSUB(j)  (1280 + 64 * (j))
#define XB_XGEN(j)  (2304 + 64 * (j))
#define XB_TOP      3328
#define XB_TOPGEN   3392
#define XCD_BAR_WORDS 3456
#define XB_SPIN_CAP (1u << 22)

__device__ __forceinline__ unsigned xb_ld(unsigned* p)              { return __hip_atomic_load(p, __ATOMIC_RELAXED, __HIP_MEMORY_SCOPE_AGENT); }
__device__ __forceinline__ unsigned xb_add(unsigned* p, unsigned v) { return __hip_atomic_fetch_add(p, v, __ATOMIC_RELAXED, __HIP_MEMORY_SCOPE_AGENT); }
__device__ __forceinline__ unsigned xb_xcc_id() { return (unsigned)__builtin_amdgcn_s_getreg((3 << 11) | 20) & 0xFu; }
#define XB_SPIN(cond, bar) do { unsigned _sp = 0; while (cond) { __builtin_amdgcn_s_sleep(1); \
    if ((++_sp & 255u) == 0u) { if (xb_ld(&(bar)[XB_TMO])) break; if (_sp > XB_SPIN_CAP) { atomicAdd(&(bar)[XB_TMO], 1u); break; } } } } while (0)

struct XcdBarrier {
    unsigned* bar; unsigned x;
    volatile LAS unsigned* st;
};

__device__ __forceinline__ XcdBarrier xcd_barrier_post(unsigned* bar, volatile LAS unsigned* st) {
    XcdBarrier b; b.bar = bar; b.x = xb_xcc_id(); b.st = st;
    if (threadIdx.x == 0) (void)xb_add(&bar[XB_XCNT(b.x)], 1u);
    return b;
}
__device__ __forceinline__ void xcd_barrier_complete(unsigned* bar, unsigned x, unsigned& nloc, unsigned& nx) {
    const unsigned G = gridDim.x * gridDim.y * gridDim.z;
    unsigned sum, cnt, mine, sp = 0u;
    for (;;) {
        sum = 0u; cnt = 0u; mine = 0u;
#pragma unroll
        for (unsigned j = 0; j < 16; ++j) { const unsigned c = xb_ld(&bar[XB_XCNT(j)]); sum += c; cnt += (c > 0u) ? 1u : 0u; mine = (j == x) ? c : mine; }
        if (sum == G) break;
        __builtin_amdgcn_s_sleep(1);
        if ((++sp & 255u) == 0u) { if (xb_ld(&bar[XB_TMO])) break; if (sp > XB_SPIN_CAP) { atomicAdd(&bar[XB_TMO], 1u); break; } }
    }
    nloc = mine > 0u ? mine : 1u; nx = cnt > 0u ? cnt : 1u;
}

__device__ __forceinline__ void xcd_barrier(const XcdBarrier& b) {
    asm volatile("s_waitcnt vmcnt(0)" ::: "memory");
    __syncthreads();
    if (threadIdx.x == 0) {
        unsigned* bar = b.bar;
        __builtin_amdgcn_s_waitcnt(0);
        unsigned nloc = b.st[0], nx = b.st[1];
        if (nloc == 0u) { xcd_barrier_complete(bar, b.x, nloc, nx); b.st[0] = nloc; b.st[1] = nx; }
        const unsigned old = xb_add(&bar[XB_XSUB(b.x)], 1u);
        const unsigned gen = old / nloc;
        if (old + 1u == (gen + 1u) * nloc) {
            __builtin_amdgcn_fence(__ATOMIC_RELEASE, "agent");
            asm volatile("s_waitcnt vmcnt(0)" ::: "memory");
            const unsigned og = xb_add(&bar[XB_TOP], 1u);
            const unsigned tg = og / nx;
            if (og + 1u == (tg + 1u) * nx) xb_add(&bar[XB_TOPGEN], 1u);
            else XB_SPIN(xb_ld(&bar[XB_TOPGEN]) == tg, bar);
            __builtin_amdgcn_fence(__ATOMIC_ACQUIRE, "agent");
            xb_add(&bar[XB_XGEN(b.x)], 1u);
            asm volatile("s_waitcnt vmcnt(0)" ::: "memory");
        } else {
            XB_SPIN(xb_ld(&bar[XB_XGEN(b.x)]) == gen, bar);
            __builtin_amdgcn_fence(__ATOMIC_ACQUIRE, "agent");
            asm volatile("s_waitcnt vmcnt(0)" ::: "memory");
        }
    }
    __syncthreads();
}

enum { IN_X = 0, IN_C, IN_CTX, IN_CCTX, IN_ADAW, IN_ADAB, IN_N1G, IN_N2G, IN_FING, IN_S5LRE, IN_S5LIM, IN_S5LOG, IN_S5BRE, IN_S5BIM, IN_S5CRE, IN_S5CIM,
       IN_S5D, IN_S5WGLU, IN_S5BGLU, IN_AWKVQ, IN_AQG, IN_AKG, IN_AWO, IN_MLWIN, IN_MLBG, IN_MLNG, IN_MLWOUT, IN_RW, IN_RB, IN_MWG, IN_MWU, IN_MWD, N_INPUTS };

struct Frame {
    LAS unsigned char* lds;
    volatile LAS unsigned* MISC;
    unsigned* ctl;
    int tid, lane, wave, G, blk;
    const float* in[N_INPUTS];
    unsigned char* ws;
    float* out;
};

template <bool HV = false>
struct DenseSchedT {
    pg8::StaticOrder so; int pm0;
    __device__ __forceinline__ void init(int Mrows, int N, int G, int c, int pm0_) { so.init(Mrows, N, G, c); pm0 = pm0_; }
    __device__ __forceinline__ bool next(int i, pg8::Unit& u) const {
        const int G = so.G, rounds = (so.nwg + G - 1) / G, R = so.nwg - G * (rounds - 1);
        if (HV && i == rounds - 1 && 2 * R <= G && (G & 15) == 0) {
            const int c = so.c, idx = ((c >> 4) << 3) | (c & 7); if (idx >= R) return false;
            pg8::StaticOrder t = so; t.c = idx; if (!t.next(i, u)) return false; u.pm += pm0; u.half = 1 + ((c >> 3) & 1); return true; }
        if (!so.next(i, u)) return false; u.pm += pm0; return true; }
    __device__ __forceinline__ void a_ready(const pg8::Unit&) const {}
    __device__ __forceinline__ void done(const pg8::Unit&) const {}
};
typedef DenseSchedT<false> DenseSched;
typedef DenseSchedT<true> DenseSchedH;
struct MoeSched {
    const LAS int* tab; int G, c, npn;
    __device__ __forceinline__ bool next(int i, pg8::Unit& u) const {
        const int total = tab[16] * npn;
        int L;
        int hsel = 0;
        if ((G & 7) == 0) { const int x = c & 7, rank = c >> 3, per = G >> 3; const int q = total >> 3, rem = total & 7; const int start = x * q + (x < rem ? x : rem), cnt = q + (x < rem ? 1 : 0);
            const int nfr = cnt / per, R = cnt - nfr * per;
            if (i < nfr) L = start + rank + per * i;
            else if (i > nfr || R == 0) return false;
            else if (2 * R <= per) { if (rank >= 2 * R) return false; L = start + nfr * per + (rank >> 1); hsel = 1 + (rank & 1); }
            else { if (rank >= R) return false; L = start + nfr * per + rank; } }
        else { L = i * G + c; if (L >= total) return false; }
        int e = 0;
#pragma unroll
        for (int k = 1; k < 16; ++k) e += (L >= tab[k] * npn) ? 1 : 0;
        const int ts = tab[e], te = tab[e + 1] - ts, idx = L - ts * npn;
        u.pm = __builtin_amdgcn_readfirstlane(ts + idx % te); u.pn = __builtin_amdgcn_readfirstlane(e * npn + idx / te); u.half = __builtin_amdgcn_readfirstlane(hsel);
        u.mb = __builtin_amdgcn_readfirstlane(e * T + (u.pm - ts) * 256); u.lim = __builtin_amdgcn_readfirstlane(tab[17 + e] - (u.pm - ts) * 256); return true;
    }
    __device__ __forceinline__ void a_ready(const pg8::Unit&) const {}
    __device__ __forceinline__ void done(const pg8::Unit&) const {}
};

template <class Epi, class Sched>
__device__ __forceinline__ void gemm_phase_naive(const pg8::Gemm g, const Sched& S, const Epi& E) {
    const int tid = threadIdx.x, wid = tid >> 6, lane = tid & 63, wr = wid >> 2, wc = wid & 3, fr = lane & 15, fq = lane >> 4;
    const int K = g.K; pg8::Unit u;
    for (int i = 0; S.next(i, u); ++i) {
        f32x4 acc[2][2][4][2];
#pragma unroll
        for (int ai = 0; ai < 2; ++ai)
#pragma unroll
            for (int m = 0; m < 4; ++m) {
                const int row = pg8::row0(u) + ai * 128 + wr * 64 + m * 16 + fr;
                const bf16* ap = g.A + (size_t)row * K;
                float s[2][2][4];
#pragma unroll
                for (int bj = 0; bj < 2; ++bj)
#pragma unroll
                    for (int n = 0; n < 2; ++n)
#pragma unroll
                        for (int e = 0; e < 4; ++e) s[bj][n][e] = 0.f;
                for (int k = 0; k < K; k += 8) {
                    const v4u av = *(const v4u*)(ap + k);
                    const float a0 = bflo(av.x), a1 = bfhi(av.x), a2 = bflo(av.y), a3 = bfhi(av.y), a4 = bflo(av.z), a5 = bfhi(av.z), a6 = bflo(av.w), a7 = bfhi(av.w);
#pragma unroll
                    for (int bj = 0; bj < 2; ++bj)
#pragma unroll
                        for (int n = 0; n < 2; ++n)
#pragma unroll
                            for (int e = 0; e < 4; ++e) {
                                const int col = u.pn * 256 + bj * 128 + wc * 32 + n * 16 + fq * 4 + e;
                                const v4u bv = *(const v4u*)(g.Bt + (size_t)col * K + k);
                                float t = s[bj][n][e];
                                t += a0 * bflo(bv.x); t += a1 * bfhi(bv.x); t += a2 * bflo(bv.y); t += a3 * bfhi(bv.y);
                                t += a4 * bflo(bv.z); t += a5 * bfhi(bv.z); t += a6 * bflo(bv.w); t += a7 * bfhi(bv.w);
                                s[bj][n][e] = t;
                            }
                }
#pragma unroll
                for (int bj = 0; bj < 2; ++bj)
#pragma unroll
                    for (int n = 0; n < 2; ++n) acc[ai][bj][m][n] = (f32x4){s[bj][n][0], s[bj][n][1], s[bj][n][2], s[bj][n][3]};
            }
        E(acc, u, wr, wc, fr, fq);
    }
}
#ifndef USE_NAIVE_GEMM
#define USE_NAIVE_GEMM 0
#endif
template <class Epi, class Sched>
__device__ __forceinline__ void run_gemm(Frame& F, const pg8::Gemm g, const Sched& S, const Epi& E) {
#if USE_NAIVE_GEMM
    gemm_phase_naive<Epi, Sched>(g, S, E);
#else
    pg8::gemm_phase<Epi, Sched, true, true>(F.lds + RING_OFF, g, S, E);
#endif
}
template <class Epi, class Sched>
__device__ __forceinline__ void run_gemm_gather(Frame& F, const pg8::Gemm g, const Sched& S, const Epi& E) {
    pg8::gemm_phase<Epi, Sched, true, true, true>(F.lds + RING_OFF, g, S, E);
}

__device__ __forceinline__ void st_bf4(bf16* p, f32x4 v) { v2u w; w.x = pk2(v.x, v.y); w.y = pk2(v.z, v.w); *(v2u*)p = w; }

struct EpiRes {
    static constexpr bool PERM = true, AFTER_DRAIN = false;
    bf16* xres; const float* __restrict__ modg; int skip; bf16* dummy;
    __device__ __forceinline__ void operator()(const f32x4 (&acc)[2][2][4][2], const pg8::Unit& u, int wr, int wc, int fr, int fq) const {
        const int cbase = u.pn * 256 + wc * 32 + fq * 8;
#pragma unroll
        for (int am = 0; am < 4; ++am) { const int ai = am >> 1, m0 = (am & 1) * 2; if (ai == 1 && u.half) break;
            v4u x[4][2]; f32x4 g0[4][2], g1[4][2];
#pragma unroll
            for (int m = m0; m < m0 + 2; ++m) { const int r = pg8::row0(u) + ai * 128 + wr * 64 + m * 16 + fr; const float* gp = modg + mrow_of(r) * 6144; const bf16* xp = xres + (size_t)r * D;
#pragma unroll
                for (int bj = 0; bj < 2; ++bj) { const int c = cbase + bj * 128; g0[m][bj] = *(const f32x4*)(gp + c); g1[m][bj] = *(const f32x4*)(gp + c + 4); x[m][bj] = *(const v4u*)(xp + c); } }
            asm volatile("" ::: "memory");
#pragma unroll
            for (int m = m0; m < m0 + 2; ++m) { const int r = pg8::row0(u) + ai * 128 + wr * 64 + m * 16 + fr; bf16* xp = (skip ? dummy : xres) + (size_t)r * D;
#pragma unroll
                for (int bj = 0; bj < 2; ++bj) { const int c = cbase + bj * 128; const v4u xv = x[m][bj]; const f32x4 a = g0[m][bj] * acc[ai][bj][m][0], b = g1[m][bj] * acc[ai][bj][m][1];
                    v4u o; o.x = pk2(bflo(xv.x) + a.x, bfhi(xv.x) + a.y); o.y = pk2(bflo(xv.y) + a.z, bfhi(xv.y) + a.w); o.z = pk2(bflo(xv.z) + b.x, bfhi(xv.z) + b.y); o.w = pk2(bflo(xv.w) + b.z, bfhi(xv.w) + b.w);
                    *(v4u*)(xp + c) = o; } }
        }
    }
};
struct EpiGlu {
    static constexpr bool PERM = true, AFTER_DRAIN = false;
    bf16* xres; const float* __restrict__ modg; const float* __restrict__ bglu; int skip;
    __device__ __forceinline__ void operator()(const f32x4 (&acc)[2][2][4][2], const pg8::Unit& u, int wr, int wc, int fr, int fq) const {
        const int oc = u.pn * 128 + wc * 32 + fq * 8;
        const f32x4 ba0 = *(const f32x4*)(bglu + oc), ba1 = *(const f32x4*)(bglu + oc + 4), bg0 = *(const f32x4*)(bglu + 1024 + oc), bg1 = *(const f32x4*)(bglu + 1024 + oc + 4);
#pragma unroll
        for (int ai = 0; ai < 2; ++ai) { if (ai == 1 && u.half) break;
            v4u x[4]; f32x4 g0[4], g1[4];
#pragma unroll
            for (int m = 0; m < 4; ++m) { const int r = pg8::row0(u) + ai * 128 + wr * 64 + m * 16 + fr; const float* gp = modg + mrow_of(r) * 6144;
                g0[m] = *(const f32x4*)(gp + oc); g1[m] = *(const f32x4*)(gp + oc + 4); x[m] = *(const v4u*)(xres + (size_t)r * D + oc); }
            asm volatile("" ::: "memory");
#pragma unroll
            for (int m = 0; m < 4; ++m) { const int r = pg8::row0(u) + ai * 128 + wr * 64 + m * 16 + fr;
                const f32x4 a0 = acc[ai][0][m][0] + ba0, a1 = acc[ai][0][m][1] + ba1, q0 = acc[ai][1][m][0] + bg0, q1 = acc[ai][1][m][1] + bg1;
                f32x4 v0, v1; v0.x = a0.x * sigmoidf_(q0.x); v0.y = a0.y * sigmoidf_(q0.y); v0.z = a0.z * sigmoidf_(q0.z); v0.w = a0.w * sigmoidf_(q0.w);
                v1.x = a1.x * sigmoidf_(q1.x); v1.y = a1.y * sigmoidf_(q1.y); v1.z = a1.z * sigmoidf_(q1.z); v1.w = a1.w * sigmoidf_(q1.w);
                v0 = v0 * g0[m]; v1 = v1 * g1[m]; const v4u xv = x[m];
                v4u o; o.x = pk2(bflo(xv.x) + v0.x, bfhi(xv.x) + v0.y); o.y = pk2(bflo(xv.y) + v0.z, bfhi(xv.y) + v0.w); o.z = pk2(bflo(xv.z) + v1.x, bfhi(xv.z) + v1.y); o.w = pk2(bflo(xv.w) + v1.z, bfhi(xv.w) + v1.w);
                if (!skip) *(v4u*)(xres + (size_t)r * D + oc) = o; }
        }
    }
};
__device__ __forceinline__ int kvrow_of(int r) { if (r < TC) return (r >> 8) * KVLEN + SEQ + (r & 255); const int rr = r - TC; return (rr >> 11) * KVLEN + (rr & 2047); }
struct EpiKvq {
    static constexpr bool PERM = false, AFTER_DRAIN = false;
    bf16* qb; bf16* kb; bf16* vb; const float* __restrict__ qg; const float* __restrict__ kg; const float* __restrict__ rope;
    __device__ __forceinline__ void operator()(const f32x4 (&acc)[2][2][4][2], const pg8::Unit& u, int wr, int wc, int fr, int fq) const {
        const int pn = u.pn;
        const float* gptr = (pn == 0) ? kg : qg;
        f32x4 gn[2][2];
#pragma unroll
        for (int bj = 0; bj < 2; ++bj)
#pragma unroll
            for (int n = 0; n < 2; ++n) gn[bj][n] = *(const f32x4*)(gptr + 32 * bj + 16 * n + 4 * fq);
#pragma unroll
        for (int ai = 0; ai < 2; ++ai)
#pragma unroll
            for (int m = 0; m < 4; ++m) { if (ai == 1 && u.half) break;
                const int r = pg8::row0(u) + ai * 128 + wr * 64 + m * 16 + fr;
                f32x4 x[2][2];
#pragma unroll
                for (int bj = 0; bj < 2; ++bj)
#pragma unroll
                    for (int n = 0; n < 2; ++n) x[bj][n] = acc[ai][bj][m][n];
                if (pn != 1) {
                    float ss = 0.f;
#pragma unroll
                    for (int bj = 0; bj < 2; ++bj)
#pragma unroll
                        for (int n = 0; n < 2; ++n) { const f32x4 v = x[bj][n]; ss += v.x * v.x + v.y * v.y + v.z * v.z + v.w * v.w; }
                    ss = xor16_sum(ss); ss = xor32_sum(ss);
                    const float rs = rsqrtf(ss * (1.f / 64.f) + EPS);
#pragma unroll
                    for (int bj = 0; bj < 2; ++bj)
#pragma unroll
                        for (int n = 0; n < 2; ++n) x[bj][n] = x[bj][n] * rs * gn[bj][n];
                    if (r >= TC) {
                        const int t = (r - TC) & 2047;
#pragma unroll
                        for (int bj = 0; bj < 2; ++bj) {
                            const int pos = bj == 0 ? (t >> 6) : (t & 63);
                            const f32x4 cs = *(const f32x4*)(rope + pos * 16 + 4 * fq), sn = *(const f32x4*)(rope + 1024 + pos * 16 + 4 * fq);
                            const f32x4 x1 = x[bj][0], x2 = x[bj][1];
                            x[bj][0] = x1 * cs - x2 * sn; x[bj][1] = x2 * cs + x1 * sn;
                        }
                    }
                }
                bf16* dst;
                if (pn == 0) dst = kb + (size_t)kvrow_of(r) * 256 + wc * 64;
                else if (pn == 1) dst = vb + (size_t)kvrow_of(r) * 256 + wc * 64;
                else { dst = qb + (size_t)r * D + ((pn - 2) * 4 + wc) * 64;
#pragma unroll
                    for (int bj = 0; bj < 2; ++bj)
#pragma unroll
                        for (int n = 0; n < 2; ++n) x[bj][n] = x[bj][n] * ATT_C2; }
#pragma unroll
                for (int bj = 0; bj < 2; ++bj)
#pragma unroll
                    for (int n = 0; n < 2; ++n) st_bf4(dst + 32 * bj + 16 * n + 4 * fq, x[bj][n]);
            }
    }
};
struct EpiMlIn {
    static constexpr bool PERM = true, AFTER_DRAIN = false;
    bf16 *k, *v, *q, *o; float* g; const float* bgate;
    __device__ __forceinline__ void operator()(const f32x4 (&acc)[2][2][4][2], const pg8::Unit& u, int wr, int wc, int fr, int fq) const {
        const int pn = u.pn;
#pragma unroll
        for (int ai = 0; ai < 2; ++ai)
#pragma unroll
            for (int m = 0; m < 4; ++m) { if (ai == 1 && u.half) break;
                const int r = pg8::row0(u) + ai * 128 + wr * 64 + m * 16 + fr;
#pragma unroll
                for (int bj = 0; bj < 2; ++bj) {
                    const int cc = bj * 128 + wc * 32 + fq * 8;
                    f32x4 a = acc[ai][bj][m][0], b = acc[ai][bj][m][1];
                    if (pn == 12) { if (cc < 32) { *(f32x4*)(g + (size_t)r * 32 + cc) = a + *(const f32x4*)(bgate + cc); *(f32x4*)(g + (size_t)r * 32 + cc + 4) = b + *(const f32x4*)(bgate + cc + 4); } continue; }
                    if (pn < 2) { a = a * 0.125f; b = b * 0.125f; }
                    v4u ov; ov.x = pk2(a.x, a.y); ov.y = pk2(a.z, a.w); ov.z = pk2(b.x, b.y); ov.w = pk2(b.z, b.w);
                    bf16* dst = (pn < 2) ? k + (size_t)r * 512 + pn * 256 + cc : (pn < 6) ? v + (size_t)r * 1024 + (pn - 2) * 256 + cc : (pn < 8) ? q + (size_t)r * 512 + (pn - 6) * 256 + cc : o + (size_t)r * 1024 + (pn - 8) * 256 + cc;
                    *(v4u*)dst = ov;
                }
            }
    }
};
struct EpiG1 {
    static constexpr bool PERM = false, AFTER_DRAIN = false;
    bf16* hid;
    __device__ __forceinline__ void operator()(const f32x4 (&acc)[2][2][4][2], const pg8::Unit& u, int wr, int wc, int fr, int fq) const {
        const int pnl = u.pn & 3;
#pragma unroll
        for (int ai = 0; ai < 2; ++ai)
#pragma unroll
            for (int m = 0; m < 4; ++m) { if (ai == 1 && u.half) break;
                const int r = pg8::row0(u) + ai * 128 + wr * 64 + m * 16 + fr;
#pragma unroll
                for (int bj = 0; bj < 2; ++bj) {
                    const int hc = pnl * 128 + bj * 64 + wc * 16 + fq * 4;
                    const f32x4 ga = acc[ai][bj][m][0], up = acc[ai][bj][m][1];
                    f32x4 h; h.x = siluf_(ga.x) * up.x; h.y = siluf_(ga.y) * up.y; h.z = siluf_(ga.z) * up.z; h.w = siluf_(ga.w) * up.w;
                    st_bf4(hid + (size_t)r * DFF + hc, h);
                }
            }
    }
};
struct EpiG2 {
    static constexpr bool PERM = true, AFTER_DRAIN = false;
    bf16* y2; const float* __restrict__ slotw;
    __device__ __forceinline__ void operator()(const f32x4 (&acc)[2][2][4][2], const pg8::Unit& u, int wr, int wc, int fr, int fq) const {
        const int pnl = u.pn & 3;
#pragma unroll
        for (int ai = 0; ai < 2; ++ai)
#pragma unroll
            for (int m = 0; m < 4; ++m) { if (ai == 1 && u.half) break;
                const int r = pg8::row0(u) + ai * 128 + wr * 64 + m * 16 + fr;
                const float w = slotw[u.mb + (r - u.pm * 256)];
#pragma unroll
                for (int bj = 0; bj < 2; ++bj) {
                    const int c = pnl * 256 + bj * 128 + wc * 32 + fq * 8;
                    const f32x4 a = acc[ai][bj][m][0] * w, b = acc[ai][bj][m][1] * w;
                    v4u o; o.x = pk2(a.x, a.y); o.y = pk2(a.z, a.w); o.z = pk2(b.x, b.y); o.w = pk2(b.z, b.w);
                    *(v4u*)(y2 + (size_t)r * D + c) = o;
                }
            }
    }
};

struct CmNat { const float* W; int ld; __device__ __forceinline__ const float* col(int j) const { return W + j; } };
struct CmGlu { const float* W; int ld;
    __device__ __forceinline__ const float* col(int j) const { const int pn = j >> 8, gpart = (j >> 7) & 1, c = j & 127; return W + gpart * 1024 + 128 * pn + c; } };
struct CmKvq { const float* W; int ld;
    __device__ __forceinline__ const float* col(int j) const { const int pn = j >> 8, bj = (j >> 7) & 1, wc = (j >> 5) & 3, n = (j >> 4) & 1, q = j & 15; return W + 256 * pn + 64 * wc + 32 * bj + 16 * n + q; } };
struct CmMlIn { const float* W; int ld;
    __device__ __forceinline__ const float* col(int j) const {
        if (j < 1536) return W + j;
        if (j < 2048) return W + 1568 + (j - 1536);
        if (j < 3072) return W + 2080 + (j - 2048);
        if (j < 3104) return W + 1536 + (j - 3072);
        return nullptr; } };
struct CmG1 { const float* Wg; const float* Wu; int ld;
    __device__ __forceinline__ const float* col(int j) const { const int le = j >> 10, jj = j & 1023; const int pn = jj >> 8, bj = (jj >> 7) & 1, wc = (jj >> 5) & 3, n = (jj >> 4) & 1, q = jj & 15;
        const uintptr_t a = (uintptr_t)Wg, b = (uintptr_t)Wu, msk = (uintptr_t)0 - (uintptr_t)n;
        return (const float*)((a & ~msk) | (b & msk)) + (size_t)le * 1024 * 512 + 128 * pn + 64 * bj + 16 * wc + q; } };
struct CmG2 { const float* Wd; int ld;
    __device__ __forceinline__ const float* col(int j) const { const int le = j >> 10, jj = j & 1023; return Wd + (size_t)le * 512 * 1024 + jj; } };

template <class CM>
__device__ __forceinline__ void transpose_item(const CM& cm, int K, bf16* WT, int kb, int nb, LAS float* scr, int lane) {
    const int k0 = 64 * kb, n0 = 32 * nb;
    const int nq = (lane & 7) * 4;
    const float* cp = cm.col(n0 + nq);
    const size_t ld = (size_t)cm.ld;
    f32x4 v[8];
#pragma unroll
    for (int i = 0; i < 8; ++i) { const int kk = 8 * i + (lane >> 3); v[i] = cp ? *(const f32x4*)(cp + (size_t)(k0 + kk) * ld) : (f32x4){0.f, 0.f, 0.f, 0.f}; }
#pragma unroll
    for (int i = 0; i < 8; ++i) { const int kk = 8 * i + (lane >> 3); LAS float* d = scr + kk * 33 + nq; d[0] = v[i].x; d[1] = v[i].y; d[2] = v[i].z; d[3] = v[i].w; }
    LDS_WAIT(); asm volatile("" ::: "memory");
    const int c = lane & 7;
#pragma unroll
    for (int j = 0; j < 4; ++j) { const int n = (lane >> 3) + 8 * j; const LAS float* s = scr + (8 * c) * 33 + n;
        v4u o; o.x = pk2(s[0 * 33], s[1 * 33]); o.y = pk2(s[2 * 33], s[3 * 33]); o.z = pk2(s[4 * 33], s[5 * 33]); o.w = pk2(s[6 * 33], s[7 * 33]);
        *(v4u*)(WT + (size_t)(n0 + n) * K + k0 + 8 * c) = o; }
    LDS_WAIT(); asm volatile("" ::: "memory");
}
template <class CM>
__device__ __forceinline__ void transpose_all(Frame& F, const CM& cm, int K, int Ndest, bf16* WT, int rot) {
    LAS float* scr = (LAS float*)(F.lds + RING_OFF + F.wave * 16384);
    const int NGW = F.G * NWAVES, gw = (F.blk * NWAVES + F.wave + rot) % NGW;
    const int nblk = Ndest / 32, items = (K / 64) * nblk;
    for (int it = gw; it < items; it += NGW) transpose_item(cm, K, WT, it / nblk, it % nblk, scr, F.lane);
}

__device__ __forceinline__ void phase_prologue(Frame& F) {
    {
        LAS float* cond = (LAS float*)(F.lds);
        LAS float* red = (LAS float*)(F.lds + 40960);
        for (int i = F.tid; i < 9 * 1024; i += NTHR) { const int mb = i >> 10, k = i & 1023; const float v = (mb < 8) ? F.in[IN_C][mb * 1024 + k] : F.in[IN_CCTX][k]; cond[i] = siluf_(v); }
        __syncthreads();
        float* mod = (float*)(F.ws + WS_MOD);
        for (int it = F.blk; it < DEPTH * 48; it += F.G) {
            const int l = it / 48, n0 = (it % 48) * 128;
            const float* w = F.in[IN_ADAW] + (size_t)l * 1024 * 6144 + n0 + 2 * F.lane;
            f32x2 a[9];
#pragma unroll
            for (int mb = 0; mb < 9; ++mb) a[mb] = (f32x2){0.f, 0.f};
            const int kb = F.wave * 128;
            for (int k8 = 0; k8 < 128; k8 += 8) {
                f32x2 wv[8];
#pragma unroll
                for (int u = 0; u < 8; ++u) wv[u] = *(const f32x2*)(w + (size_t)(kb + k8 + u) * 6144);
#pragma unroll
                for (int u = 0; u < 8; ++u)
#pragma unroll
                    for (int mb = 0; mb < 9; ++mb) a[mb] += wv[u] * cond[mb * 1024 + kb + k8 + u];
            }
#pragma unroll
            for (int mb = 0; mb < 9; ++mb) *(LAS f32x2*)(red + (F.wave * 9 + mb) * 128 + 2 * F.lane) = a[mb];
            __syncthreads();
            for (int i = F.tid; i < 9 * 128; i += NTHR) { const int mb = i >> 7, ln = i & 127; float s = F.in[IN_ADAB][l * 6144 + n0 + ln];
#pragma unroll
                for (int wv = 0; wv < 8; ++wv) s += red[(wv * 9 + mb) * 128 + ln];
                mod[(size_t)(l * 9 + mb) * 6144 + n0 + ln] = s; }
            __syncthreads();
        }
    }
    { const int idx = F.blk * NTHR + F.tid;
      if (idx < 1024) { const int pos = idx >> 4, f = idx & 15; const float inv = exp2f(-(float)f * (13.287712379549449f / 16.f)); const float ang = (float)pos * inv;
          double s, c; sincos_d((double)ang, s, c); float* rope = (float*)(F.ws + WS_ROPE); rope[idx] = (float)c; rope[1024 + idx] = (float)s; } }
    __syncthreads();
    { CmGlu cm{F.in[IN_S5WGLU], 2048}; transpose_all(F, cm, 1024, 2048, (bf16*)(F.ws + WS_WGLU), 0); }
    { CmGlu cm{F.in[IN_S5WGLU] + (size_t)1024 * 2048, 2048}; transpose_all(F, cm, 1024, 2048, (bf16*)(F.ws + WS_WGLU) + (size_t)2048 * 1024, 1024); }
    { CmKvq cm{F.in[IN_AWKVQ], 1536}; transpose_all(F, cm, 1024, 1536, (bf16*)(F.ws + WS_WKVQ), 0); }
    { CmNat cm{F.in[IN_AWO], 1024}; transpose_all(F, cm, 1024, 1024, (bf16*)(F.ws + WS_WO), 768); }
    { CmMlIn cm{F.in[IN_MLWIN], 3104}; transpose_all(F, cm, 1024, ML_NIN, (bf16*)(F.ws + WS_WIN), 1280); }
    { CmNat cm{F.in[IN_MLWOUT], 1024}; transpose_all(F, cm, 1024, 1024, (bf16*)(F.ws + WS_WOUT), 896); }
    { CmG1 cm{F.in[IN_MWG], F.in[IN_MWU], 512}; transpose_all(F, cm, 1024, DEPTH * NEXP * 1024, (bf16*)(F.ws + WS_WG1), 1408); }
    { CmG2 cm{F.in[IN_MWD], 1024}; transpose_all(F, cm, 512, DEPTH * NEXP * 1024, (bf16*)(F.ws + WS_WG2), 1408); }
}

struct RowMod { f32x4 a[4], b[4], c[4]; int mr; };
__device__ __forceinline__ void rowmod_load(RowMod& M, const float* base, int mr, int oa, int ob, int oc, int lane) {
    if (mr == M.mr) return; M.mr = mr; const float* p = base + (size_t)mr * 6144;
#pragma unroll
    for (int j = 0; j < 4; ++j) { M.a[j] = *(const f32x4*)(p + oa + 4 * lane + 256 * j); M.b[j] = *(const f32x4*)(p + ob + 4 * lane + 256 * j); if (oc >= 0) M.c[j] = *(const f32x4*)(p + oc + 4 * lane + 256 * j); }
}
struct RawRow { f32x4 x[4]; v2u ya[4], yb[4]; };
template <bool COMB, bool XBF>
__device__ __forceinline__ void raw_load(RawRow& R, const void* xrow, const bf16* y2, int s0, int s1, int lane) {
#pragma unroll
    for (int j = 0; j < 4; ++j) {
        if (XBF) { const v2u w = *(const v2u*)((const bf16*)xrow + 4 * lane + 256 * j); R.x[j] = (f32x4){bflo(w.x), bfhi(w.x), bflo(w.y), bfhi(w.y)}; }
        else R.x[j] = *(const f32x4*)((const float*)xrow + 4 * lane + 256 * j);
        if (COMB) { R.ya[j] = *(const v2u*)(y2 + (size_t)s0 * D + 4 * lane + 256 * j); R.yb[j] = *(const v2u*)(y2 + (size_t)s1 * D + 4 * lane + 256 * j); } }
}
__device__ __forceinline__ void load_etab(Frame& F, int L) {
    LAS int* tab = (LAS int*)(F.lds + ETAB_OFF);
    if (F.tid < 16) tab[17 + F.tid] = (int)F.ctl[CTL_GCNT + L * 64 + F.tid];
    __syncthreads();
    if (F.tid == 0) { int ts = 0; for (int e = 0; e < 16; ++e) { tab[e] = ts; ts += (tab[17 + e] + 255) >> 8; } tab[16] = ts; }
    __syncthreads();
}
template <int L>
__device__ __forceinline__ void phase_a1(Frame& F, const int skip = 0) {
    const float* mod = (const float*)(F.ws + WS_MOD);
    bf16* xres = (bf16*)(F.ws + WS_XRES); bf16* hb = (bf16*)(F.ws + WS_H);
    const bf16* y2 = (const bf16*)(F.ws + WS_Y2); const int* toke = (const int*)(F.ws + WS_TOKE); const int* tokr = (const int*)(F.ws + WS_TOKR);
    if (L > 0) load_etab(F, L > 0 ? L - 1 : 0);
    const LAS int* etab = (const LAS int*)(F.lds + ETAB_OFF);
    auto toks = [&](int idx) { return etab[toke[idx]] * 256 + tokr[idx]; };
    const int gw = F.blk * NWAVES + F.wave, NGW = F.G * NWAVES, lane = F.lane;
    const int RPW = (T + NGW - 1) / NGW, r0 = gw * RPW, r1 = (r0 + RPW < T) ? r0 + RPW : T;
    if (r0 >= T) return;
    f32x4 gv[4];
#pragma unroll
    for (int j = 0; j < 4; ++j) gv[j] = *(const f32x4*)(F.in[IN_N1G] + L * D + 4 * lane + 256 * j);
    auto rowptr = [&](int r) -> const void* { if (L == 0) return (r < TC) ? (const void*)(F.in[IN_CTX] + (size_t)r * D) : (const void*)(F.in[IN_X] + (size_t)(r - TC) * D); return (const void*)(xres + (size_t)r * D); };
    RowMod M1, M2; M1.mr = -1; M2.mr = -1;
    int ns0 = 0, ns1 = 0;
    if (L > 0) { ns0 = toks(2 * r0); ns1 = toks(2 * r0 + 1); }
    RawRow nx; raw_load<(L > 0), (L > 0)>(nx, rowptr(r0), y2, ns0, ns1, lane);
    if (L > 0 && r0 + 1 < r1) { ns0 = toks(2 * r0 + 2); ns1 = toks(2 * r0 + 3); }
    for (int r = r0; r < r1; ++r) {
        const int mr = mrow_of(r);
        RawRow cur = nx;
        if (r + 1 < r1) { raw_load<(L > 0), (L > 0)>(nx, rowptr(r + 1), y2, ns0, ns1, lane); if (L > 0 && r + 2 < r1) { ns0 = toks(2 * r + 4); ns1 = toks(2 * r + 5); } }
        rowmod_load(M1, mod + (size_t)L * 9 * 6144, mr, 0, 1024, -1, lane);
        if (L > 0) rowmod_load(M2, mod + (size_t)(L - 1) * 9 * 6144, mr, 5120, 5120, -1, lane);
        float ss = 0.f;
#pragma unroll
        for (int j = 0; j < 4; ++j) {
            f32x4 v = cur.x[j];
            if (L > 0) { const v2u a = cur.ya[j], b = cur.yb[j]; const f32x4 gg = M2.a[j];
                v.x += gg.x * (bflo(a.x) + bflo(b.x)); v.y += gg.y * (bfhi(a.x) + bfhi(b.x)); v.z += gg.z * (bflo(a.y) + bflo(b.y)); v.w += gg.w * (bfhi(a.y) + bfhi(b.y)); }
            cur.x[j] = v;
            if (!skip) st_bf4(xres + (size_t)r * D + 4 * lane + 256 * j, v); ss += v.x * v.x + v.y * v.y + v.z * v.z + v.w * v.w;
        }
        const float rs = rsqrtf(wave_sum(ss) * (1.f / D) + EPS);
#pragma unroll
        for (int j = 0; j < 4; ++j) { const f32x4 h = cur.x[j] * rs * gv[j] * (M1.b[j] + 1.f) + M1.a[j]; st_bf4(hb + (size_t)r * D + 4 * lane + 256 * j, h); }
    }
}
__device__ __forceinline__ float quad_get(float v, int k) {
    return k == 1 ? dpp_f<0x39>(v, v) : k == 2 ? dpp_f<0x4E>(v, v) : dpp_f<0x93>(v, v); }
template <int L>
__device__ __forceinline__ void phase_n2(Frame& F, const int var = 0) {
    constexpr int R0 = (L == DEPTH - 1) ? TC : 0;
    const float* mod = (const float*)(F.ws + WS_MOD);
    const bf16* xres = (const bf16*)(F.ws + WS_XRES); bf16* hb = (bf16*)(F.ws + WS_H);
    int* toke = (int*)(F.ws + WS_TOKE); int* tokr = (int*)(F.ws + WS_TOKR);
    LAS int* entE = (LAS int*)(F.lds + 90112); LAS int* entR = entE + 1024; LAS float* entW = (LAS float*)(entR + 1024); LAS int* baseL = entE + 3072;
    LAS v4u* rwf = (LAS v4u*)(F.lds);
    LAS float* PS = (LAS float*)(F.lds + 65536);
    LAS float* PL = (LAS float*)(F.lds + 65536 + 1024);
    LAS int* cntL = (LAS int*)(F.lds + SCT_OFF);
    for (int i = F.tid; i < 32 * 64; i += NTHR) { const int ks = i >> 6, ln = i & 63, e = ln & 15, k0 = 32 * ks + 8 * (ln >> 4);
        float w[8]; unsigned hi[4], lo[4];
#pragma unroll
        for (int jj = 0; jj < 8; ++jj) w[jj] = F.in[IN_RW][(k0 + jj) * 16 + e];
#pragma unroll
        for (int jj = 0; jj < 4; ++jj) { hi[jj] = pk2(w[2 * jj], w[2 * jj + 1]); lo[jj] = pk2(w[2 * jj] - bflo(hi[jj]), w[2 * jj + 1] - bfhi(hi[jj])); }
        rwf[2 * i] = (v4u){hi[0], hi[1], hi[2], hi[3]}; rwf[2 * i + 1] = (v4u){lo[0], lo[1], lo[2], lo[3]}; }
    if (F.tid < 16) cntL[F.tid] = 0;
    __syncthreads();
    const int lane = F.lane, rl = lane & 15, kg = lane >> 4, w = F.wave;
    const float rbias = F.in[IN_RB][rl];
    constexpr int NTILES = (T - R0) / 16;
    const int ntl = (NTILES - F.blk + F.G - 1) / F.G;
    const int c0 = 128 * w + 8 * kg;
    v4u xw4[4];
    if (ntl > 0) { const bf16* xr = xres + (size_t)(R0 + 16 * F.blk + rl) * D + c0;
#pragma unroll
        for (int q = 0; q < 4; ++q) xw4[q] = *(const v4u*)(xr + 32 * q); }
    for (int j = 0; j < ntl; ++j) {
        const int tile = F.blk + F.G * j, rbase = R0 + 16 * tile, mr = mrow_of(rbase), pb = j & 1;
        f32x4 ca[4], cb[4]; float ss = 0.f;
#pragma unroll
        for (int q = 0; q < 4; ++q) { const v4u t = xw4[q]; ca[q] = (f32x4){bflo(t.x), bfhi(t.x), bflo(t.y), bfhi(t.y)}; cb[q] = (f32x4){bflo(t.z), bfhi(t.z), bflo(t.w), bfhi(t.w)};
            ss += ca[q].x * ca[q].x + ca[q].y * ca[q].y + ca[q].z * ca[q].z + ca[q].w * ca[q].w + cb[q].x * cb[q].x + cb[q].y * cb[q].y + cb[q].z * cb[q].z + cb[q].w * cb[q].w; }
        ss = xor16_sum(ss); ss = xor32_sum(ss);
        if (kg == 0) PS[(pb * 8 + w) * 16 + rl] = ss;
        if (j + 1 < ntl) { const bf16* xr = xres + (size_t)(R0 + 16 * (tile + F.G) + rl) * D + c0;
#pragma unroll
            for (int q = 0; q < 4; ++q) xw4[q] = *(const v4u*)(xr + 32 * q); }
        __syncthreads();
        float tot = 0.f;
#pragma unroll
        for (int ww = 0; ww < 8; ++ww) tot += PS[(pb * 8 + ww) * 16 + rl];
        const float rs = rsqrtf(tot * (1.f / D) + EPS);
        const float* gp = F.in[IN_N2G] + L * D + c0; const float* shp = mod + (size_t)(L * 9 + mr) * 6144 + 3072 + c0; const float* scp = shp + 1024;
        bf16* hrow = hb + (size_t)(rbase + rl) * D + c0;
        f32x4 acc = (f32x4){0.f, 0.f, 0.f, 0.f};
#pragma unroll
        for (int q = 0; q < 4; ++q) {
            float h[8];
            { const f32x4 g0 = *(const f32x4*)(gp + 32 * q), g1 = *(const f32x4*)(gp + 32 * q + 4), cc0 = *(const f32x4*)(scp + 32 * q), cc1 = *(const f32x4*)(scp + 32 * q + 4), s0 = *(const f32x4*)(shp + 32 * q), s1 = *(const f32x4*)(shp + 32 * q + 4);
              const f32x4 h0 = ca[q] * rs * g0 * (cc0 + 1.f) + s0, h1 = cb[q] * rs * g1 * (cc1 + 1.f) + s1;
              h[0] = h0.x; h[1] = h0.y; h[2] = h0.z; h[3] = h0.w; h[4] = h1.x; h[5] = h1.y; h[6] = h1.z; h[7] = h1.w; }
            unsigned hi[4], lo[4];
#pragma unroll
            for (int jj = 0; jj < 4; ++jj) { hi[jj] = pk2(h[2 * jj], h[2 * jj + 1]); lo[jj] = pk2(h[2 * jj] - bflo(hi[jj]), h[2 * jj + 1] - bfhi(hi[jj])); }
            const v4u hv = (v4u){hi[0], hi[1], hi[2], hi[3]}, lv = (v4u){lo[0], lo[1], lo[2], lo[3]};
            *(v4u*)(hrow + 32 * q) = hv;
            const int ks = 4 * w + q;
            const v4u bh = rwf[2 * (ks * 64 + lane)], bl = rwf[2 * (ks * 64 + lane) + 1];
            acc = __builtin_amdgcn_mfma_f32_16x16x32_bf16(__builtin_bit_cast(bf16x8, hv), __builtin_bit_cast(bf16x8, bh), acc, 0, 0, 0);
            acc = __builtin_amdgcn_mfma_f32_16x16x32_bf16(__builtin_bit_cast(bf16x8, hv), __builtin_bit_cast(bf16x8, bl), acc, 0, 0, 0);
            acc = __builtin_amdgcn_mfma_f32_16x16x32_bf16(__builtin_bit_cast(bf16x8, lv), __builtin_bit_cast(bf16x8, bh), acc, 0, 0, 0);
        }
        *(LAS f32x4*)(PL + ((pb * 8 + w) * 64 + lane) * 4) = acc;
        __syncthreads();
        if (w != (j & 7) || (var & 1)) continue;
        f32x4 lg = (f32x4){0.f, 0.f, 0.f, 0.f};
#pragma unroll
        for (int ww = 0; ww < 8; ++ww) lg = lg + *(const LAS f32x4*)(PL + ((pb * 8 + ww) * 64 + lane) * 4);
#pragma unroll
        for (int r = 0; r < 4; ++r) {
            const float sco = sigmoidf_(lg[r]), sel = sco + rbias;
            int rank = 0;
#pragma unroll
            for (int k = 1; k < 4; ++k) { const float o = quad_get(sel, k); const int oi = (rl & ~3) | ((rl + k) & 3); rank += (o > sel || (o == sel && oi < rl)) ? 1 : 0; }
            const bool top2 = rank < 2;
            float gs = top2 ? sel : 0.f; gs += dpp_f<0xB1>(0.f, gs); gs += dpp_f<0x4E>(0.f, gs);
            bool best = true; const int q = rl >> 2;
            { const float o1 = dpp_f<0x124>(gs, gs), o2 = dpp_f<0x128>(gs, gs), o3 = dpp_f<0x12C>(gs, gs);
              const int q1 = (q + 3) & 3, q2 = (q + 2) & 3, q3 = (q + 1) & 3;
              best = !(o1 > gs || (o1 == gs && q1 < q)) && !(o2 > gs || (o2 == gs && q2 < q)) && !(o3 > gs || (o3 == gs && q3 < q)); }
            const bool selv = best && top2;
            const float wsum = red16_sum(selv ? sco : 0.f);
            if (selv) { const int row = rbase + 4 * kg + r;
                const int lr = __hip_atomic_fetch_add(cntL + rl, 1, __ATOMIC_RELAXED, __HIP_MEMORY_SCOPE_WORKGROUP);
                const int ei = j * 32 + (4 * kg + r) * 2 + rank; (void)row; entE[ei] = rl; entR[ei] = lr; entW[ei] = sco * __builtin_amdgcn_rcpf(wsum); }
        }
    }
    __syncthreads();
    if (var & 1) return;
    if (F.tid < 16) baseL[F.tid] = (int)__hip_atomic_fetch_add(F.ctl + CTL_GCNT + L * 64 + F.tid, (unsigned)cntL[F.tid], __ATOMIC_RELAXED, __HIP_MEMORY_SCOPE_AGENT);
    __syncthreads();
    int* slotre = (int*)(F.ws + WS_SLOTRE); float* slotwe = (float*)(F.ws + WS_SLOTWE);
    for (int i = F.tid; i < ntl * 32; i += NTHR) { const int j = i >> 5, row = R0 + 16 * (F.blk + F.G * j) + ((i & 31) >> 1), k = i & 1;
        const int e = entE[i], pos = baseL[e] + entR[i];
        toke[2 * row + k] = e; tokr[2 * row + k] = pos; slotre[e * T + pos] = row; slotwe[e * T + pos] = entW[i]; }
}
__device__ __forceinline__ void phase_fin(Frame& F) {
    const float* mod = (const float*)(F.ws + WS_MOD);
    const bf16* xres = (const bf16*)(F.ws + WS_XRES);
    const bf16* y2 = (const bf16*)(F.ws + WS_Y2); const int* toke = (const int*)(F.ws + WS_TOKE); const int* tokr = (const int*)(F.ws + WS_TOKR);
    load_etab(F, DEPTH - 1);
    const LAS int* etab = (const LAS int*)(F.lds + ETAB_OFF);
    auto toks = [&](int idx) { return etab[toke[idx]] * 256 + tokr[idx]; };
    const int gw = F.blk * NWAVES + F.wave, NGW = F.G * NWAVES, lane = F.lane;
    const int RPW = (TL + NGW - 1) / NGW, r0 = TC + gw * RPW, r1 = (r0 + RPW < T) ? r0 + RPW : T;
    if (r0 >= T) return;
    f32x4 gv[4];
#pragma unroll
    for (int j = 0; j < 4; ++j) gv[j] = *(const f32x4*)(F.in[IN_FING] + 4 * lane + 256 * j);
    RowMod M2; M2.mr = -1;
    int ns0 = toks(2 * r0), ns1 = toks(2 * r0 + 1);
    RawRow nx; raw_load<true, true>(nx, xres + (size_t)r0 * D, y2, ns0, ns1, lane);
    if (r0 + 1 < r1) { ns0 = toks(2 * r0 + 2); ns1 = toks(2 * r0 + 3); }
    for (int r = r0; r < r1; ++r) {
        const int mr = mrow_of(r);
        RawRow cur = nx;
        if (r + 1 < r1) { raw_load<true, true>(nx, xres + (size_t)(r + 1) * D, y2, ns0, ns1, lane); if (r + 2 < r1) { ns0 = toks(2 * r + 4); ns1 = toks(2 * r + 5); } }
        rowmod_load(M2, mod + (size_t)(DEPTH - 1) * 9 * 6144, mr, 5120, 5120, -1, lane);
        float ss = 0.f;
#pragma unroll
        for (int j = 0; j < 4; ++j) { f32x4 v = cur.x[j]; const v2u a = cur.ya[j], b = cur.yb[j]; const f32x4 gg = M2.a[j];
            v.x += gg.x * (bflo(a.x) + bflo(b.x)); v.y += gg.y * (bfhi(a.x) + bfhi(b.x)); v.z += gg.z * (bflo(a.y) + bflo(b.y)); v.w += gg.w * (bfhi(a.y) + bfhi(b.y));
            cur.x[j] = v; ss += v.x * v.x + v.y * v.y + v.z * v.z + v.w * v.w; }
        const float rs = rsqrtf(wave_sum(ss) * (1.f / D) + EPS);
#pragma unroll
        for (int j = 0; j < 4; ++j) *(f32x4*)(F.out + (size_t)(r - TC) * D + 4 * lane + 256 * j) = cur.x[j] * rs * gv[j];
    }
}

__device__ __forceinline__ int seq_row(int b, int dir, int s) {
    if (s < CTX) return b * CTX + (dir ? (CTX - 1 - s) : s);
    const int t = s - CTX; return TC + b * SEQ + (dir ? (SEQ - 1 - t) : t);
}
template <int J, bool WCTX>
__device__ __forceinline__ void phase_s5_naive(Frame& F) {
    const int gw = F.blk * NWAVES + F.wave, lane = F.lane;
    if ((gw & 3) != 0) return;
    const int it = gw >> 2; if (it >= NB * 64) return;
    const int b = it >> 6, g = it & 63, p = lane;
    const bf16* hb = (const bf16*)(F.ws + WS_H); float* ysum = (float*)(F.ws + WS_YSUM);
    for (int dir = 0; dir < 2; ++dir) {
        const int gi = (J * 2 + dir) * 64 + g, pidx = gi * 64 + p;
        const float lam_re = F.in[IN_S5LRE][pidx], lam_im = F.in[IN_S5LIM][pidx];
        const float dt = expf(F.in[IN_S5LOG][gi]);
        const float mag = expf(lam_re * dt);
        double sd, cd; sincos_d((double)(lam_im * dt), sd, cd);
        const float a_re = mag * (float)cd, a_im = mag * (float)sd;
        const float den = lam_re * lam_re + lam_im * lam_im, n_re = a_re - 1.f, n_im = a_im;
        const float f_re = (n_re * lam_re + n_im * lam_im) / den, f_im = (n_im * lam_re - n_re * lam_im) / den;
        float bbr[16], bbi[16], cre[16], cim[16];
#pragma unroll
        for (int c = 0; c < 16; ++c) { const float br = F.in[IN_S5BRE][(size_t)pidx * 16 + c], bi = F.in[IN_S5BIM][(size_t)pidx * 16 + c];
            bbr[c] = f_re * br - f_im * bi; bbi[c] = f_re * bi + f_im * br;
            cre[c] = F.in[IN_S5CRE][((size_t)gi * 16 + c) * 64 + p]; cim[c] = F.in[IN_S5CIM][((size_t)gi * 16 + c) * 64 + p]; }
        float x_re = 0.f, x_im = 0.f;
        for (int s = 0; s < CTX + SEQ; ++s) {
            const int r = seq_row(b, dir, s);
            const v4u u0 = *(const v4u*)(hb + (size_t)r * D + g * 16), u1 = *(const v4u*)(hb + (size_t)r * D + g * 16 + 8);
            float u[16];
            u[0] = bflo(u0.x); u[1] = bfhi(u0.x); u[2] = bflo(u0.y); u[3] = bfhi(u0.y); u[4] = bflo(u0.z); u[5] = bfhi(u0.z); u[6] = bflo(u0.w); u[7] = bfhi(u0.w);
            u[8] = bflo(u1.x); u[9] = bfhi(u1.x); u[10] = bflo(u1.y); u[11] = bfhi(u1.y); u[12] = bflo(u1.z); u[13] = bfhi(u1.z); u[14] = bflo(u1.w); u[15] = bfhi(u1.w);
            float bur = 0.f, bui = 0.f;
#pragma unroll
            for (int c = 0; c < 16; ++c) { bur += u[c] * bbr[c]; bui += u[c] * bbi[c]; }
            const float nr = a_re * x_re - a_im * x_im + bur, ni = a_re * x_im + a_im * x_re + bui;
            x_re = nr; x_im = ni;
            if (WCTX || s >= CTX) {
                float yv = 0.f;
#pragma unroll
                for (int c = 0; c < 16; ++c) { const float t = wave_sum(x_re * cre[c] - x_im * cim[c]); if (lane == c) yv = t; }
                if (lane < 16) { float* yp = ysum + (size_t)r * D + g * 16 + lane; if (dir == 0) *yp = yv; else *yp = *yp + yv; }
            }
        }
    }
}
template <int J, bool WCTX>
__device__ __forceinline__ void phase_s5_combine(Frame& F) {
    constexpr int R0 = WCTX ? 0 : TC;
    const bf16* hb = (const bf16*)(F.ws + WS_H); const float* ysum = (const float*)(F.ws + WS_YSUM); bf16* zb = (bf16*)(F.ws + WS_Z);
    const int gw = F.blk * NWAVES + F.wave, NGW = F.G * NWAVES, lane = F.lane;
    f32x4 dv[4];
#pragma unroll
    for (int j = 0; j < 4; ++j) dv[j] = *(const f32x4*)(F.in[IN_S5D] + J * D + 4 * lane + 256 * j);
    for (int r = R0 + gw; r < T; r += NGW) {
#pragma unroll
        for (int j = 0; j < 4; ++j) {
            const f32x4 y = *(const f32x4*)(ysum + (size_t)r * D + 4 * lane + 256 * j);
            const v2u hv = *(const v2u*)(hb + (size_t)r * D + 4 * lane + 256 * j);
            f32x4 z; z.x = gelu_tanh(y.x + dv[j].x * bflo(hv.x)); z.y = gelu_tanh(y.y + dv[j].y * bfhi(hv.x)); z.z = gelu_tanh(y.z + dv[j].z * bflo(hv.y)); z.w = gelu_tanh(y.w + dv[j].w * bfhi(hv.y));
            st_bf4(zb + (size_t)r * D + 4 * lane + 256 * j, z);
        }
    }
}
template <bool WCTX>
__device__ __forceinline__ void phase_attn_naive(Frame& F) {
    constexpr int R0 = WCTX ? 0 : TC;
    const bf16* qb = (const bf16*)(F.ws + WS_QB); const bf16* kb = (const bf16*)(F.ws + WS_KB); const bf16* vb = (const bf16*)(F.ws + WS_VB); bf16* zb = (bf16*)(F.ws + WS_Z);
    const int gw = F.blk * NWAVES + F.wave, NGW = F.G * NWAVES, lane = F.lane;
    for (int it = gw; it < (T - R0) * 16; it += NGW) {
        const int r = R0 + (it >> 4), h = it & 15, kvh = h >> 2;
        int kv0, nk;
        if (r < TC) { kv0 = (r >> 8) * KVLEN + SEQ; nk = CTX; } else { kv0 = ((r - TC) >> 11) * KVLEN; nk = KVLEN; }
        float q[64];
#pragma unroll
        for (int c = 0; c < 8; ++c) { const v4u w = *(const v4u*)(qb + (size_t)r * D + h * 64 + 8 * c);
            q[8 * c] = bflo(w.x); q[8 * c + 1] = bfhi(w.x); q[8 * c + 2] = bflo(w.y); q[8 * c + 3] = bfhi(w.y); q[8 * c + 4] = bflo(w.z); q[8 * c + 5] = bfhi(w.z); q[8 * c + 6] = bflo(w.w); q[8 * c + 7] = bfhi(w.w); }
        float m = -INFINITY, l = 0.f, o[64];
#pragma unroll
        for (int d = 0; d < 64; ++d) o[d] = 0.f;
        for (int kk = lane; kk < nk; kk += 64) {
            const bf16* kp = kb + (size_t)(kv0 + kk) * 256 + kvh * 64; const bf16* vp = vb + (size_t)(kv0 + kk) * 256 + kvh * 64;
            float s = 0.f;
#pragma unroll
            for (int c = 0; c < 8; ++c) { const v4u w = *(const v4u*)(kp + 8 * c);
                s += q[8 * c] * bflo(w.x) + q[8 * c + 1] * bfhi(w.x) + q[8 * c + 2] * bflo(w.y) + q[8 * c + 3] * bfhi(w.y) + q[8 * c + 4] * bflo(w.z) + q[8 * c + 5] * bfhi(w.z) + q[8 * c + 6] * bflo(w.w) + q[8 * c + 7] * bfhi(w.w); }
            const float mn = fmaxf(m, s), sc = exp2f(m - mn), pp = exp2f(s - mn);
            l = l * sc + pp; m = mn;
#pragma unroll
            for (int c = 0; c < 8; ++c) { const v4u w = *(const v4u*)(vp + 8 * c);
                o[8 * c] = o[8 * c] * sc + pp * bflo(w.x); o[8 * c + 1] = o[8 * c + 1] * sc + pp * bfhi(w.x); o[8 * c + 2] = o[8 * c + 2] * sc + pp * bflo(w.y); o[8 * c + 3] = o[8 * c + 3] * sc + pp * bfhi(w.y);
                o[8 * c + 4] = o[8 * c + 4] * sc + pp * bflo(w.z); o[8 * c + 5] = o[8 * c + 5] * sc + pp * bfhi(w.z); o[8 * c + 6] = o[8 * c + 6] * sc + pp * bflo(w.w); o[8 * c + 7] = o[8 * c + 7] * sc + pp * bfhi(w.w); }
        }
        const float M = wave_max(m), f = exp2f(m - M);
        const float lt = wave_sum(l * f);
        float res = 0.f;
#pragma unroll
        for (int d = 0; d < 64; ++d) { const float t = wave_sum(o[d] * f); if (lane == d) res = t; }
        zb[(size_t)r * D + h * 64 + lane] = (bf16)f2bf(res / lt);
    }
}
template <bool WCTX>
__device__ __forceinline__ void phase_mlstm_naive(Frame& F) {
    const int gw = F.blk * NWAVES + F.wave, lane = F.lane;
    if ((gw & 15) != 0) return;
    const int it = gw >> 4; if (it >= NB * 8 * 2) return;
    const int b = it >> 4, hd = (it >> 1) & 7, j = (it & 1) * 64 + lane;
    const bf16* kb = (const bf16*)(F.ws + WS_MK); const bf16* vb = (const bf16*)(F.ws + WS_MV); const bf16* qb = (const bf16*)(F.ws + WS_MQ);
    const float* gb = (const float*)(F.ws + WS_MG); float* hsum = (float*)(F.ws + WS_MHS);
    for (int dir = 0; dir < 2; ++dir) {
        float C[64], nn[64], m = 0.f;
#pragma unroll
        for (int d = 0; d < 64; ++d) { C[d] = 0.f; nn[d] = 0.f; }
        for (int s = 0; s < CTX + SEQ; ++s) {
            const int r = seq_row(b, dir, s);
            const float ig = gb[(size_t)r * 32 + dir * 16 + hd], lf = log_sigmoidf_(gb[(size_t)r * 32 + dir * 16 + 8 + hd]);
            const float mn = fmaxf(lf + m, ig), fa = __expf(lf + m - mn), ia = __expf(ig - mn); m = mn;
            const float vj = bf2f(vb[(size_t)r * 1024 + hd * 128 + j]) * ia;
            float num = 0.f, den = 0.f;
#pragma unroll
            for (int c = 0; c < 8; ++c) {
                const v4u kw = *(const v4u*)(kb + (size_t)r * 512 + hd * 64 + 8 * c), qw = *(const v4u*)(qb + (size_t)r * 512 + hd * 64 + 8 * c);
                float kk[8], qq[8];
                kk[0] = bflo(kw.x); kk[1] = bfhi(kw.x); kk[2] = bflo(kw.y); kk[3] = bfhi(kw.y); kk[4] = bflo(kw.z); kk[5] = bfhi(kw.z); kk[6] = bflo(kw.w); kk[7] = bfhi(kw.w);
                qq[0] = bflo(qw.x); qq[1] = bfhi(qw.x); qq[2] = bflo(qw.y); qq[3] = bfhi(qw.y); qq[4] = bflo(qw.z); qq[5] = bfhi(qw.z); qq[6] = bflo(qw.w); qq[7] = bfhi(qw.w);
#pragma unroll
                for (int e = 0; e < 8; ++e) { const int d = 8 * c + e;
                    C[d] = fa * C[d] + kk[e] * vj; nn[d] = fa * nn[d] + ia * kk[e]; num += C[d] * qq[e]; den += nn[d] * qq[e]; }
            }
            if (WCTX || s >= CTX) {
                const float outv = num / fmaxf(fabsf(den), __expf(-m));
                float* hp = hsum + (size_t)r * D + hd * 128 + j;
                if (dir == 0) *hp = outv; else *hp = *hp + outv;
            }
        }
    }
}
template <bool WCTX>
__device__ __forceinline__ void phase_mlstm_combine(Frame& F) {
    constexpr int R0 = WCTX ? 0 : TC;
    const float* hsum = (const float*)(F.ws + WS_MHS); const bf16* ob = (const bf16*)(F.ws + WS_MO); bf16* zb = (bf16*)(F.ws + WS_Z);
    const int gw = F.blk * NWAVES + F.wave, NGW = F.G * NWAVES, lane = F.lane;
    f32x4 gv[4];
#pragma unroll
    for (int j = 0; j < 4; ++j) gv[j] = *(const f32x4*)(F.in[IN_MLNG] + 4 * lane + 256 * j);
    for (int r = R0 + gw; r < T; r += NGW) {
#pragma unroll
        for (int j = 0; j < 4; ++j) {
            const f32x4 hv = *(const f32x4*)(hsum + (size_t)r * D + 4 * lane + 256 * j);
            float ss = hv.x * hv.x + hv.y * hv.y + hv.z * hv.z + hv.w * hv.w;
#pragma unroll
            for (int o = 1; o < 32; o <<= 1) ss += __shfl_xor(ss, o);
            const float rs = rsqrtf(ss * (1.f / 128.f) + EPS);
            const v2u ow = *(const v2u*)(ob + (size_t)r * D + 4 * lane + 256 * j);
            f32x4 z = hv * rs * gv[j];
            z.x *= sigmoidf_(bflo(ow.x)); z.y *= sigmoidf_(bfhi(ow.x)); z.z *= sigmoidf_(bflo(ow.y)); z.w *= sigmoidf_(bfhi(ow.y));
            st_bf4(zb + (size_t)r * D + 4 * lane + 256 * j, z);
        }
    }
}
#include <hip/hip_bf16.h>
#include <cmath>
namespace attn_body {
using bf16=__hip_bfloat16;
using bf16x8=__attribute__((ext_vector_type(8)))short;
using s16x4=__attribute__((ext_vector_type(4)))short;
using f32x16=__attribute__((ext_vector_type(16)))float;
using u32x4=__attribute__((ext_vector_type(4)))unsigned;
constexpr int D=64,QP=1024,KP=256;
constexpr int NW=8,QBLK=32,QB=QBLK*NW,KVBLK=64;
__device__ __forceinline__ int crow(int r,int hi){return (r&3)+8*(r>>2)+4*hi;}
#define SBAR() __builtin_amdgcn_sched_barrier(0)
__device__ __forceinline__ void cmask(f32x16&p0,f32x16&p1,int jb,int qrel,int hi){
  const float NEG=-INFINITY; int kb=64*jb+4*hi;
  #pragma unroll
  for(int r=0;r<16;++r){int kv=kb+(r&3)+8*(r>>2); if(kv>qrel)p0[r]=NEG; if(kv+32>qrel)p1[r]=NEG;}
}

constexpr int NSLOT=3, SLOTB=8192;
constexpr int LDS_K=0, LDS_V=NSLOT*SLOTB, LDS_WS=2*NSLOT*SLOTB, LDS_OST=LDS_WS+NW*64*4, LDS_BYTES=LDS_OST+NW*4096;
constexpr float C2=0.125f*1.4426950408889634f;
__device__ __forceinline__ void glds16(const void*gsrc,unsigned lds_dst){unsigned keep;
  asm volatile("s_mov_b32 %0, m0\n\ts_mov_b32 m0, %2\n\ts_nop 0\n\tglobal_load_lds_dwordx4 %1, off\n\ts_mov_b32 m0, %0":"=&s"(keep):"v"(gsrc),"s"(lds_dst):"memory");}
__device__ __forceinline__ float max3f(float a,float b,float c){float r;asm("v_max3_f32 %0, %1, %2, %3":"=v"(r):"v"(a),"v"(b),"v"(c));return r;}
__device__ __forceinline__ float max2f(float a,float b){float r;asm("v_max_f32_e32 %0, %1, %2":"=v"(r):"v"(a),"v"(b));return r;}
__device__ __forceinline__ float fadd_s(float a,float b){float r;asm("v_add_f32_e32 %0, %1, %2":"=v"(r):"v"(a),"v"(b));return r;}
__device__ __forceinline__ float fsub_s(float a,float b){float r;asm("v_sub_f32_e32 %0, %1, %2":"=v"(r):"v"(a),"v"(b));return r;}
typedef float f32x2_t __attribute__((ext_vector_type(2))); typedef __bf16 bf16x2_t __attribute__((ext_vector_type(2)));
__device__ __forceinline__ unsigned cvtpk_s(float lo,float hi){f32x2_t v={lo,hi};bf16x2_t b=__builtin_convertvector(v,bf16x2_t);return __builtin_bit_cast(unsigned,b);}
#define WAIT_BAR(N) asm volatile("s_waitcnt vmcnt(" #N ") lgkmcnt(0)\n\ts_barrier":::"memory")

__device__ __forceinline__ void qkt(f32x16&p0,f32x16&p1,const char*Kslot,const bf16x8*qr,const f32x16&negm,int r32,int hi){
  const char*kb=Kslot+hi*1024+r32*16;
  #pragma unroll
  for(int d0=0;d0<4;++d0){
    const bf16x8 b0=*reinterpret_cast<const bf16x8*>(kb+d0*2048);
    const bf16x8 b1=*reinterpret_cast<const bf16x8*>(kb+d0*2048+512);
    if(d0==0){p0=__builtin_amdgcn_mfma_f32_32x32x16_bf16(b0,qr[0],negm,0,0,0);p1=__builtin_amdgcn_mfma_f32_32x32x16_bf16(b1,qr[0],negm,0,0,0);}
    else{p0=__builtin_amdgcn_mfma_f32_32x32x16_bf16(b0,qr[d0],p0,0,0,0);p1=__builtin_amdgcn_mfma_f32_32x32x16_bf16(b1,qr[d0],p1,0,0,0);}}
}
typedef __attribute__((address_space(3))) const char* lds_cptr;
typedef short v4i16_t __attribute__((ext_vector_type(4)));
__device__ __forceinline__ void kload8(bf16x8*kf,lds_cptr kp){
  kf[0]=*(const __attribute__((address_space(3))) bf16x8*)(kp);      kf[1]=*(const __attribute__((address_space(3))) bf16x8*)(kp+512);
  kf[2]=*(const __attribute__((address_space(3))) bf16x8*)(kp+2048); kf[3]=*(const __attribute__((address_space(3))) bf16x8*)(kp+2560);
  kf[4]=*(const __attribute__((address_space(3))) bf16x8*)(kp+4096); kf[5]=*(const __attribute__((address_space(3))) bf16x8*)(kp+4608);
  kf[6]=*(const __attribute__((address_space(3))) bf16x8*)(kp+6144); kf[7]=*(const __attribute__((address_space(3))) bf16x8*)(kp+6656);
}
__device__ __forceinline__ void kload2(bf16x8*kf,lds_cptr kp,int j){ kf[2*j]=*(const __attribute__((address_space(3))) bf16x8*)(kp+j*2048); kf[2*j+1]=*(const __attribute__((address_space(3))) bf16x8*)(kp+j*2048+512); }
__device__ __forceinline__ s16x4 vtr(lds_cptr p){ return __builtin_bit_cast(s16x4,__builtin_amdgcn_ds_read_tr16_b64_v4i16((__attribute__((address_space(3))) v4i16_t*)p)); }
__device__ __forceinline__ float rowmax(const f32x16&p0,const f32x16&p1){
  float a=max3f(p0[0],p0[1],p1[0]),b=max3f(p0[2],p0[3],p1[1]);a=max3f(a,p1[2],p1[3]);
  #pragma unroll
  for(int r=4;r<16;r+=4){a=max3f(a,p0[r],p0[r+1]);b=max3f(b,p0[r+2],p0[r+3]);a=max3f(a,p1[r],p1[r+1]);b=max3f(b,p1[r+2],p1[r+3]);}
  const float m=max2f(a,b);
  auto rr=__builtin_amdgcn_permlane32_swap(__float_as_uint(m),__float_as_uint(m),false,false);
  return max2f(__uint_as_float(rr[0]),__uint_as_float(rr[1]));
}
__device__ __forceinline__ void pv(f32x16*o,int vb,bf16x8 pa0,bf16x8 pa1,bf16x8 pa2,bf16x8 pa3){
  #pragma unroll
  for(int d0=0;d0<2;++d0){s16x4 lo[4],hi[4];
    #pragma unroll
    for(int ks=0;ks<4;++ks){
      asm volatile("ds_read_b64_tr_b16 %0,%1 offset:%c2":"=&v"(lo[ks]):"v"(vb),"i"(d0*4096+ks*1024):"memory");
      asm volatile("ds_read_b64_tr_b16 %0,%1 offset:%c2":"=&v"(hi[ks]):"v"(vb),"i"(d0*4096+ks*1024+512):"memory");}
    asm volatile("s_waitcnt lgkmcnt(0)":::"memory");SBAR();
    #define PK(k) (bf16x8){lo[k][0],lo[k][1],lo[k][2],lo[k][3],hi[k][0],hi[k][1],hi[k][2],hi[k][3]}
    o[d0]=__builtin_amdgcn_mfma_f32_32x32x16_bf16(pa0,PK(0),o[d0],0,0,0);
    o[d0]=__builtin_amdgcn_mfma_f32_32x32x16_bf16(pa1,PK(1),o[d0],0,0,0);
    o[d0]=__builtin_amdgcn_mfma_f32_32x32x16_bf16(pa2,PK(2),o[d0],0,0,0);
    o[d0]=__builtin_amdgcn_mfma_f32_32x32x16_bf16(pa3,PK(3),o[d0],0,0,0);
    #undef PK
  }
}

#ifndef ATTN_STORE16
#define ATTN_STORE16(p,v) (*(u32x4*)(p)=(v))
#endif
template<int THRL> __device__ __forceinline__ void attn_unit(const bf16*Qu,const bf16*__restrict__ Kh,const bf16*__restrict__ Vh,bf16*Ou,const int NT,char*shm){
  const int tid=threadIdx.x,lane=tid&63,r32=lane&31,hi=lane>>5; const int wid=__builtin_amdgcn_readfirstlane(tid>>6);
  const bf16*Qw=Qu+(long)(wid*QBLK)*QP;
  const unsigned lds0=(unsigned)(uintptr_t)shm;
  float*wsf=(float*)(shm+LDS_WS)+wid*64;
  const bf16*ksrc=Kh+(long)lane*KP+wid*8;
  const bf16*vsrc=Vh+(long)(16*(wid&3)+(lane>>2))*KP+(wid>>2)*32+(lane&3)*8;
  const unsigned kdst=lds0+LDS_K+wid*1024, vdst=lds0+LDS_V+wid*1024;
  #define DMA_K(t,slot) glds16(ksrc+(long)(t)*KVBLK*KP,(unsigned)__builtin_amdgcn_readfirstlane(kdst+(slot)))
  #define DMA_V(t,slot) glds16(vsrc+(long)(t)*KVBLK*KP,(unsigned)__builtin_amdgcn_readfirstlane(vdst+(slot)))
  const int vb0=(int)(lds0+LDS_V)+((lane>>4)&1)*32+(lane&3)*8+(4*hi+((lane&15)>>2))*64;
  const char*Kbase=shm+LDS_K; bf16x8 kf[8];
  const lds_cptr shm3=(lds_cptr)shm; const lds_cptr kp0=shm3+LDS_K+hi*1024+r32*16; const lds_cptr vp0=shm3+LDS_V+((lane>>4)&1)*32+(lane&3)*8+(4*hi+((lane&15)>>2))*64;
  DMA_K(0,0);DMA_V(0,0);DMA_K(1,SLOTB);
  bf16x8 qr[4];
  #pragma unroll
  for(int d0=0;d0<4;++d0)qr[d0]=*reinterpret_cast<const bf16x8*>(&Qw[(long)r32*QP+d0*16+hi*8]);
  float mhat=0.f,l_reg=0.f;f32x16 o[2];o[0]=f32x16{};o[1]=f32x16{};f32x16 negm=f32x16{};asm volatile("":"+v"(negm));
  #define CMASK(P0,P1,t) do{}while(0)
  bool resc=false;
  #define START(P0,P1) do{ const float rm=rowmax(P0,P1); resc=false; \
    { const float dl=rm; mhat=fadd_s(mhat,dl); \
      _Pragma("unroll") for(int r=0;r<16;++r){P0[r]=fsub_s(P0[r],dl);P1[r]=fsub_s(P1[r],dl);} \
      _Pragma("unroll") for(int r=0;r<16;++r)negm[r]=-mhat; asm volatile("":"+v"(negm)); } \
    _Pragma("unroll") for(int r=0;r<16;++r)P0[r]=__builtin_amdgcn_exp2f(P0[r]); }while(0)
  #define RESC() do{ if(resc){ asm volatile("s_waitcnt lgkmcnt(0)":::"memory"); \
      _Pragma("unroll") for(int d_=0;d_<2;++d_) _Pragma("unroll") for(int r=0;r<16;++r)o[d_][r]*=wsf[crow(r,hi)]; } }while(0)
  f32x16 pA0,pA1,pB0,pB1;
  int sl_prev=0,sl_cur=0,sl_next=SLOTB;
  #define ROT() do{sl_prev=sl_cur;sl_cur=sl_next;sl_next=(sl_next==(NSLOT-1)*SLOTB)?0:sl_next+SLOTB;}while(0)
  DMA_K(2,2*SLOTB);
  WAIT_BAR(3);
  qkt(pA0,pA1,Kbase,qr,negm,r32,hi);asm volatile("s_nop 15\n\ts_nop 7":"+v"(pA0),"+v"(pA1));CMASK(pA0,pA1,0);
  START(pA0,pA1);
  _Pragma("unroll") for(int r=0;r<16;++r)pA1[r]=__builtin_amdgcn_exp2f(pA1[r]);
  WAIT_BAR(0);
  DMA_K(3,0);DMA_V(1,SLOTB);
  ROT();
  kload8(kf,kp0+sl_cur);
  WAIT_BAR(2);
  s16x4 vlo[8],vhi[8]; u32x4 pw0,pw1,pw2,pw3;
  #define PKW(P,B) cvtpk_s(P[B],P[B+1])
  #define PAF(k) __builtin_bit_cast(bf16x8,pw##k)
  #define VFR(i) (bf16x8){vlo[i][0],vlo[i][1],vlo[i][2],vlo[i][3],vhi[i][0],vhi[i][1],vhi[i][2],vhi[i][3]}
  #define PIN(x) asm volatile("":"+v"(x))
  #define MX3(a,b,c) __builtin_fmaxf(__builtin_fmaxf((a),(b)),(c))
  #define GAPA(MF,A0,A1,A2,A3,W0,W1,PW) do{ MF; sacc+=A0; sacc+=A1; sacc+=A2; sacc+=A3; PIN(sacc); W0; W1; PIN(PW); SBAR(); }while(0)
  #define EX(v) __builtin_amdgcn_exp2f(v)
  #define GAPB(MF,X,B) do{ MF; X[B]=EX(X[B]); X[B+1]=EX(X[B+1]); X[B+2]=EX(X[B+2]); X[B+3]=EX(X[B+3]); PIN(X); SBAR(); }while(0)
  #define VRD(i) do{ vlo[i]=vtr(vp_+(((i)>>2)*4096+((i)&3)*1024)); vhi[i]=vtr(vp_+(((i)>>2)*4096+((i)&3)*1024+512)); }while(0)
  #define KRD(G,j) do{ if(G){ kload2(kf,kp0+sl_next,j); SBAR(); } }while(0)
  #define STEP(C0,C1,P0,P1,t,GK,GV,GL) do{ SBAR(); \
    const lds_cptr vp_=vp0+sl_prev; \
    VRD(0); SBAR(); float sacc=(P0[0]+P0[1]); \
    GAPA(C0=__builtin_amdgcn_mfma_f32_32x32x16_bf16(kf[0],qr[0],negm,0,0,0), P0[2],P0[3],P0[4],P0[5],     pw0[0]=PKW(P0,0), pw0[1]=PKW(P0,2), pw0); \
    VRD(4); SBAR(); GAPA(C1=__builtin_amdgcn_mfma_f32_32x32x16_bf16(kf[1],qr[0],negm,0,0,0), P0[6],P0[7],P0[8],P0[9],     pw0[2]=PKW(P0,4), pw0[3]=PKW(P0,6), pw0); \
    VRD(1); SBAR(); GAPA(C0=__builtin_amdgcn_mfma_f32_32x32x16_bf16(kf[2],qr[1],C0,0,0,0),   P0[10],P0[11],P0[12],P0[13], pw1[0]=PKW(P0,8), pw1[1]=PKW(P0,10), pw1); \
    VRD(5); SBAR(); GAPA(C1=__builtin_amdgcn_mfma_f32_32x32x16_bf16(kf[3],qr[1],C1,0,0,0),   P0[14],P0[15],P1[0],P1[1],   pw1[2]=PKW(P0,12),pw1[3]=PKW(P0,14), pw1); \
    VRD(2); SBAR(); GAPA(C0=__builtin_amdgcn_mfma_f32_32x32x16_bf16(kf[4],qr[2],C0,0,0,0),   P1[2],P1[3],P1[4],P1[5],     pw2[0]=PKW(P1,0), pw2[1]=PKW(P1,2), pw2); \
    VRD(6); SBAR(); GAPA(C1=__builtin_amdgcn_mfma_f32_32x32x16_bf16(kf[5],qr[2],C1,0,0,0),   P1[6],P1[7],P1[8],P1[9],     pw2[2]=PKW(P1,4), pw2[3]=PKW(P1,6), pw2); \
    VRD(3); SBAR(); GAPA(C0=__builtin_amdgcn_mfma_f32_32x32x16_bf16(kf[6],qr[3],C0,0,0,0),   P1[10],P1[11],P1[12],P1[13], pw3[0]=PKW(P1,8), pw3[1]=PKW(P1,10), pw3); \
    VRD(7); SBAR(); GAPA(C1=__builtin_amdgcn_mfma_f32_32x32x16_bf16(kf[7],qr[3],C1,0,0,0),   P1[14],P1[15],0.f,0.f,       pw3[2]=PKW(P1,12),pw3[3]=PKW(P1,14), pw3); \
    l_reg+=sacc; \
    if(GK){DMA_K((t)+3,sl_cur);} if(GV){DMA_V((t)+1,sl_next);} \
    CMASK(C0,C1,t); \
    { float a=MX3(C0[0],C0[1],C1[0]),b=MX3(C0[2],C0[3],C1[1]); a=MX3(a,C1[2],C1[3]); \
      _Pragma("unroll") for(int r=4;r<16;r+=4){a=MX3(a,C0[r],C0[r+1]);b=MX3(b,C0[r+2],C0[r+3]);a=MX3(a,C1[r],C1[r+1]);b=MX3(b,C1[r+2],C1[r+3]);} \
      float rm=__builtin_fmaxf(a,b); { auto rr=__builtin_amdgcn_permlane32_swap(__float_as_uint(rm),__float_as_uint(rm),false,false); rm=__builtin_fmaxf(__uint_as_float(rr[0]),__uint_as_float(rr[1])); } \
      resc=false; \
      if(__builtin_expect(__any(rm>(float)THRL),0)){ const float dl=__builtin_fmaxf(rm,0.f); mhat+=dl; \
        _Pragma("unroll") for(int r=0;r<16;++r){C0[r]-=dl;C1[r]-=dl;} \
        _Pragma("unroll") for(int r=0;r<16;++r)negm[r]=-mhat; asm volatile("":"+v"(negm)); \
        const float f=__builtin_amdgcn_exp2f(-dl); l_reg*=f; if(hi==0)wsf[r32]=f; resc=true; } } \
    SBAR(); \
    GAPB(o[0]=__builtin_amdgcn_mfma_f32_32x32x16_bf16(PAF(0),VFR(0),o[0],0,0,0), C0,0); \
    GAPB(o[1]=__builtin_amdgcn_mfma_f32_32x32x16_bf16(PAF(0),VFR(4),o[1],0,0,0), C0,4); \
    KRD(GL,0); GAPB(o[0]=__builtin_amdgcn_mfma_f32_32x32x16_bf16(PAF(1),VFR(1),o[0],0,0,0), C0,8); \
    KRD(GL,1); GAPB(o[1]=__builtin_amdgcn_mfma_f32_32x32x16_bf16(PAF(1),VFR(5),o[1],0,0,0), C0,12); \
    KRD(GL,2); GAPB(o[0]=__builtin_amdgcn_mfma_f32_32x32x16_bf16(PAF(2),VFR(2),o[0],0,0,0), C1,0); \
    KRD(GL,3); GAPB(o[1]=__builtin_amdgcn_mfma_f32_32x32x16_bf16(PAF(2),VFR(6),o[1],0,0,0), C1,4); \
    GAPB(o[0]=__builtin_amdgcn_mfma_f32_32x32x16_bf16(PAF(3),VFR(3),o[0],0,0,0), C1,8); \
    GAPB(o[1]=__builtin_amdgcn_mfma_f32_32x32x16_bf16(PAF(3),VFR(7),o[1],0,0,0), C1,12); \
    }while(0)
  int t=1;
  #undef CMASK
  #define CMASK(P0,P1,t) do{}while(0)
  for(;t+5<NT;t+=2){
    STEP(pB0,pB1,pA0,pA1,t,true,true,true);     WAIT_BAR(2); RESC(); ROT();
    STEP(pA0,pA1,pB0,pB1,t+1,true,true,true);   WAIT_BAR(2); RESC(); ROT();
  }
  #undef CMASK
  #define CMASK(P0,P1,t) do{}while(0)
  #define ENDW(tt) do{ if((tt)+3<NT){WAIT_BAR(2);} else if((tt)+2<NT){WAIT_BAR(1);} else {WAIT_BAR(0);} }while(0)
  for(;t+1<NT;t+=2){
    STEP(pB0,pB1,pA0,pA1,t,(t+3<NT),(t+1<NT),(t+1<NT));       ENDW(t);   RESC(); ROT();
    STEP(pA0,pA1,pB0,pB1,t+1,(t+4<NT),(t+2<NT),(t+2<NT));     ENDW(t+1); RESC(); ROT();
  }
  STEP(pB0,pB1,pA0,pA1,NT-1,false,false,false); RESC();
  { float sacc=pB0[0]+pB0[1]; _Pragma("unroll") for(int r=2;r<16;++r)sacc+=pB0[r]; _Pragma("unroll") for(int r=0;r<16;++r)sacc+=pB1[r]; l_reg+=sacc;
    pw0=(u32x4){PKW(pB0,0),PKW(pB0,2),PKW(pB0,4),PKW(pB0,6)};pw1=(u32x4){PKW(pB0,8),PKW(pB0,10),PKW(pB0,12),PKW(pB0,14)};pw2=(u32x4){PKW(pB1,0),PKW(pB1,2),PKW(pB1,4),PKW(pB1,6)};pw3=(u32x4){PKW(pB1,8),PKW(pB1,10),PKW(pB1,12),PKW(pB1,14)};
    SBAR(); pv(o,vb0+sl_cur,PAF(0),PAF(1),PAF(2),PAF(3)); }
  #undef PKW
  #undef PAF
  #undef VFR
  #undef PIN
  #undef MX3
  #undef GAPA
  #undef GAPB
  #undef EX
  #undef VRD
  #undef KRD
  #undef STEP
  #undef ENDW
  {auto rr=__builtin_amdgcn_permlane32_swap(__float_as_uint(l_reg),__float_as_uint(l_reg),false,false);l_reg=__uint_as_float(rr[0])+__uint_as_float(rr[1]);}
  if(hi==0)wsf[32+r32]=l_reg;asm volatile("s_waitcnt lgkmcnt(0)":::"memory");
  float rli[16];
  #pragma unroll
  for(int r=0;r<16;++r)rli[r]=__builtin_amdgcn_rcpf(wsf[32+crow(r,hi)]);
  bf16*Ow=Ou+(long)(wid*QBLK)*QP;
  { bf16*stg=(bf16*)(shm+LDS_OST)+wid*2048;
    #pragma unroll
    for(int r=0;r<16;++r){const int orow=crow(r,hi);
      #pragma unroll
      for(int d0=0;d0<2;++d0)stg[orow*64+d0*32+r32]=__float2bfloat16(o[d0][r]*rli[r]);}
    asm volatile("s_waitcnt lgkmcnt(0)":::"memory");
    #pragma unroll
    for(int i=0;i<4;++i){const int row=i*8+(lane>>3),ch=lane&7; const u32x4 v=*(const u32x4*)(stg+row*64+ch*8); ATTN_STORE16(Ow+(long)row*QP+ch*8,v);} }
  asm volatile("s_waitcnt lgkmcnt(0)\n\ts_barrier":::"memory");
  #undef DMA_K
  #undef DMA_V
  #undef CMASK
  #undef START
  #undef RESC
  #undef ROT
}
constexpr int ATTN_LDS_BYTES=LDS_BYTES;
#undef SBAR
#undef WAIT_BAR
}

template <bool WCTX>
__device__ __forceinline__ void phase_attn_fast(Frame& F, char* ldsg) {
    typedef attn_body::bf16 abf;
    const abf* Q = (const abf*)(F.ws + WS_QB); const abf* K = (const abf*)(F.ws + WS_KB); const abf* V = (const abf*)(F.ws + WS_VB); abf* O = (abf*)(F.ws + WS_Z);
    const int vcu = (F.G % 8 == 0) ? (F.blk % 8) * (F.G / 8) + F.blk / 8 : F.blk;
    const int nunits = WCTX ? 1024 + 128 : 1024;
    for (int u = vcu; u < nunits; u += F.G) {
        int h, kvh, qrow0, kv0, NT;
        if (u < 1024) { const int grp = u >> 5, b = grp >> 2; kvh = grp & 3; const int qb = (u >> 2) & 7; h = kvh * 4 + (u & 3); qrow0 = TC + b * SEQ + qb * 256; kv0 = b * KVLEN; NT = KVLEN / 64; }
        else { const int u2 = u - 1024, b = u2 >> 4; h = u2 & 15; kvh = h >> 2; qrow0 = b * CTX; kv0 = b * KVLEN + SEQ; NT = CTX / 64; }
        attn_body::attn_unit<8>(Q + (size_t)qrow0 * 1024 + h * 64, K + (size_t)kv0 * 256 + kvh * 64, V + (size_t)kv0 * 256 + kvh * 64, O + (size_t)qrow0 * 1024 + h * 64, NT, ldsg + RING_OFF);
    }
}

constexpr int S5_BU_STRIDE = 132;
constexpr int S5_X_STRIDE = 136;
constexpr int S5_BU_BYTES = 16 * S5_BU_STRIDE * 4, S5_X_BYTES = 16 * S5_X_STRIDE * 2, S5_Y_BYTES = 2 * 64 * 16, S5_U_BYTES = 64 * 16;
constexpr int S5_ITEM_LDS = S5_BU_BYTES + S5_X_BYTES + 2 * S5_Y_BYTES + 4 * S5_U_BYTES;
constexpr int S5_NT = (CTX + SEQ) / 32;
static_assert(4 * S5_ITEM_LDS <= RING_BYTES, "S5 LDS");
#define S5_BAR() do { asm volatile("s_waitcnt lgkmcnt(0)" ::: "memory"); __builtin_amdgcn_s_barrier(); asm volatile("" ::: "memory"); } while (0)
__device__ __forceinline__ f32x2 cmul(f32x2 a, f32x2 b) { return (f32x2){a.x * b.x - a.y * b.y, a.x * b.y + a.y * b.x}; }

template <int J, bool WCTX>
__device__ __forceinline__ void phase_s5_fast(Frame& F) {
    const int lane = F.lane, w = F.wave;
    const bool helper = w >= 4;
    const int iw = w & 3, pairi = iw >> 1, dir = iw & 1;
    const int tq = lane & 15, kg = lane >> 4;
    const bf16* hb = (const bf16*)(F.ws + WS_H); float* ypart = (float*)(F.ws + WS_YSUM); bf16* zb = (bf16*)(F.ws + WS_Z);
    LAS unsigned char* base = F.lds + iw * S5_ITEM_LDS;
    LAS float* BU = (LAS float*)base;
    LAS bf16* XS = (LAS bf16*)(base + S5_BU_BYTES);
    LAS f32x4* YL = (LAS f32x4*)(base + S5_BU_BYTES + S5_X_BYTES);
    LAS v4u* UL = (LAS v4u*)(base + S5_BU_BYTES + S5_X_BYTES + 2 * S5_Y_BYTES);
    for (int it0 = F.blk * 2; it0 < NB * 64; it0 += F.G * 2) {
        const int it = it0 + pairi, b = it >> 6, g = it & 63;
        const int gi = (J * 2 + dir) * 64 + g;
        LAS v4u* TAB = (LAS v4u*)(F.lds);
        LAS f32x2* CST = (LAS f32x2*)(F.lds + 65536);
        LAS float* KMS = (LAS float*)(F.lds + 65536 + 6144);
        static_assert(65536 + 6144 + 8192 <= 4 * S5_ITEM_LDS, "S5 set-up scratch inside the item buffers");
        if (F.tid < 256) { const int i = F.tid >> 6, p = F.tid & 63; const int git = (J * 2 + (i & 1)) * 64 + ((it0 + (i >> 1)) & 63);
            const float dt = expf(F.in[IN_S5LOG][git]);
            const float lr = F.in[IN_S5LRE][git * 64 + p], li = F.in[IN_S5LIM][git * 64 + p]; const float mag = expf(lr * dt); double sd, cd; sincos_d((double)(li * dt), sd, cd);
            const float ar = mag * (float)cd, ai = mag * (float)sd, den = lr * lr + li * li, nr = ar - 1.f, ni = ai;
            const f32x2 a = (f32x2){ar, ai};
            CST[(i * 3 + 0) * 64 + p] = a; CST[(i * 3 + 1) * 64 + p] = cmul(a, a); CST[(i * 3 + 2) * 64 + p] = (f32x2){(nr * lr + ni * li) / den, (ni * lr - nr * li) / den}; }
        __syncthreads();
        for (int f = F.tid; f < 4 * 16 * 64; f += NTHR) {
            const int i = f >> 10, fi = (f >> 6) & 15, ln = f & 63, ltq = ln & 15, lkg = ln >> 4; const int git = (J * 2 + (i & 1)) * 64 + ((it0 + (i >> 1)) & 63);
            unsigned o[4];
            if (fi < 8) {
                const int n = 16 * fi + ltq, p = n >> 1, ri = n & 1;
                f32x2 co = CST[(i * 3 + 2) * 64 + p]; if ((lkg >> 1) == 0) co = cmul(co, CST[(i * 3 + 0) * 64 + p]);
                const float* brp = F.in[IN_S5BRE] + (size_t)git * 1024 + p * 16 + 8 * (lkg & 1); const float* bip = F.in[IN_S5BIM] + (size_t)git * 1024 + p * 16 + 8 * (lkg & 1);
#pragma unroll
                for (int q = 0; q < 4; ++q) { const f32x2 v0 = cmul(co, (f32x2){brp[2 * q], bip[2 * q]}), v1 = cmul(co, (f32x2){brp[2 * q + 1], bip[2 * q + 1]}); o[q] = pk2(ri ? v0.y : v0.x, ri ? v1.y : v1.x); }
            } else {
                const int tau = (fi - 8) >> 2, ks = fi & 3, p0 = 16 * ks + 4 * lkg;
                const float* crp = F.in[IN_S5CRE] + (size_t)git * 1024 + ltq * 64 + p0; const float* cip = F.in[IN_S5CIM] + (size_t)git * 1024 + ltq * 64 + p0;
#pragma unroll
                for (int q = 0; q < 4; ++q) { const f32x2 v = cmul((f32x2){crp[q], cip[q]}, CST[(i * 3 + tau) * 64 + p0 + q]); o[q] = pk2(v.x, -v.y); }
            }
            TAB[f] = (v4u){o[0], o[1], o[2], o[3]};
        }
        __syncthreads();
        if (helper) {
            const f32x4 d4 = *(const f32x4*)(F.in[IN_S5D] + J * D + g * 16 + 4 * kg);
            v4u ub[4]; f32x4 yoA0, yoA1, yoB0, yoB1;
#pragma unroll
            for (int k = 0; k < 4; ++k) ub[k] = *(const v4u*)(hb + (size_t)seq_row(b, dir, 32 * k + 2 * tq + (kg >> 1)) * D + g * 16 + 8 * (kg & 1));
            yoA0 = (f32x4){0.f, 0.f, 0.f, 0.f}; yoA1 = yoA0; yoB0 = yoA0; yoB1 = yoA0;
            S5_BAR();
#pragma unroll 4
            for (int T = -1; T < S5_NT + 3; ++T) {
                const int e = T - 1, d = T + 1;
                const bool e_ok = (e >= 0) && (e < S5_NT) && (WCTX || e >= 8);
                const bool e_second = (e < 8) ? (e >= 4) : (e >= 40);
                if (d >= 0 && d < S5_NT) UL[(d & 3) * 64 + lane] = ub[d & 3];
                if (e_ok) {
#pragma unroll
                    for (int tau = 0; tau < 2; ++tau) {
                        const size_t idx = (size_t)seq_row(b, dir, 32 * e + 2 * tq + tau) * D + g * 16 + 4 * kg;
                        const f32x4 y = YL[((e & 1) * 2 + tau) * 64 + lane];
                        if (!e_second) *(f32x4*)(ypart + idx) = y;
                        else {
                            f32x4 yo = (e & 1) ? (tau ? yoB1 : yoB0) : (tau ? yoA1 : yoA0);
                            if (e == 4 || e == 40) yo = *(const f32x4*)(ypart + idx);
                            const v2u hw = *(const v2u*)(hb + idx);
                            f32x4 v = y + yo; v.x += d4.x * bflo(hw.x); v.y += d4.y * bfhi(hw.x); v.z += d4.z * bflo(hw.y); v.w += d4.w * bfhi(hw.y);
                            v2u zo; zo.x = pk2(gelu_tanh(v.x), gelu_tanh(v.y)); zo.y = pk2(gelu_tanh(v.z), gelu_tanh(v.w));
                            *(v2u*)(zb + idx) = zo;
                        }
                    }
                }
                { const int e1 = e + 1; const bool e1_ok = (e1 >= 0) && (e1 < S5_NT) && (WCTX || e1 >= 8); const bool e1_second = (e1 < 8) ? (e1 >= 4) : (e1 >= 40);
                  if (e1_ok && e1_second && e1 != 4 && e1 != 40) {
                      const f32x4 l0 = *(const f32x4*)(ypart + (size_t)seq_row(b, dir, 32 * e1 + 2 * tq) * D + g * 16 + 4 * kg), l1 = *(const f32x4*)(ypart + (size_t)seq_row(b, dir, 32 * e1 + 2 * tq + 1) * D + g * 16 + 4 * kg);
                      if (e1 & 1) { yoB0 = l0; yoB1 = l1; } else { yoA0 = l0; yoA1 = l1; }
                  } }
                if (d >= 0 && d + 4 < S5_NT) ub[d & 3] = *(const v4u*)(hb + (size_t)seq_row(b, dir, 32 * (d + 4) + 2 * tq + (kg >> 1)) * D + g * 16 + 8 * (kg & 1));
                if (e == 3 || e == 39) asm volatile("s_waitcnt vmcnt(0)" ::: "memory");
                S5_BAR();
            }
        } else {
            const float* cre = F.in[IN_S5CRE] + (size_t)gi * 1024; const float* cim = F.in[IN_S5CIM] + (size_t)gi * 1024;
            bf16x8 wf[8], vkf[2][5];
#pragma unroll
            for (int rt = 0; rt < 8; ++rt) wf[rt] = __builtin_bit_cast(bf16x8, TAB[(iw * 16 + rt) * 64 + lane]);
#pragma unroll
            for (int tau = 0; tau < 2; ++tau)
#pragma unroll
                for (int ks = 0; ks < 4; ++ks) vkf[tau][ks] = __builtin_bit_cast(bf16x8, TAB[(iw * 16 + 8 + tau * 4 + ks) * 64 + lane]);
            const f32x2 a2 = CST[(iw * 3 + 1) * 64 + lane];
            { LAS float* KM = KMS + iw * 512;
              const LAS bf16* W2T = (const LAS bf16*)(TAB + (iw * 16) * 64);
#pragma unroll
              for (int e = 0; e < 2; ++e) {
                  f32x4 acc = (f32x4){0.f, 0.f, 0.f, 0.f};
#pragma unroll
                  for (int ks = 0; ks < 4; ++ks) {
                      bf16x8 cfr, fr;
                      const int p0 = 16 * ks + 4 * kg;
                      const f32x4 cr = *(const f32x4*)(cre + tq * 64 + p0), ci = *(const f32x4*)(cim + tq * 64 + p0);
                      cfr[0] = (short)f2bf(cr.x); cfr[1] = (short)f2bf(-ci.x); cfr[2] = (short)f2bf(cr.y); cfr[3] = (short)f2bf(-ci.y); cfr[4] = (short)f2bf(cr.z); cfr[5] = (short)f2bf(-ci.z); cfr[6] = (short)f2bf(cr.w); cfr[7] = (short)f2bf(-ci.w);
#pragma unroll
                      for (int jj = 0; jj < 8; ++jj) { const int n = 32 * ks + 8 * kg + jj, k = 16 * (1 - e) + tq; fr[jj] = (short)W2T[(((n >> 4) * 64) + (n & 15) + 16 * (k >> 3)) * 8 + (k & 7)]; }
                      acc = __builtin_amdgcn_mfma_f32_16x16x32_bf16(cfr, fr, acc, 0, 0, 0);
                  }
#pragma unroll
                  for (int r = 0; r < 4; ++r) KM[(e * 16 + 4 * kg + r) * 16 + tq] = acc[r];
              }
#pragma unroll
              for (int tau = 0; tau < 2; ++tau) { const int tp = kg >> 1; bf16x8 fr;
#pragma unroll
                  for (int jj = 0; jj < 8; ++jj) { const float v = (tp <= tau) ? KM[((tau - tp) * 16 + tq) * 16 + 8 * (kg & 1) + jj] : 0.f; fr[jj] = (short)f2bf(v); }
                  vkf[tau][4] = fr; } }
            asm volatile("s_waitcnt vmcnt(0) lgkmcnt(0)" ::: "memory");
            f32x2 x = (f32x2){0.f, 0.f};
            const f32x2 a2re = (f32x2){a2.x, a2.x}, a2im = (f32x2){-a2.y, a2.y};
            S5_BAR();
            for (int T = -1; T < S5_NT + 3; ++T) {
                if (T >= 0 && T < S5_NT) {
                    const bf16x8 uf = __builtin_bit_cast(bf16x8, UL[(T & 3) * 64 + lane]);
#pragma unroll
                    for (int rt = 0; rt < 8; ++rt) {
                        const f32x4 dacc = __builtin_amdgcn_mfma_f32_16x16x32_bf16(wf[rt], uf, (f32x4){0.f, 0.f, 0.f, 0.f}, 0, 0, 0);
                        *(LAS f32x4*)(BU + tq * S5_BU_STRIDE + 16 * rt + 4 * kg) = dacc;
                    }
                    f32x2 buv[16]; unsigned xw[16];
#pragma unroll
                    for (int t = 0; t < 16; ++t) buv[t] = *(const LAS f32x2*)(BU + t * S5_BU_STRIDE + 2 * lane);
#pragma unroll
                    for (int t = 0; t < 16; ++t) { xw[t] = pk2(x.x, x.y); const f32x2 xs = (f32x2){x.y, x.x}; x = a2re * x + (a2im * xs + buv[t]); }
                    if (WCTX || T >= 8) {
#pragma unroll
                        for (int t = 0; t < 16; ++t) *(LAS unsigned*)(XS + t * S5_X_STRIDE + 2 * lane) = xw[t];
                        bf16x8 xf[4];
#pragma unroll
                        for (int ks = 0; ks < 4; ++ks) xf[ks] = *(const LAS bf16x8*)(XS + tq * S5_X_STRIDE + 32 * ks + 8 * kg);
#pragma unroll
                        for (int tau = 0; tau < 2; ++tau) {
                            f32x4 y = __builtin_amdgcn_mfma_f32_16x16x32_bf16(vkf[tau][4], uf, (f32x4){0.f, 0.f, 0.f, 0.f}, 0, 0, 0);
#pragma unroll
                            for (int ks = 0; ks < 4; ++ks) y = __builtin_amdgcn_mfma_f32_16x16x32_bf16(vkf[tau][ks], xf[ks], y, 0, 0, 0);
                            YL[((T & 1) * 2 + tau) * 64 + lane] = y;
                        }
                    }
                }
                S5_BAR();
            }
        }
        __syncthreads();
    }
}

constexpr size_t WS_MCT = WS_MHS;
constexpr size_t WS_MN = WS_MG + 2359296;
constexpr size_t WS_MSC = WS_MN + 589824;
static_assert(WS_MSC + 2304 * 16 <= WS_MHS, "mLSTM small tables");
constexpr int ML_TS = 136;
constexpr int ML_DS = 72;

template <bool MAX>
__device__ __forceinline__ void scan128(LAS float* a, int lane) {
    const float v0 = a[2 * lane], v1 = a[2 * lane + 1];
    const float s = MAX ? fmaxf(v0, v1) : v0 + v1;
    float inc = s;
#pragma unroll
    for (int o = 1; o < 64; o <<= 1) { const float t = __shfl_up(inc, o); if (lane >= o) inc = MAX ? fmaxf(inc, t) : inc + t; }
    float exc = __shfl_up(inc, 1); if (lane == 0) exc = MAX ? -INFINITY : 0.f;
    a[2 * lane] = MAX ? fmaxf(exc, v0) : exc + v0; a[2 * lane + 1] = inc;
}

__device__ __forceinline__ void phase_ml_states(Frame& F) {
    const int tid = F.tid, lane = F.lane, w = F.wave, tq = lane & 15, kg = lane >> 4;
    const bf16* kb = (const bf16*)(F.ws + WS_MK); const bf16* vb = (const bf16*)(F.ws + WS_MV); const float* gb = (const float*)(F.ws + WS_MG);
    float* cT = (float*)(F.ws + WS_MCT); float* nl = (float*)(F.ws + WS_MN); float* sc = (float*)(F.ws + WS_MSC);
    LAS bf16* KeT = (LAS bf16*)(F.lds);
    LAS bf16* VT = (LAS bf16*)(F.lds + 64 * ML_TS * 2);
    LAS float* cumS = (LAS float*)(F.lds + 192 * ML_TS * 2);
    LAS float* igS = cumS + 128; LAS float* ewS = igS + 128; LAS float* red = ewS + 128;
    for (int us = F.blk; us < 2304; us += F.G) {
        const int jc = us % 18, bhd = us / 18, dir = bhd & 1, hd = (bhd >> 1) & 7, b = bhd >> 4;
        if (tid < 128) { const int r = seq_row(b, dir, 128 * jc + tid); igS[tid] = gb[(size_t)r * 32 + dir * 16 + hd]; cumS[tid] = log_sigmoidf_(gb[(size_t)r * 32 + dir * 16 + 8 + hd]); }
        __syncthreads();
        if (w == 0) {
            scan128<false>(cumS, lane);
            const float total = __shfl(cumS[2 * lane + 1], 63);
            const float w0 = total - cumS[2 * lane] + igS[2 * lane], w1 = total - cumS[2 * lane + 1] + igS[2 * lane + 1];
            const float ml = wave_max(fmaxf(w0, w1));
            ewS[2 * lane] = __expf(w0 - ml); ewS[2 * lane + 1] = __expf(w1 - ml);
            if (lane == 0) { sc[(size_t)us * 4] = total; sc[(size_t)us * 4 + 1] = ml; }
        }
        __syncthreads();
        { const int i = tid & 127, c = tid >> 7; const int r = seq_row(b, dir, 128 * jc + i); const float e = ewS[i];
#pragma unroll
          for (int h2 = 0; h2 < 2; ++h2) { const v4u kw = *(const v4u*)(kb + (size_t)r * 512 + hd * 64 + 16 * c + 8 * h2);
              const float kv[8] = {bflo(kw.x), bfhi(kw.x), bflo(kw.y), bfhi(kw.y), bflo(kw.z), bfhi(kw.z), bflo(kw.w), bfhi(kw.w)};
#pragma unroll
              for (int jj = 0; jj < 8; ++jj) KeT[(16 * c + 8 * h2 + jj) * ML_TS + i] = (bf16)f2bf(kv[jj] * e); }
#pragma unroll
          for (int h4 = 0; h4 < 4; ++h4) { const v4u vw = *(const v4u*)(vb + (size_t)r * 1024 + hd * 128 + 32 * c + 8 * h4);
              const unsigned vv[4] = {vw.x, vw.y, vw.z, vw.w};
#pragma unroll
              for (int jj = 0; jj < 8; ++jj) VT[(32 * c + 8 * h4 + jj) * ML_TS + i] = (bf16)((jj & 1) ? (vv[jj >> 1] >> 16) : (vv[jj >> 1] & 0xffffu)); } }
        __syncthreads();
#pragma unroll
        for (int dt = 0; dt < 4; ++dt) {
            f32x4 acc = (f32x4){0.f, 0.f, 0.f, 0.f};
#pragma unroll
            for (int ks = 0; ks < 4; ++ks) {
                const bf16x8 af = *(const LAS bf16x8*)(VT + (16 * w + tq) * ML_TS + 32 * ks + 8 * kg);
                const bf16x8 bfr = *(const LAS bf16x8*)(KeT + (16 * dt + tq) * ML_TS + 32 * ks + 8 * kg);
                acc = __builtin_amdgcn_mfma_f32_16x16x32_bf16(af, bfr, acc, 0, 0, 0);
            }
#pragma unroll
            for (int r = 0; r < 4; ++r) cT[(size_t)us * 8192 + (16 * w + 4 * kg + r) * 64 + 16 * dt + tq] = acc[r];
        }
        if (tid < 64) { float s = 0.f;
#pragma unroll
            for (int c8 = 0; c8 < 16; ++c8) { const v4u q = *(const LAS v4u*)(KeT + tid * ML_TS + 8 * c8); s += bflo(q.x) + bfhi(q.x) + bflo(q.y) + bfhi(q.y) + bflo(q.z) + bfhi(q.z) + bflo(q.w) + bfhi(q.w); }
            nl[(size_t)us * 64 + tid] = s; }
        __syncthreads();
    }
}

__device__ __forceinline__ void phase_ml_scan(Frame& F, const int skip = 0) {
    const int tid = F.tid;
    float* cT = (float*)(F.ws + WS_MCT); float* nl = (float*)(F.ws + WS_MN); float* sc = (float*)(F.ws + WS_MSC);
    for (int wi = F.blk; wi < 256; wi += F.G) {
        const int sq = wi >> 1, half = wi & 1; const bool don = (half == 0 && tid < 64);
        const size_t e0 = (size_t)half * 4096 + (size_t)tid * 8;
        f32x4 c0 = (f32x4){0.f, 0.f, 0.f, 0.f}, c1 = c0; float nn = 0.f, m = 0.f;
        size_t us = (size_t)sq * 18;
        f32x4 l0 = *(const f32x4*)(cT + us * 8192 + e0), l1 = *(const f32x4*)(cT + us * 8192 + e0 + 4);
        float ln = don ? nl[us * 64 + tid] : 0.f, tot = sc[us * 4], ml = sc[us * 4 + 1];
        for (int j = 0; j < 18; ++j, ++us) {
            const f32x4 a0 = l0, a1 = l1; const float an = ln, atot = tot, aml = ml;
            if (j + 1 < 18) { l0 = *(const f32x4*)(cT + (us + 1) * 8192 + e0); l1 = *(const f32x4*)(cT + (us + 1) * 8192 + e0 + 4); ln = don ? nl[(us + 1) * 64 + tid] : 0.f; tot = sc[(us + 1) * 4]; ml = sc[(us + 1) * 4 + 1]; }
            if (!skip) { *(f32x4*)(cT + us * 8192 + e0) = c0; *(f32x4*)(cT + us * 8192 + e0 + 4) = c1;
            if (don) nl[us * 64 + tid] = nn;
            if (half == 0 && tid == 0) sc[us * 4 + 2] = m; }
            const float mn = fmaxf(atot + m, aml), fa = __expf(atot + m - mn), fb = __expf(aml - mn);
            c0 = c0 * fa + a0 * fb; c1 = c1 * fa + a1 * fb; nn = nn * fa + an * fb; m = mn;
        }
    }
}

struct M3Regs { float gi, gf, n0v, m00, m01; v4u q[2], k[2], v[4]; };
__device__ __forceinline__ void m3_load(M3Regs& R, Frame& F, int u, int tid) {
    const bf16* kb = (const bf16*)(F.ws + WS_MK); const bf16* vb = (const bf16*)(F.ws + WS_MV); const bf16* qb = (const bf16*)(F.ws + WS_MQ);
    const float* gb = (const float*)(F.ws + WS_MG); const float* cT = (const float*)(F.ws + WS_MCT); const float* nl = (const float*)(F.ws + WS_MN); const float* sc = (const float*)(F.ws + WS_MSC);
    const int jo = u % 18, bh = u / 18, hd = bh & 7, b = bh >> 3;
    const int row0 = (jo < 2) ? b * CTX + 128 * jo : TC + b * SEQ + 128 * (jo - 2);
    const int jc1 = (jo < 2) ? 1 - jo : 19 - jo;
    const size_t us0 = (size_t)((b * 8 + hd) * 2 + 0) * 18 + jo, us1 = (size_t)((b * 8 + hd) * 2 + 1) * 18 + jc1;
    R.m00 = sc[us0 * 4 + 2]; R.m01 = sc[us1 * 4 + 2];
    R.gi = 0.f; R.gf = 0.f; R.n0v = 0.f;
    if (tid < 256) { const int dd = tid >> 7, sp = tid & 127; const int r = row0 + (dd ? 127 - sp : sp); R.gi = gb[(size_t)r * 32 + dd * 16 + hd]; R.gf = gb[(size_t)r * 32 + dd * 16 + 8 + hd]; }
    { const int i = tid & 127, c = tid >> 7; const int r = row0 + i;
#pragma unroll
      for (int h2 = 0; h2 < 2; ++h2) { R.q[h2] = *(const v4u*)(qb + (size_t)r * 512 + hd * 64 + 16 * c + 8 * h2); R.k[h2] = *(const v4u*)(kb + (size_t)r * 512 + hd * 64 + 16 * c + 8 * h2); } }
    { const int tp = tid & 63, c8 = tid >> 6;
#pragma unroll
      for (int tk = 0; tk < 2; ++tk)
#pragma unroll
          for (int h2 = 0; h2 < 2; ++h2) R.v[2 * tk + h2] = *(const v4u*)(vb + (size_t)(row0 + 2 * tp + tk) * 1024 + hd * 128 + 16 * c8 + 8 * h2); }
    if (tid < 128) R.n0v = nl[((tid >> 6) ? us1 : us0) * 64 + (tid & 63)];
}
__device__ __forceinline__ void phase_ml_out(Frame& F) {
    const int tid = F.tid, lane = F.lane, w = F.wave, tq = lane & 15, kg = lane >> 4;
    const bf16* ob = (const bf16*)(F.ws + WS_MO); bf16* zb = (bf16*)(F.ws + WS_Z);
    LAS bf16* QL = (LAS bf16*)(F.lds);
    LAS bf16* KL = (LAS bf16*)(F.lds + 18432);
    LAS bf16* SwL = (LAS bf16*)(F.lds + w * (16 * ML_TS * 2));
    LAS bf16* VT = (LAS bf16*)(F.lds + 36864);
    LAS bf16* C0T = (LAS bf16*)(F.lds + 36864 + 128 * ML_TS * 2);
    LAS float* GT = (LAS float*)(F.lds + 36864 + 128 * ML_TS * 2 + 2 * 144 * ML_DS * 2);
    static_assert(36864 + 128 * ML_TS * 2 + 2 * 144 * ML_DS * 2 + 2 * 3 * 128 * 4 <= RING_BYTES, "M3 LDS");
    for (int i = tid; i < 2 * 16 * ML_DS; i += NTHR) { const int dd = i / (16 * ML_DS), ii = i % (16 * ML_DS); C0T[dd * 144 * ML_DS + 128 * ML_DS + ii] = (bf16)0u; }
    constexpr int NU = NB * 8 * 18;
    M3Regs R;
    if (F.blk < NU) m3_load(R, F, F.blk, tid);
    __syncthreads();
    for (int u = F.blk; u < NU; u += F.G) {
        const int jo = u % 18, bh = u / 18, hd = bh & 7, b = bh >> 3;
        const int row0 = (jo < 2) ? b * CTX + 128 * jo : TC + b * SEQ + 128 * (jo - 2);
        const float m00 = R.m00, m01 = R.m01;
        if (tid < 256) { const int dd = tid >> 7, sp = tid & 127; GT[dd * 384 + sp] = R.gi; GT[dd * 384 + 256 + sp] = log_sigmoidf_(R.gf); }
        { const int i = tid & 127, c = tid >> 7;
#pragma unroll
          for (int h2 = 0; h2 < 2; ++h2) { *(LAS v4u*)(QL + i * ML_DS + 16 * c + 8 * h2) = R.q[h2]; *(LAS v4u*)(KL + i * ML_DS + 16 * c + 8 * h2) = R.k[h2]; } }
        { const int tp = tid & 63, c8 = tid >> 6;
#pragma unroll
          for (int h2 = 0; h2 < 2; ++h2) { const v4u a = R.v[h2], bq = R.v[2 + h2]; const unsigned av[4] = {a.x, a.y, a.z, a.w}, bv[4] = {bq.x, bq.y, bq.z, bq.w};
#pragma unroll
              for (int jj = 0; jj < 8; ++jj) { const unsigned lo = (jj & 1) ? (av[jj >> 1] >> 16) : (av[jj >> 1] & 0xffffu), hi = (jj & 1) ? (bv[jj >> 1] & 0xffff0000u) : (bv[jj >> 1] << 16);
                  *(LAS unsigned*)(VT + (16 * c8 + 8 * h2 + jj) * ML_TS + 2 * tp) = lo | hi; } } }
        { const float* cT = (const float*)(F.ws + WS_MCT); const int jc1 = (jo < 2) ? 1 - jo : 19 - jo;
          const size_t us0 = (size_t)((b * 8 + hd) * 2 + 0) * 18 + jo, us1 = (size_t)((b * 8 + hd) * 2 + 1) * 18 + jc1;
#pragma unroll
          for (int dd = 0; dd < 2; ++dd) { const size_t us = dd ? us1 : us0; const int jv = tid >> 2, dq = (tid & 3) * 16; const float* src = cT + us * 8192 + jv * 64 + dq;
#pragma unroll
              for (int h2 = 0; h2 < 2; ++h2) { const f32x4 a = *(const f32x4*)(src + 8 * h2), bq = *(const f32x4*)(src + 8 * h2 + 4);
                  v4u o; o.x = pk2(a.x, a.y); o.y = pk2(a.z, a.w); o.z = pk2(bq.x, bq.y); o.w = pk2(bq.z, bq.w);
                  *(LAS v4u*)(C0T + dd * 144 * ML_DS + jv * ML_DS + dq + 8 * h2) = o; } } }
        if (tid < 128) C0T[(tid >> 6) * 144 * ML_DS + 128 * ML_DS + (tid & 63)] = (bf16)f2bf(R.n0v);
        __syncthreads();
        if (u + F.G < NU) m3_load(R, F, u + F.G, tid);
        if (w < 2) {
            LAS float* gS = GT + w * 384; LAS float* mmS = gS + 128; LAS float* cumS = gS + 256; const float m0 = w ? m01 : m00;
            scan128<false>(cumS, lane);
            const float g0 = gS[2 * lane] - cumS[2 * lane], g1 = gS[2 * lane + 1] - cumS[2 * lane + 1];
            gS[2 * lane] = g0; gS[2 * lane + 1] = g1; mmS[2 * lane] = g0; mmS[2 * lane + 1] = g1;
            scan128<true>(mmS, lane);
            mmS[2 * lane] = fmaxf(mmS[2 * lane], m0); mmS[2 * lane + 1] = fmaxf(mmS[2 * lane + 1], m0);
        }
        __syncthreads();
        bf16x8 qf[2];
#pragma unroll
        for (int ks = 0; ks < 2; ++ks) qf[ks] = *(const LAS bf16x8*)(QL + (16 * w + tq) * ML_DS + 32 * ks + 8 * kg);
        float mm0r[4], mm1r[4], ai0[4], ai1[4], lb0[4], lb1[4];
#pragma unroll
        for (int r = 0; r < 4; ++r) { const int t0 = 16 * w + 4 * kg + r, t1 = 127 - t0;
            mm0r[r] = GT[128 + t0]; ai0[r] = __expf(m00 - mm0r[r]); lb0[r] = __expf(-GT[256 + t0] - mm0r[r]);
            mm1r[r] = GT[384 + 128 + t1]; ai1[r] = __expf(m01 - mm1r[r]); lb1[r] = __expf(-GT[384 + 256 + t1] - mm1r[r]); }
        f32x4 sraw[8]; float rs0[4] = {0.f, 0.f, 0.f, 0.f}, rs1[4] = {0.f, 0.f, 0.f, 0.f};
#pragma unroll
        for (int ct = 0; ct < 8; ++ct) {
            f32x4 a = (f32x4){0.f, 0.f, 0.f, 0.f};
#pragma unroll
            for (int ks = 0; ks < 2; ++ks) a = __builtin_amdgcn_mfma_f32_16x16x32_bf16(qf[ks], *(const LAS bf16x8*)(KL + (16 * ct + tq) * ML_DS + 32 * ks + 8 * kg), a, 0, 0, 0);
            sraw[ct] = a;
            const int o = 16 * ct + tq; const float g0o = GT[o], g1o = GT[384 + 127 - o];
#pragma unroll
            for (int r = 0; r < 4; ++r) { const int t0 = 16 * w + 4 * kg + r;
                rs0[r] += (o <= t0) ? a[r] * __expf(g0o - mm0r[r]) : 0.f; rs1[r] += (o >= t0) ? a[r] * __expf(g1o - mm1r[r]) : 0.f; }
        }
        f32x4 acc[8]; float sc0[4], sc1[4];
        {
            f32x4 q0 = (f32x4){0.f, 0.f, 0.f, 0.f}, q1 = q0;
#pragma unroll
            for (int ks = 0; ks < 2; ++ks) { q0 = __builtin_amdgcn_mfma_f32_16x16x32_bf16(qf[ks], *(const LAS bf16x8*)(C0T + (128 + tq) * ML_DS + 32 * ks + 8 * kg), q0, 0, 0, 0);
                                             q1 = __builtin_amdgcn_mfma_f32_16x16x32_bf16(qf[ks], *(const LAS bf16x8*)(C0T + 144 * ML_DS + (128 + tq) * ML_DS + 32 * ks + 8 * kg), q1, 0, 0, 0); }
#pragma unroll
            for (int r = 0; r < 4; ++r) {
                const float qn0 = red16_sum(q0[r]), qn1 = red16_sum(q1[r]);
                const float den0 = ai0[r] * qn0 + red16_sum(rs0[r]), den1 = ai1[r] * qn1 + red16_sum(rs1[r]);
                const float inv0 = __builtin_amdgcn_rcpf(fmaxf(fabsf(den0), lb0[r])), inv1 = __builtin_amdgcn_rcpf(fmaxf(fabsf(den1), lb1[r]));
                rs0[r] = inv0; rs1[r] = inv1; sc0[r] = ai0[r] * inv0; sc1[r] = ai1[r] * inv1; }
        }
#pragma unroll
        for (int ct = 0; ct < 8; ++ct) {
            f32x4 a0 = (f32x4){0.f, 0.f, 0.f, 0.f}, a1 = a0;
#pragma unroll
            for (int ks = 0; ks < 2; ++ks) { a0 = __builtin_amdgcn_mfma_f32_16x16x32_bf16(qf[ks], *(const LAS bf16x8*)(C0T + (16 * ct + tq) * ML_DS + 32 * ks + 8 * kg), a0, 0, 0, 0);
                                             a1 = __builtin_amdgcn_mfma_f32_16x16x32_bf16(qf[ks], *(const LAS bf16x8*)(C0T + 144 * ML_DS + (16 * ct + tq) * ML_DS + 32 * ks + 8 * kg), a1, 0, 0, 0); }
#pragma unroll
            for (int r = 0; r < 4; ++r) acc[ct][r] = a0[r] * sc0[r] + a1[r] * sc1[r];
        }
        __syncthreads();
#pragma unroll
        for (int ct = 0; ct < 8; ++ct) { const int o = 16 * ct + tq; const float g0o = GT[o], g1o = GT[384 + 127 - o];
#pragma unroll
            for (int r = 0; r < 4; ++r) { const int t0 = 16 * w + 4 * kg + r;
                const float x0 = (o <= t0) ? __expf(g0o - mm0r[r]) * rs0[r] : 0.f, x1 = (o >= t0) ? __expf(g1o - mm1r[r]) * rs1[r] : 0.f;
                SwL[(4 * kg + r) * ML_TS + 16 * ct + tq] = (bf16)f2bf(sraw[ct][r] * (x0 + x1)); } }
#pragma unroll
        for (int ks = 0; ks < 4; ++ks) {
            const bf16x8 af = *(const LAS bf16x8*)(SwL + tq * ML_TS + 32 * ks + 8 * kg);
#pragma unroll
            for (int ct = 0; ct < 8; ++ct) acc[ct] = __builtin_amdgcn_mfma_f32_16x16x32_bf16(af, *(const LAS bf16x8*)(VT + (16 * ct + tq) * ML_TS + 32 * ks + 8 * kg), acc[ct], 0, 0, 0);
        }
        float ss[4] = {0.f, 0.f, 0.f, 0.f};
#pragma unroll
        for (int ct = 0; ct < 8; ++ct) { ss[0] += acc[ct].x * acc[ct].x; ss[1] += acc[ct].y * acc[ct].y; ss[2] += acc[ct].z * acc[ct].z; ss[3] += acc[ct].w * acc[ct].w; }
#pragma unroll
        for (int r = 0; r < 4; ++r) ss[r] = rsqrtf(red16_sum(ss[r]) * (1.f / 128.f) + EPS);
#pragma unroll
        for (int ct = 0; ct < 8; ++ct) { const float gn = F.in[IN_MLNG][hd * 128 + 16 * ct + tq];
#pragma unroll
            for (int r = 0; r < 4; ++r) SwL[(4 * kg + r) * ML_TS + 16 * ct + tq] = (bf16)f2bf(acc[ct][r] * ss[r] * gn); }
#pragma unroll
        for (int i = 0; i < 4; ++i) { const int rr = 4 * i + kg, ch = tq;
            const v4u hv = *(const LAS v4u*)(SwL + rr * ML_TS + 8 * ch);
            const size_t idx = (size_t)(row0 + 16 * w + rr) * D + hd * 128 + 8 * ch;
            const v4u ov = *(const v4u*)(ob + idx);
            v4u zo; zo.x = pk2(bflo(hv.x) * sigmoidf_(bflo(ov.x)), bfhi(hv.x) * sigmoidf_(bfhi(ov.x))); zo.y = pk2(bflo(hv.y) * sigmoidf_(bflo(ov.y)), bfhi(hv.y) * sigmoidf_(bfhi(ov.y)));
            zo.z = pk2(bflo(hv.z) * sigmoidf_(bflo(ov.z)), bfhi(hv.z) * sigmoidf_(bfhi(ov.z))); zo.w = pk2(bflo(hv.w) * sigmoidf_(bflo(ov.w)), bfhi(hv.w) * sigmoidf_(bfhi(ov.w)));
            *(v4u*)(zb + idx) = zo; }
        __syncthreads();
    }
}

#ifndef USE_NAIVE_ATTN
#define USE_NAIVE_ATTN 0
#endif
#ifndef USE_NAIVE_S5
#define USE_NAIVE_S5 0
#endif
#ifndef USE_NAIVE_MLSTM
#define USE_NAIVE_MLSTM 0
#endif
#ifndef MK_MODE
#define MK_MODE 0
#endif
struct Args { const float* in[N_INPUTS]; float* out; unsigned char* ws; int ph_lo, ph_hi; };
enum { CBASE = __COUNTER__ + 1 };
#ifndef S5VAR
#define S5VAR 0
#endif
#ifndef DUP_A
#define DUP_A -1
#endif
#ifndef DUP_B
#define DUP_B -1
#endif
#define PHASE_IDS() { int t_ = threadIdx.x; asm volatile("" : "+v"(t_)); F.tid = t_; F.lane = t_ & 63; F.wave = __builtin_amdgcn_readfirstlane(t_ >> 6); }
#ifndef SW_PHASE
#define SW_PHASE -1
#endif
#define PHASE(...) { constexpr int k_ = __COUNTER__ - CBASE; if (lo <= k_ && k_ < hi) { PHASE_IDS() unsigned long long swt_ = 0; if (k_ == SW_PHASE) swt_ = __builtin_amdgcn_s_memtime(); \
    { constexpr int rep_ = 0; (void)rep_; __VA_ARGS__ } \
    if constexpr (k_ == DUP_A || k_ == DUP_B) { xcd_barrier(bar); { constexpr int rep_ = 1; (void)rep_; __VA_ARGS__ } } \
    if (k_ + 1 < hi) xcd_barrier(bar); \
    if (k_ == SW_PHASE && F.blk == 0 && threadIdx.x == 0) F.ctl[64] = (unsigned)((__builtin_amdgcn_s_memtime() - swt_) >> 4); } }

__global__ void __launch_bounds__(NTHR, 2) fwd_kernel(Args args) {
    extern __shared__ __attribute__((aligned(16))) unsigned char lds[];
    Frame F;
    F.lds = (LAS unsigned char*)lds;
    F.MISC = (volatile LAS unsigned*)(F.lds + MISC_OFF);
    F.tid = threadIdx.x; F.lane = F.tid & 63; F.wave = __builtin_amdgcn_readfirstlane(F.tid >> 6);
    F.G = gridDim.x; F.blk = blockIdx.x;
    F.ws = args.ws; F.out = args.out; F.ctl = (unsigned*)(args.ws + WS_CTL);
#pragma unroll
    for (int i = 0; i < N_INPUTS; ++i) F.in[i] = args.in[i];
    for (int u = F.tid; u < (LDS_BYTES - LDSCTL_OFF) / 4; u += NTHR) ((LAS unsigned*)(F.lds + LDSCTL_OFF))[u] = 0u;
    __syncthreads();
    const int lo = args.ph_lo, hi = args.ph_hi;
    XcdBarrier bar; bar.bar = F.ctl + CW_BAR; bar.x = 0; bar.st = nullptr;
    if (hi - lo > 1) bar = xcd_barrier_post(F.ctl + CW_BAR, F.MISC + 8);

    unsigned char* ws = F.ws;
    bf16* xres = (bf16*)(ws + WS_XRES); const float* mod = (const float*)(ws + WS_MOD);
    bf16* hb = (bf16*)(ws + WS_H); bf16* zb = (bf16*)(ws + WS_Z);
    const LAS int* etab = (const LAS int*)(F.lds + ETAB_OFF);

#define MOE_PHASES(L) \
    PHASE(phase_n2<L>(F, rep_);) \
    PHASE({ load_etab(F, L); pg8::Gemm g{(const bf16*)(ws + WS_H), (const bf16*)(ws + WS_WG1) + (size_t)(L) * NEXP * 1024 * 1024, SLOTS, NEXP * 1024, 1024, (const int*)(ws + WS_SLOTRE)}; \
               MoeSched S{etab, F.G, F.blk, 4}; EpiG1 E{(bf16*)(ws + WS_HID)}; run_gemm_gather(F, g, S, E); }) \
    PHASE({ load_etab(F, L); pg8::Gemm g{(const bf16*)(ws + WS_HID), (const bf16*)(ws + WS_WG2) + (size_t)(L) * NEXP * 1024 * 512, SLOTS, NEXP * 1024, 512}; \
               MoeSched S{etab, F.G, F.blk, 4}; EpiG2 E{(bf16*)(ws + WS_Y2), (const float*)(ws + WS_SLOTWE)}; run_gemm(F, g, S, E); })

    PHASE(phase_prologue(F);)
    PHASE(phase_a1<0>(F, rep_);)
#if USE_NAIVE_S5
    PHASE(phase_s5_naive<0, true>(F);)
    PHASE(phase_s5_combine<0, true>(F);)
#else
    PHASE(phase_s5_fast<0, true>(F);)
#endif
    PHASE({ pg8::Gemm g{zb, (const bf16*)(ws + WS_WGLU), T, 2048, 1024}; DenseSchedH S; S.init(T, 2048, F.G, F.blk, 0);
               EpiGlu E{xres, mod + 0 * 9 * 6144 + 2048, F.in[IN_S5BGLU], rep_}; run_gemm(F, g, S, E); })
    MOE_PHASES(0)
    PHASE(phase_a1<1>(F, rep_);)
    PHASE({ pg8::Gemm g{hb, (const bf16*)(ws + WS_WKVQ), T, 1536, 1024}; DenseSched S; S.init(T, 1536, F.G, F.blk, 0);
               EpiKvq E{(bf16*)(ws + WS_QB), (bf16*)(ws + WS_KB), (bf16*)(ws + WS_VB), F.in[IN_AQG], F.in[IN_AKG], (const float*)(ws + WS_ROPE)}; run_gemm(F, g, S, E); })
#if USE_NAIVE_ATTN
    PHASE(phase_attn_naive<true>(F);)
#else
    PHASE(phase_attn_fast<true>(F, (char*)lds);)
#endif
    PHASE({ pg8::Gemm g{zb, (const bf16*)(ws + WS_WO), T, 1024, 1024}; DenseSchedH S; S.init(T, 1024, F.G, F.blk, 0);
               EpiRes E{xres, mod + 1 * 9 * 6144 + 2048, rep_, (bf16*)(ws + WS_MIX)}; run_gemm(F, g, S, E); })
    MOE_PHASES(1)
    PHASE(phase_a1<2>(F, rep_);)
    PHASE({ pg8::Gemm g{hb, (const bf16*)(ws + WS_WIN), T, ML_NIN, 1024}; DenseSched S; S.init(T, ML_NIN, F.G, F.blk, 0);
               EpiMlIn E{(bf16*)(ws + WS_MK), (bf16*)(ws + WS_MV), (bf16*)(ws + WS_MQ), (bf16*)(ws + WS_MO), (float*)(ws + WS_MG), F.in[IN_MLBG]}; run_gemm(F, g, S, E); })
#if USE_NAIVE_MLSTM
    PHASE(phase_mlstm_naive<true>(F);)
    PHASE(phase_mlstm_combine<true>(F);)
#else
    PHASE(phase_ml_states(F);)
    PHASE(phase_ml_scan(F, rep_);)
    PHASE(phase_ml_out(F);)
#endif
    PHASE({ pg8::Gemm g{zb, (const bf16*)(ws + WS_WOUT), T, 1024, 1024}; DenseSchedH S; S.init(T, 1024, F.G, F.blk, 0);
               EpiRes E{xres, mod + 2 * 9 * 6144 + 2048, rep_, (bf16*)(ws + WS_MHS)}; run_gemm(F, g, S, E); })
    MOE_PHASES(2)
    PHASE(phase_a1<3>(F, rep_);)
#if USE_NAIVE_S5
    PHASE(phase_s5_naive<1, false>(F);)
    PHASE(phase_s5_combine<1, false>(F);)
#else
    PHASE(phase_s5_fast<1, false>(F);)
#endif
    PHASE({ pg8::Gemm g{zb, (const bf16*)(ws + WS_WGLU) + (size_t)2048 * 1024, T, 2048, 1024}; DenseSched S; S.init(TL, 2048, F.G, F.blk, TC / 256);
               EpiGlu E{xres, mod + 3 * 9 * 6144 + 2048, F.in[IN_S5BGLU] + 2048, rep_}; run_gemm(F, g, S, E); })
    MOE_PHASES(3)
    PHASE(phase_fin(F);)
#if SW_PHASE >= 0
    if (F.blk == 0 && threadIdx.x == 0) { const unsigned v = __hip_atomic_load(F.ctl + 64, __ATOMIC_RELAXED, __HIP_MEMORY_SCOPE_AGENT); const unsigned long long t0 = __builtin_amdgcn_s_memtime();
        while (__builtin_amdgcn_s_memtime() - t0 < (unsigned long long)v * 16ull * 16ull) __builtin_amdgcn_s_sleep(8); }
#endif
}
constexpr int NPH = __COUNTER__ - CBASE;

extern "C" void kernel_launch(void* const* d_in, const int* in_sizes, int n_in, void* d_out, int out_size, void* d_ws, size_t ws_size, hipStream_t stream) {
    static int grid = 0;
    if (grid == 0) {
        if (n_in != N_INPUTS || out_size != TL * D || ws_size < WS_END) { fprintf(stderr, "kernel_launch: unexpected problem: n_in %d out %d ws %zu (need %zu)\n", n_in, out_size, ws_size, (size_t)WS_END); grid = -1; return; }
        int dev = 0, cus = 0, per_cu = 0;
        if (hipGetDevice(&dev) != hipSuccess || hipDeviceGetAttribute(&cus, hipDeviceAttributeMultiprocessorCount, dev) != hipSuccess) { grid = -1; return; }
        if (hipFuncSetAttribute((const void*)fwd_kernel, hipFuncAttributeMaxDynamicSharedMemorySize, LDS_BYTES) != hipSuccess) { fprintf(stderr, "kernel_launch: hipFuncSetAttribute failed\n"); grid = -1; return; }
        if (hipOccupancyMaxActiveBlocksPerMultiprocessor(&per_cu, (const void*)fwd_kernel, NTHR, LDS_BYTES) != hipSuccess || per_cu < 1) fprintf(stderr, "kernel_launch: occupancy query reports %d\n", per_cu);
        (void)hipGetLastError();
        grid = cus;
        if (grid > 256) grid = 256;
    }
    if (grid < 0) return;
    if (hipMemsetAsync((char*)d_ws + WS_CTL, 0, CTL_ZERO_BYTES, stream) != hipSuccess) return;
    Args a{};
    for (int i = 0; i < N_INPUTS; ++i) a.in[i] = (const float*)d_in[i];
    a.out = (float*)d_out; a.ws = (unsigned char*)d_ws;
#if MK_MODE == 0
    a.ph_lo = 0; a.ph_hi = NPH;
    hipLaunchKernelGGL(fwd_kernel, dim3(grid), dim3(NTHR), LDS_BYTES, stream, a);
#else
    for (int p = 0; p < NPH; ++p) { a.ph_lo = p; a.ph_hi = p + 1; hipLaunchKernelGGL(fwd_kernel, dim3(grid), dim3(NTHR), LDS_BYTES, stream, a); }
#endif
}
```

```cpp
#include <hip/hip_runtime.h>
#include <cstdio>
#include <cstdint>

#define GAS __attribute__((address_space(1)))
#define LAS __attribute__((address_space(3)))
typedef unsigned short bf16;
typedef unsigned v4u __attribute__((ext_vector_type(4)));
typedef unsigned v2u __attribute__((ext_vector_type(2)));
typedef float f32x4 __attribute__((ext_vector_type(4)));
typedef float f32x2 __attribute__((ext_vector_type(2)));
typedef short bf16x8 __attribute__((ext_vector_type(8)));

constexpr int D = 1024, NB = 8, SEQ = 2048, CTX = 256, DEPTH = 4;
constexpr int TC = NB * CTX;
constexpr int TL = NB * SEQ;
constexpr int T = TC + TL;
constexpr int KVLEN = SEQ + CTX;
constexpr int NEXP = 16, DFF = 512;
constexpr int SLOTS = 40960;
constexpr int ML_NIN = 3328;
constexpr float EPS = 1e-6f;
constexpr int NWAVES = 8, NTHR = 512;
constexpr float ATT_C2 = 0.125f * 1.4426950408889634f;

constexpr size_t MiB = 1u << 20;
constexpr size_t WS_CTL = 0, CTL_ZERO_BYTES = 1 * MiB;
constexpr size_t WS_MOD = 1 * MiB;
constexpr size_t WS_ROPE = 2 * MiB;
constexpr size_t WS_TOKE = 2 * MiB + 65536;
constexpr size_t WS_TOKR = WS_TOKE + 163840;
constexpr size_t WS_TOKW = WS_TOKR + 163840;
constexpr size_t WS_TOKS = WS_TOKW + 163840;
constexpr size_t WS_BCNT = WS_TOKS + 163840;
constexpr size_t WS_ETAB = WS_BCNT + 16384;
constexpr size_t WS_SLOTW = WS_ETAB + 4096;
static_assert(WS_SLOTW + SLOTS * 4 <= 4 * MiB, "small tables");
constexpr int CTL_GCNT = 8192;
constexpr size_t WS_WGLU = 4 * MiB;
constexpr size_t WS_WKVQ = WS_WGLU + 8 * MiB;
constexpr size_t WS_WO = WS_WKVQ + 3 * MiB;
constexpr size_t WS_WIN = WS_WO + 2 * MiB;
constexpr size_t WS_WOUT = WS_WIN + 7 * MiB;
constexpr size_t WS_WG1 = WS_WOUT + 2 * MiB;
constexpr size_t WS_WG2 = WS_WG1 + 128 * MiB;
constexpr size_t WS_XRES = WS_WG2 + 64 * MiB;
constexpr size_t WS_H = WS_XRES + 72 * MiB;
constexpr size_t WS_Z = WS_H + 36 * MiB;
constexpr size_t WS_MIX = WS_Z + 36 * MiB;
constexpr size_t WS_HS = WS_MIX;
constexpr size_t WS_SLOTRE = WS_HS;
constexpr size_t WS_SLOTWE = WS_HS + 2 * MiB;
constexpr size_t WS_HID = WS_HS + 80 * MiB;
constexpr size_t WS_Y2 = WS_HID + 40 * MiB;
constexpr size_t WS_END = WS_Y2 + 80 * MiB;
constexpr size_t WS_YSUM = WS_MIX;
constexpr size_t WS_QB = WS_MIX;
constexpr size_t WS_KB = WS_QB + 36 * MiB;
constexpr size_t WS_VB = WS_KB + 9 * MiB;
constexpr size_t WS_MK = WS_MIX;
constexpr size_t WS_MV = WS_MK + 18 * MiB;
constexpr size_t WS_MQ = WS_MV + 36 * MiB;
constexpr size_t WS_MO = WS_MQ + 18 * MiB;
constexpr size_t WS_MG = WS_MO + 36 * MiB;
constexpr size_t WS_MHS = WS_MG + 3 * MiB;
static_assert(WS_MHS + 72 * MiB <= WS_END, "mLSTM view fits");
static_assert(WS_END <= 600 * MiB, "workspace budget");

constexpr int CW_BAR = 4096;

constexpr int RING_OFF = 0, RING_BYTES = 131072;
constexpr int LDSCTL_OFF = RING_BYTES, MISC_OFF = LDSCTL_OFF + 320;
constexpr int ETAB_OFF = MISC_OFF + 128;
constexpr int SCT_OFF = ETAB_OFF + 256;
constexpr int LDS_BYTES = 147456;
static_assert(SCT_OFF + 256 <= LDS_BYTES, "LDS map");

#define LDS_WAIT() asm volatile("s_waitcnt lgkmcnt(0)" ::: "memory")
#define VM_WAIT() asm volatile("s_waitcnt vmcnt(0)" ::: "memory")
__device__ __forceinline__ unsigned f2bf(float f) { unsigned u = __builtin_bit_cast(unsigned, f); return (u + 0x7fffu + ((u >> 16) & 1u)) >> 16; }
typedef float f32x2_cv __attribute__((ext_vector_type(2))); typedef __bf16 bf16x2_cv __attribute__((ext_vector_type(2)));
__device__ __forceinline__ unsigned pk2(float lo, float hi) { f32x2_cv v = {lo, hi}; bf16x2_cv b = __builtin_convertvector(v, bf16x2_cv); return __builtin_bit_cast(unsigned, b); }
__device__ __forceinline__ float bf2f(unsigned h) { return __builtin_bit_cast(float, h << 16); }
__device__ __forceinline__ float bflo(unsigned w) { return __builtin_bit_cast(float, w << 16); }
__device__ __forceinline__ float bfhi(unsigned w) { return __builtin_bit_cast(float, w & 0xffff0000u); }
template <int CTRL, int RMASK = 0xF>
__device__ __forceinline__ float dpp_f(float oldv, float v) { return __builtin_bit_cast(float, __builtin_amdgcn_update_dpp(__builtin_bit_cast(int, oldv), __builtin_bit_cast(int, v), CTRL, RMASK, 0xF, false)); }
#ifndef USE_SHFL_XOR
#define USE_SHFL_XOR 0
#endif
#ifndef USE_SHFL_PARTIAL
#define USE_SHFL_PARTIAL 0
#endif
__device__ __forceinline__ float red16_sum(float v) {
#if USE_SHFL_PARTIAL
    for (int o = 1; o < 16; o <<= 1) v += __shfl_xor(v, o);
    return v;
#endif
    v += dpp_f<0xB1>(0.f, v); v += dpp_f<0x4E>(0.f, v); v += dpp_f<0x141>(0.f, v); v += dpp_f<0x140>(0.f, v); return v; }
__device__ __forceinline__ float red16_max(float v) {
    v = fmaxf(v, dpp_f<0xB1>(v, v)); v = fmaxf(v, dpp_f<0x4E>(v, v)); v = fmaxf(v, dpp_f<0x141>(v, v)); v = fmaxf(v, dpp_f<0x140>(v, v)); return v; }
#ifndef USE_SHFL_REDUCE
#define USE_SHFL_REDUCE 0
#endif
__device__ __forceinline__ float wave_sum(float v) {
#if USE_SHFL_REDUCE
    for (int o = 1; o < 64; o <<= 1) v += __shfl_xor(v, o);
    return v;
#endif
    v = red16_sum(v); v += dpp_f<0x142, 0xA>(0.f, v); v += dpp_f<0x143, 0xC>(0.f, v);
    return __builtin_bit_cast(float, __builtin_amdgcn_readlane(__builtin_bit_cast(int, v), 63)); }
__device__ __forceinline__ float wave_max(float v) {
    v = red16_max(v); v = fmaxf(v, dpp_f<0x142, 0xA>(v, v)); v = fmaxf(v, dpp_f<0x143, 0xC>(v, v));
    return __builtin_bit_cast(float, __builtin_amdgcn_readlane(__builtin_bit_cast(int, v), 63)); }
__device__ __forceinline__ float xor16_sum(float v) { return v + __shfl_xor(v, 16); }
__device__ __forceinline__ float xor32_sum(float v) { return v + __shfl_xor(v, 32); }
__device__ __forceinline__ float sigmoidf_(float x) { return __builtin_amdgcn_rcpf(1.f + __expf(-x)); }
__device__ __forceinline__ float siluf_(float x) { return x * __builtin_amdgcn_rcpf(1.f + __expf(-x)); }
__device__ __forceinline__ float gelu_tanh(float x) {
    const float p = __builtin_fmaf(x * x, 0.044715f, 1.0f);
    const float e = __builtin_amdgcn_exp2f((x * -2.302208198f) * p);
    return x * __builtin_amdgcn_rcpf(1.0f + e);
}
__device__ __forceinline__ float log_sigmoidf_(float x) { return fminf(x, 0.f) - __logf(1.f + __expf(-fabsf(x))); }
__device__ __forceinline__ void sincos_d(double a, double& s, double& c) {
    const double k = __builtin_rint(a * 0.63661977236758134308);
    double r = __builtin_fma(-k, 1.57079632679489655800e+00, a);
    r = __builtin_fma(-k, 6.12323399573676603587e-17, r);
    const double r2 = r * r;
    double sp = -1.0 / 1307674368000.0;
    sp = sp * r2 + 1.0 / 6227020800.0; sp = sp * r2 - 1.0 / 39916800.0; sp = sp * r2 + 1.0 / 362880.0; sp = sp * r2 - 1.0 / 5040.0; sp = sp * r2 + 1.0 / 120.0; sp = sp * r2 - 1.0 / 6.0;
    const double sr = r + r * r2 * sp;
    double cp = 1.0 / 20922789888000.0;
    cp = cp * r2 - 1.0 / 87178291200.0; cp = cp * r2 + 1.0 / 479001600.0; cp = cp * r2 - 1.0 / 3628800.0; cp = cp * r2 + 1.0 / 40320.0; cp = cp * r2 - 1.0 / 720.0; cp = cp * r2 + 1.0 / 24.0; cp = cp * r2 - 0.5;
    const double cr = 1.0 + r2 * cp;
    const int q = ((int)k) & 3;
    s = (q == 0) ? sr : (q == 1) ? cr : (q == 2) ? -sr : -cr;
    c = (q == 0) ? cr : (q == 1) ? -sr : (q == 2) ? -cr : sr;
}
__device__ __forceinline__ int mrow_of(int r) { return r < TC ? 8 : ((r - TC) >> 11); }
namespace pg8 {
#define PG8_LAS __attribute__((address_space(3)))
typedef unsigned short bf16_t;
typedef short bf16x8 __attribute__((ext_vector_type(8)));
typedef float f32x4 __attribute__((ext_vector_type(4)));
typedef unsigned u32x4 __attribute__((ext_vector_type(4)));
constexpr int BM = 256, BK = 64, HALF = 128, HTB = HALF * BK * 2  , STAGE_BYTES = 8 * HTB, NXCD = 8, WGM = 8;

__host__ __device__ __forceinline__ int lds_byte(int r, int c) { const int st = (r >> 4) * 2 + (c >> 5), rr = r & 15, cc = c & 31, ob = rr * 64 + cc * 2; return st * 1024 + (ob ^ (((ob >> 9) & 1) << 5)); }
__host__ __device__ __forceinline__ void stage_rc(int b, int& R, int& C) { const int st = b / 1024, sb = b % 1024, swz = sb ^ (((sb >> 9) & 1) << 5); R = (st >> 1) * 16 + swz / 64; C = (st & 1) * 32 + (swz % 64) / 2; }
__host__ __device__ __forceinline__ int perm32(int rho) { const int n = rho >> 4, i = rho & 15; return 8 * (i >> 2) + 4 * n + (i & 3); }

struct Unit { int pm, pn, half, mb, lim; };
__device__ __forceinline__ int row0(const Unit& u) { return u.pm * 256 + ((u.half >> 1) << 7); }
struct Gemm { const bf16_t* A; const bf16_t* Bt; int M, N, K; const int* rowmap; };

struct StaticOrder {
    int nM, nN, nwg, G, c;
    __host__ __device__ void init(int M, int N, int G_, int c_) { nM = M / BM; nN = N / BM; nwg = nM * nN; G = G_; c = c_; }
    __host__ __device__ bool next(int i, Unit& u) const {
        const long L = (long)i * G + c; if (L >= nwg) return false;
        int wgid = (int)L; { const int q = nwg / NXCD, r = nwg % NXCD, xcd = wgid % NXCD, off = wgid / NXCD; wgid = (xcd < r ? xcd * (q + 1) : r * (q + 1) + (xcd - r) * q) + off; }
        const int nig = WGM * nN, gid = wgid / nig, fm = gid * WGM, gsz = (nM - fm) < WGM ? (nM - fm) : WGM;
        u.pm = fm + ((wgid % nig) % gsz); u.pn = (wgid % nig) / gsz; u.half = 0; u.mb = 0; u.lim = 256; return true;
    }
    __device__ __forceinline__ void a_ready(const Unit&) const {}
    __device__ __forceinline__ void done(const Unit&) const {}
};


template <class Epi, class Sched, bool ALIGN_EPI = false, bool SP2 = false, bool GATHER = false>
__device__ __forceinline__ void gemm_phase(PG8_LAS unsigned char* lds, const Gemm g, const Sched& S, const Epi& E) {
    const int tid = threadIdx.x, wid = __builtin_amdgcn_readfirstlane(tid >> 6), lane = tid & 63, wr = wid >> 2, wc = wid & 3, fr = lane & 15, fq = lane >> 4;
    const int K = g.K, nt = K / BK;
    unsigned voffA[2], voffB[2];
#pragma unroll
    for (int i = 0; i < 2; ++i) { int R, C; stage_rc(tid * 16 + i * 8192, R, C); const int Rb = Epi::PERM ? ((R & ~31) + perm32(R & 31)) : R;
        voffA[i] = (unsigned)(R * K + C) * 2u; voffB[i] = (unsigned)(Rb * K + C) * 2u; }
    static_assert(!GATHER || SP2, "gather path is written for the SP2 loop");
    unsigned oc[2][2], rn[2][2], cbA[2]; int Rg[2];
    if constexpr (GATHER) {
#pragma unroll
        for (int i = 0; i < 2; ++i) { int R, C; stage_rc(tid * 16 + i * 8192, R, C); Rg[i] = R; cbA[i] = (unsigned)C * 2u; } }
    const char* gA = (const char*)g.A;
    const size_t kstep = (size_t)(BK * 2);
    const size_t hstep = (size_t)HALF * K * 2;
    const size_t tstep = 2 * hstep;
    const unsigned ldsw = (unsigned)wid * 1024u;
    const int aoff = lds_byte(wr * 64 + fr, fq * 8), boff = lds_byte(wc * 32 + fr, fq * 8);
#define PG8_SA(b, h) (((b) * 2 + (h)) * HTB)
#define PG8_SB(b, h) ((4 + (b) * 2 + (h)) * HTB)
#define PG8_STAGE(bufoff, gbase, voff) do { _Pragma("unroll") for (int _i = 0; _i < 2; ++_i) \
        __builtin_amdgcn_global_load_lds((const unsigned*)((const char*)(gbase) + (voff)[_i]), (PG8_LAS unsigned*)(lds + (bufoff) + ldsw + _i * 8192), 16, 0, 0); } while (0)
#define PG8_STA(b, h, base_ng, base_g, OFF) do { if constexpr (GATHER) PG8_STAGE(PG8_SA(b, h), base_g, OFF[h]); else PG8_STAGE(PG8_SA(b, h), (base_ng) + (h) * hstep, voffA); } while (0)
#define PG8_LDA(dst, b, h) do { _Pragma("unroll") for (int m = 0; m < 4; ++m) _Pragma("unroll") for (int k = 0; k < 2; ++k) dst[m][k] = *(const PG8_LAS bf16x8*)(lds + PG8_SA(b, h) + aoff + m * 2048 + k * 1024); } while (0)
#define PG8_LDB(dst, b, h) do { _Pragma("unroll") for (int n = 0; n < 2; ++n) _Pragma("unroll") for (int k = 0; k < 2; ++k) dst[n][k] = *(const PG8_LAS bf16x8*)(lds + PG8_SB(b, h) + boff + n * 2048 + k * 1024); } while (0)
#define PG8_MMA(ai, bj, At, Bt) do { __builtin_amdgcn_s_setprio(1); _Pragma("unroll") for (int m = 0; m < 4; ++m) _Pragma("unroll") for (int n = 0; n < 2; ++n) _Pragma("unroll") for (int k = 0; k < 2; ++k) \
        acc[ai][bj][m][n] = __builtin_amdgcn_mfma_f32_16x16x32_bf16(Bt[n][k], At[m][k], acc[ai][bj][m][n], 0, 0, 0); __builtin_amdgcn_s_setprio(0); } while (0)
#define PG8_WAIT_V(n) asm volatile("s_waitcnt vmcnt(" #n ")" ::: "memory")
#define PG8_WAIT_L(n) asm volatile("s_waitcnt lgkmcnt(" #n ")" ::: "memory")
#define PG8_BAR __builtin_amdgcn_s_barrier()
#define PG8_SCHED __builtin_amdgcn_sched_barrier(0)
    Unit cur, nxt; int ui = 0;
    if (!S.next(0, cur)) return;
    f32x4 acc[2][2][4][2];
#pragma unroll
    for (int a = 0; a < 2; ++a)
#pragma unroll
        for (int b = 0; b < 2; ++b)
#pragma unroll
            for (int m = 0; m < 4; ++m)
#pragma unroll
                for (int n = 0; n < 2; ++n) acc[a][b][m][n] = (f32x4){0.f, 0.f, 0.f, 0.f};
    bf16x8 At[4][2], B0[2][2], B1[2][2];
    const char* cA = (const char*)g.A + (size_t)cur.pm * tstep + (cur.half == 2 ? hstep : (size_t)0); const char* cB = (const char*)g.Bt + (size_t)cur.pn * tstep;
    bool hf = cur.half != 0;
    S.a_ready(cur);
    if constexpr (GATHER) {
#pragma unroll
        for (int h = 0; h < 2; ++h)
#pragma unroll
            for (int i = 0; i < 2; ++i) { const int lr = (cur.half == 2 ? 128 : h * 128) + Rg[i]; oc[h][i] = (unsigned)g.rowmap[cur.mb + (lr < cur.lim ? lr : 0)] * (unsigned)(K * 2) + cbA[i]; } }
    if constexpr (SP2) {
        PG8_STAGE(PG8_SB(0, 0), cB, voffB); PG8_STAGE(PG8_SB(0, 1), cB + hstep, voffB); PG8_STA(0, 0, cA, gA, oc); PG8_STA(0, 1, cA, gA, oc);
        if (wr == 1) PG8_BAR;
        PG8_WAIT_V(2); PG8_BAR;
        PG8_STAGE(PG8_SB(1, 0), cB + kstep, voffB); PG8_STA(1, 0, cA + kstep, gA + kstep, oc); PG8_STAGE(PG8_SB(1, 1), cB + hstep + kstep, voffB);
        PG8_WAIT_V(6); PG8_BAR;
    } else {
        PG8_STAGE(PG8_SB(0, 0), cB, voffB); PG8_STAGE(PG8_SA(0, 0), cA, voffA); PG8_STAGE(PG8_SB(0, 1), cB + hstep, voffB); PG8_STAGE(PG8_SA(0, 1), cA + hstep, voffA);
        if (wr == 1) PG8_BAR;
        PG8_WAIT_V(4); PG8_BAR;
        PG8_STAGE(PG8_SB(1, 0), cB + kstep, voffB); PG8_STAGE(PG8_SA(1, 0), cA + kstep, voffA); PG8_STAGE(PG8_SB(1, 1), cB + hstep + kstep, voffB);
        PG8_WAIT_V(6); PG8_BAR;
    }
    for (;;) {
        const bool has_next = S.next(ui + 1, nxt);
        if constexpr (GATHER) { if (has_next) {
#pragma unroll
            for (int h = 0; h < 2; ++h)
#pragma unroll
                for (int i = 0; i < 2; ++i) { const int lr = (nxt.half == 2 ? 128 : h * 128) + Rg[i]; rn[h][i] = (unsigned)g.rowmap[nxt.mb + (lr < nxt.lim ? lr : 0)]; } } }
        const char* nA = has_next ? (const char*)g.A + (size_t)nxt.pm * tstep + (nxt.half == 2 ? hstep : (size_t)0) : cA; const char* nB = has_next ? (const char*)g.Bt + (size_t)nxt.pn * tstep : cB;
        for (int t = 0; t < nt; t += 2) {
            const bool last = (t == nt - 2);
            const char* a1 = cA + (size_t)(t + 1) * kstep;
            const char* a2 = last ? nA : cA + (size_t)(t + 2) * kstep; const char* b2 = last ? nB : cB + (size_t)(t + 2) * kstep;
            const char* a3 = a2 + kstep; const char* b3 = b2 + kstep;
            if (last && has_next) S.a_ready(nxt);
            unsigned o2[2][2]; const char* a1g = gA + (size_t)(t + 1) * kstep; const char* a2g = gA + (last ? (size_t)0 : (size_t)(t + 2) * kstep); const char* a3g = a2g + kstep;
            if constexpr (GATHER) {
                if (last && has_next) {
#pragma unroll
                    for (int h = 0; h < 2; ++h)
#pragma unroll
                        for (int i = 0; i < 2; ++i) { unsigned v = rn[h][i]; asm volatile("" : "+v"(v)); o2[h][i] = v * (unsigned)(K * 2) + cbA[i]; } }
                else {
#pragma unroll
                    for (int h = 0; h < 2; ++h)
#pragma unroll
                        for (int i = 0; i < 2; ++i) o2[h][i] = oc[h][i]; }
            }
            if constexpr (SP2) {
            PG8_LDB(B0, 0, 0); PG8_LDB(B1, 0, 1); PG8_SCHED; PG8_LDA(At, 0, 0); PG8_STA(1, 1, a1, a1g, oc);
            PG8_WAIT_V(8); PG8_WAIT_L(0); PG8_BAR; PG8_MMA(0, 0, At, B0); PG8_MMA(0, 1, At, B1); PG8_BAR; PG8_SCHED;
            if (!hf) PG8_LDA(At, 0, 1); PG8_STAGE(PG8_SB(0, 0), b2, voffB); PG8_STAGE(PG8_SB(0, 1), b2 + hstep, voffB); PG8_STA(0, 0, a2, a2g, o2);
            PG8_WAIT_V(8); PG8_WAIT_L(0); PG8_BAR; if (!hf) { PG8_MMA(1, 0, At, B0); PG8_MMA(1, 1, At, B1); } PG8_BAR; PG8_SCHED;
            PG8_LDB(B0, 1, 0); PG8_LDB(B1, 1, 1); PG8_SCHED; PG8_LDA(At, 1, 0); PG8_STA(0, 1, a2, a2g, o2);
            PG8_WAIT_V(8); PG8_WAIT_L(0); PG8_BAR; PG8_MMA(0, 0, At, B0); PG8_MMA(0, 1, At, B1); PG8_BAR; PG8_SCHED;
            if (!hf) PG8_LDA(At, 1, 1); PG8_STAGE(PG8_SB(1, 0), b3, voffB); PG8_STAGE(PG8_SB(1, 1), b3 + hstep, voffB); PG8_STA(1, 0, a3, a3g, o2);
            PG8_WAIT_V(8); PG8_WAIT_L(0); PG8_BAR; if (!hf) { PG8_MMA(1, 0, At, B0); PG8_MMA(1, 1, At, B1); } PG8_BAR; PG8_SCHED;
            } else {
            PG8_LDB(B0, 0, 0); PG8_SCHED; PG8_LDA(At, 0, 0); PG8_STAGE(PG8_SA(1, 1), a1 + hstep, voffA);
            PG8_WAIT_L(8); PG8_BAR; PG8_WAIT_L(0); PG8_MMA(0, 0, At, B0); PG8_BAR; PG8_SCHED;
            PG8_LDB(B1, 0, 1); PG8_STAGE(PG8_SB(0, 0), b2, voffB);
            PG8_BAR; PG8_WAIT_L(0); PG8_MMA(0, 1, At, B1); PG8_BAR;
            PG8_LDA(At, 0, 1); PG8_STAGE(PG8_SA(0, 0), a2, voffA);
            PG8_BAR; PG8_WAIT_L(0); PG8_MMA(1, 0, At, B0); PG8_BAR; PG8_SCHED;
            PG8_STAGE(PG8_SB(0, 1), b2 + hstep, voffB);
            PG8_WAIT_V(6); PG8_BAR; PG8_MMA(1, 1, At, B1); PG8_BAR;
            PG8_LDB(B0, 1, 0); PG8_SCHED; PG8_LDA(At, 1, 0); PG8_STAGE(PG8_SA(0, 1), a2 + hstep, voffA);
            PG8_WAIT_L(8); PG8_BAR; PG8_WAIT_L(0); PG8_MMA(0, 0, At, B0); PG8_BAR; PG8_SCHED;
            PG8_LDB(B1, 1, 1); PG8_STAGE(PG8_SB(1, 0), b3, voffB);
            PG8_BAR; PG8_WAIT_L(0); PG8_MMA(0, 1, At, B1); PG8_BAR;
            PG8_LDA(At, 1, 1); PG8_STAGE(PG8_SA(1, 0), a3, voffA);
            PG8_BAR; PG8_WAIT_L(0); PG8_MMA(1, 0, At, B0); PG8_BAR; PG8_SCHED;
            PG8_STAGE(PG8_SB(1, 1), b3 + hstep, voffB);
            PG8_WAIT_V(6); PG8_BAR; PG8_MMA(1, 1, At, B1); PG8_BAR;
            }
        }
        if constexpr (ALIGN_EPI) { if (wr == 0) PG8_BAR; }
        if constexpr (!Epi::AFTER_DRAIN) { E(acc, cur, wr, wc, fr, fq); S.done(cur); }
        if (!has_next) break;
#pragma unroll
        for (int a = 0; a < 2; ++a)
#pragma unroll
            for (int b = 0; b < 2; ++b)
#pragma unroll
                for (int m = 0; m < 4; ++m)
#pragma unroll
                    for (int n = 0; n < 2; ++n) acc[a][b][m][n] = (f32x4){0.f, 0.f, 0.f, 0.f};
        cur = nxt; cA = nA; cB = nB; ++ui; hf = cur.half != 0;
        if constexpr (GATHER) {
#pragma unroll
            for (int h = 0; h < 2; ++h)
#pragma unroll
                for (int i = 0; i < 2; ++i) oc[h][i] = rn[h][i] * (unsigned)(K * 2) + cbA[i]; }
        if constexpr (ALIGN_EPI) { if (wr == 1) PG8_BAR; }
    }
    PG8_WAIT_V(0);
    if constexpr (!ALIGN_EPI) { if (wr == 0) PG8_BAR; }
    PG8_BAR;
    if constexpr (Epi::AFTER_DRAIN) { E.fused(acc, cur, wr, wc, fr, fq, lds, wid, lane); S.done(cur); }
#undef PG8_SA
#undef PG8_SB
#undef PG8_STAGE
#undef PG8_STA
#undef PG8_LDA
#undef PG8_LDB
#undef PG8_MMA
#undef PG8_WAIT_V
#undef PG8_WAIT_L
#undef PG8_BAR
#undef PG8_SCHED
}
}
#define XB_TMO      128
#define XB_XCNT(j)  (256  + 64 * (j))
#define XB_XSUB(j)  (1280 + 64 * (j))
#define XB_XGEN(j)  (2304 + 64 * (j))
#define XB_TOP      3328
#define XB_TOPGEN   3392
#define XCD_BAR_WORDS 3456
#define XB_SPIN_CAP (1u << 22)

__device__ __forceinline__ unsigned xb_ld(unsigned* p)              { return __hip_atomic_load(p, __ATOMIC_RELAXED, __HIP_MEMORY_SCOPE_AGENT); }
__device__ __forceinline__ unsigned xb_add(unsigned* p, unsigned v) { return __hip_atomic_fetch_add(p, v, __ATOMIC_RELAXED, __HIP_MEMORY_SCOPE_AGENT); }
__device__ __forceinline__ unsigned xb_xcc_id() { return (unsigned)__builtin_amdgcn_s_getreg((3 << 11) | 20) & 0xFu; }
#define XB_SPIN(cond, bar) do { unsigned _sp = 0; while (cond) { __builtin_amdgcn_s_sleep(1); \
    if ((++_sp & 255u) == 0u) { if (xb_ld(&(bar)[XB_TMO])) break; if (_sp > XB_SPIN_CAP) { atomicAdd(&(bar)[XB_TMO], 1u); break; } } } } while (0)

struct XcdBarrier {
    unsigned* bar; unsigned x;
    volatile LAS unsigned* st;
};

__device__ __forceinline__ XcdBarrier xcd_barrier_post(unsigned* bar, volatile LAS unsigned* st) {
    XcdBarrier b; b.bar = bar; b.x = xb_xcc_id(); b.st = st;
    if (threadIdx.x == 0) (void)xb_add(&bar[XB_XCNT(b.x)], 1u);
    return b;
}
__device__ __forceinline__ void xcd_barrier_complete(unsigned* bar, unsigned x, unsigned& nloc, unsigned& nx) {
    const unsigned G = gridDim.x * gridDim.y * gridDim.z;
    unsigned sum, cnt, mine, sp = 0u;
    for (;;) {
        sum = 0u; cnt = 0u; mine = 0u;
#pragma unroll
        for (unsigned j = 0; j < 16; ++j) { const unsigned c = xb_ld(&bar[XB_XCNT(j)]); sum += c; cnt += (c > 0u) ? 1u : 0u; mine = (j == x) ? c : mine; }
        if (sum == G) break;
        __builtin_amdgcn_s_sleep(1);
        if ((++sp & 255u) == 0u) { if (xb_ld(&bar[XB_TMO])) break; if (sp > XB_SPIN_CAP) { atomicAdd(&bar[XB_TMO], 1u); break; } }
    }
    nloc = mine > 0u ? mine : 1u; nx = cnt > 0u ? cnt : 1u;
}

__device__ __forceinline__ void xcd_barrier(const XcdBarrier& b) {
    asm volatile("s_waitcnt vmcnt(0)" ::: "memory");
    __syncthreads();
    if (threadIdx.x == 0) {
        unsigned* bar = b.bar;
        __builtin_amdgcn_s_waitcnt(0);
        unsigned nloc = b.st[0], nx = b.st[1];
        if (nloc == 0u) { xcd_barrier_complete(bar, b.x, nloc, nx); b.st[0] = nloc; b.st[1] = nx; }
        const unsigned old = xb_add(&bar[XB_XSUB(b.x)], 1u);
        const unsigned gen = old / nloc;
        if (old + 1u == (gen + 1u) * nloc) {
            __builtin_amdgcn_fence(__ATOMIC_RELEASE, "agent");
            asm volatile("s_waitcnt vmcnt(0)" ::: "memory");
            const unsigned og = xb_add(&bar[XB_TOP], 1u);
            const unsigned tg = og / nx;
            if (og + 1u == (tg + 1u) * nx) xb_add(&bar[XB_TOPGEN], 1u);
            else XB_SPIN(xb_ld(&bar[XB_TOPGEN]) == tg, bar);
            __builtin_amdgcn_fence(__ATOMIC_ACQUIRE, "agent");
            xb_add(&bar[XB_XGEN(b.x)], 1u);
            asm volatile("s_waitcnt vmcnt(0)" ::: "memory");
        } else {
            XB_SPIN(xb_ld(&bar[XB_XGEN(b.x)]) == gen, bar);
            __builtin_amdgcn_fence(__ATOMIC_ACQUIRE, "agent");
            asm volatile("s_waitcnt vmcnt(0)" ::: "memory");
        }
    }
    __syncthreads();
}

enum { IN_X = 0, IN_C, IN_CTX, IN_CCTX, IN_ADAW, IN_ADAB, IN_N1G, IN_N2G, IN_FING, IN_S5LRE, IN_S5LIM, IN_S5LOG, IN_S5BRE, IN_S5BIM, IN_S5CRE, IN_S5CIM,
       IN_S5D, IN_S5WGLU, IN_S5BGLU, IN_AWKVQ, IN_AQG, IN_AKG, IN_AWO, IN_MLWIN, IN_MLBG, IN_MLNG, IN_MLWOUT, IN_RW, IN_RB, IN_MWG, IN_MWU, IN_MWD, N_INPUTS };

struct Frame {
    LAS unsigned char* lds;
    volatile LAS unsigned* MISC;
    unsigned* ctl;
    int tid, lane, wave, G, blk;
    const float* in[N_INPUTS];
    unsigned char* ws;
    float* out;
};

template <bool HV = false>
struct DenseSchedT {
    pg8::StaticOrder so; int pm0;
    __device__ __forceinline__ void init(int Mrows, int N, int G, int c, int pm0_) { so.init(Mrows, N, G, c); pm0 = pm0_; }
    __device__ __forceinline__ bool next(int i, pg8::Unit& u) const {
        const int G = so.G, rounds = (so.nwg + G - 1) / G, R = so.nwg - G * (rounds - 1);
        if (HV && i == rounds - 1 && 2 * R <= G && (G & 15) == 0) {
            const int c = so.c, idx = ((c >> 4) << 3) | (c & 7); if (idx >= R) return false;
            pg8::StaticOrder t = so; t.c = idx; if (!t.next(i, u)) return false; u.pm += pm0; u.half = 1 + ((c >> 3) & 1); return true; }
        if (!so.next(i, u)) return false; u.pm += pm0; return true; }
    __device__ __forceinline__ void a_ready(const pg8::Unit&) const {}
    __device__ __forceinline__ void done(const pg8::Unit&) const {}
};
typedef DenseSchedT<false> DenseSched;
typedef DenseSchedT<true> DenseSchedH;
struct MoeSched {
    const LAS int* tab; int G, c, npn;
    __device__ __forceinline__ bool next(int i, pg8::Unit& u) const {
        const int total = tab[16] * npn;
        int L;
        int hsel = 0;
        if ((G & 7) == 0) { const int x = c & 7, rank = c >> 3, per = G >> 3; const int q = total >> 3, rem = total & 7; const int start = x * q + (x < rem ? x : rem), cnt = q + (x < rem ? 1 : 0);
            const int nfr = cnt / per, R = cnt - nfr * per;
            if (i < nfr) L = start + rank + per * i;
            else if (i > nfr || R == 0) return false;
            else if (2 * R <= per) { if (rank >= 2 * R) return false; L = start + nfr * per + (rank >> 1); hsel = 1 + (rank & 1); }
            else { if (rank >= R) return false; L = start + nfr * per + rank; } }
        else { L = i * G + c; if (L >= total) return false; }
        int e = 0;
#pragma unroll
        for (int k = 1; k < 16; ++k) e += (L >= tab[k] * npn) ? 1 : 0;
        const int ts = tab[e], te = tab[e + 1] - ts, idx = L - ts * npn;
        u.pm = __builtin_amdgcn_readfirstlane(ts + idx % te); u.pn = __builtin_amdgcn_readfirstlane(e * npn + idx / te); u.half = __builtin_amdgcn_readfirstlane(hsel);
        u.mb = __builtin_amdgcn_readfirstlane(e * T + (u.pm - ts) * 256); u.lim = __builtin_amdgcn_readfirstlane(tab[17 + e] - (u.pm - ts) * 256); return true;
    }
    __device__ __forceinline__ void a_ready(const pg8::Unit&) const {}
    __device__ __forceinline__ void done(const pg8::Unit&) const {}
};

template <class Epi, class Sched>
__device__ __forceinline__ void gemm_phase_naive(const pg8::Gemm g, const Sched& S, const Epi& E) {
    const int tid = threadIdx.x, wid = tid >> 6, lane = tid & 63, wr = wid >> 2, wc = wid & 3, fr = lane & 15, fq = lane >> 4;
    const int K = g.K; pg8::Unit u;
    for (int i = 0; S.next(i, u); ++i) {
        f32x4 acc[2][2][4][2];
#pragma unroll
        for (int ai = 0; ai < 2; ++ai)
#pragma unroll
            for (int m = 0; m < 4; ++m) {
                const int row = pg8::row0(u) + ai * 128 + wr * 64 + m * 16 + fr;
                const bf16* ap = g.A + (size_t)row * K;
                float s[2][2][4];
#pragma unroll
                for (int bj = 0; bj < 2; ++bj)
#pragma unroll
                    for (int n = 0; n < 2; ++n)
#pragma unroll
                        for (int e = 0; e < 4; ++e) s[bj][n][e] = 0.f;
                for (int k = 0; k < K; k += 8) {
                    const v4u av = *(const v4u*)(ap + k);
                    const float a0 = bflo(av.x), a1 = bfhi(av.x), a2 = bflo(av.y), a3 = bfhi(av.y), a4 = bflo(av.z), a5 = bfhi(av.z), a6 = bflo(av.w), a7 = bfhi(av.w);
#pragma unroll
                    for (int bj = 0; bj < 2; ++bj)
#pragma unroll
                        for (int n = 0; n < 2; ++n)
#pragma unroll
                            for (int e = 0; e < 4; ++e) {
                                const int col = u.pn * 256 + bj * 128 + wc * 32 + n * 16 + fq * 4 + e;
                                const v4u bv = *(const v4u*)(g.Bt + (size_t)col * K + k);
                                float t = s[bj][n][e];
                                t += a0 * bflo(bv.x); t += a1 * bfhi(bv.x); t += a2 * bflo(bv.y); t += a3 * bfhi(bv.y);
                                t += a4 * bflo(bv.z); t += a5 * bfhi(bv.z); t += a6 * bflo(bv.w); t += a7 * bfhi(bv.w);
                                s[bj][n][e] = t;
                            }
                }
#pragma unroll
                for (int bj = 0; bj < 2; ++bj)
#pragma unroll
                    for (int n = 0; n < 2; ++n) acc[ai][bj][m][n] = (f32x4){s[bj][n][0], s[bj][n][1], s[bj][n][2], s[bj][n][3]};
            }
        E(acc, u, wr, wc, fr, fq);
    }
}
#ifndef USE_NAIVE_GEMM
#define USE_NAIVE_GEMM 0
#endif
template <class Epi, class Sched>
__device__ __forceinline__ void run_gemm(Frame& F, const pg8::Gemm g, const Sched& S, const Epi& E) {
#if USE_NAIVE_GEMM
    gemm_phase_naive<Epi, Sched>(g, S, E);
#else
    pg8::gemm_phase<Epi, Sched, true, true>(F.lds + RING_OFF, g, S, E);
#endif
}
template <class Epi, class Sched>
__device__ __forceinline__ void run_gemm_gather(Frame& F, const pg8::Gemm g, const Sched& S, const Epi& E) {
    pg8::gemm_phase<Epi, Sched, true, true, true>(F.lds + RING_OFF, g, S, E);
}

__device__ __forceinline__ void st_bf4(bf16* p, f32x4 v) { v2u w; w.x = pk2(v.x, v.y); w.y = pk2(v.z, v.w); *(v2u*)p = w; }

struct EpiRes {
    static constexpr bool PERM = true, AFTER_DRAIN = false;
    bf16* xres; const float* __restrict__ modg; int skip; bf16* dummy;
    __device__ __forceinline__ void operator()(const f32x4 (&acc)[2][2][4][2], const pg8::Unit& u, int wr, int wc, int fr, int fq) const {
        const int cbase = u.pn * 256 + wc * 32 + fq * 8;
#pragma unroll
        for (int am = 0; am < 4; ++am) { const int ai = am >> 1, m0 = (am & 1) * 2; if (ai == 1 && u.half) break;
            v4u x[4][2]; f32x4 g0[4][2], g1[4][2];
#pragma unroll
            for (int m = m0; m < m0 + 2; ++m) { const int r = pg8::row0(u) + ai * 128 + wr * 64 + m * 16 + fr; const float* gp = modg + mrow_of(r) * 6144; const bf16* xp = xres + (size_t)r * D;
#pragma unroll
                for (int bj = 0; bj < 2; ++bj) { const int c = cbase + bj * 128; g0[m][bj] = *(const f32x4*)(gp + c); g1[m][bj] = *(const f32x4*)(gp + c + 4); x[m][bj] = *(const v4u*)(xp + c); } }
            asm volatile("" ::: "memory");
#pragma unroll
            for (int m = m0; m < m0 + 2; ++m) { const int r = pg8::row0(u) + ai * 128 + wr * 64 + m * 16 + fr; bf16* xp = (skip ? dummy : xres) + (size_t)r * D;
#pragma unroll
                for (int bj = 0; bj < 2; ++bj) { const int c = cbase + bj * 128; const v4u xv = x[m][bj]; const f32x4 a = g0[m][bj] * acc[ai][bj][m][0], b = g1[m][bj] * acc[ai][bj][m][1];
                    v4u o; o.x = pk2(bflo(xv.x) + a.x, bfhi(xv.x) + a.y); o.y = pk2(bflo(xv.y) + a.z, bfhi(xv.y) + a.w); o.z = pk2(bflo(xv.z) + b.x, bfhi(xv.z) + b.y); o.w = pk2(bflo(xv.w) + b.z, bfhi(xv.w) + b.w);
                    *(v4u*)(xp + c) = o; } }
        }
    }
};
struct EpiGlu {
    static constexpr bool PERM = true, AFTER_DRAIN = false;
    bf16* xres; const float* __restrict__ modg; const float* __restrict__ bglu; int skip;
    __device__ __forceinline__ void operator()(const f32x4 (&acc)[2][2][4][2], const pg8::Unit& u, int wr, int wc, int fr, int fq) const {
        const int oc = u.pn * 128 + wc * 32 + fq * 8;
        const f32x4 ba0 = *(const f32x4*)(bglu + oc), ba1 = *(const f32x4*)(bglu + oc + 4), bg0 = *(const f32x4*)(bglu + 1024 + oc), bg1 = *(const f32x4*)(bglu + 1024 + oc + 4);
#pragma unroll
        for (int ai = 0; ai < 2; ++ai) { if (ai == 1 && u.half) break;
            v4u x[4]; f32x4 g0[4], g1[4];
#pragma unroll
            for (int m = 0; m < 4; ++m) { const int r = pg8::row0(u) + ai * 128 + wr * 64 + m * 16 + fr; const float* gp = modg + mrow_of(r) * 6144;
                g0[m] = *(const f32x4*)(gp + oc); g1[m] = *(const f32x4*)(gp + oc + 4); x[m] = *(const v4u*)(xres + (size_t)r * D + oc); }
            asm volatile("" ::: "memory");
#pragma unroll
            for (int m = 0; m < 4; ++m) { const int r = pg8::row0(u) + ai * 128 + wr * 64 + m * 16 + fr;
                const f32x4 a0 = acc[ai][0][m][0] + ba0, a1 = acc[ai][0][m][1] + ba1, q0 = acc[ai][1][m][0] + bg0, q1 = acc[ai][1][m][1] + bg1;
                f32x4 v0, v1; v0.x = a0.x * sigmoidf_(q0.x); v0.y = a0.y * sigmoidf_(q0.y); v0.z = a0.z * sigmoidf_(q0.z); v0.w = a0.w * sigmoidf_(q0.w);
                v1.x = a1.x * sigmoidf_(q1.x); v1.y = a1.y * sigmoidf_(q1.y); v1.z = a1.z * sigmoidf_(q1.z); v1.w = a1.w * sigmoidf_(q1.w);
                v0 = v0 * g0[m]; v1 = v1 * g1[m]; const v4u xv = x[m];
                v4u o; o.x = pk2(bflo(xv.x) + v0.x, bfhi(xv.x) + v0.y); o.y = pk2(bflo(xv.y) + v0.z, bfhi(xv.y) + v0.w); o.z = pk2(bflo(xv.z) + v1.x, bfhi(xv.z) + v1.y); o.w = pk2(bflo(xv.w) + v1.z, bfhi(xv.w) + v1.w);
                if (!skip) *(v4u*)(xres + (size_t)r * D + oc) = o; }
        }
    }
};
__device__ __forceinline__ int kvrow_of(int r) { if (r < TC) return (r >> 8) * KVLEN + SEQ + (r & 255); const int rr = r - TC; return (rr >> 11) * KVLEN + (rr & 2047); }
struct EpiKvq {
    static constexpr bool PERM = false, AFTER_DRAIN = false;
    bf16* qb; bf16* kb; bf16* vb; const float* __restrict__ qg; const float* __restrict__ kg; const float* __restrict__ rope;
    __device__ __forceinline__ void operator()(const f32x4 (&acc)[2][2][4][2], const pg8::Unit& u, int wr, int wc, int fr, int fq) const {
        const int pn = u.pn;
        const float* gptr = (pn == 0) ? kg : qg;
        f32x4 gn[2][2];
#pragma unroll
        for (int bj = 0; bj < 2; ++bj)
#pragma unroll
            for (int n = 0; n < 2; ++n) gn[bj][n] = *(const f32x4*)(gptr + 32 * bj + 16 * n + 4 * fq);
#pragma unroll
        for (int ai = 0; ai < 2; ++ai)
#pragma unroll
            for (int m = 0; m < 4; ++m) { if (ai == 1 && u.half) break;
                const int r = pg8::row0(u) + ai * 128 + wr * 64 + m * 16 + fr;
                f32x4 x[2][2];
#pragma unroll
                for (int bj = 0; bj < 2; ++bj)
#pragma unroll
                    for (int n = 0; n < 2; ++n) x[bj][n] = acc[ai][bj][m][n];
                if (pn != 1) {
                    float ss = 0.f;
#pragma unroll
                    for (int bj = 0; bj < 2; ++bj)
#pragma unroll
                        for (int n = 0; n < 2; ++n) { const f32x4 v = x[bj][n]; ss += v.x * v.x + v.y * v.y + v.z * v.z + v.w * v.w; }
                    ss = xor16_sum(ss); ss = xor32_sum(ss);
                    const float rs = rsqrtf(ss * (1.f / 64.f) + EPS);
#pragma unroll
                    for (int bj = 0; bj < 2; ++bj)
#pragma unroll
                        for (int n = 0; n < 2; ++n) x[bj][n] = x[bj][n] * rs * gn[bj][n];
                    if (r >= TC) {
                        const int t = (r - TC) & 2047;
#pragma unroll
                        for (int bj = 0; bj < 2; ++bj) {
                            const int pos = bj == 0 ? (t >> 6) : (t & 63);
                            const f32x4 cs = *(const f32x4*)(rope + pos * 16 + 4 * fq), sn = *(const f32x4*)(rope + 1024 + pos * 16 + 4 * fq);
                            const f32x4 x1 = x[bj][0], x2 = x[bj][1];
                            x[bj][0] = x1 * cs - x2 * sn; x[bj][1] = x2 * cs + x1 * sn;
                        }
                    }
                }
                bf16* dst;
                if (pn == 0) dst = kb + (size_t)kvrow_of(r) * 256 + wc * 64;
                else if (pn == 1) dst = vb + (size_t)kvrow_of(r) * 256 + wc * 64;
                else { dst = qb + (size_t)r * D + ((pn - 2) * 4 + wc) * 64;
#pragma unroll
                    for (int bj = 0; bj < 2; ++bj)
#pragma unroll
                        for (int n = 0; n < 2; ++n) x[bj][n] = x[bj][n] * ATT_C2; }
#pragma unroll
                for (int bj = 0; bj < 2; ++bj)
#pragma unroll
                    for (int n = 0; n < 2; ++n) st_bf4(dst + 32 * bj + 16 * n + 4 * fq, x[bj][n]);
            }
    }
};
struct EpiMlIn {
    static constexpr bool PERM = true, AFTER_DRAIN = false;
    bf16 *k, *v, *q, *o; float* g; const float* bgate;
    __device__ __forceinline__ void operator()(const f32x4 (&acc)[2][2][4][2], const pg8::Unit& u, int wr, int wc, int fr, int fq) const {
        const int pn = u.pn;
#pragma unroll
        for (int ai = 0; ai < 2; ++ai)
#pragma unroll
            for (int m = 0; m < 4; ++m) { if (ai == 1 && u.half) break;
                const int r = pg8::row0(u) + ai * 128 + wr * 64 + m * 16 + fr;
#pragma unroll
                for (int bj = 0; bj < 2; ++bj) {
                    const int cc = bj * 128 + wc * 32 + fq * 8;
                    f32x4 a = acc[ai][bj][m][0], b = acc[ai][bj][m][1];
                    if (pn == 12) { if (cc < 32) { *(f32x4*)(g + (size_t)r * 32 + cc) = a + *(const f32x4*)(bgate + cc); *(f32x4*)(g + (size_t)r * 32 + cc + 4) = b + *(const f32x4*)(bgate + cc + 4); } continue; }
                    if (pn < 2) { a = a * 0.125f; b = b * 0.125f; }
                    v4u ov; ov.x = pk2(a.x, a.y); ov.y = pk2(a.z, a.w); ov.z = pk2(b.x, b.y); ov.w = pk2(b.z, b.w);
                    bf16* dst = (pn < 2) ? k + (size_t)r * 512 + pn * 256 + cc : (pn < 6) ? v + (size_t)r * 1024 + (pn - 2) * 256 + cc : (pn < 8) ? q + (size_t)r * 512 + (pn - 6) * 256 + cc : o + (size_t)r * 1024 + (pn - 8) * 256 + cc;
                    *(v4u*)dst = ov;
                }
            }
    }
};
struct EpiG1 {
    static constexpr bool PERM = false, AFTER_DRAIN = false;
    bf16* hid;
    __device__ __forceinline__ void operator()(const f32x4 (&acc)[2][2][4][2], const pg8::Unit& u, int wr, int wc, int fr, int fq) const {
        const int pnl = u.pn & 3;
#pragma unroll
        for (int ai = 0; ai < 2; ++ai)
#pragma unroll
            for (int m = 0; m < 4; ++m) { if (ai == 1 && u.half) break;
                const int r = pg8::row0(u) + ai * 128 + wr * 64 + m * 16 + fr;
#pragma unroll
                for (int bj = 0; bj < 2; ++bj) {
                    const int hc = pnl * 128 + bj * 64 + wc * 16 + fq * 4;
                    const f32x4 ga = acc[ai][bj][m][0], up = acc[ai][bj][m][1];
                    f32x4 h; h.x = siluf_(ga.x) * up.x; h.y = siluf_(ga.y) * up.y; h.z = siluf_(ga.z) * up.z; h.w = siluf_(ga.w) * up.w;
                    st_bf4(hid + (size_t)r * DFF + hc, h);
                }
            }
    }
};
struct EpiG2 {
    static constexpr bool PERM = true, AFTER_DRAIN = false;
    bf16* y2; const float* __restrict__ slotw;
    __device__ __forceinline__ void operator()(const f32x4 (&acc)[2][2][4][2], const pg8::Unit& u, int wr, int wc, int fr, int fq) const {
        const int pnl = u.pn & 3;
#pragma unroll
        for (int ai = 0; ai < 2; ++ai)
#pragma unroll
            for (int m = 0; m < 4; ++m) { if (ai == 1 && u.half) break;
                const int r = pg8::row0(u) + ai * 128 + wr * 64 + m * 16 + fr;
                const float w = slotw[u.mb + (r - u.pm * 256)];
#pragma unroll
                for (int bj = 0; bj < 2; ++bj) {
                    const int c = pnl * 256 + bj * 128 + wc * 32 + fq * 8;
                    const f32x4 a = acc[ai][bj][m][0] * w, b = acc[ai][bj][m][1] * w;
                    v4u o; o.x = pk2(a.x, a.y); o.y = pk2(a.z, a.w); o.z = pk2(b.x, b.y); o.w = pk2(b.z, b.w);
                    *(v4u*)(y2 + (size_t)r * D + c) = o;
                }
            }
    }
};

struct CmNat { const float* W; int ld; __device__ __forceinline__ const float* col(int j) const { return W + j; } };
struct CmGlu { const float* W; int ld;
    __device__ __forceinline__ const float* col(int j) const { const int pn = j >> 8, gpart = (j >> 7) & 1, c = j & 127; return W + gpart * 1024 + 128 * pn + c; } };
struct CmKvq { const float* W; int ld;
    __device__ __forceinline__ const float* col(int j) const { const int pn = j >> 8, bj = (j >> 7) & 1, wc = (j >> 5) & 3, n = (j >> 4) & 1, q = j & 15; return W + 256 * pn + 64 * wc + 32 * bj + 16 * n + q; } };
struct CmMlIn { const float* W; int ld;
    __device__ __forceinline__ const float* col(int j) const {
        if (j < 1536) return W + j;
        if (j < 2048) return W + 1568 + (j - 1536);
        if (j < 3072) return W + 2080 + (j - 2048);
        if (j < 3104) return W + 1536 + (j - 3072);
        return nullptr; } };
struct CmG1 { const float* Wg; const float* Wu; int ld;
    __device__ __forceinline__ const float* col(int j) const { const int le = j >> 10, jj = j & 1023; const int pn = jj >> 8, bj = (jj >> 7) & 1, wc = (jj >> 5) & 3, n = (jj >> 4) & 1, q = jj & 15;
        const uintptr_t a = (uintptr_t)Wg, b = (uintptr_t)Wu, msk = (uintptr_t)0 - (uintptr_t)n;
        return (const float*)((a & ~msk) | (b & msk)) + (size_t)le * 1024 * 512 + 128 * pn + 64 * bj + 16 * wc + q; } };
struct CmG2 { const float* Wd; int ld;
    __device__ __forceinline__ const float* col(int j) const { const int le = j >> 10, jj = j & 1023; return Wd + (size_t)le * 512 * 1024 + jj; } };

template <class CM>
__device__ __forceinline__ void transpose_load(const CM& cm, int kb, int nb, f32x4 (&v)[8], int lane) {
    const int k0 = 64 * kb, n0 = 32 * nb;
    const int nq = (lane & 7) * 4;
    const float* cp = cm.col(n0 + nq);
    const size_t ld = (size_t)cm.ld;
#pragma unroll
    for (int i = 0; i < 8; ++i) { const int kk = 8 * i + (lane >> 3); v[i] = cp ? *(const f32x4*)(cp + (size_t)(k0 + kk) * ld) : (f32x4){0.f, 0.f, 0.f, 0.f}; }
}
__device__ __forceinline__ void transpose_store(int K, bf16* WT, int kb, int nb, const f32x4 (&v)[8], LAS float* scr, int lane) {
    const int k0 = 64 * kb, n0 = 32 * nb, nq = (lane & 7) * 4;
#pragma unroll
    for (int i = 0; i < 8; ++i) { const int kk = 8 * i + (lane >> 3); LAS float* d = scr + kk * 33 + nq; d[0] = v[i].x; d[1] = v[i].y; d[2] = v[i].z; d[3] = v[i].w; }
    LDS_WAIT(); asm volatile("" ::: "memory");
    const int c = lane & 7;
#pragma unroll
    for (int j = 0; j < 4; ++j) { const int n = (lane >> 3) + 8 * j; const LAS float* s = scr + (8 * c) * 33 + n;
        v4u o; o.x = pk2(s[0 * 33], s[1 * 33]); o.y = pk2(s[2 * 33], s[3 * 33]); o.z = pk2(s[4 * 33], s[5 * 33]); o.w = pk2(s[6 * 33], s[7 * 33]);
        *(v4u*)(WT + (size_t)(n0 + n) * K + k0 + 8 * c) = o; }
    LDS_WAIT(); asm volatile("" ::: "memory");
}
template <class CM>
__device__ __forceinline__ void transpose_all(Frame& F, const CM& cm, int K, int Ndest, bf16* WT, int rot) {
    LAS float* scr = (LAS float*)(F.lds + RING_OFF + F.wave * 16384);
    const int NGW = F.G * NWAVES, gw = (F.blk * NWAVES + F.wave + rot) % NGW;
    const int nblk = Ndest / 32, items = (K / 64) * nblk;
    for (int it = gw; it < items; it += 2 * NGW) {
        const int it2 = it + NGW; const bool two = it2 < items;
        f32x4 va[8], vb[8];
        transpose_load(cm, it / nblk, it % nblk, va, F.lane);
        if (two) transpose_load(cm, it2 / nblk, it2 % nblk, vb, F.lane);
        transpose_store(K, WT, it / nblk, it % nblk, va, scr, F.lane);
        if (two) transpose_store(K, WT, it2 / nblk, it2 % nblk, vb, scr, F.lane);
    }
}

__device__ __forceinline__ void phase_prologue(Frame& F) {
    {
        LAS float* cond = (LAS float*)(F.lds);
        LAS float* red = (LAS float*)(F.lds + 40960);
        for (int i = F.tid; i < 9 * 1024; i += NTHR) { const int mb = i >> 10, k = i & 1023; const float v = (mb < 8) ? F.in[IN_C][mb * 1024 + k] : F.in[IN_CCTX][k]; cond[i] = siluf_(v); }
        __syncthreads();
        float* mod = (float*)(F.ws + WS_MOD);
        const int kp = (F.lane >= 24) ? 1 : 0, cl = F.lane - 24 * kp; const bool act = F.lane < 48;
        for (int it = F.blk; it < DEPTH * 64; it += F.G) {
            const int l = it >> 6, n0 = (it & 63) * 96;
            const float* w = F.in[IN_ADAW] + (size_t)l * 1024 * 6144 + n0 + 4 * (act ? cl : 0);
            f32x4 a[9];
#pragma unroll
            for (int mb = 0; mb < 9; ++mb) a[mb] = (f32x4){0.f, 0.f, 0.f, 0.f};
            const int kb = F.wave * 128 + kp;
            for (int k16 = 0; k16 < 128; k16 += 16) {
                f32x4 wv[8];
#pragma unroll
                for (int u = 0; u < 8; ++u) wv[u] = *(const f32x4*)(w + (size_t)(kb + k16 + 2 * u) * 6144);
#pragma unroll
                for (int u = 0; u < 8; ++u)
#pragma unroll
                    for (int mb = 0; mb < 9; ++mb) a[mb] += wv[u] * cond[mb * 1024 + kb + k16 + 2 * u];
            }
            if (act) {
#pragma unroll
                for (int mb = 0; mb < 9; ++mb) *(LAS f32x4*)(red + ((F.wave * 2 + kp) * 9 + mb) * 96 + 4 * cl) = a[mb]; }
            __syncthreads();
            for (int i = F.tid; i < 9 * 96; i += NTHR) { const int mb = i / 96, ln = i - 96 * mb; float s = F.in[IN_ADAB][l * 6144 + n0 + ln];
#pragma unroll
                for (int pq = 0; pq < 16; ++pq) s += red[(pq * 9 + mb) * 96 + ln];
                mod[(size_t)(l * 9 + mb) * 6144 + n0 + ln] = s; }
            __syncthreads();
        }
    }
    { const int idx = F.blk * NTHR + F.tid;
      if (idx < 1024) { const int pos = idx >> 4, f = idx & 15; const float inv = exp2f(-(float)f * (13.287712379549449f / 16.f)); const float ang = (float)pos * inv;
          double s, c; sincos_d((double)ang, s, c); float* rope = (float*)(F.ws + WS_ROPE); rope[idx] = (float)c; rope[1024 + idx] = (float)s; } }
    __syncthreads();
    { CmGlu cm{F.in[IN_S5WGLU], 2048}; transpose_all(F, cm, 1024, 2048, (bf16*)(F.ws + WS_WGLU), 0); }
    { CmGlu cm{F.in[IN_S5WGLU] + (size_t)1024 * 2048, 2048}; transpose_all(F, cm, 1024, 2048, (bf16*)(F.ws + WS_WGLU) + (size_t)2048 * 1024, 1024); }
    { CmKvq cm{F.in[IN_AWKVQ], 1536}; transpose_all(F, cm, 1024, 1536, (bf16*)(F.ws + WS_WKVQ), 0); }
    { CmNat cm{F.in[IN_AWO], 1024}; transpose_all(F, cm, 1024, 1024, (bf16*)(F.ws + WS_WO), 768); }
    { CmMlIn cm{F.in[IN_MLWIN], 3104}; transpose_all(F, cm, 1024, ML_NIN, (bf16*)(F.ws + WS_WIN), 1280); }
    { CmNat cm{F.in[IN_MLWOUT], 1024}; transpose_all(F, cm, 1024, 1024, (bf16*)(F.ws + WS_WOUT), 896); }
    { CmG1 cm{F.in[IN_MWG], F.in[IN_MWU], 512}; transpose_all(F, cm, 1024, DEPTH * NEXP * 1024, (bf16*)(F.ws + WS_WG1), 1408); }
    { CmG2 cm{F.in[IN_MWD], 1024}; transpose_all(F, cm, 512, DEPTH * NEXP * 1024, (bf16*)(F.ws + WS_WG2), 1408); }
}

struct RowMod { f32x4 a[4], b[4], c[4]; int mr; };
__device__ __forceinline__ void rowmod_load(RowMod& M, const float* base, int mr, int oa, int ob, int oc, int lane) {
    if (mr == M.mr) return; M.mr = mr; const float* p = base + (size_t)mr * 6144;
#pragma unroll
    for (int j = 0; j < 4; ++j) { M.a[j] = *(const f32x4*)(p + oa + 4 * lane + 256 * j); M.b[j] = *(const f32x4*)(p + ob + 4 * lane + 256 * j); if (oc >= 0) M.c[j] = *(const f32x4*)(p + oc + 4 * lane + 256 * j); }
}
struct RawRow { f32x4 x[4]; v2u ya[4], yb[4]; };
template <bool COMB, bool XBF>
__device__ __forceinline__ void raw_load(RawRow& R, const void* xrow, const bf16* y2, int s0, int s1, int lane) {
#pragma unroll
    for (int j = 0; j < 4; ++j) {
        if (XBF) { const v2u w = *(const v2u*)((const bf16*)xrow + 4 * lane + 256 * j); R.x[j] = (f32x4){bflo(w.x), bfhi(w.x), bflo(w.y), bfhi(w.y)}; }
        else R.x[j] = *(const f32x4*)((const float*)xrow + 4 * lane + 256 * j);
        if (COMB) { R.ya[j] = *(const v2u*)(y2 + (size_t)s0 * D + 4 * lane + 256 * j); R.yb[j] = *(const v2u*)(y2 + (size_t)s1 * D + 4 * lane + 256 * j); } }
}
__device__ __forceinline__ void load_etab(Frame& F, int L) {
    LAS int* tab = (LAS int*)(F.lds + ETAB_OFF);
    if (F.tid < 16) tab[17 + F.tid] = (int)F.ctl[CTL_GCNT + L * 64 + F.tid];
    __syncthreads();
    if (F.tid == 0) { int ts = 0; for (int e = 0; e < 16; ++e) { tab[e] = ts; ts += (tab[17 + e] + 255) >> 8; } tab[16] = ts; }
    __syncthreads();
}
template <int L>
__device__ __forceinline__ void phase_a1(Frame& F, const int skip = 0) {
    const float* mod = (const float*)(F.ws + WS_MOD);
    bf16* xres = (bf16*)(F.ws + WS_XRES); bf16* hb = (bf16*)(F.ws + WS_H);
    const bf16* y2 = (const bf16*)(F.ws + WS_Y2); const int* toke = (const int*)(F.ws + WS_TOKE); const int* tokr = (const int*)(F.ws + WS_TOKR);
    if (L > 0) load_etab(F, L > 0 ? L - 1 : 0);
    const LAS int* etab = (const LAS int*)(F.lds + ETAB_OFF);
    auto toks = [&](int idx) { return etab[toke[idx]] * 256 + tokr[idx]; };
    const int gw = F.blk * NWAVES + F.wave, NGW = F.G * NWAVES, lane = F.lane;
    const int RPW = (T + NGW - 1) / NGW, r0 = gw * RPW, r1 = (r0 + RPW < T) ? r0 + RPW : T;
    if (r0 >= T) return;
    f32x4 gv[4];
#pragma unroll
    for (int j = 0; j < 4; ++j) gv[j] = *(const f32x4*)(F.in[IN_N1G] + L * D + 4 * lane + 256 * j);
    auto rowptr = [&](int r) -> const void* { if (L == 0) return (r < TC) ? (const void*)(F.in[IN_CTX] + (size_t)r * D) : (const void*)(F.in[IN_X] + (size_t)(r - TC) * D); return (const void*)(xres + (size_t)r * D); };
    RowMod M1, M2; M1.mr = -1; M2.mr = -1;
    int ns0 = 0, ns1 = 0;
    if (L > 0) { ns0 = toks(2 * r0); ns1 = toks(2 * r0 + 1); }
    RawRow nx; raw_load<(L > 0), (L > 0)>(nx, rowptr(r0), y2, ns0, ns1, lane);
    if (L > 0 && r0 + 1 < r1) { ns0 = toks(2 * r0 + 2); ns1 = toks(2 * r0 + 3); }
    for (int r = r0; r < r1; ++r) {
        const int mr = mrow_of(r);
        RawRow cur = nx;
        if (r + 1 < r1) { raw_load<(L > 0), (L > 0)>(nx, rowptr(r + 1), y2, ns0, ns1, lane); if (L > 0 && r + 2 < r1) { ns0 = toks(2 * r + 4); ns1 = toks(2 * r + 5); } }
        rowmod_load(M1, mod + (size_t)L * 9 * 6144, mr, 0, 1024, -1, lane);
        if (L > 0) rowmod_load(M2, mod + (size_t)(L - 1) * 9 * 6144, mr, 5120, 5120, -1, lane);
        float ss = 0.f;
#pragma unroll
        for (int j = 0; j < 4; ++j) {
            f32x4 v = cur.x[j];
            if (L > 0) { const v2u a = cur.ya[j], b = cur.yb[j]; const f32x4 gg = M2.a[j];
                v.x += gg.x * (bflo(a.x) + bflo(b.x)); v.y += gg.y * (bfhi(a.x) + bfhi(b.x)); v.z += gg.z * (bflo(a.y) + bflo(b.y)); v.w += gg.w * (bfhi(a.y) + bfhi(b.y)); }
            cur.x[j] = v;
            if (!skip) st_bf4(xres + (size_t)r * D + 4 * lane + 256 * j, v); ss += v.x * v.x + v.y * v.y + v.z * v.z + v.w * v.w;
        }
        const float rs = rsqrtf(wave_sum(ss) * (1.f / D) + EPS);
#pragma unroll
        for (int j = 0; j < 4; ++j) { const f32x4 h = cur.x[j] * rs * gv[j] * (M1.b[j] + 1.f) + M1.a[j]; st_bf4(hb + (size_t)r * D + 4 * lane + 256 * j, h); }
    }
}
__device__ __forceinline__ float quad_get(float v, int k) {
    return k == 1 ? dpp_f<0x39>(v, v) : k == 2 ? dpp_f<0x4E>(v, v) : dpp_f<0x93>(v, v); }
template <int L>
__device__ __forceinline__ void phase_n2(Frame& F, const int var = 0) {
    constexpr int R0 = (L == DEPTH - 1) ? TC : 0;
    const float* mod = (const float*)(F.ws + WS_MOD);
    const bf16* xres = (const bf16*)(F.ws + WS_XRES); bf16* hb = (bf16*)(F.ws + WS_H);
    int* toke = (int*)(F.ws + WS_TOKE); int* tokr = (int*)(F.ws + WS_TOKR);
    LAS int* entE = (LAS int*)(F.lds + 90112); LAS int* entR = entE + 1024; LAS float* entW = (LAS float*)(entR + 1024); LAS int* baseL = entE + 3072;
    LAS v4u* rwf = (LAS v4u*)(F.lds);
    LAS float* PS = (LAS float*)(F.lds + 65536);
    LAS float* PL = (LAS float*)(F.lds + 65536 + 1024);
    LAS int* cntL = (LAS int*)(F.lds + SCT_OFF);
    for (int i = F.tid; i < 32 * 64; i += NTHR) { const int ks = i >> 6, ln = i & 63, e = ln & 15, k0 = 32 * ks + 8 * (ln >> 4);
        float w[8]; unsigned hi[4], lo[4];
#pragma unroll
        for (int jj = 0; jj < 8; ++jj) w[jj] = F.in[IN_RW][(k0 + jj) * 16 + e];
#pragma unroll
        for (int jj = 0; jj < 4; ++jj) { hi[jj] = pk2(w[2 * jj], w[2 * jj + 1]); lo[jj] = pk2(w[2 * jj] - bflo(hi[jj]), w[2 * jj + 1] - bfhi(hi[jj])); }
        rwf[2 * i] = (v4u){hi[0], hi[1], hi[2], hi[3]}; rwf[2 * i + 1] = (v4u){lo[0], lo[1], lo[2], lo[3]}; }
    if (F.tid < 16) cntL[F.tid] = 0;
    __syncthreads();
    const int lane = F.lane, rl = lane & 15, kg = lane >> 4, w = F.wave;
    const float rbias = F.in[IN_RB][rl];
    constexpr int NTILES = (T - R0) / 16;
    const int ntl = (NTILES - F.blk + F.G - 1) / F.G;
    const int c0 = 128 * w + 8 * kg;
    v4u xw4[4];
    if (ntl > 0) { const bf16* xr = xres + (size_t)(R0 + 16 * F.blk + rl) * D + c0;
#pragma unroll
        for (int q = 0; q < 4; ++q) xw4[q] = *(const v4u*)(xr + 32 * q); }
    for (int j = 0; j < ntl; ++j) {
        const int tile = F.blk + F.G * j, rbase = R0 + 16 * tile, mr = mrow_of(rbase), pb = j & 1;
        f32x4 ca[4], cb[4]; float ss = 0.f;
#pragma unroll
        for (int q = 0; q < 4; ++q) { const v4u t = xw4[q]; ca[q] = (f32x4){bflo(t.x), bfhi(t.x), bflo(t.y), bfhi(t.y)}; cb[q] = (f32x4){bflo(t.z), bfhi(t.z), bflo(t.w), bfhi(t.w)};
            ss += ca[q].x * ca[q].x + ca[q].y * ca[q].y + ca[q].z * ca[q].z + ca[q].w * ca[q].w + cb[q].x * cb[q].x + cb[q].y * cb[q].y + cb[q].z * cb[q].z + cb[q].w * cb[q].w; }
        ss = xor16_sum(ss); ss = xor32_sum(ss);
        if (kg == 0) PS[(pb * 8 + w) * 16 + rl] = ss;
        if (j + 1 < ntl) { const bf16* xr = xres + (size_t)(R0 + 16 * (tile + F.G) + rl) * D + c0;
#pragma unroll
            for (int q = 0; q < 4; ++q) xw4[q] = *(const v4u*)(xr + 32 * q); }
        __syncthreads();
        float tot = 0.f;
#pragma unroll
        for (int ww = 0; ww < 8; ++ww) tot += PS[(pb * 8 + ww) * 16 + rl];
        const float rs = rsqrtf(tot * (1.f / D) + EPS);
        const float* gp = F.in[IN_N2G] + L * D + c0; const float* shp = mod + (size_t)(L * 9 + mr) * 6144 + 3072 + c0; const float* scp = shp + 1024;
        bf16* hrow = hb + (size_t)(rbase + rl) * D + c0;
        f32x4 acc = (f32x4){0.f, 0.f, 0.f, 0.f};
#pragma unroll
        for (int q = 0; q < 4; ++q) {
            float h[8];
            { const f32x4 g0 = *(const f32x4*)(gp + 32 * q), g1 = *(const f32x4*)(gp + 32 * q + 4), cc0 = *(const f32x4*)(scp + 32 * q), cc1 = *(const f32x4*)(scp + 32 * q + 4), s0 = *(const f32x4*)(shp + 32 * q), s1 = *(const f32x4*)(shp + 32 * q + 4);
              const f32x4 h0 = ca[q] * rs * g0 * (cc0 + 1.f) + s0, h1 = cb[q] * rs * g1 * (cc1 + 1.f) + s1;
              h[0] = h0.x; h[1] = h0.y; h[2] = h0.z; h[3] = h0.w; h[4] = h1.x; h[5] = h1.y; h[6] = h1.z; h[7] = h1.w; }
            unsigned hi[4], lo[4];
#pragma unroll
            for (int jj = 0; jj < 4; ++jj) { hi[jj] = pk2(h[2 * jj], h[2 * jj + 1]); lo[jj] = pk2(h[2 * jj] - bflo(hi[jj]), h[2 * jj + 1] - bfhi(hi[jj])); }
            const v4u hv = (v4u){hi[0], hi[1], hi[2], hi[3]}, lv = (v4u){lo[0], lo[1], lo[2], lo[3]};
            *(v4u*)(hrow + 32 * q) = hv;
            const int ks = 4 * w + q;
            const v4u bh = rwf[2 * (ks * 64 + lane)], bl = rwf[2 * (ks * 64 + lane) + 1];
            acc = __builtin_amdgcn_mfma_f32_16x16x32_bf16(__builtin_bit_cast(bf16x8, hv), __builtin_bit_cast(bf16x8, bh), acc, 0, 0, 0);
            acc = __builtin_amdgcn_mfma_f32_16x16x32_bf16(__builtin_bit_cast(bf16x8, hv), __builtin_bit_cast(bf16x8, bl), acc, 0, 0, 0);
            acc = __builtin_amdgcn_mfma_f32_16x16x32_bf16(__builtin_bit_cast(bf16x8, lv), __builtin_bit_cast(bf16x8, bh), acc, 0, 0, 0);
        }
        *(LAS f32x4*)(PL + ((pb * 8 + w) * 64 + lane) * 4) = acc;
        __syncthreads();
        if (w != (j & 7) || (var & 1)) continue;
        f32x4 lg = (f32x4){0.f, 0.f, 0.f, 0.f};
#pragma unroll
        for (int ww = 0; ww < 8; ++ww) lg = lg + *(const LAS f32x4*)(PL + ((pb * 8 + ww) * 64 + lane) * 4);
#pragma unroll
        for (int r = 0; r < 4; ++r) {
            const float sco = sigmoidf_(lg[r]), sel = sco + rbias;
            int rank = 0;
#pragma unroll
            for (int k = 1; k < 4; ++k) { const float o = quad_get(sel, k); const int oi = (rl & ~3) | ((rl + k) & 3); rank += (o > sel || (o == sel && oi < rl)) ? 1 : 0; }
            const bool top2 = rank < 2;
            float gs = top2 ? sel : 0.f; gs += dpp_f<0xB1>(0.f, gs); gs += dpp_f<0x4E>(0.f, gs);
            bool best = true; const int q = rl >> 2;
            { const float o1 = dpp_f<0x124>(gs, gs), o2 = dpp_f<0x128>(gs, gs), o3 = dpp_f<0x12C>(gs, gs);
              const int q1 = (q + 3) & 3, q2 = (q + 2) & 3, q3 = (q + 1) & 3;
              best = !(o1 > gs || (o1 == gs && q1 < q)) && !(o2 > gs || (o2 == gs && q2 < q)) && !(o3 > gs || (o3 == gs && q3 < q)); }
            const bool selv = best && top2;
            const float wsum = red16_sum(selv ? sco : 0.f);
            if (selv) { const int row = rbase + 4 * kg + r;
                const int lr = __hip_atomic_fetch_add(cntL + rl, 1, __ATOMIC_RELAXED, __HIP_MEMORY_SCOPE_WORKGROUP);
                const int ei = j * 32 + (4 * kg + r) * 2 + rank; (void)row; entE[ei] = rl; entR[ei] = lr; entW[ei] = sco * __builtin_amdgcn_rcpf(wsum); }
        }
    }
    __syncthreads();
    if (var & 1) return;
    if (F.tid < 16) baseL[F.tid] = (int)__hip_atomic_fetch_add(F.ctl + CTL_GCNT + L * 64 + F.tid, (unsigned)cntL[F.tid], __ATOMIC_RELAXED, __HIP_MEMORY_SCOPE_AGENT);
    __syncthreads();
    int* slotre = (int*)(F.ws + WS_SLOTRE); float* slotwe = (float*)(F.ws + WS_SLOTWE);
    for (int i = F.tid; i < ntl * 32; i += NTHR) { const int j = i >> 5, row = R0 + 16 * (F.blk + F.G * j) + ((i & 31) >> 1), k = i & 1;
        const int e = entE[i], pos = baseL[e] + entR[i];
        toke[2 * row + k] = e; tokr[2 * row + k] = pos; slotre[e * T + pos] = row; slotwe[e * T + pos] = entW[i]; }
}
__device__ __forceinline__ void phase_fin(Frame& F) {
    const float* mod = (const float*)(F.ws + WS_MOD);
    const bf16* xres = (const bf16*)(F.ws + WS_XRES);
    const bf16* y2 = (const bf16*)(F.ws + WS_Y2); const int* toke = (const int*)(F.ws + WS_TOKE); const int* tokr = (const int*)(F.ws + WS_TOKR);
    load_etab(F, DEPTH - 1);
    const LAS int* etab = (const LAS int*)(F.lds + ETAB_OFF);
    auto toks = [&](int idx) { return etab[toke[idx]] * 256 + tokr[idx]; };
    const int gw = F.blk * NWAVES + F.wave, NGW = F.G * NWAVES, lane = F.lane;
    const int RPW = (TL + NGW - 1) / NGW, r0 = TC + gw * RPW, r1 = (r0 + RPW < T) ? r0 + RPW : T;
    if (r0 >= T) return;
    f32x4 gv[4];
#pragma unroll
    for (int j = 0; j < 4; ++j) gv[j] = *(const f32x4*)(F.in[IN_FING] + 4 * lane + 256 * j);
    RowMod M2; M2.mr = -1;
    int ns0 = toks(2 * r0), ns1 = toks(2 * r0 + 1);
    RawRow nx; raw_load<true, true>(nx, xres + (size_t)r0 * D, y2, ns0, ns1, lane);
    if (r0 + 1 < r1) { ns0 = toks(2 * r0 + 2); ns1 = toks(2 * r0 + 3); }
    for (int r = r0; r < r1; ++r) {
        const int mr = mrow_of(r);
        RawRow cur = nx;
        if (r + 1 < r1) { raw_load<true, true>(nx, xres + (size_t)(r + 1) * D, y2, ns0, ns1, lane); if (r + 2 < r1) { ns0 = toks(2 * r + 4); ns1 = toks(2 * r + 5); } }
        rowmod_load(M2, mod + (size_t)(DEPTH - 1) * 9 * 6144, mr, 5120, 5120, -1, lane);
        float ss = 0.f;
#pragma unroll
        for (int j = 0; j < 4; ++j) { f32x4 v = cur.x[j]; const v2u a = cur.ya[j], b = cur.yb[j]; const f32x4 gg = M2.a[j];
            v.x += gg.x * (bflo(a.x) + bflo(b.x)); v.y += gg.y * (bfhi(a.x) + bfhi(b.x)); v.z += gg.z * (bflo(a.y) + bflo(b.y)); v.w += gg.w * (bfhi(a.y) + bfhi(b.y));
            cur.x[j] = v; ss += v.x * v.x + v.y * v.y + v.z * v.z + v.w * v.w; }
        const float rs = rsqrtf(wave_sum(ss) * (1.f / D) + EPS);
#pragma unroll
        for (int j = 0; j < 4; ++j) *(f32x4*)(F.out + (size_t)(r - TC) * D + 4 * lane + 256 * j) = cur.x[j] * rs * gv[j];
    }
}

__device__ __forceinline__ int seq_row(int b, int dir, int s) {
    if (s < CTX) return b * CTX + (dir ? (CTX - 1 - s) : s);
    const int t = s - CTX; return TC + b * SEQ + (dir ? (SEQ - 1 - t) : t);
}
template <int J, bool WCTX>
__device__ __forceinline__ void phase_s5_naive(Frame& F) {
    const int gw = F.blk * NWAVES + F.wave, lane = F.lane;
    if ((gw & 3) != 0) return;
    const int it = gw >> 2; if (it >= NB * 64) return;
    const int b = it >> 6, g = it & 63, p = lane;
    const bf16* hb = (const bf16*)(F.ws + WS_H); float* ysum = (float*)(F.ws + WS_YSUM);
    for (int dir = 0; dir < 2; ++dir) {
        const int gi = (J * 2 + dir) * 64 + g, pidx = gi * 64 + p;
        const float lam_re = F.in[IN_S5LRE][pidx], lam_im = F.in[IN_S5LIM][pidx];
        const float dt = expf(F.in[IN_S5LOG][gi]);
        const float mag = expf(lam_re * dt);
        double sd, cd; sincos_d((double)(lam_im * dt), sd, cd);
        const float a_re = mag * (float)cd, a_im = mag * (float)sd;
        const float den = lam_re * lam_re + lam_im * lam_im, n_re = a_re - 1.f, n_im = a_im;
        const float f_re = (n_re * lam_re + n_im * lam_im) / den, f_im = (n_im * lam_re - n_re * lam_im) / den;
        float bbr[16], bbi[16], cre[16], cim[16];
#pragma unroll
        for (int c = 0; c < 16; ++c) { const float br = F.in[IN_S5BRE][(size_t)pidx * 16 + c], bi = F.in[IN_S5BIM][(size_t)pidx * 16 + c];
            bbr[c] = f_re * br - f_im * bi; bbi[c] = f_re * bi + f_im * br;
            cre[c] = F.in[IN_S5CRE][((size_t)gi * 16 + c) * 64 + p]; cim[c] = F.in[IN_S5CIM][((size_t)gi * 16 + c) * 64 + p]; }
        float x_re = 0.f, x_im = 0.f;
        for (int s = 0; s < CTX + SEQ; ++s) {
            const int r = seq_row(b, dir, s);
            const v4u u0 = *(const v4u*)(hb + (size_t)r * D + g * 16), u1 = *(const v4u*)(hb + (size_t)r * D + g * 16 + 8);
            float u[16];
            u[0] = bflo(u0.x); u[1] = bfhi(u0.x); u[2] = bflo(u0.y); u[3] = bfhi(u0.y); u[4] = bflo(u0.z); u[5] = bfhi(u0.z); u[6] = bflo(u0.w); u[7] = bfhi(u0.w);
            u[8] = bflo(u1.x); u[9] = bfhi(u1.x); u[10] = bflo(u1.y); u[11] = bfhi(u1.y); u[12] = bflo(u1.z); u[13] = bfhi(u1.z); u[14] = bflo(u1.w); u[15] = bfhi(u1.w);
            float bur = 0.f, bui = 0.f;
#pragma unroll
            for (int c = 0; c < 16; ++c) { bur += u[c] * bbr[c]; bui += u[c] * bbi[c]; }
            const float nr = a_re * x_re - a_im * x_im + bur, ni = a_re * x_im + a_im * x_re + bui;
            x_re = nr; x_im = ni;
            if (WCTX || s >= CTX) {
                float yv = 0.f;
#pragma unroll
                for (int c = 0; c < 16; ++c) { const float t = wave_sum(x_re * cre[c] - x_im * cim[c]); if (lane == c) yv = t; }
                if (lane < 16) { float* yp = ysum + (size_t)r * D + g * 16 + lane; if (dir == 0) *yp = yv; else *yp = *yp + yv; }
            }
        }
    }
}
template <int J, bool WCTX>
__device__ __forceinline__ void phase_s5_combine(Frame& F) {
    constexpr int R0 = WCTX ? 0 : TC;
    const bf16* hb = (const bf16*)(F.ws + WS_H); const float* ysum = (const float*)(F.ws + WS_YSUM); bf16* zb = (bf16*)(F.ws + WS_Z);
    const int gw = F.blk * NWAVES + F.wave, NGW = F.G * NWAVES, lane = F.lane;
    f32x4 dv[4];
#pragma unroll
    for (int j = 0; j < 4; ++j) dv[j] = *(const f32x4*)(F.in[IN_S5D] + J * D + 4 * lane + 256 * j);
    for (int r = R0 + gw; r < T; r += NGW) {
#pragma unroll
        for (int j = 0; j < 4; ++j) {
            const f32x4 y = *(const f32x4*)(ysum + (size_t)r * D + 4 * lane + 256 * j);
            const v2u hv = *(const v2u*)(hb + (size_t)r * D + 4 * lane + 256 * j);
            f32x4 z; z.x = gelu_tanh(y.x + dv[j].x * bflo(hv.x)); z.y = gelu_tanh(y.y + dv[j].y * bfhi(hv.x)); z.z = gelu_tanh(y.z + dv[j].z * bflo(hv.y)); z.w = gelu_tanh(y.w + dv[j].w * bfhi(hv.y));
            st_bf4(zb + (size_t)r * D + 4 * lane + 256 * j, z);
        }
    }
}
template <bool WCTX>
__device__ __forceinline__ void phase_attn_naive(Frame& F) {
    constexpr int R0 = WCTX ? 0 : TC;
    const bf16* qb = (const bf16*)(F.ws + WS_QB); const bf16* kb = (const bf16*)(F.ws + WS_KB); const bf16* vb = (const bf16*)(F.ws + WS_VB); bf16* zb = (bf16*)(F.ws + WS_Z);
    const int gw = F.blk * NWAVES + F.wave, NGW = F.G * NWAVES, lane = F.lane;
    for (int it = gw; it < (T - R0) * 16; it += NGW) {
        const int r = R0 + (it >> 4), h = it & 15, kvh = h >> 2;
        int kv0, nk;
        if (r < TC) { kv0 = (r >> 8) * KVLEN + SEQ; nk = CTX; } else { kv0 = ((r - TC) >> 11) * KVLEN; nk = KVLEN; }
        float q[64];
#pragma unroll
        for (int c = 0; c < 8; ++c) { const v4u w = *(const v4u*)(qb + (size_t)r * D + h * 64 + 8 * c);
            q[8 * c] = bflo(w.x); q[8 * c + 1] = bfhi(w.x); q[8 * c + 2] = bflo(w.y); q[8 * c + 3] = bfhi(w.y); q[8 * c + 4] = bflo(w.z); q[8 * c + 5] = bfhi(w.z); q[8 * c + 6] = bflo(w.w); q[8 * c + 7] = bfhi(w.w); }
        float m = -INFINITY, l = 0.f, o[64];
#pragma unroll
        for (int d = 0; d < 64; ++d) o[d] = 0.f;
        for (int kk = lane; kk < nk; kk += 64) {
            const bf16* kp = kb + (size_t)(kv0 + kk) * 256 + kvh * 64; const bf16* vp = vb + (size_t)(kv0 + kk) * 256 + kvh * 64;
            float s = 0.f;
#pragma unroll
            for (int c = 0; c < 8; ++c) { const v4u w = *(const v4u*)(kp + 8 * c);
                s += q[8 * c] * bflo(w.x) + q[8 * c + 1] * bfhi(w.x) + q[8 * c + 2] * bflo(w.y) + q[8 * c + 3] * bfhi(w.y) + q[8 * c + 4] * bflo(w.z) + q[8 * c + 5] * bfhi(w.z) + q[8 * c + 6] * bflo(w.w) + q[8 * c + 7] * bfhi(w.w); }
            const float mn = fmaxf(m, s), sc = exp2f(m - mn), pp = exp2f(s - mn);
            l = l * sc + pp; m = mn;
#pragma unroll
            for (int c = 0; c < 8; ++c) { const v4u w = *(const v4u*)(vp + 8 * c);
                o[8 * c] = o[8 * c] * sc + pp * bflo(w.x); o[8 * c + 1] = o[8 * c + 1] * sc + pp * bfhi(w.x); o[8 * c + 2] = o[8 * c + 2] * sc + pp * bflo(w.y); o[8 * c + 3] = o[8 * c + 3] * sc + pp * bfhi(w.y);
                o[8 * c + 4] = o[8 * c + 4] * sc + pp * bflo(w.z); o[8 * c + 5] = o[8 * c + 5] * sc + pp * bfhi(w.z); o[8 * c + 6] = o[8 * c + 6] * sc + pp * bflo(w.w); o[8 * c + 7] = o[8 * c + 7] * sc + pp * bfhi(w.w); }
        }
        const float M = wave_max(m), f = exp2f(m - M);
        const float lt = wave_sum(l * f);
        float res = 0.f;
#pragma unroll
        for (int d = 0; d < 64; ++d) { const float t = wave_sum(o[d] * f); if (lane == d) res = t; }
        zb[(size_t)r * D + h * 64 + lane] = (bf16)f2bf(res / lt);
    }
}
template <bool WCTX>
__device__ __forceinline__ void phase_mlstm_naive(Frame& F) {
    const int gw = F.blk * NWAVES + F.wave, lane = F.lane;
    if ((gw & 15) != 0) return;
    const int it = gw >> 4; if (it >= NB * 8 * 2) return;
    const int b = it >> 4, hd = (it >> 1) & 7, j = (it & 1) * 64 + lane;
    const bf16* kb = (const bf16*)(F.ws + WS_MK); const bf16* vb = (const bf16*)(F.ws + WS_MV); const bf16* qb = (const bf16*)(F.ws + WS_MQ);
    const float* gb = (const float*)(F.ws + WS_MG); float* hsum = (float*)(F.ws + WS_MHS);
    for (int dir = 0; dir < 2; ++dir) {
        float C[64], nn[64], m = 0.f;
#pragma unroll
        for (int d = 0; d < 64; ++d) { C[d] = 0.f; nn[d] = 0.f; }
        for (int s = 0; s < CTX + SEQ; ++s) {
            const int r = seq_row(b, dir, s);
            const float ig = gb[(size_t)r * 32 + dir * 16 + hd], lf = log_sigmoidf_(gb[(size_t)r * 32 + dir * 16 + 8 + hd]);
            const float mn = fmaxf(lf + m, ig), fa = __expf(lf + m - mn), ia = __expf(ig - mn); m = mn;
            const float vj = bf2f(vb[(size_t)r * 1024 + hd * 128 + j]) * ia;
            float num = 0.f, den = 0.f;
#pragma unroll
            for (int c = 0; c < 8; ++c) {
                const v4u kw = *(const v4u*)(kb + (size_t)r * 512 + hd * 64 + 8 * c), qw = *(const v4u*)(qb + (size_t)r * 512 + hd * 64 + 8 * c);
                float kk[8], qq[8];
                kk[0] = bflo(kw.x); kk[1] = bfhi(kw.x); kk[2] = bflo(kw.y); kk[3] = bfhi(kw.y); kk[4] = bflo(kw.z); kk[5] = bfhi(kw.z); kk[6] = bflo(kw.w); kk[7] = bfhi(kw.w);
                qq[0] = bflo(qw.x); qq[1] = bfhi(qw.x); qq[2] = bflo(qw.y); qq[3] = bfhi(qw.y); qq[4] = bflo(qw.z); qq[5] = bfhi(qw.z); qq[6] = bflo(qw.w); qq[7] = bfhi(qw.w);
#pragma unroll
                for (int e = 0; e < 8; ++e) { const int d = 8 * c + e;
                    C[d] = fa * C[d] + kk[e] * vj; nn[d] = fa * nn[d] + ia * kk[e]; num += C[d] * qq[e]; den += nn[d] * qq[e]; }
            }
            if (WCTX || s >= CTX) {
                const float outv = num / fmaxf(fabsf(den), __expf(-m));
                float* hp = hsum + (size_t)r * D + hd * 128 + j;
                if (dir == 0) *hp = outv; else *hp = *hp + outv;
            }
        }
    }
}
template <bool WCTX>
__device__ __forceinline__ void phase_mlstm_combine(Frame& F) {
    constexpr int R0 = WCTX ? 0 : TC;
    const float* hsum = (const float*)(F.ws + WS_MHS); const bf16* ob = (const bf16*)(F.ws + WS_MO); bf16* zb = (bf16*)(F.ws + WS_Z);
    const int gw = F.blk * NWAVES + F.wave, NGW = F.G * NWAVES, lane = F.lane;
    f32x4 gv[4];
#pragma unroll
    for (int j = 0; j < 4; ++j) gv[j] = *(const f32x4*)(F.in[IN_MLNG] + 4 * lane + 256 * j);
    for (int r = R0 + gw; r < T; r += NGW) {
#pragma unroll
        for (int j = 0; j < 4; ++j) {
            const f32x4 hv = *(const f32x4*)(hsum + (size_t)r * D + 4 * lane + 256 * j);
            float ss = hv.x * hv.x + hv.y * hv.y + hv.z * hv.z + hv.w * hv.w;
#pragma unroll
            for (int o = 1; o < 32; o <<= 1) ss += __shfl_xor(ss, o);
            const float rs = rsqrtf(ss * (1.f / 128.f) + EPS);
            const v2u ow = *(const v2u*)(ob + (size_t)r * D + 4 * lane + 256 * j);
            f32x4 z = hv * rs * gv[j];
            z.x *= sigmoidf_(bflo(ow.x)); z.y *= sigmoidf_(bfhi(ow.x)); z.z *= sigmoidf_(bflo(ow.y)); z.w *= sigmoidf_(bfhi(ow.y));
            st_bf4(zb + (size_t)r * D + 4 * lane + 256 * j, z);
        }
    }
}
#include <hip/hip_bf16.h>
#include <cmath>
namespace attn_body {
using bf16=__hip_bfloat16;
using bf16x8=__attribute__((ext_vector_type(8)))short;
using s16x4=__attribute__((ext_vector_type(4)))short;
using f32x16=__attribute__((ext_vector_type(16)))float;
using u32x4=__attribute__((ext_vector_type(4)))unsigned;
constexpr int D=64,QP=1024,KP=256;
constexpr int NW=8,QBLK=32,QB=QBLK*NW,KVBLK=64;
__device__ __forceinline__ int crow(int r,int hi){return (r&3)+8*(r>>2)+4*hi;}
#define SBAR() __builtin_amdgcn_sched_barrier(0)
__device__ __forceinline__ void cmask(f32x16&p0,f32x16&p1,int jb,int qrel,int hi){
  const float NEG=-INFINITY; int kb=64*jb+4*hi;
  #pragma unroll
  for(int r=0;r<16;++r){int kv=kb+(r&3)+8*(r>>2); if(kv>qrel)p0[r]=NEG; if(kv+32>qrel)p1[r]=NEG;}
}

constexpr int NSLOT=3, SLOTB=8192;
constexpr int LDS_K=0, LDS_V=NSLOT*SLOTB, LDS_WS=2*NSLOT*SLOTB, LDS_OST=LDS_WS+NW*64*4, LDS_BYTES=LDS_OST+NW*4096;
constexpr float C2=0.125f*1.4426950408889634f;
__device__ __forceinline__ void glds16(const void*gsrc,unsigned lds_dst){unsigned keep;
  asm volatile("s_mov_b32 %0, m0\n\ts_mov_b32 m0, %2\n\ts_nop 0\n\tglobal_load_lds_dwordx4 %1, off\n\ts_mov_b32 m0, %0":"=&s"(keep):"v"(gsrc),"s"(lds_dst):"memory");}
__device__ __forceinline__ float max3f(float a,float b,float c){float r;asm("v_max3_f32 %0, %1, %2, %3":"=v"(r):"v"(a),"v"(b),"v"(c));return r;}
__device__ __forceinline__ float max2f(float a,float b){float r;asm("v_max_f32_e32 %0, %1, %2":"=v"(r):"v"(a),"v"(b));return r;}
__device__ __forceinline__ float fadd_s(float a,float b){float r;asm("v_add_f32_e32 %0, %1, %2":"=v"(r):"v"(a),"v"(b));return r;}
__device__ __forceinline__ float fsub_s(float a,float b){float r;asm("v_sub_f32_e32 %0, %1, %2":"=v"(r):"v"(a),"v"(b));return r;}
typedef float f32x2_t __attribute__((ext_vector_type(2))); typedef __bf16 bf16x2_t __attribute__((ext_vector_type(2)));
__device__ __forceinline__ unsigned cvtpk_s(float lo,float hi){f32x2_t v={lo,hi};bf16x2_t b=__builtin_convertvector(v,bf16x2_t);return __builtin_bit_cast(unsigned,b);}
#define WAIT_BAR(N) asm volatile("s_waitcnt vmcnt(" #N ") lgkmcnt(0)\n\ts_barrier":::"memory")

__device__ __forceinline__ void qkt(f32x16&p0,f32x16&p1,const char*Kslot,const bf16x8*qr,const f32x16&negm,int r32,int hi){
  const char*kb=Kslot+hi*1024+r32*16;
  #pragma unroll
  for(int d0=0;d0<4;++d0){
    const bf16x8 b0=*reinterpret_cast<const bf16x8*>(kb+d0*2048);
    const bf16x8 b1=*reinterpret_cast<const bf16x8*>(kb+d0*2048+512);
    if(d0==0){p0=__builtin_amdgcn_mfma_f32_32x32x16_bf16(b0,qr[0],negm,0,0,0);p1=__builtin_amdgcn_mfma_f32_32x32x16_bf16(b1,qr[0],negm,0,0,0);}
    else{p0=__builtin_amdgcn_mfma_f32_32x32x16_bf16(b0,qr[d0],p0,0,0,0);p1=__builtin_amdgcn_mfma_f32_32x32x16_bf16(b1,qr[d0],p1,0,0,0);}}
}
typedef __attribute__((address_space(3))) const char* lds_cptr;
typedef short v4i16_t __attribute__((ext_vector_type(4)));
__device__ __forceinline__ void kload8(bf16x8*kf,lds_cptr kp){
  kf[0]=*(const __attribute__((address_space(3))) bf16x8*)(kp);      kf[1]=*(const __attribute__((address_space(3))) bf16x8*)(kp+512);
  kf[2]=*(const __attribute__((address_space(3))) bf16x8*)(kp+2048); kf[3]=*(const __attribute__((address_space(3))) bf16x8*)(kp+2560);
  kf[4]=*(const __attribute__((address_space(3))) bf16x8*)(kp+4096); kf[5]=*(const __attribute__((address_space(3))) bf16x8*)(kp+4608);
  kf[6]=*(const __attribute__((address_space(3))) bf16x8*)(kp+6144); kf[7]=*(const __attribute__((address_space(3))) bf16x8*)(kp+6656);
}
__device__ __forceinline__ void kload2(bf16x8*kf,lds_cptr kp,int j){ kf[2*j]=*(const __attribute__((address_space(3))) bf16x8*)(kp+j*2048); kf[2*j+1]=*(const __attribute__((address_space(3))) bf16x8*)(kp+j*2048+512); }
__device__ __forceinline__ s16x4 vtr(lds_cptr p){ return __builtin_bit_cast(s16x4,__builtin_amdgcn_ds_read_tr16_b64_v4i16((__attribute__((address_space(3))) v4i16_t*)p)); }
__device__ __forceinline__ float rowmax(const f32x16&p0,const f32x16&p1){
  float a=max3f(p0[0],p0[1],p1[0]),b=max3f(p0[2],p0[3],p1[1]);a=max3f(a,p1[2],p1[3]);
  #pragma unroll
  for(int r=4;r<16;r+=4){a=max3f(a,p0[r],p0[r+1]);b=max3f(b,p0[r+2],p0[r+3]);a=max3f(a,p1[r],p1[r+1]);b=max3f(b,p1[r+2],p1[r+3]);}
  const float m=max2f(a,b);
  auto rr=__builtin_amdgcn_permlane32_swap(__float_as_uint(m),__float_as_uint(m),false,false);
  return max2f(__uint_as_float(rr[0]),__uint_as_float(rr[1]));
}
__device__ __forceinline__ void pv(f32x16*o,int vb,bf16x8 pa0,bf16x8 pa1,bf16x8 pa2,bf16x8 pa3){
  #pragma unroll
  for(int d0=0;d0<2;++d0){s16x4 lo[4],hi[4];
    #pragma unroll
    for(int ks=0;ks<4;++ks){
      asm volatile("ds_read_b64_tr_b16 %0,%1 offset:%c2":"=&v"(lo[ks]):"v"(vb),"i"(d0*4096+ks*1024):"memory");
      asm volatile("ds_read_b64_tr_b16 %0,%1 offset:%c2":"=&v"(hi[ks]):"v"(vb),"i"(d0*4096+ks*1024+512):"memory");}
    asm volatile("s_waitcnt lgkmcnt(0)":::"memory");SBAR();
    #define PK(k) (bf16x8){lo[k][0],lo[k][1],lo[k][2],lo[k][3],hi[k][0],hi[k][1],hi[k][2],hi[k][3]}
    o[d0]=__builtin_amdgcn_mfma_f32_32x32x16_bf16(pa0,PK(0),o[d0],0,0,0);
    o[d0]=__builtin_amdgcn_mfma_f32_32x32x16_bf16(pa1,PK(1),o[d0],0,0,0);
    o[d0]=__builtin_amdgcn_mfma_f32_32x32x16_bf16(pa2,PK(2),o[d0],0,0,0);
    o[d0]=__builtin_amdgcn_mfma_f32_32x32x16_bf16(pa3,PK(3),o[d0],0,0,0);
    #undef PK
  }
}

#ifndef ATTN_STORE16
#define ATTN_STORE16(p,v) (*(u32x4*)(p)=(v))
#endif
template<int THRL> __device__ __forceinline__ void attn_unit(const bf16*Qu,const bf16*__restrict__ Kh,const bf16*__restrict__ Vh,bf16*Ou,const int NT,char*shm){
  const int tid=threadIdx.x,lane=tid&63,r32=lane&31,hi=lane>>5; const int wid=__builtin_amdgcn_readfirstlane(tid>>6);
  const bf16*Qw=Qu+(long)(wid*QBLK)*QP;
  const unsigned lds0=(unsigned)(uintptr_t)shm;
  float*wsf=(float*)(shm+LDS_WS)+wid*64;
  const bf16*ksrc=Kh+(long)lane*KP+wid*8;
  const bf16*vsrc=Vh+(long)(16*(wid&3)+(lane>>2))*KP+(wid>>2)*32+(lane&3)*8;
  const unsigned kdst=lds0+LDS_K+wid*1024, vdst=lds0+LDS_V+wid*1024;
  #define DMA_K(t,slot) glds16(ksrc+(long)(t)*KVBLK*KP,(unsigned)__builtin_amdgcn_readfirstlane(kdst+(slot)))
  #define DMA_V(t,slot) glds16(vsrc+(long)(t)*KVBLK*KP,(unsigned)__builtin_amdgcn_readfirstlane(vdst+(slot)))
  const int vb0=(int)(lds0+LDS_V)+((lane>>4)&1)*32+(lane&3)*8+(4*hi+((lane&15)>>2))*64;
  const char*Kbase=shm+LDS_K; bf16x8 kf[8];
  const lds_cptr shm3=(lds_cptr)shm; const lds_cptr kp0=shm3+LDS_K+hi*1024+r32*16; const lds_cptr vp0=shm3+LDS_V+((lane>>4)&1)*32+(lane&3)*8+(4*hi+((lane&15)>>2))*64;
  DMA_K(0,0);DMA_V(0,0);DMA_K(1,SLOTB);
  bf16x8 qr[4];
  #pragma unroll
  for(int d0=0;d0<4;++d0)qr[d0]=*reinterpret_cast<const bf16x8*>(&Qw[(long)r32*QP+d0*16+hi*8]);
  float mhat=0.f,l_reg=0.f;f32x16 o[2];o[0]=f32x16{};o[1]=f32x16{};f32x16 negm=f32x16{};asm volatile("":"+v"(negm));
  #define CMASK(P0,P1,t) do{}while(0)
  bool resc=false;
  #define START(P0,P1) do{ const float rm=rowmax(P0,P1); resc=false; \
    { const float dl=rm; mhat=fadd_s(mhat,dl); \
      _Pragma("unroll") for(int r=0;r<16;++r){P0[r]=fsub_s(P0[r],dl);P1[r]=fsub_s(P1[r],dl);} \
      _Pragma("unroll") for(int r=0;r<16;++r)negm[r]=-mhat; asm volatile("":"+v"(negm)); } \
    _Pragma("unroll") for(int r=0;r<16;++r)P0[r]=__builtin_amdgcn_exp2f(P0[r]); }while(0)
  #define RESC() do{ if(resc){ asm volatile("s_waitcnt lgkmcnt(0)":::"memory"); \
      _Pragma("unroll") for(int d_=0;d_<2;++d_) _Pragma("unroll") for(int r=0;r<16;++r)o[d_][r]*=wsf[crow(r,hi)]; } }while(0)
  f32x16 pA0,pA1,pB0,pB1;
  int sl_prev=0,sl_cur=0,sl_next=SLOTB;
  #define ROT() do{sl_prev=sl_cur;sl_cur=sl_next;sl_next=(sl_next==(NSLOT-1)*SLOTB)?0:sl_next+SLOTB;}while(0)
  DMA_K(2,2*SLOTB);
  WAIT_BAR(3);
  qkt(pA0,pA1,Kbase,qr,negm,r32,hi);asm volatile("s_nop 15\n\ts_nop 7":"+v"(pA0),"+v"(pA1));CMASK(pA0,pA1,0);
  START(pA0,pA1);
  _Pragma("unroll") for(int r=0;r<16;++r)pA1[r]=__builtin_amdgcn_exp2f(pA1[r]);
  WAIT_BAR(0);
  DMA_K(3,0);DMA_V(1,SLOTB);
  ROT();
  kload8(kf,kp0+sl_cur);
  WAIT_BAR(2);
  s16x4 vlo[8],vhi[8]; u32x4 pw0,pw1,pw2,pw3;
  #define PKW(P,B) cvtpk_s(P[B],P[B+1])
  #define PAF(k) __builtin_bit_cast(bf16x8,pw##k)
  #define VFR(i) (bf16x8){vlo[i][0],vlo[i][1],vlo[i][2],vlo[i][3],vhi[i][0],vhi[i][1],vhi[i][2],vhi[i][3]}
  #define PIN(x) asm volatile("":"+v"(x))
  #define MX3(a,b,c) __builtin_fmaxf(__builtin_fmaxf((a),(b)),(c))
  #define GAPA(MF,A0,A1,A2,A3,W0,W1,PW) do{ MF; sacc+=A0; sacc+=A1; sacc+=A2; sacc+=A3; PIN(sacc); W0; W1; PIN(PW); SBAR(); }while(0)
  #define EX(v) __builtin_amdgcn_exp2f(v)
  #define GAPB(MF,X,B) do{ MF; X[B]=EX(X[B]); X[B+1]=EX(X[B+1]); X[B+2]=EX(X[B+2]); X[B+3]=EX(X[B+3]); PIN(X); SBAR(); }while(0)
  #define VRD(i) do{ vlo[i]=vtr(vp_+(((i)>>2)*4096+((i)&3)*1024)); vhi[i]=vtr(vp_+(((i)>>2)*4096+((i)&3)*1024+512)); }while(0)
  #define KRD(G,j) do{ if(G){ kload2(kf,kp0+sl_next,j); SBAR(); } }while(0)
  #define STEP(C0,C1,P0,P1,t,GK,GV,GL) do{ SBAR(); \
    const lds_cptr vp_=vp0+sl_prev; \
    VRD(0); SBAR(); float sacc=(P0[0]+P0[1]); \
    GAPA(C0=__builtin_amdgcn_mfma_f32_32x32x16_bf16(kf[0],qr[0],negm,0,0,0), P0[2],P0[3],P0[4],P0[5],     pw0[0]=PKW(P0,0), pw0[1]=PKW(P0,2), pw0); \
    VRD(4); SBAR(); GAPA(C1=__builtin_amdgcn_mfma_f32_32x32x16_bf16(kf[1],qr[0],negm,0,0,0), P0[6],P0[7],P0[8],P0[9],     pw0[2]=PKW(P0,4), pw0[3]=PKW(P0,6), pw0); \
    VRD(1); SBAR(); GAPA(C0=__builtin_amdgcn_mfma_f32_32x32x16_bf16(kf[2],qr[1],C0,0,0,0),   P0[10],P0[11],P0[12],P0[13], pw1[0]=PKW(P0,8), pw1[1]=PKW(P0,10), pw1); \
    VRD(5); SBAR(); GAPA(C1=__builtin_amdgcn_mfma_f32_32x32x16_bf16(kf[3],qr[1],C1,0,0,0),   P0[14],P0[15],P1[0],P1[1],   pw1[2]=PKW(P0,12),pw1[3]=PKW(P0,14), pw1); \
    VRD(2); SBAR(); GAPA(C0=__builtin_amdgcn_mfma_f32_32x32x16_bf16(kf[4],qr[2],C0,0,0,0),   P1[2],P1[3],P1[4],P1[5],     pw2[0]=PKW(P1,0), pw2[1]=PKW(P1,2), pw2); \
    VRD(6); SBAR(); GAPA(C1=__builtin_amdgcn_mfma_f32_32x32x16_bf16(kf[5],qr[2],C1,0,0,0),   P1[6],P1[7],P1[8],P1[9],     pw2[2]=PKW(P1,4), pw2[3]=PKW(P1,6), pw2); \
    VRD(3); SBAR(); GAPA(C0=__builtin_amdgcn_mfma_f32_32x32x16_bf16(kf[6],qr[3],C0,0,0,0),   P1[10],P1[11],P1[12],P1[13], pw3[0]=PKW(P1,8), pw3[1]=PKW(P1,10), pw3); \
    VRD(7); SBAR(); GAPA(C1=__builtin_amdgcn_mfma_f32_32x32x16_bf16(kf[7],qr[3],C1,0,0,0),   P1[14],P1[15],0.f,0.f,       pw3[2]=PKW(P1,12),pw3[3]=PKW(P1,14), pw3); \
    l_reg+=sacc; \
    if(GK){DMA_K((t)+3,sl_cur);} if(GV){DMA_V((t)+1,sl_next);} \
    CMASK(C0,C1,t); \
    { float a=MX3(C0[0],C0[1],C1[0]),b=MX3(C0[2],C0[3],C1[1]); a=MX3(a,C1[2],C1[3]); \
      _Pragma("unroll") for(int r=4;r<16;r+=4){a=MX3(a,C0[r],C0[r+1]);b=MX3(b,C0[r+2],C0[r+3]);a=MX3(a,C1[r],C1[r+1]);b=MX3(b,C1[r+2],C1[r+3]);} \
      float rm=__builtin_fmaxf(a,b); { auto rr=__builtin_amdgcn_permlane32_swap(__float_as_uint(rm),__float_as_uint(rm),false,false); rm=__builtin_fmaxf(__uint_as_float(rr[0]),__uint_as_float(rr[1])); } \
      resc=false; \
      if(__builtin_expect(__any(rm>(float)THRL),0)){ const float dl=__builtin_fmaxf(rm,0.f); mhat+=dl; \
        _Pragma("unroll") for(int r=0;r<16;++r){C0[r]-=dl;C1[r]-=dl;} \
        _Pragma("unroll") for(int r=0;r<16;++r)negm[r]=-mhat; asm volatile("":"+v"(negm)); \
        const float f=__builtin_amdgcn_exp2f(-dl); l_reg*=f; if(hi==0)wsf[r32]=f; resc=true; } } \
    SBAR(); \
    GAPB(o[0]=__builtin_amdgcn_mfma_f32_32x32x16_bf16(PAF(0),VFR(0),o[0],0,0,0), C0,0); \
    GAPB(o[1]=__builtin_amdgcn_mfma_f32_32x32x16_bf16(PAF(0),VFR(4),o[1],0,0,0), C0,4); \
    KRD(GL,0); GAPB(o[0]=__builtin_amdgcn_mfma_f32_32x32x16_bf16(PAF(1),VFR(1),o[0],0,0,0), C0,8); \
    KRD(GL,1); GAPB(o[1]=__builtin_amdgcn_mfma_f32_32x32x16_bf16(PAF(1),VFR(5),o[1],0,0,0), C0,12); \
    KRD(GL,2); GAPB(o[0]=__builtin_amdgcn_mfma_f32_32x32x16_bf16(PAF(2),VFR(2),o[0],0,0,0), C1,0); \
    KRD(GL,3); GAPB(o[1]=__builtin_amdgcn_mfma_f32_32x32x16_bf16(PAF(2),VFR(6),o[1],0,0,0), C1,4); \
    GAPB(o[0]=__builtin_amdgcn_mfma_f32_32x32x16_bf16(PAF(3),VFR(3),o[0],0,0,0), C1,8); \
    GAPB(o[1]=__builtin_amdgcn_mfma_f32_32x32x16_bf16(PAF(3),VFR(7),o[1],0,0,0), C1,12); \
    }while(0)
  int t=1;
  #undef CMASK
  #define CMASK(P0,P1,t) do{}while(0)
  for(;t+5<NT;t+=2){
    STEP(pB0,pB1,pA0,pA1,t,true,true,true);     WAIT_BAR(2); RESC(); ROT();
    STEP(pA0,pA1,pB0,pB1,t+1,true,true,true);   WAIT_BAR(2); RESC(); ROT();
  }
  #undef CMASK
  #define CMASK(P0,P1,t) do{}while(0)
  #define ENDW(tt) do{ if((tt)+3<NT){WAIT_BAR(2);} else if((tt)+2<NT){WAIT_BAR(1);} else {WAIT_BAR(0);} }while(0)
  for(;t+1<NT;t+=2){
    STEP(pB0,pB1,pA0,pA1,t,(t+3<NT),(t+1<NT),(t+1<NT));       ENDW(t);   RESC(); ROT();
    STEP(pA0,pA1,pB0,pB1,t+1,(t+4<NT),(t+2<NT),(t+2<NT));     ENDW(t+1); RESC(); ROT();
  }
  STEP(pB0,pB1,pA0,pA1,NT-1,false,false,false); RESC();
  { float sacc=pB0[0]+pB0[1]; _Pragma("unroll") for(int r=2;r<16;++r)sacc+=pB0[r]; _Pragma("unroll") for(int r=0;r<16;++r)sacc+=pB1[r]; l_reg+=sacc;
    pw0=(u32x4){PKW(pB0,0),PKW(pB0,2),PKW(pB0,4),PKW(pB0,6)};pw1=(u32x4){PKW(pB0,8),PKW(pB0,10),PKW(pB0,12),PKW(pB0,14)};pw2=(u32x4){PKW(pB1,0),PKW(pB1,2),PKW(pB1,4),PKW(pB1,6)};pw3=(u32x4){PKW(pB1,8),PKW(pB1,10),PKW(pB1,12),PKW(pB1,14)};
    SBAR(); pv(o,vb0+sl_cur,PAF(0),PAF(1),PAF(2),PAF(3)); }
  #undef PKW
  #undef PAF
  #undef VFR
  #undef PIN
  #undef MX3
  #undef GAPA
  #undef GAPB
  #undef EX
  #undef VRD
  #undef KRD
  #undef STEP
  #undef ENDW
  {auto rr=__builtin_amdgcn_permlane32_swap(__float_as_uint(l_reg),__float_as_uint(l_reg),false,false);l_reg=__uint_as_float(rr[0])+__uint_as_float(rr[1]);}
  if(hi==0)wsf[32+r32]=l_reg;asm volatile("s_waitcnt lgkmcnt(0)":::"memory");
  float rli[16];
  #pragma unroll
  for(int r=0;r<16;++r)rli[r]=__builtin_amdgcn_rcpf(wsf[32+crow(r,hi)]);
  bf16*Ow=Ou+(long)(wid*QBLK)*QP;
  { bf16*stg=(bf16*)(shm+LDS_OST)+wid*2048;
    #pragma unroll
    for(int r=0;r<16;++r){const int orow=crow(r,hi);
      #pragma unroll
      for(int d0=0;d0<2;++d0)stg[orow*64+d0*32+r32]=__float2bfloat16(o[d0][r]*rli[r]);}
    asm volatile("s_waitcnt lgkmcnt(0)":::"memory");
    #pragma unroll
    for(int i=0;i<4;++i){const int row=i*8+(lane>>3),ch=lane&7; const u32x4 v=*(const u32x4*)(stg+row*64+ch*8); ATTN_STORE16(Ow+(long)row*QP+ch*8,v);} }
  asm volatile("s_waitcnt lgkmcnt(0)\n\ts_barrier":::"memory");
  #undef DMA_K
  #undef DMA_V
  #undef CMASK
  #undef START
  #undef RESC
  #undef ROT
}
constexpr int ATTN_LDS_BYTES=LDS_BYTES;
#undef SBAR
#undef WAIT_BAR
}

template <bool WCTX>
__device__ __forceinline__ void phase_attn_fast(Frame& F, char* ldsg) {
    typedef attn_body::bf16 abf;
    const abf* Q = (const abf*)(F.ws + WS_QB); const abf* K = (const abf*)(F.ws + WS_KB); const abf* V = (const abf*)(F.ws + WS_VB); abf* O = (abf*)(F.ws + WS_Z);
    const int vcu = (F.G % 8 == 0) ? (F.blk % 8) * (F.G / 8) + F.blk / 8 : F.blk;
    const int nunits = WCTX ? 1024 + 128 : 1024;
    for (int u = vcu; u < nunits; u += F.G) {
        int h, kvh, qrow0, kv0, NT;
        if (u < 1024) { const int grp = u >> 5, b = grp >> 2; kvh = grp & 3; const int qb = (u >> 2) & 7; h = kvh * 4 + (u & 3); qrow0 = TC + b * SEQ + qb * 256; kv0 = b * KVLEN; NT = KVLEN / 64; }
        else { const int u2 = u - 1024, b = u2 >> 4; h = u2 & 15; kvh = h >> 2; qrow0 = b * CTX; kv0 = b * KVLEN + SEQ; NT = CTX / 64; }
        attn_body::attn_unit<8>(Q + (size_t)qrow0 * 1024 + h * 64, K + (size_t)kv0 * 256 + kvh * 64, V + (size_t)kv0 * 256 + kvh * 64, O + (size_t)qrow0 * 1024 + h * 64, NT, ldsg + RING_OFF);
    }
}

constexpr int S5_BU_STRIDE = 132;
constexpr int S5_X_STRIDE = 136;
constexpr int S5_BU_BYTES = 16 * S5_BU_STRIDE * 4, S5_X_BYTES = 16 * S5_X_STRIDE * 2, S5_Y_BYTES = 2 * 64 * 16, S5_U_BYTES = 64 * 16;
constexpr int S5_ITEM_LDS = S5_BU_BYTES + S5_X_BYTES + 2 * S5_Y_BYTES + 4 * S5_U_BYTES;
constexpr int S5_NT = (CTX + SEQ) / 32;
static_assert(4 * S5_ITEM_LDS <= RING_BYTES, "S5 LDS");
#define S5_BAR() do { asm volatile("s_waitcnt lgkmcnt(0)" ::: "memory"); __builtin_amdgcn_s_barrier(); asm volatile("" ::: "memory"); } while (0)
__device__ __forceinline__ f32x2 cmul(f32x2 a, f32x2 b) { return (f32x2){a.x * b.x - a.y * b.y, a.x * b.y + a.y * b.x}; }

template <int J, bool WCTX>
__device__ __forceinline__ void phase_s5_fast(Frame& F) {
    const int lane = F.lane, w = F.wave;
    const bool helper = w >= 4;
    const int iw = w & 3, pairi = iw >> 1, dir = iw & 1;
    const int tq = lane & 15, kg = lane >> 4;
    const bf16* hb = (const bf16*)(F.ws + WS_H); float* ypart = (float*)(F.ws + WS_YSUM); bf16* zb = (bf16*)(F.ws + WS_Z);
    LAS unsigned char* base = F.lds + iw * S5_ITEM_LDS;
    LAS float* BU = (LAS float*)base;
    LAS bf16* XS = (LAS bf16*)(base + S5_BU_BYTES);
    LAS f32x4* YL = (LAS f32x4*)(base + S5_BU_BYTES + S5_X_BYTES);
    LAS v4u* UL = (LAS v4u*)(base + S5_BU_BYTES + S5_X_BYTES + 2 * S5_Y_BYTES);
    for (int it0 = F.blk * 2; it0 < NB * 64; it0 += F.G * 2) {
        const int it = it0 + pairi, b = it >> 6, g = it & 63;
        const int gi = (J * 2 + dir) * 64 + g;
        LAS v4u* TAB = (LAS v4u*)(F.lds);
        LAS f32x2* CST = (LAS f32x2*)(F.lds + 65536);
        LAS float* KMS = (LAS float*)(F.lds + 65536 + 6144);
        static_assert(65536 + 6144 + 8192 <= 4 * S5_ITEM_LDS, "S5 set-up scratch inside the item buffers");
        if (F.tid < 256) { const int i = F.tid >> 6, p = F.tid & 63; const int git = (J * 2 + (i & 1)) * 64 + ((it0 + (i >> 1)) & 63);
            const float dt = expf(F.in[IN_S5LOG][git]);
            const float lr = F.in[IN_S5LRE][git * 64 + p], li = F.in[IN_S5LIM][git * 64 + p]; const float mag = expf(lr * dt); double sd, cd; sincos_d((double)(li * dt), sd, cd);
            const float ar = mag * (float)cd, ai = mag * (float)sd, den = lr * lr + li * li, nr = ar - 1.f, ni = ai;
            const f32x2 a = (f32x2){ar, ai};
            CST[(i * 3 + 0) * 64 + p] = a; CST[(i * 3 + 1) * 64 + p] = cmul(a, a); CST[(i * 3 + 2) * 64 + p] = (f32x2){(nr * lr + ni * li) / den, (ni * lr - nr * li) / den}; }
        __syncthreads();
        for (int f = F.tid; f < 4 * 16 * 64; f += NTHR) {
            const int i = f >> 10, fi = (f >> 6) & 15, ln = f & 63, ltq = ln & 15, lkg = ln >> 4; const int git = (J * 2 + (i & 1)) * 64 + ((it0 + (i >> 1)) & 63);
            unsigned o[4];
            if (fi < 8) {
                const int n = 16 * fi + ltq, p = n >> 1, ri = n & 1;
                f32x2 co = CST[(i * 3 + 2) * 64 + p]; if ((lkg >> 1) == 0) co = cmul(co, CST[(i * 3 + 0) * 64 + p]);
                const float* brp = F.in[IN_S5BRE] + (size_t)git * 1024 + p * 16 + 8 * (lkg & 1); const float* bip = F.in[IN_S5BIM] + (size_t)git * 1024 + p * 16 + 8 * (lkg & 1);
#pragma unroll
                for (int q = 0; q < 4; ++q) { const f32x2 v0 = cmul(co, (f32x2){brp[2 * q], bip[2 * q]}), v1 = cmul(co, (f32x2){brp[2 * q + 1], bip[2 * q + 1]}); o[q] = pk2(ri ? v0.y : v0.x, ri ? v1.y : v1.x); }
            } else {
                const int tau = (fi - 8) >> 2, ks = fi & 3, p0 = 16 * ks + 4 * lkg;
                const float* crp = F.in[IN_S5CRE] + (size_t)git * 1024 + ltq * 64 + p0; const float* cip = F.in[IN_S5CIM] + (size_t)git * 1024 + ltq * 64 + p0;
#pragma unroll
                for (int q = 0; q < 4; ++q) { const f32x2 v = cmul((f32x2){crp[q], cip[q]}, CST[(i * 3 + tau) * 64 + p0 + q]); o[q] = pk2(v.x, -v.y); }
            }
            TAB[f] = (v4u){o[0], o[1], o[2], o[3]};
        }
        __syncthreads();
        if (helper) {
            const f32x4 d4 = *(const f32x4*)(F.in[IN_S5D] + J * D + g * 16 + 4 * kg);
            v4u ub[4]; f32x4 yoA0, yoA1, yoB0, yoB1;
#pragma unroll
            for (int k = 0; k < 4; ++k) ub[k] = *(const v4u*)(hb + (size_t)seq_row(b, dir, 32 * k + 2 * tq + (kg >> 1)) * D + g * 16 + 8 * (kg & 1));
            yoA0 = (f32x4){0.f, 0.f, 0.f, 0.f}; yoA1 = yoA0; yoB0 = yoA0; yoB1 = yoA0;
            S5_BAR();
#pragma unroll 4
            for (int T = -1; T < S5_NT + 3; ++T) {
                const int e = T - 1, d = T + 1;
                const bool e_ok = (e >= 0) && (e < S5_NT) && (WCTX || e >= 8);
                const bool e_second = (e < 8) ? (e >= 4) : (e >= 40);
                if (d >= 0 && d < S5_NT) UL[(d & 3) * 64 + lane] = ub[d & 3];
                if (e_ok) {
#pragma unroll
                    for (int tau = 0; tau < 2; ++tau) {
                        const size_t idx = (size_t)seq_row(b, dir, 32 * e + 2 * tq + tau) * D + g * 16 + 4 * kg;
                        const f32x4 y = YL[((e & 1) * 2 + tau) * 64 + lane];
                        if (!e_second) *(f32x4*)(ypart + idx) = y;
                        else {
                            f32x4 yo = (e & 1) ? (tau ? yoB1 : yoB0) : (tau ? yoA1 : yoA0);
                            if (e == 4 || e == 40) yo = *(const f32x4*)(ypart + idx);
                            const v2u hw = *(const v2u*)(hb + idx);
                            f32x4 v = y + yo; v.x += d4.x * bflo(hw.x); v.y += d4.y * bfhi(hw.x); v.z += d4.z * bflo(hw.y); v.w += d4.w * bfhi(hw.y);
                            v2u zo; zo.x = pk2(gelu_tanh(v.x), gelu_tanh(v.y)); zo.y = pk2(gelu_tanh(v.z), gelu_tanh(v.w));
                            *(v2u*)(zb + idx) = zo;
                        }
                    }
                }
                { const int e1 = e + 1; const bool e1_ok = (e1 >= 0) && (e1 < S5_NT) && (WCTX || e1 >= 8); const bool e1_second = (e1 < 8) ? (e1 >= 4) : (e1 >= 40);
                  if (e1_ok && e1_second && e1 != 4 && e1 != 40) {
                      const f32x4 l0 = *(const f32x4*)(ypart + (size_t)seq_row(b, dir, 32 * e1 + 2 * tq) * D + g * 16 + 4 * kg), l1 = *(const f32x4*)(ypart + (size_t)seq_row(b, dir, 32 * e1 + 2 * tq + 1) * D + g * 16 + 4 * kg);
                      if (e1 & 1) { yoB0 = l0; yoB1 = l1; } else { yoA0 = l0; yoA1 = l1; }
                  } }
                if (d >= 0 && d + 4 < S5_NT) ub[d & 3] = *(const v4u*)(hb + (size_t)seq_row(b, dir, 32 * (d + 4) + 2 * tq + (kg >> 1)) * D + g * 16 + 8 * (kg & 1));
                if (e == 3 || e == 39) asm volatile("s_waitcnt vmcnt(0)" ::: "memory");
                S5_BAR();
            }
        } else {
            const float* cre = F.in[IN_S5CRE] + (size_t)gi * 1024; const float* cim = F.in[IN_S5CIM] + (size_t)gi * 1024;
            bf16x8 wf[8], vkf[2][5];
#pragma unroll
            for (int rt = 0; rt < 8; ++rt) wf[rt] = __builtin_bit_cast(bf16x8, TAB[(iw * 16 + rt) * 64 + lane]);
#pragma unroll
            for (int tau = 0; tau < 2; ++tau)
#pragma unroll
                for (int ks = 0; ks < 4; ++ks) vkf[tau][ks] = __builtin_bit_cast(bf16x8, TAB[(iw * 16 + 8 + tau * 4 + ks) * 64 + lane]);
            const f32x2 a2 = CST[(iw * 3 + 1) * 64 + lane];
            { LAS float* KM = KMS + iw * 512;
              const LAS bf16* W2T = (const LAS bf16*)(TAB + (iw * 16) * 64);
#pragma unroll
              for (int e = 0; e < 2; ++e) {
                  f32x4 acc = (f32x4){0.f, 0.f, 0.f, 0.f};
#pragma unroll
                  for (int ks = 0; ks < 4; ++ks) {
                      bf16x8 cfr, fr;
                      const int p0 = 16 * ks + 4 * kg;
                      const f32x4 cr = *(const f32x4*)(cre + tq * 64 + p0), ci = *(const f32x4*)(cim + tq * 64 + p0);
                      cfr[0] = (short)f2bf(cr.x); cfr[1] = (short)f2bf(-ci.x); cfr[2] = (short)f2bf(cr.y); cfr[3] = (short)f2bf(-ci.y); cfr[4] = (short)f2bf(cr.z); cfr[5] = (short)f2bf(-ci.z); cfr[6] = (short)f2bf(cr.w); cfr[7] = (short)f2bf(-ci.w);
#pragma unroll
                      for (int jj = 0; jj < 8; ++jj) { const int n = 32 * ks + 8 * kg + jj, k = 16 * (1 - e) + tq; fr[jj] = (short)W2T[(((n >> 4) * 64) + (n & 15) + 16 * (k >> 3)) * 8 + (k & 7)]; }
                      acc = __builtin_amdgcn_mfma_f32_16x16x32_bf16(cfr, fr, acc, 0, 0, 0);
                  }
#pragma unroll
                  for (int r = 0; r < 4; ++r) KM[(e * 16 + 4 * kg + r) * 16 + tq] = acc[r];
              }
#pragma unroll
              for (int tau = 0; tau < 2; ++tau) { const int tp = kg >> 1; bf16x8 fr;
#pragma unroll
                  for (int jj = 0; jj < 8; ++jj) { const float v = (tp <= tau) ? KM[((tau - tp) * 16 + tq) * 16 + 8 * (kg & 1) + jj] : 0.f; fr[jj] = (short)f2bf(v); }
                  vkf[tau][4] = fr; } }
            asm volatile("s_waitcnt vmcnt(0) lgkmcnt(0)" ::: "memory");
            f32x2 x = (f32x2){0.f, 0.f};
            const f32x2 a2re = (f32x2){a2.x, a2.x}, a2im = (f32x2){-a2.y, a2.y};
            S5_BAR();
            for (int T = -1; T < S5_NT + 3; ++T) {
                if (T >= 0 && T < S5_NT) {
                    const bf16x8 uf = __builtin_bit_cast(bf16x8, UL[(T & 3) * 64 + lane]);
#pragma unroll
                    for (int rt = 0; rt < 8; ++rt) {
                        const f32x4 dacc = __builtin_amdgcn_mfma_f32_16x16x32_bf16(wf[rt], uf, (f32x4){0.f, 0.f, 0.f, 0.f}, 0, 0, 0);
                        *(LAS f32x4*)(BU + tq * S5_BU_STRIDE + 16 * rt + 4 * kg) = dacc;
                    }
                    f32x2 buv[16]; unsigned xw[16];
#pragma unroll
                    for (int t = 0; t < 16; ++t) buv[t] = *(const LAS f32x2*)(BU + t * S5_BU_STRIDE + 2 * lane);
#pragma unroll
                    for (int t = 0; t < 16; ++t) { xw[t] = pk2(x.x, x.y); const f32x2 xs = (f32x2){x.y, x.x}; x = a2re * x + (a2im * xs + buv[t]); }
                    if (WCTX || T >= 8) {
#pragma unroll
                        for (int t = 0; t < 16; ++t) *(LAS unsigned*)(XS + t * S5_X_STRIDE + 2 * lane) = xw[t];
                        bf16x8 xf[4];
#pragma unroll
                        for (int ks = 0; ks < 4; ++ks) xf[ks] = *(const LAS bf16x8*)(XS + tq * S5_X_STRIDE + 32 * ks + 8 * kg);
#pragma unroll
                        for (int tau = 0; tau < 2; ++tau) {
                            f32x4 y = __builtin_amdgcn_mfma_f32_16x16x32_bf16(vkf[tau][4], uf, (f32x4){0.f, 0.f, 0.f, 0.f}, 0, 0, 0);
#pragma unroll
                            for (int ks = 0; ks < 4; ++ks) y = __builtin_amdgcn_mfma_f32_16x16x32_bf16(vkf[tau][ks], xf[ks], y, 0, 0, 0);
                            YL[((T & 1) * 2 + tau) * 64 + lane] = y;
                        }
                    }
                }
                S5_BAR();
            }
        }
        __syncthreads();
    }
}

constexpr size_t WS_MCT = WS_MHS;
constexpr size_t WS_MN = WS_MG + 2359296;
constexpr size_t WS_MSC = WS_MN + 589824;
static_assert(WS_MSC + 2304 * 16 <= WS_MHS, "mLSTM small tables");
constexpr int ML_TS = 136;
constexpr int ML_DS = 72;

template <bool MAX>
__device__ __forceinline__ void scan128(LAS float* a, int lane) {
    const float v0 = a[2 * lane], v1 = a[2 * lane + 1];
    const float s = MAX ? fmaxf(v0, v1) : v0 + v1;
    float inc = s;
#pragma unroll
    for (int o = 1; o < 64; o <<= 1) { const float t = __shfl_up(inc, o); if (lane >= o) inc = MAX ? fmaxf(inc, t) : inc + t; }
    float exc = __shfl_up(inc, 1); if (lane == 0) exc = MAX ? -INFINITY : 0.f;
    a[2 * lane] = MAX ? fmaxf(exc, v0) : exc + v0; a[2 * lane + 1] = inc;
}

__device__ __forceinline__ void phase_ml_states(Frame& F) {
    const int tid = F.tid, lane = F.lane, w = F.wave, tq = lane & 15, kg = lane >> 4;
    const bf16* kb = (const bf16*)(F.ws + WS_MK); const bf16* vb = (const bf16*)(F.ws + WS_MV); const float* gb = (const float*)(F.ws + WS_MG);
    float* cT = (float*)(F.ws + WS_MCT); float* nl = (float*)(F.ws + WS_MN); float* sc = (float*)(F.ws + WS_MSC);
    LAS bf16* KeT = (LAS bf16*)(F.lds);
    LAS bf16* VT = (LAS bf16*)(F.lds + 64 * ML_TS * 2);
    LAS float* cumS = (LAS float*)(F.lds + 192 * ML_TS * 2);
    LAS float* igS = cumS + 128; LAS float* ewS = igS + 128; LAS float* red = ewS + 128;
    for (int us = F.blk; us < 2304; us += F.G) {
        const int jc = us % 18, bhd = us / 18, dir = bhd & 1, hd = (bhd >> 1) & 7, b = bhd >> 4;
        if (tid < 128) { const int r = seq_row(b, dir, 128 * jc + tid); igS[tid] = gb[(size_t)r * 32 + dir * 16 + hd]; cumS[tid] = log_sigmoidf_(gb[(size_t)r * 32 + dir * 16 + 8 + hd]); }
        __syncthreads();
        if (w == 0) {
            scan128<false>(cumS, lane);
            const float total = __shfl(cumS[2 * lane + 1], 63);
            const float w0 = total - cumS[2 * lane] + igS[2 * lane], w1 = total - cumS[2 * lane + 1] + igS[2 * lane + 1];
            const float ml = wave_max(fmaxf(w0, w1));
            ewS[2 * lane] = __expf(w0 - ml); ewS[2 * lane + 1] = __expf(w1 - ml);
            if (lane == 0) { sc[(size_t)us * 4] = total; sc[(size_t)us * 4 + 1] = ml; }
        }
        __syncthreads();
        { const int i = tid & 127, c = tid >> 7; const int r = seq_row(b, dir, 128 * jc + i); const float e = ewS[i];
#pragma unroll
          for (int h2 = 0; h2 < 2; ++h2) { const v4u kw = *(const v4u*)(kb + (size_t)r * 512 + hd * 64 + 16 * c + 8 * h2);
              const float kv[8] = {bflo(kw.x), bfhi(kw.x), bflo(kw.y), bfhi(kw.y), bflo(kw.z), bfhi(kw.z), bflo(kw.w), bfhi(kw.w)};
#pragma unroll
              for (int jj = 0; jj < 8; ++jj) KeT[(16 * c + 8 * h2 + jj) * ML_TS + i] = (bf16)f2bf(kv[jj] * e); }
#pragma unroll
          for (int h4 = 0; h4 < 4; ++h4) { const v4u vw = *(const v4u*)(vb + (size_t)r * 1024 + hd * 128 + 32 * c + 8 * h4);
              const unsigned vv[4] = {vw.x, vw.y, vw.z, vw.w};
#pragma unroll
              for (int jj = 0; jj < 8; ++jj) VT[(32 * c + 8 * h4 + jj) * ML_TS + i] = (bf16)((jj & 1) ? (vv[jj >> 1] >> 16) : (vv[jj >> 1] & 0xffffu)); } }
        __syncthreads();
#pragma unroll
        for (int dt = 0; dt < 4; ++dt) {
            f32x4 acc = (f32x4){0.f, 0.f, 0.f, 0.f};
#pragma unroll
            for (int ks = 0; ks < 4; ++ks) {
                const bf16x8 af = *(const LAS bf16x8*)(VT + (16 * w + tq) * ML_TS + 32 * ks + 8 * kg);
                const bf16x8 bfr = *(const LAS bf16x8*)(KeT + (16 * dt + tq) * ML_TS + 32 * ks + 8 * kg);
                acc = __builtin_amdgcn_mfma_f32_16x16x32_bf16(af, bfr, acc, 0, 0, 0);
            }
#pragma unroll
            for (int r = 0; r < 4; ++r) cT[(size_t)us * 8192 + (16 * w + 4 * kg + r) * 64 + 16 * dt + tq] = acc[r];
        }
        if (tid < 64) { float s = 0.f;
#pragma unroll
            for (int c8 = 0; c8 < 16; ++c8) { const v4u q = *(const LAS v4u*)(KeT + tid * ML_TS + 8 * c8); s += bflo(q.x) + bfhi(q.x) + bflo(q.y) + bfhi(q.y) + bflo(q.z) + bfhi(q.z) + bflo(q.w) + bfhi(q.w); }
            nl[(size_t)us * 64 + tid] = s; }
        __syncthreads();
    }
}

__device__ __forceinline__ void phase_ml_scan(Frame& F, const int skip = 0) {
    const int tid = F.tid;
    float* cT = (float*)(F.ws + WS_MCT); float* nl = (float*)(F.ws + WS_MN); float* sc = (float*)(F.ws + WS_MSC);
    for (int wi = F.blk; wi < 256; wi += F.G) {
        const int sq = wi >> 1, half = wi & 1; const bool don = (half == 0 && tid < 64);
        const size_t e0 = (size_t)half * 4096 + (size_t)tid * 8;
        f32x4 c0 = (f32x4){0.f, 0.f, 0.f, 0.f}, c1 = c0; float nn = 0.f, m = 0.f;
        size_t us = (size_t)sq * 18;
        f32x4 l0 = *(const f32x4*)(cT + us * 8192 + e0), l1 = *(const f32x4*)(cT + us * 8192 + e0 + 4);
        float ln = don ? nl[us * 64 + tid] : 0.f, tot = sc[us * 4], ml = sc[us * 4 + 1];
        for (int j = 0; j < 18; ++j, ++us) {
            const f32x4 a0 = l0, a1 = l1; const float an = ln, atot = tot, aml = ml;
            if (j + 1 < 18) { l0 = *(const f32x4*)(cT + (us + 1) * 8192 + e0); l1 = *(const f32x4*)(cT + (us + 1) * 8192 + e0 + 4); ln = don ? nl[(us + 1) * 64 + tid] : 0.f; tot = sc[(us + 1) * 4]; ml = sc[(us + 1) * 4 + 1]; }
            if (!skip) { *(f32x4*)(cT + us * 8192 + e0) = c0; *(f32x4*)(cT + us * 8192 + e0 + 4) = c1;
            if (don) nl[us * 64 + tid] = nn;
            if (half == 0 && tid == 0) sc[us * 4 + 2] = m; }
            const float mn = fmaxf(atot + m, aml), fa = __expf(atot + m - mn), fb = __expf(aml - mn);
            c0 = c0 * fa + a0 * fb; c1 = c1 * fa + a1 * fb; nn = nn * fa + an * fb; m = mn;
        }
    }
}

struct M3Regs { float gi, gf, n0v, m00, m01; v4u q[2], k[2], v[4]; };
__device__ __forceinline__ void m3_load(M3Regs& R, Frame& F, int u, int tid) {
    const bf16* kb = (const bf16*)(F.ws + WS_MK); const bf16* vb = (const bf16*)(F.ws + WS_MV); const bf16* qb = (const bf16*)(F.ws + WS_MQ);
    const float* gb = (const float*)(F.ws + WS_MG); const float* cT = (const float*)(F.ws + WS_MCT); const float* nl = (const float*)(F.ws + WS_MN); const float* sc = (const float*)(F.ws + WS_MSC);
    const int jo = u % 18, bh = u / 18, hd = bh & 7, b = bh >> 3;
    const int row0 = (jo < 2) ? b * CTX + 128 * jo : TC + b * SEQ + 128 * (jo - 2);
    const int jc1 = (jo < 2) ? 1 - jo : 19 - jo;
    const size_t us0 = (size_t)((b * 8 + hd) * 2 + 0) * 18 + jo, us1 = (size_t)((b * 8 + hd) * 2 + 1) * 18 + jc1;
    R.m00 = sc[us0 * 4 + 2]; R.m01 = sc[us1 * 4 + 2];
    R.gi = 0.f; R.gf = 0.f; R.n0v = 0.f;
    if (tid < 256) { const int dd = tid >> 7, sp = tid & 127; const int r = row0 + (dd ? 127 - sp : sp); R.gi = gb[(size_t)r * 32 + dd * 16 + hd]; R.gf = gb[(size_t)r * 32 + dd * 16 + 8 + hd]; }
    { const int i = tid & 127, c = tid >> 7; const int r = row0 + i;
#pragma unroll
      for (int h2 = 0; h2 < 2; ++h2) { R.q[h2] = *(const v4u*)(qb + (size_t)r * 512 + hd * 64 + 16 * c + 8 * h2); R.k[h2] = *(const v4u*)(kb + (size_t)r * 512 + hd * 64 + 16 * c + 8 * h2); } }
    { const int tp = tid & 63, c8 = tid >> 6;
#pragma unroll
      for (int tk = 0; tk < 2; ++tk)
#pragma unroll
          for (int h2 = 0; h2 < 2; ++h2) R.v[2 * tk + h2] = *(const v4u*)(vb + (size_t)(row0 + 2 * tp + tk) * 1024 + hd * 128 + 16 * c8 + 8 * h2); }
    if (tid < 128) R.n0v = nl[((tid >> 6) ? us1 : us0) * 64 + (tid & 63)];
}
__device__ __forceinline__ void phase_ml_out(Frame& F) {
    const int tid = F.tid, lane = F.lane, w = F.wave, tq = lane & 15, kg = lane >> 4;
    const bf16* ob = (const bf16*)(F.ws + WS_MO); bf16* zb = (bf16*)(F.ws + WS_Z);
    LAS bf16* QL = (LAS bf16*)(F.lds);
    LAS bf16* KL = (LAS bf16*)(F.lds + 18432);
    LAS bf16* SwL = (LAS bf16*)(F.lds + w * (16 * ML_TS * 2));
    LAS bf16* VT = (LAS bf16*)(F.lds + 36864);
    LAS bf16* C0T = (LAS bf16*)(F.lds + 36864 + 128 * ML_TS * 2);
    LAS float* GT = (LAS float*)(F.lds + 36864 + 128 * ML_TS * 2 + 2 * 144 * ML_DS * 2);
    static_assert(36864 + 128 * ML_TS * 2 + 2 * 144 * ML_DS * 2 + 2 * 3 * 128 * 4 <= RING_BYTES, "M3 LDS");
    for (int i = tid; i < 2 * 16 * ML_DS; i += NTHR) { const int dd = i / (16 * ML_DS), ii = i % (16 * ML_DS); C0T[dd * 144 * ML_DS + 128 * ML_DS + ii] = (bf16)0u; }
    constexpr int NU = NB * 8 * 18;
    M3Regs R;
    if (F.blk < NU) m3_load(R, F, F.blk, tid);
    __syncthreads();
    for (int u = F.blk; u < NU; u += F.G) {
        const int jo = u % 18, bh = u / 18, hd = bh & 7, b = bh >> 3;
        const int row0 = (jo < 2) ? b * CTX + 128 * jo : TC + b * SEQ + 128 * (jo - 2);
        const float m00 = R.m00, m01 = R.m01;
        if (tid < 256) { const int dd = tid >> 7, sp = tid & 127; GT[dd * 384 + sp] = R.gi; GT[dd * 384 + 256 + sp] = log_sigmoidf_(R.gf); }
        { const int i = tid & 127, c = tid >> 7;
#pragma unroll
          for (int h2 = 0; h2 < 2; ++h2) { *(LAS v4u*)(QL + i * ML_DS + 16 * c + 8 * h2) = R.q[h2]; *(LAS v4u*)(KL + i * ML_DS + 16 * c + 8 * h2) = R.k[h2]; } }
        { const int tp = tid & 63, c8 = tid >> 6;
#pragma unroll
          for (int h2 = 0; h2 < 2; ++h2) { const v4u a = R.v[h2], bq = R.v[2 + h2]; const unsigned av[4] = {a.x, a.y, a.z, a.w}, bv[4] = {bq.x, bq.y, bq.z, bq.w};
#pragma unroll
              for (int jj = 0; jj < 8; ++jj) { const unsigned lo = (jj & 1) ? (av[jj >> 1] >> 16) : (av[jj >> 1] & 0xffffu), hi = (jj & 1) ? (bv[jj >> 1] & 0xffff0000u) : (bv[jj >> 1] << 16);
                  *(LAS unsigned*)(VT + (16 * c8 + 8 * h2 + jj) * ML_TS + 2 * tp) = lo | hi; } } }
        { const float* cT = (const float*)(F.ws + WS_MCT); const int jc1 = (jo < 2) ? 1 - jo : 19 - jo;
          const size_t us0 = (size_t)((b * 8 + hd) * 2 + 0) * 18 + jo, us1 = (size_t)((b * 8 + hd) * 2 + 1) * 18 + jc1;
#pragma unroll
          for (int dd = 0; dd < 2; ++dd) { const size_t us = dd ? us1 : us0; const int jv = tid >> 2, dq = (tid & 3) * 16; const float* src = cT + us * 8192 + jv * 64 + dq;
#pragma unroll
              for (int h2 = 0; h2 < 2; ++h2) { const f32x4 a = *(const f32x4*)(src + 8 * h2), bq = *(const f32x4*)(src + 8 * h2 + 4);
                  v4u o; o.x = pk2(a.x, a.y); o.y = pk2(a.z, a.w); o.z = pk2(bq.x, bq.y); o.w = pk2(bq.z, bq.w);
                  *(LAS v4u*)(C0T + dd * 144 * ML_DS + jv * ML_DS + dq + 8 * h2) = o; } } }
        if (tid < 128) C0T[(tid >> 6) * 144 * ML_DS + 128 * ML_DS + (tid & 63)] = (bf16)f2bf(R.n0v);
        __syncthreads();
        if (u + F.G < NU) m3_load(R, F, u + F.G, tid);
        if (w < 2) {
            LAS float* gS = GT + w * 384; LAS float* mmS = gS + 128; LAS float* cumS = gS + 256; const float m0 = w ? m01 : m00;
            scan128<false>(cumS, lane);
            const float g0 = gS[2 * lane] - cumS[2 * lane], g1 = gS[2 * lane + 1] - cumS[2 * lane + 1];
            gS[2 * lane] = g0; gS[2 * lane + 1] = g1; mmS[2 * lane] = g0; mmS[2 * lane + 1] = g1;
            scan128<true>(mmS, lane);
            mmS[2 * lane] = fmaxf(mmS[2 * lane], m0); mmS[2 * lane + 1] = fmaxf(mmS[2 * lane + 1], m0);
        }
        __syncthreads();
        bf16x8 qf[2];
#pragma unroll
        for (int ks = 0; ks < 2; ++ks) qf[ks] = *(const LAS bf16x8*)(QL + (16 * w + tq) * ML_DS + 32 * ks + 8 * kg);
        float mm0r[4], mm1r[4], ai0[4], ai1[4], lb0[4], lb1[4];
#pragma unroll
        for (int r = 0; r < 4; ++r) { const int t0 = 16 * w + 4 * kg + r, t1 = 127 - t0;
            mm0r[r] = GT[128 + t0]; ai0[r] = __expf(m00 - mm0r[r]); lb0[r] = __expf(-GT[256 + t0] - mm0r[r]);
            mm1r[r] = GT[384 + 128 + t1]; ai1[r] = __expf(m01 - mm1r[r]); lb1[r] = __expf(-GT[384 + 256 + t1] - mm1r[r]); }
        f32x4 sraw[8]; float rs0[4] = {0.f, 0.f, 0.f, 0.f}, rs1[4] = {0.f, 0.f, 0.f, 0.f};
#pragma unroll
        for (int ct = 0; ct < 8; ++ct) {
            f32x4 a = (f32x4){0.f, 0.f, 0.f, 0.f};
#pragma unroll
            for (int ks = 0; ks < 2; ++ks) a = __builtin_amdgcn_mfma_f32_16x16x32_bf16(qf[ks], *(const LAS bf16x8*)(KL + (16 * ct + tq) * ML_DS + 32 * ks + 8 * kg), a, 0, 0, 0);
            sraw[ct] = a;
            const int o = 16 * ct + tq; const float g0o = GT[o], g1o = GT[384 + 127 - o];
#pragma unroll
            for (int r = 0; r < 4; ++r) { const int t0 = 16 * w + 4 * kg + r;
                rs0[r] += (o <= t0) ? a[r] * __expf(g0o - mm0r[r]) : 0.f; rs1[r] += (o >= t0) ? a[r] * __expf(g1o - mm1r[r]) : 0.f; }
        }
        f32x4 acc[8]; float sc0[4], sc1[4];
        {
            f32x4 q0 = (f32x4){0.f, 0.f, 0.f, 0.f}, q1 = q0;
#pragma unroll
            for (int ks = 0; ks < 2; ++ks) { q0 = __builtin_amdgcn_mfma_f32_16x16x32_bf16(qf[ks], *(const LAS bf16x8*)(C0T + (128 + tq) * ML_DS + 32 * ks + 8 * kg), q0, 0, 0, 0);
                                             q1 = __builtin_amdgcn_mfma_f32_16x16x32_bf16(qf[ks], *(const LAS bf16x8*)(C0T + 144 * ML_DS + (128 + tq) * ML_DS + 32 * ks + 8 * kg), q1, 0, 0, 0); }
#pragma unroll
            for (int r = 0; r < 4; ++r) {
                const float qn0 = red16_sum(q0[r]), qn1 = red16_sum(q1[r]);
                const float den0 = ai0[r] * qn0 + red16_sum(rs0[r]), den1 = ai1[r] * qn1 + red16_sum(rs1[r]);
                const float inv0 = __builtin_amdgcn_rcpf(fmaxf(fabsf(den0), lb0[r])), inv1 = __builtin_amdgcn_rcpf(fmaxf(fabsf(den1), lb1[r]));
                rs0[r] = inv0; rs1[r] = inv1; sc0[r] = ai0[r] * inv0; sc1[r] = ai1[r] * inv1; }
        }
#pragma unroll
        for (int ct = 0; ct < 8; ++ct) {
            f32x4 a0 = (f32x4){0.f, 0.f, 0.f, 0.f}, a1 = a0;
#pragma unroll
            for (int ks = 0; ks < 2; ++ks) { a0 = __builtin_amdgcn_mfma_f32_16x16x32_bf16(qf[ks], *(const LAS bf16x8*)(C0T + (16 * ct + tq) * ML_DS + 32 * ks + 8 * kg), a0, 0, 0, 0);
                                             a1 = __builtin_amdgcn_mfma_f32_16x16x32_bf16(qf[ks], *(const LAS bf16x8*)(C0T + 144 * ML_DS + (16 * ct + tq) * ML_DS + 32 * ks + 8 * kg), a1, 0, 0, 0); }
#pragma unroll
            for (int r = 0; r < 4; ++r) acc[ct][r] = a0[r] * sc0[r] + a1[r] * sc1[r];
        }
        __syncthreads();
#pragma unroll
        for (int ct = 0; ct < 8; ++ct) { const int o = 16 * ct + tq; const float g0o = GT[o], g1o = GT[384 + 127 - o];
#pragma unroll
            for (int r = 0; r < 4; ++r) { const int t0 = 16 * w + 4 * kg + r;
                const float x0 = (o <= t0) ? __expf(g0o - mm0r[r]) * rs0[r] : 0.f, x1 = (o >= t0) ? __expf(g1o - mm1r[r]) * rs1[r] : 0.f;
                SwL[(4 * kg + r) * ML_TS + 16 * ct + tq] = (bf16)f2bf(sraw[ct][r] * (x0 + x1)); } }
#pragma unroll
        for (int ks = 0; ks < 4; ++ks) {
            const bf16x8 af = *(const LAS bf16x8*)(SwL + tq * ML_TS + 32 * ks + 8 * kg);
#pragma unroll
            for (int ct = 0; ct < 8; ++ct) acc[ct] = __builtin_amdgcn_mfma_f32_16x16x32_bf16(af, *(const LAS bf16x8*)(VT + (16 * ct + tq) * ML_TS + 32 * ks + 8 * kg), acc[ct], 0, 0, 0);
        }
        float ss[4] = {0.f, 0.f, 0.f, 0.f};
#pragma unroll
        for (int ct = 0; ct < 8; ++ct) { ss[0] += acc[ct].x * acc[ct].x; ss[1] += acc[ct].y * acc[ct].y; ss[2] += acc[ct].z * acc[ct].z; ss[3] += acc[ct].w * acc[ct].w; }
#pragma unroll
        for (int r = 0; r < 4; ++r) ss[r] = rsqrtf(red16_sum(ss[r]) * (1.f / 128.f) + EPS);
#pragma unroll
        for (int ct = 0; ct < 8; ++ct) { const float gn = F.in[IN_MLNG][hd * 128 + 16 * ct + tq];
#pragma unroll
            for (int r = 0; r < 4; ++r) SwL[(4 * kg + r) * ML_TS + 16 * ct + tq] = (bf16)f2bf(acc[ct][r] * ss[r] * gn); }
#pragma unroll
        for (int i = 0; i < 4; ++i) { const int rr = 4 * i + kg, ch = tq;
            const v4u hv = *(const LAS v4u*)(SwL + rr * ML_TS + 8 * ch);
            const size_t idx = (size_t)(row0 + 16 * w + rr) * D + hd * 128 + 8 * ch;
            const v4u ov = *(const v4u*)(ob + idx);
            v4u zo; zo.x = pk2(bflo(hv.x) * sigmoidf_(bflo(ov.x)), bfhi(hv.x) * sigmoidf_(bfhi(ov.x))); zo.y = pk2(bflo(hv.y) * sigmoidf_(bflo(ov.y)), bfhi(hv.y) * sigmoidf_(bfhi(ov.y)));
            zo.z = pk2(bflo(hv.z) * sigmoidf_(bflo(ov.z)), bfhi(hv.z) * sigmoidf_(bfhi(ov.z))); zo.w = pk2(bflo(hv.w) * sigmoidf_(bflo(ov.w)), bfhi(hv.w) * sigmoidf_(bfhi(ov.w)));
            *(v4u*)(zb + idx) = zo; }
        __syncthreads();
    }
}

#ifndef USE_NAIVE_ATTN
#define USE_NAIVE_ATTN 0
#endif
#ifndef USE_NAIVE_S5
#define USE_NAIVE_S5 0
#endif
#ifndef USE_NAIVE_MLSTM
#define USE_NAIVE_MLSTM 0
#endif
#ifndef MK_MODE
#define MK_MODE 0
#endif
struct Args { const float* in[N_INPUTS]; float* out; unsigned char* ws; int ph_lo, ph_hi; };
enum { CBASE = __COUNTER__ + 1 };
#ifndef S5VAR
#define S5VAR 0
#endif
#ifndef DUP_A
#define DUP_A -1
#endif
#ifndef DUP_B
#define DUP_B -1
#endif
#define PHASE_IDS() { int t_ = threadIdx.x; asm volatile("" : "+v"(t_)); F.tid = t_; F.lane = t_ & 63; F.wave = __builtin_amdgcn_readfirstlane(t_ >> 6); }
#ifndef SW_PHASE
#define SW_PHASE -1
#endif
#define PHASE(...) { constexpr int k_ = __COUNTER__ - CBASE; if (lo <= k_ && k_ < hi) { PHASE_IDS() unsigned long long swt_ = 0; if (k_ == SW_PHASE) swt_ = __builtin_amdgcn_s_memtime(); \
    { constexpr int rep_ = 0; (void)rep_; __VA_ARGS__ } \
    if constexpr (k_ == DUP_A || k_ == DUP_B) { xcd_barrier(bar); { constexpr int rep_ = 1; (void)rep_; __VA_ARGS__ } } \
    if (k_ + 1 < hi) xcd_barrier(bar); \
    if (k_ == SW_PHASE && F.blk == 0 && threadIdx.x == 0) F.ctl[64] = (unsigned)((__builtin_amdgcn_s_memtime() - swt_) >> 4); } }

__global__ void __launch_bounds__(NTHR, 2) fwd_kernel(Args args) {
    extern __shared__ __attribute__((aligned(16))) unsigned char lds[];
    Frame F;
    F.lds = (LAS unsigned char*)lds;
    F.MISC = (volatile LAS unsigned*)(F.lds + MISC_OFF);
    F.tid = threadIdx.x; F.lane = F.tid & 63; F.wave = __builtin_amdgcn_readfirstlane(F.tid >> 6);
    F.G = gridDim.x; F.blk = blockIdx.x;
    F.ws = args.ws; F.out = args.out; F.ctl = (unsigned*)(args.ws + WS_CTL);
#pragma unroll
    for (int i = 0; i < N_INPUTS; ++i) F.in[i] = args.in[i];
    for (int u = F.tid; u < (LDS_BYTES - LDSCTL_OFF) / 4; u += NTHR) ((LAS unsigned*)(F.lds + LDSCTL_OFF))[u] = 0u;
    __syncthreads();
    const int lo = args.ph_lo, hi = args.ph_hi;
    XcdBarrier bar; bar.bar = F.ctl + CW_BAR; bar.x = 0; bar.st = nullptr;
    if (hi - lo > 1) bar = xcd_barrier_post(F.ctl + CW_BAR, F.MISC + 8);

    unsigned char* ws = F.ws;
    bf16* xres = (bf16*)(ws + WS_XRES); const float* mod = (const float*)(ws + WS_MOD);
    bf16* hb = (bf16*)(ws + WS_H); bf16* zb = (bf16*)(ws + WS_Z);
    const LAS int* etab = (const LAS int*)(F.lds + ETAB_OFF);

#define MOE_PHASES(L) \
    PHASE(phase_n2<L>(F, rep_);) \
    PHASE({ load_etab(F, L); pg8::Gemm g{(const bf16*)(ws + WS_H), (const bf16*)(ws + WS_WG1) + (size_t)(L) * NEXP * 1024 * 1024, SLOTS, NEXP * 1024, 1024, (const int*)(ws + WS_SLOTRE)}; \
               MoeSched S{etab, F.G, F.blk, 4}; EpiG1 E{(bf16*)(ws + WS_HID)}; run_gemm_gather(F, g, S, E); }) \
    PHASE({ load_etab(F, L); pg8::Gemm g{(const bf16*)(ws + WS_HID), (const bf16*)(ws + WS_WG2) + (size_t)(L) * NEXP * 1024 * 512, SLOTS, NEXP * 1024, 512}; \
               MoeSched S{etab, F.G, F.blk, 4}; EpiG2 E{(bf16*)(ws + WS_Y2), (const float*)(ws + WS_SLOTWE)}; run_gemm(F, g, S, E); })

    PHASE(phase_prologue(F);)
    PHASE(phase_a1<0>(F, rep_);)
#if USE_NAIVE_S5
    PHASE(phase_s5_naive<0, true>(F);)
    PHASE(phase_s5_combine<0, true>(F);)
#else
    PHASE(phase_s5_fast<0, true>(F);)
#endif
    PHASE({ pg8::Gemm g{zb, (const bf16*)(ws + WS_WGLU), T, 2048, 1024}; DenseSchedH S; S.init(T, 2048, F.G, F.blk, 0);
               EpiGlu E{xres, mod + 0 * 9 * 6144 + 2048, F.in[IN_S5BGLU], rep_}; run_gemm(F, g, S, E); })
    MOE_PHASES(0)
    PHASE(phase_a1<1>(F, rep_);)
    PHASE({ pg8::Gemm g{hb, (const bf16*)(ws + WS_WKVQ), T, 1536, 1024}; DenseSched S; S.init(T, 1536, F.G, F.blk, 0);
               EpiKvq E{(bf16*)(ws + WS_QB), (bf16*)(ws + WS_KB), (bf16*)(ws + WS_VB), F.in[IN_AQG], F.in[IN_AKG], (const float*)(ws + WS_ROPE)}; run_gemm(F, g, S, E); })
#if USE_NAIVE_ATTN
    PHASE(phase_attn_naive<true>(F);)
#else
    PHASE(phase_attn_fast<true>(F, (char*)lds);)
#endif
    PHASE({ pg8::Gemm g{zb, (const bf16*)(ws + WS_WO), T, 1024, 1024}; DenseSchedH S; S.init(T, 1024, F.G, F.blk, 0);
               EpiRes E{xres, mod + 1 * 9 * 6144 + 2048, rep_, (bf16*)(ws + WS_MIX)}; run_gemm(F, g, S, E); })
    MOE_PHASES(1)
    PHASE(phase_a1<2>(F, rep_);)
    PHASE({ pg8::Gemm g{hb, (const bf16*)(ws + WS_WIN), T, ML_NIN, 1024}; DenseSched S; S.init(T, ML_NIN, F.G, F.blk, 0);
               EpiMlIn E{(bf16*)(ws + WS_MK), (bf16*)(ws + WS_MV), (bf16*)(ws + WS_MQ), (bf16*)(ws + WS_MO), (float*)(ws + WS_MG), F.in[IN_MLBG]}; run_gemm(F, g, S, E); })
#if USE_NAIVE_MLSTM
    PHASE(phase_mlstm_naive<true>(F);)
    PHASE(phase_mlstm_combine<true>(F);)
#else
    PHASE(phase_ml_states(F);)
    PHASE(phase_ml_scan(F, rep_);)
    PHASE(phase_ml_out(F);)
#endif
    PHASE({ pg8::Gemm g{zb, (const bf16*)(ws + WS_WOUT), T, 1024, 1024}; DenseSchedH S; S.init(T, 1024, F.G, F.blk, 0);
               EpiRes E{xres, mod + 2 * 9 * 6144 + 2048, rep_, (bf16*)(ws + WS_MHS)}; run_gemm(F, g, S, E); })
    MOE_PHASES(2)
    PHASE(phase_a1<3>(F, rep_);)
#if USE_NAIVE_S5
    PHASE(phase_s5_naive<1, false>(F);)
    PHASE(phase_s5_combine<1, false>(F);)
#else
    PHASE(phase_s5_fast<1, false>(F);)
#endif
    PHASE({ pg8::Gemm g{zb, (const bf16*)(ws + WS_WGLU) + (size_t)2048 * 1024, T, 2048, 1024}; DenseSched S; S.init(TL, 2048, F.G, F.blk, TC / 256);
               EpiGlu E{xres, mod + 3 * 9 * 6144 + 2048, F.in[IN_S5BGLU] + 2048, rep_}; run_gemm(F, g, S, E); })
    MOE_PHASES(3)
    PHASE(phase_fin(F);)
#if SW_PHASE >= 0
    if (F.blk == 0 && threadIdx.x == 0) { const unsigned v = __hip_atomic_load(F.ctl + 64, __ATOMIC_RELAXED, __HIP_MEMORY_SCOPE_AGENT); const unsigned long long t0 = __builtin_amdgcn_s_memtime();
        while (__builtin_amdgcn_s_memtime() - t0 < (unsigned long long)v * 16ull * 16ull) __builtin_amdgcn_s_sleep(8); }
#endif
}
constexpr int NPH = __COUNTER__ - CBASE;

extern "C" void kernel_launch(void* const* d_in, const int* in_sizes, int n_in, void* d_out, int out_size, void* d_ws, size_t ws_size, hipStream_t stream) {
    static int grid = 0;
    if (grid == 0) {
        if (n_in != N_INPUTS || out_size != TL * D || ws_size < WS_END) { fprintf(stderr, "kernel_launch: unexpected problem: n_in %d out %d ws %zu (need %zu)\n", n_in, out_size, ws_size, (size_t)WS_END); grid = -1; return; }
        int dev = 0, cus = 0, per_cu = 0;
        if (hipGetDevice(&dev) != hipSuccess || hipDeviceGetAttribute(&cus, hipDeviceAttributeMultiprocessorCount, dev) != hipSuccess) { grid = -1; return; }
        if (hipFuncSetAttribute((const void*)fwd_kernel, hipFuncAttributeMaxDynamicSharedMemorySize, LDS_BYTES) != hipSuccess) { fprintf(stderr, "kernel_launch: hipFuncSetAttribute failed\n"); grid = -1; return; }
        if (hipOccupancyMaxActiveBlocksPerMultiprocessor(&per_cu, (const void*)fwd_kernel, NTHR, LDS_BYTES) != hipSuccess || per_cu < 1) fprintf(stderr, "kernel_launch: occupancy query reports %d\n", per_cu);
        (void)hipGetLastError();
        grid = cus;
        if (grid > 256) grid = 256;
    }
    if (grid < 0) return;
    if (hipMemsetAsync((char*)d_ws + WS_CTL, 0, CTL_ZERO_BYTES, stream) != hipSuccess) return;
    Args a{};
    for (int i = 0; i < N_INPUTS; ++i) a.in[i] = (const float*)d_in[i];
    a.out = (float*)d_out; a.ws = (unsigned char*)d_ws;
#if MK_MODE == 0
    a.ph_lo = 0; a.ph_hi = NPH;
    hipLaunchKernelGGL(fwd_kernel, dim3(grid), dim3(NTHR), LDS_BYTES, stream, a);
#else
    for (int p = 0; p < NPH; ++p) { a.ph_lo = p; a.ph_hi = p + 1; hipLaunchKernelGGL(fwd_kernel, dim3(grid), dim3(NTHR), LDS_BYTES, stream, a); }
#endif
}
```

```cpp
#include <hip/hip_runtime.h>
#include <cstdio>
#include <cstdint>

#define GAS __attribute__((address_space(1)))
#define LAS __attribute__((address_space(3)))
typedef unsigned short bf16;
typedef unsigned v4u __attribute__((ext_vector_type(4)));
typedef unsigned v2u __attribute__((ext_vector_type(2)));
typedef float f32x4 __attribute__((ext_vector_type(4)));
typedef float f32x2 __attribute__((ext_vector_type(2)));
typedef short bf16x8 __attribute__((ext_vector_type(8)));

constexpr int D = 1024, NB = 8, SEQ = 2048, CTX = 256, DEPTH = 4;
constexpr int TC = NB * CTX;
constexpr int TL = NB * SEQ;
constexpr int T = TC + TL;
constexpr int KVLEN = SEQ + CTX;
constexpr int NEXP = 16, DFF = 512;
constexpr int SLOTS = 40960;
constexpr int ML_NIN = 3328;
constexpr float EPS = 1e-6f;
constexpr int NWAVES = 8, NTHR = 512;
constexpr float ATT_C2 = 0.125f * 1.4426950408889634f;

constexpr size_t MiB = 1u << 20;
constexpr size_t WS_CTL = 0, CTL_ZERO_BYTES = 1 * MiB;
constexpr size_t WS_MOD = 1 * MiB;
constexpr size_t WS_ROPE = 2 * MiB;
constexpr size_t WS_TOKE = 2 * MiB + 65536;
constexpr size_t WS_TOKR = WS_TOKE + 163840;
constexpr size_t WS_TOKW = WS_TOKR + 163840;
constexpr size_t WS_TOKS = WS_TOKW + 163840;
constexpr size_t WS_BCNT = WS_TOKS + 163840;
constexpr size_t WS_ETAB = WS_BCNT + 16384;
constexpr size_t WS_SLOTW = WS_ETAB + 4096;
static_assert(WS_SLOTW + 163840 + 65536 <= 4 * MiB, "small tables");
constexpr int CTL_GCNT = 8192;
constexpr size_t WS_WGLU = 4 * MiB;
constexpr size_t WS_WKVQ = WS_WGLU + 8 * MiB;
constexpr size_t WS_WO = WS_WKVQ + 3 * MiB;
constexpr size_t WS_WIN = WS_WO + 2 * MiB;
constexpr size_t WS_WOUT = WS_WIN + 7 * MiB;
constexpr size_t WS_WG1 = WS_WOUT + 2 * MiB;
constexpr size_t WS_WG2 = WS_WG1 + 128 * MiB;
constexpr size_t WS_XRES = WS_WG2 + 64 * MiB;
constexpr size_t WS_H = WS_XRES + 72 * MiB;
constexpr size_t WS_Z = WS_H + 36 * MiB;
constexpr size_t WS_MIX = WS_Z + 36 * MiB;
constexpr size_t WS_HS = WS_MIX;
constexpr size_t WS_SLOTRE = WS_HS;
constexpr size_t WS_RWF = WS_SLOTW + 163840;
constexpr size_t WS_HID = WS_HS + 80 * MiB;
constexpr size_t WS_Y2 = WS_HID + 40 * MiB;
constexpr size_t WS_END = WS_Y2 + 80 * MiB;
constexpr size_t WS_YSUM = WS_MIX;
constexpr size_t WS_QB = WS_MIX;
constexpr size_t WS_KB = WS_QB + 36 * MiB;
constexpr size_t WS_VB = WS_KB + 9 * MiB;
constexpr size_t WS_MK = WS_MIX;
constexpr size_t WS_MV = WS_MK + 18 * MiB;
constexpr size_t WS_MQ = WS_MV + 36 * MiB;
constexpr size_t WS_MO = WS_MQ + 18 * MiB;
constexpr size_t WS_MG = WS_MO + 36 * MiB;
constexpr size_t WS_MHS = WS_MG + 3 * MiB;
static_assert(WS_MHS + 72 * MiB <= WS_END, "mLSTM view fits");
static_assert(WS_END <= 600 * MiB, "workspace budget");

constexpr int CW_BAR = 4096;

constexpr int RING_OFF = 0, RING_BYTES = 131072;
constexpr int LDSCTL_OFF = RING_BYTES, MISC_OFF = LDSCTL_OFF + 320;
constexpr int ETAB_OFF = MISC_OFF + 128;
constexpr int SCT_OFF = ETAB_OFF + 256;
constexpr int LDS_BYTES = 147456;
static_assert(SCT_OFF + 256 <= LDS_BYTES, "LDS map");

#define LDS_WAIT() asm volatile("s_waitcnt lgkmcnt(0)" ::: "memory")
#define VM_WAIT() asm volatile("s_waitcnt vmcnt(0)" ::: "memory")
__device__ __forceinline__ unsigned f2bf(float f) { unsigned u = __builtin_bit_cast(unsigned, f); return (u + 0x7fffu + ((u >> 16) & 1u)) >> 16; }
typedef float f32x2_cv __attribute__((ext_vector_type(2))); typedef __bf16 bf16x2_cv __attribute__((ext_vector_type(2)));
__device__ __forceinline__ unsigned pk2(float lo, float hi) { f32x2_cv v = {lo, hi}; bf16x2_cv b = __builtin_convertvector(v, bf16x2_cv); return __builtin_bit_cast(unsigned, b); }
__device__ __forceinline__ float bf2f(unsigned h) { return __builtin_bit_cast(float, h << 16); }
__device__ __forceinline__ float bflo(unsigned w) { return __builtin_bit_cast(float, w << 16); }
__device__ __forceinline__ float bfhi(unsigned w) { return __builtin_bit_cast(float, w & 0xffff0000u); }
template <int CTRL, int RMASK = 0xF>
__device__ __forceinline__ float dpp_f(float oldv, float v) { return __builtin_bit_cast(float, __builtin_amdgcn_update_dpp(__builtin_bit_cast(int, oldv), __builtin_bit_cast(int, v), CTRL, RMASK, 0xF, false)); }
#ifndef USE_SHFL_XOR
#define USE_SHFL_XOR 0
#endif
#ifndef USE_SHFL_PARTIAL
#define USE_SHFL_PARTIAL 0
#endif
__device__ __forceinline__ float red16_sum(float v) {
#if USE_SHFL_PARTIAL
    for (int o = 1; o < 16; o <<= 1) v += __shfl_xor(v, o);
    return v;
#endif
    v += dpp_f<0xB1>(0.f, v); v += dpp_f<0x4E>(0.f, v); v += dpp_f<0x141>(0.f, v); v += dpp_f<0x140>(0.f, v); return v; }
__device__ __forceinline__ float red16_max(float v) {
    v = fmaxf(v, dpp_f<0xB1>(v, v)); v = fmaxf(v, dpp_f<0x4E>(v, v)); v = fmaxf(v, dpp_f<0x141>(v, v)); v = fmaxf(v, dpp_f<0x140>(v, v)); return v; }
#ifndef USE_SHFL_REDUCE
#define USE_SHFL_REDUCE 0
#endif
__device__ __forceinline__ float wave_sum(float v) {
#if USE_SHFL_REDUCE
    for (int o = 1; o < 64; o <<= 1) v += __shfl_xor(v, o);
    return v;
#endif
    v = red16_sum(v); v += dpp_f<0x142, 0xA>(0.f, v); v += dpp_f<0x143, 0xC>(0.f, v);
    return __builtin_bit_cast(float, __builtin_amdgcn_readlane(__builtin_bit_cast(int, v), 63)); }
__device__ __forceinline__ float wave_max(float v) {
    v = red16_max(v); v = fmaxf(v, dpp_f<0x142, 0xA>(v, v)); v = fmaxf(v, dpp_f<0x143, 0xC>(v, v));
    return __builtin_bit_cast(float, __builtin_amdgcn_readlane(__builtin_bit_cast(int, v), 63)); }
__device__ __forceinline__ float xor16_sum(float v) { return v + __shfl_xor(v, 16); }
__device__ __forceinline__ float xor32_sum(float v) { return v + __shfl_xor(v, 32); }
__device__ __forceinline__ float sigmoidf_(float x) { return __builtin_amdgcn_rcpf(1.f + __expf(-x)); }
__device__ __forceinline__ float siluf_(float x) { return x * __builtin_amdgcn_rcpf(1.f + __expf(-x)); }
__device__ __forceinline__ float gelu_tanh(float x) {
    const float p = __builtin_fmaf(x * x, 0.044715f, 1.0f);
    const float e = __builtin_amdgcn_exp2f((x * -2.302208198f) * p);
    return x * __builtin_amdgcn_rcpf(1.0f + e);
}
__device__ __forceinline__ float log_sigmoidf_(float x) { return fminf(x, 0.f) - __logf(1.f + __expf(-fabsf(x))); }
__device__ __forceinline__ void sincos_d(double a, double& s, double& c) {
    const double k = __builtin_rint(a * 0.63661977236758134308);
    double r = __builtin_fma(-k, 1.57079632679489655800e+00, a);
    r = __builtin_fma(-k, 6.12323399573676603587e-17, r);
    const double r2 = r * r;
    double sp = -1.0 / 1307674368000.0;
    sp = sp * r2 + 1.0 / 6227020800.0; sp = sp * r2 - 1.0 / 39916800.0; sp = sp * r2 + 1.0 / 362880.0; sp = sp * r2 - 1.0 / 5040.0; sp = sp * r2 + 1.0 / 120.0; sp = sp * r2 - 1.0 / 6.0;
    const double sr = r + r * r2 * sp;
    double cp = 1.0 / 20922789888000.0;
    cp = cp * r2 - 1.0 / 87178291200.0; cp = cp * r2 + 1.0 / 479001600.0; cp = cp * r2 - 1.0 / 3628800.0; cp = cp * r2 + 1.0 / 40320.0; cp = cp * r2 - 1.0 / 720.0; cp = cp * r2 + 1.0 / 24.0; cp = cp * r2 - 0.5;
    const double cr = 1.0 + r2 * cp;
    const int q = ((int)k) & 3;
    s = (q == 0) ? sr : (q == 1) ? cr : (q == 2) ? -sr : -cr;
    c = (q == 0) ? cr : (q == 1) ? -sr : (q == 2) ? -cr : sr;
}
__device__ __forceinline__ int mrow_of(int r) { return r < TC ? 8 : ((r - TC) >> 11); }
namespace pg8 {
#define PG8_LAS __attribute__((address_space(3)))
typedef unsigned short bf16_t;
typedef short bf16x8 __attribute__((ext_vector_type(8)));
typedef float f32x4 __attribute__((ext_vector_type(4)));
typedef unsigned u32x4 __attribute__((ext_vector_type(4)));
constexpr int BM = 256, BK = 64, HALF = 128, HTB = HALF * BK * 2  , STAGE_BYTES = 8 * HTB, NXCD = 8, WGM = 8;

__host__ __device__ __forceinline__ int lds_byte(int r, int c) { const int st = (r >> 4) * 2 + (c >> 5), rr = r & 15, cc = c & 31, ob = rr * 64 + cc * 2; return st * 1024 + (ob ^ (((ob >> 9) & 1) << 5)); }
__host__ __device__ __forceinline__ void stage_rc(int b, int& R, int& C) { const int st = b / 1024, sb = b % 1024, swz = sb ^ (((sb >> 9) & 1) << 5); R = (st >> 1) * 16 + swz / 64; C = (st & 1) * 32 + (swz % 64) / 2; }
__host__ __device__ __forceinline__ int perm32(int rho) { const int n = rho >> 4, i = rho & 15; return 8 * (i >> 2) + 4 * n + (i & 3); }

struct Unit { int pm, pn, half, mb, lim; };
__device__ __forceinline__ int row0(const Unit& u) { return u.pm * 256 + ((u.half >> 1) << 7); }
struct Gemm { const bf16_t* A; const bf16_t* Bt; int M, N, K; const int* rowmap; };

struct StaticOrder {
    int nM, nN, nwg, G, c;
    __host__ __device__ void init(int M, int N, int G_, int c_) { nM = M / BM; nN = N / BM; nwg = nM * nN; G = G_; c = c_; }
    __host__ __device__ bool next(int i, Unit& u) const {
        const long L = (long)i * G + c; if (L >= nwg) return false;
        int wgid = (int)L; { const int q = nwg / NXCD, r = nwg % NXCD, xcd = wgid % NXCD, off = wgid / NXCD; wgid = (xcd < r ? xcd * (q + 1) : r * (q + 1) + (xcd - r) * q) + off; }
        const int nig = WGM * nN, gid = wgid / nig, fm = gid * WGM, gsz = (nM - fm) < WGM ? (nM - fm) : WGM;
        u.pm = fm + ((wgid % nig) % gsz); u.pn = (wgid % nig) / gsz; u.half = 0; u.mb = 0; u.lim = 256; return true;
    }
    __device__ __forceinline__ void a_ready(const Unit&) const {}
    __device__ __forceinline__ void done(const Unit&) const {}
};


template <class Epi, class Sched, bool ALIGN_EPI = false, bool SP2 = false, bool GATHER = false>
__device__ __forceinline__ void gemm_phase(PG8_LAS unsigned char* lds, const Gemm g, const Sched& S, const Epi& E) {
    const int tid = threadIdx.x, wid = __builtin_amdgcn_readfirstlane(tid >> 6), lane = tid & 63, wr = wid >> 2, wc = wid & 3, fr = lane & 15, fq = lane >> 4;
    const int K = g.K, nt = K / BK;
    unsigned voffA[2], voffB[2];
#pragma unroll
    for (int i = 0; i < 2; ++i) { int R, C; stage_rc(tid * 16 + i * 8192, R, C); const int Rb = Epi::PERM ? ((R & ~31) + perm32(R & 31)) : R;
        voffA[i] = (unsigned)(R * K + C) * 2u; voffB[i] = (unsigned)(Rb * K + C) * 2u; }
    static_assert(!GATHER || SP2, "gather path is written for the SP2 loop");
    unsigned oc[2][2], rn[2][2], cbA[2]; int Rg[2];
    if constexpr (GATHER) {
#pragma unroll
        for (int i = 0; i < 2; ++i) { int R, C; stage_rc(tid * 16 + i * 8192, R, C); Rg[i] = R; cbA[i] = (unsigned)C * 2u; } }
    const char* gA = (const char*)g.A;
    unsigned voffD[2]; voffD[0] = voffD[1] = (unsigned)lane * 16u;
    const size_t kstep = (size_t)(BK * 2);
    const size_t hstep = (size_t)HALF * K * 2;
    const size_t tstep = 2 * hstep;
    const unsigned ldsw = (unsigned)wid * 1024u;
    const int aoff = lds_byte(wr * 64 + fr, fq * 8), boff = lds_byte(wc * 32 + fr, fq * 8);
#define PG8_SA(b, h) (((b) * 2 + (h)) * HTB)
#define PG8_SB(b, h) ((4 + (b) * 2 + (h)) * HTB)
#define PG8_STAGE(bufoff, gbase, voff) do { _Pragma("unroll") for (int _i = 0; _i < 2; ++_i) \
        __builtin_amdgcn_global_load_lds((const unsigned*)((const char*)(gbase) + (voff)[_i]), (PG8_LAS unsigned*)(lds + (bufoff) + ldsw + _i * 8192), 16, 0, 0); } while (0)
#define PG8_STA(b, h, base_ng, base_g, OFF) do { if constexpr (GATHER) PG8_STAGE(PG8_SA(b, h), base_g, OFF[h]); else PG8_STAGE(PG8_SA(b, h), (base_ng) + (h) * hstep, voffA); } while (0)
#define PG8_STA1(b, base_ng, base_g, OFF, HX) do { if (HX) PG8_STAGE(PG8_SA(b, 1), gA, voffD); else PG8_STA(b, 1, base_ng, base_g, OFF); } while (0)
#define PG8_LDA(dst, b, h) do { _Pragma("unroll") for (int m = 0; m < 4; ++m) _Pragma("unroll") for (int k = 0; k < 2; ++k) dst[m][k] = *(const PG8_LAS bf16x8*)(lds + PG8_SA(b, h) + aoff + m * 2048 + k * 1024); } while (0)
#define PG8_LDB(dst, b, h) do { _Pragma("unroll") for (int n = 0; n < 2; ++n) _Pragma("unroll") for (int k = 0; k < 2; ++k) dst[n][k] = *(const PG8_LAS bf16x8*)(lds + PG8_SB(b, h) + boff + n * 2048 + k * 1024); } while (0)
#define PG8_MMA(ai, bj, At, Bt) do { __builtin_amdgcn_s_setprio(1); _Pragma("unroll") for (int m = 0; m < 4; ++m) _Pragma("unroll") for (int n = 0; n < 2; ++n) _Pragma("unroll") for (int k = 0; k < 2; ++k) \
        acc[ai][bj][m][n] = __builtin_amdgcn_mfma_f32_16x16x32_bf16(Bt[n][k], At[m][k], acc[ai][bj][m][n], 0, 0, 0); __builtin_amdgcn_s_setprio(0); } while (0)
#define PG8_WAIT_V(n) asm volatile("s_waitcnt vmcnt(" #n ")" ::: "memory")
#define PG8_WAIT_L(n) asm volatile("s_waitcnt lgkmcnt(" #n ")" ::: "memory")
#define PG8_BAR __builtin_amdgcn_s_barrier()
#define PG8_SCHED __builtin_amdgcn_sched_barrier(0)
    Unit cur, nxt; int ui = 0;
    if (!S.next(0, cur)) return;
    f32x4 acc[2][2][4][2];
#pragma unroll
    for (int a = 0; a < 2; ++a)
#pragma unroll
        for (int b = 0; b < 2; ++b)
#pragma unroll
            for (int m = 0; m < 4; ++m)
#pragma unroll
                for (int n = 0; n < 2; ++n) acc[a][b][m][n] = (f32x4){0.f, 0.f, 0.f, 0.f};
    bf16x8 At[4][2], B0[2][2], B1[2][2];
    const char* cA = (const char*)g.A + (size_t)cur.pm * tstep + (cur.half == 2 ? hstep : (size_t)0); const char* cB = (const char*)g.Bt + (size_t)cur.pn * tstep;
    bool hf = cur.half != 0;
    S.a_ready(cur);
    if constexpr (GATHER) {
#pragma unroll
        for (int h = 0; h < 2; ++h)
#pragma unroll
            for (int i = 0; i < 2; ++i) { const int lr = (cur.half == 2 ? 128 : h * 128) + Rg[i]; oc[h][i] = (unsigned)g.rowmap[cur.mb + (lr < cur.lim ? lr : 0)] * (unsigned)(K * 2) + cbA[i]; } }
    if constexpr (SP2) {
        PG8_STAGE(PG8_SB(0, 0), cB, voffB); PG8_STAGE(PG8_SB(0, 1), cB + hstep, voffB); PG8_STA(0, 0, cA, gA, oc); PG8_STA1(0, cA, gA, oc, hf);
        if (wr == 1) PG8_BAR;
        PG8_WAIT_V(2); PG8_BAR;
        PG8_STAGE(PG8_SB(1, 0), cB + kstep, voffB); PG8_STA(1, 0, cA + kstep, gA + kstep, oc); PG8_STAGE(PG8_SB(1, 1), cB + hstep + kstep, voffB);
        PG8_WAIT_V(6); PG8_BAR;
    } else {
        PG8_STAGE(PG8_SB(0, 0), cB, voffB); PG8_STAGE(PG8_SA(0, 0), cA, voffA); PG8_STAGE(PG8_SB(0, 1), cB + hstep, voffB); PG8_STAGE(PG8_SA(0, 1), cA + hstep, voffA);
        if (wr == 1) PG8_BAR;
        PG8_WAIT_V(4); PG8_BAR;
        PG8_STAGE(PG8_SB(1, 0), cB + kstep, voffB); PG8_STAGE(PG8_SA(1, 0), cA + kstep, voffA); PG8_STAGE(PG8_SB(1, 1), cB + hstep + kstep, voffB);
        PG8_WAIT_V(6); PG8_BAR;
    }
    for (;;) {
        const bool has_next = S.next(ui + 1, nxt);
        if constexpr (GATHER) { if (has_next) {
#pragma unroll
            for (int h = 0; h < 2; ++h)
#pragma unroll
                for (int i = 0; i < 2; ++i) { const int lr = (nxt.half == 2 ? 128 : h * 128) + Rg[i]; rn[h][i] = (unsigned)g.rowmap[nxt.mb + (lr < nxt.lim ? lr : 0)]; } } }
        const char* nA = has_next ? (const char*)g.A + (size_t)nxt.pm * tstep + (nxt.half == 2 ? hstep : (size_t)0) : cA; const char* nB = has_next ? (const char*)g.Bt + (size_t)nxt.pn * tstep : cB;
        for (int t = 0; t < nt; t += 2) {
            const bool last = (t == nt - 2);
            const char* a1 = cA + (size_t)(t + 1) * kstep;
            const char* a2 = last ? nA : cA + (size_t)(t + 2) * kstep; const char* b2 = last ? nB : cB + (size_t)(t + 2) * kstep;
            const char* a3 = a2 + kstep; const char* b3 = b2 + kstep;
            if (last && has_next) S.a_ready(nxt);
            const bool hf2 = (last && has_next) ? (nxt.half != 0) : hf;
            unsigned o2[2][2]; const char* a1g = gA + (size_t)(t + 1) * kstep; const char* a2g = gA + (last ? (size_t)0 : (size_t)(t + 2) * kstep); const char* a3g = a2g + kstep;
            if constexpr (GATHER) {
                if (last && has_next) {
#pragma unroll
                    for (int h = 0; h < 2; ++h)
#pragma unroll
                        for (int i = 0; i < 2; ++i) { unsigned v = rn[h][i]; asm volatile("" : "+v"(v)); o2[h][i] = v * (unsigned)(K * 2) + cbA[i]; } }
                else {
#pragma unroll
                    for (int h = 0; h < 2; ++h)
#pragma unroll
                        for (int i = 0; i < 2; ++i) o2[h][i] = oc[h][i]; }
            }
            if constexpr (SP2) {
            PG8_LDB(B0, 0, 0); PG8_LDB(B1, 0, 1); PG8_SCHED; PG8_LDA(At, 0, 0); PG8_STA1(1, a1, a1g, oc, hf);
            PG8_WAIT_V(8); PG8_WAIT_L(0); PG8_BAR; PG8_MMA(0, 0, At, B0); PG8_MMA(0, 1, At, B1); PG8_BAR; PG8_SCHED;
            if (!hf) PG8_LDA(At, 0, 1); PG8_STAGE(PG8_SB(0, 0), b2, voffB); PG8_STAGE(PG8_SB(0, 1), b2 + hstep, voffB); PG8_STA(0, 0, a2, a2g, o2);
            PG8_WAIT_V(8); PG8_WAIT_L(0); PG8_BAR; if (!hf) { PG8_MMA(1, 0, At, B0); PG8_MMA(1, 1, At, B1); } PG8_BAR; PG8_SCHED;
            PG8_LDB(B0, 1, 0); PG8_LDB(B1, 1, 1); PG8_SCHED; PG8_LDA(At, 1, 0); PG8_STA1(0, a2, a2g, o2, hf2);
            PG8_WAIT_V(8); PG8_WAIT_L(0); PG8_BAR; PG8_MMA(0, 0, At, B0); PG8_MMA(0, 1, At, B1); PG8_BAR; PG8_SCHED;
            if (!hf) PG8_LDA(At, 1, 1); PG8_STAGE(PG8_SB(1, 0), b3, voffB); PG8_STAGE(PG8_SB(1, 1), b3 + hstep, voffB); PG8_STA(1, 0, a3, a3g, o2);
            PG8_WAIT_V(8); PG8_WAIT_L(0); PG8_BAR; if (!hf) { PG8_MMA(1, 0, At, B0); PG8_MMA(1, 1, At, B1); } PG8_BAR; PG8_SCHED;
            } else {
            PG8_LDB(B0, 0, 0); PG8_SCHED; PG8_LDA(At, 0, 0); PG8_STAGE(PG8_SA(1, 1), a1 + hstep, voffA);
            PG8_WAIT_L(8); PG8_BAR; PG8_WAIT_L(0); PG8_MMA(0, 0, At, B0); PG8_BAR; PG8_SCHED;
            PG8_LDB(B1, 0, 1); PG8_STAGE(PG8_SB(0, 0), b2, voffB);
            PG8_BAR; PG8_WAIT_L(0); PG8_MMA(0, 1, At, B1); PG8_BAR;
            PG8_LDA(At, 0, 1); PG8_STAGE(PG8_SA(0, 0), a2, voffA);
            PG8_BAR; PG8_WAIT_L(0); PG8_MMA(1, 0, At, B0); PG8_BAR; PG8_SCHED;
            PG8_STAGE(PG8_SB(0, 1), b2 + hstep, voffB);
            PG8_WAIT_V(6); PG8_BAR; PG8_MMA(1, 1, At, B1); PG8_BAR;
            PG8_LDB(B0, 1, 0); PG8_SCHED; PG8_LDA(At, 1, 0); PG8_STAGE(PG8_SA(0, 1), a2 + hstep, voffA);
            PG8_WAIT_L(8); PG8_BAR; PG8_WAIT_L(0); PG8_MMA(0, 0, At, B0); PG8_BAR; PG8_SCHED;
            PG8_LDB(B1, 1, 1); PG8_STAGE(PG8_SB(1, 0), b3, voffB);
            PG8_BAR; PG8_WAIT_L(0); PG8_MMA(0, 1, At, B1); PG8_BAR;
            PG8_LDA(At, 1, 1); PG8_STAGE(PG8_SA(1, 0), a3, voffA);
            PG8_BAR; PG8_WAIT_L(0); PG8_MMA(1, 0, At, B0); PG8_BAR; PG8_SCHED;
            PG8_STAGE(PG8_SB(1, 1), b3 + hstep, voffB);
            PG8_WAIT_V(6); PG8_BAR; PG8_MMA(1, 1, At, B1); PG8_BAR;
            }
        }
        if constexpr (ALIGN_EPI) { if (wr == 0) PG8_BAR; }
        if constexpr (!Epi::AFTER_DRAIN) { E(acc, cur, wr, wc, fr, fq); S.done(cur); }
        if (!has_next) break;
#pragma unroll
        for (int a = 0; a < 2; ++a)
#pragma unroll
            for (int b = 0; b < 2; ++b)
#pragma unroll
                for (int m = 0; m < 4; ++m)
#pragma unroll
                    for (int n = 0; n < 2; ++n) acc[a][b][m][n] = (f32x4){0.f, 0.f, 0.f, 0.f};
        cur = nxt; cA = nA; cB = nB; ++ui; hf = cur.half != 0;
        if constexpr (GATHER) {
#pragma unroll
            for (int h = 0; h < 2; ++h)
#pragma unroll
                for (int i = 0; i < 2; ++i) oc[h][i] = rn[h][i] * (unsigned)(K * 2) + cbA[i]; }
        if constexpr (ALIGN_EPI) { if (wr == 1) PG8_BAR; }
    }
    PG8_WAIT_V(0);
    if constexpr (!ALIGN_EPI) { if (wr == 0) PG8_BAR; }
    PG8_BAR;
    if constexpr (Epi::AFTER_DRAIN) { E.fused(acc, cur, wr, wc, fr, fq, lds, wid, lane); S.done(cur); }
#undef PG8_SA
#undef PG8_SB
#undef PG8_STAGE
#undef PG8_STA
#undef PG8_STA1
#undef PG8_LDA
#undef PG8_LDB
#undef PG8_MMA
#undef PG8_WAIT_V
#undef PG8_WAIT_L
#undef PG8_BAR
#undef PG8_SCHED
}
}
#define XB_TMO      128
#define XB_XCNT(j)  (256  + 64 * (j))
#define XB_XSUB(j)  (1280 + 64 * (j))
#define XB_XGEN(j)  (2304 + 64 * (j))
#define XB_TOP      3328
#define XB_TOPGEN   3392
#define XCD_BAR_WORDS 3456
#define XB_SPIN_CAP (1u << 22)

__device__ __forceinline__ unsigned xb_ld(unsigned* p)              { return __hip_atomic_load(p, __ATOMIC_RELAXED, __HIP_MEMORY_SCOPE_AGENT); }
__device__ __forceinline__ unsigned xb_add(unsigned* p, unsigned v) { return __hip_atomic_fetch_add(p, v, __ATOMIC_RELAXED, __HIP_MEMORY_SCOPE_AGENT); }
__device__ __forceinline__ unsigned xb_xcc_id() { return (unsigned)__builtin_amdgcn_s_getreg((3 << 11) | 20) & 0xFu; }
#define XB_SPIN(cond, bar) do { unsigned _sp = 0; while (cond) { __builtin_amdgcn_s_sleep(1); \
    if ((++_sp & 255u) == 0u) { if (xb_ld(&(bar)[XB_TMO])) break; if (_sp > XB_SPIN_CAP) { atomicAdd(&(bar)[XB_TMO], 1u); break; } } } } while (0)

struct XcdBarrier {
    unsigned* bar; unsigned x;
    volatile LAS unsigned* st;
};

__device__ __forceinline__ XcdBarrier xcd_barrier_post(unsigned* bar, volatile LAS unsigned* st) {
    XcdBarrier b; b.bar = bar; b.x = xb_xcc_id(); b.st = st;
    if (threadIdx.x == 0) (void)xb_add(&bar[XB_XCNT(b.x)], 1u);
    return b;
}
__device__ __forceinline__ void xcd_barrier_complete(unsigned* bar, unsigned x, unsigned& nloc, unsigned& nx) {
    const unsigned G = gridDim.x * gridDim.y * gridDim.z;
    unsigned sum, cnt, mine, sp = 0u;
    for (;;) {
        sum = 0u; cnt = 0u; mine = 0u;
#pragma unroll
        for (unsigned j = 0; j < 16; ++j) { const unsigned c = xb_ld(&bar[XB_XCNT(j)]); sum += c; cnt += (c > 0u) ? 1u : 0u; mine = (j == x) ? c : mine; }
        if (sum == G) break;
        __builtin_amdgcn_s_sleep(1);
        if ((++sp & 255u) == 0u) { if (xb_ld(&bar[XB_TMO])) break; if (sp > XB_SPIN_CAP) { atomicAdd(&bar[XB_TMO], 1u); break; } }
    }
    nloc = mine > 0u ? mine : 1u; nx = cnt > 0u ? cnt : 1u;
}

__device__ __forceinline__ void xcd_barrier(const XcdBarrier& b) {
    asm volatile("s_waitcnt vmcnt(0)" ::: "memory");
    __syncthreads();
    if (threadIdx.x == 0) {
        unsigned* bar = b.bar;
        __builtin_amdgcn_s_waitcnt(0);
        unsigned nloc = b.st[0], nx = b.st[1];
        if (nloc == 0u) { xcd_barrier_complete(bar, b.x, nloc, nx); b.st[0] = nloc; b.st[1] = nx; }
        const unsigned old = xb_add(&bar[XB_XSUB(b.x)], 1u);
        const unsigned gen = old / nloc;
        if (old + 1u == (gen + 1u) * nloc) {
            __builtin_amdgcn_fence(__ATOMIC_RELEASE, "agent");
            asm volatile("s_waitcnt vmcnt(0)" ::: "memory");
            const unsigned og = xb_add(&bar[XB_TOP], 1u);
            const unsigned tg = og / nx;
            if (og + 1u == (tg + 1u) * nx) xb_add(&bar[XB_TOPGEN], 1u);
            else XB_SPIN(xb_ld(&bar[XB_TOPGEN]) == tg, bar);
            __builtin_amdgcn_fence(__ATOMIC_ACQUIRE, "agent");
            xb_add(&bar[XB_XGEN(b.x)], 1u);
            asm volatile("s_waitcnt vmcnt(0)" ::: "memory");
        } else {
            XB_SPIN(xb_ld(&bar[XB_XGEN(b.x)]) == gen, bar);
            __builtin_amdgcn_fence(__ATOMIC_ACQUIRE, "agent");
            asm volatile("s_waitcnt vmcnt(0)" ::: "memory");
        }
    }
    __syncthreads();
}

enum { IN_X = 0, IN_C, IN_CTX, IN_CCTX, IN_ADAW, IN_ADAB, IN_N1G, IN_N2G, IN_FING, IN_S5LRE, IN_S5LIM, IN_S5LOG, IN_S5BRE, IN_S5BIM, IN_S5CRE, IN_S5CIM,
       IN_S5D, IN_S5WGLU, IN_S5BGLU, IN_AWKVQ, IN_AQG, IN_AKG, IN_AWO, IN_MLWIN, IN_MLBG, IN_MLNG, IN_MLWOUT, IN_RW, IN_RB, IN_MWG, IN_MWU, IN_MWD, N_INPUTS };

struct Frame {
    LAS unsigned char* lds;
    volatile LAS unsigned* MISC;
    unsigned* ctl;
    int tid, lane, wave, G, blk;
    const float* in[N_INPUTS];
    unsigned char* ws;
    float* out;
};

template <bool HV = false>
struct DenseSchedT {
    pg8::StaticOrder so; int pm0;
    __device__ __forceinline__ void init(int Mrows, int N, int G, int c, int pm0_) { so.init(Mrows, N, G, c); pm0 = pm0_; }
    __device__ __forceinline__ bool next(int i, pg8::Unit& u) const {
        const int G = so.G, rounds = (so.nwg + G - 1) / G, R = so.nwg - G * (rounds - 1);
        if (HV && i == rounds - 1 && 2 * R <= G && (G & 15) == 0) {
            const int c = so.c, idx = ((c >> 4) << 3) | (c & 7); if (idx >= R) return false;
            pg8::StaticOrder t = so; t.c = idx; if (!t.next(i, u)) return false; u.pm += pm0; u.half = 1 + ((c >> 3) & 1); return true; }
        if (!so.next(i, u)) return false; u.pm += pm0; return true; }
    __device__ __forceinline__ void a_ready(const pg8::Unit&) const {}
    __device__ __forceinline__ void done(const pg8::Unit&) const {}
};
typedef DenseSchedT<false> DenseSched;
typedef DenseSchedT<true> DenseSchedH;
struct MoeSched {
    const LAS int* tab; int G, c, npn;
    __device__ __forceinline__ bool next(int i, pg8::Unit& u) const {
        const int total = tab[16] * npn;
        int L;
        int hsel = 0;
        if ((G & 7) == 0) { const int x = c & 7, rank = c >> 3, per = G >> 3; const int q = total >> 3, rem = total & 7; const int start = x * q + (x < rem ? x : rem), cnt = q + (x < rem ? 1 : 0);
            const int nfr = cnt / per, R = cnt - nfr * per;
            if (i < nfr) L = start + rank + per * i;
            else if (i > nfr || R == 0) return false;
            else if (2 * R <= per) { if (rank >= 2 * R) return false; L = start + nfr * per + (rank >> 1); hsel = 1 + (rank & 1); }
            else { if (rank >= R) return false; L = start + nfr * per + rank; } }
        else { L = i * G + c; if (L >= total) return false; }
        int e = 0;
#pragma unroll
        for (int k = 1; k < 16; ++k) e += (L >= tab[k] * npn) ? 1 : 0;
        const int ts = tab[e], te = tab[e + 1] - ts, idx = L - ts * npn;
        u.pm = __builtin_amdgcn_readfirstlane(ts + idx % te); u.pn = __builtin_amdgcn_readfirstlane(e * npn + idx / te); u.half = __builtin_amdgcn_readfirstlane(hsel);
        u.mb = __builtin_amdgcn_readfirstlane(e * T + (u.pm - ts) * 256); u.lim = __builtin_amdgcn_readfirstlane(tab[17 + e] - (u.pm - ts) * 256); return true;
    }
    __device__ __forceinline__ void a_ready(const pg8::Unit&) const {}
    __device__ __forceinline__ void done(const pg8::Unit&) const {}
};

template <class Epi, class Sched>
__device__ __forceinline__ void gemm_phase_naive(const pg8::Gemm g, const Sched& S, const Epi& E) {
    const int tid = threadIdx.x, wid = tid >> 6, lane = tid & 63, wr = wid >> 2, wc = wid & 3, fr = lane & 15, fq = lane >> 4;
    const int K = g.K; pg8::Unit u;
    for (int i = 0; S.next(i, u); ++i) {
        f32x4 acc[2][2][4][2];
#pragma unroll
        for (int ai = 0; ai < 2; ++ai)
#pragma unroll
            for (int m = 0; m < 4; ++m) {
                const int row = pg8::row0(u) + ai * 128 + wr * 64 + m * 16 + fr;
                const bf16* ap = g.A + (size_t)row * K;
                float s[2][2][4];
#pragma unroll
                for (int bj = 0; bj < 2; ++bj)
#pragma unroll
                    for (int n = 0; n < 2; ++n)
#pragma unroll
                        for (int e = 0; e < 4; ++e) s[bj][n][e] = 0.f;
                for (int k = 0; k < K; k += 8) {
                    const v4u av = *(const v4u*)(ap + k);
                    const float a0 = bflo(av.x), a1 = bfhi(av.x), a2 = bflo(av.y), a3 = bfhi(av.y), a4 = bflo(av.z), a5 = bfhi(av.z), a6 = bflo(av.w), a7 = bfhi(av.w);
#pragma unroll
                    for (int bj = 0; bj < 2; ++bj)
#pragma unroll
                        for (int n = 0; n < 2; ++n)
#pragma unroll
                            for (int e = 0; e < 4; ++e) {
                                const int col = u.pn * 256 + bj * 128 + wc * 32 + n * 16 + fq * 4 + e;
                                const v4u bv = *(const v4u*)(g.Bt + (size_t)col * K + k);
                                float t = s[bj][n][e];
                                t += a0 * bflo(bv.x); t += a1 * bfhi(bv.x); t += a2 * bflo(bv.y); t += a3 * bfhi(bv.y);
                                t += a4 * bflo(bv.z); t += a5 * bfhi(bv.z); t += a6 * bflo(bv.w); t += a7 * bfhi(bv.w);
                                s[bj][n][e] = t;
                            }
                }
#pragma unroll
                for (int bj = 0; bj < 2; ++bj)
#pragma unroll
                    for (int n = 0; n < 2; ++n) acc[ai][bj][m][n] = (f32x4){s[bj][n][0], s[bj][n][1], s[bj][n][2], s[bj][n][3]};
            }
        E(acc, u, wr, wc, fr, fq);
    }
}
#ifndef USE_NAIVE_GEMM
#define USE_NAIVE_GEMM 0
#endif
template <class Epi, class Sched>
__device__ __forceinline__ void run_gemm(Frame& F, const pg8::Gemm g, const Sched& S, const Epi& E) {
#if USE_NAIVE_GEMM
    gemm_phase_naive<Epi, Sched>(g, S, E);
#else
    pg8::gemm_phase<Epi, Sched, true, true>(F.lds + RING_OFF, g, S, E);
#endif
}
template <class Epi, class Sched>
__device__ __forceinline__ void run_gemm_gather(Frame& F, const pg8::Gemm g, const Sched& S, const Epi& E) {
    pg8::gemm_phase<Epi, Sched, true, true, true>(F.lds + RING_OFF, g, S, E);
}

__device__ __forceinline__ void st_bf4(bf16* p, f32x4 v) { v2u w; w.x = pk2(v.x, v.y); w.y = pk2(v.z, v.w); *(v2u*)p = w; }

struct EpiRes {
    static constexpr bool PERM = true, AFTER_DRAIN = false;
    bf16* xres; const float* __restrict__ modg; int skip; bf16* dummy;
    __device__ __forceinline__ void operator()(const f32x4 (&acc)[2][2][4][2], const pg8::Unit& u, int wr, int wc, int fr, int fq) const {
        const int cbase = u.pn * 256 + wc * 32 + fq * 8;
        const float* gp = modg + mrow_of(pg8::row0(u)) * 6144 + cbase;
        f32x4 g0[2], g1[2];
#pragma unroll
        for (int bj = 0; bj < 2; ++bj) { g0[bj] = *(const f32x4*)(gp + bj * 128); g1[bj] = *(const f32x4*)(gp + bj * 128 + 4); }
#pragma unroll
        for (int am = 0; am < 4; ++am) { const int ai = am >> 1, m0 = (am & 1) * 2; if (ai == 1 && u.half) break;
            v4u x[4][2];
#pragma unroll
            for (int m = m0; m < m0 + 2; ++m) { const int r = pg8::row0(u) + ai * 128 + wr * 64 + m * 16 + fr; const bf16* xp = xres + (size_t)r * D + cbase;
#pragma unroll
                for (int bj = 0; bj < 2; ++bj) x[m][bj] = *(const v4u*)(xp + bj * 128); }
            asm volatile("" ::: "memory");
#pragma unroll
            for (int m = m0; m < m0 + 2; ++m) { const int r = pg8::row0(u) + ai * 128 + wr * 64 + m * 16 + fr; bf16* xp = (skip ? dummy : xres) + (size_t)r * D + cbase;
#pragma unroll
                for (int bj = 0; bj < 2; ++bj) { const v4u xv = x[m][bj]; const f32x4 a = g0[bj] * acc[ai][bj][m][0], b = g1[bj] * acc[ai][bj][m][1];
                    v4u o; o.x = pk2(bflo(xv.x) + a.x, bfhi(xv.x) + a.y); o.y = pk2(bflo(xv.y) + a.z, bfhi(xv.y) + a.w); o.z = pk2(bflo(xv.z) + b.x, bfhi(xv.z) + b.y); o.w = pk2(bflo(xv.w) + b.z, bfhi(xv.w) + b.w);
                    *(v4u*)(xp + bj * 128) = o; } }
        }
    }
};
struct EpiGlu {
    static constexpr bool PERM = true, AFTER_DRAIN = false;
    bf16* xres; const float* __restrict__ modg; const float* __restrict__ bglu; int skip;
    __device__ __forceinline__ void operator()(const f32x4 (&acc)[2][2][4][2], const pg8::Unit& u, int wr, int wc, int fr, int fq) const {
        const int oc = u.pn * 128 + wc * 32 + fq * 8;
        const f32x4 ba0 = *(const f32x4*)(bglu + oc), ba1 = *(const f32x4*)(bglu + oc + 4), bg0 = *(const f32x4*)(bglu + 1024 + oc), bg1 = *(const f32x4*)(bglu + 1024 + oc + 4);
        const float* gp = modg + mrow_of(pg8::row0(u)) * 6144 + oc;
#pragma unroll
        for (int ai = 0; ai < 2; ++ai) { if (ai == 1 && u.half) break;
            const f32x4 g0 = *(const f32x4*)gp, g1 = *(const f32x4*)(gp + 4);
            v4u x[4];
#pragma unroll
            for (int m = 0; m < 4; ++m) { const int r = pg8::row0(u) + ai * 128 + wr * 64 + m * 16 + fr; x[m] = *(const v4u*)(xres + (size_t)r * D + oc); }
            asm volatile("" ::: "memory");
#pragma unroll
            for (int m = 0; m < 4; ++m) { const int r = pg8::row0(u) + ai * 128 + wr * 64 + m * 16 + fr;
                const f32x4 a0 = acc[ai][0][m][0] + ba0, a1 = acc[ai][0][m][1] + ba1, q0 = acc[ai][1][m][0] + bg0, q1 = acc[ai][1][m][1] + bg1;
                f32x4 v0, v1; v0.x = a0.x * sigmoidf_(q0.x); v0.y = a0.y * sigmoidf_(q0.y); v0.z = a0.z * sigmoidf_(q0.z); v0.w = a0.w * sigmoidf_(q0.w);
                v1.x = a1.x * sigmoidf_(q1.x); v1.y = a1.y * sigmoidf_(q1.y); v1.z = a1.z * sigmoidf_(q1.z); v1.w = a1.w * sigmoidf_(q1.w);
                v0 = v0 * g0; v1 = v1 * g1; const v4u xv = x[m];
                v4u o; o.x = pk2(bflo(xv.x) + v0.x, bfhi(xv.x) + v0.y); o.y = pk2(bflo(xv.y) + v0.z, bfhi(xv.y) + v0.w); o.z = pk2(bflo(xv.z) + v1.x, bfhi(xv.z) + v1.y); o.w = pk2(bflo(xv.w) + v1.z, bfhi(xv.w) + v1.w);
                if (!skip) *(v4u*)(xres + (size_t)r * D + oc) = o; }
        }
    }
};
__device__ __forceinline__ int kvrow_of(int r) { if (r < TC) return (r >> 8) * KVLEN + SEQ + (r & 255); const int rr = r - TC; return (rr >> 11) * KVLEN + (rr & 2047); }
struct EpiKvq {
    static constexpr bool PERM = false, AFTER_DRAIN = false;
    bf16* qb; bf16* kb; bf16* vb; const float* __restrict__ qg; const float* __restrict__ kg; const float* __restrict__ rope;
    __device__ __forceinline__ void operator()(const f32x4 (&acc)[2][2][4][2], const pg8::Unit& u, int wr, int wc, int fr, int fq) const {
        const int pn = u.pn, rb = pg8::row0(u) + wr * 64 + fr;
        if (pn == 1) {
#pragma unroll
            for (int ai = 0; ai < 2; ++ai)
#pragma unroll
                for (int m = 0; m < 4; ++m) { if (ai == 1 && u.half) break;
                    bf16* dst = vb + (size_t)kvrow_of(rb + ai * 128 + m * 16) * 256 + wc * 64;
#pragma unroll
                    for (int bj = 0; bj < 2; ++bj)
#pragma unroll
                        for (int n = 0; n < 2; ++n) st_bf4(dst + 32 * bj + 16 * n + 4 * fq, acc[ai][bj][m][n]); }
            return;
        }
        const float* gptr = (pn == 0) ? kg : qg;
        f32x4 gn[2][2];
#pragma unroll
        for (int bj = 0; bj < 2; ++bj)
#pragma unroll
            for (int n = 0; n < 2; ++n) gn[bj][n] = *(const f32x4*)(gptr + 32 * bj + 16 * n + 4 * fq);
        const bool lat = pg8::row0(u) >= TC;
        int fro = fr, fqo = fq; asm volatile("" : "+v"(fro), "+v"(fqo));
        f32x4 c0[2], s0[2];
        if (lat) { const int t0 = (pg8::row0(u) + wr * 64 - TC) & 2047;
#pragma unroll
            for (int ai = 0; ai < 2; ++ai) { const int pos = ((t0 + ai * 128) & 2047) >> 6; c0[ai] = *(const f32x4*)(rope + pos * 16 + 4 * fqo); s0[ai] = *(const f32x4*)(rope + 1024 + pos * 16 + 4 * fqo); } }
        float ssv[2][4];
#pragma unroll
        for (int ai = 0; ai < 2; ++ai)
#pragma unroll
            for (int m = 0; m < 4; ++m) { float ss = 0.f;
#pragma unroll
                for (int bj = 0; bj < 2; ++bj)
#pragma unroll
                    for (int n = 0; n < 2; ++n) { const f32x4 v = acc[ai][bj][m][n]; ss += v.x * v.x + v.y * v.y + v.z * v.z + v.w * v.w; }
                ssv[ai][m] = ss; }
#pragma unroll
        for (int ai = 0; ai < 2; ++ai)
#pragma unroll
            for (int m = 0; m < 4; ++m) ssv[ai][m] = xor16_sum(ssv[ai][m]);
#pragma unroll
        for (int ai = 0; ai < 2; ++ai)
#pragma unroll
            for (int m = 0; m < 4; ++m) ssv[ai][m] = xor32_sum(ssv[ai][m]);
        const float qs = (pn >= 2) ? ATT_C2 : 1.f;
#pragma unroll
        for (int m = 0; m < 4; ++m) {
            f32x4 c1 = (f32x4){1.f, 1.f, 1.f, 1.f}, s1 = (f32x4){0.f, 0.f, 0.f, 0.f};
            if (lat) { const int pos = 16 * m + fro; c1 = *(const f32x4*)(rope + pos * 16 + 4 * fqo); s1 = *(const f32x4*)(rope + 1024 + pos * 16 + 4 * fqo); }
#pragma unroll
            for (int ai = 0; ai < 2; ++ai) { if (ai == 1 && u.half) break;
                const int r = rb + ai * 128 + m * 16;
                const float rs = rsqrtf(ssv[ai][m] * (1.f / 64.f) + EPS) * qs;
                f32x4 x[2][2];
#pragma unroll
                for (int bj = 0; bj < 2; ++bj)
#pragma unroll
                    for (int n = 0; n < 2; ++n) x[bj][n] = acc[ai][bj][m][n] * rs * gn[bj][n];
                if (lat) {
                    { const f32x4 x1 = x[0][0], x2 = x[0][1]; x[0][0] = x1 * c0[ai] - x2 * s0[ai]; x[0][1] = x2 * c0[ai] + x1 * s0[ai]; }
                    { const f32x4 x1 = x[1][0], x2 = x[1][1]; x[1][0] = x1 * c1 - x2 * s1; x[1][1] = x2 * c1 + x1 * s1; }
                }
                bf16* dst;
                if (pn == 0) dst = kb + (size_t)kvrow_of(r) * 256 + wc * 64; else dst = qb + (size_t)r * D + ((pn - 2) * 4 + wc) * 64;
#pragma unroll
                for (int bj = 0; bj < 2; ++bj)
#pragma unroll
                    for (int n = 0; n < 2; ++n) st_bf4(dst + 32 * bj + 16 * n + 4 * fq, x[bj][n]);
            }
        }
    }
};
struct EpiMlIn {
    static constexpr bool PERM = true, AFTER_DRAIN = false;
    bf16 *k, *v, *q, *o; float* g; const float* bgate;
    __device__ __forceinline__ void operator()(const f32x4 (&acc)[2][2][4][2], const pg8::Unit& u, int wr, int wc, int fr, int fq) const {
        const int pn = u.pn;
#pragma unroll
        for (int ai = 0; ai < 2; ++ai)
#pragma unroll
            for (int m = 0; m < 4; ++m) { if (ai == 1 && u.half) break;
                const int r = pg8::row0(u) + ai * 128 + wr * 64 + m * 16 + fr;
#pragma unroll
                for (int bj = 0; bj < 2; ++bj) {
                    const int cc = bj * 128 + wc * 32 + fq * 8;
                    f32x4 a = acc[ai][bj][m][0], b = acc[ai][bj][m][1];
                    if (pn == 12) { if (cc < 32) { *(f32x4*)(g + (size_t)r * 32 + cc) = a + *(const f32x4*)(bgate + cc); *(f32x4*)(g + (size_t)r * 32 + cc + 4) = b + *(const f32x4*)(bgate + cc + 4); } continue; }
                    if (pn < 2) { a = a * 0.125f; b = b * 0.125f; }
                    v4u ov; ov.x = pk2(a.x, a.y); ov.y = pk2(a.z, a.w); ov.z = pk2(b.x, b.y); ov.w = pk2(b.z, b.w);
                    bf16* dst = (pn < 2) ? k + (size_t)r * 512 + pn * 256 + cc : (pn < 6) ? v + (size_t)r * 1024 + (pn - 2) * 256 + cc : (pn < 8) ? q + (size_t)r * 512 + (pn - 6) * 256 + cc : o + (size_t)r * 1024 + (pn - 8) * 256 + cc;
                    *(v4u*)(dst) = ov;
                }
            }
    }
};
struct EpiG1 {
    static constexpr bool PERM = false, AFTER_DRAIN = false;
    bf16* hid;
    __device__ __forceinline__ void operator()(const f32x4 (&acc)[2][2][4][2], const pg8::Unit& u, int wr, int wc, int fr, int fq) const {
        const int pnl = u.pn & 3;
#pragma unroll
        for (int ai = 0; ai < 2; ++ai)
#pragma unroll
            for (int m = 0; m < 4; ++m) { if (ai == 1 && u.half) break;
                const int r = pg8::row0(u) + ai * 128 + wr * 64 + m * 16 + fr;
#pragma unroll
                for (int bj = 0; bj < 2; ++bj) {
                    const int hc = pnl * 128 + bj * 64 + wc * 16 + fq * 4;
                    const f32x4 ga = acc[ai][bj][m][0], up = acc[ai][bj][m][1];
                    f32x4 h; h.x = siluf_(ga.x) * up.x; h.y = siluf_(ga.y) * up.y; h.z = siluf_(ga.z) * up.z; h.w = siluf_(ga.w) * up.w;
                    st_bf4(hid + (size_t)r * DFF + hc, h);
                }
            }
    }
};
struct EpiG2 {
    static constexpr bool PERM = true, AFTER_DRAIN = false;
    bf16* y2;
    __device__ __forceinline__ void operator()(const f32x4 (&acc)[2][2][4][2], const pg8::Unit& u, int wr, int wc, int fr, int fq) const {
        const int pnl = u.pn & 3;
#pragma unroll
        for (int ai = 0; ai < 2; ++ai)
#pragma unroll
            for (int m = 0; m < 4; ++m) { if (ai == 1 && u.half) break;
                const int r = pg8::row0(u) + ai * 128 + wr * 64 + m * 16 + fr;
#pragma unroll
                for (int bj = 0; bj < 2; ++bj) {
                    const int c = pnl * 256 + bj * 128 + wc * 32 + fq * 8;
                    const f32x4 a = acc[ai][bj][m][0], b = acc[ai][bj][m][1];
                    v4u o; o.x = pk2(a.x, a.y); o.y = pk2(a.z, a.w); o.z = pk2(b.x, b.y); o.w = pk2(b.z, b.w);
                    *(v4u*)(y2 + (size_t)r * D + c) = o;
                }
            }
    }
};

struct CmNat { const float* W; int ld; __device__ __forceinline__ const float* col(int j) const { return W + j; } };
struct CmGlu { const float* W; int ld;
    __device__ __forceinline__ const float* col(int j) const { const int pn = j >> 8, gpart = (j >> 7) & 1, c = j & 127; return W + gpart * 1024 + 128 * pn + c; } };
struct CmKvq { const float* W; int ld;
    __device__ __forceinline__ const float* col(int j) const { const int pn = j >> 8, bj = (j >> 7) & 1, wc = (j >> 5) & 3, n = (j >> 4) & 1, q = j & 15; return W + 256 * pn + 64 * wc + 32 * bj + 16 * n + q; } };
struct CmMlIn { const float* W; int ld;
    __device__ __forceinline__ const float* col(int j) const {
        if (j < 1536) return W + j;
        if (j < 2048) return W + 1568 + (j - 1536);
        if (j < 3072) return W + 2080 + (j - 2048);
        if (j < 3104) return W + 1536 + (j - 3072);
        return nullptr; } };
struct CmG1 { const float* Wg; const float* Wu; int ld;
    __device__ __forceinline__ const float* col(int j) const { const int le = j >> 10, jj = j & 1023; const int pn = jj >> 8, bj = (jj >> 7) & 1, wc = (jj >> 5) & 3, n = (jj >> 4) & 1, q = jj & 15;
        const uintptr_t a = (uintptr_t)Wg, b = (uintptr_t)Wu, msk = (uintptr_t)0 - (uintptr_t)n;
        return (const float*)((a & ~msk) | (b & msk)) + (size_t)le * 1024 * 512 + 128 * pn + 64 * bj + 16 * wc + q; } };
struct CmG2 { const float* Wd; int ld;
    __device__ __forceinline__ const float* col(int j) const { const int le = j >> 10, jj = j & 1023; return Wd + (size_t)le * 512 * 1024 + jj; } };

template <class CM>
__device__ __forceinline__ void transpose_load(const CM& cm, int kb, int nb, f32x4 (&v)[8], int lane) {
    const int k0 = 64 * kb, n0 = 32 * nb;
    const int nq = (lane & 7) * 4;
    const float* cp = cm.col(n0 + nq);
    const size_t ld = (size_t)cm.ld;
#pragma unroll
    for (int i = 0; i < 8; ++i) { const int kk = 8 * i + (lane >> 3); v[i] = cp ? *(const f32x4*)(cp + (size_t)(k0 + kk) * ld) : (f32x4){0.f, 0.f, 0.f, 0.f}; }
}
__device__ __forceinline__ void transpose_store(int K, bf16* WT, int kb, int nb, const f32x4 (&v)[8], LAS float* scr, int lane) {
    const int k0 = 64 * kb, n0 = 32 * nb, nq = (lane & 7) * 4;
#pragma unroll
    for (int i = 0; i < 8; ++i) { const int kk = 8 * i + (lane >> 3); LAS float* d = scr + kk * 33 + nq; d[0] = v[i].x; d[1] = v[i].y; d[2] = v[i].z; d[3] = v[i].w; }
    LDS_WAIT(); asm volatile("" ::: "memory");
    const int c = lane & 7;
#pragma unroll
    for (int j = 0; j < 4; ++j) { const int n = (lane >> 3) + 8 * j; const LAS float* s = scr + (8 * c) * 33 + n;
        v4u o; o.x = pk2(s[0 * 33], s[1 * 33]); o.y = pk2(s[2 * 33], s[3 * 33]); o.z = pk2(s[4 * 33], s[5 * 33]); o.w = pk2(s[6 * 33], s[7 * 33]);
        *(v4u*)(WT + (size_t)(n0 + n) * K + k0 + 8 * c) = o; }
    LDS_WAIT(); asm volatile("" ::: "memory");
}
template <class CM>
__device__ __forceinline__ void transpose_all(Frame& F, const CM& cm, int K, int Ndest, bf16* WT, int rot) {
    LAS float* scr = (LAS float*)(F.lds + RING_OFF + F.wave * 16384);
    const int NGW = F.G * NWAVES, gw = (F.blk * NWAVES + F.wave + rot) % NGW;
    const int nblk = Ndest / 32, items = (K / 64) * nblk;
    for (int it = gw; it < items; it += 2 * NGW) {
        const int it2 = it + NGW; const bool two = it2 < items;
        f32x4 va[8], vb[8];
        transpose_load(cm, it / nblk, it % nblk, va, F.lane);
        if (two) transpose_load(cm, it2 / nblk, it2 % nblk, vb, F.lane);
        transpose_store(K, WT, it / nblk, it % nblk, va, scr, F.lane);
        if (two) transpose_store(K, WT, it2 / nblk, it2 % nblk, vb, scr, F.lane);
    }
}

__device__ __forceinline__ void phase_prologue(Frame& F) {
    {
        LAS float* cond = (LAS float*)(F.lds);
        LAS float* red = (LAS float*)(F.lds + 40960);
        for (int i = F.tid; i < 9 * 1024; i += NTHR) { const int mb = i >> 10, k = i & 1023; const float v = (mb < 8) ? F.in[IN_C][mb * 1024 + k] : F.in[IN_CCTX][k]; cond[i] = siluf_(v); }
        __syncthreads();
        float* mod = (float*)(F.ws + WS_MOD);
        const int kp = (F.lane >= 24) ? 1 : 0, cl = F.lane - 24 * kp; const bool act = F.lane < 48;
        for (int it = F.blk; it < DEPTH * 64; it += F.G) {
            const int l = it >> 6, n0 = (it & 63) * 96;
            const float* w = F.in[IN_ADAW] + (size_t)l * 1024 * 6144 + n0 + 4 * (act ? cl : 0);
            f32x4 a[9];
#pragma unroll
            for (int mb = 0; mb < 9; ++mb) a[mb] = (f32x4){0.f, 0.f, 0.f, 0.f};
            const int kb = F.wave * 128 + kp;
            for (int k16 = 0; k16 < 128; k16 += 16) {
                f32x4 wv[8];
#pragma unroll
                for (int u = 0; u < 8; ++u) wv[u] = *(const f32x4*)(w + (size_t)(kb + k16 + 2 * u) * 6144);
#pragma unroll
                for (int u = 0; u < 8; ++u)
#pragma unroll
                    for (int mb = 0; mb < 9; ++mb) a[mb] += wv[u] * cond[mb * 1024 + kb + k16 + 2 * u];
            }
            if (act) {
#pragma unroll
                for (int mb = 0; mb < 9; ++mb) *(LAS f32x4*)(red + ((F.wave * 2 + kp) * 9 + mb) * 96 + 4 * cl) = a[mb]; }
            __syncthreads();
            for (int i = F.tid; i < 9 * 96; i += NTHR) { const int mb = i / 96, ln = i - 96 * mb; float s = F.in[IN_ADAB][l * 6144 + n0 + ln];
#pragma unroll
                for (int pq = 0; pq < 16; ++pq) s += red[(pq * 9 + mb) * 96 + ln];
                mod[(size_t)(l * 9 + mb) * 6144 + n0 + ln] = s; }
            __syncthreads();
        }
    }
    { const int idx = F.blk * NTHR + F.tid;
      if (idx < 1024) { const int pos = idx >> 4, f = idx & 15; const float inv = exp2f(-(float)f * (13.287712379549449f / 16.f)); const float ang = (float)pos * inv;
          double s, c; sincos_d((double)ang, s, c); float* rope = (float*)(F.ws + WS_ROPE); rope[idx] = (float)c; rope[1024 + idx] = (float)s; } }
    __syncthreads();
    { CmGlu cm{F.in[IN_S5WGLU], 2048}; transpose_all(F, cm, 1024, 2048, (bf16*)(F.ws + WS_WGLU), 0); }
    { CmGlu cm{F.in[IN_S5WGLU] + (size_t)1024 * 2048, 2048}; transpose_all(F, cm, 1024, 2048, (bf16*)(F.ws + WS_WGLU) + (size_t)2048 * 1024, 1024); }
    { CmKvq cm{F.in[IN_AWKVQ], 1536}; transpose_all(F, cm, 1024, 1536, (bf16*)(F.ws + WS_WKVQ), 0); }
    { CmNat cm{F.in[IN_AWO], 1024}; transpose_all(F, cm, 1024, 1024, (bf16*)(F.ws + WS_WO), 768); }
    { CmMlIn cm{F.in[IN_MLWIN], 3104}; transpose_all(F, cm, 1024, ML_NIN, (bf16*)(F.ws + WS_WIN), 1280); }
    { CmNat cm{F.in[IN_MLWOUT], 1024}; transpose_all(F, cm, 1024, 1024, (bf16*)(F.ws + WS_WOUT), 896); }
    { CmG1 cm{F.in[IN_MWG], F.in[IN_MWU], 512}; transpose_all(F, cm, 1024, DEPTH * NEXP * 1024, (bf16*)(F.ws + WS_WG1), 1408); }
    { CmG2 cm{F.in[IN_MWD], 1024}; transpose_all(F, cm, 512, DEPTH * NEXP * 1024, (bf16*)(F.ws + WS_WG2), 1408); }
}

struct RowMod { f32x4 a[4], b[4], c[4]; int mr; };
__device__ __forceinline__ void rowmod_load(RowMod& M, const float* base, int mr, int oa, int ob, int oc, int lane) {
    if (mr == M.mr) return; M.mr = mr; const float* p = base + (size_t)mr * 6144;
#pragma unroll
    for (int j = 0; j < 4; ++j) { M.a[j] = *(const f32x4*)(p + oa + 4 * lane + 256 * j); M.b[j] = *(const f32x4*)(p + ob + 4 * lane + 256 * j); if (oc >= 0) M.c[j] = *(const f32x4*)(p + oc + 4 * lane + 256 * j); }
}
struct RawRow { f32x4 x[4]; v2u ya[4], yb[4]; float w0, w1; };
template <bool COMB, bool XBF>
__device__ __forceinline__ void raw_load(RawRow& R, const void* xrow, const bf16* y2, int s0, int s1, int lane) {
#pragma unroll
    for (int j = 0; j < 4; ++j) {
        if (XBF) { const v2u w = *(const v2u*)((const bf16*)xrow + 4 * lane + 256 * j); R.x[j] = (f32x4){bflo(w.x), bfhi(w.x), bflo(w.y), bfhi(w.y)}; }
        else R.x[j] = *(const f32x4*)((const float*)xrow + 4 * lane + 256 * j);
        if (COMB) { R.ya[j] = *(const v2u*)(y2 + (size_t)s0 * D + 4 * lane + 256 * j); R.yb[j] = *(const v2u*)(y2 + (size_t)s1 * D + 4 * lane + 256 * j); } }
}
__device__ __forceinline__ void load_etab(Frame& F, int L, bool fresh = true) {
#if MK_MODE == 0
    if (!fresh) return;
#endif
    LAS int* tab = (LAS int*)(F.lds + ETAB_OFF);
    if (F.tid < 16) tab[17 + F.tid] = (int)F.ctl[CTL_GCNT + L * 64 + F.tid];
    __syncthreads();
    if (F.tid == 0) { int ts = 0; for (int e = 0; e < 16; ++e) { tab[e] = ts; ts += (tab[17 + e] + 255) >> 8; } tab[16] = ts; }
    __syncthreads();
}
template <int L>
__device__ __forceinline__ void phase_a1(Frame& F, const int skip = 0) {
    const float* mod = (const float*)(F.ws + WS_MOD);
    bf16* xres = (bf16*)(F.ws + WS_XRES); bf16* hb = (bf16*)(F.ws + WS_H);
    const bf16* y2 = (const bf16*)(F.ws + WS_Y2); const int* toke = (const int*)(F.ws + WS_TOKE); const int* tokr = (const int*)(F.ws + WS_TOKR);
    if (L > 0) load_etab(F, L > 0 ? L - 1 : 0, false);
    if (L == 0 && F.blk < DEPTH * 9) {
        const int l = F.blk / 9, mr = F.blk - 9 * l, e = F.tid & 15, kq = F.tid >> 4;
        const float* shp = mod + (size_t)(l * 9 + mr) * 6144 + 3072; LAS float* red = (LAS float*)(F.lds);
        float a = 0.f;
        for (int k = 32 * kq; k < 32 * kq + 32; ++k) a += shp[k] * F.in[IN_RW][k * 16 + e];
        red[F.tid] = a; __syncthreads();
        if (F.tid < 16) { float t = 0.f; for (int q = 0; q < 32; ++q) t += red[q * 16 + F.tid]; ((float*)(F.ws + WS_SLOTW))[(l * 9 + mr) * 16 + F.tid] = t; }
    }
    if (L == 0 && F.blk >= 64 && F.blk < 96 && F.tid < 64) {
        const int i = (F.blk - 64) * 64 + F.tid, ks = i >> 6, ln = i & 63, e = ln & 15, k0 = 32 * ks + 8 * (ln >> 4);
        float w[8]; unsigned hi[4], lo[4];
#pragma unroll
        for (int jj = 0; jj < 8; ++jj) w[jj] = F.in[IN_RW][(k0 + jj) * 16 + e];
#pragma unroll
        for (int jj = 0; jj < 4; ++jj) { hi[jj] = pk2(w[2 * jj], w[2 * jj + 1]); lo[jj] = pk2(w[2 * jj] - bflo(hi[jj]), w[2 * jj + 1] - bfhi(hi[jj])); }
        v4u* rwfg = (v4u*)(F.ws + WS_RWF); rwfg[2 * i] = (v4u){hi[0], hi[1], hi[2], hi[3]}; rwfg[2 * i + 1] = (v4u){lo[0], lo[1], lo[2], lo[3]};
    }
    const LAS int* etab = (const LAS int*)(F.lds + ETAB_OFF);
    auto toks = [&](int idx) { return etab[toke[idx]] * 256 + tokr[idx]; };
    const int vblk = ((F.G & 7) == 0) ? (F.blk & 7) * (F.G >> 3) + (F.blk >> 3) : F.blk;
    const int gw = vblk * NWAVES + F.wave, NGW = F.G * NWAVES, lane = F.lane;
    const int RPW = (T + NGW - 1) / NGW, r0 = gw * RPW, r1 = (r0 + RPW < T) ? r0 + RPW : T;
    if (r0 >= T) return;
    f32x4 gv[4];
#pragma unroll
    for (int j = 0; j < 4; ++j) gv[j] = *(const f32x4*)(F.in[IN_N1G] + L * D + 4 * lane + 256 * j);
    auto rowptr = [&](int r) -> const void* { if (L == 0) return (r < TC) ? (const void*)(F.in[IN_CTX] + (size_t)r * D) : (const void*)(F.in[IN_X] + (size_t)(r - TC) * D); return (const void*)(xres + (size_t)r * D); };
    RowMod M1, M2; M1.mr = -1; M2.mr = -1;
    int ns0 = 0, ns1 = 0;
    if (L > 0) { ns0 = toks(2 * r0); ns1 = toks(2 * r0 + 1); }
    const float* tokw = (const float*)(F.ws + WS_TOKW);
    RawRow nx; raw_load<(L > 0), (L > 0)>(nx, rowptr(r0), y2, ns0, ns1, lane); nx.w0 = 0.f; nx.w1 = 0.f; if (L > 0) { nx.w0 = tokw[2 * r0]; nx.w1 = tokw[2 * r0 + 1]; }
    if (L > 0 && r0 + 1 < r1) { ns0 = toks(2 * r0 + 2); ns1 = toks(2 * r0 + 3); }
    for (int r = r0; r < r1; ++r) {
        const int mr = mrow_of(r);
        RawRow cur = nx;
        if (r + 1 < r1) { raw_load<(L > 0), (L > 0)>(nx, rowptr(r + 1), y2, ns0, ns1, lane); if (L > 0) { nx.w0 = tokw[2 * r + 2]; nx.w1 = tokw[2 * r + 3]; } if (L > 0 && r + 2 < r1) { ns0 = toks(2 * r + 4); ns1 = toks(2 * r + 5); } }
        rowmod_load(M1, mod + (size_t)L * 9 * 6144, mr, 0, 1024, -1, lane);
        if (L > 0) rowmod_load(M2, mod + (size_t)(L - 1) * 9 * 6144, mr, 5120, 5120, -1, lane);
        float ss = 0.f;
#pragma unroll
        for (int j = 0; j < 4; ++j) {
            f32x4 v = cur.x[j];
            if (L > 0) { const v2u a = cur.ya[j], b = cur.yb[j]; const f32x4 gg = M2.a[j]; const float w0 = cur.w0, w1 = cur.w1;
                v.x += gg.x * (w0 * bflo(a.x) + w1 * bflo(b.x)); v.y += gg.y * (w0 * bfhi(a.x) + w1 * bfhi(b.x)); v.z += gg.z * (w0 * bflo(a.y) + w1 * bflo(b.y)); v.w += gg.w * (w0 * bfhi(a.y) + w1 * bfhi(b.y)); }
            cur.x[j] = v;
            if (!skip) st_bf4(xres + (size_t)r * D + 4 * lane + 256 * j, v); ss += v.x * v.x + v.y * v.y + v.z * v.z + v.w * v.w;
        }
        const float rs = rsqrtf(wave_sum(ss) * (1.f / D) + EPS);
#pragma unroll
        for (int j = 0; j < 4; ++j) { const f32x4 h = cur.x[j] * rs * gv[j] * (M1.b[j] + 1.f) + M1.a[j]; st_bf4(hb + (size_t)r * D + 4 * lane + 256 * j, h); }
    }
}
__device__ __forceinline__ float quad_get(float v, int k) {
    return k == 1 ? dpp_f<0x39>(v, v) : k == 2 ? dpp_f<0x4E>(v, v) : dpp_f<0x93>(v, v); }
template <int L>
__device__ __forceinline__ void phase_n2(Frame& F, const int var = 0) {
    constexpr int R0 = (L == DEPTH - 1) ? TC : 0;
    const float* mod = (const float*)(F.ws + WS_MOD);
    const bf16* xres = (const bf16*)(F.ws + WS_XRES); bf16* hb = (bf16*)(F.ws + WS_H);
    int* toke = (int*)(F.ws + WS_TOKE); int* tokr = (int*)(F.ws + WS_TOKR);
    const float* qw = (const float*)(F.ws + WS_SLOTW);
    LAS v4u* rwf = (LAS v4u*)(F.lds);
    LAS float* PS = (LAS float*)(F.lds + 65536);
    LAS float* PL = (LAS float*)(F.lds + 65536 + 1024);
    LAS int* entE = (LAS int*)(F.lds + 82944); LAS int* entR = entE + 256; LAS float* entW = (LAS float*)(entR + 256); LAS int* baseL = entE + 768;
    constexpr int NTLMAX = 5;
    LAS float* GM = (LAS float*)(F.lds + 86080);
    LAS float* SH = GM + NTLMAX * 1024;
    static_assert(86080 + 2 * NTLMAX * 4096 <= RING_BYTES, "N2 LDS");
    LAS int* cntL = (LAS int*)(F.lds + SCT_OFF);
    constexpr int NTILES = (T - R0) / 16;
    const bool xal = ((F.G & 7) == 0) && (NTILES % 8 == 0);
    const int tper = xal ? (F.G >> 3) : F.G, tk = xal ? (F.blk >> 3) : F.blk, tbase = xal ? (F.blk & 7) * (NTILES / 8) : 0, tlim = xal ? NTILES / 8 : NTILES;
    auto tile_of = [&](int j) { return tbase + tk + tper * j; };
    const int ntl = (tlim - tk + tper - 1) / tper;
    { const v4u* rwfg = (const v4u*)(F.ws + WS_RWF); v4u t[8];
#pragma unroll
      for (int q = 0; q < 8; ++q) t[q] = rwfg[F.tid + NTHR * q];
      f32x4 gq[3], shq[3], scq[3]; const int kq = (F.tid & 255) * 4;
#pragma unroll
      for (int p2 = 0; p2 < 3; ++p2) { const int j = 2 * p2 + (F.tid >> 8);
          if (j < ntl && j < NTLMAX) { const int mrj = mrow_of(R0 + 16 * tile_of(j)); const float* mp = mod + (size_t)(L * 9 + mrj) * 6144 + 3072 + kq;
              gq[p2] = *(const f32x4*)(F.in[IN_N2G] + L * D + kq); shq[p2] = *(const f32x4*)mp; scq[p2] = *(const f32x4*)(mp + 1024); } }
#pragma unroll
      for (int q = 0; q < 8; ++q) rwf[F.tid + NTHR * q] = t[q];
#pragma unroll
      for (int p2 = 0; p2 < 3; ++p2) { const int j = 2 * p2 + (F.tid >> 8);
          if (j < ntl && j < NTLMAX) { *(LAS f32x4*)(GM + j * 1024 + kq) = gq[p2] * (scq[p2] + 1.f); *(LAS f32x4*)(SH + j * 1024 + kq) = shq[p2]; } } }
    if (F.tid < 16) cntL[F.tid] = 0;
    __syncthreads();
    const int lane = F.lane, rl = lane & 15, kg = lane >> 4, w = F.wave;
    const float rbias = F.in[IN_RB][rl];
    const int c0 = 128 * w + 8 * kg;
    v4u xw4[4];
    if (ntl > 0) { const bf16* xr = xres + (size_t)(R0 + 16 * tile_of(0) + rl) * D + c0;
#pragma unroll
        for (int q = 0; q < 4; ++q) xw4[q] = *(const v4u*)(xr + 32 * q); }
    for (int j = 0; j < ntl; ++j) {
        const int tile = tile_of(j), rbase = R0 + 16 * tile, mr = mrow_of(rbase), pb = j & 1;
        const float qwv = qw[(L * 9 + mr) * 16 + rl];
        f32x4 ua[4], ub[4]; float ss = 0.f; f32x4 acc = (f32x4){0.f, 0.f, 0.f, 0.f};
#pragma unroll
        for (int q = 0; q < 4; ++q) { const v4u t = xw4[q]; const f32x4 xa = (f32x4){bflo(t.x), bfhi(t.x), bflo(t.y), bfhi(t.y)}, xb = (f32x4){bflo(t.z), bfhi(t.z), bflo(t.w), bfhi(t.w)};
            ss += xa.x * xa.x + xa.y * xa.y + xa.z * xa.z + xa.w * xa.w + xb.x * xb.x + xb.y * xb.y + xb.z * xb.z + xb.w * xb.w;
            const f32x4 g0 = *(const LAS f32x4*)(GM + j * 1024 + c0 + 32 * q), g1 = *(const LAS f32x4*)(GM + j * 1024 + c0 + 32 * q + 4);
            ua[q] = xa * g0; ub[q] = xb * g1;
            const float h[8] = {ua[q].x, ua[q].y, ua[q].z, ua[q].w, ub[q].x, ub[q].y, ub[q].z, ub[q].w};
            unsigned hi[4], lo[4];
#pragma unroll
            for (int jj = 0; jj < 4; ++jj) { hi[jj] = pk2(h[2 * jj], h[2 * jj + 1]); lo[jj] = pk2(h[2 * jj] - bflo(hi[jj]), h[2 * jj + 1] - bfhi(hi[jj])); }
            const v4u hv = (v4u){hi[0], hi[1], hi[2], hi[3]}, lv = (v4u){lo[0], lo[1], lo[2], lo[3]};
            const int ks = 4 * w + q;
            const v4u bh = rwf[2 * (ks * 64 + lane)], bl = rwf[2 * (ks * 64 + lane) + 1];
            acc = __builtin_amdgcn_mfma_f32_16x16x32_bf16(__builtin_bit_cast(bf16x8, hv), __builtin_bit_cast(bf16x8, bh), acc, 0, 0, 0);
            acc = __builtin_amdgcn_mfma_f32_16x16x32_bf16(__builtin_bit_cast(bf16x8, hv), __builtin_bit_cast(bf16x8, bl), acc, 0, 0, 0);
            acc = __builtin_amdgcn_mfma_f32_16x16x32_bf16(__builtin_bit_cast(bf16x8, lv), __builtin_bit_cast(bf16x8, bh), acc, 0, 0, 0);
        }
        ss = xor16_sum(ss); ss = xor32_sum(ss);
        if (kg == 0) PS[(pb * 8 + w) * 16 + rl] = ss;
        *(LAS f32x4*)(PL + ((pb * 8 + w) * 64 + lane) * 4) = acc;
        if (j + 1 < ntl) { const bf16* xr = xres + (size_t)(R0 + 16 * tile_of(j + 1) + rl) * D + c0;
#pragma unroll
            for (int q = 0; q < 4; ++q) xw4[q] = *(const v4u*)(xr + 32 * q); }
        __syncthreads();
        float tot = 0.f;
#pragma unroll
        for (int ww = 0; ww < 8; ++ww) tot += PS[(pb * 8 + ww) * 16 + rl];
        const float rs = rsqrtf(tot * (1.f / D) + EPS);
        bf16* hrow = hb + (size_t)(rbase + rl) * D + c0;
#pragma unroll
        for (int q = 0; q < 4; ++q) { const f32x4 s0 = *(const LAS f32x4*)(SH + j * 1024 + c0 + 32 * q), s1 = *(const LAS f32x4*)(SH + j * 1024 + c0 + 32 * q + 4);
            const f32x4 h0 = ua[q] * rs + s0, h1 = ub[q] * rs + s1;
            *(v4u*)(hrow + 32 * q) = (v4u){pk2(h0.x, h0.y), pk2(h0.z, h0.w), pk2(h1.x, h1.y), pk2(h1.z, h1.w)}; }
        if (var & 1) continue;
        {
            const int rowi = 2 * w + ((lane >> 4) & 1), kgp = rowi >> 2, rr = rowi & 3;
            float lgv = 0.f, tr = 0.f;
#pragma unroll
            for (int ww = 0; ww < 8; ++ww) { lgv += PL[((pb * 8 + ww) * 64 + kgp * 16 + rl) * 4 + rr]; tr += PS[(pb * 8 + ww) * 16 + rowi]; }
            const float logit = lgv * rsqrtf(tr * (1.f / D) + EPS) + qwv;
            const float sco = sigmoidf_(logit), sel = sco + rbias;
            int rank = 0;
#pragma unroll
            for (int k = 1; k < 4; ++k) { const float o = quad_get(sel, k); const int oi = (rl & ~3) | ((rl + k) & 3); rank += (o > sel || (o == sel && oi < rl)) ? 1 : 0; }
            const bool top2 = rank < 2;
            float gs = top2 ? sel : 0.f; gs += dpp_f<0xB1>(0.f, gs); gs += dpp_f<0x4E>(0.f, gs);
            bool best = true; const int q = rl >> 2;
            { const float o1 = dpp_f<0x124>(gs, gs), o2 = dpp_f<0x128>(gs, gs), o3 = dpp_f<0x12C>(gs, gs);
              const int q1 = (q + 3) & 3, q2 = (q + 2) & 3, q3 = (q + 1) & 3;
              best = !(o1 > gs || (o1 == gs && q1 < q)) && !(o2 > gs || (o2 == gs && q2 < q)) && !(o3 > gs || (o3 == gs && q3 < q)); }
            const bool selv = best && top2;
            const float wsum = red16_sum(selv ? sco : 0.f);
            if (selv && lane < 32) { const int lr = __hip_atomic_fetch_add(cntL + rl, 1, __ATOMIC_RELAXED, __HIP_MEMORY_SCOPE_WORKGROUP);
                const int ei = j * 32 + rowi * 2 + rank; entE[ei] = rl; entR[ei] = lr; entW[ei] = sco * __builtin_amdgcn_rcpf(wsum); }
        }
    }
    __syncthreads();
    if (var & 1) return;
    if (F.tid < 16) baseL[F.tid] = (int)__hip_atomic_fetch_add(F.ctl + CTL_GCNT + L * 64 + F.tid, (unsigned)cntL[F.tid], __ATOMIC_RELAXED, __HIP_MEMORY_SCOPE_AGENT);
    __syncthreads();
    int* slotre = (int*)(F.ws + WS_SLOTRE); float* tokw = (float*)(F.ws + WS_TOKW);
    for (int i = F.tid; i < ntl * 32; i += NTHR) { const int j = i >> 5, row = R0 + 16 * tile_of(j) + ((i & 31) >> 1), k = i & 1;
        const int e = entE[i], pos = baseL[e] + entR[i];
        toke[2 * row + k] = e; tokr[2 * row + k] = pos; tokw[2 * row + k] = entW[i]; slotre[e * T + pos] = row; }
}
__device__ __forceinline__ void phase_fin(Frame& F) {
    const float* mod = (const float*)(F.ws + WS_MOD);
    const bf16* xres = (const bf16*)(F.ws + WS_XRES);
    const bf16* y2 = (const bf16*)(F.ws + WS_Y2); const int* toke = (const int*)(F.ws + WS_TOKE); const int* tokr = (const int*)(F.ws + WS_TOKR);
    load_etab(F, DEPTH - 1, false);
    const LAS int* etab = (const LAS int*)(F.lds + ETAB_OFF);
    auto toks = [&](int idx) { return etab[toke[idx]] * 256 + tokr[idx]; };
    const int gw = F.blk * NWAVES + F.wave, NGW = F.G * NWAVES, lane = F.lane;
    const int RPW = (TL + NGW - 1) / NGW, r0 = TC + gw * RPW, r1 = (r0 + RPW < T) ? r0 + RPW : T;
    if (r0 >= T) return;
    f32x4 gv[4];
#pragma unroll
    for (int j = 0; j < 4; ++j) gv[j] = *(const f32x4*)(F.in[IN_FING] + 4 * lane + 256 * j);
    RowMod M2; M2.mr = -1;
    int ns0 = toks(2 * r0), ns1 = toks(2 * r0 + 1);
    const float* tokw = (const float*)(F.ws + WS_TOKW);
    RawRow nx; raw_load<true, true>(nx, xres + (size_t)r0 * D, y2, ns0, ns1, lane); nx.w0 = tokw[2 * r0]; nx.w1 = tokw[2 * r0 + 1];
    if (r0 + 1 < r1) { ns0 = toks(2 * r0 + 2); ns1 = toks(2 * r0 + 3); }
    for (int r = r0; r < r1; ++r) {
        const int mr = mrow_of(r);
        RawRow cur = nx;
        if (r + 1 < r1) { raw_load<true, true>(nx, xres + (size_t)(r + 1) * D, y2, ns0, ns1, lane); nx.w0 = tokw[2 * r + 2]; nx.w1 = tokw[2 * r + 3]; if (r + 2 < r1) { ns0 = toks(2 * r + 4); ns1 = toks(2 * r + 5); } }
        rowmod_load(M2, mod + (size_t)(DEPTH - 1) * 9 * 6144, mr, 5120, 5120, -1, lane);
        float ss = 0.f;
#pragma unroll
        for (int j = 0; j < 4; ++j) { f32x4 v = cur.x[j]; const v2u a = cur.ya[j], b = cur.yb[j]; const f32x4 gg = M2.a[j]; const float w0 = cur.w0, w1 = cur.w1;
            v.x += gg.x * (w0 * bflo(a.x) + w1 * bflo(b.x)); v.y += gg.y * (w0 * bfhi(a.x) + w1 * bfhi(b.x)); v.z += gg.z * (w0 * bflo(a.y) + w1 * bflo(b.y)); v.w += gg.w * (w0 * bfhi(a.y) + w1 * bfhi(b.y));
            cur.x[j] = v; ss += v.x * v.x + v.y * v.y + v.z * v.z + v.w * v.w; }
        const float rs = rsqrtf(wave_sum(ss) * (1.f / D) + EPS);
#pragma unroll
        for (int j = 0; j < 4; ++j) *(f32x4*)(F.out + (size_t)(r - TC) * D + 4 * lane + 256 * j) = cur.x[j] * rs * gv[j];
    }
}

__device__ __forceinline__ int seq_row(int b, int dir, int s) {
    if (s < CTX) return b * CTX + (dir ? (CTX - 1 - s) : s);
    const int t = s - CTX; return TC + b * SEQ + (dir ? (SEQ - 1 - t) : t);
}
template <int J, bool WCTX>
__device__ __forceinline__ void phase_s5_naive(Frame& F) {
    const int gw = F.blk * NWAVES + F.wave, lane = F.lane;
    if ((gw & 3) != 0) return;
    const int it = gw >> 2; if (it >= NB * 64) return;
    const int b = it >> 6, g = it & 63, p = lane;
    const bf16* hb = (const bf16*)(F.ws + WS_H); float* ysum = (float*)(F.ws + WS_YSUM);
    for (int dir = 0; dir < 2; ++dir) {
        const int gi = (J * 2 + dir) * 64 + g, pidx = gi * 64 + p;
        const float lam_re = F.in[IN_S5LRE][pidx], lam_im = F.in[IN_S5LIM][pidx];
        const float dt = expf(F.in[IN_S5LOG][gi]);
        const float mag = expf(lam_re * dt);
        double sd, cd; sincos_d((double)(lam_im * dt), sd, cd);
        const float a_re = mag * (float)cd, a_im = mag * (float)sd;
        const float den = lam_re * lam_re + lam_im * lam_im, n_re = a_re - 1.f, n_im = a_im;
        const float f_re = (n_re * lam_re + n_im * lam_im) / den, f_im = (n_im * lam_re - n_re * lam_im) / den;
        float bbr[16], bbi[16], cre[16], cim[16];
#pragma unroll
        for (int c = 0; c < 16; ++c) { const float br = F.in[IN_S5BRE][(size_t)pidx * 16 + c], bi = F.in[IN_S5BIM][(size_t)pidx * 16 + c];
            bbr[c] = f_re * br - f_im * bi; bbi[c] = f_re * bi + f_im * br;
            cre[c] = F.in[IN_S5CRE][((size_t)gi * 16 + c) * 64 + p]; cim[c] = F.in[IN_S5CIM][((size_t)gi * 16 + c) * 64 + p]; }
        float x_re = 0.f, x_im = 0.f;
        for (int s = 0; s < CTX + SEQ; ++s) {
            const int r = seq_row(b, dir, s);
            const v4u u0 = *(const v4u*)(hb + (size_t)r * D + g * 16), u1 = *(const v4u*)(hb + (size_t)r * D + g * 16 + 8);
            float u[16];
            u[0] = bflo(u0.x); u[1] = bfhi(u0.x); u[2] = bflo(u0.y); u[3] = bfhi(u0.y); u[4] = bflo(u0.z); u[5] = bfhi(u0.z); u[6] = bflo(u0.w); u[7] = bfhi(u0.w);
            u[8] = bflo(u1.x); u[9] = bfhi(u1.x); u[10] = bflo(u1.y); u[11] = bfhi(u1.y); u[12] = bflo(u1.z); u[13] = bfhi(u1.z); u[14] = bflo(u1.w); u[15] = bfhi(u1.w);
            float bur = 0.f, bui = 0.f;
#pragma unroll
            for (int c = 0; c < 16; ++c) { bur += u[c] * bbr[c]; bui += u[c] * bbi[c]; }
            const float nr = a_re * x_re - a_im * x_im + bur, ni = a_re * x_im + a_im * x_re + bui;
            x_re = nr; x_im = ni;
            if (WCTX || s >= CTX) {
                float yv = 0.f;
#pragma unroll
                for (int c = 0; c < 16; ++c) { const float t = wave_sum(x_re * cre[c] - x_im * cim[c]); if (lane == c) yv = t; }
                if (lane < 16) { float* yp = ysum + (size_t)r * D + g * 16 + lane; if (dir == 0) *yp = yv; else *yp = *yp + yv; }
            }
        }
    }
}
template <int J, bool WCTX>
__device__ __forceinline__ void phase_s5_combine(Frame& F) {
    constexpr int R0 = WCTX ? 0 : TC;
    const bf16* hb = (const bf16*)(F.ws + WS_H); const float* ysum = (const float*)(F.ws + WS_YSUM); bf16* zb = (bf16*)(F.ws + WS_Z);
    const int gw = F.blk * NWAVES + F.wave, NGW = F.G * NWAVES, lane = F.lane;
    f32x4 dv[4];
#pragma unroll
    for (int j = 0; j < 4; ++j) dv[j] = *(const f32x4*)(F.in[IN_S5D] + J * D + 4 * lane + 256 * j);
    for (int r = R0 + gw; r < T; r += NGW) {
#pragma unroll
        for (int j = 0; j < 4; ++j) {
            const f32x4 y = *(const f32x4*)(ysum + (size_t)r * D + 4 * lane + 256 * j);
            const v2u hv = *(const v2u*)(hb + (size_t)r * D + 4 * lane + 256 * j);
            f32x4 z; z.x = gelu_tanh(y.x + dv[j].x * bflo(hv.x)); z.y = gelu_tanh(y.y + dv[j].y * bfhi(hv.x)); z.z = gelu_tanh(y.z + dv[j].z * bflo(hv.y)); z.w = gelu_tanh(y.w + dv[j].w * bfhi(hv.y));
            st_bf4(zb + (size_t)r * D + 4 * lane + 256 * j, z);
        }
    }
}
template <bool WCTX>
__device__ __forceinline__ void phase_attn_naive(Frame& F) {
    constexpr int R0 = WCTX ? 0 : TC;
    const bf16* qb = (const bf16*)(F.ws + WS_QB); const bf16* kb = (const bf16*)(F.ws + WS_KB); const bf16* vb = (const bf16*)(F.ws + WS_VB); bf16* zb = (bf16*)(F.ws + WS_Z);
    const int gw = F.blk * NWAVES + F.wave, NGW = F.G * NWAVES, lane = F.lane;
    for (int it = gw; it < (T - R0) * 16; it += NGW) {
        const int r = R0 + (it >> 4), h = it & 15, kvh = h >> 2;
        int kv0, nk;
        if (r < TC) { kv0 = (r >> 8) * KVLEN + SEQ; nk = CTX; } else { kv0 = ((r - TC) >> 11) * KVLEN; nk = KVLEN; }
        float q[64];
#pragma unroll
        for (int c = 0; c < 8; ++c) { const v4u w = *(const v4u*)(qb + (size_t)r * D + h * 64 + 8 * c);
            q[8 * c] = bflo(w.x); q[8 * c + 1] = bfhi(w.x); q[8 * c + 2] = bflo(w.y); q[8 * c + 3] = bfhi(w.y); q[8 * c + 4] = bflo(w.z); q[8 * c + 5] = bfhi(w.z); q[8 * c + 6] = bflo(w.w); q[8 * c + 7] = bfhi(w.w); }
        float m = -INFINITY, l = 0.f, o[64];
#pragma unroll
        for (int d = 0; d < 64; ++d) o[d] = 0.f;
        for (int kk = lane; kk < nk; kk += 64) {
            const bf16* kp = kb + (size_t)(kv0 + kk) * 256 + kvh * 64; const bf16* vp = vb + (size_t)(kv0 + kk) * 256 + kvh * 64;
            float s = 0.f;
#pragma unroll
            for (int c = 0; c < 8; ++c) { const v4u w = *(const v4u*)(kp + 8 * c);
                s += q[8 * c] * bflo(w.x) + q[8 * c + 1] * bfhi(w.x) + q[8 * c + 2] * bflo(w.y) + q[8 * c + 3] * bfhi(w.y) + q[8 * c + 4] * bflo(w.z) + q[8 * c + 5] * bfhi(w.z) + q[8 * c + 6] * bflo(w.w) + q[8 * c + 7] * bfhi(w.w); }
            const float mn = fmaxf(m, s), sc = exp2f(m - mn), pp = exp2f(s - mn);
            l = l * sc + pp; m = mn;
#pragma unroll
            for (int c = 0; c < 8; ++c) { const v4u w = *(const v4u*)(vp + 8 * c);
                o[8 * c] = o[8 * c] * sc + pp * bflo(w.x); o[8 * c + 1] = o[8 * c + 1] * sc + pp * bfhi(w.x); o[8 * c + 2] = o[8 * c + 2] * sc + pp * bflo(w.y); o[8 * c + 3] = o[8 * c + 3] * sc + pp * bfhi(w.y);
                o[8 * c + 4] = o[8 * c + 4] * sc + pp * bflo(w.z); o[8 * c + 5] = o[8 * c + 5] * sc + pp * bfhi(w.z); o[8 * c + 6] = o[8 * c + 6] * sc + pp * bflo(w.w); o[8 * c + 7] = o[8 * c + 7] * sc + pp * bfhi(w.w); }
        }
        const float M = wave_max(m), f = exp2f(m - M);
        const float lt = wave_sum(l * f);
        float res = 0.f;
#pragma unroll
        for (int d = 0; d < 64; ++d) { const float t = wave_sum(o[d] * f); if (lane == d) res = t; }
        zb[(size_t)r * D + h * 64 + lane] = (bf16)f2bf(res / lt);
    }
}
template <bool WCTX>
__device__ __forceinline__ void phase_mlstm_naive(Frame& F) {
    const int gw = F.blk * NWAVES + F.wave, lane = F.lane;
    if ((gw & 15) != 0) return;
    const int it = gw >> 4; if (it >= NB * 8 * 2) return;
    const int b = it >> 4, hd = (it >> 1) & 7, j = (it & 1) * 64 + lane;
    const bf16* kb = (const bf16*)(F.ws + WS_MK); const bf16* vb = (const bf16*)(F.ws + WS_MV); const bf16* qb = (const bf16*)(F.ws + WS_MQ);
    const float* gb = (const float*)(F.ws + WS_MG); float* hsum = (float*)(F.ws + WS_MHS);
    for (int dir = 0; dir < 2; ++dir) {
        float C[64], nn[64], m = 0.f;
#pragma unroll
        for (int d = 0; d < 64; ++d) { C[d] = 0.f; nn[d] = 0.f; }
        for (int s = 0; s < CTX + SEQ; ++s) {
            const int r = seq_row(b, dir, s);
            const float ig = gb[(size_t)r * 32 + dir * 16 + hd], lf = log_sigmoidf_(gb[(size_t)r * 32 + dir * 16 + 8 + hd]);
            const float mn = fmaxf(lf + m, ig), fa = __expf(lf + m - mn), ia = __expf(ig - mn); m = mn;
            const float vj = bf2f(vb[(size_t)r * 1024 + hd * 128 + j]) * ia;
            float num = 0.f, den = 0.f;
#pragma unroll
            for (int c = 0; c < 8; ++c) {
                const v4u kw = *(const v4u*)(kb + (size_t)r * 512 + hd * 64 + 8 * c), qw = *(const v4u*)(qb + (size_t)r * 512 + hd * 64 + 8 * c);
                float kk[8], qq[8];
                kk[0] = bflo(kw.x); kk[1] = bfhi(kw.x); kk[2] = bflo(kw.y); kk[3] = bfhi(kw.y); kk[4] = bflo(kw.z); kk[5] = bfhi(kw.z); kk[6] = bflo(kw.w); kk[7] = bfhi(kw.w);
                qq[0] = bflo(qw.x); qq[1] = bfhi(qw.x); qq[2] = bflo(qw.y); qq[3] = bfhi(qw.y); qq[4] = bflo(qw.z); qq[5] = bfhi(qw.z); qq[6] = bflo(qw.w); qq[7] = bfhi(qw.w);
#pragma unroll
                for (int e = 0; e < 8; ++e) { const int d = 8 * c + e;
                    C[d] = fa * C[d] + kk[e] * vj; nn[d] = fa * nn[d] + ia * kk[e]; num += C[d] * qq[e]; den += nn[d] * qq[e]; }
            }
            if (WCTX || s >= CTX) {
                const float outv = num / fmaxf(fabsf(den), __expf(-m));
                float* hp = hsum + (size_t)r * D + hd * 128 + j;
                if (dir == 0) *hp = outv; else *hp = *hp + outv;
            }
        }
    }
}
template <bool WCTX>
__device__ __forceinline__ void phase_mlstm_combine(Frame& F) {
    constexpr int R0 = WCTX ? 0 : TC;
    const float* hsum = (const float*)(F.ws + WS_MHS); const bf16* ob = (const bf16*)(F.ws + WS_MO); bf16* zb = (bf16*)(F.ws + WS_Z);
    const int gw = F.blk * NWAVES + F.wave, NGW = F.G * NWAVES, lane = F.lane;
    f32x4 gv[4];
#pragma unroll
    for (int j = 0; j < 4; ++j) gv[j] = *(const f32x4*)(F.in[IN_MLNG] + 4 * lane + 256 * j);
    for (int r = R0 + gw; r < T; r += NGW) {
#pragma unroll
        for (int j = 0; j < 4; ++j) {
            const f32x4 hv = *(const f32x4*)(hsum + (size_t)r * D + 4 * lane + 256 * j);
            float ss = hv.x * hv.x + hv.y * hv.y + hv.z * hv.z + hv.w * hv.w;
#pragma unroll
            for (int o = 1; o < 32; o <<= 1) ss += __shfl_xor(ss, o);
            const float rs = rsqrtf(ss * (1.f / 128.f) + EPS);
            const v2u ow = *(const v2u*)(ob + (size_t)r * D + 4 * lane + 256 * j);
            f32x4 z = hv * rs * gv[j];
            z.x *= sigmoidf_(bflo(ow.x)); z.y *= sigmoidf_(bfhi(ow.x)); z.z *= sigmoidf_(bflo(ow.y)); z.w *= sigmoidf_(bfhi(ow.y));
            st_bf4(zb + (size_t)r * D + 4 * lane + 256 * j, z);
        }
    }
}
#include <hip/hip_bf16.h>
#include <cmath>
namespace attn_body {
using bf16=__hip_bfloat16;
using bf16x8=__attribute__((ext_vector_type(8)))short;
using s16x4=__attribute__((ext_vector_type(4)))short;
using f32x16=__attribute__((ext_vector_type(16)))float;
using u32x4=__attribute__((ext_vector_type(4)))unsigned;
constexpr int D=64,QP=1024,KP=256;
constexpr int NW=8,QBLK=32,QB=QBLK*NW,KVBLK=64;
__device__ __forceinline__ int crow(int r,int hi){return (r&3)+8*(r>>2)+4*hi;}
#define SBAR() __builtin_amdgcn_sched_barrier(0)
__device__ __forceinline__ void cmask(f32x16&p0,f32x16&p1,int jb,int qrel,int hi){
  const float NEG=-INFINITY; int kb=64*jb+4*hi;
  #pragma unroll
  for(int r=0;r<16;++r){int kv=kb+(r&3)+8*(r>>2); if(kv>qrel)p0[r]=NEG; if(kv+32>qrel)p1[r]=NEG;}
}

constexpr int NSLOT=3, SLOTB=8192;
constexpr int LDS_K=0, LDS_V=NSLOT*SLOTB, LDS_WS=2*NSLOT*SLOTB, LDS_OST=LDS_WS+NW*64*4, LDS_BYTES=LDS_OST+NW*4096;
constexpr float C2=0.125f*1.4426950408889634f;
__device__ __forceinline__ void glds16(const void*gsrc,unsigned lds_dst){unsigned keep;
  asm volatile("s_mov_b32 %0, m0\n\ts_mov_b32 m0, %2\n\ts_nop 0\n\tglobal_load_lds_dwordx4 %1, off\n\ts_mov_b32 m0, %0":"=&s"(keep):"v"(gsrc),"s"(lds_dst):"memory");}
__device__ __forceinline__ float max3f(float a,float b,float c){float r;asm("v_max3_f32 %0, %1, %2, %3":"=v"(r):"v"(a),"v"(b),"v"(c));return r;}
__device__ __forceinline__ float max2f(float a,float b){float r;asm("v_max_f32_e32 %0, %1, %2":"=v"(r):"v"(a),"v"(b));return r;}
__device__ __forceinline__ float fadd_s(float a,float b){float r;asm("v_add_f32_e32 %0, %1, %2":"=v"(r):"v"(a),"v"(b));return r;}
__device__ __forceinline__ float fsub_s(float a,float b){float r;asm("v_sub_f32_e32 %0, %1, %2":"=v"(r):"v"(a),"v"(b));return r;}
typedef float f32x2_t __attribute__((ext_vector_type(2))); typedef __bf16 bf16x2_t __attribute__((ext_vector_type(2)));
__device__ __forceinline__ unsigned cvtpk_s(float lo,float hi){f32x2_t v={lo,hi};bf16x2_t b=__builtin_convertvector(v,bf16x2_t);return __builtin_bit_cast(unsigned,b);}
#define WAIT_BAR(N) asm volatile("s_waitcnt vmcnt(" #N ") lgkmcnt(0)\n\ts_barrier":::"memory")

__device__ __forceinline__ void qkt(f32x16&p0,f32x16&p1,const char*Kslot,const bf16x8*qr,const f32x16&negm,int r32,int hi){
  const char*kb=Kslot+hi*1024+r32*16;
  #pragma unroll
  for(int d0=0;d0<4;++d0){
    const bf16x8 b0=*reinterpret_cast<const bf16x8*>(kb+d0*2048);
    const bf16x8 b1=*reinterpret_cast<const bf16x8*>(kb+d0*2048+512);
    if(d0==0){p0=__builtin_amdgcn_mfma_f32_32x32x16_bf16(b0,qr[0],negm,0,0,0);p1=__builtin_amdgcn_mfma_f32_32x32x16_bf16(b1,qr[0],negm,0,0,0);}
    else{p0=__builtin_amdgcn_mfma_f32_32x32x16_bf16(b0,qr[d0],p0,0,0,0);p1=__builtin_amdgcn_mfma_f32_32x32x16_bf16(b1,qr[d0],p1,0,0,0);}}
}
typedef __attribute__((address_space(3))) const char* lds_cptr;
typedef short v4i16_t __attribute__((ext_vector_type(4)));
__device__ __forceinline__ void kload8(bf16x8*kf,lds_cptr kp){
  kf[0]=*(const __attribute__((address_space(3))) bf16x8*)(kp);      kf[1]=*(const __attribute__((address_space(3))) bf16x8*)(kp+512);
  kf[2]=*(const __attribute__((address_space(3))) bf16x8*)(kp+2048); kf[3]=*(const __attribute__((address_space(3))) bf16x8*)(kp+2560);
  kf[4]=*(const __attribute__((address_space(3))) bf16x8*)(kp+4096); kf[5]=*(const __attribute__((address_space(3))) bf16x8*)(kp+4608);
  kf[6]=*(const __attribute__((address_space(3))) bf16x8*)(kp+6144); kf[7]=*(const __attribute__((address_space(3))) bf16x8*)(kp+6656);
}
__device__ __forceinline__ void kload2(bf16x8*kf,lds_cptr kp,int j){ kf[2*j]=*(const __attribute__((address_space(3))) bf16x8*)(kp+j*2048); kf[2*j+1]=*(const __attribute__((address_space(3))) bf16x8*)(kp+j*2048+512); }
__device__ __forceinline__ s16x4 vtr(lds_cptr p){ return __builtin_bit_cast(s16x4,__builtin_amdgcn_ds_read_tr16_b64_v4i16((__attribute__((address_space(3))) v4i16_t*)p)); }
__device__ __forceinline__ float rowmax(const f32x16&p0,const f32x16&p1){
  float a=max3f(p0[0],p0[1],p1[0]),b=max3f(p0[2],p0[3],p1[1]);a=max3f(a,p1[2],p1[3]);
  #pragma unroll
  for(int r=4;r<16;r+=4){a=max3f(a,p0[r],p0[r+1]);b=max3f(b,p0[r+2],p0[r+3]);a=max3f(a,p1[r],p1[r+1]);b=max3f(b,p1[r+2],p1[r+3]);}
  const float m=max2f(a,b);
  auto rr=__builtin_amdgcn_permlane32_swap(__float_as_uint(m),__float_as_uint(m),false,false);
  return max2f(__uint_as_float(rr[0]),__uint_as_float(rr[1]));
}
__device__ __forceinline__ void pv(f32x16*o,int vb,bf16x8 pa0,bf16x8 pa1,bf16x8 pa2,bf16x8 pa3){
  #pragma unroll
  for(int d0=0;d0<2;++d0){s16x4 lo[4],hi[4];
    #pragma unroll
    for(int ks=0;ks<4;++ks){
      asm volatile("ds_read_b64_tr_b16 %0,%1 offset:%c2":"=&v"(lo[ks]):"v"(vb),"i"(d0*4096+ks*1024):"memory");
      asm volatile("ds_read_b64_tr_b16 %0,%1 offset:%c2":"=&v"(hi[ks]):"v"(vb),"i"(d0*4096+ks*1024+512):"memory");}
    asm volatile("s_waitcnt lgkmcnt(0)":::"memory");SBAR();
    #define PK(k) (bf16x8){lo[k][0],lo[k][1],lo[k][2],lo[k][3],hi[k][0],hi[k][1],hi[k][2],hi[k][3]}
    o[d0]=__builtin_amdgcn_mfma_f32_32x32x16_bf16(pa0,PK(0),o[d0],0,0,0);
    o[d0]=__builtin_amdgcn_mfma_f32_32x32x16_bf16(pa1,PK(1),o[d0],0,0,0);
    o[d0]=__builtin_amdgcn_mfma_f32_32x32x16_bf16(pa2,PK(2),o[d0],0,0,0);
    o[d0]=__builtin_amdgcn_mfma_f32_32x32x16_bf16(pa3,PK(3),o[d0],0,0,0);
    #undef PK
  }
}

#ifndef ATTN_STORE16
#define ATTN_STORE16(p,v) (*(u32x4*)(p)=(v))
#endif
template<int THRL> __device__ __forceinline__ void attn_unit(const bf16*Qu,const bf16*__restrict__ Kh,const bf16*__restrict__ Vh,bf16*Ou,const int NT,char*shm){
  const int tid=threadIdx.x,lane=tid&63,r32=lane&31,hi=lane>>5; const int wid=__builtin_amdgcn_readfirstlane(tid>>6);
  const bf16*Qw=Qu+(long)(wid*QBLK)*QP;
  const unsigned lds0=(unsigned)(uintptr_t)shm;
  float*wsf=(float*)(shm+LDS_WS)+wid*64;
  const bf16*ksrc=Kh+(long)lane*KP+wid*8;
  const bf16*vsrc=Vh+(long)(16*(wid&3)+(lane>>2))*KP+(wid>>2)*32+(lane&3)*8;
  const unsigned kdst=lds0+LDS_K+wid*1024, vdst=lds0+LDS_V+wid*1024;
  #define DMA_K(t,slot) glds16(ksrc+(long)(t)*KVBLK*KP,(unsigned)__builtin_amdgcn_readfirstlane(kdst+(slot)))
  #define DMA_V(t,slot) glds16(vsrc+(long)(t)*KVBLK*KP,(unsigned)__builtin_amdgcn_readfirstlane(vdst+(slot)))
  const int vb0=(int)(lds0+LDS_V)+((lane>>4)&1)*32+(lane&3)*8+(4*hi+((lane&15)>>2))*64;
  const char*Kbase=shm+LDS_K; bf16x8 kf[8];
  const lds_cptr shm3=(lds_cptr)shm; const lds_cptr kp0=shm3+LDS_K+hi*1024+r32*16; const lds_cptr vp0=shm3+LDS_V+((lane>>4)&1)*32+(lane&3)*8+(4*hi+((lane&15)>>2))*64;
  DMA_K(0,0);DMA_V(0,0);DMA_K(1,SLOTB);
  bf16x8 qr[4];
  #pragma unroll
  for(int d0=0;d0<4;++d0)qr[d0]=*reinterpret_cast<const bf16x8*>(&Qw[(long)r32*QP+d0*16+hi*8]);
  float mhat=0.f,l_reg=0.f;f32x16 o[2];o[0]=f32x16{};o[1]=f32x16{};f32x16 negm=f32x16{};asm volatile("":"+v"(negm));
  #define CMASK(P0,P1,t) do{}while(0)
  bool resc=false;
  #define START(P0,P1) do{ const float rm=rowmax(P0,P1); resc=false; \
    { const float dl=rm; mhat=fadd_s(mhat,dl); \
      _Pragma("unroll") for(int r=0;r<16;++r){P0[r]=fsub_s(P0[r],dl);P1[r]=fsub_s(P1[r],dl);} \
      _Pragma("unroll") for(int r=0;r<16;++r)negm[r]=-mhat; asm volatile("":"+v"(negm)); } \
    _Pragma("unroll") for(int r=0;r<16;++r)P0[r]=__builtin_amdgcn_exp2f(P0[r]); }while(0)
  #define RESC() do{ if(resc){ asm volatile("s_waitcnt lgkmcnt(0)":::"memory"); \
      _Pragma("unroll") for(int d_=0;d_<2;++d_) _Pragma("unroll") for(int r=0;r<16;++r)o[d_][r]*=wsf[crow(r,hi)]; } }while(0)
  f32x16 pA0,pA1,pB0,pB1;
  int sl_prev=0,sl_cur=0,sl_next=SLOTB;
  #define ROT() do{sl_prev=sl_cur;sl_cur=sl_next;sl_next=(sl_next==(NSLOT-1)*SLOTB)?0:sl_next+SLOTB;}while(0)
  DMA_K(2,2*SLOTB);
  WAIT_BAR(3);
  qkt(pA0,pA1,Kbase,qr,negm,r32,hi);asm volatile("s_nop 15\n\ts_nop 7":"+v"(pA0),"+v"(pA1));CMASK(pA0,pA1,0);
  START(pA0,pA1);
  _Pragma("unroll") for(int r=0;r<16;++r)pA1[r]=__builtin_amdgcn_exp2f(pA1[r]);
  WAIT_BAR(0);
  DMA_K(3,0);DMA_V(1,SLOTB);
  ROT();
  kload8(kf,kp0+sl_cur);
  WAIT_BAR(2);
  s16x4 vlo[8],vhi[8]; u32x4 pw0,pw1,pw2,pw3;
  #define PKW(P,B) cvtpk_s(P[B],P[B+1])
  #define PAF(k) __builtin_bit_cast(bf16x8,pw##k)
  #define VFR(i) (bf16x8){vlo[i][0],vlo[i][1],vlo[i][2],vlo[i][3],vhi[i][0],vhi[i][1],vhi[i][2],vhi[i][3]}
  #define PIN(x) asm volatile("":"+v"(x))
  #define MX3(a,b,c) __builtin_fmaxf(__builtin_fmaxf((a),(b)),(c))
  #define GAPA(MF,A0,A1,A2,A3,W0,W1,PW) do{ MF; sacc+=A0; sacc+=A1; sacc+=A2; sacc+=A3; PIN(sacc); W0; W1; PIN(PW); SBAR(); }while(0)
  #define EX(v) __builtin_amdgcn_exp2f(v)
  #define GAPB(MF,X,B) do{ MF; X[B]=EX(X[B]); X[B+1]=EX(X[B+1]); X[B+2]=EX(X[B+2]); X[B+3]=EX(X[B+3]); PIN(X); SBAR(); }while(0)
  #define VRD(i) do{ vlo[i]=vtr(vp_+(((i)>>2)*4096+((i)&3)*1024)); vhi[i]=vtr(vp_+(((i)>>2)*4096+((i)&3)*1024+512)); }while(0)
  #define KRD(G,j) do{ if(G){ kload2(kf,kp0+sl_next,j); SBAR(); } }while(0)
  #define STEP(C0,C1,P0,P1,t,GK,GV,GL) do{ SBAR(); \
    const lds_cptr vp_=vp0+sl_prev; \
    VRD(0); SBAR(); float sacc=(P0[0]+P0[1]); \
    GAPA(C0=__builtin_amdgcn_mfma_f32_32x32x16_bf16(kf[0],qr[0],negm,0,0,0), P0[2],P0[3],P0[4],P0[5],     pw0[0]=PKW(P0,0), pw0[1]=PKW(P0,2), pw0); \
    VRD(4); SBAR(); GAPA(C1=__builtin_amdgcn_mfma_f32_32x32x16_bf16(kf[1],qr[0],negm,0,0,0), P0[6],P0[7],P0[8],P0[9],     pw0[2]=PKW(P0,4), pw0[3]=PKW(P0,6), pw0); \
    VRD(1); SBAR(); GAPA(C0=__builtin_amdgcn_mfma_f32_32x32x16_bf16(kf[2],qr[1],C0,0,0,0),   P0[10],P0[11],P0[12],P0[13], pw1[0]=PKW(P0,8), pw1[1]=PKW(P0,10), pw1); \
    VRD(5); SBAR(); GAPA(C1=__builtin_amdgcn_mfma_f32_32x32x16_bf16(kf[3],qr[1],C1,0,0,0),   P0[14],P0[15],P1[0],P1[1],   pw1[2]=PKW(P0,12),pw1[3]=PKW(P0,14), pw1); \
    VRD(2); SBAR(); GAPA(C0=__builtin_amdgcn_mfma_f32_32x32x16_bf16(kf[4],qr[2],C0,0,0,0),   P1[2],P1[3],P1[4],P1[5],     pw2[0]=PKW(P1,0), pw2[1]=PKW(P1,2), pw2); \
    VRD(6); SBAR(); GAPA(C1=__builtin_amdgcn_mfma_f32_32x32x16_bf16(kf[5],qr[2],C1,0,0,0),   P1[6],P1[7],P1[8],P1[9],     pw2[2]=PKW(P1,4), pw2[3]=PKW(P1,6), pw2); \
    VRD(3); SBAR(); GAPA(C0=__builtin_amdgcn_mfma_f32_32x32x16_bf16(kf[6],qr[3],C0,0,0,0),   P1[10],P1[11],P1[12],P1[13], pw3[0]=PKW(P1,8), pw3[1]=PKW(P1,10), pw3); \
    VRD(7); SBAR(); GAPA(C1=__builtin_amdgcn_mfma_f32_32x32x16_bf16(kf[7],qr[3],C1,0,0,0),   P1[14],P1[15],0.f,0.f,       pw3[2]=PKW(P1,12),pw3[3]=PKW(P1,14), pw3); \
    l_reg+=sacc; \
    if(GK){DMA_K((t)+3,sl_cur);} if(GV){DMA_V((t)+1,sl_next);} \
    CMASK(C0,C1,t); \
    { float a=MX3(C0[0],C0[1],C1[0]),b=MX3(C0[2],C0[3],C1[1]); a=MX3(a,C1[2],C1[3]); \
      _Pragma("unroll") for(int r=4;r<16;r+=4){a=MX3(a,C0[r],C0[r+1]);b=MX3(b,C0[r+2],C0[r+3]);a=MX3(a,C1[r],C1[r+1]);b=MX3(b,C1[r+2],C1[r+3]);} \
      float rm=__builtin_fmaxf(a,b); { auto rr=__builtin_amdgcn_permlane32_swap(__float_as_uint(rm),__float_as_uint(rm),false,false); rm=__builtin_fmaxf(__uint_as_float(rr[0]),__uint_as_float(rr[1])); } \
      resc=false; \
      if(__builtin_expect(__any(rm>(float)THRL),0)){ const float dl=__builtin_fmaxf(rm,0.f); mhat+=dl; \
        _Pragma("unroll") for(int r=0;r<16;++r){C0[r]-=dl;C1[r]-=dl;} \
        _Pragma("unroll") for(int r=0;r<16;++r)negm[r]=-mhat; asm volatile("":"+v"(negm)); \
        const float f=__builtin_amdgcn_exp2f(-dl); l_reg*=f; if(hi==0)wsf[r32]=f; resc=true; } } \
    SBAR(); \
    GAPB(o[0]=__builtin_amdgcn_mfma_f32_32x32x16_bf16(PAF(0),VFR(0),o[0],0,0,0), C0,0); \
    GAPB(o[1]=__builtin_amdgcn_mfma_f32_32x32x16_bf16(PAF(0),VFR(4),o[1],0,0,0), C0,4); \
    KRD(GL,0); GAPB(o[0]=__builtin_amdgcn_mfma_f32_32x32x16_bf16(PAF(1),VFR(1),o[0],0,0,0), C0,8); \
    KRD(GL,1); GAPB(o[1]=__builtin_amdgcn_mfma_f32_32x32x16_bf16(PAF(1),VFR(5),o[1],0,0,0), C0,12); \
    KRD(GL,2); GAPB(o[0]=__builtin_amdgcn_mfma_f32_32x32x16_bf16(PAF(2),VFR(2),o[0],0,0,0), C1,0); \
    KRD(GL,3); GAPB(o[1]=__builtin_amdgcn_mfma_f32_32x32x16_bf16(PAF(2),VFR(6),o[1],0,0,0), C1,4); \
    GAPB(o[0]=__builtin_amdgcn_mfma_f32_32x32x16_bf16(PAF(3),VFR(3),o[0],0,0,0), C1,8); \
    GAPB(o[1]=__builtin_amdgcn_mfma_f32_32x32x16_bf16(PAF(3),VFR(7),o[1],0,0,0), C1,12); \
    }while(0)
  int t=1;
  #undef CMASK
  #define CMASK(P0,P1,t) do{}while(0)
  for(;t+5<NT;t+=2){
    STEP(pB0,pB1,pA0,pA1,t,true,true,true);     WAIT_BAR(2); RESC(); ROT();
    STEP(pA0,pA1,pB0,pB1,t+1,true,true,true);   WAIT_BAR(2); RESC(); ROT();
  }
  #undef CMASK
  #define CMASK(P0,P1,t) do{}while(0)
  #define ENDW(tt) do{ if((tt)+3<NT){WAIT_BAR(2);} else if((tt)+2<NT){WAIT_BAR(1);} else {WAIT_BAR(0);} }while(0)
  for(;t+1<NT;t+=2){
    STEP(pB0,pB1,pA0,pA1,t,(t+3<NT),(t+1<NT),(t+1<NT));       ENDW(t);   RESC(); ROT();
    STEP(pA0,pA1,pB0,pB1,t+1,(t+4<NT),(t+2<NT),(t+2<NT));     ENDW(t+1); RESC(); ROT();
  }
  STEP(pB0,pB1,pA0,pA1,NT-1,false,false,false); RESC();
  { float sacc=pB0[0]+pB0[1]; _Pragma("unroll") for(int r=2;r<16;++r)sacc+=pB0[r]; _Pragma("unroll") for(int r=0;r<16;++r)sacc+=pB1[r]; l_reg+=sacc;
    pw0=(u32x4){PKW(pB0,0),PKW(pB0,2),PKW(pB0,4),PKW(pB0,6)};pw1=(u32x4){PKW(pB0,8),PKW(pB0,10),PKW(pB0,12),PKW(pB0,14)};pw2=(u32x4){PKW(pB1,0),PKW(pB1,2),PKW(pB1,4),PKW(pB1,6)};pw3=(u32x4){PKW(pB1,8),PKW(pB1,10),PKW(pB1,12),PKW(pB1,14)};
    SBAR(); pv(o,vb0+sl_cur,PAF(0),PAF(1),PAF(2),PAF(3)); }
  #undef PKW
  #undef PAF
  #undef VFR
  #undef PIN
  #undef MX3
  #undef GAPA
  #undef GAPB
  #undef EX
  #undef VRD
  #undef KRD
  #undef STEP
  #undef ENDW
  {auto rr=__builtin_amdgcn_permlane32_swap(__float_as_uint(l_reg),__float_as_uint(l_reg),false,false);l_reg=__uint_as_float(rr[0])+__uint_as_float(rr[1]);}
  if(hi==0)wsf[32+r32]=l_reg;asm volatile("s_waitcnt lgkmcnt(0)":::"memory");
  float rli[16];
  #pragma unroll
  for(int r=0;r<16;++r)rli[r]=__builtin_amdgcn_rcpf(wsf[32+crow(r,hi)]);
  bf16*Ow=Ou+(long)(wid*QBLK)*QP;
  { bf16*stg=(bf16*)(shm+LDS_OST)+wid*2048;
    #pragma unroll
    for(int r=0;r<16;++r){const int orow=crow(r,hi);
      #pragma unroll
      for(int d0=0;d0<2;++d0)stg[orow*64+d0*32+r32]=__float2bfloat16(o[d0][r]*rli[r]);}
    asm volatile("s_waitcnt lgkmcnt(0)":::"memory");
    #pragma unroll
    for(int i=0;i<4;++i){const int row=i*8+(lane>>3),ch=lane&7; const u32x4 v=*(const u32x4*)(stg+row*64+ch*8); ATTN_STORE16(Ow+(long)row*QP+ch*8,v);} }
  asm volatile("s_waitcnt lgkmcnt(0)\n\ts_barrier":::"memory");
  #undef DMA_K
  #undef DMA_V
  #undef CMASK
  #undef START
  #undef RESC
  #undef ROT
}
constexpr int ATTN_LDS_BYTES=LDS_BYTES;
#undef SBAR
#undef WAIT_BAR
}

template <bool WCTX>
__device__ __forceinline__ void phase_attn_fast(Frame& F, char* ldsg) {
    typedef attn_body::bf16 abf;
    const abf* Q = (const abf*)(F.ws + WS_QB); const abf* K = (const abf*)(F.ws + WS_KB); const abf* V = (const abf*)(F.ws + WS_VB); abf* O = (abf*)(F.ws + WS_Z);
    const int vcu = (F.G % 8 == 0) ? (F.blk % 8) * (F.G / 8) + F.blk / 8 : F.blk;
    const int nunits = WCTX ? 1024 + 128 : 1024;
    for (int u = vcu; u < nunits; u += F.G) {
        int h, kvh, qrow0, kv0, NT;
        if (u < 1024) { const int grp = u >> 5, b = grp >> 2; kvh = grp & 3; const int qb = (u >> 2) & 7; h = kvh * 4 + (u & 3); qrow0 = TC + b * SEQ + qb * 256; kv0 = b * KVLEN; NT = KVLEN / 64; }
        else { const int u2 = u - 1024, b = u2 >> 4; h = u2 & 15; kvh = h >> 2; qrow0 = b * CTX; kv0 = b * KVLEN + SEQ; NT = CTX / 64; }
        attn_body::attn_unit<8>(Q + (size_t)qrow0 * 1024 + h * 64, K + (size_t)kv0 * 256 + kvh * 64, V + (size_t)kv0 * 256 + kvh * 64, O + (size_t)qrow0 * 1024 + h * 64, NT, ldsg + RING_OFF);
    }
}

constexpr int S5_BU_STRIDE = 132;
constexpr int S5_X_STRIDE = 136;
constexpr int S5_BU_BYTES = 16 * S5_BU_STRIDE * 4, S5_X_BYTES = 16 * S5_X_STRIDE * 2, S5_Y_BYTES = 2 * 64 * 16, S5_U_BYTES = 64 * 16;
constexpr int S5_ITEM_LDS = S5_BU_BYTES + S5_X_BYTES + 2 * S5_Y_BYTES + 4 * S5_U_BYTES;
constexpr int S5_NT = (CTX + SEQ) / 32;
static_assert(4 * S5_ITEM_LDS <= RING_BYTES, "S5 LDS");
#define S5_BAR() do { asm volatile("s_waitcnt lgkmcnt(0)" ::: "memory"); __builtin_amdgcn_s_barrier(); asm volatile("" ::: "memory"); } while (0)
__device__ __forceinline__ f32x2 cmul(f32x2 a, f32x2 b) { return (f32x2){a.x * b.x - a.y * b.y, a.x * b.y + a.y * b.x}; }

template <int J, bool WCTX>
__device__ __forceinline__ void phase_s5_fast(Frame& F) {
    const int lane = F.lane, w = F.wave;
    const bool helper = w >= 4;
    const int iw = w & 3, pairi = iw >> 1, dir = iw & 1;
    const int tq = lane & 15, kg = lane >> 4;
    const bf16* hb = (const bf16*)(F.ws + WS_H); float* ypart = (float*)(F.ws + WS_YSUM); bf16* zb = (bf16*)(F.ws + WS_Z);
    LAS unsigned char* base = F.lds + iw * S5_ITEM_LDS;
    LAS float* BU = (LAS float*)base;
    LAS bf16* XS = (LAS bf16*)(base + S5_BU_BYTES);
    LAS f32x4* YL = (LAS f32x4*)(base + S5_BU_BYTES + S5_X_BYTES);
    LAS v4u* UL = (LAS v4u*)(base + S5_BU_BYTES + S5_X_BYTES + 2 * S5_Y_BYTES);
    for (int it0 = F.blk * 2; it0 < NB * 64; it0 += F.G * 2) {
        const int it = it0 + pairi, b = it >> 6, g = it & 63;
        const int gi = (J * 2 + dir) * 64 + g;
        LAS v4u* TAB = (LAS v4u*)(F.lds);
        LAS f32x2* CST = (LAS f32x2*)(F.lds + 65536);
        LAS float* KMS = (LAS float*)(F.lds + 65536 + 6144);
        static_assert(65536 + 6144 + 8192 <= 4 * S5_ITEM_LDS, "S5 set-up scratch inside the item buffers");
        if (F.tid < 256) { const int i = F.tid >> 6, p = F.tid & 63; const int git = (J * 2 + (i & 1)) * 64 + ((it0 + (i >> 1)) & 63);
            const float dt = expf(F.in[IN_S5LOG][git]);
            const float lr = F.in[IN_S5LRE][git * 64 + p], li = F.in[IN_S5LIM][git * 64 + p]; const float mag = expf(lr * dt); double sd, cd; sincos_d((double)(li * dt), sd, cd);
            const float ar = mag * (float)cd, ai = mag * (float)sd, den = lr * lr + li * li, nr = ar - 1.f, ni = ai;
            const f32x2 a = (f32x2){ar, ai};
            CST[(i * 3 + 0) * 64 + p] = a; CST[(i * 3 + 1) * 64 + p] = cmul(a, a); CST[(i * 3 + 2) * 64 + p] = (f32x2){(nr * lr + ni * li) / den, (ni * lr - nr * li) / den}; }
        __syncthreads();
        { const int ln = F.tid & 63, ltq = ln & 15, lkg = ln >> 4, wv = F.tid >> 6;
          f32x4 br[4][2], bi[4][2], cr[4], ci[4];
          const int n = 16 * wv + ltq, pw = n >> 1, ri = n & 1;
          const int tau = wv >> 2, ks = wv & 3, p0 = 16 * ks + 4 * lkg;
#pragma unroll
          for (int i = 0; i < 4; ++i) { const int git = (J * 2 + (i & 1)) * 64 + ((it0 + (i >> 1)) & 63);
              const float* brp = F.in[IN_S5BRE] + (size_t)git * 1024 + pw * 16 + 8 * (lkg & 1); const float* bip = F.in[IN_S5BIM] + (size_t)git * 1024 + pw * 16 + 8 * (lkg & 1);
              br[i][0] = *(const f32x4*)brp; br[i][1] = *(const f32x4*)(brp + 4); bi[i][0] = *(const f32x4*)bip; bi[i][1] = *(const f32x4*)(bip + 4);
              cr[i] = *(const f32x4*)(F.in[IN_S5CRE] + (size_t)git * 1024 + ltq * 64 + p0); ci[i] = *(const f32x4*)(F.in[IN_S5CIM] + (size_t)git * 1024 + ltq * 64 + p0); }
#pragma unroll
          for (int i = 0; i < 4; ++i) {
              unsigned o[4];
              { f32x2 co = CST[(i * 3 + 2) * 64 + pw]; if ((lkg >> 1) == 0) co = cmul(co, CST[(i * 3 + 0) * 64 + pw]);
                const float brv[8] = {br[i][0].x, br[i][0].y, br[i][0].z, br[i][0].w, br[i][1].x, br[i][1].y, br[i][1].z, br[i][1].w};
                const float biv[8] = {bi[i][0].x, bi[i][0].y, bi[i][0].z, bi[i][0].w, bi[i][1].x, bi[i][1].y, bi[i][1].z, bi[i][1].w};
#pragma unroll
                for (int q = 0; q < 4; ++q) { const f32x2 v0 = cmul(co, (f32x2){brv[2 * q], biv[2 * q]}), v1 = cmul(co, (f32x2){brv[2 * q + 1], biv[2 * q + 1]}); o[q] = pk2(ri ? v0.y : v0.x, ri ? v1.y : v1.x); }
                TAB[(i * 16 + wv) * 64 + ln] = (v4u){o[0], o[1], o[2], o[3]}; }
              { const float crv[4] = {cr[i].x, cr[i].y, cr[i].z, cr[i].w}, civ[4] = {ci[i].x, ci[i].y, ci[i].z, ci[i].w};
#pragma unroll
                for (int q = 0; q < 4; ++q) { const f32x2 v = cmul((f32x2){crv[q], civ[q]}, CST[(i * 3 + tau) * 64 + p0 + q]); o[q] = pk2(v.x, -v.y); }
                TAB[(i * 16 + 8 + wv) * 64 + ln] = (v4u){o[0], o[1], o[2], o[3]}; }
          } }
        __syncthreads();
        if (helper) {
            const f32x4 d4 = *(const f32x4*)(F.in[IN_S5D] + J * D + g * 16 + 4 * kg);
            v2u hwA0 = (v2u){0u, 0u}, hwA1 = hwA0, hwB0 = hwA0, hwB1 = hwA0;
            v4u ub[4]; f32x4 yoA0, yoA1, yoB0, yoB1;
#pragma unroll
            for (int k = 0; k < 4; ++k) ub[k] = *(const v4u*)(hb + (size_t)seq_row(b, dir, 32 * k + 2 * tq + (kg >> 1)) * D + g * 16 + 8 * (kg & 1));
            yoA0 = (f32x4){0.f, 0.f, 0.f, 0.f}; yoA1 = yoA0; yoB0 = yoA0; yoB1 = yoA0;
            S5_BAR();
#pragma unroll 4
            for (int T = -1; T < S5_NT + 3; ++T) {
                const int e = T - 1, d = T + 1;
                const bool e_ok = (e >= 0) && (e < S5_NT) && (WCTX || e >= 8);
                const bool e_second = (e < 8) ? (e >= 4) : (e >= 40);
                if (d >= 0 && d < S5_NT) UL[(d & 3) * 64 + lane] = ub[d & 3];
                if (e_ok) {
#pragma unroll
                    for (int tau = 0; tau < 2; ++tau) {
                        const size_t idx = (size_t)seq_row(b, dir, 32 * e + 2 * tq + tau) * D + g * 16 + 4 * kg;
                        const f32x4 y = YL[((e & 1) * 2 + tau) * 64 + lane];
                        if (!e_second) *(f32x4*)(ypart + idx) = y;
                        else {
                            f32x4 yo = (e & 1) ? (tau ? yoB1 : yoB0) : (tau ? yoA1 : yoA0);
                            if (e == 4 || e == 40) yo = *(const f32x4*)(ypart + idx);
                            const v2u hw = (e & 1) ? (tau ? hwB1 : hwB0) : (tau ? hwA1 : hwA0);
                            f32x4 v = y + yo; v.x += d4.x * bflo(hw.x); v.y += d4.y * bfhi(hw.x); v.z += d4.z * bflo(hw.y); v.w += d4.w * bfhi(hw.y);
                            v2u zo; zo.x = pk2(gelu_tanh(v.x), gelu_tanh(v.y)); zo.y = pk2(gelu_tanh(v.z), gelu_tanh(v.w));
                            *(v2u*)(zb + idx) = zo;
                        }
                    }
                }
                { const int e1 = e + 1; const bool e1_ok = (e1 >= 0) && (e1 < S5_NT) && (WCTX || e1 >= 8); const bool e1_second = (e1 < 8) ? (e1 >= 4) : (e1 >= 40);
                  if (e1_ok && e1_second) { const v2u h0 = *(const v2u*)(hb + (size_t)seq_row(b, dir, 32 * e1 + 2 * tq) * D + g * 16 + 4 * kg), h1 = *(const v2u*)(hb + (size_t)seq_row(b, dir, 32 * e1 + 2 * tq + 1) * D + g * 16 + 4 * kg);
                      if (e1 & 1) { hwB0 = h0; hwB1 = h1; } else { hwA0 = h0; hwA1 = h1; } }
                  if (e1_ok && e1_second && e1 != 4 && e1 != 40) {
                      const f32x4 l0 = *(const f32x4*)(ypart + (size_t)seq_row(b, dir, 32 * e1 + 2 * tq) * D + g * 16 + 4 * kg), l1 = *(const f32x4*)(ypart + (size_t)seq_row(b, dir, 32 * e1 + 2 * tq + 1) * D + g * 16 + 4 * kg);
                      if (e1 & 1) { yoB0 = l0; yoB1 = l1; } else { yoA0 = l0; yoA1 = l1; }
                  } }
                if (d >= 0 && d + 4 < S5_NT) ub[d & 3] = *(const v4u*)(hb + (size_t)seq_row(b, dir, 32 * (d + 4) + 2 * tq + (kg >> 1)) * D + g * 16 + 8 * (kg & 1));
                if (e == 3 || e == 39) asm volatile("s_waitcnt vmcnt(0)" ::: "memory");
                S5_BAR();
            }
        } else {
            const float* cre = F.in[IN_S5CRE] + (size_t)gi * 1024; const float* cim = F.in[IN_S5CIM] + (size_t)gi * 1024;
            bf16x8 wf[8], vkf[2][5];
#pragma unroll
            for (int rt = 0; rt < 8; ++rt) wf[rt] = __builtin_bit_cast(bf16x8, TAB[(iw * 16 + rt) * 64 + lane]);
#pragma unroll
            for (int tau = 0; tau < 2; ++tau)
#pragma unroll
                for (int ks = 0; ks < 4; ++ks) vkf[tau][ks] = __builtin_bit_cast(bf16x8, TAB[(iw * 16 + 8 + tau * 4 + ks) * 64 + lane]);
            const f32x2 a2 = CST[(iw * 3 + 1) * 64 + lane];
            { LAS float* KM = KMS + iw * 512;
              const LAS bf16* W2T = (const LAS bf16*)(TAB + (iw * 16) * 64);
#pragma unroll
              for (int e = 0; e < 2; ++e) {
                  f32x4 acc = (f32x4){0.f, 0.f, 0.f, 0.f};
#pragma unroll
                  for (int ks = 0; ks < 4; ++ks) {
                      bf16x8 cfr, fr;
                      const int p0 = 16 * ks + 4 * kg;
                      const f32x4 cr = *(const f32x4*)(cre + tq * 64 + p0), ci = *(const f32x4*)(cim + tq * 64 + p0);
                      cfr[0] = (short)f2bf(cr.x); cfr[1] = (short)f2bf(-ci.x); cfr[2] = (short)f2bf(cr.y); cfr[3] = (short)f2bf(-ci.y); cfr[4] = (short)f2bf(cr.z); cfr[5] = (short)f2bf(-ci.z); cfr[6] = (short)f2bf(cr.w); cfr[7] = (short)f2bf(-ci.w);
#pragma unroll
                      for (int jj = 0; jj < 8; ++jj) { const int n = 32 * ks + 8 * kg + jj, k = 16 * (1 - e) + tq; fr[jj] = (short)W2T[(((n >> 4) * 64) + (n & 15) + 16 * (k >> 3)) * 8 + (k & 7)]; }
                      acc = __builtin_amdgcn_mfma_f32_16x16x32_bf16(cfr, fr, acc, 0, 0, 0);
                  }
#pragma unroll
                  for (int r = 0; r < 4; ++r) KM[(e * 16 + 4 * kg + r) * 16 + tq] = acc[r];
              }
#pragma unroll
              for (int tau = 0; tau < 2; ++tau) { const int tp = kg >> 1; bf16x8 fr;
#pragma unroll
                  for (int jj = 0; jj < 8; ++jj) { const float v = (tp <= tau) ? KM[((tau - tp) * 16 + tq) * 16 + 8 * (kg & 1) + jj] : 0.f; fr[jj] = (short)f2bf(v); }
                  vkf[tau][4] = fr; } }
            asm volatile("s_waitcnt vmcnt(0) lgkmcnt(0)" ::: "memory");
            f32x2 x = (f32x2){0.f, 0.f};
            const f32x2 a2re = (f32x2){a2.x, a2.x}, a2im = (f32x2){-a2.y, a2.y};
            S5_BAR();
            for (int T = -1; T < S5_NT + 3; ++T) {
                if (T >= 0 && T < S5_NT) {
                    const bf16x8 uf = __builtin_bit_cast(bf16x8, UL[(T & 3) * 64 + lane]);
#pragma unroll
                    for (int rt = 0; rt < 8; ++rt) {
                        const f32x4 dacc = __builtin_amdgcn_mfma_f32_16x16x32_bf16(wf[rt], uf, (f32x4){0.f, 0.f, 0.f, 0.f}, 0, 0, 0);
                        *(LAS f32x4*)(BU + tq * S5_BU_STRIDE + 16 * rt + 4 * kg) = dacc;
                    }
                    f32x2 buv[16]; unsigned xw[16];
#pragma unroll
                    for (int t = 0; t < 16; ++t) buv[t] = *(const LAS f32x2*)(BU + t * S5_BU_STRIDE + 2 * lane);
#pragma unroll
                    for (int t = 0; t < 16; ++t) { xw[t] = pk2(x.x, x.y); const f32x2 xs = (f32x2){x.y, x.x}; x = a2re * x + (a2im * xs + buv[t]); }
                    if (WCTX || T >= 8) {
#pragma unroll
                        for (int t = 0; t < 16; ++t) *(LAS unsigned*)(XS + t * S5_X_STRIDE + 2 * lane) = xw[t];
                        bf16x8 xf[4];
#pragma unroll
                        for (int ks = 0; ks < 4; ++ks) xf[ks] = *(const LAS bf16x8*)(XS + tq * S5_X_STRIDE + 32 * ks + 8 * kg);
#pragma unroll
                        for (int tau = 0; tau < 2; ++tau) {
                            f32x4 y = __builtin_amdgcn_mfma_f32_16x16x32_bf16(vkf[tau][4], uf, (f32x4){0.f, 0.f, 0.f, 0.f}, 0, 0, 0);
#pragma unroll
                            for (int ks = 0; ks < 4; ++ks) y = __builtin_amdgcn_mfma_f32_16x16x32_bf16(vkf[tau][ks], xf[ks], y, 0, 0, 0);
                            YL[((T & 1) * 2 + tau) * 64 + lane] = y;
                        }
                    }
                }
                S5_BAR();
            }
        }
        __syncthreads();
    }
}

constexpr size_t WS_MCT = WS_MHS;
constexpr size_t WS_MN = WS_MG + 2359296;
constexpr size_t WS_MSC = WS_MN + 589824;
static_assert(WS_MSC + 2304 * 16 <= WS_MHS, "mLSTM small tables");
constexpr int ML_TS = 136;
constexpr int ML_DS = 72;

template <bool MAX>
__device__ __forceinline__ void scan128(LAS float* a, int lane) {
    const float v0 = a[2 * lane], v1 = a[2 * lane + 1];
    const float s = MAX ? fmaxf(v0, v1) : v0 + v1;
    float inc = s;
#pragma unroll
    for (int o = 1; o < 64; o <<= 1) { const float t = __shfl_up(inc, o); if (lane >= o) inc = MAX ? fmaxf(inc, t) : inc + t; }
    float exc = __shfl_up(inc, 1); if (lane == 0) exc = MAX ? -INFINITY : 0.f;
    a[2 * lane] = MAX ? fmaxf(exc, v0) : exc + v0; a[2 * lane + 1] = inc;
}

struct M1Regs { float gi, gf; v4u k[2], v[4]; };
__device__ __forceinline__ void m1_load(M1Regs& R, Frame& F, int u, int tid) {
    const bf16* kb = (const bf16*)(F.ws + WS_MK); const bf16* vb = (const bf16*)(F.ws + WS_MV); const float* gb = (const float*)(F.ws + WS_MG);
    const int jo = u % 18, bh = u / 18, hd = bh & 7, b = bh >> 3;
    const int row0 = (jo < 2) ? b * CTX + 128 * jo : TC + b * SEQ + 128 * (jo - 2);
    R.gi = 0.f; R.gf = 0.f;
    if (tid < 256) { const int dd = tid >> 7, sp = tid & 127; const int r = row0 + (dd ? 127 - sp : sp); R.gi = gb[(size_t)r * 32 + dd * 16 + hd]; R.gf = gb[(size_t)r * 32 + dd * 16 + 8 + hd]; }
    const int i = tid & 127, c = tid >> 7; const int r = row0 + i;
#pragma unroll
    for (int h2 = 0; h2 < 2; ++h2) R.k[h2] = *(const v4u*)(kb + (size_t)r * 512 + hd * 64 + 16 * c + 8 * h2);
#pragma unroll
    for (int h4 = 0; h4 < 4; ++h4) R.v[h4] = *(const v4u*)(vb + (size_t)r * 1024 + hd * 128 + 32 * c + 8 * h4);
}
__device__ __forceinline__ void phase_ml_states(Frame& F) {
    const int tid = F.tid, lane = F.lane, w = F.wave, tq = lane & 15, kg = lane >> 4;
    bf16* cT = (bf16*)(F.ws + WS_MCT); float* nl = (float*)(F.ws + WS_MN); float* sc = (float*)(F.ws + WS_MSC);
    LAS bf16* KeT = (LAS bf16*)(F.lds);
    LAS bf16* VT = (LAS bf16*)(F.lds + 128 * ML_TS * 2);
    LAS float* cumS = (LAS float*)(F.lds + 256 * ML_TS * 2);
    LAS float* igS = cumS + 256; LAS float* ewS = igS + 256;
    constexpr int NU = NB * 8 * 18;
    M1Regs R;
    if (F.blk < NU) m1_load(R, F, F.blk, tid);
    for (int u = F.blk; u < NU; u += F.G) {
        const int jo = u % 18, bh = u / 18, hd = bh & 7, b = bh >> 3;
        const int jc1 = (jo < 2) ? 1 - jo : 19 - jo;
        const size_t us0 = (size_t)((b * 8 + hd) * 2 + 0) * 18 + jo, us1 = (size_t)((b * 8 + hd) * 2 + 1) * 18 + jc1;
        if (tid < 256) { igS[tid] = R.gi; cumS[tid] = log_sigmoidf_(R.gf); }
        __syncthreads();
        if (w < 2) {
            LAS float* cs = cumS + 128 * w; LAS float* is = igS + 128 * w; LAS float* es = ewS + 128 * w;
            scan128<false>(cs, lane);
            const float total = __shfl(cs[2 * lane + 1], 63);
            const float w0 = total - cs[2 * lane] + is[2 * lane], w1 = total - cs[2 * lane + 1] + is[2 * lane + 1];
            const float ml = wave_max(fmaxf(w0, w1));
            es[2 * lane] = __expf(w0 - ml); es[2 * lane + 1] = __expf(w1 - ml);
            if (lane == 0) { const size_t us = w ? us1 : us0; sc[us * 4] = total; sc[us * 4 + 1] = ml; }
        }
        __syncthreads();
        { const int i = tid & 127, c = tid >> 7; const float e0 = ewS[i], e1 = ewS[128 + 127 - i];
#pragma unroll
          for (int h2 = 0; h2 < 2; ++h2) { const v4u kw = R.k[h2];
              const float kv[8] = {bflo(kw.x), bfhi(kw.x), bflo(kw.y), bfhi(kw.y), bflo(kw.z), bfhi(kw.z), bflo(kw.w), bfhi(kw.w)};
#pragma unroll
              for (int jj = 0; jj < 8; ++jj) { KeT[(16 * c + 8 * h2 + jj) * ML_TS + i] = (bf16)f2bf(kv[jj] * e0); KeT[(64 + 16 * c + 8 * h2 + jj) * ML_TS + i] = (bf16)f2bf(kv[jj] * e1); } }
#pragma unroll
          for (int h4 = 0; h4 < 4; ++h4) { const v4u vw = R.v[h4];
              const unsigned vv[4] = {vw.x, vw.y, vw.z, vw.w};
#pragma unroll
              for (int jj = 0; jj < 8; ++jj) VT[(32 * c + 8 * h4 + jj) * ML_TS + i] = (bf16)((jj & 1) ? (vv[jj >> 1] >> 16) : (vv[jj >> 1] & 0xffffu)); } }
        __syncthreads();
        if (u + F.G < NU) m1_load(R, F, u + F.G, tid);
#pragma unroll
        for (int dd = 0; dd < 2; ++dd) { const size_t us = dd ? us1 : us0;
#pragma unroll
            for (int dt = 0; dt < 4; ++dt) {
                f32x4 acc = (f32x4){0.f, 0.f, 0.f, 0.f};
#pragma unroll
                for (int ks = 0; ks < 4; ++ks) {
                    const bf16x8 af = *(const LAS bf16x8*)(VT + (16 * w + tq) * ML_TS + 32 * ks + 8 * kg);
                    const bf16x8 bfr = *(const LAS bf16x8*)(KeT + (64 * dd + 16 * dt + tq) * ML_TS + 32 * ks + 8 * kg);
                    acc = __builtin_amdgcn_mfma_f32_16x16x32_bf16(bfr, af, acc, 0, 0, 0);
                }
                v2u o; o.x = pk2(acc[0], acc[1]); o.y = pk2(acc[2], acc[3]);
                *(v2u*)(cT + us * 8192 + (16 * w + tq) * 64 + 16 * dt + 4 * kg) = o;
            } }
        if (tid < 128) { float sm = 0.f; const int dd = tid >> 6, d = tid & 63;
#pragma unroll
            for (int c8 = 0; c8 < 16; ++c8) { const v4u q = *(const LAS v4u*)(KeT + (64 * dd + d) * ML_TS + 8 * c8); sm += bflo(q.x) + bfhi(q.x) + bflo(q.y) + bfhi(q.y) + bflo(q.z) + bfhi(q.z) + bflo(q.w) + bfhi(q.w); }
            nl[(dd ? us1 : us0) * 64 + d] = sm; }
        __syncthreads();
    }
}

__device__ __forceinline__ void phase_ml_scan(Frame& F, const int skip = 0) {
    const int tid = F.tid;
    bf16* cT = (bf16*)(F.ws + WS_MCT); float* nl = (float*)(F.ws + WS_MN); float* sc = (float*)(F.ws + WS_MSC);
    for (int wi = F.blk; wi < 256; wi += F.G) {
        const int sq = wi >> 1, half = wi & 1; const bool don = (half == 0 && tid < 64);
        const size_t e0 = (size_t)half * 4096 + (size_t)tid * 8;
        f32x4 c0 = (f32x4){0.f, 0.f, 0.f, 0.f}, c1 = c0; float nn = 0.f, m = 0.f;
        const size_t us0 = (size_t)sq * 18;
        v4u lw[18]; float ln[18], tot[18], ml[18];
#pragma unroll
        for (int j = 0; j < 18; ++j) { const size_t us = us0 + j; lw[j] = *(const v4u*)(cT + us * 8192 + e0);
            ln[j] = don ? nl[us * 64 + tid] : 0.f; tot[j] = sc[us * 4]; ml[j] = sc[us * 4 + 1]; }
#pragma unroll
        for (int j = 0; j < 18; ++j) { const size_t us = us0 + j;
            if (!skip) { *(v4u*)(cT + us * 8192 + e0) = (v4u){pk2(c0.x, c0.y), pk2(c0.z, c0.w), pk2(c1.x, c1.y), pk2(c1.z, c1.w)};
                if (don) nl[us * 64 + tid] = nn;
                if (half == 0 && tid == 0) sc[us * 4 + 2] = m; }
            const float mn = fmaxf(tot[j] + m, ml[j]), fa = __expf(tot[j] + m - mn), fb = __expf(ml[j] - mn);
            const v4u t = lw[j]; const f32x4 a0 = (f32x4){bflo(t.x), bfhi(t.x), bflo(t.y), bfhi(t.y)}, a1 = (f32x4){bflo(t.z), bfhi(t.z), bflo(t.w), bfhi(t.w)};
            c0 = c0 * fa + a0 * fb; c1 = c1 * fa + a1 * fb; nn = nn * fa + ln[j] * fb; m = mn;
        }
    }
}

struct M3Regs { float gi, gf, n0v, m00, m01; v4u q[2], k[2], v[4]; };
__device__ __forceinline__ void m3_load(M3Regs& R, Frame& F, int u, int tid) {
    const bf16* kb = (const bf16*)(F.ws + WS_MK); const bf16* vb = (const bf16*)(F.ws + WS_MV); const bf16* qb = (const bf16*)(F.ws + WS_MQ);
    const float* gb = (const float*)(F.ws + WS_MG); const float* cT = (const float*)(F.ws + WS_MCT); const float* nl = (const float*)(F.ws + WS_MN); const float* sc = (const float*)(F.ws + WS_MSC);
    const int jo = u % 18, bh = u / 18, hd = bh & 7, b = bh >> 3;
    const int row0 = (jo < 2) ? b * CTX + 128 * jo : TC + b * SEQ + 128 * (jo - 2);
    const int jc1 = (jo < 2) ? 1 - jo : 19 - jo;
    const size_t us0 = (size_t)((b * 8 + hd) * 2 + 0) * 18 + jo, us1 = (size_t)((b * 8 + hd) * 2 + 1) * 18 + jc1;
    R.m00 = sc[us0 * 4 + 2]; R.m01 = sc[us1 * 4 + 2];
    R.gi = 0.f; R.gf = 0.f; R.n0v = 0.f;
    if (tid < 256) { const int dd = tid >> 7, sp = tid & 127; const int r = row0 + (dd ? 127 - sp : sp); R.gi = gb[(size_t)r * 32 + dd * 16 + hd]; R.gf = gb[(size_t)r * 32 + dd * 16 + 8 + hd]; }
    { const int i = tid & 127, c = tid >> 7; const int r = row0 + i;
#pragma unroll
      for (int h2 = 0; h2 < 2; ++h2) { R.q[h2] = *(const v4u*)(qb + (size_t)r * 512 + hd * 64 + 16 * c + 8 * h2); R.k[h2] = *(const v4u*)(kb + (size_t)r * 512 + hd * 64 + 16 * c + 8 * h2); } }
    { const int tp = tid & 63, c8 = tid >> 6;
#pragma unroll
      for (int tk = 0; tk < 2; ++tk)
#pragma unroll
          for (int h2 = 0; h2 < 2; ++h2) R.v[2 * tk + h2] = *(const v4u*)(vb + (size_t)(row0 + 2 * tp + tk) * 1024 + hd * 128 + 16 * c8 + 8 * h2); }
    if (tid < 128) R.n0v = nl[((tid >> 6) ? us1 : us0) * 64 + (tid & 63)];
}
__device__ __forceinline__ void phase_ml_out(Frame& F) {
    const int tid = F.tid, lane = F.lane, w = F.wave, tq = lane & 15, kg = lane >> 4;
    const bf16* ob = (const bf16*)(F.ws + WS_MO); bf16* zb = (bf16*)(F.ws + WS_Z);
    LAS bf16* QL = (LAS bf16*)(F.lds);
    LAS bf16* KL = (LAS bf16*)(F.lds + 18432);
    LAS bf16* SwL = (LAS bf16*)(F.lds + w * (16 * ML_TS * 2));
    LAS bf16* VT = (LAS bf16*)(F.lds + 36864);
    LAS bf16* C0T = (LAS bf16*)(F.lds + 36864 + 128 * ML_TS * 2);
    LAS float* GT = (LAS float*)(F.lds + 36864 + 128 * ML_TS * 2 + 2 * 144 * ML_DS * 2);
    LAS float* GNL = GT + 2 * 3 * 128;
    static_assert(36864 + 128 * ML_TS * 2 + 2 * 144 * ML_DS * 2 + 2 * 3 * 128 * 4 + 4096 <= RING_BYTES, "M3 LDS");
    for (int i = tid; i < 1024; i += NTHR) GNL[i] = F.in[IN_MLNG][i];
    for (int i = tid; i < 2 * 16 * ML_DS; i += NTHR) { const int dd = i / (16 * ML_DS), ii = i % (16 * ML_DS); C0T[dd * 144 * ML_DS + 128 * ML_DS + ii] = (bf16)0u; }
    constexpr int NU = NB * 8 * 18;
    M3Regs R;
    if (F.blk < NU) m3_load(R, F, F.blk, tid);
    __syncthreads();
    for (int u = F.blk; u < NU; u += F.G) {
        const int jo = u % 18, bh = u / 18, hd = bh & 7, b = bh >> 3;
        const int row0 = (jo < 2) ? b * CTX + 128 * jo : TC + b * SEQ + 128 * (jo - 2);
        const float m00 = R.m00, m01 = R.m01;
        if (tid < 256) { const int dd = tid >> 7, sp = tid & 127; GT[dd * 384 + sp] = R.gi; GT[dd * 384 + 256 + sp] = log_sigmoidf_(R.gf); }
        { const int i = tid & 127, c = tid >> 7;
#pragma unroll
          for (int h2 = 0; h2 < 2; ++h2) { *(LAS v4u*)(QL + i * ML_DS + 16 * c + 8 * h2) = R.q[h2]; *(LAS v4u*)(KL + i * ML_DS + 16 * c + 8 * h2) = R.k[h2]; } }
        { const int tp = tid & 63, c8 = tid >> 6;
#pragma unroll
          for (int h2 = 0; h2 < 2; ++h2) { const v4u a = R.v[h2], bq = R.v[2 + h2]; const unsigned av[4] = {a.x, a.y, a.z, a.w}, bv[4] = {bq.x, bq.y, bq.z, bq.w};
#pragma unroll
              for (int jj = 0; jj < 8; ++jj) { const unsigned lo = (jj & 1) ? (av[jj >> 1] >> 16) : (av[jj >> 1] & 0xffffu), hi = (jj & 1) ? (bv[jj >> 1] & 0xffff0000u) : (bv[jj >> 1] << 16);
                  *(LAS unsigned*)(VT + (16 * c8 + 8 * h2 + jj) * ML_TS + 2 * tp) = lo | hi; } } }
        { const bf16* cT = (const bf16*)(F.ws + WS_MCT); const int jc1 = (jo < 2) ? 1 - jo : 19 - jo;
          const size_t us0 = (size_t)((b * 8 + hd) * 2 + 0) * 18 + jo, us1 = (size_t)((b * 8 + hd) * 2 + 1) * 18 + jc1;
#pragma unroll
          for (int dd = 0; dd < 2; ++dd) { const size_t us = dd ? us1 : us0; const int jv = tid >> 2, dq = (tid & 3) * 16; const bf16* src = cT + us * 8192 + jv * 64 + dq;
#pragma unroll
              for (int h2 = 0; h2 < 2; ++h2) *(LAS v4u*)(C0T + dd * 144 * ML_DS + jv * ML_DS + dq + 8 * h2) = *(const v4u*)(src + 8 * h2); } }
        if (tid < 128) C0T[(tid >> 6) * 144 * ML_DS + 128 * ML_DS + (tid & 63)] = (bf16)f2bf(R.n0v);
        __syncthreads();
        if (u + F.G < NU) m3_load(R, F, u + F.G, tid);
        if (w < 2) {
            LAS float* gS = GT + w * 384; LAS float* mmS = gS + 128; LAS float* cumS = gS + 256; const float m0 = w ? m01 : m00;
            scan128<false>(cumS, lane);
            const float g0 = gS[2 * lane] - cumS[2 * lane], g1 = gS[2 * lane + 1] - cumS[2 * lane + 1];
            gS[2 * lane] = g0; gS[2 * lane + 1] = g1; mmS[2 * lane] = g0; mmS[2 * lane + 1] = g1;
            scan128<true>(mmS, lane);
            mmS[2 * lane] = fmaxf(mmS[2 * lane], m0); mmS[2 * lane + 1] = fmaxf(mmS[2 * lane + 1], m0);
        }
        __syncthreads();
        bf16x8 qf[2];
#pragma unroll
        for (int ks = 0; ks < 2; ++ks) qf[ks] = *(const LAS bf16x8*)(QL + (16 * w + tq) * ML_DS + 32 * ks + 8 * kg);
        float mm0r[4], mm1r[4], ai0[4], ai1[4], lb0[4], lb1[4];
#pragma unroll
        for (int r = 0; r < 4; ++r) { const int t0 = 16 * w + 4 * kg + r, t1 = 127 - t0;
            mm0r[r] = GT[128 + t0]; ai0[r] = __expf(m00 - mm0r[r]); lb0[r] = __expf(-GT[256 + t0] - mm0r[r]);
            mm1r[r] = GT[384 + 128 + t1]; ai1[r] = __expf(m01 - mm1r[r]); lb1[r] = __expf(-GT[384 + 256 + t1] - mm1r[r]); }
        f32x4 sraw[8]; float rs0[4] = {0.f, 0.f, 0.f, 0.f}, rs1[4] = {0.f, 0.f, 0.f, 0.f};
#pragma unroll
        for (int ct = 0; ct < 8; ++ct) {
            f32x4 a = (f32x4){0.f, 0.f, 0.f, 0.f};
#pragma unroll
            for (int ks = 0; ks < 2; ++ks) a = __builtin_amdgcn_mfma_f32_16x16x32_bf16(qf[ks], *(const LAS bf16x8*)(KL + (16 * ct + tq) * ML_DS + 32 * ks + 8 * kg), a, 0, 0, 0);
            sraw[ct] = a;
            const int o = 16 * ct + tq; const float g0o = GT[o], g1o = GT[384 + 127 - o];
#pragma unroll
            for (int r = 0; r < 4; ++r) { const int t0 = 16 * w + 4 * kg + r;
                rs0[r] += (o <= t0) ? a[r] * __expf(g0o - mm0r[r]) : 0.f; rs1[r] += (o >= t0) ? a[r] * __expf(g1o - mm1r[r]) : 0.f; }
        }
        f32x4 acc[8]; float sc0[4], sc1[4];
        {
            f32x4 q0 = (f32x4){0.f, 0.f, 0.f, 0.f}, q1 = q0;
#pragma unroll
            for (int ks = 0; ks < 2; ++ks) { q0 = __builtin_amdgcn_mfma_f32_16x16x32_bf16(qf[ks], *(const LAS bf16x8*)(C0T + (128 + tq) * ML_DS + 32 * ks + 8 * kg), q0, 0, 0, 0);
                                             q1 = __builtin_amdgcn_mfma_f32_16x16x32_bf16(qf[ks], *(const LAS bf16x8*)(C0T + 144 * ML_DS + (128 + tq) * ML_DS + 32 * ks + 8 * kg), q1, 0, 0, 0); }
#pragma unroll
            for (int r = 0; r < 4; ++r) {
                const float qn0 = red16_sum(q0[r]), qn1 = red16_sum(q1[r]);
                const float den0 = ai0[r] * qn0 + red16_sum(rs0[r]), den1 = ai1[r] * qn1 + red16_sum(rs1[r]);
                const float inv0 = __builtin_amdgcn_rcpf(fmaxf(fabsf(den0), lb0[r])), inv1 = __builtin_amdgcn_rcpf(fmaxf(fabsf(den1), lb1[r]));
                rs0[r] = inv0; rs1[r] = inv1; sc0[r] = ai0[r] * inv0; sc1[r] = ai1[r] * inv1; }
        }
#pragma unroll
        for (int ct = 0; ct < 8; ++ct) {
            f32x4 a0 = (f32x4){0.f, 0.f, 0.f, 0.f}, a1 = a0;
#pragma unroll
            for (int ks = 0; ks < 2; ++ks) { a0 = __builtin_amdgcn_mfma_f32_16x16x32_bf16(qf[ks], *(const LAS bf16x8*)(C0T + (16 * ct + tq) * ML_DS + 32 * ks + 8 * kg), a0, 0, 0, 0);
                                             a1 = __builtin_amdgcn_mfma_f32_16x16x32_bf16(qf[ks], *(const LAS bf16x8*)(C0T + 144 * ML_DS + (16 * ct + tq) * ML_DS + 32 * ks + 8 * kg), a1, 0, 0, 0); }
#pragma unroll
            for (int r = 0; r < 4; ++r) acc[ct][r] = a0[r] * sc0[r] + a1[r] * sc1[r];
        }
        __syncthreads();
        v4u ovr[4];
#pragma unroll
        for (int i = 0; i < 4; ++i) ovr[i] = *(const v4u*)(ob + (size_t)(row0 + 16 * w + 4 * i + kg) * D + hd * 128 + 8 * tq);
#pragma unroll
        for (int ct = 0; ct < 8; ++ct) { const int o = 16 * ct + tq; const float g0o = GT[o], g1o = GT[384 + 127 - o];
#pragma unroll
            for (int r = 0; r < 4; ++r) { const int t0 = 16 * w + 4 * kg + r;
                const float x0 = (o <= t0) ? __expf(g0o - mm0r[r]) * rs0[r] : 0.f, x1 = (o >= t0) ? __expf(g1o - mm1r[r]) * rs1[r] : 0.f;
                SwL[(4 * kg + r) * ML_TS + 16 * ct + tq] = (bf16)f2bf(sraw[ct][r] * (x0 + x1)); } }
#pragma unroll
        for (int ks = 0; ks < 4; ++ks) {
            const bf16x8 af = *(const LAS bf16x8*)(SwL + tq * ML_TS + 32 * ks + 8 * kg);
#pragma unroll
            for (int ct = 0; ct < 8; ++ct) acc[ct] = __builtin_amdgcn_mfma_f32_16x16x32_bf16(af, *(const LAS bf16x8*)(VT + (16 * ct + tq) * ML_TS + 32 * ks + 8 * kg), acc[ct], 0, 0, 0);
        }
        float ss[4] = {0.f, 0.f, 0.f, 0.f};
#pragma unroll
        for (int ct = 0; ct < 8; ++ct) { ss[0] += acc[ct].x * acc[ct].x; ss[1] += acc[ct].y * acc[ct].y; ss[2] += acc[ct].z * acc[ct].z; ss[3] += acc[ct].w * acc[ct].w; }
#pragma unroll
        for (int r = 0; r < 4; ++r) ss[r] = rsqrtf(red16_sum(ss[r]) * (1.f / 128.f) + EPS);
#pragma unroll
        for (int ct = 0; ct < 8; ++ct) { const float gn = GNL[hd * 128 + 16 * ct + tq];
#pragma unroll
            for (int r = 0; r < 4; ++r) SwL[(4 * kg + r) * ML_TS + 16 * ct + tq] = (bf16)f2bf(acc[ct][r] * ss[r] * gn); }
#pragma unroll
        for (int i = 0; i < 4; ++i) { const int rr = 4 * i + kg, ch = tq;
            const v4u hv = *(const LAS v4u*)(SwL + rr * ML_TS + 8 * ch);
            const size_t idx = (size_t)(row0 + 16 * w + rr) * D + hd * 128 + 8 * ch;
            const v4u ov = ovr[i];
            v4u zo; zo.x = pk2(bflo(hv.x) * sigmoidf_(bflo(ov.x)), bfhi(hv.x) * sigmoidf_(bfhi(ov.x))); zo.y = pk2(bflo(hv.y) * sigmoidf_(bflo(ov.y)), bfhi(hv.y) * sigmoidf_(bfhi(ov.y)));
            zo.z = pk2(bflo(hv.z) * sigmoidf_(bflo(ov.z)), bfhi(hv.z) * sigmoidf_(bfhi(ov.z))); zo.w = pk2(bflo(hv.w) * sigmoidf_(bflo(ov.w)), bfhi(hv.w) * sigmoidf_(bfhi(ov.w)));
            *(v4u*)(zb + idx) = zo; }
        __syncthreads();
    }
}

#ifndef USE_NAIVE_ATTN
#define USE_NAIVE_ATTN 0
#endif
#ifndef USE_NAIVE_S5
#define USE_NAIVE_S5 0
#endif
#ifndef USE_NAIVE_MLSTM
#define USE_NAIVE_MLSTM 0
#endif
#ifndef MK_MODE
#define MK_MODE 0
#endif
struct Args { const float* in[N_INPUTS]; float* out; unsigned char* ws; int ph_lo, ph_hi; };
enum { CBASE = __COUNTER__ + 1 };
#ifndef S5VAR
#define S5VAR 0
#endif
#ifndef DUP_A
#define DUP_A -1
#endif
#ifndef DUP_B
#define DUP_B -1
#endif
#define PHASE_IDS() { int t_ = threadIdx.x; asm volatile("" : "+v"(t_)); F.tid = t_; F.lane = t_ & 63; F.wave = __builtin_amdgcn_readfirstlane(t_ >> 6); }
#ifndef SW_PHASE
#define SW_PHASE -1
#endif
#define PHASE(...) { constexpr int k_ = __COUNTER__ - CBASE; if (lo <= k_ && k_ < hi) { PHASE_IDS() unsigned long long swt_ = 0; if (k_ == SW_PHASE) swt_ = __builtin_amdgcn_s_memtime(); \
    { constexpr int rep_ = 0; (void)rep_; __VA_ARGS__ } \
    if constexpr (k_ == DUP_A || k_ == DUP_B) { xcd_barrier(bar); { constexpr int rep_ = 1; (void)rep_; __VA_ARGS__ } } \
    if (k_ + 1 < hi) xcd_barrier(bar); \
    if (k_ == SW_PHASE && F.blk == 0 && threadIdx.x == 0) F.ctl[64] = (unsigned)((__builtin_amdgcn_s_memtime() - swt_) >> 4); } }

__global__ void __launch_bounds__(NTHR, 2) fwd_kernel(Args args) {
    extern __shared__ __attribute__((aligned(16))) unsigned char lds[];
    Frame F;
    F.lds = (LAS unsigned char*)lds;
    F.MISC = (volatile LAS unsigned*)(F.lds + MISC_OFF);
    F.tid = threadIdx.x; F.lane = F.tid & 63; F.wave = __builtin_amdgcn_readfirstlane(F.tid >> 6);
    F.G = gridDim.x; F.blk = blockIdx.x;
    F.ws = args.ws; F.out = args.out; F.ctl = (unsigned*)(args.ws + WS_CTL);
#pragma unroll
    for (int i = 0; i < N_INPUTS; ++i) F.in[i] = args.in[i];
    for (int u = F.tid; u < (LDS_BYTES - LDSCTL_OFF) / 4; u += NTHR) ((LAS unsigned*)(F.lds + LDSCTL_OFF))[u] = 0u;
    __syncthreads();
    const int lo = args.ph_lo, hi = args.ph_hi;
    XcdBarrier bar; bar.bar = F.ctl + CW_BAR; bar.x = 0; bar.st = nullptr;
    if (hi - lo > 1) bar = xcd_barrier_post(F.ctl + CW_BAR, F.MISC + 8);

    unsigned char* ws = F.ws;
    bf16* xres = (bf16*)(ws + WS_XRES); const float* mod = (const float*)(ws + WS_MOD);
    bf16* hb = (bf16*)(ws + WS_H); bf16* zb = (bf16*)(ws + WS_Z);
    const LAS int* etab = (const LAS int*)(F.lds + ETAB_OFF);

#define MOE_PHASES(L) \
    PHASE(phase_n2<L>(F, rep_);) \
    PHASE({ load_etab(F, L); pg8::Gemm g{(const bf16*)(ws + WS_H), (const bf16*)(ws + WS_WG1) + (size_t)(L) * NEXP * 1024 * 1024, SLOTS, NEXP * 1024, 1024, (const int*)(ws + WS_SLOTRE)}; \
               MoeSched S{etab, F.G, F.blk, 4}; EpiG1 E{(bf16*)(ws + WS_HID)}; run_gemm_gather(F, g, S, E); }) \
    PHASE({ load_etab(F, L, false); pg8::Gemm g{(const bf16*)(ws + WS_HID), (const bf16*)(ws + WS_WG2) + (size_t)(L) * NEXP * 1024 * 512, SLOTS, NEXP * 1024, 512}; \
               MoeSched S{etab, F.G, F.blk, 4}; EpiG2 E{(bf16*)(ws + WS_Y2)}; run_gemm(F, g, S, E); })

    PHASE(phase_prologue(F);)
    PHASE(phase_a1<0>(F, rep_);)
#if USE_NAIVE_S5
    PHASE(phase_s5_naive<0, true>(F);)
    PHASE(phase_s5_combine<0, true>(F);)
#else
    PHASE(phase_s5_fast<0, true>(F);)
#endif
    PHASE({ pg8::Gemm g{zb, (const bf16*)(ws + WS_WGLU), T, 2048, 1024}; DenseSchedH S; S.init(T, 2048, F.G, F.blk, 0);
               EpiGlu E{xres, mod + 0 * 9 * 6144 + 2048, F.in[IN_S5BGLU], rep_}; run_gemm(F, g, S, E); })
    MOE_PHASES(0)
    PHASE(phase_a1<1>(F, rep_);)
    PHASE({ pg8::Gemm g{hb, (const bf16*)(ws + WS_WKVQ), T, 1536, 1024}; DenseSched S; S.init(T, 1536, F.G, F.blk, 0);
               EpiKvq E{(bf16*)(ws + WS_QB), (bf16*)(ws + WS_KB), (bf16*)(ws + WS_VB), F.in[IN_AQG], F.in[IN_AKG], (const float*)(ws + WS_ROPE)}; run_gemm(F, g, S, E); })
#if USE_NAIVE_ATTN
    PHASE(phase_attn_naive<true>(F);)
#else
    PHASE(phase_attn_fast<true>(F, (char*)lds);)
#endif
    PHASE({ pg8::Gemm g{zb, (const bf16*)(ws + WS_WO), T, 1024, 1024}; DenseSchedH S; S.init(T, 1024, F.G, F.blk, 0);
               EpiRes E{xres, mod + 1 * 9 * 6144 + 2048, rep_, (bf16*)(ws + WS_MIX)}; run_gemm(F, g, S, E); })
    MOE_PHASES(1)
    PHASE(phase_a1<2>(F, rep_);)
    PHASE({ pg8::Gemm g{hb, (const bf16*)(ws + WS_WIN), T, ML_NIN, 1024}; DenseSched S; S.init(T, ML_NIN, F.G, F.blk, 0);
               EpiMlIn E{(bf16*)(ws + WS_MK), (bf16*)(ws + WS_MV), (bf16*)(ws + WS_MQ), (bf16*)(ws + WS_MO), (float*)(ws + WS_MG), F.in[IN_MLBG]}; run_gemm(F, g, S, E); })
#if USE_NAIVE_MLSTM
    PHASE(phase_mlstm_naive<true>(F);)
    PHASE(phase_mlstm_combine<true>(F);)
#else
    PHASE(phase_ml_states(F);)
    PHASE(phase_ml_scan(F, rep_);)
    PHASE(phase_ml_out(F);)
#endif
    PHASE({ pg8::Gemm g{zb, (const bf16*)(ws + WS_WOUT), T, 1024, 1024}; DenseSchedH S; S.init(T, 1024, F.G, F.blk, 0);
               EpiRes E{xres, mod + 2 * 9 * 6144 + 2048, rep_, (bf16*)(ws + WS_MHS)}; run_gemm(F, g, S, E); })
    MOE_PHASES(2)
    PHASE(phase_a1<3>(F, rep_);)
#if USE_NAIVE_S5
    PHASE(phase_s5_naive<1, false>(F);)
    PHASE(phase_s5_combine<1, false>(F);)
#else
    PHASE(phase_s5_fast<1, false>(F);)
#endif
    PHASE({ pg8::Gemm g{zb, (const bf16*)(ws + WS_WGLU) + (size_t)2048 * 1024, T, 2048, 1024}; DenseSched S; S.init(TL, 2048, F.G, F.blk, TC / 256);
               EpiGlu E{xres, mod + 3 * 9 * 6144 + 2048, F.in[IN_S5BGLU] + 2048, rep_}; run_gemm(F, g, S, E); })
    MOE_PHASES(3)
    PHASE(phase_fin(F);)
#ifdef RD_TILES
#ifndef RD_MUL
#define RD_MUL 1ull
#endif
    if (F.blk == 0 && threadIdx.x == 0) { unsigned tiles = 0; for (int e = 0; e < 16; ++e) tiles += (__hip_atomic_load(F.ctl + CTL_GCNT + RD_TILES * 64 + e, __ATOMIC_RELAXED, __HIP_MEMORY_SCOPE_AGENT) + 255u) >> 8;
#ifdef RD_CONST
        tiles = RD_CONST;
#endif
        const unsigned long long t0 = __builtin_amdgcn_s_memtime(); while (__builtin_amdgcn_s_memtime() - t0 < (unsigned long long)tiles * 1600ull * RD_MUL) __builtin_amdgcn_s_sleep(8); }
#endif
#if SW_PHASE >= 0
    if (F.blk == 0 && threadIdx.x == 0) { const unsigned v = __hip_atomic_load(F.ctl + 64, __ATOMIC_RELAXED, __HIP_MEMORY_SCOPE_AGENT); const unsigned long long t0 = __builtin_amdgcn_s_memtime();
        while (__builtin_amdgcn_s_memtime() - t0 < (unsigned long long)v * 16ull * 16ull) __builtin_amdgcn_s_sleep(8); }
#endif
}
constexpr int NPH = __COUNTER__ - CBASE;

extern "C" void kernel_launch(void* const* d_in, const int* in_sizes, int n_in, void* d_out, int out_size, void* d_ws, size_t ws_size, hipStream_t stream) {
    static int grid = 0;
    if (grid == 0) {
        if (n_in != N_INPUTS || out_size != TL * D || ws_size < WS_END) { fprintf(stderr, "kernel_launch: unexpected problem: n_in %d out %d ws %zu (need %zu)\n", n_in, out_size, ws_size, (size_t)WS_END); grid = -1; return; }
        int dev = 0, cus = 0, per_cu = 0;
        if (hipGetDevice(&dev) != hipSuccess || hipDeviceGetAttribute(&cus, hipDeviceAttributeMultiprocessorCount, dev) != hipSuccess) { grid = -1; return; }
        if (hipFuncSetAttribute((const void*)fwd_kernel, hipFuncAttributeMaxDynamicSharedMemorySize, LDS_BYTES) != hipSuccess) { fprintf(stderr, "kernel_launch: hipFuncSetAttribute failed\n"); grid = -1; return; }
        if (hipOccupancyMaxActiveBlocksPerMultiprocessor(&per_cu, (const void*)fwd_kernel, NTHR, LDS_BYTES) != hipSuccess || per_cu < 1) fprintf(stderr, "kernel_launch: occupancy query reports %d\n", per_cu);
        (void)hipGetLastError();
        grid = cus;
        if (grid > 256) grid = 256;
    }
    if (grid < 0) return;
    if (hipMemsetAsync((char*)d_ws + WS_CTL, 0, CTL_ZERO_BYTES, stream) != hipSuccess) return;
    Args a{};
    for (int i = 0; i < N_INPUTS; ++i) a.in[i] = (const float*)d_in[i];
    a.out = (float*)d_out; a.ws = (unsigned char*)d_ws;
#if MK_MODE == 0
    a.ph_lo = 0; a.ph_hi = NPH;
    hipLaunchKernelGGL(fwd_kernel, dim3(grid), dim3(NTHR), LDS_BYTES, stream, a);
#else
    for (int p = 0; p < NPH; ++p) { a.ph_lo = p; a.ph_hi = p + 1; hipLaunchKernelGGL(fwd_kernel, dim3(grid), dim3(NTHR), LDS_BYTES, stream, a); }
#endif
}
```
